# Optimizing an MI355X kernel written in HIP

```python
import math
import jax, jax.numpy as jnp
from jax import lax
import numpy as np

D_MODEL = 1024
BATCH = 8
SEQ = 2048
DEPTH = 2
DEC_BATCH = 128
DEC_SEQ = 8
PAST_LEN = 16384
PAGE_SIZE = 128

N_MIXERS = 2
N_SSM_LAYERS = (DEPTH + 1) // 2
N_CONV_LAYERS = DEPTH // 2
GROUP_SIZE = 16
N_GROUPS = D_MODEL // GROUP_SIZE
P_STATE = 64
D_CONV = D_MODEL
CONV_W = 3
D_FF = 4 * D_MODEL
EPS = 1e-6
DT_MIN = 1e-3
DT_MAX = 1e-1

kernel_name = "s5_shortconv_macaron_decode_step"


def _rmsnorm(x, g):
    xf = x.astype(jnp.float32)
    y = xf * lax.rsqrt(jnp.mean(xf * xf, axis=-1, keepdims=True) + EPS) * g.astype(jnp.float32)
    return y.astype(x.dtype)


def _ffn_half(x, g, w_gu, w_down):
    h = _rmsnorm(x, g)
    gate, up = jnp.split(h @ w_gu, 2, axis=-1)
    return (jax.nn.silu(gate) * up) @ w_down


def _ssm_combine(e1, e2):
    a1r, a1i, b1r, b1i = e1
    a2r, a2i, b2r, b2i = e2
    ar = a2r * a1r - a2i * a1i
    ai = a2r * a1i + a2i * a1r
    br = a2r * b1r - a2i * b1i + b2r
    bi = a2r * b1i + a2i * b1r + b2i
    return (ar, ai, br, bi)


def _s5_mixer(h, s0_re, s0_im, lam_re, lam_im, log_dt, b_re, b_im, c_re, c_im, d_skip, w_glu):
    f32 = jnp.float32
    lam_re = lam_re.astype(f32); lam_im = lam_im.astype(f32)
    dt = jnp.exp(log_dt.astype(f32))[:, None]
    mag = jnp.exp(lam_re * dt)
    lb_re = mag * jnp.cos(lam_im * dt)
    lb_im = mag * jnp.sin(lam_im * dt)
    den = lam_re * lam_re + lam_im * lam_im
    nr = lb_re - 1.0
    ni = lb_im
    f_re = (nr * lam_re + ni * lam_im) / den
    f_im = (ni * lam_re - nr * lam_im) / den
    b_re = b_re.astype(f32); b_im = b_im.astype(f32)
    bb_re = f_re[..., None] * b_re - f_im[..., None] * b_im
    bb_im = f_re[..., None] * b_im + f_im[..., None] * b_re
    c_re = c_re.astype(f32); c_im = c_im.astype(f32)
    d_skip = d_skip.astype(f32)

    def one_seq(args):
        u, sr, si = args
        L = u.shape[0]
        u = u.astype(f32)
        ug = u.reshape(L, N_GROUPS, GROUP_SIZE)
        bu_re = jnp.einsum('gpc,lgc->lgp', bb_re, ug)
        bu_im = jnp.einsum('gpc,lgc->lgp', bb_im, ug)
        sr = sr.astype(f32); si = si.astype(f32)
        bu_re = bu_re.at[0].add(lb_re * sr - lb_im * si)
        bu_im = bu_im.at[0].add(lb_re * si + lb_im * sr)
        a_re = jnp.broadcast_to(lb_re, bu_re.shape)
        a_im = jnp.broadcast_to(lb_im, bu_im.shape)
        _, _, hs_re, hs_im = lax.associative_scan(_ssm_combine, (a_re, a_im, bu_re, bu_im), axis=0)
        y = (jnp.einsum('gcp,lgp->lgc', c_re, hs_re) - jnp.einsum('gcp,lgp->lgc', c_im, hs_im))
        y = y.reshape(L, D_MODEL) + d_skip * u
        return y, hs_re[-1], hs_im[-1]

    y, new_re, new_im = lax.map(one_seq, (h, s0_re, s0_im))
    g = jax.nn.gelu(y)
    ga, gb = jnp.split(g @ w_glu.astype(f32), 2, axis=-1)
    return ga * jax.nn.sigmoid(gb), new_re, new_im


def _conv_mixer(h, buf, w_in, conv_w, w_out):
    gb, gc, v = jnp.split(h @ w_in, 3, axis=-1)
    z = gc * v
    zp = jnp.concatenate([buf.astype(z.dtype), z], axis=1)
    L = h.shape[1]
    conv = conv_w[0] * zp[:, 0:L]
    for k in range(1, CONV_W):
        conv = conv + conv_w[k] * zp[:, k:k + L]
    return (gb * conv) @ w_out, zp[:, zp.shape[1] - (CONV_W - 1):]


def setup_inputs(seed: int = 0) -> dict:
    key = jax.random.key(seed)
    ks = jax.random.split(key, 24)
    f32 = jnp.float32
    x_prompt = jax.random.normal(ks[0], (BATCH, SEQ, D_MODEL), f32)
    x_sample = jax.random.normal(ks[1], (DEC_BATCH, DEC_SEQ, D_MODEL), f32)
    state_ssm_re = 0.5 * jax.random.normal(ks[2], (N_SSM_LAYERS, DEC_BATCH, N_GROUPS, P_STATE), f32)
    state_ssm_im = 0.5 * jax.random.normal(ks[3], (N_SSM_LAYERS, DEC_BATCH, N_GROUPS, P_STATE), f32)
    cache_conv = 0.5 * jax.random.normal(ks[4], (N_CONV_LAYERS, DEC_BATCH, CONV_W - 1, D_CONV), f32)

    norm_g = 1.0 + 0.05 * jax.random.normal(ks[5], (DEPTH, 3, D_MODEL), f32)
    final_norm_g = 1.0 + 0.05 * jax.random.normal(ks[6], (D_MODEL,), f32)
    ffn_w_gate_up = jax.random.normal(ks[7], (DEPTH, 2, D_MODEL, 2 * D_FF), f32) * D_MODEL ** -0.5
    ffn_w_down = jax.random.normal(ks[8], (DEPTH, 2, D_FF, D_MODEL), f32) * D_FF ** -0.5

    n = jnp.arange(P_STATE, dtype=f32)
    ssm_lam_re = -0.5 + 0.01 * jax.random.normal(ks[9], (N_SSM_LAYERS, N_GROUPS, P_STATE), f32)
    ssm_lam_im = math.pi * n + 0.01 * jax.random.normal(ks[10], (N_SSM_LAYERS, N_GROUPS, P_STATE), f32)
    ssm_log_dt = jax.random.uniform(ks[11], (N_SSM_LAYERS, N_GROUPS), f32,
                                    minval=math.log(DT_MIN), maxval=math.log(DT_MAX))
    bscale = (2.0 * GROUP_SIZE) ** -0.5
    ssm_b_re = jax.random.normal(ks[12], (N_SSM_LAYERS, N_GROUPS, P_STATE, GROUP_SIZE), f32) * bscale
    ssm_b_im = jax.random.normal(ks[13], (N_SSM_LAYERS, N_GROUPS, P_STATE, GROUP_SIZE), f32) * bscale
    cscale = (2.0 * P_STATE) ** -0.5
    ssm_c_re = jax.random.normal(ks[14], (N_SSM_LAYERS, N_GROUPS, GROUP_SIZE, P_STATE), f32) * cscale
    ssm_c_im = jax.random.normal(ks[15], (N_SSM_LAYERS, N_GROUPS, GROUP_SIZE, P_STATE), f32) * cscale
    ssm_d = jax.random.normal(ks[16], (N_SSM_LAYERS, D_MODEL), f32)
    ssm_w_glu = jax.random.normal(ks[17], (N_SSM_LAYERS, D_MODEL, 2 * D_MODEL), f32) * D_MODEL ** -0.5

    conv_w_in = jax.random.normal(ks[18], (N_CONV_LAYERS, D_MODEL, 3 * D_CONV), f32) * D_MODEL ** -0.5
    conv_w = jax.random.normal(ks[19], (N_CONV_LAYERS, CONV_W, D_CONV), f32) * CONV_W ** -0.5
    conv_w_out = jax.random.normal(ks[20], (N_CONV_LAYERS, D_CONV, D_MODEL), f32) * D_CONV ** -0.5
    return {"x_prompt": x_prompt, "x_sample": x_sample,
            "state_ssm_re": state_ssm_re, "state_ssm_im": state_ssm_im, "cache_conv": cache_conv,
            "norm_g": norm_g, "final_norm_g": final_norm_g,
            "ffn_w_gate_up": ffn_w_gate_up, "ffn_w_down": ffn_w_down,
            "ssm_lam_re": ssm_lam_re, "ssm_lam_im": ssm_lam_im, "ssm_log_dt": ssm_log_dt,
            "ssm_b_re": ssm_b_re, "ssm_b_im": ssm_b_im, "ssm_c_re": ssm_c_re, "ssm_c_im": ssm_c_im,
            "ssm_d": ssm_d, "ssm_w_glu": ssm_w_glu,
            "conv_w_in": conv_w_in, "conv_w": conv_w, "conv_w_out": conv_w_out}


def reference(x_prompt, x_sample, state_ssm_re, state_ssm_im, cache_conv,
              norm_g, final_norm_g, ffn_w_gate_up, ffn_w_down,
              ssm_lam_re, ssm_lam_im, ssm_log_dt, ssm_b_re, ssm_b_im, ssm_c_re, ssm_c_im,
              ssm_d, ssm_w_glu, conv_w_in, conv_w, conv_w_out):
    nb = x_prompt.shape[0]
    zero_re = jnp.zeros((N_SSM_LAYERS, nb, N_GROUPS, P_STATE), jnp.float32)
    zero_im = jnp.zeros((N_SSM_LAYERS, nb, N_GROUPS, P_STATE), jnp.float32)
    zero_buf = jnp.zeros((N_CONV_LAYERS, nb, CONV_W - 1, D_CONV), x_prompt.dtype)
    groups = ((x_prompt, zero_re, zero_im, zero_buf),
              (x_sample, state_ssm_re, state_ssm_im, cache_conv))
    outs = []
    for x, s_re, s_im, buf in groups:
        new_re, new_im, new_buf = [], [], []
        for i in range(DEPTH):
            x = x + 0.5 * _ffn_half(x, norm_g[i, 0], ffn_w_gate_up[i, 0], ffn_w_down[i, 0])
            h = _rmsnorm(x, norm_g[i, 1])
            j = i // N_MIXERS
            if i % N_MIXERS == 0:
                m, r, im = _s5_mixer(h, s_re[j], s_im[j], ssm_lam_re[j], ssm_lam_im[j], ssm_log_dt[j],
                                     ssm_b_re[j], ssm_b_im[j], ssm_c_re[j], ssm_c_im[j],
                                     ssm_d[j], ssm_w_glu[j])
                new_re.append(r)
                new_im.append(im)
            else:
                m, b = _conv_mixer(h, buf[j], conv_w_in[j], conv_w[j], conv_w_out[j])
                new_buf.append(b)
            x = x + m.astype(x.dtype)
            x = x + 0.5 * _ffn_half(x, norm_g[i, 2], ffn_w_gate_up[i, 1], ffn_w_down[i, 1])
        y = _rmsnorm(x, final_norm_g)
        outs.append((y, jnp.stack(new_re), jnp.stack(new_im), jnp.stack(new_buf)))
    (y_prompt, sre_p, sim_p, conv_p), (y_sample, sre_s, sim_s, conv_s) = outs
    return (y_prompt, y_sample, sre_p, sim_p, conv_p, sre_s, sim_s, conv_s)
```

```cpp
#include <hip/hip_runtime.h>
#include <cstdio>
#include <cstdint>
namespace pg8 {
#define PG8_LAS __attribute__((address_space(3)))
typedef unsigned short bf16_t;
typedef short bf16x8 __attribute__((ext_vector_type(8)));
typedef float f32x4 __attribute__((ext_vector_type(4)));
typedef unsigned u32x4 __attribute__((ext_vector_type(4)));
constexpr int BM = 256, BK = 64, HALF = 128, HTB = HALF * BK * 2  , STAGE_BYTES = 8 * HTB, NXCD = 8, WGM = 8;

__host__ __device__ __forceinline__ int lds_byte(int r, int c) { const int st = (r >> 4) * 2 + (c >> 5), rr = r & 15, cc = c & 31, ob = rr * 64 + cc * 2; return st * 1024 + (ob ^ (((ob >> 9) & 1) << 5)); }
__host__ __device__ __forceinline__ void stage_rc(int b, int& R, int& C) { const int st = b / 1024, sb = b % 1024, swz = sb ^ (((sb >> 9) & 1) << 5); R = (st >> 1) * 16 + swz / 64; C = (st & 1) * 32 + (swz % 64) / 2; }
__host__ __device__ __forceinline__ int perm32(int rho) { const int n = rho >> 4, i = rho & 15; return 8 * (i >> 2) + 4 * n + (i & 3); }

struct Unit { int pm, pn; };
struct Gemm { const bf16_t* A; const bf16_t* Bt; int M, N, K; };

struct StaticOrder {
    int nM, nN, nwg, G, c;
    __host__ __device__ void init(int M, int N, int G_, int c_) { nM = M / BM; nN = N / BM; nwg = nM * nN; G = G_; c = c_; }
    __host__ __device__ bool next(int i, Unit& u) const {
        const long L = (long)i * G + c; if (L >= nwg) return false;
        int wgid = (int)L; { const int q = nwg / NXCD, r = nwg % NXCD, xcd = wgid % NXCD, off = wgid / NXCD; wgid = (xcd < r ? xcd * (q + 1) : r * (q + 1) + (xcd - r) * q) + off; }
        const int nig = WGM * nN, gid = wgid / nig, fm = gid * WGM, gsz = (nM - fm) < WGM ? (nM - fm) : WGM;
        u.pm = fm + ((wgid % nig) % gsz); u.pn = (wgid % nig) / gsz; return true;
    }
    __device__ __forceinline__ void a_ready(const Unit&) const {}
    __device__ __forceinline__ void done(const Unit&) const {}
};


__device__ __forceinline__ unsigned cvt_pk_bf16(float lo, float hi) { unsigned r; asm volatile("v_cvt_pk_bf16_f32 %0, %1, %2" : "=v"(r) : "v"(lo), "v"(hi)); return r; }

constexpr float RMS_EPS = 1e-6f;
constexpr float INV_D = 1.0f / 1024.0f;
__device__ __forceinline__ float sigmoid_f(float x) { return __builtin_amdgcn_rcpf(1.0f + __builtin_amdgcn_exp2f(-1.4426950408889634f * x)); }
__device__ __forceinline__ float rstd_of(float ssq) { return __builtin_amdgcn_rsqf(ssq * INV_D + RMS_EPS); }

struct EpiGateUp {
    static constexpr bool PERM = true, AFTER_DRAIN = false;
    bf16_t* H; int ldh; const float* ssq;
    __device__ __forceinline__ void operator()(const f32x4 (&acc)[2][2][4][2], const Unit& u, int wr, int wc, int fr, int fq) const {
        const int row0 = u.pm * BM + wr * 64 + fr, col0 = u.pn * HALF + wc * 32 + 8 * fq;
#pragma unroll
        for (int ai = 0; ai < 2; ++ai)
#pragma unroll
            for (int m = 0; m < 4; ++m) { const int row = row0 + ai * HALF + m * 16; const float rs = rstd_of(ssq[row]);
                float h[8];
#pragma unroll
                for (int n = 0; n < 2; ++n)
#pragma unroll
                    for (int e = 0; e < 4; ++e) { const float g = acc[ai][0][m][n][e] * rs, up = acc[ai][1][m][n][e] * rs; h[4 * n + e] = g * sigmoid_f(g) * up; }
                u32x4 w; w.x = cvt_pk_bf16(h[0], h[1]); w.y = cvt_pk_bf16(h[2], h[3]); w.z = cvt_pk_bf16(h[4], h[5]); w.w = cvt_pk_bf16(h[6], h[7]);
                *(u32x4*)(H + (size_t)row * ldh + col0) = w; }
    }
};

template <int MODE> struct EpiResid {
    static constexpr bool PERM = true, AFTER_DRAIN = false;
    float* X; bf16_t* XB; float* ssq; float scale;
    __device__ __forceinline__ void operator()(const f32x4 (&acc)[2][2][4][2], const Unit& u, int wr, int wc, int fr, int fq) const {
        const int row0 = u.pm * BM + wr * 64 + fr;
        const int col0 = (MODE == 0 ? u.pn * BM : u.pn * HALF) + wc * 32 + 8 * fq;
#pragma unroll
        for (int ai = 0; ai < 2; ++ai)
#pragma unroll
            for (int m = 0; m < 4; ++m) { const int row = row0 + ai * HALF + m * 16; float sq = 0.f;
#pragma unroll
                for (int bj = 0; bj < (MODE == 0 ? 2 : 1); ++bj) {
                    float* xp = X + (size_t)row * 1024 + col0 + bj * HALF;
                    f32x4 x0 = *(const f32x4*)xp, x1 = *(const f32x4*)(xp + 4);
                    if (MODE == 0) { x0 += acc[ai][bj][m][0] * scale; x1 += acc[ai][bj][m][1] * scale; }
                    else {
#pragma unroll
                        for (int e = 0; e < 4; ++e) { x0[e] += acc[ai][0][m][0][e] * sigmoid_f(acc[ai][1][m][0][e]); x1[e] += acc[ai][0][m][1][e] * sigmoid_f(acc[ai][1][m][1][e]); } }
                    *(f32x4*)xp = x0; *(f32x4*)(xp + 4) = x1;
                    u32x4 w; w.x = cvt_pk_bf16(x0[0], x0[1]); w.y = cvt_pk_bf16(x0[2], x0[3]); w.z = cvt_pk_bf16(x1[0], x1[1]); w.w = cvt_pk_bf16(x1[2], x1[3]);
                    *(u32x4*)(XB + (size_t)row * 1024 + col0 + bj * HALF) = w;
                    sq += (x0[0] * x0[0] + x0[1] * x0[1]) + (x0[2] * x0[2] + x0[3] * x0[3]) + (x1[0] * x1[0] + x1[1] * x1[1]) + (x1[2] * x1[2] + x1[3] * x1[3]); }
                sq += __shfl_xor(sq, 16); sq += __shfl_xor(sq, 32);
                if (fq == 0) atomicAdd(ssq + row, sq); }
    }
};

struct EpiConvIn {
    static constexpr bool PERM = true, AFTER_DRAIN = false;
    bf16_t* Z; bf16_t* GB; const float* ssq; float* conv_p; float* conv_s;
    __device__ __forceinline__ void operator()(const f32x4 (&acc)[2][2][4][2], const Unit& u, int wr, int wc, int fr, int fq) const {
        const int row0 = u.pm * BM + wr * 64 + fr;
        if (u.pn < 8) {
            const int col0 = u.pn * HALF + wc * 32 + 8 * fq;
#pragma unroll
            for (int ai = 0; ai < 2; ++ai)
#pragma unroll
                for (int m = 0; m < 4; ++m) { const int row = row0 + ai * HALF + m * 16; const float rs = rstd_of(ssq[row]), rs2 = rs * rs;
                    const f32x4 z0 = acc[ai][0][m][0] * acc[ai][1][m][0] * rs2, z1 = acc[ai][0][m][1] * acc[ai][1][m][1] * rs2;
                    u32x4 w; w.x = cvt_pk_bf16(z0[0], z0[1]); w.y = cvt_pk_bf16(z0[2], z0[3]); w.z = cvt_pk_bf16(z1[0], z1[1]); w.w = cvt_pk_bf16(z1[2], z1[3]);
                    *(u32x4*)(Z + (size_t)row * 1024 + col0) = w;
                    float* cp = nullptr;
                    if (row < 16384) { const int t = row & 2047; if (t >= 2046) cp = conv_p + ((size_t)(row >> 11) * 2 + (t - 2046)) * 1024 + col0; }
                    else { const int r2 = row - 16384, t = r2 & 7; if (t >= 6) cp = conv_s + ((size_t)(r2 >> 3) * 2 + (t - 6)) * 1024 + col0; }
                    if (cp) { *(f32x4*)cp = z0; *(f32x4*)(cp + 4) = z1; } }
        } else {
            const int col0 = (u.pn - 8) * BM + wc * 32 + 8 * fq;
#pragma unroll
            for (int ai = 0; ai < 2; ++ai)
#pragma unroll
                for (int m = 0; m < 4; ++m) { const int row = row0 + ai * HALF + m * 16; const float rs = rstd_of(ssq[row]);
#pragma unroll
                    for (int bj = 0; bj < 2; ++bj) { const f32x4 g0 = acc[ai][bj][m][0] * rs, g1 = acc[ai][bj][m][1] * rs;
                        u32x4 w; w.x = cvt_pk_bf16(g0[0], g0[1]); w.y = cvt_pk_bf16(g0[2], g0[3]); w.z = cvt_pk_bf16(g1[0], g1[1]); w.w = cvt_pk_bf16(g1[2], g1[3]);
                        *(u32x4*)(GB + (size_t)row * 1024 + col0 + bj * HALF) = w; } }
        }
    }
};

template <class Epi, class Sched, bool ALIGN_EPI = false, bool SP2 = false>
__device__ __forceinline__ void gemm_phase(PG8_LAS unsigned char* lds, const Gemm g, const Sched& S, const Epi& E) {
    const int tid = threadIdx.x, wid = __builtin_amdgcn_readfirstlane(tid >> 6), lane = tid & 63, wr = wid >> 2, wc = wid & 3, fr = lane & 15, fq = lane >> 4;
    const int K = g.K, nt = K / BK;
    unsigned voffA[2], voffB[2];
#pragma unroll
    for (int i = 0; i < 2; ++i) { int R, C; stage_rc(tid * 16 + i * 8192, R, C); const int Rb = Epi::PERM ? ((R & ~31) + perm32(R & 31)) : R;
        voffA[i] = (unsigned)(R * K + C) * 2u; voffB[i] = (unsigned)(Rb * K + C) * 2u; }
    const size_t kstep = (size_t)(BK * 2);
    const size_t hstep = (size_t)HALF * K * 2;
    const size_t tstep = 2 * hstep;
    const unsigned ldsw = (unsigned)wid * 1024u;
    const int aoff = lds_byte(wr * 64 + fr, fq * 8), boff = lds_byte(wc * 32 + fr, fq * 8);
#define PG8_SA(b, h) (((b) * 2 + (h)) * HTB)
#define PG8_SB(b, h) ((4 + (b) * 2 + (h)) * HTB)
#define PG8_STAGE(bufoff, gbase, voff) do { _Pragma("unroll") for (int _i = 0; _i < 2; ++_i) \
        __builtin_amdgcn_global_load_lds((const unsigned*)((const char*)(gbase) + (voff)[_i]), (PG8_LAS unsigned*)(lds + (bufoff) + ldsw + _i * 8192), 16, 0, 0); } while (0)
#define PG8_LDA(dst, b, h) do { _Pragma("unroll") for (int m = 0; m < 4; ++m) _Pragma("unroll") for (int k = 0; k < 2; ++k) dst[m][k] = *(const PG8_LAS bf16x8*)(lds + PG8_SA(b, h) + aoff + m * 2048 + k * 1024); } while (0)
#define PG8_LDB(dst, b, h) do { _Pragma("unroll") for (int n = 0; n < 2; ++n) _Pragma("unroll") for (int k = 0; k < 2; ++k) dst[n][k] = *(const PG8_LAS bf16x8*)(lds + PG8_SB(b, h) + boff + n * 2048 + k * 1024); } while (0)
#define PG8_MMA(ai, bj, At, Bt) do { __builtin_amdgcn_s_setprio(1); _Pragma("unroll") for (int m = 0; m < 4; ++m) _Pragma("unroll") for (int n = 0; n < 2; ++n) _Pragma("unroll") for (int k = 0; k < 2; ++k) \
        acc[ai][bj][m][n] = __builtin_amdgcn_mfma_f32_16x16x32_bf16(Bt[n][k], At[m][k], acc[ai][bj][m][n], 0, 0, 0); __builtin_amdgcn_s_setprio(0); } while (0)
#define PG8_WAIT_V(n) asm volatile("s_waitcnt vmcnt(" #n ")" ::: "memory")
#define PG8_WAIT_L(n) asm volatile("s_waitcnt lgkmcnt(" #n ")" ::: "memory")
#define PG8_BAR __builtin_amdgcn_s_barrier()
#define PG8_SCHED __builtin_amdgcn_sched_barrier(0)
    Unit cur, nxt; int ui = 0;
    if (!S.next(0, cur)) return;
    f32x4 acc[2][2][4][2];
#pragma unroll
    for (int a = 0; a < 2; ++a)
#pragma unroll
        for (int b = 0; b < 2; ++b)
#pragma unroll
            for (int m = 0; m < 4; ++m)
#pragma unroll
                for (int n = 0; n < 2; ++n) acc[a][b][m][n] = (f32x4){0.f, 0.f, 0.f, 0.f};
    bf16x8 At[4][2], B0[2][2], B1[2][2];
    const char* cA = (const char*)g.A + (size_t)cur.pm * tstep; const char* cB = (const char*)g.Bt + (size_t)cur.pn * tstep;
    S.a_ready(cur);
    if constexpr (SP2) {
        PG8_STAGE(PG8_SB(0, 0), cB, voffB); PG8_STAGE(PG8_SB(0, 1), cB + hstep, voffB); PG8_STAGE(PG8_SA(0, 0), cA, voffA); PG8_STAGE(PG8_SA(0, 1), cA + hstep, voffA);
        if (wr == 1) PG8_BAR;
        PG8_WAIT_V(2); PG8_BAR;
        PG8_STAGE(PG8_SB(1, 0), cB + kstep, voffB); PG8_STAGE(PG8_SA(1, 0), cA + kstep, voffA); PG8_STAGE(PG8_SB(1, 1), cB + hstep + kstep, voffB);
        PG8_WAIT_V(6); PG8_BAR;
    } else {
        PG8_STAGE(PG8_SB(0, 0), cB, voffB); PG8_STAGE(PG8_SA(0, 0), cA, voffA); PG8_STAGE(PG8_SB(0, 1), cB + hstep, voffB); PG8_STAGE(PG8_SA(0, 1), cA + hstep, voffA);
        if (wr == 1) PG8_BAR;
        PG8_WAIT_V(4); PG8_BAR;
        PG8_STAGE(PG8_SB(1, 0), cB + kstep, voffB); PG8_STAGE(PG8_SA(1, 0), cA + kstep, voffA); PG8_STAGE(PG8_SB(1, 1), cB + hstep + kstep, voffB);
        PG8_WAIT_V(6); PG8_BAR;
    }
    for (;;) {
        const bool has_next = S.next(ui + 1, nxt);
        const char* nA = has_next ? (const char*)g.A + (size_t)nxt.pm * tstep : cA; const char* nB = has_next ? (const char*)g.Bt + (size_t)nxt.pn * tstep : cB;
        for (int t = 0; t < nt; t += 2) {
            const bool last = (t == nt - 2);
            const char* a1 = cA + (size_t)(t + 1) * kstep;
            const char* a2 = last ? nA : cA + (size_t)(t + 2) * kstep; const char* b2 = last ? nB : cB + (size_t)(t + 2) * kstep;
            const char* a3 = a2 + kstep; const char* b3 = b2 + kstep;
            if (last && has_next) S.a_ready(nxt);
            if constexpr (SP2) {
            PG8_LDB(B0, 0, 0); PG8_LDB(B1, 0, 1); PG8_SCHED; PG8_LDA(At, 0, 0); PG8_STAGE(PG8_SA(1, 1), a1 + hstep, voffA);
            PG8_WAIT_V(8); PG8_WAIT_L(0); PG8_BAR; PG8_MMA(0, 0, At, B0); PG8_MMA(0, 1, At, B1); PG8_BAR; PG8_SCHED;
            PG8_LDA(At, 0, 1); PG8_STAGE(PG8_SB(0, 0), b2, voffB); PG8_STAGE(PG8_SB(0, 1), b2 + hstep, voffB); PG8_STAGE(PG8_SA(0, 0), a2, voffA);
            PG8_WAIT_V(8); PG8_WAIT_L(0); PG8_BAR; PG8_MMA(1, 0, At, B0); PG8_MMA(1, 1, At, B1); PG8_BAR; PG8_SCHED;
            PG8_LDB(B0, 1, 0); PG8_LDB(B1, 1, 1); PG8_SCHED; PG8_LDA(At, 1, 0); PG8_STAGE(PG8_SA(0, 1), a2 + hstep, voffA);
            PG8_WAIT_V(8); PG8_WAIT_L(0); PG8_BAR; PG8_MMA(0, 0, At, B0); PG8_MMA(0, 1, At, B1); PG8_BAR; PG8_SCHED;
            PG8_LDA(At, 1, 1); PG8_STAGE(PG8_SB(1, 0), b3, voffB); PG8_STAGE(PG8_SB(1, 1), b3 + hstep, voffB); PG8_STAGE(PG8_SA(1, 0), a3, voffA);
            PG8_WAIT_V(8); PG8_WAIT_L(0); PG8_BAR; PG8_MMA(1, 0, At, B0); PG8_MMA(1, 1, At, B1); PG8_BAR; PG8_SCHED;
            } else {
            PG8_LDB(B0, 0, 0); PG8_SCHED; PG8_LDA(At, 0, 0); PG8_STAGE(PG8_SA(1, 1), a1 + hstep, voffA);
            PG8_WAIT_L(8); PG8_BAR; PG8_WAIT_L(0); PG8_MMA(0, 0, At, B0); PG8_BAR; PG8_SCHED;
            PG8_LDB(B1, 0, 1); PG8_STAGE(PG8_SB(0, 0), b2, voffB);
            PG8_BAR; PG8_WAIT_L(0); PG8_MMA(0, 1, At, B1); PG8_BAR;
            PG8_LDA(At, 0, 1); PG8_STAGE(PG8_SA(0, 0), a2, voffA);
            PG8_BAR; PG8_WAIT_L(0); PG8_MMA(1, 0, At, B0); PG8_BAR; PG8_SCHED;
            PG8_STAGE(PG8_SB(0, 1), b2 + hstep, voffB);
            PG8_WAIT_V(6); PG8_BAR; PG8_MMA(1, 1, At, B1); PG8_BAR;
            PG8_LDB(B0, 1, 0); PG8_SCHED; PG8_LDA(At, 1, 0); PG8_STAGE(PG8_SA(0, 1), a2 + hstep, voffA);
            PG8_WAIT_L(8); PG8_BAR; PG8_WAIT_L(0); PG8_MMA(0, 0, At, B0); PG8_BAR; PG8_SCHED;
            PG8_LDB(B1, 1, 1); PG8_STAGE(PG8_SB(1, 0), b3, voffB);
            PG8_BAR; PG8_WAIT_L(0); PG8_MMA(0, 1, At, B1); PG8_BAR;
            PG8_LDA(At, 1, 1); PG8_STAGE(PG8_SA(1, 0), a3, voffA);
            PG8_BAR; PG8_WAIT_L(0); PG8_MMA(1, 0, At, B0); PG8_BAR; PG8_SCHED;
            PG8_STAGE(PG8_SB(1, 1), b3 + hstep, voffB);
            PG8_WAIT_V(6); PG8_BAR; PG8_MMA(1, 1, At, B1); PG8_BAR;
            }
        }
        if constexpr (ALIGN_EPI) { if (wr == 0) PG8_BAR; }
        if constexpr (!Epi::AFTER_DRAIN) { E(acc, cur, wr, wc, fr, fq); S.done(cur); }
        if (!has_next) break;
#pragma unroll
        for (int a = 0; a < 2; ++a)
#pragma unroll
            for (int b = 0; b < 2; ++b)
#pragma unroll
                for (int m = 0; m < 4; ++m)
#pragma unroll
                    for (int n = 0; n < 2; ++n) acc[a][b][m][n] = (f32x4){0.f, 0.f, 0.f, 0.f};
        cur = nxt; cA = nA; cB = nB; ++ui;
        if constexpr (ALIGN_EPI) { if (wr == 1) PG8_BAR; }
    }
    PG8_WAIT_V(0);
    if constexpr (!ALIGN_EPI) { if (wr == 0) PG8_BAR; }
    PG8_BAR;
    if constexpr (Epi::AFTER_DRAIN) { E.fused(acc, cur, wr, wc, fr, fq, lds, wid, lane); S.done(cur); }
#undef PG8_SA
#undef PG8_SB
#undef PG8_STAGE
#undef PG8_LDA
#undef PG8_LDB
#undef PG8_MMA
#undef PG8_WAIT_V
#undef PG8_WAIT_L
#undef PG8_BAR
#undef PG8_SCHED
}
}

#define GAS __attribute__((address_space(1)))
#define LAS __attribute__((address_space(3)))
typedef unsigned short bf16;
typedef unsigned v4u __attribute__((ext_vector_type(4)));
typedef float f32x4 __attribute__((ext_vector_type(4)));
typedef short bf16x8 __attribute__((ext_vector_type(8)));
typedef GAS unsigned gu32;
typedef GAS unsigned long long gu64;
#define RLX_AGENT __ATOMIC_RELAXED, __HIP_MEMORY_SCOPE_AGENT
#define LDS_WAIT() asm volatile("s_waitcnt lgkmcnt(0)" ::: "memory")
#define VM_WAIT() asm volatile("s_waitcnt vmcnt(0)" ::: "memory")
__device__ __forceinline__ unsigned long long rt() { return __builtin_amdgcn_s_memrealtime(); }
__device__ __forceinline__ unsigned f2bf(float f) { unsigned u = __builtin_bit_cast(unsigned, f); return (u + 0x7fffu + ((u >> 16) & 1u)) >> 16; }
__device__ __forceinline__ unsigned pk2(float lo, float hi) { return f2bf(lo) | (f2bf(hi) << 16); }

#define XB_TMO      128
#define XB_XCNT(j)  (256  + 64 * (j))
#define XB_XSUB(j)  (1280 + 64 * (j))
#define XB_XGEN(j)  (2304 + 64 * (j))
#define XB_TOP      3328
#define XB_TOPGEN   3392
#define XCD_BAR_WORDS 3456
#define XB_SPIN_CAP (1u << 18)

__device__ __forceinline__ unsigned xb_ld(unsigned* p)              { return __hip_atomic_load(p, __ATOMIC_RELAXED, __HIP_MEMORY_SCOPE_AGENT); }
__device__ __forceinline__ unsigned xb_add(unsigned* p, unsigned v) { return __hip_atomic_fetch_add(p, v, __ATOMIC_RELAXED, __HIP_MEMORY_SCOPE_AGENT); }
__device__ __forceinline__ unsigned xb_xcc_id() { return (unsigned)__builtin_amdgcn_s_getreg((3 << 11) | 20) & 0xFu; }
#define XB_SPIN(cond, bar) do { unsigned _sp = 0; while (cond) { __builtin_amdgcn_s_sleep(1); \
    if ((++_sp & 255u) == 0u) { if (xb_ld(&(bar)[XB_TMO])) break; if (_sp > XB_SPIN_CAP) { atomicAdd(&(bar)[XB_TMO], 1u); break; } } } } while (0)

struct XcdBarrier {
    unsigned* bar; unsigned x;
    volatile LAS unsigned* st;
};

__device__ __forceinline__ XcdBarrier xcd_barrier_post(unsigned* bar, volatile LAS unsigned* st) {
    XcdBarrier b; b.bar = bar; b.x = xb_xcc_id(); b.st = st;
    if (threadIdx.x == 0) (void)xb_add(&bar[XB_XCNT(b.x)], 1u);
    return b;
}
__device__ __forceinline__ void xcd_barrier_complete(unsigned* bar, unsigned x, unsigned& nloc, unsigned& nx) {
    const unsigned G = gridDim.x * gridDim.y * gridDim.z;
    unsigned sum, cnt, mine, sp = 0u;
    for (;;) {
        sum = 0u; cnt = 0u; mine = 0u;
#pragma unroll
        for (unsigned j = 0; j < 16; ++j) { const unsigned c = xb_ld(&bar[XB_XCNT(j)]); sum += c; cnt += (c > 0u) ? 1u : 0u; mine = (j == x) ? c : mine; }
        if (sum == G) break;
        __builtin_amdgcn_s_sleep(1);
        if ((++sp & 255u) == 0u) { if (xb_ld(&bar[XB_TMO])) break; if (sp > XB_SPIN_CAP) { atomicAdd(&bar[XB_TMO], 1u); break; } }
    }
    nloc = mine > 0u ? mine : 1u; nx = cnt > 0u ? cnt : 1u;
}

__device__ __forceinline__ void xcd_barrier(const XcdBarrier& b) {
    asm volatile("s_waitcnt vmcnt(0)" ::: "memory");
    __syncthreads();
    if (threadIdx.x == 0) {
        unsigned* bar = b.bar;
        __builtin_amdgcn_s_waitcnt(0);
        unsigned nloc = b.st[0], nx = b.st[1];
        if (nloc == 0u) { xcd_barrier_complete(bar, b.x, nloc, nx); b.st[0] = nloc; b.st[1] = nx; }
        const unsigned old = xb_add(&bar[XB_XSUB(b.x)], 1u);
        const unsigned gen = old / nloc;
        if (old + 1u == (gen + 1u) * nloc) {
            __builtin_amdgcn_fence(__ATOMIC_RELEASE, "agent");
            asm volatile("s_waitcnt vmcnt(0)" ::: "memory");
            const unsigned og = xb_add(&bar[XB_TOP], 1u);
            const unsigned tg = og / nx;
            if (og + 1u == (tg + 1u) * nx) xb_add(&bar[XB_TOPGEN], 1u);
            else XB_SPIN(xb_ld(&bar[XB_TOPGEN]) == tg, bar);
            __builtin_amdgcn_fence(__ATOMIC_ACQUIRE, "agent");
            xb_add(&bar[XB_XGEN(b.x)], 1u);
            asm volatile("s_waitcnt vmcnt(0)" ::: "memory");
        } else {
            XB_SPIN(xb_ld(&bar[XB_XGEN(b.x)]) == gen, bar);
            __builtin_amdgcn_fence(__ATOMIC_ACQUIRE, "agent");
            asm volatile("s_waitcnt vmcnt(0)" ::: "memory");
        }
    }
    __syncthreads();
}


constexpr int NWAVES = 8;
#ifndef MK_ONE_LAUNCH
#define MK_ONE_LAUNCH 0
#endif
constexpr int N_PHASES = 15;

constexpr int D = 1024, FF = 4096, MP = 8 * 2048, MS = 128 * 8, M = MP + MS;
constexpr int NG = 64, PS = 64, GS = 16;
constexpr float EPS = 1e-6f;
constexpr size_t O_Y = 0, O_SRP = (size_t)M * D, O_SIP = O_SRP + 8 * 4096, O_CP = O_SIP + 8 * 4096, O_SRS = O_CP + 8 * 2 * 1024, O_SIS = O_SRS + 128 * 4096, O_CS = O_SIS + 128 * 4096, O_END = O_CS + 128 * 2 * 1024;
static_assert(O_END == 19218432, "output size");

constexpr size_t MiB = 1u << 20;
constexpr size_t WS_CTL = 0, CTL_ZERO_BYTES = 1 * MiB;
constexpr size_t WS_SSQ = 1 * MiB;
constexpr size_t WS_SSMP = 2 * MiB;
constexpr size_t WS_WGU = 4 * MiB;
constexpr size_t WS_WD = 68 * MiB;
constexpr size_t WS_WGLU = 100 * MiB;
constexpr size_t WS_WIN = 104 * MiB;
constexpr size_t WS_WOUT = 110 * MiB;
constexpr size_t WS_X = 112 * MiB;
constexpr size_t WS_XB = 180 * MiB;
constexpr size_t WS_H = 214 * MiB;
constexpr size_t WS_G = WS_H, WS_Z = WS_H, WS_GB = WS_H + 34 * MiB, WS_A2 = WS_H + 68 * MiB;
constexpr size_t WS_END = 350 * MiB;
constexpr int CW_BAR = 4096;

constexpr int RING_OFF = 0, RING_BYTES = 131072;
constexpr int LDSCTL_OFF = RING_BYTES, MISC_OFF = LDSCTL_OFF + 320;
constexpr int LDS_BYTES = 147456;

struct Frame {
    LAS unsigned char* lds;
    volatile LAS unsigned* MISC;
    gu32* ctl;
    int tid, lane, wave, vcu, G;
    const float* in[21]; float* out; unsigned char* ws;
};

__device__ __forceinline__ float wave_sum(float v) {
#pragma unroll
    for (int o = 1; o < 64; o <<= 1) v += __shfl_xor(v, o);
    return v;
}
__device__ __forceinline__ float bf2f(unsigned short b) { return __builtin_bit_cast(float, (unsigned)b << 16); }

__device__ __forceinline__ void p0_transpose_item(const float* W, int K, int N, bf16* WT, const float* gk, int k0, int n0s, int n0d, LAS float* scr, int lane) {
#pragma unroll 8
    for (int i = 0; i < 32; ++i) { const int kk = 2 * i + (lane >> 5); float v = W[(size_t)(k0 + kk) * N + n0s + (lane & 31)]; if (gk) v *= gk[k0 + kk]; scr[kk * 33 + (lane & 31)] = v; }
    LDS_WAIT(); asm volatile("" ::: "memory");
    const int c = lane & 7;
#pragma unroll
    for (int j = 0; j < 4; ++j) { const int n = (lane >> 3) + 8 * j; const LAS float* s = scr + (8 * c) * 33 + n;
        v4u o; o.x = pk2(s[0 * 33], s[1 * 33]); o.y = pk2(s[2 * 33], s[3 * 33]); o.z = pk2(s[4 * 33], s[5 * 33]); o.w = pk2(s[6 * 33], s[7 * 33]);
        *(GAS v4u*)(WT + (size_t)(n0d + n) * K + k0 + 8 * c) = o; }
    LDS_WAIT(); asm volatile("" ::: "memory");
}
__device__ __forceinline__ int pair_src(int nd, int base, int hstride) { return base + ((nd >> 7) & 1) * hstride + 128 * (nd >> 8) + (nd & 127); }

__device__ __forceinline__ void p0_prologue(Frame& F) {
    LAS float* scr = (LAS float*)(F.lds + RING_OFF + F.wave * 16384);
    const int gw = F.vcu * NWAVES + F.wave, NGW = F.G * NWAVES, lane = F.lane;
    const float* norm_g = F.in[5];
    constexpr int I_GU = (D / 64) * (2 * FF / 32), I_D = (FF / 64) * (D / 32), I_GLU = (D / 64) * (2 * D / 32), I_IN = (D / 64) * (3 * D / 32), I_OUT = (D / 64) * (D / 32);
    constexpr int NITEMS = 4 * I_GU + 4 * I_D + I_GLU + I_IN + I_OUT;
    for (int it = gw; it < NITEMS; it += NGW) {
        int r = it;
        if (r < 4 * I_GU) { const int f = r / I_GU; r -= f * I_GU; const int nb = r % (2 * FF / 32), kb = r / (2 * FF / 32), nd = 32 * nb;
            const float* gk = norm_g + ((f >> 1) * 3 + (f & 1) * 2) * D;
            p0_transpose_item(F.in[7] + (size_t)f * D * 2 * FF, D, 2 * FF, (bf16*)(F.ws + WS_WGU) + (size_t)f * 2 * FF * D, gk, 64 * kb, pair_src(nd, 0, FF), nd, scr, lane); continue; }
        r -= 4 * I_GU;
        if (r < 4 * I_D) { const int f = r / I_D; r -= f * I_D; const int nb = r % (D / 32), kb = r / (D / 32), nd = 32 * nb;
            p0_transpose_item(F.in[8] + (size_t)f * FF * D, FF, D, (bf16*)(F.ws + WS_WD) + (size_t)f * D * FF, nullptr, 64 * kb, nd, nd, scr, lane); continue; }
        r -= 4 * I_D;
        if (r < I_GLU) { const int nb = r % (2 * D / 32), kb = r / (2 * D / 32), nd = 32 * nb;
            p0_transpose_item(F.in[17], D, 2 * D, (bf16*)(F.ws + WS_WGLU), nullptr, 64 * kb, pair_src(nd, 0, D), nd, scr, lane); continue; }
        r -= I_GLU;
        if (r < I_IN) { const int nb = r % (3 * D / 32), kb = r / (3 * D / 32), nd = 32 * nb;
            const int ns = nd < 2048 ? pair_src(nd, D, D) : nd - 2048;
            p0_transpose_item(F.in[18], D, 3 * D, (bf16*)(F.ws + WS_WIN), norm_g + 4 * D, 64 * kb, ns, nd, scr, lane); continue; }
        r -= I_IN;
        { const int nb = r % (D / 32), kb = r / (D / 32), nd = 32 * nb;
            p0_transpose_item(F.in[20], D, D, (bf16*)(F.ws + WS_WOUT), nullptr, 64 * kb, nd, nd, scr, lane); }
    }
    float* X = (float*)(F.ws + WS_X); bf16* XB = (bf16*)(F.ws + WS_XB); float* ssq = (float*)(F.ws + WS_SSQ);
    for (int m = gw; m < M; m += NGW) {
        const float* src = m < MP ? F.in[0] + (size_t)m * D : F.in[1] + (size_t)(m - MP) * D;
        const GAS f32x4* xr = (const GAS f32x4*)src + lane; GAS f32x4* xo = (GAS f32x4*)(X + (size_t)m * D) + lane;
        GAS unsigned long long* o8 = (GAS unsigned long long*)(XB + (size_t)m * D) + lane;
        float s = 0.f;
#pragma unroll
        for (int j = 0; j < 4; ++j) { const f32x4 v = xr[64 * j]; s += (v.x * v.x + v.y * v.y) + (v.z * v.z + v.w * v.w); xo[64 * j] = v;
            o8[64 * j] = (unsigned long long)pk2(v.x, v.y) | ((unsigned long long)pk2(v.z, v.w) << 32); }
        s = wave_sum(s);
        if (lane == 0) ssq[m] = s;
    }
    for (int i = gw * 64 + lane; i < 7 * M; i += NGW * 64) ssq[M + i] = 0.f;
    float* sp = (float*)(F.ws + WS_SSMP);
    for (int i = gw * 64 + lane; i < NG * PS; i += NGW * 64) {
        const int g = i / PS;
        const float lr = F.in[9][i], li = F.in[10][i], dt = expf(F.in[11][g]);
        const float mag = expf(lr * dt); float sn, cs; sincosf(li * dt, &sn, &cs);
        const float lbr = mag * cs, lbi = mag * sn, den = lr * lr + li * li, nr = lbr - 1.0f, ni = lbi;
        const float fr = (nr * lr + ni * li) / den, fi = (ni * lr - nr * li) / den;
        sp[i] = lbr; sp[4096 + i] = lbi;
#pragma unroll
        for (int c = 0; c < GS; ++c) { const float br = F.in[12][(size_t)i * GS + c], bi = F.in[13][(size_t)i * GS + c];
            sp[8192 + (size_t)i * GS + c] = fr * br - fi * bi; sp[8192 + 65536 + (size_t)i * GS + c] = fr * bi + fi * br; }
    }
}

__device__ __forceinline__ float gelu_tanh(float x) {
    const float a = 0.7978845608028654f * (x + 0.044715f * x * x * x);
    return x * __builtin_amdgcn_rcpf(1.0f + __builtin_amdgcn_exp2f(-2.0f * 1.4426950408889634f * a));
}

__device__ __forceinline__ void ssm_phase(Frame& F) {
    constexpr int TB = 8;
    LAS float* wl = (LAS float*)(F.lds + RING_OFF + F.wave * 16384);
    LAS float* hsr = wl; LAS float* hsi = wl + TB * 65; LAS float* cre = wl + 2 * TB * 65; LAS float* cim = cre + 16 * 65;
    const int gw = F.vcu * NWAVES + F.wave, NGW = F.G * NWAVES, lane = F.lane;
    const float* X = (const float*)(F.ws + WS_X); const float* ssq = (const float*)(F.ws + WS_SSQ) + 1 * M;
    const float* sp = (const float*)(F.ws + WS_SSMP); bf16* Gb = (bf16*)(F.ws + WS_G);
    const float* g1 = F.in[5] + 1 * D; const float* dsk = F.in[16];
    constexpr int NITEM = 8 * NG + 128 * NG;
    for (int it = gw; it < NITEM; it += NGW) {
        int seq, g, L, row0; const float *s0r = nullptr, *s0i = nullptr; float *outr, *outi;
        if (it < 8 * NG) { seq = it / NG; g = it % NG; L = 2048; row0 = seq * 2048; outr = F.out + O_SRP + (size_t)(seq * NG + g) * PS; outi = F.out + O_SIP + (size_t)(seq * NG + g) * PS; }
        else { const int j = it - 8 * NG; seq = j / NG; g = j % NG; L = 8; row0 = MP + seq * 8; s0r = F.in[2] + (size_t)(seq * NG + g) * PS; s0i = F.in[3] + (size_t)(seq * NG + g) * PS;
               outr = F.out + O_SRS + (size_t)(seq * NG + g) * PS; outi = F.out + O_SIS + (size_t)(seq * NG + g) * PS; }
        const int gp = g * PS + lane;
        const float lbr = sp[gp], lbi = sp[4096 + gp];
        float bbr[GS], bbi[GS];
#pragma unroll
        for (int c = 0; c < GS; ++c) { bbr[c] = sp[8192 + (size_t)gp * GS + c]; bbi[c] = sp[8192 + 65536 + (size_t)gp * GS + c]; }
#pragma unroll
        for (int c = 0; c < GS; ++c) { cre[c * 65 + lane] = F.in[14][((size_t)g * GS + c) * PS + lane]; cim[c * 65 + lane] = F.in[15][((size_t)g * GS + c) * PS + lane]; }
        float gn[GS];
#pragma unroll
        for (int c = 0; c < GS; ++c) gn[c] = g1[g * GS + c];
        float hr = s0r ? s0r[lane] : 0.f, hi = s0i ? s0i[lane] : 0.f;
        const int oc = lane & 15, otq = lane >> 4;
        const float dc = dsk[g * GS + oc], gc = g1[g * GS + oc];
        for (int t0 = 0; t0 < L; t0 += TB) {
#pragma unroll
            for (int tl = 0; tl < TB; ++tl) { const int row = row0 + t0 + tl; const float rs = __builtin_amdgcn_rsqf(ssq[row] * (1.0f / D) + EPS);
                const float* xr = X + (size_t)row * D + g * GS; float br = 0.f, bi = 0.f;
#pragma unroll
                for (int c = 0; c < GS; ++c) { const float uu = xr[c] * rs * gn[c]; br += bbr[c] * uu; bi += bbi[c] * uu; }
                const float nr = lbr * hr - lbi * hi + br, ni = lbr * hi + lbi * hr + bi; hr = nr; hi = ni;
                hsr[tl * 65 + lane] = hr; hsi[tl * 65 + lane] = hi; }
            LDS_WAIT(); __builtin_amdgcn_wave_barrier(); asm volatile("" ::: "memory");
#pragma unroll
            for (int j = 0; j < 2; ++j) { const int tl = otq * 2 + j; const int row = row0 + t0 + tl; float y = 0.f;
                for (int p = 0; p < PS; ++p) y += cre[oc * 65 + p] * hsr[tl * 65 + p] - cim[oc * 65 + p] * hsi[tl * 65 + p];
                const float rs = __builtin_amdgcn_rsqf(ssq[row] * (1.0f / D) + EPS);
                const float uu = X[(size_t)row * D + g * GS + oc] * rs * gc;
                y += dc * uu;
                Gb[(size_t)row * D + g * GS + oc] = (bf16)f2bf(gelu_tanh(y)); }
            LDS_WAIT(); __builtin_amdgcn_wave_barrier(); asm volatile("" ::: "memory");
        }
        outr[lane] = hr; outi[lane] = hi;
    }
}

__device__ __forceinline__ void conv_phase(Frame& F) {
    const bf16* Z = (const bf16*)(F.ws + WS_Z); const bf16* GBp = (const bf16*)(F.ws + WS_GB); bf16* A2 = (bf16*)(F.ws + WS_A2);
    const float* cw = F.in[19]; const float* cache = F.in[4];
    const int gt = (F.vcu * NWAVES + F.wave) * 64 + F.lane, NGT = F.G * NWAVES * 64;
    for (int it = gt; it < M * (D / 8); it += NGT) {
        const int row = it >> 7, c0 = (it & 127) * 8;
        int t; const float* cb = nullptr;
        if (row < MP) t = row & 2047; else { const int r2 = row - MP; t = r2 & 7; cb = cache + (size_t)(r2 >> 3) * 2 * D; }
        float z0[8], z1[8], z2[8], gb[8];
        { const v4u v = *(const GAS v4u*)(Z + (size_t)row * D + c0); const v4u q = *(const GAS v4u*)(GBp + (size_t)row * D + c0);
#pragma unroll
          for (int e = 0; e < 4; ++e) { z2[2 * e] = __builtin_bit_cast(float, v[e] << 16); z2[2 * e + 1] = __builtin_bit_cast(float, v[e] & 0xffff0000u);
                                        gb[2 * e] = __builtin_bit_cast(float, q[e] << 16); gb[2 * e + 1] = __builtin_bit_cast(float, q[e] & 0xffff0000u); } }
        if (t >= 1) { const v4u v = *(const GAS v4u*)(Z + (size_t)(row - 1) * D + c0);
#pragma unroll
          for (int e = 0; e < 4; ++e) { z1[2 * e] = __builtin_bit_cast(float, v[e] << 16); z1[2 * e + 1] = __builtin_bit_cast(float, v[e] & 0xffff0000u); } }
        else {
#pragma unroll
          for (int e = 0; e < 8; ++e) z1[e] = cb ? cb[D + c0 + e] : 0.f; }
        if (t >= 2) { const v4u v = *(const GAS v4u*)(Z + (size_t)(row - 2) * D + c0);
#pragma unroll
          for (int e = 0; e < 4; ++e) { z0[2 * e] = __builtin_bit_cast(float, v[e] << 16); z0[2 * e + 1] = __builtin_bit_cast(float, v[e] & 0xffff0000u); } }
        else {
#pragma unroll
          for (int e = 0; e < 8; ++e) z0[e] = cb ? cb[t * D + c0 + e] : 0.f; }
        float o[8];
#pragma unroll
        for (int e = 0; e < 8; ++e) o[e] = gb[e] * (cw[c0 + e] * z0[e] + cw[D + c0 + e] * z1[e] + cw[2 * D + c0 + e] * z2[e]);
        v4u w; w.x = pk2(o[0], o[1]); w.y = pk2(o[2], o[3]); w.z = pk2(o[4], o[5]); w.w = pk2(o[6], o[7]);
        *(GAS v4u*)(A2 + (size_t)row * D + c0) = w;
    }
}

__device__ __forceinline__ void final_phase(Frame& F) {
    const float* X = (const float*)(F.ws + WS_X); const float* ssq = (const float*)(F.ws + WS_SSQ) + 6 * M; const float* fg = F.in[6];
    const int gw = F.vcu * NWAVES + F.wave, NGW = F.G * NWAVES, lane = F.lane;
    f32x4 gv[4];
#pragma unroll
    for (int j = 0; j < 4; ++j) gv[j] = ((const GAS f32x4*)fg)[lane + 64 * j];
    for (int m = gw; m < M; m += NGW) {
        const float rs = __builtin_amdgcn_rsqf(ssq[m] * (1.0f / D) + EPS);
        const GAS f32x4* xr = (const GAS f32x4*)(X + (size_t)m * D) + lane; GAS f32x4* yo = (GAS f32x4*)(F.out + O_Y + (size_t)m * D) + lane;
#pragma unroll
        for (int j = 0; j < 4; ++j) yo[64 * j] = xr[64 * j] * rs * gv[j];
    }
}

struct Args { const float* in[21]; float* out; unsigned char* ws; int ph_lo, ph_hi; };
__global__ void __launch_bounds__(NWAVES * 64, 2) skel_fwd(Args args) {
    extern __shared__ __attribute__((aligned(16))) unsigned char lds[];
    Frame F;
    F.lds = (LAS unsigned char*)lds;
    F.MISC = (volatile LAS unsigned*)(F.lds + MISC_OFF);
    F.tid = threadIdx.x; F.lane = F.tid & 63; F.wave = __builtin_amdgcn_readfirstlane(F.tid >> 6);
    F.G = gridDim.x; { const int bx = blockIdx.x; F.vcu = (F.G % 8 == 0) ? (bx % 8) * (F.G / 8) + bx / 8 : bx; }
    F.ws = args.ws; F.out = args.out; F.ctl = (gu32*)(args.ws + WS_CTL);
#pragma unroll
    for (int i = 0; i < 21; ++i) F.in[i] = args.in[i];
    for (int u = F.tid; u < (LDS_BYTES - LDSCTL_OFF) / 4; u += NWAVES * 64) ((LAS unsigned*)(F.lds + LDSCTL_OFF))[u] = 0u;
    __syncthreads();
    XcdBarrier bar; bar.bar = (unsigned*)(F.ctl + CW_BAR); bar.x = 0; bar.st = nullptr;
    if (MK_ONE_LAUNCH) bar = xcd_barrier_post((unsigned*)(F.ctl + CW_BAR), F.MISC + 8);
    const int lo = args.ph_lo, hi = args.ph_hi;
#define IN(k) (lo <= (k) && (k) < hi)
#define SEAM(k) do { if (MK_ONE_LAUNCH && IN((k) + 1)) xcd_barrier(bar); } while (0)
    bf16* XB = (bf16*)(F.ws + WS_XB); bf16* H = (bf16*)(F.ws + WS_H); float* X = (float*)(F.ws + WS_X); float* ssq = (float*)(F.ws + WS_SSQ);
    const int bx = (int)blockIdx.x;

    if (IN(0)) { p0_prologue(F); SEAM(0); }
#define FFN_GU(ph, f, sin) if (IN(ph)) { pg8::Gemm g{XB, (const bf16*)(F.ws + WS_WGU) + (size_t)(f) * 2 * FF * D, M, 2 * FF, D}; pg8::StaticOrder S; S.init(M, 2 * FF, F.G, bx); \
        pg8::EpiGateUp E{H, FF, ssq + (size_t)(sin) * M}; pg8::gemm_phase<pg8::EpiGateUp, pg8::StaticOrder, true, true>(F.lds + RING_OFF, g, S, E); SEAM(ph); }
#define FFN_DN(ph, f, sout) if (IN(ph)) { pg8::Gemm g{H, (const bf16*)(F.ws + WS_WD) + (size_t)(f) * D * FF, M, D, FF}; pg8::StaticOrder S; S.init(M, D, F.G, bx); \
        pg8::EpiResid<0> E{X, XB, ssq + (size_t)(sout) * M, 0.5f}; pg8::gemm_phase<pg8::EpiResid<0>, pg8::StaticOrder, true, true>(F.lds + RING_OFF, g, S, E); SEAM(ph); }
    FFN_GU(1, 0, 0)
    FFN_DN(2, 0, 1)
    if (IN(3)) { ssm_phase(F); SEAM(3); }
    if (IN(4)) { pg8::Gemm g{(const bf16*)(F.ws + WS_G), (const bf16*)(F.ws + WS_WGLU), M, 2 * D, D}; pg8::StaticOrder S; S.init(M, 2 * D, F.G, bx);
        pg8::EpiResid<1> E{X, XB, ssq + (size_t)2 * M, 1.0f}; pg8::gemm_phase<pg8::EpiResid<1>, pg8::StaticOrder, true, true>(F.lds + RING_OFF, g, S, E); SEAM(4); }
    FFN_GU(5, 1, 2)
    FFN_DN(6, 1, 3)
    FFN_GU(7, 2, 3)
    FFN_DN(8, 2, 4)
    if (IN(9)) { pg8::Gemm g{XB, (const bf16*)(F.ws + WS_WIN), M, 3 * D, D}; pg8::StaticOrder S; S.init(M, 3 * D, F.G, bx);
        pg8::EpiConvIn E{(bf16*)(F.ws + WS_Z), (bf16*)(F.ws + WS_GB), ssq + (size_t)4 * M, F.out + O_CP, F.out + O_CS};
        pg8::gemm_phase<pg8::EpiConvIn, pg8::StaticOrder, true, true>(F.lds + RING_OFF, g, S, E); SEAM(9); }
    if (IN(10)) { conv_phase(F); SEAM(10); }
    if (IN(11)) { pg8::Gemm g{(const bf16*)(F.ws + WS_A2), (const bf16*)(F.ws + WS_WOUT), M, D, D}; pg8::StaticOrder S; S.init(M, D, F.G, bx);
        pg8::EpiResid<0> E{X, XB, ssq + (size_t)5 * M, 1.0f}; pg8::gemm_phase<pg8::EpiResid<0>, pg8::StaticOrder, true, true>(F.lds + RING_OFF, g, S, E); SEAM(11); }
    FFN_GU(12, 3, 5)
    FFN_DN(13, 3, 6)
    if (IN(14)) { final_phase(F); }
#undef IN
#undef SEAM
}

extern "C" void kernel_launch(void* const* d_in, const int* in_sizes, int n_in, void* d_out, int out_size, void* d_ws, size_t ws_size, hipStream_t stream) {
    static int grid = 0;
    if (grid == 0) {
        if (n_in != 21 || out_size != (int)O_END || ws_size < WS_END) { fprintf(stderr, "kernel_launch: unexpected shapes: n_in %d out %d ws %zu; nothing launched\n", n_in, out_size, ws_size); grid = -1; return; }
        int dev = 0, cus = 0, per_cu = 0;
        if (hipGetDevice(&dev) != hipSuccess || hipDeviceGetAttribute(&cus, hipDeviceAttributeMultiprocessorCount, dev) != hipSuccess) { grid = -1; return; }
        if (hipFuncSetAttribute((const void*)skel_fwd, hipFuncAttributeMaxDynamicSharedMemorySize, LDS_BYTES) != hipSuccess) { fprintf(stderr, "kernel_launch: hipFuncSetAttribute failed\n"); grid = -1; return; }
        if (hipOccupancyMaxActiveBlocksPerMultiprocessor(&per_cu, (const void*)skel_fwd, NWAVES * 64, LDS_BYTES) != hipSuccess || per_cu < 1) fprintf(stderr, "kernel_launch: occupancy query reports %d\n", per_cu);
        (void)hipGetLastError();
        grid = cus;
    }
    if (grid < 0) return;
    if (hipMemsetAsync((char*)d_ws + WS_CTL, 0, CTL_ZERO_BYTES, stream) != hipSuccess) return;
    Args a{};
    for (int i = 0; i < 21; ++i) a.in[i] = (const float*)d_in[i];
    a.out = (float*)d_out; a.ws = (unsigned char*)d_ws;
#if MK_ONE_LAUNCH
    a.ph_lo = 0; a.ph_hi = N_PHASES;
    hipLaunchKernelGGL(skel_fwd, dim3(grid), dim3(NWAVES * 64), LDS_BYTES, stream, a);
#else
    for (int p = 0; p < N_PHASES; ++p) { a.ph_lo = p; a.ph_hi = p + 1; hipLaunchKernelGGL(skel_fwd, dim3(grid), dim3(NWAVES * 64), LDS_BYTES, stream, a); }
#endif
}
```

```cpp
#include <hip/hip_runtime.h>
#include <cstdio>
#include <cstdint>
namespace pg8 {
#define PG8_LAS __attribute__((address_space(3)))
typedef unsigned short bf16_t;
typedef short bf16x8 __attribute__((ext_vector_type(8)));
typedef float f32x4 __attribute__((ext_vector_type(4)));
typedef unsigned u32x4 __attribute__((ext_vector_type(4)));
constexpr int BM = 256, BK = 64, HALF = 128, HTB = HALF * BK * 2  , STAGE_BYTES = 8 * HTB, NXCD = 8, WGM = 8;

__host__ __device__ __forceinline__ int lds_byte(int r, int c) { const int st = (r >> 4) * 2 + (c >> 5), rr = r & 15, cc = c & 31, ob = rr * 64 + cc * 2; return st * 1024 + (ob ^ (((ob >> 9) & 1) << 5)); }
__host__ __device__ __forceinline__ void stage_rc(int b, int& R, int& C) { const int st = b / 1024, sb = b % 1024, swz = sb ^ (((sb >> 9) & 1) << 5); R = (st >> 1) * 16 + swz / 64; C = (st & 1) * 32 + (swz % 64) / 2; }
__host__ __device__ __forceinline__ int perm32(int rho) { const int n = rho >> 4, i = rho & 15; return 8 * (i >> 2) + 4 * n + (i & 3); }

struct Unit { int pm, pn; };
struct Gemm { const bf16_t* A; const bf16_t* Bt; int M, N, K; };

struct StaticOrder {
    int nM, nN, nwg, G, c;
    __host__ __device__ void init(int M, int N, int G_, int c_) { nM = M / BM; nN = N / BM; nwg = nM * nN; G = G_; c = c_; }
    __host__ __device__ bool next(int i, Unit& u) const {
        const long L = (long)i * G + c; if (L >= nwg) return false;
        int wgid = (int)L; { const int q = nwg / NXCD, r = nwg % NXCD, xcd = wgid % NXCD, off = wgid / NXCD; wgid = (xcd < r ? xcd * (q + 1) : r * (q + 1) + (xcd - r) * q) + off; }
        const int nig = WGM * nN, gid = wgid / nig, fm = gid * WGM, gsz = (nM - fm) < WGM ? (nM - fm) : WGM;
        u.pm = fm + ((wgid % nig) % gsz); u.pn = (wgid % nig) / gsz; return true;
    }
    __device__ __forceinline__ void a_ready(const Unit&) const {}
    __device__ __forceinline__ void done(const Unit&) const {}
};


__device__ __forceinline__ unsigned cvt_pk_bf16(float lo, float hi) { unsigned r; asm volatile("v_cvt_pk_bf16_f32 %0, %1, %2" : "=v"(r) : "v"(lo), "v"(hi)); return r; }

constexpr float RMS_EPS = 1e-6f;
constexpr float INV_D = 1.0f / 1024.0f;
__device__ __forceinline__ float sigmoid_f(float x) { return __builtin_amdgcn_rcpf(1.0f + __builtin_amdgcn_exp2f(-1.4426950408889634f * x)); }
__device__ __forceinline__ float rstd_of(float ssq) { return __builtin_amdgcn_rsqf(ssq * INV_D + RMS_EPS); }

struct EpiGateUp {
    static constexpr bool PERM = true, AFTER_DRAIN = false;
    bf16_t* H; int ldh; const float* ssq;
    __device__ __forceinline__ void operator()(const f32x4 (&acc)[2][2][4][2], const Unit& u, int wr, int wc, int fr, int fq) const {
        const int row0 = u.pm * BM + wr * 64 + fr, col0 = u.pn * HALF + wc * 32 + 8 * fq;
#pragma unroll
        for (int ai = 0; ai < 2; ++ai)
#pragma unroll
            for (int m = 0; m < 4; ++m) { const int row = row0 + ai * HALF + m * 16; const float rs = rstd_of(ssq[row]);
                float h[8];
#pragma unroll
                for (int n = 0; n < 2; ++n)
#pragma unroll
                    for (int e = 0; e < 4; ++e) { const float g = acc[ai][0][m][n][e] * rs, up = acc[ai][1][m][n][e] * rs; h[4 * n + e] = g * sigmoid_f(g) * up; }
                u32x4 w; w.x = cvt_pk_bf16(h[0], h[1]); w.y = cvt_pk_bf16(h[2], h[3]); w.z = cvt_pk_bf16(h[4], h[5]); w.w = cvt_pk_bf16(h[6], h[7]);
                *(u32x4*)(H + (size_t)row * ldh + col0) = w; }
    }
};

template <int MODE> struct EpiResid {
    static constexpr bool PERM = true, AFTER_DRAIN = false;
    float* X; bf16_t* XB; float* ssq; float scale;
    __device__ __forceinline__ void operator()(const f32x4 (&acc)[2][2][4][2], const Unit& u, int wr, int wc, int fr, int fq) const {
        const int row0 = u.pm * BM + wr * 64 + fr;
        const int col0 = (MODE == 0 ? u.pn * BM : u.pn * HALF) + wc * 32 + 8 * fq;
#pragma unroll
        for (int ai = 0; ai < 2; ++ai)
#pragma unroll
            for (int m = 0; m < 4; ++m) { const int row = row0 + ai * HALF + m * 16; float sq = 0.f;
#pragma unroll
                for (int bj = 0; bj < (MODE == 0 ? 2 : 1); ++bj) {
                    float* xp = X + (size_t)row * 1024 + col0 + bj * HALF;
                    f32x4 x0 = *(const f32x4*)xp, x1 = *(const f32x4*)(xp + 4);
                    if (MODE == 0) { x0 += acc[ai][bj][m][0] * scale; x1 += acc[ai][bj][m][1] * scale; }
                    else {
#pragma unroll
                        for (int e = 0; e < 4; ++e) { x0[e] += acc[ai][0][m][0][e] * sigmoid_f(acc[ai][1][m][0][e]); x1[e] += acc[ai][0][m][1][e] * sigmoid_f(acc[ai][1][m][1][e]); } }
                    *(f32x4*)xp = x0; *(f32x4*)(xp + 4) = x1;
                    u32x4 w; w.x = cvt_pk_bf16(x0[0], x0[1]); w.y = cvt_pk_bf16(x0[2], x0[3]); w.z = cvt_pk_bf16(x1[0], x1[1]); w.w = cvt_pk_bf16(x1[2], x1[3]);
                    *(u32x4*)(XB + (size_t)row * 1024 + col0 + bj * HALF) = w;
                    sq += (x0[0] * x0[0] + x0[1] * x0[1]) + (x0[2] * x0[2] + x0[3] * x0[3]) + (x1[0] * x1[0] + x1[1] * x1[1]) + (x1[2] * x1[2] + x1[3] * x1[3]); }
                sq += __shfl_xor(sq, 16); sq += __shfl_xor(sq, 32);
                if (fq == 0) atomicAdd(ssq + row, sq); }
    }
};

struct EpiConvIn {
    static constexpr bool PERM = true, AFTER_DRAIN = false;
    bf16_t* Z; bf16_t* GB; const float* ssq; float* conv_p; float* conv_s;
    __device__ __forceinline__ void operator()(const f32x4 (&acc)[2][2][4][2], const Unit& u, int wr, int wc, int fr, int fq) const {
        const int row0 = u.pm * BM + wr * 64 + fr;
        if (u.pn < 8) {
            const int col0 = u.pn * HALF + wc * 32 + 8 * fq;
#pragma unroll
            for (int ai = 0; ai < 2; ++ai)
#pragma unroll
                for (int m = 0; m < 4; ++m) { const int row = row0 + ai * HALF + m * 16; const float rs = rstd_of(ssq[row]), rs2 = rs * rs;
                    const f32x4 z0 = acc[ai][0][m][0] * acc[ai][1][m][0] * rs2, z1 = acc[ai][0][m][1] * acc[ai][1][m][1] * rs2;
                    u32x4 w; w.x = cvt_pk_bf16(z0[0], z0[1]); w.y = cvt_pk_bf16(z0[2], z0[3]); w.z = cvt_pk_bf16(z1[0], z1[1]); w.w = cvt_pk_bf16(z1[2], z1[3]);
                    *(u32x4*)(Z + (size_t)row * 1024 + col0) = w;
                    float* cp = nullptr;
                    if (row < 16384) { const int t = row & 2047; if (t >= 2046) cp = conv_p + ((size_t)(row >> 11) * 2 + (t - 2046)) * 1024 + col0; }
                    else { const int r2 = row - 16384, t = r2 & 7; if (t >= 6) cp = conv_s + ((size_t)(r2 >> 3) * 2 + (t - 6)) * 1024 + col0; }
                    if (cp) { *(f32x4*)cp = z0; *(f32x4*)(cp + 4) = z1; } }
        } else {
            const int col0 = (u.pn - 8) * BM + wc * 32 + 8 * fq;
#pragma unroll
            for (int ai = 0; ai < 2; ++ai)
#pragma unroll
                for (int m = 0; m < 4; ++m) { const int row = row0 + ai * HALF + m * 16; const float rs = rstd_of(ssq[row]);
#pragma unroll
                    for (int bj = 0; bj < 2; ++bj) { const f32x4 g0 = acc[ai][bj][m][0] * rs, g1 = acc[ai][bj][m][1] * rs;
                        u32x4 w; w.x = cvt_pk_bf16(g0[0], g0[1]); w.y = cvt_pk_bf16(g0[2], g0[3]); w.z = cvt_pk_bf16(g1[0], g1[1]); w.w = cvt_pk_bf16(g1[2], g1[3]);
                        *(u32x4*)(GB + (size_t)row * 1024 + col0 + bj * HALF) = w; } }
        }
    }
};

template <class Epi, class Sched, bool ALIGN_EPI = false, bool SP2 = false>
__device__ __forceinline__ void gemm_phase(PG8_LAS unsigned char* lds, const Gemm g, const Sched& S, const Epi& E) {
    const int tid = threadIdx.x, wid = __builtin_amdgcn_readfirstlane(tid >> 6), lane = tid & 63, wr = wid >> 2, wc = wid & 3, fr = lane & 15, fq = lane >> 4;
    const int K = g.K, nt = K / BK;
    unsigned voffA[2], voffB[2];
#pragma unroll
    for (int i = 0; i < 2; ++i) { int R, C; stage_rc(tid * 16 + i * 8192, R, C); const int Rb = Epi::PERM ? ((R & ~31) + perm32(R & 31)) : R;
        voffA[i] = (unsigned)(R * K + C) * 2u; voffB[i] = (unsigned)(Rb * K + C) * 2u; }
    const size_t kstep = (size_t)(BK * 2);
    const size_t hstep = (size_t)HALF * K * 2;
    const size_t tstep = 2 * hstep;
    const unsigned ldsw = (unsigned)wid * 1024u;
    const int aoff = lds_byte(wr * 64 + fr, fq * 8), boff = lds_byte(wc * 32 + fr, fq * 8);
#define PG8_SA(b, h) (((b) * 2 + (h)) * HTB)
#define PG8_SB(b, h) ((4 + (b) * 2 + (h)) * HTB)
#define PG8_STAGE(bufoff, gbase, voff) do { _Pragma("unroll") for (int _i = 0; _i < 2; ++_i) \
        __builtin_amdgcn_global_load_lds((const unsigned*)((const char*)(gbase) + (voff)[_i]), (PG8_LAS unsigned*)(lds + (bufoff) + ldsw + _i * 8192), 16, 0, 0); } while (0)
#define PG8_LDA(dst, b, h) do { _Pragma("unroll") for (int m = 0; m < 4; ++m) _Pragma("unroll") for (int k = 0; k < 2; ++k) dst[m][k] = *(const PG8_LAS bf16x8*)(lds + PG8_SA(b, h) + aoff + m * 2048 + k * 1024); } while (0)
#define PG8_LDB(dst, b, h) do { _Pragma("unroll") for (int n = 0; n < 2; ++n) _Pragma("unroll") for (int k = 0; k < 2; ++k) dst[n][k] = *(const PG8_LAS bf16x8*)(lds + PG8_SB(b, h) + boff + n * 2048 + k * 1024); } while (0)
#define PG8_MMA(ai, bj, At, Bt) do { __builtin_amdgcn_s_setprio(1); _Pragma("unroll") for (int m = 0; m < 4; ++m) _Pragma("unroll") for (int n = 0; n < 2; ++n) _Pragma("unroll") for (int k = 0; k < 2; ++k) \
        acc[ai][bj][m][n] = __builtin_amdgcn_mfma_f32_16x16x32_bf16(Bt[n][k], At[m][k], acc[ai][bj][m][n], 0, 0, 0); __builtin_amdgcn_s_setprio(0); } while (0)
#define PG8_WAIT_V(n) asm volatile("s_waitcnt vmcnt(" #n ")" ::: "memory")
#define PG8_WAIT_L(n) asm volatile("s_waitcnt lgkmcnt(" #n ")" ::: "memory")
#define PG8_BAR __builtin_amdgcn_s_barrier()
#define PG8_SCHED __builtin_amdgcn_sched_barrier(0)
    Unit cur, nxt; int ui = 0;
    if (!S.next(0, cur)) return;
    f32x4 acc[2][2][4][2];
#pragma unroll
    for (int a = 0; a < 2; ++a)
#pragma unroll
        for (int b = 0; b < 2; ++b)
#pragma unroll
            for (int m = 0; m < 4; ++m)
#pragma unroll
                for (int n = 0; n < 2; ++n) acc[a][b][m][n] = (f32x4){0.f, 0.f, 0.f, 0.f};
    bf16x8 At[4][2], B0[2][2], B1[2][2];
    const char* cA = (const char*)g.A + (size_t)cur.pm * tstep; const char* cB = (const char*)g.Bt + (size_t)cur.pn * tstep;
    S.a_ready(cur);
    if constexpr (SP2) {
        PG8_STAGE(PG8_SB(0, 0), cB, voffB); PG8_STAGE(PG8_SB(0, 1), cB + hstep, voffB); PG8_STAGE(PG8_SA(0, 0), cA, voffA); PG8_STAGE(PG8_SA(0, 1), cA + hstep, voffA);
        if (wr == 1) PG8_BAR;
        PG8_WAIT_V(2); PG8_BAR;
        PG8_STAGE(PG8_SB(1, 0), cB + kstep, voffB); PG8_STAGE(PG8_SA(1, 0), cA + kstep, voffA); PG8_STAGE(PG8_SB(1, 1), cB + hstep + kstep, voffB);
        PG8_WAIT_V(6); PG8_BAR;
    } else {
        PG8_STAGE(PG8_SB(0, 0), cB, voffB); PG8_STAGE(PG8_SA(0, 0), cA, voffA); PG8_STAGE(PG8_SB(0, 1), cB + hstep, voffB); PG8_STAGE(PG8_SA(0, 1), cA + hstep, voffA);
        if (wr == 1) PG8_BAR;
        PG8_WAIT_V(4); PG8_BAR;
        PG8_STAGE(PG8_SB(1, 0), cB + kstep, voffB); PG8_STAGE(PG8_SA(1, 0), cA + kstep, voffA); PG8_STAGE(PG8_SB(1, 1), cB + hstep + kstep, voffB);
        PG8_WAIT_V(6); PG8_BAR;
    }
    for (;;) {
        const bool has_next = S.next(ui + 1, nxt);
        const char* nA = has_next ? (const char*)g.A + (size_t)nxt.pm * tstep : cA; const char* nB = has_next ? (const char*)g.Bt + (size_t)nxt.pn * tstep : cB;
        for (int t = 0; t < nt; t += 2) {
            const bool last = (t == nt - 2);
            const char* a1 = cA + (size_t)(t + 1) * kstep;
            const char* a2 = last ? nA : cA + (size_t)(t + 2) * kstep; const char* b2 = last ? nB : cB + (size_t)(t + 2) * kstep;
            const char* a3 = a2 + kstep; const char* b3 = b2 + kstep;
            if (last && has_next) S.a_ready(nxt);
            if constexpr (SP2) {
            PG8_LDB(B0, 0, 0); PG8_LDB(B1, 0, 1); PG8_SCHED; PG8_LDA(At, 0, 0); PG8_STAGE(PG8_SA(1, 1), a1 + hstep, voffA);
            PG8_WAIT_V(8); PG8_WAIT_L(0); PG8_BAR; PG8_MMA(0, 0, At, B0); PG8_MMA(0, 1, At, B1); PG8_BAR; PG8_SCHED;
            PG8_LDA(At, 0, 1); PG8_STAGE(PG8_SB(0, 0), b2, voffB); PG8_STAGE(PG8_SB(0, 1), b2 + hstep, voffB); PG8_STAGE(PG8_SA(0, 0), a2, voffA);
            PG8_WAIT_V(8); PG8_WAIT_L(0); PG8_BAR; PG8_MMA(1, 0, At, B0); PG8_MMA(1, 1, At, B1); PG8_BAR; PG8_SCHED;
            PG8_LDB(B0, 1, 0); PG8_LDB(B1, 1, 1); PG8_SCHED; PG8_LDA(At, 1, 0); PG8_STAGE(PG8_SA(0, 1), a2 + hstep, voffA);
            PG8_WAIT_V(8); PG8_WAIT_L(0); PG8_BAR; PG8_MMA(0, 0, At, B0); PG8_MMA(0, 1, At, B1); PG8_BAR; PG8_SCHED;
            PG8_LDA(At, 1, 1); PG8_STAGE(PG8_SB(1, 0), b3, voffB); PG8_STAGE(PG8_SB(1, 1), b3 + hstep, voffB); PG8_STAGE(PG8_SA(1, 0), a3, voffA);
            PG8_WAIT_V(8); PG8_WAIT_L(0); PG8_BAR; PG8_MMA(1, 0, At, B0); PG8_MMA(1, 1, At, B1); PG8_BAR; PG8_SCHED;
            } else {
            PG8_LDB(B0, 0, 0); PG8_SCHED; PG8_LDA(At, 0, 0); PG8_STAGE(PG8_SA(1, 1), a1 + hstep, voffA);
            PG8_WAIT_L(8); PG8_BAR; PG8_WAIT_L(0); PG8_MMA(0, 0, At, B0); PG8_BAR; PG8_SCHED;
            PG8_LDB(B1, 0, 1); PG8_STAGE(PG8_SB(0, 0), b2, voffB);
            PG8_BAR; PG8_WAIT_L(0); PG8_MMA(0, 1, At, B1); PG8_BAR;
            PG8_LDA(At, 0, 1); PG8_STAGE(PG8_SA(0, 0), a2, voffA);
            PG8_BAR; PG8_WAIT_L(0); PG8_MMA(1, 0, At, B0); PG8_BAR; PG8_SCHED;
            PG8_STAGE(PG8_SB(0, 1), b2 + hstep, voffB);
            PG8_WAIT_V(6); PG8_BAR; PG8_MMA(1, 1, At, B1); PG8_BAR;
            PG8_LDB(B0, 1, 0); PG8_SCHED; PG8_LDA(At, 1, 0); PG8_STAGE(PG8_SA(0, 1), a2 + hstep, voffA);
            PG8_WAIT_L(8); PG8_BAR; PG8_WAIT_L(0); PG8_MMA(0, 0, At, B0); PG8_BAR; PG8_SCHED;
            PG8_LDB(B1, 1, 1); PG8_STAGE(PG8_SB(1, 0), b3, voffB);
            PG8_BAR; PG8_WAIT_L(0); PG8_MMA(0, 1, At, B1); PG8_BAR;
            PG8_LDA(At, 1, 1); PG8_STAGE(PG8_SA(1, 0), a3, voffA);
            PG8_BAR; PG8_WAIT_L(0); PG8_MMA(1, 0, At, B0); PG8_BAR; PG8_SCHED;
            PG8_STAGE(PG8_SB(1, 1), b3 + hstep, voffB);
            PG8_WAIT_V(6); PG8_BAR; PG8_MMA(1, 1, At, B1); PG8_BAR;
            }
        }
        if constexpr (ALIGN_EPI) { if (wr == 0) PG8_BAR; }
        if constexpr (!Epi::AFTER_DRAIN) { E(acc, cur, wr, wc, fr, fq); S.done(cur); }
        if (!has_next) break;
#pragma unroll
        for (int a = 0; a < 2; ++a)
#pragma unroll
            for (int b = 0; b < 2; ++b)
#pragma unroll
                for (int m = 0; m < 4; ++m)
#pragma unroll
                    for (int n = 0; n < 2; ++n) acc[a][b][m][n] = (f32x4){0.f, 0.f, 0.f, 0.f};
        cur = nxt; cA = nA; cB = nB; ++ui;
        if constexpr (ALIGN_EPI) { if (wr == 1) PG8_BAR; }
    }
    PG8_WAIT_V(0);
    if constexpr (!ALIGN_EPI) { if (wr == 0) PG8_BAR; }
    PG8_BAR;
    if constexpr (Epi::AFTER_DRAIN) { E.fused(acc, cur, wr, wc, fr, fq, lds, wid, lane); S.done(cur); }
#undef PG8_SA
#undef PG8_SB
#undef PG8_STAGE
#undef PG8_LDA
#undef PG8_LDB
#undef PG8_MMA
#undef PG8_WAIT_V
#undef PG8_WAIT_L
#undef PG8_BAR
#undef PG8_SCHED
}
}

#define GAS __attribute__((address_space(1)))
#define LAS __attribute__((address_space(3)))
typedef unsigned short bf16;
typedef unsigned v4u __attribute__((ext_vector_type(4)));
typedef float f32x4 __attribute__((ext_vector_type(4)));
typedef short bf16x8 __attribute__((ext_vector_type(8)));
typedef GAS unsigned gu32;
typedef GAS unsigned long long gu64;
#define RLX_AGENT __ATOMIC_RELAXED, __HIP_MEMORY_SCOPE_AGENT
#define LDS_WAIT() asm volatile("s_waitcnt lgkmcnt(0)" ::: "memory")
#define VM_WAIT() asm volatile("s_waitcnt vmcnt(0)" ::: "memory")
__device__ __forceinline__ unsigned long long rt() { return __builtin_amdgcn_s_memrealtime(); }
__device__ __forceinline__ unsigned f2bf(float f) { unsigned u = __builtin_bit_cast(unsigned, f); return (u + 0x7fffu + ((u >> 16) & 1u)) >> 16; }
__device__ __forceinline__ unsigned pk2(float lo, float hi) { return f2bf(lo) | (f2bf(hi) << 16); }

#define XB_TMO      128
#define XB_XCNT(j)  (256  + 64 * (j))
#define XB_XSUB(j)  (1280 + 64 * (j))
#define XB_XGEN(j)  (2304 + 64 * (j))
#define XB_TOP      3328
#define XB_TOPGEN   3392
#define XCD_BAR_WORDS 3456
#define XB_SPIN_CAP (1u << 18)

__device__ __forceinline__ unsigned xb_ld(unsigned* p)              { return __hip_atomic_load(p, __ATOMIC_RELAXED, __HIP_MEMORY_SCOPE_AGENT); }
__device__ __forceinline__ unsigned xb_add(unsigned* p, unsigned v) { return __hip_atomic_fetch_add(p, v, __ATOMIC_RELAXED, __HIP_MEMORY_SCOPE_AGENT); }
__device__ __forceinline__ unsigned xb_xcc_id() { return (unsigned)__builtin_amdgcn_s_getreg((3 << 11) | 20) & 0xFu; }
#define XB_SPIN(cond, bar) do { unsigned _sp = 0; while (cond) { __builtin_amdgcn_s_sleep(1); \
    if ((++_sp & 255u) == 0u) { if (xb_ld(&(bar)[XB_TMO])) break; if (_sp > XB_SPIN_CAP) { atomicAdd(&(bar)[XB_TMO], 1u); break; } } } } while (0)

struct XcdBarrier {
    unsigned* bar; unsigned x;
    volatile LAS unsigned* st;
};

__device__ __forceinline__ XcdBarrier xcd_barrier_post(unsigned* bar, volatile LAS unsigned* st) {
    XcdBarrier b; b.bar = bar; b.x = xb_xcc_id(); b.st = st;
    if (threadIdx.x == 0) (void)xb_add(&bar[XB_XCNT(b.x)], 1u);
    return b;
}
__device__ __forceinline__ void xcd_barrier_complete(unsigned* bar, unsigned x, unsigned& nloc, unsigned& nx) {
    const unsigned G = gridDim.x * gridDim.y * gridDim.z;
    unsigned sum, cnt, mine, sp = 0u;
    for (;;) {
        sum = 0u; cnt = 0u; mine = 0u;
#pragma unroll
        for (unsigned j = 0; j < 16; ++j) { const unsigned c = xb_ld(&bar[XB_XCNT(j)]); sum += c; cnt += (c > 0u) ? 1u : 0u; mine = (j == x) ? c : mine; }
        if (sum == G) break;
        __builtin_amdgcn_s_sleep(1);
        if ((++sp & 255u) == 0u) { if (xb_ld(&bar[XB_TMO])) break; if (sp > XB_SPIN_CAP) { atomicAdd(&bar[XB_TMO], 1u); break; } }
    }
    nloc = mine > 0u ? mine : 1u; nx = cnt > 0u ? cnt : 1u;
}

__device__ __forceinline__ void xcd_barrier(const XcdBarrier& b) {
    asm volatile("s_waitcnt vmcnt(0)" ::: "memory");
    __syncthreads();
    if (threadIdx.x == 0) {
        unsigned* bar = b.bar;
        __builtin_amdgcn_s_waitcnt(0);
        unsigned nloc = b.st[0], nx = b.st[1];
        if (nloc == 0u) { xcd_barrier_complete(bar, b.x, nloc, nx); b.st[0] = nloc; b.st[1] = nx; }
        const unsigned old = xb_add(&bar[XB_XSUB(b.x)], 1u);
        const unsigned gen = old / nloc;
        if (old + 1u == (gen + 1u) * nloc) {
            __builtin_amdgcn_fence(__ATOMIC_RELEASE, "agent");
            asm volatile("s_waitcnt vmcnt(0)" ::: "memory");
            const unsigned og = xb_add(&bar[XB_TOP], 1u);
            const unsigned tg = og / nx;
            if (og + 1u == (tg + 1u) * nx) xb_add(&bar[XB_TOPGEN], 1u);
            else XB_SPIN(xb_ld(&bar[XB_TOPGEN]) == tg, bar);
            __builtin_amdgcn_fence(__ATOMIC_ACQUIRE, "agent");
            xb_add(&bar[XB_XGEN(b.x)], 1u);
            asm volatile("s_waitcnt vmcnt(0)" ::: "memory");
        } else {
            XB_SPIN(xb_ld(&bar[XB_XGEN(b.x)]) == gen, bar);
            __builtin_amdgcn_fence(__ATOMIC_ACQUIRE, "agent");
            asm volatile("s_waitcnt vmcnt(0)" ::: "memory");
        }
    }
    __syncthreads();
}


constexpr int NWAVES = 8;
#ifndef MK_ONE_LAUNCH
#define MK_ONE_LAUNCH 1
#endif
constexpr int N_PHASES = 15;

constexpr int D = 1024, FF = 4096, MP = 8 * 2048, MS = 128 * 8, M = MP + MS;
constexpr int NG = 64, PS = 64, GS = 16;
constexpr float EPS = 1e-6f;
constexpr size_t O_Y = 0, O_SRP = (size_t)M * D, O_SIP = O_SRP + 8 * 4096, O_CP = O_SIP + 8 * 4096, O_SRS = O_CP + 8 * 2 * 1024, O_SIS = O_SRS + 128 * 4096, O_CS = O_SIS + 128 * 4096, O_END = O_CS + 128 * 2 * 1024;
static_assert(O_END == 19218432, "output size");

constexpr size_t MiB = 1u << 20;
constexpr size_t WS_CTL = 0, CTL_ZERO_BYTES = 1 * MiB;
constexpr size_t WS_SSQ = 1 * MiB;
constexpr size_t WS_SSMP = 2 * MiB;
constexpr size_t WS_WGU = 4 * MiB;
constexpr size_t WS_WD = 68 * MiB;
constexpr size_t WS_WGLU = 100 * MiB;
constexpr size_t WS_WIN = 104 * MiB;
constexpr size_t WS_WOUT = 110 * MiB;
constexpr size_t WS_X = 112 * MiB;
constexpr size_t WS_XB = 180 * MiB;
constexpr size_t WS_H = 214 * MiB;
constexpr size_t WS_G = WS_H, WS_Z = WS_H, WS_GB = WS_H + 34 * MiB, WS_A2 = WS_H + 68 * MiB;
constexpr size_t WS_END = 350 * MiB;
constexpr int CW_BAR = 4096;

constexpr int RING_OFF = 0, RING_BYTES = 131072;
constexpr int LDSCTL_OFF = RING_BYTES, MISC_OFF = LDSCTL_OFF + 320;
constexpr int LDS_BYTES = 147456;

struct Frame {
    LAS unsigned char* lds;
    volatile LAS unsigned* MISC;
    gu32* ctl;
    int tid, lane, wave, vcu, G;
    const float* in[21]; float* out; unsigned char* ws;
};

__device__ __forceinline__ float wave_sum(float v) {
#pragma unroll
    for (int o = 1; o < 64; o <<= 1) v += __shfl_xor(v, o);
    return v;
}
__device__ __forceinline__ float bf2f(unsigned short b) { return __builtin_bit_cast(float, (unsigned)b << 16); }

__device__ __forceinline__ void p0_transpose_item(const float* W, int K, int N, bf16* WT, const float* gk, int k0, int n0s, int n0d, LAS float* scr, int lane) {
#pragma unroll 8
    for (int i = 0; i < 32; ++i) { const int kk = 2 * i + (lane >> 5); float v = W[(size_t)(k0 + kk) * N + n0s + (lane & 31)]; if (gk) v *= gk[k0 + kk]; scr[kk * 33 + (lane & 31)] = v; }
    LDS_WAIT(); asm volatile("" ::: "memory");
    const int c = lane & 7;
#pragma unroll
    for (int j = 0; j < 4; ++j) { const int n = (lane >> 3) + 8 * j; const LAS float* s = scr + (8 * c) * 33 + n;
        v4u o; o.x = pk2(s[0 * 33], s[1 * 33]); o.y = pk2(s[2 * 33], s[3 * 33]); o.z = pk2(s[4 * 33], s[5 * 33]); o.w = pk2(s[6 * 33], s[7 * 33]);
        *(GAS v4u*)(WT + (size_t)(n0d + n) * K + k0 + 8 * c) = o; }
    LDS_WAIT(); asm volatile("" ::: "memory");
}
__device__ __forceinline__ int pair_src(int nd, int base, int hstride) { return base + ((nd >> 7) & 1) * hstride + 128 * (nd >> 8) + (nd & 127); }

__device__ __forceinline__ void p0_prologue(Frame& F) {
    LAS float* scr = (LAS float*)(F.lds + RING_OFF + F.wave * 16384);
    const int gw = F.vcu * NWAVES + F.wave, NGW = F.G * NWAVES, lane = F.lane;
    const float* norm_g = F.in[5];
    constexpr int I_GU = (D / 64) * (2 * FF / 32), I_D = (FF / 64) * (D / 32), I_GLU = (D / 64) * (2 * D / 32), I_IN = (D / 64) * (3 * D / 32), I_OUT = (D / 64) * (D / 32);
    constexpr int NITEMS = 4 * I_GU + 4 * I_D + I_GLU + I_IN + I_OUT;
    for (int it = gw; it < NITEMS; it += NGW) {
        int r = it;
        if (r < 4 * I_GU) { const int f = r / I_GU; r -= f * I_GU; const int nb = r % (2 * FF / 32), kb = r / (2 * FF / 32), nd = 32 * nb;
            const float* gk = norm_g + ((f >> 1) * 3 + (f & 1) * 2) * D;
            p0_transpose_item(F.in[7] + (size_t)f * D * 2 * FF, D, 2 * FF, (bf16*)(F.ws + WS_WGU) + (size_t)f * 2 * FF * D, gk, 64 * kb, pair_src(nd, 0, FF), nd, scr, lane); continue; }
        r -= 4 * I_GU;
        if (r < 4 * I_D) { const int f = r / I_D; r -= f * I_D; const int nb = r % (D / 32), kb = r / (D / 32), nd = 32 * nb;
            p0_transpose_item(F.in[8] + (size_t)f * FF * D, FF, D, (bf16*)(F.ws + WS_WD) + (size_t)f * D * FF, nullptr, 64 * kb, nd, nd, scr, lane); continue; }
        r -= 4 * I_D;
        if (r < I_GLU) { const int nb = r % (2 * D / 32), kb = r / (2 * D / 32), nd = 32 * nb;
            p0_transpose_item(F.in[17], D, 2 * D, (bf16*)(F.ws + WS_WGLU), nullptr, 64 * kb, pair_src(nd, 0, D), nd, scr, lane); continue; }
        r -= I_GLU;
        if (r < I_IN) { const int nb = r % (3 * D / 32), kb = r / (3 * D / 32), nd = 32 * nb;
            const int ns = nd < 2048 ? pair_src(nd, D, D) : nd - 2048;
            p0_transpose_item(F.in[18], D, 3 * D, (bf16*)(F.ws + WS_WIN), norm_g + 4 * D, 64 * kb, ns, nd, scr, lane); continue; }
        r -= I_IN;
        { const int nb = r % (D / 32), kb = r / (D / 32), nd = 32 * nb;
            p0_transpose_item(F.in[20], D, D, (bf16*)(F.ws + WS_WOUT), nullptr, 64 * kb, nd, nd, scr, lane); }
    }
    float* X = (float*)(F.ws + WS_X); bf16* XB = (bf16*)(F.ws + WS_XB); float* ssq = (float*)(F.ws + WS_SSQ);
    for (int m = gw; m < M; m += NGW) {
        const float* src = m < MP ? F.in[0] + (size_t)m * D : F.in[1] + (size_t)(m - MP) * D;
        const GAS f32x4* xr = (const GAS f32x4*)src + lane; GAS f32x4* xo = (GAS f32x4*)(X + (size_t)m * D) + lane;
        GAS unsigned long long* o8 = (GAS unsigned long long*)(XB + (size_t)m * D) + lane;
        float s = 0.f;
#pragma unroll
        for (int j = 0; j < 4; ++j) { const f32x4 v = xr[64 * j]; s += (v.x * v.x + v.y * v.y) + (v.z * v.z + v.w * v.w); xo[64 * j] = v;
            o8[64 * j] = (unsigned long long)pk2(v.x, v.y) | ((unsigned long long)pk2(v.z, v.w) << 32); }
        s = wave_sum(s);
        if (lane == 0) ssq[m] = s;
    }
    for (int i = gw * 64 + lane; i < 7 * M; i += NGW * 64) ssq[M + i] = 0.f;
    float* sp = (float*)(F.ws + WS_SSMP);
    for (int i = gw * 64 + lane; i < NG * PS; i += NGW * 64) {
        const int g = i / PS;
        const float lr = F.in[9][i], li = F.in[10][i], dt = expf(F.in[11][g]);
        const float mag = expf(lr * dt); float sn, cs; sincosf(li * dt, &sn, &cs);
        const float lbr = mag * cs, lbi = mag * sn, den = lr * lr + li * li, nr = lbr - 1.0f, ni = lbi;
        const float fr = (nr * lr + ni * li) / den, fi = (ni * lr - nr * li) / den;
        sp[i] = lbr; sp[4096 + i] = lbi;
#pragma unroll
        for (int c = 0; c < GS; ++c) { const float br = F.in[12][(size_t)i * GS + c], bi = F.in[13][(size_t)i * GS + c];
            sp[8192 + (size_t)i * GS + c] = fr * br - fi * bi; sp[8192 + 65536 + (size_t)i * GS + c] = fr * bi + fi * br; }
    }
}

__device__ __forceinline__ float gelu_tanh(float x) {
    const float a = 0.7978845608028654f * (x + 0.044715f * x * x * x);
    return x * __builtin_amdgcn_rcpf(1.0f + __builtin_amdgcn_exp2f(-2.0f * 1.4426950408889634f * a));
}

__device__ __forceinline__ void ssm_phase(Frame& F) {
    constexpr int TB = 8;
    LAS float* wl = (LAS float*)(F.lds + RING_OFF + F.wave * 16384);
    LAS float* hsr = wl; LAS float* hsi = wl + TB * 65; LAS float* cre = wl + 2 * TB * 65; LAS float* cim = cre + 16 * 65;
    const int gw = F.vcu * NWAVES + F.wave, NGW = F.G * NWAVES, lane = F.lane;
    const float* X = (const float*)(F.ws + WS_X); const float* ssq = (const float*)(F.ws + WS_SSQ) + 1 * M;
    const float* sp = (const float*)(F.ws + WS_SSMP); bf16* Gb = (bf16*)(F.ws + WS_G);
    const float* g1 = F.in[5] + 1 * D; const float* dsk = F.in[16];
    constexpr int NITEM = 8 * NG + 128 * NG;
    for (int it = gw; it < NITEM; it += NGW) {
        int seq, g, L, row0; const float *s0r = nullptr, *s0i = nullptr; float *outr, *outi;
        if (it < 8 * NG) { seq = it / NG; g = it % NG; L = 2048; row0 = seq * 2048; outr = F.out + O_SRP + (size_t)(seq * NG + g) * PS; outi = F.out + O_SIP + (size_t)(seq * NG + g) * PS; }
        else { const int j = it - 8 * NG; seq = j / NG; g = j % NG; L = 8; row0 = MP + seq * 8; s0r = F.in[2] + (size_t)(seq * NG + g) * PS; s0i = F.in[3] + (size_t)(seq * NG + g) * PS;
               outr = F.out + O_SRS + (size_t)(seq * NG + g) * PS; outi = F.out + O_SIS + (size_t)(seq * NG + g) * PS; }
        const int gp = g * PS + lane;
        const float lbr = sp[gp], lbi = sp[4096 + gp];
        float bbr[GS], bbi[GS];
#pragma unroll
        for (int c = 0; c < GS; ++c) { bbr[c] = sp[8192 + (size_t)gp * GS + c]; bbi[c] = sp[8192 + 65536 + (size_t)gp * GS + c]; }
#pragma unroll
        for (int c = 0; c < GS; ++c) { cre[c * 65 + lane] = F.in[14][((size_t)g * GS + c) * PS + lane]; cim[c * 65 + lane] = F.in[15][((size_t)g * GS + c) * PS + lane]; }
        float gn[GS];
#pragma unroll
        for (int c = 0; c < GS; ++c) gn[c] = g1[g * GS + c];
        float hr = s0r ? s0r[lane] : 0.f, hi = s0i ? s0i[lane] : 0.f;
        const int oc = lane & 15, otq = lane >> 4;
        const float dc = dsk[g * GS + oc], gc = g1[g * GS + oc];
        for (int t0 = 0; t0 < L; t0 += TB) {
#pragma unroll
            for (int tl = 0; tl < TB; ++tl) { const int row = row0 + t0 + tl; const float rs = __builtin_amdgcn_rsqf(ssq[row] * (1.0f / D) + EPS);
                const float* xr = X + (size_t)row * D + g * GS; float br = 0.f, bi = 0.f;
#pragma unroll
                for (int c = 0; c < GS; ++c) { const float uu = xr[c] * rs * gn[c]; br += bbr[c] * uu; bi += bbi[c] * uu; }
                const float nr = lbr * hr - lbi * hi + br, ni = lbr * hi + lbi * hr + bi; hr = nr; hi = ni;
                hsr[tl * 65 + lane] = hr; hsi[tl * 65 + lane] = hi; }
            LDS_WAIT(); __builtin_amdgcn_wave_barrier(); asm volatile("" ::: "memory");
#pragma unroll
            for (int j = 0; j < 2; ++j) { const int tl = otq * 2 + j; const int row = row0 + t0 + tl; float y = 0.f;
                for (int p = 0; p < PS; ++p) y += cre[oc * 65 + p] * hsr[tl * 65 + p] - cim[oc * 65 + p] * hsi[tl * 65 + p];
                const float rs = __builtin_amdgcn_rsqf(ssq[row] * (1.0f / D) + EPS);
                const float uu = X[(size_t)row * D + g * GS + oc] * rs * gc;
                y += dc * uu;
                Gb[(size_t)row * D + g * GS + oc] = (bf16)f2bf(gelu_tanh(y)); }
            LDS_WAIT(); __builtin_amdgcn_wave_barrier(); asm volatile("" ::: "memory");
        }
        outr[lane] = hr; outi[lane] = hi;
    }
}

__device__ __forceinline__ void conv_phase(Frame& F) {
    const bf16* Z = (const bf16*)(F.ws + WS_Z); const bf16* GBp = (const bf16*)(F.ws + WS_GB); bf16* A2 = (bf16*)(F.ws + WS_A2);
    const float* cw = F.in[19]; const float* cache = F.in[4];
    const int gt = (F.vcu * NWAVES + F.wave) * 64 + F.lane, NGT = F.G * NWAVES * 64;
    for (int it = gt; it < M * (D / 8); it += NGT) {
        const int row = it >> 7, c0 = (it & 127) * 8;
        int t; const float* cb = nullptr;
        if (row < MP) t = row & 2047; else { const int r2 = row - MP; t = r2 & 7; cb = cache + (size_t)(r2 >> 3) * 2 * D; }
        float z0[8], z1[8], z2[8], gb[8];
        { const v4u v = *(const GAS v4u*)(Z + (size_t)row * D + c0); const v4u q = *(const GAS v4u*)(GBp + (size_t)row * D + c0);
#pragma unroll
          for (int e = 0; e < 4; ++e) { z2[2 * e] = __builtin_bit_cast(float, v[e] << 16); z2[2 * e + 1] = __builtin_bit_cast(float, v[e] & 0xffff0000u);
                                        gb[2 * e] = __builtin_bit_cast(float, q[e] << 16); gb[2 * e + 1] = __builtin_bit_cast(float, q[e] & 0xffff0000u); } }
        if (t >= 1) { const v4u v = *(const GAS v4u*)(Z + (size_t)(row - 1) * D + c0);
#pragma unroll
          for (int e = 0; e < 4; ++e) { z1[2 * e] = __builtin_bit_cast(float, v[e] << 16); z1[2 * e + 1] = __builtin_bit_cast(float, v[e] & 0xffff0000u); } }
        else {
#pragma unroll
          for (int e = 0; e < 8; ++e) z1[e] = cb ? cb[D + c0 + e] : 0.f; }
        if (t >= 2) { const v4u v = *(const GAS v4u*)(Z + (size_t)(row - 2) * D + c0);
#pragma unroll
          for (int e = 0; e < 4; ++e) { z0[2 * e] = __builtin_bit_cast(float, v[e] << 16); z0[2 * e + 1] = __builtin_bit_cast(float, v[e] & 0xffff0000u); } }
        else {
#pragma unroll
          for (int e = 0; e < 8; ++e) z0[e] = cb ? cb[t * D + c0 + e] : 0.f; }
        float o[8];
#pragma unroll
        for (int e = 0; e < 8; ++e) o[e] = gb[e] * (cw[c0 + e] * z0[e] + cw[D + c0 + e] * z1[e] + cw[2 * D + c0 + e] * z2[e]);
        v4u w; w.x = pk2(o[0], o[1]); w.y = pk2(o[2], o[3]); w.z = pk2(o[4], o[5]); w.w = pk2(o[6], o[7]);
        *(GAS v4u*)(A2 + (size_t)row * D + c0) = w;
    }
}

__device__ __forceinline__ void final_phase(Frame& F) {
    const float* X = (const float*)(F.ws + WS_X); const float* ssq = (const float*)(F.ws + WS_SSQ) + 6 * M; const float* fg = F.in[6];
    const int gw = F.vcu * NWAVES + F.wave, NGW = F.G * NWAVES, lane = F.lane;
    f32x4 gv[4];
#pragma unroll
    for (int j = 0; j < 4; ++j) gv[j] = ((const GAS f32x4*)fg)[lane + 64 * j];
    for (int m = gw; m < M; m += NGW) {
        const float rs = __builtin_amdgcn_rsqf(ssq[m] * (1.0f / D) + EPS);
        const GAS f32x4* xr = (const GAS f32x4*)(X + (size_t)m * D) + lane; GAS f32x4* yo = (GAS f32x4*)(F.out + O_Y + (size_t)m * D) + lane;
#pragma unroll
        for (int j = 0; j < 4; ++j) yo[64 * j] = xr[64 * j] * rs * gv[j];
    }
}

struct Args { const float* in[21]; float* out; unsigned char* ws; int ph_lo, ph_hi; };
__global__ void __launch_bounds__(NWAVES * 64, 2) skel_fwd(Args args) {
    extern __shared__ __attribute__((aligned(16))) unsigned char lds[];
    Frame F;
    F.lds = (LAS unsigned char*)lds;
    F.MISC = (volatile LAS unsigned*)(F.lds + MISC_OFF);
    F.tid = threadIdx.x; F.lane = F.tid & 63; F.wave = __builtin_amdgcn_readfirstlane(F.tid >> 6);
    F.G = gridDim.x; { const int bx = blockIdx.x; F.vcu = (F.G % 8 == 0) ? (bx % 8) * (F.G / 8) + bx / 8 : bx; }
    F.ws = args.ws; F.out = args.out; F.ctl = (gu32*)(args.ws + WS_CTL);
#pragma unroll
    for (int i = 0; i < 21; ++i) F.in[i] = args.in[i];
    for (int u = F.tid; u < (LDS_BYTES - LDSCTL_OFF) / 4; u += NWAVES * 64) ((LAS unsigned*)(F.lds + LDSCTL_OFF))[u] = 0u;
    __syncthreads();
    XcdBarrier bar; bar.bar = (unsigned*)(F.ctl + CW_BAR); bar.x = 0; bar.st = nullptr;
    if (MK_ONE_LAUNCH) bar = xcd_barrier_post((unsigned*)(F.ctl + CW_BAR), F.MISC + 8);
    const int lo = args.ph_lo, hi = args.ph_hi;
#define IN(k) (lo <= (k) && (k) < hi)
#define SEAM(k) do { if (MK_ONE_LAUNCH && IN((k) + 1)) xcd_barrier(bar); } while (0)
    bf16* XB = (bf16*)(F.ws + WS_XB); bf16* H = (bf16*)(F.ws + WS_H); float* X = (float*)(F.ws + WS_X); float* ssq = (float*)(F.ws + WS_SSQ);
    const int bx = (int)blockIdx.x;

    if (IN(0)) { p0_prologue(F); SEAM(0); }
#define FFN_GU(ph, f, sin) if (IN(ph)) { pg8::Gemm g{XB, (const bf16*)(F.ws + WS_WGU) + (size_t)(f) * 2 * FF * D, M, 2 * FF, D}; pg8::StaticOrder S; S.init(M, 2 * FF, F.G, bx); \
        pg8::EpiGateUp E{H, FF, ssq + (size_t)(sin) * M}; pg8::gemm_phase<pg8::EpiGateUp, pg8::StaticOrder, true, true>(F.lds + RING_OFF, g, S, E); SEAM(ph); }
#define FFN_DN(ph, f, sout) if (IN(ph)) { pg8::Gemm g{H, (const bf16*)(F.ws + WS_WD) + (size_t)(f) * D * FF, M, D, FF}; pg8::StaticOrder S; S.init(M, D, F.G, bx); \
        pg8::EpiResid<0> E{X, XB, ssq + (size_t)(sout) * M, 0.5f}; pg8::gemm_phase<pg8::EpiResid<0>, pg8::StaticOrder, true, true>(F.lds + RING_OFF, g, S, E); SEAM(ph); }
    FFN_GU(1, 0, 0)
    FFN_DN(2, 0, 1)
    if (IN(3)) { ssm_phase(F); SEAM(3); }
    if (IN(4)) { pg8::Gemm g{(const bf16*)(F.ws + WS_G), (const bf16*)(F.ws + WS_WGLU), M, 2 * D, D}; pg8::StaticOrder S; S.init(M, 2 * D, F.G, bx);
        pg8::EpiResid<1> E{X, XB, ssq + (size_t)2 * M, 1.0f}; pg8::gemm_phase<pg8::EpiResid<1>, pg8::StaticOrder, true, true>(F.lds + RING_OFF, g, S, E); SEAM(4); }
    FFN_GU(5, 1, 2)
    FFN_DN(6, 1, 3)
    FFN_GU(7, 2, 3)
    FFN_DN(8, 2, 4)
    if (IN(9)) { pg8::Gemm g{XB, (const bf16*)(F.ws + WS_WIN), M, 3 * D, D}; pg8::StaticOrder S; S.init(M, 3 * D, F.G, bx);
        pg8::EpiConvIn E{(bf16*)(F.ws + WS_Z), (bf16*)(F.ws + WS_GB), ssq + (size_t)4 * M, F.out + O_CP, F.out + O_CS};
        pg8::gemm_phase<pg8::EpiConvIn, pg8::StaticOrder, true, true>(F.lds + RING_OFF, g, S, E); SEAM(9); }
    if (IN(10)) { conv_phase(F); SEAM(10); }
    if (IN(11)) { pg8::Gemm g{(const bf16*)(F.ws + WS_A2), (const bf16*)(F.ws + WS_WOUT), M, D, D}; pg8::StaticOrder S; S.init(M, D, F.G, bx);
        pg8::EpiResid<0> E{X, XB, ssq + (size_t)5 * M, 1.0f}; pg8::gemm_phase<pg8::EpiResid<0>, pg8::StaticOrder, true, true>(F.lds + RING_OFF, g, S, E); SEAM(11); }
    FFN_GU(12, 3, 5)
    FFN_DN(13, 3, 6)
    if (IN(14)) { final_phase(F); }
#undef IN
#undef SEAM
}

extern "C" void kernel_launch(void* const* d_in, const int* in_sizes, int n_in, void* d_out, int out_size, void* d_ws, size_t ws_size, hipStream_t stream) {
    static int grid = 0;
    if (grid == 0) {
        if (n_in != 21 || out_size != (int)O_END || ws_size < WS_END) { fprintf(stderr, "kernel_launch: unexpected shapes: n_in %d out %d ws %zu; nothing launched\n", n_in, out_size, ws_size); grid = -1; return; }
        int dev = 0, cus = 0, per_cu = 0;
        if (hipGetDevice(&dev) != hipSuccess || hipDeviceGetAttribute(&cus, hipDeviceAttributeMultiprocessorCount, dev) != hipSuccess) { grid = -1; return; }
        if (hipFuncSetAttribute((const void*)skel_fwd, hipFuncAttributeMaxDynamicSharedMemorySize, LDS_BYTES) != hipSuccess) { fprintf(stderr, "kernel_launch: hipFuncSetAttribute failed\n"); grid = -1; return; }
        if (hipOccupancyMaxActiveBlocksPerMultiprocessor(&per_cu, (const void*)skel_fwd, NWAVES * 64, LDS_BYTES) != hipSuccess || per_cu < 1) fprintf(stderr, "kernel_launch: occupancy query reports %d\n", per_cu);
        (void)hipGetLastError();
        grid = cus;
    }
    if (grid < 0) return;
    if (hipMemsetAsync((char*)d_ws + WS_CTL, 0, CTL_ZERO_BYTES, stream) != hipSuccess) return;
    Args a{};
    for (int i = 0; i < 21; ++i) a.in[i] = (const float*)d_in[i];
    a.out = (float*)d_out; a.ws = (unsigned char*)d_ws;
#if MK_ONE_LAUNCH
    a.ph_lo = 0; a.ph_hi = N_PHASES;
    hipLaunchKernelGGL(skel_fwd, dim3(grid), dim3(NWAVES * 64), LDS_BYTES, stream, a);
#else
    for (int p = 0; p < N_PHASES; ++p) { a.ph_lo = p; a.ph_hi = p + 1; hipLaunchKernelGGL(skel_fwd, dim3(grid), dim3(NWAVES * 64), LDS_BYTES, stream, a); }
#endif
}
```

```cpp
#include <hip/hip_runtime.h>
#include <cstdio>
#include <cstdint>
namespace pg8 {
#define PG8_LAS __attribute__((address_space(3)))
typedef unsigned short bf16_t;
typedef short bf16x8 __attribute__((ext_vector_type(8)));
typedef float f32x4 __attribute__((ext_vector_type(4)));
typedef unsigned u32x4 __attribute__((ext_vector_type(4)));
constexpr int BM = 256, BK = 64, HALF = 128, HTB = HALF * BK * 2  , STAGE_BYTES = 8 * HTB, NXCD = 8, WGM = 8;

__host__ __device__ __forceinline__ int lds_byte(int r, int c) { const int st = (r >> 4) * 2 + (c >> 5), rr = r & 15, cc = c & 31, ob = rr * 64 + cc * 2; return st * 1024 + (ob ^ (((ob >> 9) & 1) << 5)); }
__host__ __device__ __forceinline__ void stage_rc(int b, int& R, int& C) { const int st = b / 1024, sb = b % 1024, swz = sb ^ (((sb >> 9) & 1) << 5); R = (st >> 1) * 16 + swz / 64; C = (st & 1) * 32 + (swz % 64) / 2; }
__host__ __device__ __forceinline__ int perm32(int rho) { const int n = rho >> 4, i = rho & 15; return 8 * (i >> 2) + 4 * n + (i & 3); }

struct Unit { int pm, pn; };
struct Gemm { const bf16_t* A; const bf16_t* Bt; int M, N, K; };

struct StaticOrder {
    int nM, nN, nwg, G, c;
    __host__ __device__ void init(int M, int N, int G_, int c_) { nM = M / BM; nN = N / BM; nwg = nM * nN; G = G_; c = c_; }
    __host__ __device__ bool next(int i, Unit& u) const {
        const long L = (long)i * G + c; if (L >= nwg) return false;
        int wgid = (int)L; { const int q = nwg / NXCD, r = nwg % NXCD, xcd = wgid % NXCD, off = wgid / NXCD; wgid = (xcd < r ? xcd * (q + 1) : r * (q + 1) + (xcd - r) * q) + off; }
        const int nig = WGM * nN, gid = wgid / nig, fm = gid * WGM, gsz = (nM - fm) < WGM ? (nM - fm) : WGM;
        u.pm = fm + ((wgid % nig) % gsz); u.pn = (wgid % nig) / gsz; return true;
    }
    __device__ __forceinline__ void a_ready(const Unit&) const {}
    __device__ __forceinline__ void done(const Unit&) const {}
};


__device__ __forceinline__ unsigned cvt_pk_bf16(float lo, float hi) { unsigned r; asm volatile("v_cvt_pk_bf16_f32 %0, %1, %2" : "=v"(r) : "v"(lo), "v"(hi)); return r; }

constexpr float RMS_EPS = 1e-6f;
constexpr float INV_D = 1.0f / 1024.0f;
__device__ __forceinline__ float sigmoid_f(float x) { return __builtin_amdgcn_rcpf(1.0f + __builtin_amdgcn_exp2f(-1.4426950408889634f * x)); }
__device__ __forceinline__ float rstd_of(float ssq) { return __builtin_amdgcn_rsqf(ssq * INV_D + RMS_EPS); }

struct EpiGateUp {
    static constexpr bool PERM = true, AFTER_DRAIN = false;
    bf16_t* H; int ldh; const float* ssq;
    __device__ __forceinline__ void operator()(const f32x4 (&acc)[2][2][4][2], const Unit& u, int wr, int wc, int fr, int fq) const {
        const int row0 = u.pm * BM + wr * 64 + fr, col0 = u.pn * HALF + wc * 32 + 8 * fq;
#pragma unroll
        for (int ai = 0; ai < 2; ++ai)
#pragma unroll
            for (int m = 0; m < 4; ++m) { const int row = row0 + ai * HALF + m * 16; const float rs = rstd_of(ssq[row]);
                float h[8];
#pragma unroll
                for (int n = 0; n < 2; ++n)
#pragma unroll
                    for (int e = 0; e < 4; ++e) { const float g = acc[ai][0][m][n][e] * rs, up = acc[ai][1][m][n][e] * rs; h[4 * n + e] = g * sigmoid_f(g) * up; }
                u32x4 w; w.x = cvt_pk_bf16(h[0], h[1]); w.y = cvt_pk_bf16(h[2], h[3]); w.z = cvt_pk_bf16(h[4], h[5]); w.w = cvt_pk_bf16(h[6], h[7]);
                *(u32x4*)(H + (size_t)row * ldh + col0) = w; }
    }
};

template <int MODE> struct EpiResid {
    static constexpr bool PERM = true, AFTER_DRAIN = false;
    float* X; bf16_t* XB; float* ssq; float scale;
    __device__ __forceinline__ void operator()(const f32x4 (&acc)[2][2][4][2], const Unit& u, int wr, int wc, int fr, int fq) const {
        const int row0 = u.pm * BM + wr * 64 + fr;
        const int col0 = (MODE == 0 ? u.pn * BM : u.pn * HALF) + wc * 32 + 8 * fq;
#pragma unroll
        for (int ai = 0; ai < 2; ++ai)
#pragma unroll
            for (int m = 0; m < 4; ++m) { const int row = row0 + ai * HALF + m * 16; float sq = 0.f;
#pragma unroll
                for (int bj = 0; bj < (MODE == 0 ? 2 : 1); ++bj) {
                    float* xp = X + (size_t)row * 1024 + col0 + bj * HALF;
                    f32x4 x0 = *(const f32x4*)xp, x1 = *(const f32x4*)(xp + 4);
                    if (MODE == 0) { x0 += acc[ai][bj][m][0] * scale; x1 += acc[ai][bj][m][1] * scale; }
                    else {
#pragma unroll
                        for (int e = 0; e < 4; ++e) { x0[e] += acc[ai][0][m][0][e] * sigmoid_f(acc[ai][1][m][0][e]); x1[e] += acc[ai][0][m][1][e] * sigmoid_f(acc[ai][1][m][1][e]); } }
                    *(f32x4*)xp = x0; *(f32x4*)(xp + 4) = x1;
                    u32x4 w; w.x = cvt_pk_bf16(x0[0], x0[1]); w.y = cvt_pk_bf16(x0[2], x0[3]); w.z = cvt_pk_bf16(x1[0], x1[1]); w.w = cvt_pk_bf16(x1[2], x1[3]);
                    *(u32x4*)(XB + (size_t)row * 1024 + col0 + bj * HALF) = w;
                    sq += (x0[0] * x0[0] + x0[1] * x0[1]) + (x0[2] * x0[2] + x0[3] * x0[3]) + (x1[0] * x1[0] + x1[1] * x1[1]) + (x1[2] * x1[2] + x1[3] * x1[3]); }
                sq += __shfl_xor(sq, 16); sq += __shfl_xor(sq, 32);
                if (fq == 0) atomicAdd(ssq + row, sq); }
    }
};

struct EpiConvIn {
    static constexpr bool PERM = true, AFTER_DRAIN = false;
    bf16_t* Z; bf16_t* GB; const float* ssq; float* conv_p; float* conv_s;
    __device__ __forceinline__ void operator()(const f32x4 (&acc)[2][2][4][2], const Unit& u, int wr, int wc, int fr, int fq) const {
        const int row0 = u.pm * BM + wr * 64 + fr;
        if (u.pn < 8) {
            const int col0 = u.pn * HALF + wc * 32 + 8 * fq;
#pragma unroll
            for (int ai = 0; ai < 2; ++ai)
#pragma unroll
                for (int m = 0; m < 4; ++m) { const int row = row0 + ai * HALF + m * 16; const float rs = rstd_of(ssq[row]), rs2 = rs * rs;
                    const f32x4 z0 = acc[ai][0][m][0] * acc[ai][1][m][0] * rs2, z1 = acc[ai][0][m][1] * acc[ai][1][m][1] * rs2;
                    u32x4 w; w.x = cvt_pk_bf16(z0[0], z0[1]); w.y = cvt_pk_bf16(z0[2], z0[3]); w.z = cvt_pk_bf16(z1[0], z1[1]); w.w = cvt_pk_bf16(z1[2], z1[3]);
                    *(u32x4*)(Z + (size_t)row * 1024 + col0) = w;
                    float* cp = nullptr;
                    if (row < 16384) { const int t = row & 2047; if (t >= 2046) cp = conv_p + ((size_t)(row >> 11) * 2 + (t - 2046)) * 1024 + col0; }
                    else { const int r2 = row - 16384, t = r2 & 7; if (t >= 6) cp = conv_s + ((size_t)(r2 >> 3) * 2 + (t - 6)) * 1024 + col0; }
                    if (cp) { *(f32x4*)cp = z0; *(f32x4*)(cp + 4) = z1; } }
        } else {
            const int col0 = (u.pn - 8) * BM + wc * 32 + 8 * fq;
#pragma unroll
            for (int ai = 0; ai < 2; ++ai)
#pragma unroll
                for (int m = 0; m < 4; ++m) { const int row = row0 + ai * HALF + m * 16; const float rs = rstd_of(ssq[row]);
#pragma unroll
                    for (int bj = 0; bj < 2; ++bj) { const f32x4 g0 = acc[ai][bj][m][0] * rs, g1 = acc[ai][bj][m][1] * rs;
                        u32x4 w; w.x = cvt_pk_bf16(g0[0], g0[1]); w.y = cvt_pk_bf16(g0[2], g0[3]); w.z = cvt_pk_bf16(g1[0], g1[1]); w.w = cvt_pk_bf16(g1[2], g1[3]);
                        *(u32x4*)(GB + (size_t)row * 1024 + col0 + bj * HALF) = w; } }
        }
    }
};

template <class Epi, class Sched, bool ALIGN_EPI = false, bool SP2 = false>
__device__ __forceinline__ void gemm_phase(PG8_LAS unsigned char* lds, const Gemm g, const Sched& S, const Epi& E) {
    const int tid = threadIdx.x, wid = __builtin_amdgcn_readfirstlane(tid >> 6), lane = tid & 63, wr = wid >> 2, wc = wid & 3, fr = lane & 15, fq = lane >> 4;
    const int K = g.K, nt = K / BK;
    unsigned voffA[2], voffB[2];
#pragma unroll
    for (int i = 0; i < 2; ++i) { int R, C; stage_rc(tid * 16 + i * 8192, R, C); const int Rb = Epi::PERM ? ((R & ~31) + perm32(R & 31)) : R;
        voffA[i] = (unsigned)(R * K + C) * 2u; voffB[i] = (unsigned)(Rb * K + C) * 2u; }
    const size_t kstep = (size_t)(BK * 2);
    const size_t hstep = (size_t)HALF * K * 2;
    const size_t tstep = 2 * hstep;
    const unsigned ldsw = (unsigned)wid * 1024u;
    const int aoff = lds_byte(wr * 64 + fr, fq * 8), boff = lds_byte(wc * 32 + fr, fq * 8);
#define PG8_SA(b, h) (((b) * 2 + (h)) * HTB)
#define PG8_SB(b, h) ((4 + (b) * 2 + (h)) * HTB)
#define PG8_STAGE(bufoff, gbase, voff) do { _Pragma("unroll") for (int _i = 0; _i < 2; ++_i) \
        __builtin_amdgcn_global_load_lds((const unsigned*)((const char*)(gbase) + (voff)[_i]), (PG8_LAS unsigned*)(lds + (bufoff) + ldsw + _i * 8192), 16, 0, 0); } while (0)
#define PG8_LDA(dst, b, h) do { _Pragma("unroll") for (int m = 0; m < 4; ++m) _Pragma("unroll") for (int k = 0; k < 2; ++k) dst[m][k] = *(const PG8_LAS bf16x8*)(lds + PG8_SA(b, h) + aoff + m * 2048 + k * 1024); } while (0)
#define PG8_LDB(dst, b, h) do { _Pragma("unroll") for (int n = 0; n < 2; ++n) _Pragma("unroll") for (int k = 0; k < 2; ++k) dst[n][k] = *(const PG8_LAS bf16x8*)(lds + PG8_SB(b, h) + boff + n * 2048 + k * 1024); } while (0)
#define PG8_MMA(ai, bj, At, Bt) do { __builtin_amdgcn_s_setprio(1); _Pragma("unroll") for (int m = 0; m < 4; ++m) _Pragma("unroll") for (int n = 0; n < 2; ++n) _Pragma("unroll") for (int k = 0; k < 2; ++k) \
        acc[ai][bj][m][n] = __builtin_amdgcn_mfma_f32_16x16x32_bf16(Bt[n][k], At[m][k], acc[ai][bj][m][n], 0, 0, 0); __builtin_amdgcn_s_setprio(0); } while (0)
#define PG8_WAIT_V(n) asm volatile("s_waitcnt vmcnt(" #n ")" ::: "memory")
#define PG8_WAIT_L(n) asm volatile("s_waitcnt lgkmcnt(" #n ")" ::: "memory")
#define PG8_BAR __builtin_amdgcn_s_barrier()
#define PG8_SCHED __builtin_amdgcn_sched_barrier(0)
    Unit cur, nxt; int ui = 0;
    if (!S.next(0, cur)) return;
    f32x4 acc[2][2][4][2];
#pragma unroll
    for (int a = 0; a < 2; ++a)
#pragma unroll
        for (int b = 0; b < 2; ++b)
#pragma unroll
            for (int m = 0; m < 4; ++m)
#pragma unroll
                for (int n = 0; n < 2; ++n) acc[a][b][m][n] = (f32x4){0.f, 0.f, 0.f, 0.f};
    bf16x8 At[4][2], B0[2][2], B1[2][2];
    const char* cA = (const char*)g.A + (size_t)cur.pm * tstep; const char* cB = (const char*)g.Bt + (size_t)cur.pn * tstep;
    S.a_ready(cur);
    if constexpr (SP2) {
        PG8_STAGE(PG8_SB(0, 0), cB, voffB); PG8_STAGE(PG8_SB(0, 1), cB + hstep, voffB); PG8_STAGE(PG8_SA(0, 0), cA, voffA); PG8_STAGE(PG8_SA(0, 1), cA + hstep, voffA);
        if (wr == 1) PG8_BAR;
        PG8_WAIT_V(2); PG8_BAR;
        PG8_STAGE(PG8_SB(1, 0), cB + kstep, voffB); PG8_STAGE(PG8_SA(1, 0), cA + kstep, voffA); PG8_STAGE(PG8_SB(1, 1), cB + hstep + kstep, voffB);
        PG8_WAIT_V(6); PG8_BAR;
    } else {
        PG8_STAGE(PG8_SB(0, 0), cB, voffB); PG8_STAGE(PG8_SA(0, 0), cA, voffA); PG8_STAGE(PG8_SB(0, 1), cB + hstep, voffB); PG8_STAGE(PG8_SA(0, 1), cA + hstep, voffA);
        if (wr == 1) PG8_BAR;
        PG8_WAIT_V(4); PG8_BAR;
        PG8_STAGE(PG8_SB(1, 0), cB + kstep, voffB); PG8_STAGE(PG8_SA(1, 0), cA + kstep, voffA); PG8_STAGE(PG8_SB(1, 1), cB + hstep + kstep, voffB);
        PG8_WAIT_V(6); PG8_BAR;
    }
    for (;;) {
        const bool has_next = S.next(ui + 1, nxt);
        const char* nA = has_next ? (const char*)g.A + (size_t)nxt.pm * tstep : cA; const char* nB = has_next ? (const char*)g.Bt + (size_t)nxt.pn * tstep : cB;
        for (int t = 0; t < nt; t += 2) {
            const bool last = (t == nt - 2);
            const char* a1 = cA + (size_t)(t + 1) * kstep;
            const char* a2 = last ? nA : cA + (size_t)(t + 2) * kstep; const char* b2 = last ? nB : cB + (size_t)(t + 2) * kstep;
            const char* a3 = a2 + kstep; const char* b3 = b2 + kstep;
            if (last && has_next) S.a_ready(nxt);
            if constexpr (SP2) {
            PG8_LDB(B0, 0, 0); PG8_LDB(B1, 0, 1); PG8_SCHED; PG8_LDA(At, 0, 0); PG8_STAGE(PG8_SA(1, 1), a1 + hstep, voffA);
            PG8_WAIT_V(8); PG8_WAIT_L(0); PG8_BAR; PG8_MMA(0, 0, At, B0); PG8_MMA(0, 1, At, B1); PG8_BAR; PG8_SCHED;
            PG8_LDA(At, 0, 1); PG8_STAGE(PG8_SB(0, 0), b2, voffB); PG8_STAGE(PG8_SB(0, 1), b2 + hstep, voffB); PG8_STAGE(PG8_SA(0, 0), a2, voffA);
            PG8_WAIT_V(8); PG8_WAIT_L(0); PG8_BAR; PG8_MMA(1, 0, At, B0); PG8_MMA(1, 1, At, B1); PG8_BAR; PG8_SCHED;
            PG8_LDB(B0, 1, 0); PG8_LDB(B1, 1, 1); PG8_SCHED; PG8_LDA(At, 1, 0); PG8_STAGE(PG8_SA(0, 1), a2 + hstep, voffA);
            PG8_WAIT_V(8); PG8_WAIT_L(0); PG8_BAR; PG8_MMA(0, 0, At, B0); PG8_MMA(0, 1, At, B1); PG8_BAR; PG8_SCHED;
            PG8_LDA(At, 1, 1); PG8_STAGE(PG8_SB(1, 0), b3, voffB); PG8_STAGE(PG8_SB(1, 1), b3 + hstep, voffB); PG8_STAGE(PG8_SA(1, 0), a3, voffA);
            PG8_WAIT_V(8); PG8_WAIT_L(0); PG8_BAR; PG8_MMA(1, 0, At, B0); PG8_MMA(1, 1, At, B1); PG8_BAR; PG8_SCHED;
            } else {
            PG8_LDB(B0, 0, 0); PG8_SCHED; PG8_LDA(At, 0, 0); PG8_STAGE(PG8_SA(1, 1), a1 + hstep, voffA);
            PG8_WAIT_L(8); PG8_BAR; PG8_WAIT_L(0); PG8_MMA(0, 0, At, B0); PG8_BAR; PG8_SCHED;
            PG8_LDB(B1, 0, 1); PG8_STAGE(PG8_SB(0, 0), b2, voffB);
            PG8_BAR; PG8_WAIT_L(0); PG8_MMA(0, 1, At, B1); PG8_BAR;
            PG8_LDA(At, 0, 1); PG8_STAGE(PG8_SA(0, 0), a2, voffA);
            PG8_BAR; PG8_WAIT_L(0); PG8_MMA(1, 0, At, B0); PG8_BAR; PG8_SCHED;
            PG8_STAGE(PG8_SB(0, 1), b2 + hstep, voffB);
            PG8_WAIT_V(6); PG8_BAR; PG8_MMA(1, 1, At, B1); PG8_BAR;
            PG8_LDB(B0, 1, 0); PG8_SCHED; PG8_LDA(At, 1, 0); PG8_STAGE(PG8_SA(0, 1), a2 + hstep, voffA);
            PG8_WAIT_L(8); PG8_BAR; PG8_WAIT_L(0); PG8_MMA(0, 0, At, B0); PG8_BAR; PG8_SCHED;
            PG8_LDB(B1, 1, 1); PG8_STAGE(PG8_SB(1, 0), b3, voffB);
            PG8_BAR; PG8_WAIT_L(0); PG8_MMA(0, 1, At, B1); PG8_BAR;
            PG8_LDA(At, 1, 1); PG8_STAGE(PG8_SA(1, 0), a3, voffA);
            PG8_BAR; PG8_WAIT_L(0); PG8_MMA(1, 0, At, B0); PG8_BAR; PG8_SCHED;
            PG8_STAGE(PG8_SB(1, 1), b3 + hstep, voffB);
            PG8_WAIT_V(6); PG8_BAR; PG8_MMA(1, 1, At, B1); PG8_BAR;
            }
        }
        if constexpr (ALIGN_EPI) { if (wr == 0) PG8_BAR; }
        if constexpr (!Epi::AFTER_DRAIN) { E(acc, cur, wr, wc, fr, fq); S.done(cur); }
        if (!has_next) break;
#pragma unroll
        for (int a = 0; a < 2; ++a)
#pragma unroll
            for (int b = 0; b < 2; ++b)
#pragma unroll
                for (int m = 0; m < 4; ++m)
#pragma unroll
                    for (int n = 0; n < 2; ++n) acc[a][b][m][n] = (f32x4){0.f, 0.f, 0.f, 0.f};
        cur = nxt; cA = nA; cB = nB; ++ui;
        if constexpr (ALIGN_EPI) { if (wr == 1) PG8_BAR; }
    }
    PG8_WAIT_V(0);
    if constexpr (!ALIGN_EPI) { if (wr == 0) PG8_BAR; }
    PG8_BAR;
    if constexpr (Epi::AFTER_DRAIN) { E.fused(acc, cur, wr, wc, fr, fq, lds, wid, lane); S.done(cur); }
#undef PG8_SA
#undef PG8_SB
#undef PG8_STAGE
#undef PG8_LDA
#undef PG8_LDB
#undef PG8_MMA
#undef PG8_WAIT_V
#undef PG8_WAIT_L
#undef PG8_BAR
#undef PG8_SCHED
}
}

#define GAS __attribute__((address_space(1)))
#define LAS __attribute__((address_space(3)))
typedef unsigned short bf16;
typedef unsigned v4u __attribute__((ext_vector_type(4)));
typedef float f32x4 __attribute__((ext_vector_type(4)));
typedef short bf16x8 __attribute__((ext_vector_type(8)));
typedef GAS unsigned gu32;
typedef GAS unsigned long long gu64;
#define RLX_AGENT __ATOMIC_RELAXED, __HIP_MEMORY_SCOPE_AGENT
#define LDS_WAIT() asm volatile("s_waitcnt lgkmcnt(0)" ::: "memory")
#define VM_WAIT() asm volatile("s_waitcnt vmcnt(0)" ::: "memory")
__device__ __forceinline__ unsigned long long rt() { return __builtin_amdgcn_s_memrealtime(); }
__device__ __forceinline__ unsigned f2bf(float f) { unsigned u = __builtin_bit_cast(unsigned, f); return (u + 0x7fffu + ((u >> 16) & 1u)) >> 16; }
__device__ __forceinline__ unsigned pk2(float lo, float hi) { return f2bf(lo) | (f2bf(hi) << 16); }

#define XB_TMO      128
#define XB_XCNT(j)  (256  + 64 * (j))
#define XB_XSUB(j)  (1280 + 64 * (j))
#define XB_XGEN(j)  (2304 + 64 * (j))
#define XB_TOP      3328
#define XB_TOPGEN   3392
#define XCD_BAR_WORDS 3456
#define XB_SPIN_CAP (1u << 18)

__device__ __forceinline__ unsigned xb_ld(unsigned* p)              { return __hip_atomic_load(p, __ATOMIC_RELAXED, __HIP_MEMORY_SCOPE_AGENT); }
__device__ __forceinline__ unsigned xb_add(unsigned* p, unsigned v) { return __hip_atomic_fetch_add(p, v, __ATOMIC_RELAXED, __HIP_MEMORY_SCOPE_AGENT); }
__device__ __forceinline__ unsigned xb_xcc_id() { return (unsigned)__builtin_amdgcn_s_getreg((3 << 11) | 20) & 0xFu; }
#define XB_SPIN(cond, bar) do { unsigned _sp = 0; while (cond) { __builtin_amdgcn_s_sleep(1); \
    if ((++_sp & 255u) == 0u) { if (xb_ld(&(bar)[XB_TMO])) break; if (_sp > XB_SPIN_CAP) { atomicAdd(&(bar)[XB_TMO], 1u); break; } } } } while (0)

struct XcdBarrier {
    unsigned* bar; unsigned x;
    volatile LAS unsigned* st;
};

__device__ __forceinline__ XcdBarrier xcd_barrier_post(unsigned* bar, volatile LAS unsigned* st) {
    XcdBarrier b; b.bar = bar; b.x = xb_xcc_id(); b.st = st;
    if (threadIdx.x == 0) (void)xb_add(&bar[XB_XCNT(b.x)], 1u);
    return b;
}
__device__ __forceinline__ void xcd_barrier_complete(unsigned* bar, unsigned x, unsigned& nloc, unsigned& nx) {
    const unsigned G = gridDim.x * gridDim.y * gridDim.z;
    unsigned sum, cnt, mine, sp = 0u;
    for (;;) {
        sum = 0u; cnt = 0u; mine = 0u;
#pragma unroll
        for (unsigned j = 0; j < 16; ++j) { const unsigned c = xb_ld(&bar[XB_XCNT(j)]); sum += c; cnt += (c > 0u) ? 1u : 0u; mine = (j == x) ? c : mine; }
        if (sum == G) break;
        __builtin_amdgcn_s_sleep(1);
        if ((++sp & 255u) == 0u) { if (xb_ld(&bar[XB_TMO])) break; if (sp > XB_SPIN_CAP) { atomicAdd(&bar[XB_TMO], 1u); break; } }
    }
    nloc = mine > 0u ? mine : 1u; nx = cnt > 0u ? cnt : 1u;
}

__device__ __forceinline__ void xcd_barrier(const XcdBarrier& b) {
    asm volatile("s_waitcnt vmcnt(0)" ::: "memory");
    __syncthreads();
    if (threadIdx.x == 0) {
        unsigned* bar = b.bar;
        __builtin_amdgcn_s_waitcnt(0);
        unsigned nloc = b.st[0], nx = b.st[1];
        if (nloc == 0u) { xcd_barrier_complete(bar, b.x, nloc, nx); b.st[0] = nloc; b.st[1] = nx; }
        const unsigned old = xb_add(&bar[XB_XSUB(b.x)], 1u);
        const unsigned gen = old / nloc;
        if (old + 1u == (gen + 1u) * nloc) {
            __builtin_amdgcn_fence(__ATOMIC_RELEASE, "agent");
            asm volatile("s_waitcnt vmcnt(0)" ::: "memory");
            const unsigned og = xb_add(&bar[XB_TOP], 1u);
            const unsigned tg = og / nx;
            if (og + 1u == (tg + 1u) * nx) xb_add(&bar[XB_TOPGEN], 1u);
            else XB_SPIN(xb_ld(&bar[XB_TOPGEN]) == tg, bar);
            __builtin_amdgcn_fence(__ATOMIC_ACQUIRE, "agent");
            xb_add(&bar[XB_XGEN(b.x)], 1u);
            asm volatile("s_waitcnt vmcnt(0)" ::: "memory");
        } else {
            XB_SPIN(xb_ld(&bar[XB_XGEN(b.x)]) == gen, bar);
            __builtin_amdgcn_fence(__ATOMIC_ACQUIRE, "agent");
            asm volatile("s_waitcnt vmcnt(0)" ::: "memory");
        }
    }
    __syncthreads();
}


constexpr int NWAVES = 8;
#ifndef MK_ONE_LAUNCH
#define MK_ONE_LAUNCH 1
#endif
constexpr int N_PHASES = 15;

constexpr int D = 1024, FF = 4096, MP = 8 * 2048, MS = 128 * 8, M = MP + MS;
constexpr int NG = 64, PS = 64, GS = 16;
constexpr float EPS = 1e-6f;
constexpr size_t O_Y = 0, O_SRP = (size_t)M * D, O_SIP = O_SRP + 8 * 4096, O_CP = O_SIP + 8 * 4096, O_SRS = O_CP + 8 * 2 * 1024, O_SIS = O_SRS + 128 * 4096, O_CS = O_SIS + 128 * 4096, O_END = O_CS + 128 * 2 * 1024;
static_assert(O_END == 19218432, "output size");

constexpr size_t MiB = 1u << 20;
constexpr size_t WS_CTL = 0, CTL_ZERO_BYTES = 1 * MiB;
constexpr size_t WS_SSQ = 1 * MiB;
constexpr size_t WS_SSMP = 2 * MiB;
constexpr size_t WS_WGU = 4 * MiB;
constexpr size_t WS_WD = 68 * MiB;
constexpr size_t WS_WGLU = 100 * MiB;
constexpr size_t WS_WIN = 104 * MiB;
constexpr size_t WS_WOUT = 110 * MiB;
constexpr size_t WS_X = 112 * MiB;
constexpr size_t WS_XB = 180 * MiB;
constexpr size_t WS_H = 214 * MiB;
constexpr size_t WS_G = WS_H, WS_Z = WS_H, WS_GB = WS_H + 34 * MiB, WS_A2 = WS_H + 68 * MiB;
constexpr size_t WS_END = 350 * MiB;
constexpr int CW_BAR = 4096;

constexpr int RING_OFF = 0, RING_BYTES = 131072;
constexpr int LDSCTL_OFF = RING_BYTES, MISC_OFF = LDSCTL_OFF + 320;
constexpr int LDS_BYTES = 147456;

struct Frame {
    LAS unsigned char* lds;
    volatile LAS unsigned* MISC;
    gu32* ctl;
    int tid, lane, wave, vcu, G;
    const float* in[21]; float* out; unsigned char* ws;
};

__device__ __forceinline__ float wave_sum(float v) {
#pragma unroll
    for (int o = 1; o < 64; o <<= 1) v += __shfl_xor(v, o);
    return v;
}
__device__ __forceinline__ float bf2f(unsigned short b) { return __builtin_bit_cast(float, (unsigned)b << 16); }

__device__ __forceinline__ void p0_transpose_item(const float* W, int K, int N, bf16* WT, const float* gk, int k0, int n0s, int n0d, LAS float* scr, int lane) {
#pragma unroll 8
    for (int i = 0; i < 32; ++i) { const int kk = 2 * i + (lane >> 5); float v = W[(size_t)(k0 + kk) * N + n0s + (lane & 31)]; if (gk) v *= gk[k0 + kk]; scr[kk * 33 + (lane & 31)] = v; }
    LDS_WAIT(); asm volatile("" ::: "memory");
    const int c = lane & 7;
#pragma unroll
    for (int j = 0; j < 4; ++j) { const int n = (lane >> 3) + 8 * j; const LAS float* s = scr + (8 * c) * 33 + n;
        v4u o; o.x = pk2(s[0 * 33], s[1 * 33]); o.y = pk2(s[2 * 33], s[3 * 33]); o.z = pk2(s[4 * 33], s[5 * 33]); o.w = pk2(s[6 * 33], s[7 * 33]);
        *(GAS v4u*)(WT + (size_t)(n0d + n) * K + k0 + 8 * c) = o; }
    LDS_WAIT(); asm volatile("" ::: "memory");
}
__device__ __forceinline__ int pair_src(int nd, int base, int hstride) { return base + ((nd >> 7) & 1) * hstride + 128 * (nd >> 8) + (nd & 127); }

__device__ __forceinline__ void p0_prologue(Frame& F) {
    LAS float* scr = (LAS float*)(F.lds + RING_OFF + F.wave * 16384);
    const int gw = F.vcu * NWAVES + F.wave, NGW = F.G * NWAVES, lane = F.lane;
    const float* norm_g = F.in[5];
    constexpr int I_GU = (D / 64) * (2 * FF / 32), I_D = (FF / 64) * (D / 32), I_GLU = (D / 64) * (2 * D / 32), I_IN = (D / 64) * (3 * D / 32), I_OUT = (D / 64) * (D / 32);
    constexpr int NITEMS = 4 * I_GU + 4 * I_D + I_GLU + I_IN + I_OUT;
    for (int it = gw; it < NITEMS; it += NGW) {
        int r = it;
        if (r < 4 * I_GU) { const int f = r / I_GU; r -= f * I_GU; const int nb = r % (2 * FF / 32), kb = r / (2 * FF / 32), nd = 32 * nb;
            const float* gk = norm_g + ((f >> 1) * 3 + (f & 1) * 2) * D;
            p0_transpose_item(F.in[7] + (size_t)f * D * 2 * FF, D, 2 * FF, (bf16*)(F.ws + WS_WGU) + (size_t)f * 2 * FF * D, gk, 64 * kb, pair_src(nd, 0, FF), nd, scr, lane); continue; }
        r -= 4 * I_GU;
        if (r < 4 * I_D) { const int f = r / I_D; r -= f * I_D; const int nb = r % (D / 32), kb = r / (D / 32), nd = 32 * nb;
            p0_transpose_item(F.in[8] + (size_t)f * FF * D, FF, D, (bf16*)(F.ws + WS_WD) + (size_t)f * D * FF, nullptr, 64 * kb, nd, nd, scr, lane); continue; }
        r -= 4 * I_D;
        if (r < I_GLU) { const int nb = r % (2 * D / 32), kb = r / (2 * D / 32), nd = 32 * nb;
            p0_transpose_item(F.in[17], D, 2 * D, (bf16*)(F.ws + WS_WGLU), nullptr, 64 * kb, pair_src(nd, 0, D), nd, scr, lane); continue; }
        r -= I_GLU;
        if (r < I_IN) { const int nb = r % (3 * D / 32), kb = r / (3 * D / 32), nd = 32 * nb;
            const int ns = nd < 2048 ? pair_src(nd, D, D) : nd - 2048;
            p0_transpose_item(F.in[18], D, 3 * D, (bf16*)(F.ws + WS_WIN), norm_g + 4 * D, 64 * kb, ns, nd, scr, lane); continue; }
        r -= I_IN;
        { const int nb = r % (D / 32), kb = r / (D / 32), nd = 32 * nb;
            p0_transpose_item(F.in[20], D, D, (bf16*)(F.ws + WS_WOUT), nullptr, 64 * kb, nd, nd, scr, lane); }
    }
    float* X = (float*)(F.ws + WS_X); bf16* XB = (bf16*)(F.ws + WS_XB); float* ssq = (float*)(F.ws + WS_SSQ);
    for (int m = gw; m < M; m += NGW) {
        const float* src = m < MP ? F.in[0] + (size_t)m * D : F.in[1] + (size_t)(m - MP) * D;
        const GAS f32x4* xr = (const GAS f32x4*)src + lane; GAS f32x4* xo = (GAS f32x4*)(X + (size_t)m * D) + lane;
        GAS unsigned long long* o8 = (GAS unsigned long long*)(XB + (size_t)m * D) + lane;
        float s = 0.f;
#pragma unroll
        for (int j = 0; j < 4; ++j) { const f32x4 v = xr[64 * j]; s += (v.x * v.x + v.y * v.y) + (v.z * v.z + v.w * v.w); xo[64 * j] = v;
            o8[64 * j] = (unsigned long long)pk2(v.x, v.y) | ((unsigned long long)pk2(v.z, v.w) << 32); }
        s = wave_sum(s);
        if (lane == 0) ssq[m] = s;
    }
    for (int i = gw * 64 + lane; i < 7 * M; i += NGW * 64) ssq[M + i] = 0.f;
    float* sp = (float*)(F.ws + WS_SSMP);
    for (int i = gw * 64 + lane; i < NG * PS; i += NGW * 64) {
        const int g = i / PS;
        const float lr = F.in[9][i], li = F.in[10][i], dt = expf(F.in[11][g]);
        const float mag = expf(lr * dt); float sn, cs; sincosf(li * dt, &sn, &cs);
        const float lbr = mag * cs, lbi = mag * sn, den = lr * lr + li * li, nr = lbr - 1.0f, ni = lbi;
        const float fr = (nr * lr + ni * li) / den, fi = (ni * lr - nr * li) / den;
        sp[i] = lbr; sp[4096 + i] = lbi;
#pragma unroll
        for (int c = 0; c < GS; ++c) { const float br = F.in[12][(size_t)i * GS + c], bi = F.in[13][(size_t)i * GS + c];
            sp[8192 + (size_t)i * GS + c] = fr * br - fi * bi; sp[8192 + 65536 + (size_t)i * GS + c] = fr * bi + fi * br; }
    }
}

__device__ __forceinline__ float gelu_tanh(float x) {
    const float a = 0.7978845608028654f * (x + 0.044715f * x * x * x);
    return x * __builtin_amdgcn_rcpf(1.0f + __builtin_amdgcn_exp2f(-2.0f * 1.4426950408889634f * a));
}

__device__ __forceinline__ void ssm_phase(Frame& F) {
    constexpr int TB = 8;
    LAS float* wl = (LAS float*)(F.lds + RING_OFF + F.wave * 16384);
    LAS float* hsr = wl; LAS float* hsi = wl + TB * 65; LAS float* cre = wl + 2 * TB * 65; LAS float* cim = cre + 16 * 65;
    const int gw = F.vcu * NWAVES + F.wave, NGW = F.G * NWAVES, lane = F.lane;
    const float* X = (const float*)(F.ws + WS_X); const float* ssq = (const float*)(F.ws + WS_SSQ) + 1 * M;
    const float* sp = (const float*)(F.ws + WS_SSMP); bf16* Gb = (bf16*)(F.ws + WS_G);
    const float* g1 = F.in[5] + 1 * D; const float* dsk = F.in[16];
    constexpr int NITEM = 8 * NG + 128 * NG;
    for (int it = gw; it < NITEM; it += NGW) {
        int seq, g, L, row0; const float *s0r = nullptr, *s0i = nullptr; float *outr, *outi;
        if (it < 8 * NG) { seq = it / NG; g = it % NG; L = 2048; row0 = seq * 2048; outr = F.out + O_SRP + (size_t)(seq * NG + g) * PS; outi = F.out + O_SIP + (size_t)(seq * NG + g) * PS; }
        else { const int j = it - 8 * NG; seq = j / NG; g = j % NG; L = 8; row0 = MP + seq * 8; s0r = F.in[2] + (size_t)(seq * NG + g) * PS; s0i = F.in[3] + (size_t)(seq * NG + g) * PS;
               outr = F.out + O_SRS + (size_t)(seq * NG + g) * PS; outi = F.out + O_SIS + (size_t)(seq * NG + g) * PS; }
        const int gp = g * PS + lane;
        const float lbr = sp[gp], lbi = sp[4096 + gp];
        float bbr[GS], bbi[GS];
#pragma unroll
        for (int c = 0; c < GS; ++c) { bbr[c] = sp[8192 + (size_t)gp * GS + c]; bbi[c] = sp[8192 + 65536 + (size_t)gp * GS + c]; }
#pragma unroll
        for (int c = 0; c < GS; ++c) { cre[c * 65 + lane] = F.in[14][((size_t)g * GS + c) * PS + lane]; cim[c * 65 + lane] = F.in[15][((size_t)g * GS + c) * PS + lane]; }
        float gn[GS];
#pragma unroll
        for (int c = 0; c < GS; ++c) gn[c] = g1[g * GS + c];
        float hr = s0r ? s0r[lane] : 0.f, hi = s0i ? s0i[lane] : 0.f;
        const int oc = lane & 15, otq = lane >> 4;
        const float dc = dsk[g * GS + oc], gc = g1[g * GS + oc];
        for (int t0 = 0; t0 < L; t0 += TB) {
#pragma unroll
            for (int tl = 0; tl < TB; ++tl) { const int row = row0 + t0 + tl; const float rs = __builtin_amdgcn_rsqf(ssq[row] * (1.0f / D) + EPS);
                const float* xr = X + (size_t)row * D + g * GS; float br = 0.f, bi = 0.f;
#pragma unroll
                for (int c = 0; c < GS; ++c) { const float uu = xr[c] * rs * gn[c]; br += bbr[c] * uu; bi += bbi[c] * uu; }
                const float nr = lbr * hr - lbi * hi + br, ni = lbr * hi + lbi * hr + bi; hr = nr; hi = ni;
                hsr[tl * 65 + lane] = hr; hsi[tl * 65 + lane] = hi; }
            LDS_WAIT(); __builtin_amdgcn_wave_barrier(); asm volatile("" ::: "memory");
#pragma unroll
            for (int j = 0; j < 2; ++j) { const int tl = otq * 2 + j; const int row = row0 + t0 + tl; float y = 0.f;
                for (int p = 0; p < PS; ++p) y += cre[oc * 65 + p] * hsr[tl * 65 + p] - cim[oc * 65 + p] * hsi[tl * 65 + p];
                const float rs = __builtin_amdgcn_rsqf(ssq[row] * (1.0f / D) + EPS);
                const float uu = X[(size_t)row * D + g * GS + oc] * rs * gc;
                y += dc * uu;
                Gb[(size_t)row * D + g * GS + oc] = (bf16)f2bf(gelu_tanh(y)); }
            LDS_WAIT(); __builtin_amdgcn_wave_barrier(); asm volatile("" ::: "memory");
        }
        outr[lane] = hr; outi[lane] = hi;
    }
}


typedef float f32x16 __attribute__((ext_vector_type(16)));
typedef unsigned u32x2v __attribute__((ext_vector_type(2)));
__device__ __forceinline__ unsigned cvtpk(float lo, float hi) { unsigned r; asm volatile("v_cvt_pk_bf16_f32 %0, %1, %2" : "=v"(r) : "v"(lo), "v"(hi)); return r; }
__device__ __forceinline__ bf16x8 pack8(const float* v) { v4u w; w.x = cvtpk(v[0], v[1]); w.y = cvtpk(v[2], v[3]); w.z = cvtpk(v[4], v[5]); w.w = cvtpk(v[6], v[7]); return __builtin_bit_cast(bf16x8, w); }
constexpr int SSM_ROWB = 272;

__device__ __forceinline__ void ssm_phase_fast(Frame& F) {
    LAS unsigned char* img = F.lds + RING_OFF + F.wave * 16384;
    const int lane = F.lane, G = F.G, gq = F.wave * G + F.vcu, NGQ = NWAVES * G;
    const float* X = (const float*)(F.ws + WS_X); const float* ssq = (const float*)(F.ws + WS_SSQ) + 1 * M;
    const float* sp = (const float*)(F.ws + WS_SSMP); bf16* Gb = (bf16*)(F.ws + WS_G);
    const float* g1 = F.in[5] + 1 * D; const float* dsk = F.in[16];
    constexpr int NPI = 8 * NG, NSB = (MS / 32) * NG, NITEM = NPI + NSB;
    const int l31 = lane & 31, h = lane >> 5, l15 = lane & 15, q4 = lane >> 4;
    for (int it = gq; it < NITEM; it += NGQ) {
        const bool sample = it >= NPI;
        int g, row_base, nblk, seq0;
        if (!sample) { seq0 = it / NG; g = it % NG; row_base = seq0 * 2048; nblk = 64; }
        else { const int j = it - NPI; const int rb = j / NG; g = j % NG; row_base = MP + rb * 32; nblk = 1; seq0 = rb * 4; }
        bf16x8 bbq[4];
#pragma unroll
        for (int q = 0; q < 4; ++q) { const int p = 32 * (q & 1) + l31; const float* src = sp + 8192 + (q >> 1) * 65536 + ((size_t)(g * PS + p) * GS + 8 * h);
            float v[8];
#pragma unroll
            for (int j = 0; j < 8; ++j) v[j] = src[j] * g1[g * GS + 8 * h + j];
            bbq[q] = pack8(v); }
        bf16x8 cm[4];
#pragma unroll
        for (int ks = 0; ks < 4; ++ks) { const int p0 = 16 * ks + 4 * q4; const float* cr = F.in[14] + ((size_t)(g * GS + l15) * PS + p0); const float* ci = F.in[15] + ((size_t)(g * GS + l15) * PS + p0);
            float v[8];
#pragma unroll
            for (int j = 0; j < 4; ++j) { v[2 * j] = cr[j]; v[2 * j + 1] = -ci[j]; }
            cm[ks] = pack8(v); }
        float dg[4];
#pragma unroll
        for (int e = 0; e < 4; ++e) dg[e] = dsk[g * GS + 4 * q4 + e] * g1[g * GS + 4 * q4 + e];
        const float lbr = sp[g * PS + lane], lbi = sp[4096 + g * PS + lane];
        float hr = 0.f, hi = 0.f;
        float s0r[4], s0i[4];
        if (sample) {
#pragma unroll
            for (int i = 0; i < 4; ++i) { s0r[i] = F.in[2][((size_t)(seq0 + i) * NG + g) * PS + lane]; s0i[i] = F.in[3][((size_t)(seq0 + i) * NG + g) * PS + lane]; } }
        else {
#pragma unroll
            for (int i = 0; i < 4; ++i) { s0r[i] = 0.f; s0i[i] = 0.f; } }
        f32x4 xa0, xa1, xe0, xe1; float qa, qe0, qe1;
#define SSM_LOAD(b) do { const int rowA = row_base + 32 * (b) + l31; const float* pa = X + (size_t)rowA * D + g * GS + 8 * h; xa0 = *(const f32x4*)pa; xa1 = *(const f32x4*)(pa + 4); qa = ssq[rowA]; \
            const int rowE = row_base + 32 * (b) + l15; xe0 = *(const f32x4*)(X + (size_t)rowE * D + g * GS + 4 * q4); xe1 = *(const f32x4*)(X + (size_t)(rowE + 16) * D + g * GS + 4 * q4); qe0 = ssq[rowE]; qe1 = ssq[rowE + 16]; } while (0)
        SSM_LOAD(0);
        for (int b = 0; b < nblk; ++b) {
            const f32x4 ca0 = xa0, ca1 = xa1, ce0 = xe0, ce1 = xe1; const float cqa = qa, cqe0 = qe0, cqe1 = qe1;
            if (b + 1 < nblk) SSM_LOAD(b + 1);
            const float rsa = __builtin_amdgcn_rsqf(cqa * (1.0f / D) + EPS);
            float ua[8];
#pragma unroll
            for (int j = 0; j < 4; ++j) { ua[j] = ca0[j] * rsa; ua[4 + j] = ca1[j] * rsa; }
            const bf16x8 ufrag = pack8(ua);
            const f32x16 zero16 = {0.f, 0.f, 0.f, 0.f, 0.f, 0.f, 0.f, 0.f, 0.f, 0.f, 0.f, 0.f, 0.f, 0.f, 0.f, 0.f};
            f32x16 Xr = __builtin_amdgcn_mfma_f32_32x32x16_bf16(ufrag, bbq[0], zero16, 0, 0, 0);
            f32x16 Yr = __builtin_amdgcn_mfma_f32_32x32x16_bf16(ufrag, bbq[1], zero16, 0, 0, 0);
            f32x16 Xi = __builtin_amdgcn_mfma_f32_32x32x16_bf16(ufrag, bbq[2], zero16, 0, 0, 0);
            f32x16 Yi = __builtin_amdgcn_mfma_f32_32x32x16_bf16(ufrag, bbq[3], zero16, 0, 0, 0);
#pragma unroll
            for (int r = 0; r < 16; ++r) {
                auto s1 = __builtin_amdgcn_permlane32_swap(__float_as_uint(Xr[r]), __float_as_uint(Yr[r]), false, false); Xr[r] = __uint_as_float(s1[0]); Yr[r] = __uint_as_float(s1[1]);
                auto s2 = __builtin_amdgcn_permlane32_swap(__float_as_uint(Xi[r]), __float_as_uint(Yi[r]), false, false); Xi[r] = __uint_as_float(s2[0]); Yi[r] = __uint_as_float(s2[1]); }
#pragma unroll
            for (int i = 0; i < 4; ++i) {
                if (sample) { hr = s0r[i]; hi = s0i[i]; }
#pragma unroll
                for (int s = 0; s < 2; ++s)
#pragma unroll
                    for (int e = 0; e < 4; ++e) { const int r = 4 * i + e; const float br = s ? Yr[r] : Xr[r], bi = s ? Yi[r] : Xi[r];
                        const float nr = lbr * hr - lbi * hi + br, ni = lbr * hi + lbi * hr + bi; hr = nr; hi = ni;
                        *(LAS unsigned*)(img + (8 * i + 4 * s + e) * SSM_ROWB + 4 * lane) = cvtpk(hr, hi); }
                if (sample) { F.out[O_SRS + ((size_t)(seq0 + i) * NG + g) * PS + lane] = hr; F.out[O_SIS + ((size_t)(seq0 + i) * NG + g) * PS + lane] = hi; }
            }
            f32x4 acc0 = {0.f, 0.f, 0.f, 0.f}, acc1 = {0.f, 0.f, 0.f, 0.f};
#pragma unroll
            for (int ks = 0; ks < 4; ++ks) {
                const bf16x8 b0 = *(const LAS bf16x8*)(img + l15 * SSM_ROWB + 64 * ks + 16 * q4);
                const bf16x8 b1 = *(const LAS bf16x8*)(img + (16 + l15) * SSM_ROWB + 64 * ks + 16 * q4);
                acc0 = __builtin_amdgcn_mfma_f32_16x16x32_bf16(cm[ks], b0, acc0, 0, 0, 0);
                acc1 = __builtin_amdgcn_mfma_f32_16x16x32_bf16(cm[ks], b1, acc1, 0, 0, 0); }
            const float rse0 = __builtin_amdgcn_rsqf(cqe0 * (1.0f / D) + EPS), rse1 = __builtin_amdgcn_rsqf(cqe1 * (1.0f / D) + EPS);
            float o0[4], o1[4];
#pragma unroll
            for (int e = 0; e < 4; ++e) { o0[e] = gelu_tanh(acc0[e] + dg[e] * ce0[e] * rse0); o1[e] = gelu_tanh(acc1[e] + dg[e] * ce1[e] * rse1); }
            const int rowE = row_base + 32 * b + l15;
            u32x2v w0, w1; w0.x = cvtpk(o0[0], o0[1]); w0.y = cvtpk(o0[2], o0[3]); w1.x = cvtpk(o1[0], o1[1]); w1.y = cvtpk(o1[2], o1[3]);
            *(u32x2v*)(Gb + (size_t)rowE * D + g * GS + 4 * q4) = w0;
            *(u32x2v*)(Gb + (size_t)(rowE + 16) * D + g * GS + 4 * q4) = w1;
        }
#undef SSM_LOAD
        if (!sample) { F.out[O_SRP + ((size_t)seq0 * NG + g) * PS + lane] = hr; F.out[O_SIP + ((size_t)seq0 * NG + g) * PS + lane] = hi; }
    }
}

__device__ __forceinline__ void conv_phase(Frame& F) {
    const bf16* Z = (const bf16*)(F.ws + WS_Z); const bf16* GBp = (const bf16*)(F.ws + WS_GB); bf16* A2 = (bf16*)(F.ws + WS_A2);
    const float* cw = F.in[19]; const float* cache = F.in[4];
    const int gt = (F.vcu * NWAVES + F.wave) * 64 + F.lane, NGT = F.G * NWAVES * 64;
    for (int it = gt; it < M * (D / 8); it += NGT) {
        const int row = it >> 7, c0 = (it & 127) * 8;
        int t; const float* cb = nullptr;
        if (row < MP) t = row & 2047; else { const int r2 = row - MP; t = r2 & 7; cb = cache + (size_t)(r2 >> 3) * 2 * D; }
        float z0[8], z1[8], z2[8], gb[8];
        { const v4u v = *(const GAS v4u*)(Z + (size_t)row * D + c0); const v4u q = *(const GAS v4u*)(GBp + (size_t)row * D + c0);
#pragma unroll
          for (int e = 0; e < 4; ++e) { z2[2 * e] = __builtin_bit_cast(float, v[e] << 16); z2[2 * e + 1] = __builtin_bit_cast(float, v[e] & 0xffff0000u);
                                        gb[2 * e] = __builtin_bit_cast(float, q[e] << 16); gb[2 * e + 1] = __builtin_bit_cast(float, q[e] & 0xffff0000u); } }
        if (t >= 1) { const v4u v = *(const GAS v4u*)(Z + (size_t)(row - 1) * D + c0);
#pragma unroll
          for (int e = 0; e < 4; ++e) { z1[2 * e] = __builtin_bit_cast(float, v[e] << 16); z1[2 * e + 1] = __builtin_bit_cast(float, v[e] & 0xffff0000u); } }
        else {
#pragma unroll
          for (int e = 0; e < 8; ++e) z1[e] = cb ? cb[D + c0 + e] : 0.f; }
        if (t >= 2) { const v4u v = *(const GAS v4u*)(Z + (size_t)(row - 2) * D + c0);
#pragma unroll
          for (int e = 0; e < 4; ++e) { z0[2 * e] = __builtin_bit_cast(float, v[e] << 16); z0[2 * e + 1] = __builtin_bit_cast(float, v[e] & 0xffff0000u); } }
        else {
#pragma unroll
          for (int e = 0; e < 8; ++e) z0[e] = cb ? cb[t * D + c0 + e] : 0.f; }
        float o[8];
#pragma unroll
        for (int e = 0; e < 8; ++e) o[e] = gb[e] * (cw[c0 + e] * z0[e] + cw[D + c0 + e] * z1[e] + cw[2 * D + c0 + e] * z2[e]);
        v4u w; w.x = pk2(o[0], o[1]); w.y = pk2(o[2], o[3]); w.z = pk2(o[4], o[5]); w.w = pk2(o[6], o[7]);
        *(GAS v4u*)(A2 + (size_t)row * D + c0) = w;
    }
}

__device__ __forceinline__ void final_phase(Frame& F) {
    const float* X = (const float*)(F.ws + WS_X); const float* ssq = (const float*)(F.ws + WS_SSQ) + 6 * M; const float* fg = F.in[6];
    const int gw = F.vcu * NWAVES + F.wave, NGW = F.G * NWAVES, lane = F.lane;
    f32x4 gv[4];
#pragma unroll
    for (int j = 0; j < 4; ++j) gv[j] = ((const GAS f32x4*)fg)[lane + 64 * j];
    for (int m = gw; m < M; m += NGW) {
        const float rs = __builtin_amdgcn_rsqf(ssq[m] * (1.0f / D) + EPS);
        const GAS f32x4* xr = (const GAS f32x4*)(X + (size_t)m * D) + lane; GAS f32x4* yo = (GAS f32x4*)(F.out + O_Y + (size_t)m * D) + lane;
#pragma unroll
        for (int j = 0; j < 4; ++j) yo[64 * j] = xr[64 * j] * rs * gv[j];
    }
}

struct Args { const float* in[21]; float* out; unsigned char* ws; int ph_lo, ph_hi; };
__global__ void __launch_bounds__(NWAVES * 64, 2) skel_fwd(Args args) {
    extern __shared__ __attribute__((aligned(16))) unsigned char lds[];
    Frame F;
    F.lds = (LAS unsigned char*)lds;
    F.MISC = (volatile LAS unsigned*)(F.lds + MISC_OFF);
    F.tid = threadIdx.x; F.lane = F.tid & 63; F.wave = __builtin_amdgcn_readfirstlane(F.tid >> 6);
    F.G = gridDim.x; { const int bx = blockIdx.x; F.vcu = (F.G % 8 == 0) ? (bx % 8) * (F.G / 8) + bx / 8 : bx; }
    F.ws = args.ws; F.out = args.out; F.ctl = (gu32*)(args.ws + WS_CTL);
#pragma unroll
    for (int i = 0; i < 21; ++i) F.in[i] = args.in[i];
    for (int u = F.tid; u < (LDS_BYTES - LDSCTL_OFF) / 4; u += NWAVES * 64) ((LAS unsigned*)(F.lds + LDSCTL_OFF))[u] = 0u;
    __syncthreads();
    XcdBarrier bar; bar.bar = (unsigned*)(F.ctl + CW_BAR); bar.x = 0; bar.st = nullptr;
    if (MK_ONE_LAUNCH) bar = xcd_barrier_post((unsigned*)(F.ctl + CW_BAR), F.MISC + 8);
    const int lo = args.ph_lo, hi = args.ph_hi;
#define IN(k) (lo <= (k) && (k) < hi)
#define SEAM(k) do { if (MK_ONE_LAUNCH && IN((k) + 1)) xcd_barrier(bar); } while (0)
    bf16* XB = (bf16*)(F.ws + WS_XB); bf16* H = (bf16*)(F.ws + WS_H); float* X = (float*)(F.ws + WS_X); float* ssq = (float*)(F.ws + WS_SSQ);
    const int bx = (int)blockIdx.x;

    if (IN(0)) { p0_prologue(F); SEAM(0); }
#define FFN_GU(ph, f, sin) if (IN(ph)) { pg8::Gemm g{XB, (const bf16*)(F.ws + WS_WGU) + (size_t)(f) * 2 * FF * D, M, 2 * FF, D}; pg8::StaticOrder S; S.init(M, 2 * FF, F.G, bx); \
        pg8::EpiGateUp E{H, FF, ssq + (size_t)(sin) * M}; pg8::gemm_phase<pg8::EpiGateUp, pg8::StaticOrder, true, true>(F.lds + RING_OFF, g, S, E); SEAM(ph); }
#define FFN_DN(ph, f, sout) if (IN(ph)) { pg8::Gemm g{H, (const bf16*)(F.ws + WS_WD) + (size_t)(f) * D * FF, M, D, FF}; pg8::StaticOrder S; S.init(M, D, F.G, bx); \
        pg8::EpiResid<0> E{X, XB, ssq + (size_t)(sout) * M, 0.5f}; pg8::gemm_phase<pg8::EpiResid<0>, pg8::StaticOrder, true, true>(F.lds + RING_OFF, g, S, E); SEAM(ph); }
    FFN_GU(1, 0, 0)
    FFN_DN(2, 0, 1)
    if (IN(3)) { ssm_phase_fast(F); SEAM(3); }
    if (IN(4)) { pg8::Gemm g{(const bf16*)(F.ws + WS_G), (const bf16*)(F.ws + WS_WGLU), M, 2 * D, D}; pg8::StaticOrder S; S.init(M, 2 * D, F.G, bx);
        pg8::EpiResid<1> E{X, XB, ssq + (size_t)2 * M, 1.0f}; pg8::gemm_phase<pg8::EpiResid<1>, pg8::StaticOrder, true, true>(F.lds + RING_OFF, g, S, E); SEAM(4); }
    FFN_GU(5, 1, 2)
    FFN_DN(6, 1, 3)
    FFN_GU(7, 2, 3)
    FFN_DN(8, 2, 4)
    if (IN(9)) { pg8::Gemm g{XB, (const bf16*)(F.ws + WS_WIN), M, 3 * D, D}; pg8::StaticOrder S; S.init(M, 3 * D, F.G, bx);
        pg8::EpiConvIn E{(bf16*)(F.ws + WS_Z), (bf16*)(F.ws + WS_GB), ssq + (size_t)4 * M, F.out + O_CP, F.out + O_CS};
        pg8::gemm_phase<pg8::EpiConvIn, pg8::StaticOrder, true, true>(F.lds + RING_OFF, g, S, E); SEAM(9); }
    if (IN(10)) { conv_phase(F); SEAM(10); }
    if (IN(11)) { pg8::Gemm g{(const bf16*)(F.ws + WS_A2), (const bf16*)(F.ws + WS_WOUT), M, D, D}; pg8::StaticOrder S; S.init(M, D, F.G, bx);
        pg8::EpiResid<0> E{X, XB, ssq + (size_t)5 * M, 1.0f}; pg8::gemm_phase<pg8::EpiResid<0>, pg8::StaticOrder, true, true>(F.lds + RING_OFF, g, S, E); SEAM(11); }
    FFN_GU(12, 3, 5)
    FFN_DN(13, 3, 6)
    if (IN(14)) { final_phase(F); }
#undef IN
#undef SEAM
}

extern "C" void kernel_launch(void* const* d_in, const int* in_sizes, int n_in, void* d_out, int out_size, void* d_ws, size_t ws_size, hipStream_t stream) {
    static int grid = 0;
    if (grid == 0) {
        if (n_in != 21 || out_size != (int)O_END || ws_size < WS_END) { fprintf(stderr, "kernel_launch: unexpected shapes: n_in %d out %d ws %zu; nothing launched\n", n_in, out_size, ws_size); grid = -1; return; }
        int dev = 0, cus = 0, per_cu = 0;
        if (hipGetDevice(&dev) != hipSuccess || hipDeviceGetAttribute(&cus, hipDeviceAttributeMultiprocessorCount, dev) != hipSuccess) { grid = -1; return; }
        if (hipFuncSetAttribute((const void*)skel_fwd, hipFuncAttributeMaxDynamicSharedMemorySize, LDS_BYTES) != hipSuccess) { fprintf(stderr, "kernel_launch: hipFuncSetAttribute failed\n"); grid = -1; return; }
        if (hipOccupancyMaxActiveBlocksPerMultiprocessor(&per_cu, (const void*)skel_fwd, NWAVES * 64, LDS_BYTES) != hipSuccess || per_cu < 1) fprintf(stderr, "kernel_launch: occupancy query reports %d\n", per_cu);
        (void)hipGetLastError();
        grid = cus;
    }
    if (grid < 0) return;
    if (hipMemsetAsync((char*)d_ws + WS_CTL, 0, CTL_ZERO_BYTES, stream) != hipSuccess) return;
    Args a{};
    for (int i = 0; i < 21; ++i) a.in[i] = (const float*)d_in[i];
    a.out = (float*)d_out; a.ws = (unsigned char*)d_ws;
#if MK_ONE_LAUNCH
    a.ph_lo = 0; a.ph_hi = N_PHASES;
    hipLaunchKernelGGL(skel_fwd, dim3(grid), dim3(NWAVES * 64), LDS_BYTES, stream, a);
#else
    for (int p = 0; p < N_PHASES; ++p) { a.ph_lo = p; a.ph_hi = p + 1; hipLaunchKernelGGL(skel_fwd, dim3(grid), dim3(NWAVES * 64), LDS_BYTES, stream, a); }
#endif
}
```

```cpp
#include <hip/hip_runtime.h>
#include <cstdio>
#include <cstdint>
namespace pg8 {
#define PG8_LAS __attribute__((address_space(3)))
typedef unsigned short bf16_t;
typedef short bf16x8 __attribute__((ext_vector_type(8)));
typedef float f32x4 __attribute__((ext_vector_type(4)));
typedef unsigned u32x4 __attribute__((ext_vector_type(4)));
constexpr int BM = 256, BK = 64, HALF = 128, HTB = HALF * BK * 2  , STAGE_BYTES = 8 * HTB, NXCD = 8, WGM = 8;

__host__ __device__ __forceinline__ int lds_byte(int r, int c) { const int st = (r >> 4) * 2 + (c >> 5), rr = r & 15, cc = c & 31, ob = rr * 64 + cc * 2; return st * 1024 + (ob ^ (((ob >> 9) & 1) << 5)); }
__host__ __device__ __forceinline__ void stage_rc(int b, int& R, int& C) { const int st = b / 1024, sb = b % 1024, swz = sb ^ (((sb >> 9) & 1) << 5); R = (st >> 1) * 16 + swz / 64; C = (st & 1) * 32 + (swz % 64) / 2; }
__host__ __device__ __forceinline__ int perm32(int rho) { const int n = rho >> 4, i = rho & 15; return 8 * (i >> 2) + 4 * n + (i & 3); }

struct Unit { int pm, pn; };
struct Gemm { const bf16_t* A; const bf16_t* Bt; int M, N, K; };

struct StaticOrder {
    int nM, nN, nwg, G, c;
    __host__ __device__ void init(int M, int N, int G_, int c_) { nM = M / BM; nN = N / BM; nwg = nM * nN; G = G_; c = c_; }
    __host__ __device__ bool next(int i, Unit& u) const {
        const long L = (long)i * G + c; if (L >= nwg) return false;
        int wgid = (int)L; { const int q = nwg / NXCD, r = nwg % NXCD, xcd = wgid % NXCD, off = wgid / NXCD; wgid = (xcd < r ? xcd * (q + 1) : r * (q + 1) + (xcd - r) * q) + off; }
        const int nig = WGM * nN, gid = wgid / nig, fm = gid * WGM, gsz = (nM - fm) < WGM ? (nM - fm) : WGM;
        u.pm = fm + ((wgid % nig) % gsz); u.pn = (wgid % nig) / gsz; return true;
    }
    __device__ __forceinline__ void a_ready(const Unit&) const {}
    __device__ __forceinline__ void done(const Unit&) const {}
};


__device__ __forceinline__ unsigned cvt_pk_bf16(float lo, float hi) { unsigned r; asm volatile("v_cvt_pk_bf16_f32 %0, %1, %2" : "=v"(r) : "v"(lo), "v"(hi)); return r; }

typedef unsigned u32x2 __attribute__((ext_vector_type(2)));
constexpr float RMS_EPS = 1e-6f;
constexpr float INV_D = 1.0f / 1024.0f;
__device__ __forceinline__ float sigmoid_f(float x) { return __builtin_amdgcn_rcpf(1.0f + __builtin_amdgcn_exp2f(-1.4426950408889634f * x)); }
__device__ __forceinline__ float rstd_of(float ssq) { return __builtin_amdgcn_rsqf(ssq * INV_D + RMS_EPS); }
#define PG8_EPI_CALL() \
    __device__ __forceinline__ void operator()(const f32x4 (&acc)[2][2][4][2], const Unit& u, int wr, int wc, int fr, int fq) const { \
        _Pragma("unroll") for (int ai = 0; ai < 2; ++ai) _Pragma("unroll") for (int m = 0; m < 4; ++m) { \
            const f32x4 a[2][2] = {{acc[ai][0][m][0], acc[ai][0][m][1]}, {acc[ai][1][m][0], acc[ai][1][m][1]}}; rg(a, u, ai, m, 3, wr, wc, fr, fq); } }

struct EpiGateUp {
    static constexpr bool PERM = true, AFTER_DRAIN = false;
    bf16_t* H; int ldh; const float* ssq;
    __device__ __forceinline__ void rg(const f32x4 (&a)[2][2], const Unit& u, int ai, int m, int bjmask, int wr, int wc, int fr, int fq) const {
        const int row = u.pm * BM + ai * HALF + wr * 64 + m * 16 + fr, col0 = u.pn * HALF + wc * 32 + 8 * fq;
        const float rs = rstd_of(ssq[row]);
        float h[8];
#pragma unroll
        for (int n = 0; n < 2; ++n)
#pragma unroll
            for (int e = 0; e < 4; ++e) { const float g = a[0][n][e] * rs, up = a[1][n][e] * rs; h[4 * n + e] = g * sigmoid_f(g) * up; }
        u32x4 w; w.x = cvt_pk_bf16(h[0], h[1]); w.y = cvt_pk_bf16(h[2], h[3]); w.z = cvt_pk_bf16(h[4], h[5]); w.w = cvt_pk_bf16(h[6], h[7]);
        *(u32x4*)(H + (size_t)row * ldh + col0) = w;
    }
    __device__ __forceinline__ void rgx(const f32x4 (&ax)[2], const Unit& u, int wr, int wc, int fr, int fq) const {
        const int row = 16384 + 16 * u.pm + fr, col0 = u.pn * HALF + wc * 32 + 8 * fq + 4 * wr;
        const float rs = rstd_of(ssq[row]);
        float h[4];
#pragma unroll
        for (int e = 0; e < 4; ++e) { const float g = ax[0][e] * rs, up = ax[1][e] * rs; h[e] = g * sigmoid_f(g) * up; }
        u32x2 w; w.x = cvt_pk_bf16(h[0], h[1]); w.y = cvt_pk_bf16(h[2], h[3]);
        *(u32x2*)(H + (size_t)row * ldh + col0) = w;
    }
    PG8_EPI_CALL()
};

template <int MODE> struct EpiResid {
    static constexpr bool PERM = true, AFTER_DRAIN = false;
    float* X; bf16_t* XB; float* ssq; float scale;
    __device__ __forceinline__ void rg(const f32x4 (&a)[2][2], const Unit& u, int ai, int m, int bjmask, int wr, int wc, int fr, int fq) const {
        const int row = u.pm * BM + ai * HALF + wr * 64 + m * 16 + fr;
        const int col0 = (MODE == 0 ? u.pn * BM : u.pn * HALF) + wc * 32 + 8 * fq;
        float sq = 0.f;
#pragma unroll
        for (int bj = 0; bj < (MODE == 0 ? 2 : 1); ++bj) {
            if (MODE == 0 && !((bjmask >> bj) & 1)) continue;
            float* xp = X + (size_t)row * 1024 + col0 + bj * HALF;
            f32x4 x0 = *(const f32x4*)xp, x1 = *(const f32x4*)(xp + 4);
            if (MODE == 0) { x0 += a[bj][0] * scale; x1 += a[bj][1] * scale; }
            else {
#pragma unroll
                for (int e = 0; e < 4; ++e) { x0[e] += a[0][0][e] * sigmoid_f(a[1][0][e]); x1[e] += a[0][1][e] * sigmoid_f(a[1][1][e]); } }
            *(f32x4*)xp = x0; *(f32x4*)(xp + 4) = x1;
            u32x4 w; w.x = cvt_pk_bf16(x0[0], x0[1]); w.y = cvt_pk_bf16(x0[2], x0[3]); w.z = cvt_pk_bf16(x1[0], x1[1]); w.w = cvt_pk_bf16(x1[2], x1[3]);
            *(u32x4*)(XB + (size_t)row * 1024 + col0 + bj * HALF) = w;
            sq += (x0[0] * x0[0] + x0[1] * x0[1]) + (x0[2] * x0[2] + x0[3] * x0[3]) + (x1[0] * x1[0] + x1[1] * x1[1]) + (x1[2] * x1[2] + x1[3] * x1[3]); }
        sq += __shfl_xor(sq, 16); sq += __shfl_xor(sq, 32);
        if (fq == 0) atomicAdd(ssq + row, sq);
    }
    __device__ __forceinline__ void rgx(const f32x4 (&ax)[2], const Unit& u, int wr, int wc, int fr, int fq) const {
        const int row = 16384 + 16 * u.pm + fr;
        const int col0 = (MODE == 0 ? u.pn * BM : u.pn * HALF) + wc * 32 + 8 * fq + 4 * wr;
        float sq = 0.f;
#pragma unroll
        for (int bj = 0; bj < (MODE == 0 ? 2 : 1); ++bj) {
            float* xp = X + (size_t)row * 1024 + col0 + bj * HALF;
            f32x4 x0 = *(const f32x4*)xp;
            if (MODE == 0) x0 += ax[bj] * scale;
            else {
#pragma unroll
                for (int e = 0; e < 4; ++e) x0[e] += ax[0][e] * sigmoid_f(ax[1][e]); }
            *(f32x4*)xp = x0;
            u32x2 w; w.x = cvt_pk_bf16(x0[0], x0[1]); w.y = cvt_pk_bf16(x0[2], x0[3]);
            *(u32x2*)(XB + (size_t)row * 1024 + col0 + bj * HALF) = w;
            sq += (x0[0] * x0[0] + x0[1] * x0[1]) + (x0[2] * x0[2] + x0[3] * x0[3]); }
        sq += __shfl_xor(sq, 16); sq += __shfl_xor(sq, 32);
        if (fq == 0) atomicAdd(ssq + row, sq);
    }
    PG8_EPI_CALL()
};

struct EpiConvIn {
    static constexpr bool PERM = true, AFTER_DRAIN = false;
    bf16_t* Z; bf16_t* GB; const float* ssq; float* conv_p; float* conv_s;
    __device__ __forceinline__ void rg(const f32x4 (&a)[2][2], const Unit& u, int ai, int m, int bjmask, int wr, int wc, int fr, int fq) const {
        const int row = u.pm * BM + ai * HALF + wr * 64 + m * 16 + fr;
        const float rs = rstd_of(ssq[row]);
        if (u.pn < 8) {
            const int col0 = u.pn * HALF + wc * 32 + 8 * fq; const float rs2 = rs * rs;
            const f32x4 z0 = a[0][0] * a[1][0] * rs2, z1 = a[0][1] * a[1][1] * rs2;
            u32x4 w; w.x = cvt_pk_bf16(z0[0], z0[1]); w.y = cvt_pk_bf16(z0[2], z0[3]); w.z = cvt_pk_bf16(z1[0], z1[1]); w.w = cvt_pk_bf16(z1[2], z1[3]);
            *(u32x4*)(Z + (size_t)row * 1024 + col0) = w;
            float* cp = nullptr;
            if (row < 16384) { const int t = row & 2047; if (t >= 2046) cp = conv_p + ((size_t)(row >> 11) * 2 + (t - 2046)) * 1024 + col0; }
            else { const int r2 = row - 16384, t = r2 & 7; if (t >= 6) cp = conv_s + ((size_t)(r2 >> 3) * 2 + (t - 6)) * 1024 + col0; }
            if (cp) { *(f32x4*)cp = z0; *(f32x4*)(cp + 4) = z1; }
        } else {
            const int col0 = (u.pn - 8) * BM + wc * 32 + 8 * fq;
#pragma unroll
            for (int bj = 0; bj < 2; ++bj) { const f32x4 g0 = a[bj][0] * rs, g1 = a[bj][1] * rs;
                u32x4 w; w.x = cvt_pk_bf16(g0[0], g0[1]); w.y = cvt_pk_bf16(g0[2], g0[3]); w.z = cvt_pk_bf16(g1[0], g1[1]); w.w = cvt_pk_bf16(g1[2], g1[3]);
                *(u32x4*)(GB + (size_t)row * 1024 + col0 + bj * HALF) = w; }
        }
    }
    __device__ __forceinline__ void rgx(const f32x4 (&ax)[2], const Unit& u, int wr, int wc, int fr, int fq) const {
        const int r2 = 16 * u.pm + fr, row = 16384 + r2;
        const float rs = rstd_of(ssq[row]);
        if (u.pn < 8) {
            const int col0 = u.pn * HALF + wc * 32 + 8 * fq + 4 * wr;
            const f32x4 z0 = ax[0] * ax[1] * (rs * rs);
            u32x2 w; w.x = cvt_pk_bf16(z0[0], z0[1]); w.y = cvt_pk_bf16(z0[2], z0[3]);
            *(u32x2*)(Z + (size_t)row * 1024 + col0) = w;
            const int t = r2 & 7;
            if (t >= 6) *(f32x4*)(conv_s + ((size_t)(r2 >> 3) * 2 + (t - 6)) * 1024 + col0) = z0;
        } else {
            const int col0 = (u.pn - 8) * BM + wc * 32 + 8 * fq + 4 * wr;
#pragma unroll
            for (int bj = 0; bj < 2; ++bj) { const f32x4 g0 = ax[bj] * rs;
                u32x2 w; w.x = cvt_pk_bf16(g0[0], g0[1]); w.y = cvt_pk_bf16(g0[2], g0[3]);
                *(u32x2*)(GB + (size_t)row * 1024 + col0 + bj * HALF) = w; }
        }
    }
    PG8_EPI_CALL()
};

struct EpiNull {
    static constexpr bool PERM = true, AFTER_DRAIN = false;
    bf16_t* sink;
    __device__ __forceinline__ void rg(const f32x4 (&a)[2][2], const Unit& u, int ai, int m, int bjmask, int wr, int wc, int fr, int fq) const {
        asm volatile("" :: "v"(a[0][0]), "v"(a[0][1]), "v"(a[1][0]), "v"(a[1][1]));
    }
    __device__ __forceinline__ void rgx(const f32x4 (&ax)[2], const Unit& u, int wr, int wc, int fr, int fq) const { asm volatile("" :: "v"(ax[0]), "v"(ax[1])); }
    PG8_EPI_CALL()
};

template <class Epi, class Sched, bool ALIGN_EPI = false, bool SP2 = false>
__device__ __forceinline__ void gemm_phase(PG8_LAS unsigned char* lds, const Gemm g, const Sched& S, const Epi& E) {
    int tid_ = threadIdx.x; asm volatile("" : "+v"(tid_));
    const int tid = tid_, wid = __builtin_amdgcn_readfirstlane(tid >> 6), lane = tid & 63, wr = wid >> 2, wc = wid & 3, fr = lane & 15, fq = lane >> 4;
    const int K = g.K, nt = K / BK;
    constexpr int XROW0 = 16384, XR = 16;
    unsigned voffA[2], voffB[2];
#pragma unroll
    for (int i = 0; i < 2; ++i) { int R, C; stage_rc(tid * 16 + i * 8192, R, C); const int Rb = Epi::PERM ? ((R & ~31) + perm32(R & 31)) : R;
        voffA[i] = (unsigned)(R * K + C) * 2u; voffB[i] = (unsigned)(Rb * K + C) * 2u; }
    unsigned voffX; { const int row = wid * 2 + (lane >> 5), q = (lane & 31) * 4, kb = q ^ (((row >> 1) & 7) << 4); voffX = (unsigned)(row * K * 2 + kb); }
    const int xoff0 = fr * 128 + ((fq * 16) ^ (((fr >> 1) & 7) << 4)), xoff1 = fr * 128 + ((64 + fq * 16) ^ (((fr >> 1) & 7) << 4));
    const unsigned kstep = (unsigned)(BK * 2);
    const unsigned hstep = (unsigned)HALF * K * 2;
    const unsigned tstep = 2 * hstep;
    const __amdgpu_buffer_rsrc_t rsA = __builtin_amdgcn_make_buffer_rsrc((void*)g.A, 0, 0x7ffff000, 0x00020000), rsB = __builtin_amdgcn_make_buffer_rsrc((void*)g.Bt, 0, 0x7ffff000, 0x00020000);
    const unsigned ldsw = (unsigned)wid * 1024u;
    const int aoff = lds_byte(wr * 64 + fr, fq * 8), boff = lds_byte(wc * 32 + fr, fq * 8);
#define PG8_SA(b, h) (((b) * 2 + (h)) * HTB)
#define PG8_SB(b, h) ((4 + (b) * 2 + (h)) * HTB)
#define PG8_SX(b) (STAGE_BYTES + (b) * 2048)
#define PG8_STAGEX(b, soff) __builtin_amdgcn_raw_ptr_buffer_load_lds(rsA, (PG8_LAS unsigned*)(lds + PG8_SX(b) + wid * 256), 4, voffX, (soff), 0, 0)
#define PG8_LDAX(dst, b) do { dst[0] = *(const PG8_LAS bf16x8*)(lds + PG8_SX(b) + xoff0); dst[1] = *(const PG8_LAS bf16x8*)(lds + PG8_SX(b) + xoff1); } while (0)
#define PG8_MMAX() do { if (wr == 0) { _Pragma("unroll") for (int k = 0; k < 2; ++k) { accx[0] = __builtin_amdgcn_mfma_f32_16x16x32_bf16(B0[0][k], Ax[k], accx[0], 0, 0, 0); accx[1] = __builtin_amdgcn_mfma_f32_16x16x32_bf16(B1[0][k], Ax[k], accx[1], 0, 0, 0); } } \
        else { _Pragma("unroll") for (int k = 0; k < 2; ++k) { accx[0] = __builtin_amdgcn_mfma_f32_16x16x32_bf16(B0[1][k], Ax[k], accx[0], 0, 0, 0); accx[1] = __builtin_amdgcn_mfma_f32_16x16x32_bf16(B1[1][k], Ax[k], accx[1], 0, 0, 0); } } } while (0)
#define PG8_STAGEA(bufoff, soff) do { _Pragma("unroll") for (int _i = 0; _i < 2; ++_i) \
        __builtin_amdgcn_raw_ptr_buffer_load_lds(rsA, (PG8_LAS unsigned*)(lds + (bufoff) + ldsw + _i * 8192), 16, voffA[_i], (soff), 0, 0); } while (0)
#define PG8_STAGEB(bufoff, soff) do { _Pragma("unroll") for (int _i = 0; _i < 2; ++_i) \
        __builtin_amdgcn_raw_ptr_buffer_load_lds(rsB, (PG8_LAS unsigned*)(lds + (bufoff) + ldsw + _i * 8192), 16, voffB[_i], (soff), 0, 0); } while (0)
#define PG8_LDA(dst, b, h) do { _Pragma("unroll") for (int m = 0; m < 4; ++m) _Pragma("unroll") for (int k = 0; k < 2; ++k) dst[m][k] = *(const PG8_LAS bf16x8*)(lds + PG8_SA(b, h) + aoff + m * 2048 + k * 1024); } while (0)
#define PG8_LDB(dst, b, h) do { _Pragma("unroll") for (int n = 0; n < 2; ++n) _Pragma("unroll") for (int k = 0; k < 2; ++k) dst[n][k] = *(const PG8_LAS bf16x8*)(lds + PG8_SB(b, h) + boff + n * 2048 + k * 1024); } while (0)
#define PG8_MMA(ai, bj, At, Bt) do { __builtin_amdgcn_s_setprio(1); _Pragma("unroll") for (int m = 0; m < 4; ++m) _Pragma("unroll") for (int n = 0; n < 2; ++n) _Pragma("unroll") for (int k = 0; k < 2; ++k) \
        acc[ai][bj][m][n] = __builtin_amdgcn_mfma_f32_16x16x32_bf16(Bt[n][k], At[m][k], acc[ai][bj][m][n], 0, 0, 0); __builtin_amdgcn_s_setprio(0); } while (0)
#define PG8_WAIT_V(n) asm volatile("s_waitcnt vmcnt(" #n ")" ::: "memory")
#define PG8_WAIT_L(n) asm volatile("s_waitcnt lgkmcnt(" #n ")" ::: "memory")
#define PG8_BAR __builtin_amdgcn_s_barrier()
#define PG8_SCHED __builtin_amdgcn_sched_barrier(0)
    Unit cur, nxt; int ui = 0;
    if (!S.next(0, cur)) return;
    f32x4 acc[2][2][4][2];
#pragma unroll
    for (int a = 0; a < 2; ++a)
#pragma unroll
        for (int b = 0; b < 2; ++b)
#pragma unroll
            for (int m = 0; m < 4; ++m)
#pragma unroll
                for (int n = 0; n < 2; ++n) acc[a][b][m][n] = (f32x4){0.f, 0.f, 0.f, 0.f};
    bf16x8 At[4][2], B0[2][2], B1[2][2], Ax[2];
    f32x4 accx[2] = {(f32x4){0.f, 0.f, 0.f, 0.f}, (f32x4){0.f, 0.f, 0.f, 0.f}};
    unsigned cA = (unsigned)cur.pm * tstep, cB = (unsigned)cur.pn * tstep;
    const unsigned xstep = (unsigned)XR * K * 2, xbase = (unsigned)XROW0 * K * 2; unsigned cX = xbase + (unsigned)cur.pm * xstep;
    S.a_ready(cur);
    if constexpr (SP2) {
        PG8_STAGEB(PG8_SB(0, 0), cB); PG8_STAGEB(PG8_SB(0, 1), cB + hstep); PG8_STAGEA(PG8_SA(0, 0), cA); PG8_STAGEX(0, cX); PG8_STAGEA(PG8_SA(0, 1), cA + hstep);
        if (wr == 1) PG8_BAR;
        PG8_WAIT_V(2); PG8_BAR;
        PG8_STAGEB(PG8_SB(1, 0), cB + kstep); PG8_STAGEA(PG8_SA(1, 0), cA + kstep); PG8_STAGEB(PG8_SB(1, 1), cB + hstep + kstep); PG8_STAGEX(1, cX + kstep);
        PG8_WAIT_V(7); PG8_BAR;
    } else {
        PG8_STAGEB(PG8_SB(0, 0), cB); PG8_STAGEA(PG8_SA(0, 0), cA); PG8_STAGEB(PG8_SB(0, 1), cB + hstep); PG8_STAGEA(PG8_SA(0, 1), cA + hstep);
        if (wr == 1) PG8_BAR;
        PG8_WAIT_V(4); PG8_BAR;
        PG8_STAGEB(PG8_SB(1, 0), cB + kstep); PG8_STAGEA(PG8_SA(1, 0), cA + kstep); PG8_STAGEB(PG8_SB(1, 1), cB + hstep + kstep);
        PG8_WAIT_V(6); PG8_BAR;
    }
    for (;;) {
        const bool has_next = S.next(ui + 1, nxt);
        const unsigned nA = has_next ? (unsigned)nxt.pm * tstep : cA, nB = has_next ? (unsigned)nxt.pn * tstep : cB, nX = has_next ? xbase + (unsigned)nxt.pm * xstep : cX;
        for (int t = 0; t < nt; t += 2) {
            const bool last = (t == nt - 2);
            const unsigned a1 = cA + (unsigned)(t + 1) * kstep;
            const unsigned a2 = last ? nA : cA + (unsigned)(t + 2) * kstep, b2 = last ? nB : cB + (unsigned)(t + 2) * kstep;
            const unsigned a3 = a2 + kstep, b3 = b2 + kstep, x2 = last ? nX : cX + (unsigned)(t + 2) * kstep, x3 = x2 + kstep;
            if (last && has_next) S.a_ready(nxt);
            if constexpr (SP2) {
            PG8_LDB(B0, 0, 0); PG8_LDB(B1, 0, 1); PG8_SCHED; PG8_LDA(At, 0, 0); PG8_LDAX(Ax, 0); PG8_STAGEA(PG8_SA(1, 1), a1 + hstep);
            PG8_WAIT_V(9); PG8_WAIT_L(0); PG8_BAR; PG8_MMA(0, 0, At, B0); PG8_MMA(0, 1, At, B1); PG8_MMAX(); PG8_BAR; PG8_SCHED;
            PG8_LDA(At, 0, 1); PG8_STAGEB(PG8_SB(0, 0), b2); PG8_STAGEB(PG8_SB(0, 1), b2 + hstep); PG8_STAGEA(PG8_SA(0, 0), a2); PG8_STAGEX(0, x2);
            PG8_WAIT_V(9); PG8_WAIT_L(0); PG8_BAR; PG8_MMA(1, 0, At, B0); PG8_MMA(1, 1, At, B1); PG8_BAR; PG8_SCHED;
            PG8_LDB(B0, 1, 0); PG8_LDB(B1, 1, 1); PG8_SCHED; PG8_LDA(At, 1, 0); PG8_LDAX(Ax, 1); PG8_STAGEA(PG8_SA(0, 1), a2 + hstep);
            PG8_WAIT_V(9); PG8_WAIT_L(0); PG8_BAR; PG8_MMA(0, 0, At, B0); PG8_MMA(0, 1, At, B1); PG8_MMAX(); PG8_BAR; PG8_SCHED;
            PG8_LDA(At, 1, 1); PG8_STAGEB(PG8_SB(1, 0), b3); PG8_STAGEB(PG8_SB(1, 1), b3 + hstep); PG8_STAGEA(PG8_SA(1, 0), a3); PG8_STAGEX(1, x3);
            PG8_WAIT_V(9); PG8_WAIT_L(0); PG8_BAR; PG8_MMA(1, 0, At, B0); PG8_MMA(1, 1, At, B1); PG8_BAR; PG8_SCHED;
            } else {
            PG8_LDB(B0, 0, 0); PG8_SCHED; PG8_LDA(At, 0, 0); PG8_STAGEA(PG8_SA(1, 1), a1 + hstep);
            PG8_WAIT_L(8); PG8_BAR; PG8_WAIT_L(0); PG8_MMA(0, 0, At, B0); PG8_BAR; PG8_SCHED;
            PG8_LDB(B1, 0, 1); PG8_STAGEB(PG8_SB(0, 0), b2);
            PG8_BAR; PG8_WAIT_L(0); PG8_MMA(0, 1, At, B1); PG8_BAR;
            PG8_LDA(At, 0, 1); PG8_STAGEA(PG8_SA(0, 0), a2);
            PG8_BAR; PG8_WAIT_L(0); PG8_MMA(1, 0, At, B0); PG8_BAR; PG8_SCHED;
            PG8_STAGEB(PG8_SB(0, 1), b2 + hstep);
            PG8_WAIT_V(6); PG8_BAR; PG8_MMA(1, 1, At, B1); PG8_BAR;
            PG8_LDB(B0, 1, 0); PG8_SCHED; PG8_LDA(At, 1, 0); PG8_STAGEA(PG8_SA(0, 1), a2 + hstep);
            PG8_WAIT_L(8); PG8_BAR; PG8_WAIT_L(0); PG8_MMA(0, 0, At, B0); PG8_BAR; PG8_SCHED;
            PG8_LDB(B1, 1, 1); PG8_STAGEB(PG8_SB(1, 0), b3);
            PG8_BAR; PG8_WAIT_L(0); PG8_MMA(0, 1, At, B1); PG8_BAR;
            PG8_LDA(At, 1, 1); PG8_STAGEA(PG8_SA(1, 0), a3);
            PG8_BAR; PG8_WAIT_L(0); PG8_MMA(1, 0, At, B0); PG8_BAR; PG8_SCHED;
            PG8_STAGEB(PG8_SB(1, 1), b3 + hstep);
            PG8_WAIT_V(6); PG8_BAR; PG8_MMA(1, 1, At, B1); PG8_BAR;
            }
        }
        if constexpr (ALIGN_EPI) { if (wr == 0) PG8_BAR; }
        E(acc, cur, wr, wc, fr, fq); E.rgx(accx, cur, wr, wc, fr, fq);
        if (!has_next) break;
#pragma unroll
        for (int a = 0; a < 2; ++a)
#pragma unroll
            for (int b = 0; b < 2; ++b)
#pragma unroll
                for (int m = 0; m < 4; ++m)
#pragma unroll
                    for (int n = 0; n < 2; ++n) acc[a][b][m][n] = (f32x4){0.f, 0.f, 0.f, 0.f};
        accx[0] = (f32x4){0.f, 0.f, 0.f, 0.f}; accx[1] = (f32x4){0.f, 0.f, 0.f, 0.f};
        cur = nxt; cA = nA; cB = nB; cX = nX; ++ui;
        if constexpr (ALIGN_EPI) { if (wr == 1) PG8_BAR; }
    }
    PG8_WAIT_V(0);
    if constexpr (!ALIGN_EPI) { if (wr == 0) PG8_BAR; }
    PG8_BAR;
#undef PG8_SA
#undef PG8_SB
#undef PG8_STAGEA
#undef PG8_STAGEB
#undef PG8_SX
#undef PG8_STAGEX
#undef PG8_LDAX
#undef PG8_MMAX
#undef PG8_LDA
#undef PG8_LDB
#undef PG8_MMA
#undef PG8_WAIT_V
#undef PG8_WAIT_L
#undef PG8_BAR
#undef PG8_SCHED
}
}

#define GAS __attribute__((address_space(1)))
#define LAS __attribute__((address_space(3)))
typedef unsigned short bf16;
typedef unsigned v4u __attribute__((ext_vector_type(4)));
typedef float f32x4 __attribute__((ext_vector_type(4)));
typedef short bf16x8 __attribute__((ext_vector_type(8)));
typedef GAS unsigned gu32;
typedef GAS unsigned long long gu64;
#define RLX_AGENT __ATOMIC_RELAXED, __HIP_MEMORY_SCOPE_AGENT
#define LDS_WAIT() asm volatile("s_waitcnt lgkmcnt(0)" ::: "memory")
#define VM_WAIT() asm volatile("s_waitcnt vmcnt(0)" ::: "memory")
__device__ __forceinline__ unsigned long long rt() { return __builtin_amdgcn_s_memrealtime(); }
__device__ __forceinline__ unsigned f2bf(float f) { unsigned u = __builtin_bit_cast(unsigned, f); return (u + 0x7fffu + ((u >> 16) & 1u)) >> 16; }
__device__ __forceinline__ unsigned pk2(float lo, float hi) { return f2bf(lo) | (f2bf(hi) << 16); }

#define XB_TMO      128
#define XB_XCNT(j)  (256  + 64 * (j))
#define XB_XSUB(j)  (1280 + 64 * (j))
#define XB_XGEN(j)  (2304 + 64 * (j))
#define XB_TOP      3328
#define XB_TOPGEN   3392
#define XCD_BAR_WORDS 3456
#define XB_SPIN_CAP (1u << 18)

__device__ __forceinline__ unsigned xb_ld(unsigned* p)              { return __hip_atomic_load(p, __ATOMIC_RELAXED, __HIP_MEMORY_SCOPE_AGENT); }
__device__ __forceinline__ unsigned xb_add(unsigned* p, unsigned v) { return __hip_atomic_fetch_add(p, v, __ATOMIC_RELAXED, __HIP_MEMORY_SCOPE_AGENT); }
__device__ __forceinline__ unsigned xb_xcc_id() { return (unsigned)__builtin_amdgcn_s_getreg((3 << 11) | 20) & 0xFu; }
#define XB_SPIN(cond, bar) do { unsigned _sp = 0; while (cond) { __builtin_amdgcn_s_sleep(1); \
    if ((++_sp & 255u) == 0u) { if (xb_ld(&(bar)[XB_TMO])) break; if (_sp > XB_SPIN_CAP) { atomicAdd(&(bar)[XB_TMO], 1u); break; } } } } while (0)

struct XcdBarrier {
    unsigned* bar; unsigned x;
    volatile LAS unsigned* st;
};

__device__ __forceinline__ XcdBarrier xcd_barrier_post(unsigned* bar, volatile LAS unsigned* st) {
    XcdBarrier b; b.bar = bar; b.x = xb_xcc_id(); b.st = st;
    if (threadIdx.x == 0) (void)xb_add(&bar[XB_XCNT(b.x)], 1u);
    return b;
}
__device__ __forceinline__ void xcd_barrier_complete(unsigned* bar, unsigned x, unsigned& nloc, unsigned& nx) {
    const unsigned G = gridDim.x * gridDim.y * gridDim.z;
    unsigned sum, cnt, mine, sp = 0u;
    for (;;) {
        sum = 0u; cnt = 0u; mine = 0u;
#pragma unroll
        for (unsigned j = 0; j < 16; ++j) { const unsigned c = xb_ld(&bar[XB_XCNT(j)]); sum += c; cnt += (c > 0u) ? 1u : 0u; mine = (j == x) ? c : mine; }
        if (sum == G) break;
        __builtin_amdgcn_s_sleep(1);
        if ((++sp & 255u) == 0u) { if (xb_ld(&bar[XB_TMO])) break; if (sp > XB_SPIN_CAP) { atomicAdd(&bar[XB_TMO], 1u); break; } }
    }
    nloc = mine > 0u ? mine : 1u; nx = cnt > 0u ? cnt : 1u;
}

__device__ __forceinline__ void xcd_barrier(const XcdBarrier& b) {
    asm volatile("s_waitcnt vmcnt(0)" ::: "memory");
    __syncthreads();
    if (threadIdx.x == 0) {
        unsigned* bar = b.bar;
        __builtin_amdgcn_s_waitcnt(0);
        unsigned nloc = b.st[0], nx = b.st[1];
        if (nloc == 0u) { xcd_barrier_complete(bar, b.x, nloc, nx); b.st[0] = nloc; b.st[1] = nx; }
        const unsigned old = xb_add(&bar[XB_XSUB(b.x)], 1u);
        const unsigned gen = old / nloc;
        if (old + 1u == (gen + 1u) * nloc) {
            __builtin_amdgcn_fence(__ATOMIC_RELEASE, "agent");
            asm volatile("s_waitcnt vmcnt(0)" ::: "memory");
            const unsigned og = xb_add(&bar[XB_TOP], 1u);
            const unsigned tg = og / nx;
            if (og + 1u == (tg + 1u) * nx) xb_add(&bar[XB_TOPGEN], 1u);
            else XB_SPIN(xb_ld(&bar[XB_TOPGEN]) == tg, bar);
            __builtin_amdgcn_fence(__ATOMIC_ACQUIRE, "agent");
            xb_add(&bar[XB_XGEN(b.x)], 1u);
            asm volatile("s_waitcnt vmcnt(0)" ::: "memory");
        } else {
            XB_SPIN(xb_ld(&bar[XB_XGEN(b.x)]) == gen, bar);
            __builtin_amdgcn_fence(__ATOMIC_ACQUIRE, "agent");
            asm volatile("s_waitcnt vmcnt(0)" ::: "memory");
        }
    }
    __syncthreads();
}


constexpr int NWAVES = 8;
#ifndef MK_ONE_LAUNCH
#define MK_ONE_LAUNCH 1
#endif
constexpr int N_PHASES = 15;

constexpr int D = 1024, FF = 4096, MP = 8 * 2048, MS = 128 * 8, M = MP + MS;
constexpr int NG = 64, PS = 64, GS = 16;
constexpr float EPS = 1e-6f;
constexpr size_t O_Y = 0, O_SRP = (size_t)M * D, O_SIP = O_SRP + 8 * 4096, O_CP = O_SIP + 8 * 4096, O_SRS = O_CP + 8 * 2 * 1024, O_SIS = O_SRS + 128 * 4096, O_CS = O_SIS + 128 * 4096, O_END = O_CS + 128 * 2 * 1024;
static_assert(O_END == 19218432, "output size");

constexpr size_t MiB = 1u << 20;
constexpr size_t WS_CTL = 0, CTL_ZERO_BYTES = 1 * MiB;
constexpr size_t WS_SSQ = 1 * MiB;
constexpr size_t WS_SSMP = 2 * MiB;
constexpr size_t WS_WGU = 4 * MiB;
constexpr size_t WS_WD = 68 * MiB;
constexpr size_t WS_WGLU = 100 * MiB;
constexpr size_t WS_WIN = 104 * MiB;
constexpr size_t WS_WOUT = 110 * MiB;
constexpr size_t WS_X = 112 * MiB;
constexpr size_t WS_XB = 180 * MiB;
constexpr size_t WS_H = 214 * MiB;
constexpr size_t WS_G = WS_H, WS_Z = WS_H, WS_GB = WS_H + 34 * MiB, WS_A2 = WS_H + 68 * MiB;
constexpr size_t WS_SLAB = 350 * MiB;
constexpr size_t WS_END = 414 * MiB;
constexpr int CW_TMO = 0;
constexpr int CW_BAR = 4096;
constexpr int CW_SK = 16384;

constexpr int RING_OFF = 0, RING_BYTES = 131072 + 4096;
constexpr int LDSCTL_OFF = RING_BYTES, MISC_OFF = LDSCTL_OFF + 320;
constexpr int LDS_BYTES = 147456;

struct Frame {
    LAS unsigned char* lds;
    volatile LAS unsigned* MISC;
    gu32* ctl;
    int tid, lane, wave, vcu, G;
    const float* in[21]; float* out; unsigned char* ws;
};

__device__ __forceinline__ int opaque_i(int v) { asm volatile("" : "+v"(v)); return v; }
__device__ __forceinline__ float wave_sum(float v) {
#pragma unroll
    for (int o = 1; o < 64; o <<= 1) v += __shfl_xor(v, o);
    return v;
}
__device__ __forceinline__ float bf2f(unsigned short b) { return __builtin_bit_cast(float, (unsigned)b << 16); }

__device__ __forceinline__ void p0_transpose_item(const float* W, int K, int N, bf16* WT, const float* gk, int k0, int n0s, int n0d, LAS float* scr, int lane) {
#pragma unroll 8
    for (int i = 0; i < 32; ++i) { const int kk = 2 * i + (lane >> 5); float v = W[(size_t)(k0 + kk) * N + n0s + (lane & 31)]; if (gk) v *= gk[k0 + kk]; scr[kk * 33 + (lane & 31)] = v; }
    LDS_WAIT(); asm volatile("" ::: "memory");
    const int c = lane & 7;
#pragma unroll
    for (int j = 0; j < 4; ++j) { const int n = (lane >> 3) + 8 * j; const LAS float* s = scr + (8 * c) * 33 + n;
        v4u o; o.x = pk2(s[0 * 33], s[1 * 33]); o.y = pk2(s[2 * 33], s[3 * 33]); o.z = pk2(s[4 * 33], s[5 * 33]); o.w = pk2(s[6 * 33], s[7 * 33]);
        *(GAS v4u*)(WT + (size_t)(n0d + n) * K + k0 + 8 * c) = o; }
    LDS_WAIT(); asm volatile("" ::: "memory");
}
__device__ __forceinline__ int pair_src(int nd, int base, int hstride) { return base + ((nd >> 7) & 1) * hstride + 128 * (nd >> 8) + (nd & 127); }

__device__ __forceinline__ void p0_prologue(Frame& F) {
    LAS float* scr = (LAS float*)(F.lds + RING_OFF + F.wave * 16384);
    const int gw = F.vcu * NWAVES + F.wave, NGW = F.G * NWAVES, lane = opaque_i(F.lane);
    const float* norm_g = F.in[5];
    constexpr int I_GU = (D / 64) * (2 * FF / 32), I_D = (FF / 64) * (D / 32), I_GLU = (D / 64) * (2 * D / 32), I_IN = (D / 64) * (3 * D / 32), I_OUT = (D / 64) * (D / 32);
    constexpr int NITEMS = 4 * I_GU + 4 * I_D + I_GLU + I_IN + I_OUT;
    for (int it = gw; it < NITEMS; it += NGW) {
        int r = it;
        if (r < 4 * I_GU) { const int f = r / I_GU; r -= f * I_GU; const int nb = r % (2 * FF / 32), kb = r / (2 * FF / 32), nd = 32 * nb;
            const float* gk = norm_g + ((f >> 1) * 3 + (f & 1) * 2) * D;
            p0_transpose_item(F.in[7] + (size_t)f * D * 2 * FF, D, 2 * FF, (bf16*)(F.ws + WS_WGU) + (size_t)f * 2 * FF * D, gk, 64 * kb, pair_src(nd, 0, FF), nd, scr, lane); continue; }
        r -= 4 * I_GU;
        if (r < 4 * I_D) { const int f = r / I_D; r -= f * I_D; const int nb = r % (D / 32), kb = r / (D / 32), nd = 32 * nb;
            p0_transpose_item(F.in[8] + (size_t)f * FF * D, FF, D, (bf16*)(F.ws + WS_WD) + (size_t)f * D * FF, nullptr, 64 * kb, nd, nd, scr, lane); continue; }
        r -= 4 * I_D;
        if (r < I_GLU) { const int nb = r % (2 * D / 32), kb = r / (2 * D / 32), nd = 32 * nb;
            p0_transpose_item(F.in[17], D, 2 * D, (bf16*)(F.ws + WS_WGLU), nullptr, 64 * kb, pair_src(nd, 0, D), nd, scr, lane); continue; }
        r -= I_GLU;
        if (r < I_IN) { const int nb = r % (3 * D / 32), kb = r / (3 * D / 32), nd = 32 * nb;
            const int ns = nd < 2048 ? pair_src(nd, D, D) : nd - 2048;
            p0_transpose_item(F.in[18], D, 3 * D, (bf16*)(F.ws + WS_WIN), norm_g + 4 * D, 64 * kb, ns, nd, scr, lane); continue; }
        r -= I_IN;
        { const int nb = r % (D / 32), kb = r / (D / 32), nd = 32 * nb;
            p0_transpose_item(F.in[20], D, D, (bf16*)(F.ws + WS_WOUT), nullptr, 64 * kb, nd, nd, scr, lane); }
    }
    float* X = (float*)(F.ws + WS_X); bf16* XB = (bf16*)(F.ws + WS_XB); float* ssq = (float*)(F.ws + WS_SSQ);
    for (int m = gw; m < M; m += NGW) {
        const float* src = m < MP ? F.in[0] + (size_t)m * D : F.in[1] + (size_t)(m - MP) * D;
        const GAS f32x4* xr = (const GAS f32x4*)src + lane; GAS f32x4* xo = (GAS f32x4*)(X + (size_t)m * D) + lane;
        GAS unsigned long long* o8 = (GAS unsigned long long*)(XB + (size_t)m * D) + lane;
        float s = 0.f;
#pragma unroll
        for (int j = 0; j < 4; ++j) { const f32x4 v = xr[64 * j]; s += (v.x * v.x + v.y * v.y) + (v.z * v.z + v.w * v.w); xo[64 * j] = v;
            o8[64 * j] = (unsigned long long)pk2(v.x, v.y) | ((unsigned long long)pk2(v.z, v.w) << 32); }
        s = wave_sum(s);
        if (lane == 0) ssq[m] = s;
    }
    for (int i = gw * 64 + lane; i < 7 * M; i += NGW * 64) ssq[M + i] = 0.f;
    float* sp = (float*)(F.ws + WS_SSMP);
    for (int i = gw * 64 + lane; i < NG * PS; i += NGW * 64) {
        const int g = i / PS;
        const float lr = F.in[9][i], li = F.in[10][i], dt = expf(F.in[11][g]);
        const float mag = expf(lr * dt); float sn, cs; sincosf(li * dt, &sn, &cs);
        const float lbr = mag * cs, lbi = mag * sn, den = lr * lr + li * li, nr = lbr - 1.0f, ni = lbi;
        const float fr = (nr * lr + ni * li) / den, fi = (ni * lr - nr * li) / den;
        sp[i] = lbr; sp[4096 + i] = lbi;
#pragma unroll
        for (int c = 0; c < GS; ++c) { const float br = F.in[12][(size_t)i * GS + c], bi = F.in[13][(size_t)i * GS + c];
            sp[8192 + (size_t)i * GS + c] = fr * br - fi * bi; sp[8192 + 65536 + (size_t)i * GS + c] = fr * bi + fi * br; }
    }
}

__device__ __forceinline__ float gelu_tanh(float x) {
    const float a = 0.7978845608028654f * (x + 0.044715f * x * x * x);
    return x * __builtin_amdgcn_rcpf(1.0f + __builtin_amdgcn_exp2f(-2.0f * 1.4426950408889634f * a));
}

__device__ __forceinline__ void ssm_phase(Frame& F) {
    constexpr int TB = 8;
    LAS float* wl = (LAS float*)(F.lds + RING_OFF + F.wave * 16384);
    LAS float* hsr = wl; LAS float* hsi = wl + TB * 65; LAS float* cre = wl + 2 * TB * 65; LAS float* cim = cre + 16 * 65;
    const int gw = F.vcu * NWAVES + F.wave, NGW = F.G * NWAVES, lane = F.lane;
    const float* X = (const float*)(F.ws + WS_X); const float* ssq = (const float*)(F.ws + WS_SSQ) + 1 * M;
    const float* sp = (const float*)(F.ws + WS_SSMP); bf16* Gb = (bf16*)(F.ws + WS_G);
    const float* g1 = F.in[5] + 1 * D; const float* dsk = F.in[16];
    constexpr int NITEM = 8 * NG + 128 * NG;
    for (int it = gw; it < NITEM; it += NGW) {
        int seq, g, L, row0; const float *s0r = nullptr, *s0i = nullptr; float *outr, *outi;
        if (it < 8 * NG) { seq = it / NG; g = it % NG; L = 2048; row0 = seq * 2048; outr = F.out + O_SRP + (size_t)(seq * NG + g) * PS; outi = F.out + O_SIP + (size_t)(seq * NG + g) * PS; }
        else { const int j = it - 8 * NG; seq = j / NG; g = j % NG; L = 8; row0 = MP + seq * 8; s0r = F.in[2] + (size_t)(seq * NG + g) * PS; s0i = F.in[3] + (size_t)(seq * NG + g) * PS;
               outr = F.out + O_SRS + (size_t)(seq * NG + g) * PS; outi = F.out + O_SIS + (size_t)(seq * NG + g) * PS; }
        const int gp = g * PS + lane;
        const float lbr = sp[gp], lbi = sp[4096 + gp];
        float bbr[GS], bbi[GS];
#pragma unroll
        for (int c = 0; c < GS; ++c) { bbr[c] = sp[8192 + (size_t)gp * GS + c]; bbi[c] = sp[8192 + 65536 + (size_t)gp * GS + c]; }
#pragma unroll
        for (int c = 0; c < GS; ++c) { cre[c * 65 + lane] = F.in[14][((size_t)g * GS + c) * PS + lane]; cim[c * 65 + lane] = F.in[15][((size_t)g * GS + c) * PS + lane]; }
        float gn[GS];
#pragma unroll
        for (int c = 0; c < GS; ++c) gn[c] = g1[g * GS + c];
        float hr = s0r ? s0r[lane] : 0.f, hi = s0i ? s0i[lane] : 0.f;
        const int oc = lane & 15, otq = lane >> 4;
        const float dc = dsk[g * GS + oc], gc = g1[g * GS + oc];
        for (int t0 = 0; t0 < L; t0 += TB) {
#pragma unroll
            for (int tl = 0; tl < TB; ++tl) { const int row = row0 + t0 + tl; const float rs = __builtin_amdgcn_rsqf(ssq[row] * (1.0f / D) + EPS);
                const float* xr = X + (size_t)row * D + g * GS; float br = 0.f, bi = 0.f;
#pragma unroll
                for (int c = 0; c < GS; ++c) { const float uu = xr[c] * rs * gn[c]; br += bbr[c] * uu; bi += bbi[c] * uu; }
                const float nr = lbr * hr - lbi * hi + br, ni = lbr * hi + lbi * hr + bi; hr = nr; hi = ni;
                hsr[tl * 65 + lane] = hr; hsi[tl * 65 + lane] = hi; }
            LDS_WAIT(); __builtin_amdgcn_wave_barrier(); asm volatile("" ::: "memory");
#pragma unroll
            for (int j = 0; j < 2; ++j) { const int tl = otq * 2 + j; const int row = row0 + t0 + tl; float y = 0.f;
                for (int p = 0; p < PS; ++p) y += cre[oc * 65 + p] * hsr[tl * 65 + p] - cim[oc * 65 + p] * hsi[tl * 65 + p];
                const float rs = __builtin_amdgcn_rsqf(ssq[row] * (1.0f / D) + EPS);
                const float uu = X[(size_t)row * D + g * GS + oc] * rs * gc;
                y += dc * uu;
                Gb[(size_t)row * D + g * GS + oc] = (bf16)f2bf(gelu_tanh(y)); }
            LDS_WAIT(); __builtin_amdgcn_wave_barrier(); asm volatile("" ::: "memory");
        }
        outr[lane] = hr; outi[lane] = hi;
    }
}


typedef float f32x16 __attribute__((ext_vector_type(16)));
typedef unsigned u32x2v __attribute__((ext_vector_type(2)));
__device__ __forceinline__ unsigned cvtpk(float lo, float hi) { unsigned r; asm volatile("v_cvt_pk_bf16_f32 %0, %1, %2" : "=v"(r) : "v"(lo), "v"(hi)); return r; }
__device__ __forceinline__ bf16x8 pack8(const float* v) { v4u w; w.x = cvtpk(v[0], v[1]); w.y = cvtpk(v[2], v[3]); w.z = cvtpk(v[4], v[5]); w.w = cvtpk(v[6], v[7]); return __builtin_bit_cast(bf16x8, w); }
constexpr int SSM_ROWB = 272;

__device__ __forceinline__ void ssm_phase_fast(Frame& F) {
    LAS unsigned char* img = F.lds + RING_OFF + F.wave * 16384;
    const int lane = opaque_i(F.lane), G = F.G, gq = F.wave * G + F.vcu, NGQ = NWAVES * G;
    const float* X = (const float*)(F.ws + WS_X); const float* ssq = (const float*)(F.ws + WS_SSQ) + 1 * M;
    const float* sp = (const float*)(F.ws + WS_SSMP); bf16* Gb = (bf16*)(F.ws + WS_G);
    const float* g1 = F.in[5] + 1 * D; const float* dsk = F.in[16];
    constexpr int NPI = 8 * NG, NSB = (MS / 32) * NG, NITEM = NPI + NSB;
    const int l31 = lane & 31, h = lane >> 5, l15 = lane & 15, q4 = lane >> 4;
    for (int it = gq; it < NITEM; it += NGQ) {
        const bool sample = it >= NPI;
        int g, row_base, nblk, seq0;
        if (!sample) { seq0 = it / NG; g = it % NG; row_base = seq0 * 2048; nblk = 64; }
        else { const int j = it - NPI; const int rb = j / NG; g = j % NG; row_base = MP + rb * 32; nblk = 1; seq0 = rb * 4; }
        bf16x8 bbq[4];
#pragma unroll
        for (int q = 0; q < 4; ++q) { const int p = 32 * (q & 1) + l31; const float* src = sp + 8192 + (q >> 1) * 65536 + ((size_t)(g * PS + p) * GS + 8 * h);
            float v[8];
#pragma unroll
            for (int j = 0; j < 8; ++j) v[j] = src[j] * g1[g * GS + 8 * h + j];
            bbq[q] = pack8(v); }
        bf16x8 cm[4];
#pragma unroll
        for (int ks = 0; ks < 4; ++ks) { const int p0 = 16 * ks + 4 * q4; const float* cr = F.in[14] + ((size_t)(g * GS + l15) * PS + p0); const float* ci = F.in[15] + ((size_t)(g * GS + l15) * PS + p0);
            float v[8];
#pragma unroll
            for (int j = 0; j < 4; ++j) { v[2 * j] = cr[j]; v[2 * j + 1] = -ci[j]; }
            cm[ks] = pack8(v); }
        float dg[4];
#pragma unroll
        for (int e = 0; e < 4; ++e) dg[e] = dsk[g * GS + 4 * q4 + e] * g1[g * GS + 4 * q4 + e];
        const float lbr = sp[g * PS + lane], lbi = sp[4096 + g * PS + lane];
        float hr = 0.f, hi = 0.f;
        float s0r[4], s0i[4];
        if (sample) {
#pragma unroll
            for (int i = 0; i < 4; ++i) { s0r[i] = F.in[2][((size_t)(seq0 + i) * NG + g) * PS + lane]; s0i[i] = F.in[3][((size_t)(seq0 + i) * NG + g) * PS + lane]; } }
        else {
#pragma unroll
            for (int i = 0; i < 4; ++i) { s0r[i] = 0.f; s0i[i] = 0.f; } }
        f32x4 xa0, xa1, xe0, xe1; float qa, qe0, qe1;
#define SSM_LOAD(b) do { const int rowA = row_base + 32 * (b) + l31; const float* pa = X + (size_t)rowA * D + g * GS + 8 * h; xa0 = *(const f32x4*)pa; xa1 = *(const f32x4*)(pa + 4); qa = ssq[rowA]; \
            const int rowE = row_base + 32 * (b) + l15; xe0 = *(const f32x4*)(X + (size_t)rowE * D + g * GS + 4 * q4); xe1 = *(const f32x4*)(X + (size_t)(rowE + 16) * D + g * GS + 4 * q4); qe0 = ssq[rowE]; qe1 = ssq[rowE + 16]; } while (0)
        SSM_LOAD(0);
        for (int b = 0; b < nblk; ++b) {
            const f32x4 ca0 = xa0, ca1 = xa1, ce0 = xe0, ce1 = xe1; const float cqa = qa, cqe0 = qe0, cqe1 = qe1;
            if (b + 1 < nblk) SSM_LOAD(b + 1);
            const float rsa = __builtin_amdgcn_rsqf(cqa * (1.0f / D) + EPS);
            float ua[8];
#pragma unroll
            for (int j = 0; j < 4; ++j) { ua[j] = ca0[j] * rsa; ua[4 + j] = ca1[j] * rsa; }
            const bf16x8 ufrag = pack8(ua);
            const f32x16 zero16 = {0.f, 0.f, 0.f, 0.f, 0.f, 0.f, 0.f, 0.f, 0.f, 0.f, 0.f, 0.f, 0.f, 0.f, 0.f, 0.f};
            f32x16 Xr = __builtin_amdgcn_mfma_f32_32x32x16_bf16(ufrag, bbq[0], zero16, 0, 0, 0);
            f32x16 Yr = __builtin_amdgcn_mfma_f32_32x32x16_bf16(ufrag, bbq[1], zero16, 0, 0, 0);
            f32x16 Xi = __builtin_amdgcn_mfma_f32_32x32x16_bf16(ufrag, bbq[2], zero16, 0, 0, 0);
            f32x16 Yi = __builtin_amdgcn_mfma_f32_32x32x16_bf16(ufrag, bbq[3], zero16, 0, 0, 0);
#pragma unroll
            for (int r = 0; r < 16; ++r) {
                auto s1 = __builtin_amdgcn_permlane32_swap(__float_as_uint(Xr[r]), __float_as_uint(Yr[r]), false, false); Xr[r] = __uint_as_float(s1[0]); Yr[r] = __uint_as_float(s1[1]);
                auto s2 = __builtin_amdgcn_permlane32_swap(__float_as_uint(Xi[r]), __float_as_uint(Yi[r]), false, false); Xi[r] = __uint_as_float(s2[0]); Yi[r] = __uint_as_float(s2[1]); }
#pragma unroll
            for (int i = 0; i < 4; ++i) {
                if (sample) { hr = s0r[i]; hi = s0i[i]; }
#pragma unroll
                for (int s = 0; s < 2; ++s)
#pragma unroll
                    for (int e = 0; e < 4; ++e) { const int r = 4 * i + e; const float br = s ? Yr[r] : Xr[r], bi = s ? Yi[r] : Xi[r];
                        const float nr = lbr * hr - lbi * hi + br, ni = lbr * hi + lbi * hr + bi; hr = nr; hi = ni;
                        *(LAS unsigned*)(img + (8 * i + 4 * s + e) * SSM_ROWB + 4 * lane) = cvtpk(hr, hi); }
                if (sample) { F.out[O_SRS + ((size_t)(seq0 + i) * NG + g) * PS + lane] = hr; F.out[O_SIS + ((size_t)(seq0 + i) * NG + g) * PS + lane] = hi; }
            }
            f32x4 acc0 = {0.f, 0.f, 0.f, 0.f}, acc1 = {0.f, 0.f, 0.f, 0.f};
#pragma unroll
            for (int ks = 0; ks < 4; ++ks) {
                const bf16x8 b0 = *(const LAS bf16x8*)(img + l15 * SSM_ROWB + 64 * ks + 16 * q4);
                const bf16x8 b1 = *(const LAS bf16x8*)(img + (16 + l15) * SSM_ROWB + 64 * ks + 16 * q4);
                acc0 = __builtin_amdgcn_mfma_f32_16x16x32_bf16(cm[ks], b0, acc0, 0, 0, 0);
                acc1 = __builtin_amdgcn_mfma_f32_16x16x32_bf16(cm[ks], b1, acc1, 0, 0, 0); }
            const float rse0 = __builtin_amdgcn_rsqf(cqe0 * (1.0f / D) + EPS), rse1 = __builtin_amdgcn_rsqf(cqe1 * (1.0f / D) + EPS);
            float o0[4], o1[4];
#pragma unroll
            for (int e = 0; e < 4; ++e) { o0[e] = gelu_tanh(acc0[e] + dg[e] * ce0[e] * rse0); o1[e] = gelu_tanh(acc1[e] + dg[e] * ce1[e] * rse1); }
            const int rowE = row_base + 32 * b + l15;
            u32x2v w0, w1; w0.x = cvtpk(o0[0], o0[1]); w0.y = cvtpk(o0[2], o0[3]); w1.x = cvtpk(o1[0], o1[1]); w1.y = cvtpk(o1[2], o1[3]);
            *(u32x2v*)(Gb + (size_t)rowE * D + g * GS + 4 * q4) = w0;
            *(u32x2v*)(Gb + (size_t)(rowE + 16) * D + g * GS + 4 * q4) = w1;
        }
#undef SSM_LOAD
        if (!sample) { F.out[O_SRP + ((size_t)seq0 * NG + g) * PS + lane] = hr; F.out[O_SIP + ((size_t)seq0 * NG + g) * PS + lane] = hi; }
    }
}

__device__ __forceinline__ void conv_phase(Frame& F) {
    const bf16* Z = (const bf16*)(F.ws + WS_Z); const bf16* GBp = (const bf16*)(F.ws + WS_GB); bf16* A2 = (bf16*)(F.ws + WS_A2);
    const float* cw = F.in[19]; const float* cache = F.in[4];
    const int gt = (F.vcu * NWAVES + F.wave) * 64 + opaque_i(F.lane), NGT = F.G * NWAVES * 64;
    for (int it = gt; it < M * (D / 8); it += NGT) {
        const int row = it >> 7, c0 = (it & 127) * 8;
        int t; const float* cb = nullptr;
        if (row < MP) t = row & 2047; else { const int r2 = row - MP; t = r2 & 7; cb = cache + (size_t)(r2 >> 3) * 2 * D; }
        float z0[8], z1[8], z2[8], gb[8];
        { const v4u v = *(const GAS v4u*)(Z + (size_t)row * D + c0); const v4u q = *(const GAS v4u*)(GBp + (size_t)row * D + c0);
#pragma unroll
          for (int e = 0; e < 4; ++e) { z2[2 * e] = __builtin_bit_cast(float, v[e] << 16); z2[2 * e + 1] = __builtin_bit_cast(float, v[e] & 0xffff0000u);
                                        gb[2 * e] = __builtin_bit_cast(float, q[e] << 16); gb[2 * e + 1] = __builtin_bit_cast(float, q[e] & 0xffff0000u); } }
        if (t >= 1) { const v4u v = *(const GAS v4u*)(Z + (size_t)(row - 1) * D + c0);
#pragma unroll
          for (int e = 0; e < 4; ++e) { z1[2 * e] = __builtin_bit_cast(float, v[e] << 16); z1[2 * e + 1] = __builtin_bit_cast(float, v[e] & 0xffff0000u); } }
        else {
#pragma unroll
          for (int e = 0; e < 8; ++e) z1[e] = cb ? cb[D + c0 + e] : 0.f; }
        if (t >= 2) { const v4u v = *(const GAS v4u*)(Z + (size_t)(row - 2) * D + c0);
#pragma unroll
          for (int e = 0; e < 4; ++e) { z0[2 * e] = __builtin_bit_cast(float, v[e] << 16); z0[2 * e + 1] = __builtin_bit_cast(float, v[e] & 0xffff0000u); } }
        else {
#pragma unroll
          for (int e = 0; e < 8; ++e) z0[e] = cb ? cb[t * D + c0 + e] : 0.f; }
        float o[8];
#pragma unroll
        for (int e = 0; e < 8; ++e) o[e] = gb[e] * (cw[c0 + e] * z0[e] + cw[D + c0 + e] * z1[e] + cw[2 * D + c0 + e] * z2[e]);
        v4u w; w.x = pk2(o[0], o[1]); w.y = pk2(o[2], o[3]); w.z = pk2(o[4], o[5]); w.w = pk2(o[6], o[7]);
        *(GAS v4u*)(A2 + (size_t)row * D + c0) = w;
    }
}

__device__ __forceinline__ void final_phase(Frame& F) {
    const float* X = (const float*)(F.ws + WS_X); const float* ssq = (const float*)(F.ws + WS_SSQ) + 6 * M; const float* fg = F.in[6];
    const int gw = F.vcu * NWAVES + F.wave, NGW = F.G * NWAVES, lane = opaque_i(F.lane);
    f32x4 gv[4];
#pragma unroll
    for (int j = 0; j < 4; ++j) gv[j] = ((const GAS f32x4*)fg)[lane + 64 * j];
    for (int m = gw; m < M; m += NGW) {
        const float rs = __builtin_amdgcn_rsqf(ssq[m] * (1.0f / D) + EPS);
        const GAS f32x4* xr = (const GAS f32x4*)(X + (size_t)m * D) + lane; GAS f32x4* yo = (GAS f32x4*)(F.out + O_Y + (size_t)m * D) + lane;
#pragma unroll
        for (int j = 0; j < 4; ++j) yo[64 * j] = xr[64 * j] * rs * gv[j];
    }
}

struct Args { const float* in[21]; float* out; unsigned char* ws; int ph_lo, ph_hi; };
__global__ void __launch_bounds__(NWAVES * 64, 2) skel_fwd(Args args) {
    extern __shared__ __attribute__((aligned(16))) unsigned char lds[];
    Frame F;
    F.lds = (LAS unsigned char*)lds;
    F.MISC = (volatile LAS unsigned*)(F.lds + MISC_OFF);
    F.tid = threadIdx.x; F.lane = F.tid & 63; F.wave = __builtin_amdgcn_readfirstlane(F.tid >> 6);
    F.G = gridDim.x; { const int bx = blockIdx.x; F.vcu = (F.G % 8 == 0) ? (bx % 8) * (F.G / 8) + bx / 8 : bx; }
    F.ws = args.ws; F.out = args.out; F.ctl = (gu32*)(args.ws + WS_CTL);
#pragma unroll
    for (int i = 0; i < 21; ++i) F.in[i] = args.in[i];
    for (int u = F.tid; u < (LDS_BYTES - LDSCTL_OFF) / 4; u += NWAVES * 64) ((LAS unsigned*)(F.lds + LDSCTL_OFF))[u] = 0u;
    __syncthreads();
    XcdBarrier bar; bar.bar = (unsigned*)(F.ctl + CW_BAR); bar.x = 0; bar.st = nullptr;
    if (MK_ONE_LAUNCH) bar = xcd_barrier_post((unsigned*)(F.ctl + CW_BAR), F.MISC + 8);
    const int lo = args.ph_lo, hi = args.ph_hi;
#define IN(k) (lo <= (k) && (k) < hi)
#if defined(PROBE_A_LO)
#define STAMP(k) do { if (blockIdx.x == 0 && F.tid == 0) { const unsigned long long t_ = __builtin_amdgcn_s_memrealtime(); F.MISC[16 + 2 * (k)] = (unsigned)t_; F.MISC[17 + 2 * (k)] = (unsigned)(t_ >> 32); } } while (0)
#else
#define STAMP(k) do { } while (0)
#endif
    STAMP(0);
#define SEAM(k) do { if (MK_ONE_LAUNCH && IN((k) + 1)) xcd_barrier(bar); STAMP((k) + 1); } while (0)
    bf16* XB = (bf16*)(F.ws + WS_XB); bf16* H = (bf16*)(F.ws + WS_H); float* X = (float*)(F.ws + WS_X); float* ssq = (float*)(F.ws + WS_SSQ);
    const int bx = (int)blockIdx.x;

    if (IN(0)) { p0_prologue(F); SEAM(0); }
#define FFN_GU(ph, f, sin) if (IN(ph)) { pg8::Gemm g{XB, (const bf16*)(F.ws + WS_WGU) + (size_t)(f) * 2 * FF * D, M, 2 * FF, D}; pg8::StaticOrder S; S.init(MP, 2 * FF, F.G, bx); \
        pg8::EpiGateUp E{H, FF, ssq + (size_t)(sin) * M}; pg8::gemm_phase<pg8::EpiGateUp, pg8::StaticOrder, true, true>(F.lds + RING_OFF, g, S, E); SEAM(ph); }
#define FFN_DN(ph, f, sout) if (IN(ph)) { pg8::Gemm g{H, (const bf16*)(F.ws + WS_WD) + (size_t)(f) * D * FF, M, D, FF}; pg8::StaticOrder S; S.init(MP, D, F.G, bx); \
        pg8::EpiResid<0> E{X, XB, ssq + (size_t)(sout) * M, 0.5f}; pg8::gemm_phase<pg8::EpiResid<0>, pg8::StaticOrder, true, true>(F.lds + RING_OFF, g, S, E); SEAM(ph); }
    FFN_GU(1, 0, 0)
    FFN_DN(2, 0, 1)
    if (IN(3)) { ssm_phase_fast(F); SEAM(3); }
    if (IN(4)) { pg8::Gemm g{(const bf16*)(F.ws + WS_G), (const bf16*)(F.ws + WS_WGLU), M, 2 * D, D}; pg8::StaticOrder S; S.init(MP, 2 * D, F.G, bx);
        pg8::EpiResid<1> E{X, XB, ssq + (size_t)2 * M, 1.0f}; pg8::gemm_phase<pg8::EpiResid<1>, pg8::StaticOrder, true, true>(F.lds + RING_OFF, g, S, E); SEAM(4); }
    FFN_GU(5, 1, 2)
    FFN_DN(6, 1, 3)
    FFN_GU(7, 2, 3)
    FFN_DN(8, 2, 4)
    if (IN(9)) { pg8::Gemm g{XB, (const bf16*)(F.ws + WS_WIN), M, 3 * D, D}; pg8::StaticOrder S; S.init(MP, 3 * D, F.G, bx);
        pg8::EpiConvIn E{(bf16*)(F.ws + WS_Z), (bf16*)(F.ws + WS_GB), ssq + (size_t)4 * M, F.out + O_CP, F.out + O_CS};
        pg8::gemm_phase<pg8::EpiConvIn, pg8::StaticOrder, true, true>(F.lds + RING_OFF, g, S, E); SEAM(9); }
    if (IN(10)) { conv_phase(F); SEAM(10); }
    if (IN(11)) { pg8::Gemm g{(const bf16*)(F.ws + WS_A2), (const bf16*)(F.ws + WS_WOUT), M, D, D}; pg8::StaticOrder S; S.init(MP, D, F.G, bx);
        pg8::EpiResid<0> E{X, XB, ssq + (size_t)5 * M, 1.0f}; pg8::gemm_phase<pg8::EpiResid<0>, pg8::StaticOrder, true, true>(F.lds + RING_OFF, g, S, E); SEAM(11); }
    FFN_GU(12, 3, 5)
    FFN_DN(13, 3, 6)
    if (IN(14)) { final_phase(F); }
#if defined(PROBE_DRY)
    xcd_barrier(bar); STAMP(15);
    { pg8::Gemm g{XB, (const bf16*)(F.ws + WS_WGU), M, 2 * FF, D}; pg8::StaticOrder S; S.init(MP, 2 * FF, F.G, bx);
      pg8::EpiNull E{H + (size_t)M * FF - 1}; pg8::gemm_phase<pg8::EpiNull, pg8::StaticOrder, true, true>(F.lds + RING_OFF, g, S, E); }
    xcd_barrier(bar); STAMP(16);
#endif
#if defined(PROBE_A_LO)
    __syncthreads();
    if (blockIdx.x == 0 && F.tid == 0) {
#define TS(k) ((unsigned long long)F.MISC[16 + 2 * (k)] | ((unsigned long long)F.MISC[17 + 2 * (k)] << 32))
        const unsigned long long ta = TS(PROBE_A_HI) - TS(PROBE_A_LO), tb = TS(PROBE_B_HI) - TS(PROBE_B_LO);
        F.out[0] += (float)tb * 1e-5f;
        const unsigned long long t0 = __builtin_amdgcn_s_memrealtime();
        while (__builtin_amdgcn_s_memrealtime() - t0 < ta * 4ull) __builtin_amdgcn_s_sleep(8);
    }
#endif
#undef IN
#undef SEAM
}

extern "C" void kernel_launch(void* const* d_in, const int* in_sizes, int n_in, void* d_out, int out_size, void* d_ws, size_t ws_size, hipStream_t stream) {
    static int grid = 0;
    if (grid == 0) {
        if (n_in != 21 || out_size != (int)O_END || ws_size < WS_END) { fprintf(stderr, "kernel_launch: unexpected shapes: n_in %d out %d ws %zu; nothing launched\n", n_in, out_size, ws_size); grid = -1; return; }
        int dev = 0, cus = 0, per_cu = 0;
        if (hipGetDevice(&dev) != hipSuccess || hipDeviceGetAttribute(&cus, hipDeviceAttributeMultiprocessorCount, dev) != hipSuccess) { grid = -1; return; }
        if (hipFuncSetAttribute((const void*)skel_fwd, hipFuncAttributeMaxDynamicSharedMemorySize, LDS_BYTES) != hipSuccess) { fprintf(stderr, "kernel_launch: hipFuncSetAttribute failed\n"); grid = -1; return; }
        if (hipOccupancyMaxActiveBlocksPerMultiprocessor(&per_cu, (const void*)skel_fwd, NWAVES * 64, LDS_BYTES) != hipSuccess || per_cu < 1) fprintf(stderr, "kernel_launch: occupancy query reports %d\n", per_cu);
        (void)hipGetLastError();
        grid = cus;
    }
    if (grid < 0) return;
    if (hipMemsetAsync((char*)d_ws + WS_CTL, 0, CTL_ZERO_BYTES, stream) != hipSuccess) return;
    Args a{};
    for (int i = 0; i < 21; ++i) a.in[i] = (const float*)d_in[i];
    a.out = (float*)d_out; a.ws = (unsigned char*)d_ws;
#if MK_ONE_LAUNCH
    a.ph_lo = 0; a.ph_hi = N_PHASES;
    hipLaunchKernelGGL(skel_fwd, dim3(grid), dim3(NWAVES * 64), LDS_BYTES, stream, a);
#else
    for (int p = 0; p < N_PHASES; ++p) { a.ph_lo = p; a.ph_hi = p + 1; hipLaunchKernelGGL(skel_fwd, dim3(grid), dim3(NWAVES * 64), LDS_BYTES, stream, a); }
#endif
}
```

```cpp
#include <hip/hip_runtime.h>
#include <cstdio>
#include <cstdint>
namespace pg8 {
#define PG8_LAS __attribute__((address_space(3)))
typedef unsigned short bf16_t;
typedef short bf16x8 __attribute__((ext_vector_type(8)));
typedef float f32x4 __attribute__((ext_vector_type(4)));
typedef unsigned u32x4 __attribute__((ext_vector_type(4)));
constexpr int BM = 256, BK = 64, HALF = 128, HTB = HALF * BK * 2  , STAGE_BYTES = 8 * HTB, NXCD = 8, WGM = 8;

__host__ __device__ __forceinline__ int lds_byte(int r, int c) { const int st = (r >> 4) * 2 + (c >> 5), rr = r & 15, cc = c & 31, ob = rr * 64 + cc * 2; return st * 1024 + (ob ^ (((ob >> 9) & 1) << 5)); }
__host__ __device__ __forceinline__ void stage_rc(int b, int& R, int& C) { const int st = b / 1024, sb = b % 1024, swz = sb ^ (((sb >> 9) & 1) << 5); R = (st >> 1) * 16 + swz / 64; C = (st & 1) * 32 + (swz % 64) / 2; }
__host__ __device__ __forceinline__ int perm32(int rho) { const int n = rho >> 4, i = rho & 15; return 8 * (i >> 2) + 4 * n + (i & 3); }

struct Unit { int pm, pn; };
struct Gemm { const bf16_t* A; const bf16_t* Bt; int M, N, K; };

struct StaticOrder {
    int nM, nN, nwg, G, c;
    __host__ __device__ void init(int M, int N, int G_, int c_) { nM = M / BM; nN = N / BM; nwg = nM * nN; G = G_; c = c_; }
    __host__ __device__ bool next(int i, Unit& u) const {
        const long L = (long)i * G + c; if (L >= nwg) return false;
        int wgid = (int)L; { const int q = nwg / NXCD, r = nwg % NXCD, xcd = wgid % NXCD, off = wgid / NXCD; wgid = (xcd < r ? xcd * (q + 1) : r * (q + 1) + (xcd - r) * q) + off; }
        const int nig = WGM * nN, gid = wgid / nig, fm = gid * WGM, gsz = (nM - fm) < WGM ? (nM - fm) : WGM;
        u.pm = fm + ((wgid % nig) % gsz); u.pn = (wgid % nig) / gsz; return true;
    }
    __device__ __forceinline__ void a_ready(const Unit&) const {}
    __device__ __forceinline__ void done(const Unit&) const {}
};


__device__ __forceinline__ unsigned cvt_pk_bf16(float lo, float hi) { unsigned r; asm volatile("v_cvt_pk_bf16_f32 %0, %1, %2" : "=v"(r) : "v"(lo), "v"(hi)); return r; }

typedef unsigned u32x2 __attribute__((ext_vector_type(2)));
constexpr float RMS_EPS = 1e-6f;
constexpr float INV_D = 1.0f / 1024.0f;
__device__ __forceinline__ float sigmoid_f(float x) { return __builtin_amdgcn_rcpf(1.0f + __builtin_amdgcn_exp2f(-1.4426950408889634f * x)); }
__device__ __forceinline__ float rstd_of(float ssq) { return __builtin_amdgcn_rsqf(ssq * INV_D + RMS_EPS); }
#define PG8_EPI_CALL() \
    __device__ __forceinline__ void operator()(const f32x4 (&acc)[2][2][4][2], const Unit& u, int wr, int wc, int fr, int fq) const { \
        _Pragma("unroll") for (int ai = 0; ai < 2; ++ai) _Pragma("unroll") for (int m = 0; m < 4; ++m) { \
            const f32x4 a[2][2] = {{acc[ai][0][m][0], acc[ai][0][m][1]}, {acc[ai][1][m][0], acc[ai][1][m][1]}}; rg(a, u, ai, m, 3, wr, wc, fr, fq); } }

struct EpiGateUp {
    static constexpr bool PERM = true, AFTER_DRAIN = false;
    bf16_t* H; int ldh; const float* ssq;
    __device__ __forceinline__ void rg(const f32x4 (&a)[2][2], const Unit& u, int ai, int m, int bjmask, int wr, int wc, int fr, int fq) const {
        const int row = u.pm * BM + ai * HALF + wr * 64 + m * 16 + fr, col0 = u.pn * HALF + wc * 32 + 8 * fq;
        const float rs = rstd_of(ssq[row]);
        float h[8];
#pragma unroll
        for (int n = 0; n < 2; ++n)
#pragma unroll
            for (int e = 0; e < 4; ++e) { const float g = a[0][n][e] * rs, up = a[1][n][e] * rs; h[4 * n + e] = g * sigmoid_f(g) * up; }
        u32x4 w; w.x = cvt_pk_bf16(h[0], h[1]); w.y = cvt_pk_bf16(h[2], h[3]); w.z = cvt_pk_bf16(h[4], h[5]); w.w = cvt_pk_bf16(h[6], h[7]);
        *(u32x4*)(H + (size_t)row * ldh + col0) = w;
    }
    __device__ __forceinline__ void rgx(const f32x4 (&ax)[2], const Unit& u, int wr, int wc, int fr, int fq) const {
        const int row = 16384 + 16 * u.pm + fr, col0 = u.pn * HALF + wc * 32 + 8 * fq + 4 * wr;
        const float rs = rstd_of(ssq[row]);
        float h[4];
#pragma unroll
        for (int e = 0; e < 4; ++e) { const float g = ax[0][e] * rs, up = ax[1][e] * rs; h[e] = g * sigmoid_f(g) * up; }
        u32x2 w; w.x = cvt_pk_bf16(h[0], h[1]); w.y = cvt_pk_bf16(h[2], h[3]);
        *(u32x2*)(H + (size_t)row * ldh + col0) = w;
    }
    PG8_EPI_CALL()
};

template <int MODE> struct EpiResid {
    static constexpr bool PERM = true, AFTER_DRAIN = false;
    const float* xin_p; const float* xin_s; float* X; bf16_t* XB; float* ssq; float scale;
    __device__ __forceinline__ void rg(const f32x4 (&a)[2][2], const Unit& u, int ai, int m, int bjmask, int wr, int wc, int fr, int fq) const {
        const int row = u.pm * BM + ai * HALF + wr * 64 + m * 16 + fr;
        const int col0 = (MODE == 0 ? u.pn * BM : u.pn * HALF) + wc * 32 + 8 * fq;
        float sq = 0.f;
#pragma unroll
        for (int bj = 0; bj < (MODE == 0 ? 2 : 1); ++bj) {
            if (MODE == 0 && !((bjmask >> bj) & 1)) continue;
            float* xp = X + (size_t)row * 1024 + col0 + bj * HALF; const float* xi = xin_p + (size_t)row * 1024 + col0 + bj * HALF;
            f32x4 x0 = *(const f32x4*)xi, x1 = *(const f32x4*)(xi + 4);
            if (MODE == 0) { x0 += a[bj][0] * scale; x1 += a[bj][1] * scale; }
            else {
#pragma unroll
                for (int e = 0; e < 4; ++e) { x0[e] += a[0][0][e] * sigmoid_f(a[1][0][e]); x1[e] += a[0][1][e] * sigmoid_f(a[1][1][e]); } }
            *(f32x4*)xp = x0; *(f32x4*)(xp + 4) = x1;
            u32x4 w; w.x = cvt_pk_bf16(x0[0], x0[1]); w.y = cvt_pk_bf16(x0[2], x0[3]); w.z = cvt_pk_bf16(x1[0], x1[1]); w.w = cvt_pk_bf16(x1[2], x1[3]);
            *(u32x4*)(XB + (size_t)row * 1024 + col0 + bj * HALF) = w;
            sq += (x0[0] * x0[0] + x0[1] * x0[1]) + (x0[2] * x0[2] + x0[3] * x0[3]) + (x1[0] * x1[0] + x1[1] * x1[1]) + (x1[2] * x1[2] + x1[3] * x1[3]); }
        sq += __shfl_xor(sq, 16); sq += __shfl_xor(sq, 32);
        if (fq == 0) atomicAdd(ssq + row, sq);
    }
    __device__ __forceinline__ void rgx(const f32x4 (&ax)[2], const Unit& u, int wr, int wc, int fr, int fq) const {
        const int row = 16384 + 16 * u.pm + fr;
        const int col0 = (MODE == 0 ? u.pn * BM : u.pn * HALF) + wc * 32 + 8 * fq + 4 * wr;
        float sq = 0.f;
#pragma unroll
        for (int bj = 0; bj < (MODE == 0 ? 2 : 1); ++bj) {
            float* xp = X + (size_t)row * 1024 + col0 + bj * HALF; const float* xi = xin_s + (size_t)(16 * u.pm + fr) * 1024 + col0 + bj * HALF;
            f32x4 x0 = *(const f32x4*)xi;
            if (MODE == 0) x0 += ax[bj] * scale;
            else {
#pragma unroll
                for (int e = 0; e < 4; ++e) x0[e] += ax[0][e] * sigmoid_f(ax[1][e]); }
            *(f32x4*)xp = x0;
            u32x2 w; w.x = cvt_pk_bf16(x0[0], x0[1]); w.y = cvt_pk_bf16(x0[2], x0[3]);
            *(u32x2*)(XB + (size_t)row * 1024 + col0 + bj * HALF) = w;
            sq += (x0[0] * x0[0] + x0[1] * x0[1]) + (x0[2] * x0[2] + x0[3] * x0[3]); }
        sq += __shfl_xor(sq, 16); sq += __shfl_xor(sq, 32);
        if (fq == 0) atomicAdd(ssq + row, sq);
    }
    PG8_EPI_CALL()
};

struct EpiConvIn {
    static constexpr bool PERM = true, AFTER_DRAIN = false;
    bf16_t* Z; bf16_t* GB; const float* ssq; float* conv_p; float* conv_s;
    __device__ __forceinline__ void rg(const f32x4 (&a)[2][2], const Unit& u, int ai, int m, int bjmask, int wr, int wc, int fr, int fq) const {
        const int row = u.pm * BM + ai * HALF + wr * 64 + m * 16 + fr;
        const float rs = rstd_of(ssq[row]);
        if (u.pn < 8) {
            const int col0 = u.pn * HALF + wc * 32 + 8 * fq; const float rs2 = rs * rs;
            const f32x4 z0 = a[0][0] * a[1][0] * rs2, z1 = a[0][1] * a[1][1] * rs2;
            u32x4 w; w.x = cvt_pk_bf16(z0[0], z0[1]); w.y = cvt_pk_bf16(z0[2], z0[3]); w.z = cvt_pk_bf16(z1[0], z1[1]); w.w = cvt_pk_bf16(z1[2], z1[3]);
            *(u32x4*)(Z + (size_t)row * 1024 + col0) = w;
            float* cp = nullptr;
            if (row < 16384) { const int t = row & 2047; if (t >= 2046) cp = conv_p + ((size_t)(row >> 11) * 2 + (t - 2046)) * 1024 + col0; }
            else { const int r2 = row - 16384, t = r2 & 7; if (t >= 6) cp = conv_s + ((size_t)(r2 >> 3) * 2 + (t - 6)) * 1024 + col0; }
            if (cp) { *(f32x4*)cp = z0; *(f32x4*)(cp + 4) = z1; }
        } else {
            const int col0 = (u.pn - 8) * BM + wc * 32 + 8 * fq;
#pragma unroll
            for (int bj = 0; bj < 2; ++bj) { const f32x4 g0 = a[bj][0] * rs, g1 = a[bj][1] * rs;
                u32x4 w; w.x = cvt_pk_bf16(g0[0], g0[1]); w.y = cvt_pk_bf16(g0[2], g0[3]); w.z = cvt_pk_bf16(g1[0], g1[1]); w.w = cvt_pk_bf16(g1[2], g1[3]);
                *(u32x4*)(GB + (size_t)row * 1024 + col0 + bj * HALF) = w; }
        }
    }
    __device__ __forceinline__ void rgx(const f32x4 (&ax)[2], const Unit& u, int wr, int wc, int fr, int fq) const {
        const int r2 = 16 * u.pm + fr, row = 16384 + r2;
        const float rs = rstd_of(ssq[row]);
        if (u.pn < 8) {
            const int col0 = u.pn * HALF + wc * 32 + 8 * fq + 4 * wr;
            const f32x4 z0 = ax[0] * ax[1] * (rs * rs);
            u32x2 w; w.x = cvt_pk_bf16(z0[0], z0[1]); w.y = cvt_pk_bf16(z0[2], z0[3]);
            *(u32x2*)(Z + (size_t)row * 1024 + col0) = w;
            const int t = r2 & 7;
            if (t >= 6) *(f32x4*)(conv_s + ((size_t)(r2 >> 3) * 2 + (t - 6)) * 1024 + col0) = z0;
        } else {
            const int col0 = (u.pn - 8) * BM + wc * 32 + 8 * fq + 4 * wr;
#pragma unroll
            for (int bj = 0; bj < 2; ++bj) { const f32x4 g0 = ax[bj] * rs;
                u32x2 w; w.x = cvt_pk_bf16(g0[0], g0[1]); w.y = cvt_pk_bf16(g0[2], g0[3]);
                *(u32x2*)(GB + (size_t)row * 1024 + col0 + bj * HALF) = w; }
        }
    }
    PG8_EPI_CALL()
};

struct EpiNull {
    static constexpr bool PERM = true, AFTER_DRAIN = false;
    bf16_t* sink;
    __device__ __forceinline__ void rg(const f32x4 (&a)[2][2], const Unit& u, int ai, int m, int bjmask, int wr, int wc, int fr, int fq) const {
        asm volatile("" :: "v"(a[0][0]), "v"(a[0][1]), "v"(a[1][0]), "v"(a[1][1]));
    }
    __device__ __forceinline__ void rgx(const f32x4 (&ax)[2], const Unit& u, int wr, int wc, int fr, int fq) const { asm volatile("" :: "v"(ax[0]), "v"(ax[1])); }
    PG8_EPI_CALL()
};

template <class Epi, class Sched, bool ALIGN_EPI = false, bool SP2 = false>
__device__ __forceinline__ void gemm_phase(PG8_LAS unsigned char* lds, const Gemm g, const Sched& S, const Epi& E) {
    int tid_ = threadIdx.x; asm volatile("" : "+v"(tid_));
    const int tid = tid_, wid = __builtin_amdgcn_readfirstlane(tid >> 6), lane = tid & 63, wr = wid >> 2, wc = wid & 3, fr = lane & 15, fq = lane >> 4;
    const int K = g.K, nt = K / BK;
    constexpr int XROW0 = 16384, XR = 16;
    unsigned voffA[2], voffB[2];
#pragma unroll
    for (int i = 0; i < 2; ++i) { int R, C; stage_rc(tid * 16 + i * 8192, R, C); const int Rb = Epi::PERM ? ((R & ~31) + perm32(R & 31)) : R;
        voffA[i] = (unsigned)(R * K + C) * 2u; voffB[i] = (unsigned)(Rb * K + C) * 2u; }
    unsigned voffX; { const int row = wid * 2 + (lane >> 5), q = (lane & 31) * 4, kb = q ^ (((row >> 1) & 7) << 4); voffX = (unsigned)(row * K * 2 + kb); }
    const int xoff0 = fr * 128 + ((fq * 16) ^ (((fr >> 1) & 7) << 4)), xoff1 = fr * 128 + ((64 + fq * 16) ^ (((fr >> 1) & 7) << 4));
    const unsigned kstep = (unsigned)(BK * 2);
    const unsigned hstep = (unsigned)HALF * K * 2;
    const unsigned tstep = 2 * hstep;
    const __amdgpu_buffer_rsrc_t rsA = __builtin_amdgcn_make_buffer_rsrc((void*)g.A, 0, 0x7ffff000, 0x00020000), rsB = __builtin_amdgcn_make_buffer_rsrc((void*)g.Bt, 0, 0x7ffff000, 0x00020000);
    const unsigned ldsw = (unsigned)wid * 1024u;
    const int aoff = lds_byte(wr * 64 + fr, fq * 8), boff = lds_byte(wc * 32 + fr, fq * 8);
#define PG8_SA(b, h) (((b) * 2 + (h)) * HTB)
#define PG8_SB(b, h) ((4 + (b) * 2 + (h)) * HTB)
#define PG8_SX(b) (STAGE_BYTES + (b) * 2048)
#define PG8_STAGEX(b, soff) __builtin_amdgcn_raw_ptr_buffer_load_lds(rsA, (PG8_LAS unsigned*)(lds + PG8_SX(b) + wid * 256), 4, voffX, (soff), 0, 0)
#define PG8_LDAX(dst, b) do { dst[0] = *(const PG8_LAS bf16x8*)(lds + PG8_SX(b) + xoff0); dst[1] = *(const PG8_LAS bf16x8*)(lds + PG8_SX(b) + xoff1); } while (0)
#define PG8_MMAX() do { if (wr == 0) { _Pragma("unroll") for (int k = 0; k < 2; ++k) { accx[0] = __builtin_amdgcn_mfma_f32_16x16x32_bf16(B0[0][k], Ax[k], accx[0], 0, 0, 0); accx[1] = __builtin_amdgcn_mfma_f32_16x16x32_bf16(B1[0][k], Ax[k], accx[1], 0, 0, 0); } } \
        else { _Pragma("unroll") for (int k = 0; k < 2; ++k) { accx[0] = __builtin_amdgcn_mfma_f32_16x16x32_bf16(B0[1][k], Ax[k], accx[0], 0, 0, 0); accx[1] = __builtin_amdgcn_mfma_f32_16x16x32_bf16(B1[1][k], Ax[k], accx[1], 0, 0, 0); } } } while (0)
#define PG8_STAGEA(bufoff, soff) do { _Pragma("unroll") for (int _i = 0; _i < 2; ++_i) \
        __builtin_amdgcn_raw_ptr_buffer_load_lds(rsA, (PG8_LAS unsigned*)(lds + (bufoff) + ldsw + _i * 8192), 16, voffA[_i], (soff), 0, 0); } while (0)
#define PG8_STAGEB(bufoff, soff) do { _Pragma("unroll") for (int _i = 0; _i < 2; ++_i) \
        __builtin_amdgcn_raw_ptr_buffer_load_lds(rsB, (PG8_LAS unsigned*)(lds + (bufoff) + ldsw + _i * 8192), 16, voffB[_i], (soff), 0, 0); } while (0)
#define PG8_LDA(dst, b, h) do { _Pragma("unroll") for (int m = 0; m < 4; ++m) _Pragma("unroll") for (int k = 0; k < 2; ++k) dst[m][k] = *(const PG8_LAS bf16x8*)(lds + PG8_SA(b, h) + aoff + m * 2048 + k * 1024); } while (0)
#define PG8_LDB(dst, b, h) do { _Pragma("unroll") for (int n = 0; n < 2; ++n) _Pragma("unroll") for (int k = 0; k < 2; ++k) dst[n][k] = *(const PG8_LAS bf16x8*)(lds + PG8_SB(b, h) + boff + n * 2048 + k * 1024); } while (0)
#define PG8_MMA(ai, bj, At, Bt) do { __builtin_amdgcn_s_setprio(1); _Pragma("unroll") for (int m = 0; m < 4; ++m) _Pragma("unroll") for (int n = 0; n < 2; ++n) _Pragma("unroll") for (int k = 0; k < 2; ++k) \
        acc[ai][bj][m][n] = __builtin_amdgcn_mfma_f32_16x16x32_bf16(Bt[n][k], At[m][k], acc[ai][bj][m][n], 0, 0, 0); __builtin_amdgcn_s_setprio(0); } while (0)
#define PG8_WAIT_V(n) asm volatile("s_waitcnt vmcnt(" #n ")" ::: "memory")
#define PG8_WAIT_L(n) asm volatile("s_waitcnt lgkmcnt(" #n ")" ::: "memory")
#define PG8_BAR __builtin_amdgcn_s_barrier()
#define PG8_SCHED __builtin_amdgcn_sched_barrier(0)
    Unit cur, nxt; int ui = 0;
    if (!S.next(0, cur)) return;
    f32x4 acc[2][2][4][2];
#pragma unroll
    for (int a = 0; a < 2; ++a)
#pragma unroll
        for (int b = 0; b < 2; ++b)
#pragma unroll
            for (int m = 0; m < 4; ++m)
#pragma unroll
                for (int n = 0; n < 2; ++n) acc[a][b][m][n] = (f32x4){0.f, 0.f, 0.f, 0.f};
    bf16x8 At[4][2], B0[2][2], B1[2][2], Ax[2];
    f32x4 accx[2] = {(f32x4){0.f, 0.f, 0.f, 0.f}, (f32x4){0.f, 0.f, 0.f, 0.f}};
    unsigned cA = (unsigned)cur.pm * tstep, cB = (unsigned)cur.pn * tstep;
    const unsigned xstep = (unsigned)XR * K * 2, xbase = (unsigned)XROW0 * K * 2; unsigned cX = xbase + (unsigned)cur.pm * xstep;
    S.a_ready(cur);
    if constexpr (SP2) {
        PG8_STAGEB(PG8_SB(0, 0), cB); PG8_STAGEB(PG8_SB(0, 1), cB + hstep); PG8_STAGEA(PG8_SA(0, 0), cA); PG8_STAGEX(0, cX); PG8_STAGEA(PG8_SA(0, 1), cA + hstep);
        if (wr == 1) PG8_BAR;
        PG8_WAIT_V(2); PG8_BAR;
        PG8_STAGEB(PG8_SB(1, 0), cB + kstep); PG8_STAGEA(PG8_SA(1, 0), cA + kstep); PG8_STAGEB(PG8_SB(1, 1), cB + hstep + kstep); PG8_STAGEX(1, cX + kstep);
        PG8_WAIT_V(7); PG8_BAR;
    } else {
        PG8_STAGEB(PG8_SB(0, 0), cB); PG8_STAGEA(PG8_SA(0, 0), cA); PG8_STAGEB(PG8_SB(0, 1), cB + hstep); PG8_STAGEA(PG8_SA(0, 1), cA + hstep);
        if (wr == 1) PG8_BAR;
        PG8_WAIT_V(4); PG8_BAR;
        PG8_STAGEB(PG8_SB(1, 0), cB + kstep); PG8_STAGEA(PG8_SA(1, 0), cA + kstep); PG8_STAGEB(PG8_SB(1, 1), cB + hstep + kstep);
        PG8_WAIT_V(6); PG8_BAR;
    }
    for (;;) {
        const bool has_next = S.next(ui + 1, nxt);
        const unsigned nA = has_next ? (unsigned)nxt.pm * tstep : cA, nB = has_next ? (unsigned)nxt.pn * tstep : cB, nX = has_next ? xbase + (unsigned)nxt.pm * xstep : cX;
        for (int t = 0; t < nt; t += 2) {
            const bool last = (t == nt - 2);
            const unsigned a1 = cA + (unsigned)(t + 1) * kstep;
            const unsigned a2 = last ? nA : cA + (unsigned)(t + 2) * kstep, b2 = last ? nB : cB + (unsigned)(t + 2) * kstep;
            const unsigned a3 = a2 + kstep, b3 = b2 + kstep, x2 = last ? nX : cX + (unsigned)(t + 2) * kstep, x3 = x2 + kstep;
            if (last && has_next) S.a_ready(nxt);
            if constexpr (SP2) {
            PG8_LDB(B0, 0, 0); PG8_LDB(B1, 0, 1); PG8_SCHED; PG8_LDA(At, 0, 0); PG8_LDAX(Ax, 0); PG8_STAGEA(PG8_SA(1, 1), a1 + hstep);
            PG8_WAIT_V(9); PG8_WAIT_L(0); PG8_BAR; PG8_MMA(0, 0, At, B0); PG8_MMA(0, 1, At, B1); PG8_MMAX(); PG8_BAR; PG8_SCHED;
            PG8_LDA(At, 0, 1); PG8_STAGEB(PG8_SB(0, 0), b2); PG8_STAGEB(PG8_SB(0, 1), b2 + hstep); PG8_STAGEA(PG8_SA(0, 0), a2); PG8_STAGEX(0, x2);
            PG8_WAIT_V(9); PG8_WAIT_L(0); PG8_BAR; PG8_MMA(1, 0, At, B0); PG8_MMA(1, 1, At, B1); PG8_BAR; PG8_SCHED;
            PG8_LDB(B0, 1, 0); PG8_LDB(B1, 1, 1); PG8_SCHED; PG8_LDA(At, 1, 0); PG8_LDAX(Ax, 1); PG8_STAGEA(PG8_SA(0, 1), a2 + hstep);
            PG8_WAIT_V(9); PG8_WAIT_L(0); PG8_BAR; PG8_MMA(0, 0, At, B0); PG8_MMA(0, 1, At, B1); PG8_MMAX(); PG8_BAR; PG8_SCHED;
            PG8_LDA(At, 1, 1); PG8_STAGEB(PG8_SB(1, 0), b3); PG8_STAGEB(PG8_SB(1, 1), b3 + hstep); PG8_STAGEA(PG8_SA(1, 0), a3); PG8_STAGEX(1, x3);
            PG8_WAIT_V(9); PG8_WAIT_L(0); PG8_BAR; PG8_MMA(1, 0, At, B0); PG8_MMA(1, 1, At, B1); PG8_BAR; PG8_SCHED;
            } else {
            PG8_LDB(B0, 0, 0); PG8_SCHED; PG8_LDA(At, 0, 0); PG8_STAGEA(PG8_SA(1, 1), a1 + hstep);
            PG8_WAIT_L(8); PG8_BAR; PG8_WAIT_L(0); PG8_MMA(0, 0, At, B0); PG8_BAR; PG8_SCHED;
            PG8_LDB(B1, 0, 1); PG8_STAGEB(PG8_SB(0, 0), b2);
            PG8_BAR; PG8_WAIT_L(0); PG8_MMA(0, 1, At, B1); PG8_BAR;
            PG8_LDA(At, 0, 1); PG8_STAGEA(PG8_SA(0, 0), a2);
            PG8_BAR; PG8_WAIT_L(0); PG8_MMA(1, 0, At, B0); PG8_BAR; PG8_SCHED;
            PG8_STAGEB(PG8_SB(0, 1), b2 + hstep);
            PG8_WAIT_V(6); PG8_BAR; PG8_MMA(1, 1, At, B1); PG8_BAR;
            PG8_LDB(B0, 1, 0); PG8_SCHED; PG8_LDA(At, 1, 0); PG8_STAGEA(PG8_SA(0, 1), a2 + hstep);
            PG8_WAIT_L(8); PG8_BAR; PG8_WAIT_L(0); PG8_MMA(0, 0, At, B0); PG8_BAR; PG8_SCHED;
            PG8_LDB(B1, 1, 1); PG8_STAGEB(PG8_SB(1, 0), b3);
            PG8_BAR; PG8_WAIT_L(0); PG8_MMA(0, 1, At, B1); PG8_BAR;
            PG8_LDA(At, 1, 1); PG8_STAGEA(PG8_SA(1, 0), a3);
            PG8_BAR; PG8_WAIT_L(0); PG8_MMA(1, 0, At, B0); PG8_BAR; PG8_SCHED;
            PG8_STAGEB(PG8_SB(1, 1), b3 + hstep);
            PG8_WAIT_V(6); PG8_BAR; PG8_MMA(1, 1, At, B1); PG8_BAR;
            }
        }
        if constexpr (ALIGN_EPI) { if (wr == 0) PG8_BAR; }
        E(acc, cur, wr, wc, fr, fq); E.rgx(accx, cur, wr, wc, fr, fq);
        if (!has_next) break;
#pragma unroll
        for (int a = 0; a < 2; ++a)
#pragma unroll
            for (int b = 0; b < 2; ++b)
#pragma unroll
                for (int m = 0; m < 4; ++m)
#pragma unroll
                    for (int n = 0; n < 2; ++n) acc[a][b][m][n] = (f32x4){0.f, 0.f, 0.f, 0.f};
        accx[0] = (f32x4){0.f, 0.f, 0.f, 0.f}; accx[1] = (f32x4){0.f, 0.f, 0.f, 0.f};
        cur = nxt; cA = nA; cB = nB; cX = nX; ++ui;
        if constexpr (ALIGN_EPI) { if (wr == 1) PG8_BAR; }
    }
    PG8_WAIT_V(0);
    if constexpr (!ALIGN_EPI) { if (wr == 0) PG8_BAR; }
    PG8_BAR;
#undef PG8_SA
#undef PG8_SB
#undef PG8_STAGEA
#undef PG8_STAGEB
#undef PG8_SX
#undef PG8_STAGEX
#undef PG8_LDAX
#undef PG8_MMAX
#undef PG8_LDA
#undef PG8_LDB
#undef PG8_MMA
#undef PG8_WAIT_V
#undef PG8_WAIT_L
#undef PG8_BAR
#undef PG8_SCHED
}
}

#define GAS __attribute__((address_space(1)))
#define LAS __attribute__((address_space(3)))
typedef unsigned short bf16;
typedef unsigned v4u __attribute__((ext_vector_type(4)));
typedef float f32x4 __attribute__((ext_vector_type(4)));
typedef short bf16x8 __attribute__((ext_vector_type(8)));
typedef GAS unsigned gu32;
typedef GAS unsigned long long gu64;
#define RLX_AGENT __ATOMIC_RELAXED, __HIP_MEMORY_SCOPE_AGENT
#define LDS_WAIT() asm volatile("s_waitcnt lgkmcnt(0)" ::: "memory")
#define VM_WAIT() asm volatile("s_waitcnt vmcnt(0)" ::: "memory")
__device__ __forceinline__ unsigned long long rt() { return __builtin_amdgcn_s_memrealtime(); }
__device__ __forceinline__ unsigned f2bf(float f) { unsigned u = __builtin_bit_cast(unsigned, f); return (u + 0x7fffu + ((u >> 16) & 1u)) >> 16; }
__device__ __forceinline__ unsigned pk2(float lo, float hi) { return f2bf(lo) | (f2bf(hi) << 16); }

#define XB_TMO      128
#define XB_XCNT(j)  (256  + 64 * (j))
#define XB_XSUB(j)  (1280 + 64 * (j))
#define XB_XGEN(j)  (2304 + 64 * (j))
#define XB_TOP      3328
#define XB_TOPGEN   3392
#define XCD_BAR_WORDS 3456
#define XB_SPIN_CAP (1u << 18)

__device__ __forceinline__ unsigned xb_ld(unsigned* p)              { return __hip_atomic_load(p, __ATOMIC_RELAXED, __HIP_MEMORY_SCOPE_AGENT); }
__device__ __forceinline__ unsigned xb_add(unsigned* p, unsigned v) { return __hip_atomic_fetch_add(p, v, __ATOMIC_RELAXED, __HIP_MEMORY_SCOPE_AGENT); }
__device__ __forceinline__ unsigned xb_xcc_id() { return (unsigned)__builtin_amdgcn_s_getreg((3 << 11) | 20) & 0xFu; }
#define XB_SPIN(cond, bar) do { unsigned _sp = 0; while (cond) { __builtin_amdgcn_s_sleep(1); \
    if ((++_sp & 255u) == 0u) { if (xb_ld(&(bar)[XB_TMO])) break; if (_sp > XB_SPIN_CAP) { atomicAdd(&(bar)[XB_TMO], 1u); break; } } } } while (0)

struct XcdBarrier {
    unsigned* bar; unsigned x;
    volatile LAS unsigned* st;
};

__device__ __forceinline__ XcdBarrier xcd_barrier_post(unsigned* bar, volatile LAS unsigned* st) {
    XcdBarrier b; b.bar = bar; b.x = xb_xcc_id(); b.st = st;
    if (threadIdx.x == 0) (void)xb_add(&bar[XB_XCNT(b.x)], 1u);
    return b;
}
__device__ __forceinline__ void xcd_barrier_complete(unsigned* bar, unsigned x, unsigned& nloc, unsigned& nx) {
    const unsigned G = gridDim.x * gridDim.y * gridDim.z;
    unsigned sum, cnt, mine, sp = 0u;
    for (;;) {
        sum = 0u; cnt = 0u; mine = 0u;
#pragma unroll
        for (unsigned j = 0; j < 16; ++j) { const unsigned c = xb_ld(&bar[XB_XCNT(j)]); sum += c; cnt += (c > 0u) ? 1u : 0u; mine = (j == x) ? c : mine; }
        if (sum == G) break;
        __builtin_amdgcn_s_sleep(1);
        if ((++sp & 255u) == 0u) { if (xb_ld(&bar[XB_TMO])) break; if (sp > XB_SPIN_CAP) { atomicAdd(&bar[XB_TMO], 1u); break; } }
    }
    nloc = mine > 0u ? mine : 1u; nx = cnt > 0u ? cnt : 1u;
}

__device__ __forceinline__ void xcd_barrier(const XcdBarrier& b) {
    asm volatile("s_waitcnt vmcnt(0)" ::: "memory");
    __syncthreads();
    if (threadIdx.x == 0) {
        unsigned* bar = b.bar;
        __builtin_amdgcn_s_waitcnt(0);
        unsigned nloc = b.st[0], nx = b.st[1];
        if (nloc == 0u) { xcd_barrier_complete(bar, b.x, nloc, nx); b.st[0] = nloc; b.st[1] = nx; }
        const unsigned old = xb_add(&bar[XB_XSUB(b.x)], 1u);
        const unsigned gen = old / nloc;
        if (old + 1u == (gen + 1u) * nloc) {
            __builtin_amdgcn_fence(__ATOMIC_RELEASE, "agent");
            asm volatile("s_waitcnt vmcnt(0)" ::: "memory");
            const unsigned og = xb_add(&bar[XB_TOP], 1u);
            const unsigned tg = og / nx;
            if (og + 1u == (tg + 1u) * nx) xb_add(&bar[XB_TOPGEN], 1u);
            else XB_SPIN(xb_ld(&bar[XB_TOPGEN]) == tg, bar);
            __builtin_amdgcn_fence(__ATOMIC_ACQUIRE, "agent");
            xb_add(&bar[XB_XGEN(b.x)], 1u);
            asm volatile("s_waitcnt vmcnt(0)" ::: "memory");
        } else {
            XB_SPIN(xb_ld(&bar[XB_XGEN(b.x)]) == gen, bar);
            __builtin_amdgcn_fence(__ATOMIC_ACQUIRE, "agent");
            asm volatile("s_waitcnt vmcnt(0)" ::: "memory");
        }
    }
    __syncthreads();
}


constexpr int NWAVES = 8;
#ifndef MK_ONE_LAUNCH
#define MK_ONE_LAUNCH 1
#endif
constexpr int N_PHASES = 15;

constexpr int D = 1024, FF = 4096, MP = 8 * 2048, MS = 128 * 8, M = MP + MS;
constexpr int NG = 64, PS = 64, GS = 16;
constexpr float EPS = 1e-6f;
constexpr size_t O_Y = 0, O_SRP = (size_t)M * D, O_SIP = O_SRP + 8 * 4096, O_CP = O_SIP + 8 * 4096, O_SRS = O_CP + 8 * 2 * 1024, O_SIS = O_SRS + 128 * 4096, O_CS = O_SIS + 128 * 4096, O_END = O_CS + 128 * 2 * 1024;
static_assert(O_END == 19218432, "output size");

constexpr size_t MiB = 1u << 20;
constexpr size_t WS_CTL = 0, CTL_ZERO_BYTES = 1 * MiB;
constexpr size_t WS_SSQ = 1 * MiB;
constexpr size_t WS_SSMP = 2 * MiB;
constexpr size_t WS_WGU = 4 * MiB;
constexpr size_t WS_WD = 68 * MiB;
constexpr size_t WS_WGLU = 100 * MiB;
constexpr size_t WS_WIN = 104 * MiB;
constexpr size_t WS_WOUT = 110 * MiB;
constexpr size_t WS_X = 112 * MiB;
constexpr size_t WS_XB = 180 * MiB;
constexpr size_t WS_H = 214 * MiB;
constexpr size_t WS_G = WS_H, WS_Z = WS_H, WS_GB = WS_H + 34 * MiB, WS_A2 = WS_H + 68 * MiB;
constexpr size_t WS_SLAB = 350 * MiB;
constexpr size_t WS_END = 414 * MiB;
constexpr int CW_TMO = 0;
constexpr int CW_BAR = 4096;
constexpr int CW_SK = 16384;

constexpr int RING_OFF = 0, RING_BYTES = 131072 + 4096;
constexpr int LDSCTL_OFF = RING_BYTES, MISC_OFF = LDSCTL_OFF + 320;
constexpr int LDS_BYTES = 147456;

struct Frame {
    LAS unsigned char* lds;
    volatile LAS unsigned* MISC;
    gu32* ctl;
    int tid, lane, wave, vcu, G;
    const float* in[21]; float* out; unsigned char* ws;
};

__device__ __forceinline__ int opaque_i(int v) { asm volatile("" : "+v"(v)); return v; }
__device__ __forceinline__ float wave_sum(float v) {
#pragma unroll
    for (int o = 1; o < 64; o <<= 1) v += __shfl_xor(v, o);
    return v;
}
__device__ __forceinline__ float bf2f(unsigned short b) { return __builtin_bit_cast(float, (unsigned)b << 16); }

__device__ __forceinline__ void p0_transpose_item(const float* W, int K, int N, bf16* WT, const float* gk, int k0, int n0s, int n0d, LAS unsigned char* scr, int lane) {
    const int kr = lane >> 4, c = lane & 15;
    f32x4 v[8][2];
#pragma unroll
    for (int i = 0; i < 8; ++i)
#pragma unroll
        for (int s = 0; s < 2; ++s) v[i][s] = *(const GAS f32x4*)(W + (size_t)(k0 + 8 * i + 2 * kr + s) * N + n0s + 4 * c);
    if (gk) {
#pragma unroll
        for (int i = 0; i < 8; ++i)
#pragma unroll
            for (int s = 0; s < 2; ++s) v[i][s] = v[i][s] * gk[k0 + 8 * i + 2 * kr + s]; }
#pragma unroll
    for (int i = 0; i < 8; ++i)
#pragma unroll
        for (int j = 0; j < 4; ++j) *(LAS unsigned*)(scr + (4 * c + j) * 128 + (((4 * i + kr) ^ ((c & 7) << 2)) << 2)) = pg8::cvt_pk_bf16(v[i][0][j], v[i][1][j]);
    LDS_WAIT(); asm volatile("" ::: "memory");
    const int nr = lane >> 3, q = lane & 7;
#pragma unroll
    for (int i = 0; i < 8; ++i) { const int n = nr + 8 * i; const v4u o = *(const LAS v4u*)(scr + n * 128 + ((q ^ ((n >> 2) & 7)) << 4));
        *(GAS v4u*)(WT + (size_t)(n0d + n) * K + k0 + 8 * q) = o; }
    LDS_WAIT(); asm volatile("" ::: "memory");
}
__device__ __forceinline__ int pair_src(int nd, int base, int hstride) { return base + ((nd >> 7) & 1) * hstride + 128 * (nd >> 8) + (nd & 127); }

__device__ __forceinline__ void p0_prologue(Frame& F) {
    LAS unsigned char* scr = F.lds + RING_OFF + F.wave * 16384;
    const int gw = F.vcu * NWAVES + F.wave, NGW = F.G * NWAVES, lane = opaque_i(F.lane);
    const float* norm_g = F.in[5];
    constexpr int I_GU = (D / 64) * (2 * FF / 64), I_D = (FF / 64) * (D / 64), I_GLU = (D / 64) * (2 * D / 64), I_IN = (D / 64) * (3 * D / 64), I_OUT = (D / 64) * (D / 64);
    constexpr int NITEMS = 4 * I_GU + 4 * I_D + I_GLU + I_IN + I_OUT;
    for (int it = gw; it < NITEMS; it += NGW) {
        int r = it;
        if (r < 4 * I_GU) { const int f = r / I_GU; r -= f * I_GU; const int nb = r % (2 * FF / 64), kb = r / (2 * FF / 64), nd = 64 * nb;
            const float* gk = norm_g + ((f >> 1) * 3 + (f & 1) * 2) * D;
            p0_transpose_item(F.in[7] + (size_t)f * D * 2 * FF, D, 2 * FF, (bf16*)(F.ws + WS_WGU) + (size_t)f * 2 * FF * D, gk, 64 * kb, pair_src(nd, 0, FF), nd, scr, lane); continue; }
        r -= 4 * I_GU;
        if (r < 4 * I_D) { const int f = r / I_D; r -= f * I_D; const int nb = r % (D / 64), kb = r / (D / 64), nd = 64 * nb;
            p0_transpose_item(F.in[8] + (size_t)f * FF * D, FF, D, (bf16*)(F.ws + WS_WD) + (size_t)f * D * FF, nullptr, 64 * kb, nd, nd, scr, lane); continue; }
        r -= 4 * I_D;
        if (r < I_GLU) { const int nb = r % (2 * D / 64), kb = r / (2 * D / 64), nd = 64 * nb;
            p0_transpose_item(F.in[17], D, 2 * D, (bf16*)(F.ws + WS_WGLU), nullptr, 64 * kb, pair_src(nd, 0, D), nd, scr, lane); continue; }
        r -= I_GLU;
        if (r < I_IN) { const int nb = r % (3 * D / 64), kb = r / (3 * D / 64), nd = 64 * nb;
            const int ns = nd < 2048 ? pair_src(nd, D, D) : nd - 2048;
            p0_transpose_item(F.in[18], D, 3 * D, (bf16*)(F.ws + WS_WIN), norm_g + 4 * D, 64 * kb, ns, nd, scr, lane); continue; }
        r -= I_IN;
        { const int nb = r % (D / 64), kb = r / (D / 64), nd = 64 * nb;
            p0_transpose_item(F.in[20], D, D, (bf16*)(F.ws + WS_WOUT), nullptr, 64 * kb, nd, nd, scr, lane); }
    }
    bf16* XB = (bf16*)(F.ws + WS_XB); float* ssq = (float*)(F.ws + WS_SSQ);
    for (int m = gw; m < M; m += NGW) {
        const float* src = m < MP ? F.in[0] + (size_t)m * D : F.in[1] + (size_t)(m - MP) * D;
        const GAS f32x4* xr = (const GAS f32x4*)src + lane;
        GAS unsigned long long* o8 = (GAS unsigned long long*)(XB + (size_t)m * D) + lane;
        float s = 0.f;
#pragma unroll
        for (int j = 0; j < 4; ++j) { const f32x4 v = xr[64 * j]; s += (v.x * v.x + v.y * v.y) + (v.z * v.z + v.w * v.w);
            o8[64 * j] = (unsigned long long)pk2(v.x, v.y) | ((unsigned long long)pk2(v.z, v.w) << 32); }
        s = wave_sum(s);
        if (lane == 0) ssq[m] = s;
    }
    for (int i = gw * 64 + lane; i < 7 * M; i += NGW * 64) ssq[M + i] = 0.f;
    float* sp = (float*)(F.ws + WS_SSMP);
    for (int i = gw * 64 + lane; i < NG * PS; i += NGW * 64) {
        const int g = i / PS;
        const float lr = F.in[9][i], li = F.in[10][i], dt = expf(F.in[11][g]);
        const float mag = expf(lr * dt); float sn, cs; sincosf(li * dt, &sn, &cs);
        const float lbr = mag * cs, lbi = mag * sn, den = lr * lr + li * li, nr = lbr - 1.0f, ni = lbi;
        const float fr = (nr * lr + ni * li) / den, fi = (ni * lr - nr * li) / den;
        sp[i] = lbr; sp[4096 + i] = lbi;
#pragma unroll
        for (int c = 0; c < GS; ++c) { const float br = F.in[12][(size_t)i * GS + c], bi = F.in[13][(size_t)i * GS + c];
            sp[8192 + (size_t)i * GS + c] = fr * br - fi * bi; sp[8192 + 65536 + (size_t)i * GS + c] = fr * bi + fi * br; }
    }
}

__device__ __forceinline__ float gelu_tanh(float x) {
    const float a = 0.7978845608028654f * (x + 0.044715f * x * x * x);
    return x * __builtin_amdgcn_rcpf(1.0f + __builtin_amdgcn_exp2f(-2.0f * 1.4426950408889634f * a));
}

__device__ __forceinline__ void ssm_phase(Frame& F) {
    constexpr int TB = 8;
    LAS float* wl = (LAS float*)(F.lds + RING_OFF + F.wave * 16384);
    LAS float* hsr = wl; LAS float* hsi = wl + TB * 65; LAS float* cre = wl + 2 * TB * 65; LAS float* cim = cre + 16 * 65;
    const int gw = F.vcu * NWAVES + F.wave, NGW = F.G * NWAVES, lane = F.lane;
    const float* X = (const float*)(F.ws + WS_X); const float* ssq = (const float*)(F.ws + WS_SSQ) + 1 * M;
    const float* sp = (const float*)(F.ws + WS_SSMP); bf16* Gb = (bf16*)(F.ws + WS_G);
    const float* g1 = F.in[5] + 1 * D; const float* dsk = F.in[16];
    constexpr int NITEM = 8 * NG + 128 * NG;
    for (int it = gw; it < NITEM; it += NGW) {
        int seq, g, L, row0; const float *s0r = nullptr, *s0i = nullptr; float *outr, *outi;
        if (it < 8 * NG) { seq = it / NG; g = it % NG; L = 2048; row0 = seq * 2048; outr = F.out + O_SRP + (size_t)(seq * NG + g) * PS; outi = F.out + O_SIP + (size_t)(seq * NG + g) * PS; }
        else { const int j = it - 8 * NG; seq = j / NG; g = j % NG; L = 8; row0 = MP + seq * 8; s0r = F.in[2] + (size_t)(seq * NG + g) * PS; s0i = F.in[3] + (size_t)(seq * NG + g) * PS;
               outr = F.out + O_SRS + (size_t)(seq * NG + g) * PS; outi = F.out + O_SIS + (size_t)(seq * NG + g) * PS; }
        const int gp = g * PS + lane;
        const float lbr = sp[gp], lbi = sp[4096 + gp];
        float bbr[GS], bbi[GS];
#pragma unroll
        for (int c = 0; c < GS; ++c) { bbr[c] = sp[8192 + (size_t)gp * GS + c]; bbi[c] = sp[8192 + 65536 + (size_t)gp * GS + c]; }
#pragma unroll
        for (int c = 0; c < GS; ++c) { cre[c * 65 + lane] = F.in[14][((size_t)g * GS + c) * PS + lane]; cim[c * 65 + lane] = F.in[15][((size_t)g * GS + c) * PS + lane]; }
        float gn[GS];
#pragma unroll
        for (int c = 0; c < GS; ++c) gn[c] = g1[g * GS + c];
        float hr = s0r ? s0r[lane] : 0.f, hi = s0i ? s0i[lane] : 0.f;
        const int oc = lane & 15, otq = lane >> 4;
        const float dc = dsk[g * GS + oc], gc = g1[g * GS + oc];
        for (int t0 = 0; t0 < L; t0 += TB) {
#pragma unroll
            for (int tl = 0; tl < TB; ++tl) { const int row = row0 + t0 + tl; const float rs = __builtin_amdgcn_rsqf(ssq[row] * (1.0f / D) + EPS);
                const float* xr = X + (size_t)row * D + g * GS; float br = 0.f, bi = 0.f;
#pragma unroll
                for (int c = 0; c < GS; ++c) { const float uu = xr[c] * rs * gn[c]; br += bbr[c] * uu; bi += bbi[c] * uu; }
                const float nr = lbr * hr - lbi * hi + br, ni = lbr * hi + lbi * hr + bi; hr = nr; hi = ni;
                hsr[tl * 65 + lane] = hr; hsi[tl * 65 + lane] = hi; }
            LDS_WAIT(); __builtin_amdgcn_wave_barrier(); asm volatile("" ::: "memory");
#pragma unroll
            for (int j = 0; j < 2; ++j) { const int tl = otq * 2 + j; const int row = row0 + t0 + tl; float y = 0.f;
                for (int p = 0; p < PS; ++p) y += cre[oc * 65 + p] * hsr[tl * 65 + p] - cim[oc * 65 + p] * hsi[tl * 65 + p];
                const float rs = __builtin_amdgcn_rsqf(ssq[row] * (1.0f / D) + EPS);
                const float uu = X[(size_t)row * D + g * GS + oc] * rs * gc;
                y += dc * uu;
                Gb[(size_t)row * D + g * GS + oc] = (bf16)f2bf(gelu_tanh(y)); }
            LDS_WAIT(); __builtin_amdgcn_wave_barrier(); asm volatile("" ::: "memory");
        }
        outr[lane] = hr; outi[lane] = hi;
    }
}


typedef float f32x16 __attribute__((ext_vector_type(16)));
typedef unsigned u32x2v __attribute__((ext_vector_type(2)));
__device__ __forceinline__ unsigned cvtpk(float lo, float hi) { unsigned r; asm volatile("v_cvt_pk_bf16_f32 %0, %1, %2" : "=v"(r) : "v"(lo), "v"(hi)); return r; }
__device__ __forceinline__ bf16x8 pack8(const float* v) { v4u w; w.x = cvtpk(v[0], v[1]); w.y = cvtpk(v[2], v[3]); w.z = cvtpk(v[4], v[5]); w.w = cvtpk(v[6], v[7]); return __builtin_bit_cast(bf16x8, w); }
constexpr int SSM_ROWB = 272;

__device__ __forceinline__ void ssm_phase_fast(Frame& F) {
    LAS unsigned char* img = F.lds + RING_OFF + F.wave * 16384;
    const int lane = opaque_i(F.lane), G = F.G, gq = F.wave * G + F.vcu, NGQ = NWAVES * G;
    const float* X = (const float*)(F.ws + WS_X); const float* ssq = (const float*)(F.ws + WS_SSQ) + 1 * M;
    const float* sp = (const float*)(F.ws + WS_SSMP); bf16* Gb = (bf16*)(F.ws + WS_G);
    const float* g1 = F.in[5] + 1 * D; const float* dsk = F.in[16];
    constexpr int NPI = 8 * NG, NSB = (MS / 32) * NG, NITEM = NPI + NSB;
    const int l31 = lane & 31, h = lane >> 5, l15 = lane & 15, q4 = lane >> 4;
    for (int it = gq; it < NITEM; it += NGQ) {
        const bool sample = it >= NPI;
        int g, row_base, nblk, seq0;
        if (!sample) { seq0 = it / NG; g = it % NG; row_base = seq0 * 2048; nblk = 64; }
        else { const int j = it - NPI; const int rb = j / NG; g = j % NG; row_base = MP + rb * 32; nblk = 1; seq0 = rb * 4; }
        bf16x8 bbq[4];
#pragma unroll
        for (int q = 0; q < 4; ++q) { const int p = 32 * (q & 1) + l31; const float* src = sp + 8192 + (q >> 1) * 65536 + ((size_t)(g * PS + p) * GS + 8 * h);
            float v[8];
#pragma unroll
            for (int j = 0; j < 8; ++j) v[j] = src[j] * g1[g * GS + 8 * h + j];
            bbq[q] = pack8(v); }
        bf16x8 cm[4];
#pragma unroll
        for (int ks = 0; ks < 4; ++ks) { const int p0 = 16 * ks + 4 * q4; const float* cr = F.in[14] + ((size_t)(g * GS + l15) * PS + p0); const float* ci = F.in[15] + ((size_t)(g * GS + l15) * PS + p0);
            float v[8];
#pragma unroll
            for (int j = 0; j < 4; ++j) { v[2 * j] = cr[j]; v[2 * j + 1] = -ci[j]; }
            cm[ks] = pack8(v); }
        float dg[4];
#pragma unroll
        for (int e = 0; e < 4; ++e) dg[e] = dsk[g * GS + 4 * q4 + e] * g1[g * GS + 4 * q4 + e];
        const float lbr = sp[g * PS + lane], lbi = sp[4096 + g * PS + lane];
        float hr = 0.f, hi = 0.f;
        float s0r[4], s0i[4];
        if (sample) {
#pragma unroll
            for (int i = 0; i < 4; ++i) { s0r[i] = F.in[2][((size_t)(seq0 + i) * NG + g) * PS + lane]; s0i[i] = F.in[3][((size_t)(seq0 + i) * NG + g) * PS + lane]; } }
        else {
#pragma unroll
            for (int i = 0; i < 4; ++i) { s0r[i] = 0.f; s0i[i] = 0.f; } }
        f32x4 xa0, xa1, xe0, xe1; float qa, qe0, qe1;
#define SSM_LOAD(b) do { const int rowA = row_base + 32 * (b) + l31; const float* pa = X + (size_t)rowA * D + g * GS + 8 * h; xa0 = *(const f32x4*)pa; xa1 = *(const f32x4*)(pa + 4); qa = ssq[rowA]; \
            const int rowE = row_base + 32 * (b) + l15; xe0 = *(const f32x4*)(X + (size_t)rowE * D + g * GS + 4 * q4); xe1 = *(const f32x4*)(X + (size_t)(rowE + 16) * D + g * GS + 4 * q4); qe0 = ssq[rowE]; qe1 = ssq[rowE + 16]; } while (0)
        SSM_LOAD(0);
        for (int b = 0; b < nblk; ++b) {
            const f32x4 ca0 = xa0, ca1 = xa1, ce0 = xe0, ce1 = xe1; const float cqa = qa, cqe0 = qe0, cqe1 = qe1;
            if (b + 1 < nblk) SSM_LOAD(b + 1);
            const float rsa = __builtin_amdgcn_rsqf(cqa * (1.0f / D) + EPS);
            float ua[8];
#pragma unroll
            for (int j = 0; j < 4; ++j) { ua[j] = ca0[j] * rsa; ua[4 + j] = ca1[j] * rsa; }
            const bf16x8 ufrag = pack8(ua);
            const f32x16 zero16 = {0.f, 0.f, 0.f, 0.f, 0.f, 0.f, 0.f, 0.f, 0.f, 0.f, 0.f, 0.f, 0.f, 0.f, 0.f, 0.f};
            f32x16 Xr = __builtin_amdgcn_mfma_f32_32x32x16_bf16(ufrag, bbq[0], zero16, 0, 0, 0);
            f32x16 Yr = __builtin_amdgcn_mfma_f32_32x32x16_bf16(ufrag, bbq[1], zero16, 0, 0, 0);
            f32x16 Xi = __builtin_amdgcn_mfma_f32_32x32x16_bf16(ufrag, bbq[2], zero16, 0, 0, 0);
            f32x16 Yi = __builtin_amdgcn_mfma_f32_32x32x16_bf16(ufrag, bbq[3], zero16, 0, 0, 0);
#pragma unroll
            for (int r = 0; r < 16; ++r) {
                auto s1 = __builtin_amdgcn_permlane32_swap(__float_as_uint(Xr[r]), __float_as_uint(Yr[r]), false, false); Xr[r] = __uint_as_float(s1[0]); Yr[r] = __uint_as_float(s1[1]);
                auto s2 = __builtin_amdgcn_permlane32_swap(__float_as_uint(Xi[r]), __float_as_uint(Yi[r]), false, false); Xi[r] = __uint_as_float(s2[0]); Yi[r] = __uint_as_float(s2[1]); }
#pragma unroll
            for (int i = 0; i < 4; ++i) {
                if (sample) { hr = s0r[i]; hi = s0i[i]; }
#pragma unroll
                for (int s = 0; s < 2; ++s)
#pragma unroll
                    for (int e = 0; e < 4; ++e) { const int r = 4 * i + e; const float br = s ? Yr[r] : Xr[r], bi = s ? Yi[r] : Xi[r];
                        const float nr = lbr * hr - lbi * hi + br, ni = lbr * hi + lbi * hr + bi; hr = nr; hi = ni;
                        *(LAS unsigned*)(img + (8 * i + 4 * s + e) * SSM_ROWB + 4 * lane) = cvtpk(hr, hi); }
                if (sample) { F.out[O_SRS + ((size_t)(seq0 + i) * NG + g) * PS + lane] = hr; F.out[O_SIS + ((size_t)(seq0 + i) * NG + g) * PS + lane] = hi; }
            }
            f32x4 acc0 = {0.f, 0.f, 0.f, 0.f}, acc1 = {0.f, 0.f, 0.f, 0.f};
#pragma unroll
            for (int ks = 0; ks < 4; ++ks) {
                const bf16x8 b0 = *(const LAS bf16x8*)(img + l15 * SSM_ROWB + 64 * ks + 16 * q4);
                const bf16x8 b1 = *(const LAS bf16x8*)(img + (16 + l15) * SSM_ROWB + 64 * ks + 16 * q4);
                acc0 = __builtin_amdgcn_mfma_f32_16x16x32_bf16(cm[ks], b0, acc0, 0, 0, 0);
                acc1 = __builtin_amdgcn_mfma_f32_16x16x32_bf16(cm[ks], b1, acc1, 0, 0, 0); }
            const float rse0 = __builtin_amdgcn_rsqf(cqe0 * (1.0f / D) + EPS), rse1 = __builtin_amdgcn_rsqf(cqe1 * (1.0f / D) + EPS);
            float o0[4], o1[4];
#pragma unroll
            for (int e = 0; e < 4; ++e) { o0[e] = gelu_tanh(acc0[e] + dg[e] * ce0[e] * rse0); o1[e] = gelu_tanh(acc1[e] + dg[e] * ce1[e] * rse1); }
            const int rowE = row_base + 32 * b + l15;
            u32x2v w0, w1; w0.x = cvtpk(o0[0], o0[1]); w0.y = cvtpk(o0[2], o0[3]); w1.x = cvtpk(o1[0], o1[1]); w1.y = cvtpk(o1[2], o1[3]);
            *(u32x2v*)(Gb + (size_t)rowE * D + g * GS + 4 * q4) = w0;
            *(u32x2v*)(Gb + (size_t)(rowE + 16) * D + g * GS + 4 * q4) = w1;
        }
#undef SSM_LOAD
        if (!sample) { F.out[O_SRP + ((size_t)seq0 * NG + g) * PS + lane] = hr; F.out[O_SIP + ((size_t)seq0 * NG + g) * PS + lane] = hi; }
    }
}

__device__ __forceinline__ void conv_phase(Frame& F) {
    const bf16* Z = (const bf16*)(F.ws + WS_Z); const bf16* GBp = (const bf16*)(F.ws + WS_GB); bf16* A2 = (bf16*)(F.ws + WS_A2);
    const float* cw = F.in[19]; const float* cache = F.in[4];
    const int gt = (F.vcu * NWAVES + F.wave) * 64 + opaque_i(F.lane), NGT = F.G * NWAVES * 64;
    for (int it = gt; it < M * (D / 8); it += NGT) {
        const int row = it >> 7, c0 = (it & 127) * 8;
        int t; const float* cb = nullptr;
        if (row < MP) t = row & 2047; else { const int r2 = row - MP; t = r2 & 7; cb = cache + (size_t)(r2 >> 3) * 2 * D; }
        float z0[8], z1[8], z2[8], gb[8];
        { const v4u v = *(const GAS v4u*)(Z + (size_t)row * D + c0); const v4u q = *(const GAS v4u*)(GBp + (size_t)row * D + c0);
#pragma unroll
          for (int e = 0; e < 4; ++e) { z2[2 * e] = __builtin_bit_cast(float, v[e] << 16); z2[2 * e + 1] = __builtin_bit_cast(float, v[e] & 0xffff0000u);
                                        gb[2 * e] = __builtin_bit_cast(float, q[e] << 16); gb[2 * e + 1] = __builtin_bit_cast(float, q[e] & 0xffff0000u); } }
        if (t >= 1) { const v4u v = *(const GAS v4u*)(Z + (size_t)(row - 1) * D + c0);
#pragma unroll
          for (int e = 0; e < 4; ++e) { z1[2 * e] = __builtin_bit_cast(float, v[e] << 16); z1[2 * e + 1] = __builtin_bit_cast(float, v[e] & 0xffff0000u); } }
        else {
#pragma unroll
          for (int e = 0; e < 8; ++e) z1[e] = cb ? cb[D + c0 + e] : 0.f; }
        if (t >= 2) { const v4u v = *(const GAS v4u*)(Z + (size_t)(row - 2) * D + c0);
#pragma unroll
          for (int e = 0; e < 4; ++e) { z0[2 * e] = __builtin_bit_cast(float, v[e] << 16); z0[2 * e + 1] = __builtin_bit_cast(float, v[e] & 0xffff0000u); } }
        else {
#pragma unroll
          for (int e = 0; e < 8; ++e) z0[e] = cb ? cb[t * D + c0 + e] : 0.f; }
        float o[8];
#pragma unroll
        for (int e = 0; e < 8; ++e) o[e] = gb[e] * (cw[c0 + e] * z0[e] + cw[D + c0 + e] * z1[e] + cw[2 * D + c0 + e] * z2[e]);
        v4u w; w.x = pk2(o[0], o[1]); w.y = pk2(o[2], o[3]); w.z = pk2(o[4], o[5]); w.w = pk2(o[6], o[7]);
        *(GAS v4u*)(A2 + (size_t)row * D + c0) = w;
    }
}

__device__ __forceinline__ void final_phase(Frame& F) {
    const float* X = (const float*)(F.ws + WS_X); const float* ssq = (const float*)(F.ws + WS_SSQ) + 6 * M; const float* fg = F.in[6];
    const int gw = F.vcu * NWAVES + F.wave, NGW = F.G * NWAVES, lane = opaque_i(F.lane);
    f32x4 gv[4];
#pragma unroll
    for (int j = 0; j < 4; ++j) gv[j] = ((const GAS f32x4*)fg)[lane + 64 * j];
    for (int m = gw; m < M; m += NGW) {
        const float rs = __builtin_amdgcn_rsqf(ssq[m] * (1.0f / D) + EPS);
        const GAS f32x4* xr = (const GAS f32x4*)(X + (size_t)m * D) + lane; GAS f32x4* yo = (GAS f32x4*)(F.out + O_Y + (size_t)m * D) + lane;
#pragma unroll
        for (int j = 0; j < 4; ++j) yo[64 * j] = xr[64 * j] * rs * gv[j];
    }
}

struct Args { const float* in[21]; float* out; unsigned char* ws; int ph_lo, ph_hi; };
__global__ void __launch_bounds__(NWAVES * 64, 2) skel_fwd(Args args) {
    extern __shared__ __attribute__((aligned(16))) unsigned char lds[];
    Frame F;
    F.lds = (LAS unsigned char*)lds;
    F.MISC = (volatile LAS unsigned*)(F.lds + MISC_OFF);
    F.tid = threadIdx.x; F.lane = F.tid & 63; F.wave = __builtin_amdgcn_readfirstlane(F.tid >> 6);
    F.G = gridDim.x; { const int bx = blockIdx.x; F.vcu = (F.G % 8 == 0) ? (bx % 8) * (F.G / 8) + bx / 8 : bx; }
    F.ws = args.ws; F.out = args.out; F.ctl = (gu32*)(args.ws + WS_CTL);
#pragma unroll
    for (int i = 0; i < 21; ++i) F.in[i] = args.in[i];
    for (int u = F.tid; u < (LDS_BYTES - LDSCTL_OFF) / 4; u += NWAVES * 64) ((LAS unsigned*)(F.lds + LDSCTL_OFF))[u] = 0u;
    __syncthreads();
    XcdBarrier bar; bar.bar = (unsigned*)(F.ctl + CW_BAR); bar.x = 0; bar.st = nullptr;
    if (MK_ONE_LAUNCH) bar = xcd_barrier_post((unsigned*)(F.ctl + CW_BAR), F.MISC + 8);
    const int lo = args.ph_lo, hi = args.ph_hi;
#define IN(k) (lo <= (k) && (k) < hi)
#if defined(PROBE_A_LO)
#define STAMP(k) do { if (blockIdx.x == 0 && F.tid == 0) { const unsigned long long t_ = __builtin_amdgcn_s_memrealtime(); F.MISC[16 + 2 * (k)] = (unsigned)t_; F.MISC[17 + 2 * (k)] = (unsigned)(t_ >> 32); } } while (0)
#else
#define STAMP(k) do { } while (0)
#endif
    STAMP(0);
#define SEAM(k) do { if (MK_ONE_LAUNCH && IN((k) + 1)) xcd_barrier(bar); STAMP((k) + 1); } while (0)
    bf16* XB = (bf16*)(F.ws + WS_XB); bf16* H = (bf16*)(F.ws + WS_H); float* X = (float*)(F.ws + WS_X); float* ssq = (float*)(F.ws + WS_SSQ);
    const int bx = (int)blockIdx.x;

    if (IN(0)) { p0_prologue(F); SEAM(0); }
#define FFN_GU(ph, f, sin) if (IN(ph)) { pg8::Gemm g{XB, (const bf16*)(F.ws + WS_WGU) + (size_t)(f) * 2 * FF * D, M, 2 * FF, D}; pg8::StaticOrder S; S.init(MP, 2 * FF, F.G, bx); \
        pg8::EpiGateUp E{H, FF, ssq + (size_t)(sin) * M}; pg8::gemm_phase<pg8::EpiGateUp, pg8::StaticOrder, true, true>(F.lds + RING_OFF, g, S, E); SEAM(ph); }
#define FFN_DN(ph, f, sout) if (IN(ph)) { pg8::Gemm g{H, (const bf16*)(F.ws + WS_WD) + (size_t)(f) * D * FF, M, D, FF}; pg8::StaticOrder S; S.init(MP, D, F.G, bx); \
        pg8::EpiResid<0> E{(ph) == 2 ? F.in[0] : X, (ph) == 2 ? F.in[1] : X + (size_t)MP * D, X, XB, ssq + (size_t)(sout) * M, 0.5f}; pg8::gemm_phase<pg8::EpiResid<0>, pg8::StaticOrder, true, true>(F.lds + RING_OFF, g, S, E); SEAM(ph); }
    FFN_GU(1, 0, 0)
    FFN_DN(2, 0, 1)
    if (IN(3)) { ssm_phase_fast(F); SEAM(3); }
    if (IN(4)) { pg8::Gemm g{(const bf16*)(F.ws + WS_G), (const bf16*)(F.ws + WS_WGLU), M, 2 * D, D}; pg8::StaticOrder S; S.init(MP, 2 * D, F.G, bx);
        pg8::EpiResid<1> E{X, X + (size_t)MP * D, X, XB, ssq + (size_t)2 * M, 1.0f}; pg8::gemm_phase<pg8::EpiResid<1>, pg8::StaticOrder, true, true>(F.lds + RING_OFF, g, S, E); SEAM(4); }
    FFN_GU(5, 1, 2)
    FFN_DN(6, 1, 3)
    FFN_GU(7, 2, 3)
    FFN_DN(8, 2, 4)
    if (IN(9)) { pg8::Gemm g{XB, (const bf16*)(F.ws + WS_WIN), M, 3 * D, D}; pg8::StaticOrder S; S.init(MP, 3 * D, F.G, bx);
        pg8::EpiConvIn E{(bf16*)(F.ws + WS_Z), (bf16*)(F.ws + WS_GB), ssq + (size_t)4 * M, F.out + O_CP, F.out + O_CS};
        pg8::gemm_phase<pg8::EpiConvIn, pg8::StaticOrder, true, true>(F.lds + RING_OFF, g, S, E); SEAM(9); }
    if (IN(10)) { conv_phase(F); SEAM(10); }
    if (IN(11)) { pg8::Gemm g{(const bf16*)(F.ws + WS_A2), (const bf16*)(F.ws + WS_WOUT), M, D, D}; pg8::StaticOrder S; S.init(MP, D, F.G, bx);
        pg8::EpiResid<0> E{X, X + (size_t)MP * D, X, XB, ssq + (size_t)5 * M, 1.0f}; pg8::gemm_phase<pg8::EpiResid<0>, pg8::StaticOrder, true, true>(F.lds + RING_OFF, g, S, E); SEAM(11); }
    FFN_GU(12, 3, 5)
    FFN_DN(13, 3, 6)
    if (IN(14)) { final_phase(F); }
#if defined(PROBE_DRY)
    xcd_barrier(bar); STAMP(15);
    { pg8::Gemm g{XB, (const bf16*)(F.ws + WS_WGU), M, 2 * FF, D}; pg8::StaticOrder S; S.init(MP, 2 * FF, F.G, bx);
      pg8::EpiNull E{H + (size_t)M * FF - 1}; pg8::gemm_phase<pg8::EpiNull, pg8::StaticOrder, true, true>(F.lds + RING_OFF, g, S, E); }
    xcd_barrier(bar); STAMP(16);
#endif
#if defined(PROBE_A_LO)
    __syncthreads();
    if (blockIdx.x == 0 && F.tid == 0) {
#define TS(k) ((unsigned long long)F.MISC[16 + 2 * (k)] | ((unsigned long long)F.MISC[17 + 2 * (k)] << 32))
        const unsigned long long ta = TS(PROBE_A_HI) - TS(PROBE_A_LO), tb = TS(PROBE_B_HI) - TS(PROBE_B_LO);
        F.out[0] += (float)tb * 1e-5f;
        const unsigned long long t0 = __builtin_amdgcn_s_memrealtime();
        while (__builtin_amdgcn_s_memrealtime() - t0 < ta * 4ull) __builtin_amdgcn_s_sleep(8);
    }
#endif
#undef IN
#undef SEAM
}

extern "C" void kernel_launch(void* const* d_in, const int* in_sizes, int n_in, void* d_out, int out_size, void* d_ws, size_t ws_size, hipStream_t stream) {
    static int grid = 0;
    if (grid == 0) {
        if (n_in != 21 || out_size != (int)O_END || ws_size < WS_END) { fprintf(stderr, "kernel_launch: unexpected shapes: n_in %d out %d ws %zu; nothing launched\n", n_in, out_size, ws_size); grid = -1; return; }
        int dev = 0, cus = 0, per_cu = 0;
        if (hipGetDevice(&dev) != hipSuccess || hipDeviceGetAttribute(&cus, hipDeviceAttributeMultiprocessorCount, dev) != hipSuccess) { grid = -1; return; }
        if (hipFuncSetAttribute((const void*)skel_fwd, hipFuncAttributeMaxDynamicSharedMemorySize, LDS_BYTES) != hipSuccess) { fprintf(stderr, "kernel_launch: hipFuncSetAttribute failed\n"); grid = -1; return; }
        if (hipOccupancyMaxActiveBlocksPerMultiprocessor(&per_cu, (const void*)skel_fwd, NWAVES * 64, LDS_BYTES) != hipSuccess || per_cu < 1) fprintf(stderr, "kernel_launch: occupancy query reports %d\n", per_cu);
        (void)hipGetLastError();
        grid = cus;
    }
    if (grid < 0) return;
    if (hipMemsetAsync((char*)d_ws + WS_CTL, 0, CTL_ZERO_BYTES, stream) != hipSuccess) return;
    Args a{};
    for (int i = 0; i < 21; ++i) a.in[i] = (const float*)d_in[i];
    a.out = (float*)d_out; a.ws = (unsigned char*)d_ws;
#if MK_ONE_LAUNCH
    a.ph_lo = 0; a.ph_hi = N_PHASES;
    hipLaunchKernelGGL(skel_fwd, dim3(grid), dim3(NWAVES * 64), LDS_BYTES, stream, a);
#else
    for (int p = 0; p < N_PHASES; ++p) { a.ph_lo = p; a.ph_hi = p + 1; hipLaunchKernelGGL(skel_fwd, dim3(grid), dim3(NWAVES * 64), LDS_BYTES, stream, a); }
#endif
}
```

```cpp
#include <hip/hip_runtime.h>
#include <cstdio>
#include <cstdint>
namespace pg8 {
#define PG8_LAS __attribute__((address_space(3)))
typedef unsigned short bf16_t;
typedef short bf16x8 __attribute__((ext_vector_type(8)));
typedef float f32x4 __attribute__((ext_vector_type(4)));
typedef unsigned u32x4 __attribute__((ext_vector_type(4)));
constexpr int BM = 256, BK = 64, HALF = 128, HTB = HALF * BK * 2  , STAGE_BYTES = 8 * HTB, NXCD = 8, WGM = 8;

__host__ __device__ __forceinline__ int lds_byte(int r, int c) { const int st = (r >> 4) * 2 + (c >> 5), rr = r & 15, cc = c & 31, ob = rr * 64 + cc * 2; return st * 1024 + (ob ^ (((ob >> 9) & 1) << 5)); }
__host__ __device__ __forceinline__ void stage_rc(int b, int& R, int& C) { const int st = b / 1024, sb = b % 1024, swz = sb ^ (((sb >> 9) & 1) << 5); R = (st >> 1) * 16 + swz / 64; C = (st & 1) * 32 + (swz % 64) / 2; }
__host__ __device__ __forceinline__ int perm32(int rho) { const int n = rho >> 4, i = rho & 15; return 8 * (i >> 2) + 4 * n + (i & 3); }

struct Unit { int pm, pn; };
struct Gemm { const bf16_t* A; const bf16_t* Bt; int M, N, K; };

struct StaticOrder {
    int nM, nN, nwg, G, c;
    __host__ __device__ void init(int M, int N, int G_, int c_) { nM = M / BM; nN = N / BM; nwg = nM * nN; G = G_; c = c_; }
    __host__ __device__ bool next(int i, Unit& u) const {
        const long L = (long)i * G + c; if (L >= nwg) return false;
        int wgid = (int)L; { const int q = nwg / NXCD, r = nwg % NXCD, xcd = wgid % NXCD, off = wgid / NXCD; wgid = (xcd < r ? xcd * (q + 1) : r * (q + 1) + (xcd - r) * q) + off; }
        const int nig = WGM * nN, gid = wgid / nig, fm = gid * WGM, gsz = (nM - fm) < WGM ? (nM - fm) : WGM;
        u.pm = fm + ((wgid % nig) % gsz); u.pn = (wgid % nig) / gsz; return true;
    }
    __device__ __forceinline__ void a_ready(const Unit&) const {}
    __device__ __forceinline__ void done(const Unit&) const {}
};


__device__ __forceinline__ unsigned cvt_pk_bf16(float lo, float hi) { unsigned r; asm volatile("v_cvt_pk_bf16_f32 %0, %1, %2" : "=v"(r) : "v"(lo), "v"(hi)); return r; }

typedef unsigned u32x2 __attribute__((ext_vector_type(2)));
constexpr float RMS_EPS = 1e-6f;
constexpr float INV_D = 1.0f / 1024.0f;
__device__ __forceinline__ float sigmoid_f(float x) { return __builtin_amdgcn_rcpf(1.0f + __builtin_amdgcn_exp2f(-1.4426950408889634f * x)); }
typedef unsigned long long ssq_t;
constexpr float SSQ_SCALE = 16777216.0f, SSQ_INV = 1.0f / 16777216.0f;
__device__ __forceinline__ ssq_t ssq_fix(float s) { return (ssq_t)(s * SSQ_SCALE + 0.5f); }
__device__ __forceinline__ float rstd_of(ssq_t q) { return __builtin_amdgcn_rsqf((float)q * (SSQ_INV * INV_D) + RMS_EPS); }
#define PG8_EPI_CALL() \
    __device__ __forceinline__ void operator()(const f32x4 (&acc)[2][2][4][2], const Unit& u, int wr, int wc, int fr, int fq) const { \
        _Pragma("unroll") for (int ai = 0; ai < 2; ++ai) _Pragma("unroll") for (int m = 0; m < 4; ++m) { \
            const f32x4 a[2][2] = {{acc[ai][0][m][0], acc[ai][0][m][1]}, {acc[ai][1][m][0], acc[ai][1][m][1]}}; rg(a, u, ai, m, 3, wr, wc, fr, fq); } }

struct EpiGateUp {
    static constexpr bool PERM = true, AFTER_DRAIN = false;
    bf16_t* H; int ldh; const ssq_t* ssq;
    __device__ __forceinline__ void rg(const f32x4 (&a)[2][2], const Unit& u, int ai, int m, int bjmask, int wr, int wc, int fr, int fq) const {
        const int row = u.pm * BM + ai * HALF + wr * 64 + m * 16 + fr, col0 = u.pn * HALF + wc * 32 + 8 * fq;
        const float rs = rstd_of(ssq[row]);
        float h[8];
#pragma unroll
        for (int n = 0; n < 2; ++n)
#pragma unroll
            for (int e = 0; e < 4; ++e) { const float g = a[0][n][e] * rs, up = a[1][n][e] * rs; h[4 * n + e] = g * sigmoid_f(g) * up; }
        u32x4 w; w.x = cvt_pk_bf16(h[0], h[1]); w.y = cvt_pk_bf16(h[2], h[3]); w.z = cvt_pk_bf16(h[4], h[5]); w.w = cvt_pk_bf16(h[6], h[7]);
        *(u32x4*)(H + (size_t)row * ldh + col0) = w;
    }
    __device__ __forceinline__ void rgx(const f32x4 (&ax)[2], const Unit& u, int wr, int wc, int fr, int fq) const {
        const int row = 16384 + 16 * u.pm + fr, col0 = u.pn * HALF + wc * 32 + 8 * fq + 4 * wr;
        const float rs = rstd_of(ssq[row]);
        float h[4];
#pragma unroll
        for (int e = 0; e < 4; ++e) { const float g = ax[0][e] * rs, up = ax[1][e] * rs; h[e] = g * sigmoid_f(g) * up; }
        u32x2 w; w.x = cvt_pk_bf16(h[0], h[1]); w.y = cvt_pk_bf16(h[2], h[3]);
        *(u32x2*)(H + (size_t)row * ldh + col0) = w;
    }
    PG8_EPI_CALL()
};

__device__ __forceinline__ void unpack8(const u32x4 w, float (&x)[8]) {
#pragma unroll
    for (int e = 0; e < 4; ++e) { x[2 * e] = __builtin_bit_cast(float, w[e] << 16); x[2 * e + 1] = __builtin_bit_cast(float, w[e] & 0xffff0000u); } }
template <int MODE> struct EpiResid {
    static constexpr bool PERM = true, AFTER_DRAIN = false;
    const float* xin_p; const float* xin_s; bf16_t* XB; ssq_t* ssq; float scale;
    __device__ __forceinline__ void rg(const f32x4 (&a)[2][2], const Unit& u, int ai, int m, int bjmask, int wr, int wc, int fr, int fq) const {
        const int row = u.pm * BM + ai * HALF + wr * 64 + m * 16 + fr;
        const int col0 = (MODE == 0 ? u.pn * BM : u.pn * HALF) + wc * 32 + 8 * fq;
        float sq = 0.f;
#pragma unroll
        for (int bj = 0; bj < (MODE == 0 ? 2 : 1); ++bj) {
            bf16_t* xp = XB + (size_t)row * 1024 + col0 + bj * HALF;
            float x[8];
            if (xin_p) { const float* xi = xin_p + (size_t)row * 1024 + col0 + bj * HALF; const f32x4 x0 = *(const f32x4*)xi, x1 = *(const f32x4*)(xi + 4);
#pragma unroll
                for (int e = 0; e < 4; ++e) { x[e] = x0[e]; x[4 + e] = x1[e]; } }
            else unpack8(*(const u32x4*)xp, x);
#pragma unroll
            for (int e = 0; e < 4; ++e) {
                if (MODE == 0) { x[e] += a[bj][0][e] * scale; x[4 + e] += a[bj][1][e] * scale; }
                else { x[e] += a[0][0][e] * sigmoid_f(a[1][0][e]); x[4 + e] += a[0][1][e] * sigmoid_f(a[1][1][e]); } }
            u32x4 w; w.x = cvt_pk_bf16(x[0], x[1]); w.y = cvt_pk_bf16(x[2], x[3]); w.z = cvt_pk_bf16(x[4], x[5]); w.w = cvt_pk_bf16(x[6], x[7]);
            *(u32x4*)xp = w;
            sq += (x[0] * x[0] + x[1] * x[1]) + (x[2] * x[2] + x[3] * x[3]) + (x[4] * x[4] + x[5] * x[5]) + (x[6] * x[6] + x[7] * x[7]); }
        sq += __shfl_xor(sq, 16); sq += __shfl_xor(sq, 32);
        if (fq == 0) atomicAdd(ssq + row, ssq_fix(sq));
    }
    __device__ __forceinline__ void rgx(const f32x4 (&ax)[2], const Unit& u, int wr, int wc, int fr, int fq) const {
        const int r2 = 16 * u.pm + fr, row = 16384 + r2;
        const int col0 = (MODE == 0 ? u.pn * BM : u.pn * HALF) + wc * 32 + 8 * fq + 4 * wr;
        float sq = 0.f;
#pragma unroll
        for (int bj = 0; bj < (MODE == 0 ? 2 : 1); ++bj) {
            bf16_t* xp = XB + (size_t)row * 1024 + col0 + bj * HALF;
            f32x4 x0;
            if (xin_s) x0 = *(const f32x4*)(xin_s + (size_t)r2 * 1024 + col0 + bj * HALF);
            else { const u32x2 w = *(const u32x2*)xp; x0[0] = __builtin_bit_cast(float, w.x << 16); x0[1] = __builtin_bit_cast(float, w.x & 0xffff0000u); x0[2] = __builtin_bit_cast(float, w.y << 16); x0[3] = __builtin_bit_cast(float, w.y & 0xffff0000u); }
            if (MODE == 0) x0 += ax[bj] * scale;
            else {
#pragma unroll
                for (int e = 0; e < 4; ++e) x0[e] += ax[0][e] * sigmoid_f(ax[1][e]); }
            u32x2 w; w.x = cvt_pk_bf16(x0[0], x0[1]); w.y = cvt_pk_bf16(x0[2], x0[3]);
            *(u32x2*)xp = w;
            sq += (x0[0] * x0[0] + x0[1] * x0[1]) + (x0[2] * x0[2] + x0[3] * x0[3]); }
        sq += __shfl_xor(sq, 16); sq += __shfl_xor(sq, 32);
        if (fq == 0) atomicAdd(ssq + row, ssq_fix(sq));
    }
    PG8_EPI_CALL()
};

struct EpiConvIn {
    static constexpr bool PERM = true, AFTER_DRAIN = false;
    bf16_t* Z; bf16_t* GB; const ssq_t* ssq; float* conv_p; float* conv_s;
    __device__ __forceinline__ void rg(const f32x4 (&a)[2][2], const Unit& u, int ai, int m, int bjmask, int wr, int wc, int fr, int fq) const {
        const int row = u.pm * BM + ai * HALF + wr * 64 + m * 16 + fr;
        const float rs = rstd_of(ssq[row]);
        if (u.pn < 8) {
            const int col0 = u.pn * HALF + wc * 32 + 8 * fq; const float rs2 = rs * rs;
            const f32x4 z0 = a[0][0] * a[1][0] * rs2, z1 = a[0][1] * a[1][1] * rs2;
            u32x4 w; w.x = cvt_pk_bf16(z0[0], z0[1]); w.y = cvt_pk_bf16(z0[2], z0[3]); w.z = cvt_pk_bf16(z1[0], z1[1]); w.w = cvt_pk_bf16(z1[2], z1[3]);
            *(u32x4*)(Z + (size_t)row * 1024 + col0) = w;
            float* cp = nullptr;
            if (row < 16384) { const int t = row & 2047; if (t >= 2046) cp = conv_p + ((size_t)(row >> 11) * 2 + (t - 2046)) * 1024 + col0; }
            else { const int r2 = row - 16384, t = r2 & 7; if (t >= 6) cp = conv_s + ((size_t)(r2 >> 3) * 2 + (t - 6)) * 1024 + col0; }
            if (cp) { *(f32x4*)cp = z0; *(f32x4*)(cp + 4) = z1; }
        } else {
            const int col0 = (u.pn - 8) * BM + wc * 32 + 8 * fq;
#pragma unroll
            for (int bj = 0; bj < 2; ++bj) { const f32x4 g0 = a[bj][0] * rs, g1 = a[bj][1] * rs;
                u32x4 w; w.x = cvt_pk_bf16(g0[0], g0[1]); w.y = cvt_pk_bf16(g0[2], g0[3]); w.z = cvt_pk_bf16(g1[0], g1[1]); w.w = cvt_pk_bf16(g1[2], g1[3]);
                *(u32x4*)(GB + (size_t)row * 1024 + col0 + bj * HALF) = w; }
        }
    }
    __device__ __forceinline__ void rgx(const f32x4 (&ax)[2], const Unit& u, int wr, int wc, int fr, int fq) const {
        const int r2 = 16 * u.pm + fr, row = 16384 + r2;
        const float rs = rstd_of(ssq[row]);
        if (u.pn < 8) {
            const int col0 = u.pn * HALF + wc * 32 + 8 * fq + 4 * wr;
            const f32x4 z0 = ax[0] * ax[1] * (rs * rs);
            u32x2 w; w.x = cvt_pk_bf16(z0[0], z0[1]); w.y = cvt_pk_bf16(z0[2], z0[3]);
            *(u32x2*)(Z + (size_t)row * 1024 + col0) = w;
            const int t = r2 & 7;
            if (t >= 6) *(f32x4*)(conv_s + ((size_t)(r2 >> 3) * 2 + (t - 6)) * 1024 + col0) = z0;
        } else {
            const int col0 = (u.pn - 8) * BM + wc * 32 + 8 * fq + 4 * wr;
#pragma unroll
            for (int bj = 0; bj < 2; ++bj) { const f32x4 g0 = ax[bj] * rs;
                u32x2 w; w.x = cvt_pk_bf16(g0[0], g0[1]); w.y = cvt_pk_bf16(g0[2], g0[3]);
                *(u32x2*)(GB + (size_t)row * 1024 + col0 + bj * HALF) = w; }
        }
    }
    PG8_EPI_CALL()
};

struct EpiNull {
    static constexpr bool PERM = true, AFTER_DRAIN = false;
    bf16_t* sink;
    __device__ __forceinline__ void rg(const f32x4 (&a)[2][2], const Unit& u, int ai, int m, int bjmask, int wr, int wc, int fr, int fq) const {
        asm volatile("" :: "v"(a[0][0]), "v"(a[0][1]), "v"(a[1][0]), "v"(a[1][1]));
    }
    __device__ __forceinline__ void rgx(const f32x4 (&ax)[2], const Unit& u, int wr, int wc, int fr, int fq) const { asm volatile("" :: "v"(ax[0]), "v"(ax[1])); }
    PG8_EPI_CALL()
};

template <class Epi, class Sched, bool ALIGN_EPI = false, bool SP2 = false, int PROBE = 0>
__device__ __forceinline__ void gemm_phase(PG8_LAS unsigned char* lds, const Gemm g, const Sched& S, const Epi& E) {
    int tid_ = threadIdx.x; asm volatile("" : "+v"(tid_));
    const int tid = tid_, wid = __builtin_amdgcn_readfirstlane(tid >> 6), lane = tid & 63, wr = wid >> 2, wc = wid & 3, fr = lane & 15, fq = lane >> 4;
    const int K = g.K, nt = K / BK;
    constexpr int XROW0 = 16384, XR = 16;
    unsigned voffA[2], voffB[2];
#pragma unroll
    for (int i = 0; i < 2; ++i) { int R, C; stage_rc(tid * 16 + i * 8192, R, C); const int Rb = Epi::PERM ? ((R & ~31) + perm32(R & 31)) : R;
        voffA[i] = (unsigned)(R * K + C) * 2u; voffB[i] = (unsigned)(Rb * K + C) * 2u; }
    unsigned voffX; { const int row = wid * 2 + (lane >> 5), q = (lane & 31) * 4, kb = q ^ (((row >> 1) & 7) << 4); voffX = (unsigned)(row * K * 2 + kb); }
    const int xoff0 = fr * 128 + ((fq * 16) ^ (((fr >> 1) & 7) << 4)), xoff1 = fr * 128 + ((64 + fq * 16) ^ (((fr >> 1) & 7) << 4));
    const unsigned kstep = (unsigned)(BK * 2);
    const unsigned hstep = (unsigned)HALF * K * 2;
    const unsigned tstep = 2 * hstep;
    const __amdgpu_buffer_rsrc_t rsA = __builtin_amdgcn_make_buffer_rsrc((void*)g.A, 0, 0x7ffff000, 0x00020000), rsB = __builtin_amdgcn_make_buffer_rsrc((void*)g.Bt, 0, 0x7ffff000, 0x00020000);
    const unsigned ldsw = (unsigned)wid * 1024u;
    const int aoff = lds_byte(wr * 64 + fr, fq * 8), boff = lds_byte(wc * 32 + fr, fq * 8);
#define PG8_SA(b, h) (((b) * 2 + (h)) * HTB)
#define PG8_SB(b, h) ((4 + (b) * 2 + (h)) * HTB)
#define PG8_SX(b) (STAGE_BYTES + (b) * 2048)
#define PG8_STAGEX(b, soff) __builtin_amdgcn_raw_ptr_buffer_load_lds(rsA, (PG8_LAS unsigned*)(lds + PG8_SX(b) + wid * 256), 4, voffX, (soff), 0, 0)
#define PG8_LDAX(dst, b) do { dst[0] = *(const PG8_LAS bf16x8*)(lds + PG8_SX(b) + xoff0); dst[1] = *(const PG8_LAS bf16x8*)(lds + PG8_SX(b) + xoff1); } while (0)
#define PG8_MMAX_NULL() do { asm volatile("" :: "v"(Ax[0]), "v"(Ax[1])); } while (0)
#define PG8_MMAX_REAL() do { if (wr == 0) { _Pragma("unroll") for (int k = 0; k < 2; ++k) { accx[0] = __builtin_amdgcn_mfma_f32_16x16x32_bf16(B0[0][k], Ax[k], accx[0], 0, 0, 0); accx[1] = __builtin_amdgcn_mfma_f32_16x16x32_bf16(B1[0][k], Ax[k], accx[1], 0, 0, 0); } } \
        else { _Pragma("unroll") for (int k = 0; k < 2; ++k) { accx[0] = __builtin_amdgcn_mfma_f32_16x16x32_bf16(B0[1][k], Ax[k], accx[0], 0, 0, 0); accx[1] = __builtin_amdgcn_mfma_f32_16x16x32_bf16(B1[1][k], Ax[k], accx[1], 0, 0, 0); } } } while (0)
#define PG8_MMAX() do { if constexpr ((PROBE & 1) != 0) PG8_MMAX_NULL(); else PG8_MMAX_REAL(); } while (0)
#define PG8_STAGEA(bufoff, soff) do { _Pragma("unroll") for (int _i = 0; _i < 2; ++_i) \
        __builtin_amdgcn_raw_ptr_buffer_load_lds(rsA, (PG8_LAS unsigned*)(lds + (bufoff) + ldsw + _i * 8192), 16, voffA[_i], (soff), 0, 0); } while (0)
#define PG8_STAGEB(bufoff, soff) do { _Pragma("unroll") for (int _i = 0; _i < 2; ++_i) \
        __builtin_amdgcn_raw_ptr_buffer_load_lds(rsB, (PG8_LAS unsigned*)(lds + (bufoff) + ldsw + _i * 8192), 16, voffB[_i], (soff), 0, 0); } while (0)
#define PG8_LDA(dst, b, h) do { _Pragma("unroll") for (int m = 0; m < 4; ++m) _Pragma("unroll") for (int k = 0; k < 2; ++k) dst[m][k] = *(const PG8_LAS bf16x8*)(lds + PG8_SA(b, h) + aoff + m * 2048 + k * 1024); } while (0)
#define PG8_LDB(dst, b, h) do { _Pragma("unroll") for (int n = 0; n < 2; ++n) _Pragma("unroll") for (int k = 0; k < 2; ++k) dst[n][k] = *(const PG8_LAS bf16x8*)(lds + PG8_SB(b, h) + boff + n * 2048 + k * 1024); } while (0)
#define PG8_MMA_NULL(ai, bj, At, Bt) do { _Pragma("unroll") for (int m = 0; m < 4; ++m) _Pragma("unroll") for (int k = 0; k < 2; ++k) asm volatile("" :: "v"(At[m][k])); _Pragma("unroll") for (int n = 0; n < 2; ++n) _Pragma("unroll") for (int k = 0; k < 2; ++k) asm volatile("" :: "v"(Bt[n][k])); } while (0)
#define PG8_MMA_REAL(ai, bj, At, Bt) do { __builtin_amdgcn_s_setprio(1); _Pragma("unroll") for (int m = 0; m < 4; ++m) _Pragma("unroll") for (int n = 0; n < 2; ++n) _Pragma("unroll") for (int k = 0; k < 2; ++k) \
        acc[ai][bj][m][n] = __builtin_amdgcn_mfma_f32_16x16x32_bf16(Bt[n][k], At[m][k], acc[ai][bj][m][n], 0, 0, 0); __builtin_amdgcn_s_setprio(0); } while (0)
#define PG8_MMA(ai, bj, At, Bt) do { if constexpr ((PROBE & 1) != 0) PG8_MMA_NULL(ai, bj, At, Bt); else PG8_MMA_REAL(ai, bj, At, Bt); } while (0)
#define PG8_WAIT_V(n) asm volatile("s_waitcnt vmcnt(" #n ")" ::: "memory")
#define PG8_WAIT_L(n) asm volatile("s_waitcnt lgkmcnt(" #n ")" ::: "memory")
#define PG8_BAR __builtin_amdgcn_s_barrier()
#define PG8_SCHED __builtin_amdgcn_sched_barrier(0)
    Unit cur, nxt; int ui = 0;
    if (!S.next(0, cur)) return;
    f32x4 acc[2][2][4][2];
#pragma unroll
    for (int a = 0; a < 2; ++a)
#pragma unroll
        for (int b = 0; b < 2; ++b)
#pragma unroll
            for (int m = 0; m < 4; ++m)
#pragma unroll
                for (int n = 0; n < 2; ++n) acc[a][b][m][n] = (f32x4){0.f, 0.f, 0.f, 0.f};
    bf16x8 At[4][2], B0[2][2], B1[2][2], Ax[2];
    f32x4 accx[2] = {(f32x4){0.f, 0.f, 0.f, 0.f}, (f32x4){0.f, 0.f, 0.f, 0.f}};
    unsigned cA = (unsigned)cur.pm * tstep, cB = (unsigned)cur.pn * tstep;
    const unsigned xstep = (unsigned)XR * K * 2, xbase = (unsigned)XROW0 * K * 2; unsigned cX = xbase + (unsigned)cur.pm * xstep;
    S.a_ready(cur);
    if constexpr (SP2) {
        PG8_STAGEB(PG8_SB(0, 0), cB); PG8_STAGEB(PG8_SB(0, 1), cB + hstep); PG8_STAGEA(PG8_SA(0, 0), cA); PG8_STAGEX(0, cX); PG8_STAGEA(PG8_SA(0, 1), cA + hstep);
        if (wr == 1) PG8_BAR;
        PG8_WAIT_V(2); PG8_BAR;
        PG8_STAGEB(PG8_SB(1, 0), cB + kstep); PG8_STAGEA(PG8_SA(1, 0), cA + kstep); PG8_STAGEB(PG8_SB(1, 1), cB + hstep + kstep); PG8_STAGEX(1, cX + kstep);
        PG8_WAIT_V(7); PG8_BAR;
    } else {
        PG8_STAGEB(PG8_SB(0, 0), cB); PG8_STAGEA(PG8_SA(0, 0), cA); PG8_STAGEB(PG8_SB(0, 1), cB + hstep); PG8_STAGEA(PG8_SA(0, 1), cA + hstep);
        if (wr == 1) PG8_BAR;
        PG8_WAIT_V(4); PG8_BAR;
        PG8_STAGEB(PG8_SB(1, 0), cB + kstep); PG8_STAGEA(PG8_SA(1, 0), cA + kstep); PG8_STAGEB(PG8_SB(1, 1), cB + hstep + kstep);
        PG8_WAIT_V(6); PG8_BAR;
    }
    for (;;) {
        const bool has_next = S.next(ui + 1, nxt);
        const unsigned nA = has_next ? (unsigned)nxt.pm * tstep : cA, nB = has_next ? (unsigned)nxt.pn * tstep : cB, nX = has_next ? xbase + (unsigned)nxt.pm * xstep : cX;
        for (int t = 0; t < nt; t += 2) {
            const bool last = (t == nt - 2);
            const unsigned a1 = cA + (unsigned)(t + 1) * kstep;
            const unsigned a2 = last ? nA : cA + (unsigned)(t + 2) * kstep, b2 = last ? nB : cB + (unsigned)(t + 2) * kstep;
            const unsigned a3 = a2 + kstep, b3 = b2 + kstep, x2 = last ? nX : cX + (unsigned)(t + 2) * kstep, x3 = x2 + kstep;
            if (last && has_next) S.a_ready(nxt);
            if constexpr (SP2) {
            PG8_LDB(B0, 0, 0); PG8_LDB(B1, 0, 1); PG8_SCHED; PG8_LDA(At, 0, 0); PG8_LDAX(Ax, 0); PG8_STAGEA(PG8_SA(1, 1), a1 + hstep);
            PG8_WAIT_V(9); PG8_WAIT_L(0); PG8_BAR; PG8_MMA(0, 0, At, B0); PG8_MMA(0, 1, At, B1); PG8_MMAX(); PG8_BAR; PG8_SCHED;
            PG8_LDA(At, 0, 1); PG8_STAGEB(PG8_SB(0, 0), b2); PG8_STAGEB(PG8_SB(0, 1), b2 + hstep); PG8_STAGEA(PG8_SA(0, 0), a2); PG8_STAGEX(0, x2);
            PG8_WAIT_V(9); PG8_WAIT_L(0); PG8_BAR; PG8_MMA(1, 0, At, B0); PG8_MMA(1, 1, At, B1); PG8_BAR; PG8_SCHED;
            PG8_LDB(B0, 1, 0); PG8_LDB(B1, 1, 1); PG8_SCHED; PG8_LDA(At, 1, 0); PG8_LDAX(Ax, 1); PG8_STAGEA(PG8_SA(0, 1), a2 + hstep);
            PG8_WAIT_V(9); PG8_WAIT_L(0); PG8_BAR; PG8_MMA(0, 0, At, B0); PG8_MMA(0, 1, At, B1); PG8_MMAX(); PG8_BAR; PG8_SCHED;
            PG8_LDA(At, 1, 1); PG8_STAGEB(PG8_SB(1, 0), b3); PG8_STAGEB(PG8_SB(1, 1), b3 + hstep); PG8_STAGEA(PG8_SA(1, 0), a3); PG8_STAGEX(1, x3);
            PG8_WAIT_V(9); PG8_WAIT_L(0); PG8_BAR; PG8_MMA(1, 0, At, B0); PG8_MMA(1, 1, At, B1); PG8_BAR; PG8_SCHED;
            } else {
            PG8_LDB(B0, 0, 0); PG8_SCHED; PG8_LDA(At, 0, 0); PG8_STAGEA(PG8_SA(1, 1), a1 + hstep);
            PG8_WAIT_L(8); PG8_BAR; PG8_WAIT_L(0); PG8_MMA(0, 0, At, B0); PG8_BAR; PG8_SCHED;
            PG8_LDB(B1, 0, 1); PG8_STAGEB(PG8_SB(0, 0), b2);
            PG8_BAR; PG8_WAIT_L(0); PG8_MMA(0, 1, At, B1); PG8_BAR;
            PG8_LDA(At, 0, 1); PG8_STAGEA(PG8_SA(0, 0), a2);
            PG8_BAR; PG8_WAIT_L(0); PG8_MMA(1, 0, At, B0); PG8_BAR; PG8_SCHED;
            PG8_STAGEB(PG8_SB(0, 1), b2 + hstep);
            PG8_WAIT_V(6); PG8_BAR; PG8_MMA(1, 1, At, B1); PG8_BAR;
            PG8_LDB(B0, 1, 0); PG8_SCHED; PG8_LDA(At, 1, 0); PG8_STAGEA(PG8_SA(0, 1), a2 + hstep);
            PG8_WAIT_L(8); PG8_BAR; PG8_WAIT_L(0); PG8_MMA(0, 0, At, B0); PG8_BAR; PG8_SCHED;
            PG8_LDB(B1, 1, 1); PG8_STAGEB(PG8_SB(1, 0), b3);
            PG8_BAR; PG8_WAIT_L(0); PG8_MMA(0, 1, At, B1); PG8_BAR;
            PG8_LDA(At, 1, 1); PG8_STAGEA(PG8_SA(1, 0), a3);
            PG8_BAR; PG8_WAIT_L(0); PG8_MMA(1, 0, At, B0); PG8_BAR; PG8_SCHED;
            PG8_STAGEB(PG8_SB(1, 1), b3 + hstep);
            PG8_WAIT_V(6); PG8_BAR; PG8_MMA(1, 1, At, B1); PG8_BAR;
            }
        }
        if constexpr (ALIGN_EPI) { if (wr == 0) PG8_BAR; }
        E(acc, cur, wr, wc, fr, fq); E.rgx(accx, cur, wr, wc, fr, fq);
        if (!has_next) break;
#pragma unroll
        for (int a = 0; a < 2; ++a)
#pragma unroll
            for (int b = 0; b < 2; ++b)
#pragma unroll
                for (int m = 0; m < 4; ++m)
#pragma unroll
                    for (int n = 0; n < 2; ++n) acc[a][b][m][n] = (f32x4){0.f, 0.f, 0.f, 0.f};
        accx[0] = (f32x4){0.f, 0.f, 0.f, 0.f}; accx[1] = (f32x4){0.f, 0.f, 0.f, 0.f};
        cur = nxt; cA = nA; cB = nB; cX = nX; ++ui;
        if constexpr (ALIGN_EPI) { if (wr == 1) PG8_BAR; }
    }
    PG8_WAIT_V(0);
    if constexpr (!ALIGN_EPI) { if (wr == 0) PG8_BAR; }
    PG8_BAR;
#undef PG8_SA
#undef PG8_SB
#undef PG8_STAGEA
#undef PG8_STAGEB
#undef PG8_SX
#undef PG8_STAGEX
#undef PG8_LDAX
#undef PG8_MMAX
#undef PG8_LDA
#undef PG8_LDB
#undef PG8_MMA
#undef PG8_WAIT_V
#undef PG8_WAIT_L
#undef PG8_BAR
#undef PG8_SCHED
}
}

#define GAS __attribute__((address_space(1)))
#define LAS __attribute__((address_space(3)))
typedef unsigned short bf16;
typedef unsigned v4u __attribute__((ext_vector_type(4)));
typedef float f32x4 __attribute__((ext_vector_type(4)));
typedef short bf16x8 __attribute__((ext_vector_type(8)));
typedef GAS unsigned gu32;
typedef GAS unsigned long long gu64;
#define RLX_AGENT __ATOMIC_RELAXED, __HIP_MEMORY_SCOPE_AGENT
#define LDS_WAIT() asm volatile("s_waitcnt lgkmcnt(0)" ::: "memory")
#define VM_WAIT() asm volatile("s_waitcnt vmcnt(0)" ::: "memory")
__device__ __forceinline__ unsigned long long rt() { return __builtin_amdgcn_s_memrealtime(); }
__device__ __forceinline__ unsigned f2bf(float f) { unsigned u = __builtin_bit_cast(unsigned, f); return (u + 0x7fffu + ((u >> 16) & 1u)) >> 16; }
__device__ __forceinline__ unsigned pk2(float lo, float hi) { return f2bf(lo) | (f2bf(hi) << 16); }

#define XB_TMO      128
#define XB_XCNT(j)  (256  + 64 * (j))
#define XB_XSUB(j)  (1280 + 64 * (j))
#define XB_XGEN(j)  (2304 + 64 * (j))
#define XB_TOP      3328
#define XB_TOPGEN   3392
#define XCD_BAR_WORDS 3456
#define XB_SPIN_CAP (1u << 18)

__device__ __forceinline__ unsigned xb_ld(unsigned* p)              { return __hip_atomic_load(p, __ATOMIC_RELAXED, __HIP_MEMORY_SCOPE_AGENT); }
__device__ __forceinline__ unsigned xb_add(unsigned* p, unsigned v) { return __hip_atomic_fetch_add(p, v, __ATOMIC_RELAXED, __HIP_MEMORY_SCOPE_AGENT); }
__device__ __forceinline__ unsigned xb_xcc_id() { return (unsigned)__builtin_amdgcn_s_getreg((3 << 11) | 20) & 0xFu; }
#define XB_SPIN(cond, bar) do { unsigned _sp = 0; while (cond) { __builtin_amdgcn_s_sleep(1); \
    if ((++_sp & 255u) == 0u) { if (xb_ld(&(bar)[XB_TMO])) break; if (_sp > XB_SPIN_CAP) { atomicAdd(&(bar)[XB_TMO], 1u); break; } } } } while (0)

struct XcdBarrier {
    unsigned* bar; unsigned x;
    volatile LAS unsigned* st;
};

__device__ __forceinline__ XcdBarrier xcd_barrier_post(unsigned* bar, volatile LAS unsigned* st) {
    XcdBarrier b; b.bar = bar; b.x = xb_xcc_id(); b.st = st;
    if (threadIdx.x == 0) (void)xb_add(&bar[XB_XCNT(b.x)], 1u);
    return b;
}
__device__ __forceinline__ void xcd_barrier_complete(unsigned* bar, unsigned x, unsigned& nloc, unsigned& nx) {
    const unsigned G = gridDim.x * gridDim.y * gridDim.z;
    unsigned sum, cnt, mine, sp = 0u;
    for (;;) {
        sum = 0u; cnt = 0u; mine = 0u;
#pragma unroll
        for (unsigned j = 0; j < 16; ++j) { const unsigned c = xb_ld(&bar[XB_XCNT(j)]); sum += c; cnt += (c > 0u) ? 1u : 0u; mine = (j == x) ? c : mine; }
        if (sum == G) break;
        __builtin_amdgcn_s_sleep(1);
        if ((++sp & 255u) == 0u) { if (xb_ld(&bar[XB_TMO])) break; if (sp > XB_SPIN_CAP) { atomicAdd(&bar[XB_TMO], 1u); break; } }
    }
    nloc = mine > 0u ? mine : 1u; nx = cnt > 0u ? cnt : 1u;
}

__device__ __forceinline__ void xcd_barrier(const XcdBarrier& b) {
    asm volatile("s_waitcnt vmcnt(0)" ::: "memory");
    __syncthreads();
    if (threadIdx.x == 0) {
        unsigned* bar = b.bar;
        __builtin_amdgcn_s_waitcnt(0);
        unsigned nloc = b.st[0], nx = b.st[1];
        if (nloc == 0u) { xcd_barrier_complete(bar, b.x, nloc, nx); b.st[0] = nloc; b.st[1] = nx; }
        const unsigned old = xb_add(&bar[XB_XSUB(b.x)], 1u);
        const unsigned gen = old / nloc;
        if (old + 1u == (gen + 1u) * nloc) {
            __builtin_amdgcn_fence(__ATOMIC_RELEASE, "agent");
            asm volatile("s_waitcnt vmcnt(0)" ::: "memory");
            const unsigned og = xb_add(&bar[XB_TOP], 1u);
            const unsigned tg = og / nx;
            if (og + 1u == (tg + 1u) * nx) xb_add(&bar[XB_TOPGEN], 1u);
            else XB_SPIN(xb_ld(&bar[XB_TOPGEN]) == tg, bar);
            __builtin_amdgcn_fence(__ATOMIC_ACQUIRE, "agent");
            xb_add(&bar[XB_XGEN(b.x)], 1u);
            asm volatile("s_waitcnt vmcnt(0)" ::: "memory");
        } else {
            XB_SPIN(xb_ld(&bar[XB_XGEN(b.x)]) == gen, bar);
            __builtin_amdgcn_fence(__ATOMIC_ACQUIRE, "agent");
            asm volatile("s_waitcnt vmcnt(0)" ::: "memory");
        }
    }
    __syncthreads();
}


constexpr int NWAVES = 8;
#ifndef MK_ONE_LAUNCH
#define MK_ONE_LAUNCH 1
#endif
constexpr int N_PHASES = 15;

constexpr int D = 1024, FF = 4096, MP = 8 * 2048, MS = 128 * 8, M = MP + MS;
constexpr int NG = 64, PS = 64, GS = 16;
constexpr float EPS = 1e-6f;
constexpr size_t O_Y = 0, O_SRP = (size_t)M * D, O_SIP = O_SRP + 8 * 4096, O_CP = O_SIP + 8 * 4096, O_SRS = O_CP + 8 * 2 * 1024, O_SIS = O_SRS + 128 * 4096, O_CS = O_SIS + 128 * 4096, O_END = O_CS + 128 * 2 * 1024;
static_assert(O_END == 19218432, "output size");

constexpr size_t MiB = 1u << 20;
constexpr size_t WS_CTL = 0, CTL_ZERO_BYTES = 1 * MiB;
constexpr size_t WS_SSQ = 112 * MiB;
constexpr size_t WS_SSMP = 2 * MiB;
constexpr size_t WS_WGU = 4 * MiB;
constexpr size_t WS_WD = 68 * MiB;
constexpr size_t WS_WGLU = 100 * MiB;
constexpr size_t WS_WIN = 104 * MiB;
constexpr size_t WS_WOUT = 110 * MiB;
constexpr size_t WS_X = 112 * MiB;
constexpr size_t WS_XB = 180 * MiB;
constexpr size_t WS_H = 214 * MiB;
constexpr size_t WS_G = WS_H, WS_Z = WS_H, WS_GB = WS_H + 34 * MiB, WS_A2 = WS_H + 68 * MiB;
constexpr size_t WS_SLAB = 350 * MiB;
constexpr size_t WS_END = 414 * MiB;
constexpr int CW_TMO = 0;
constexpr int CW_BAR = 4096;
constexpr int CW_SK = 16384;

constexpr int RING_OFF = 0, RING_BYTES = 131072 + 4096;
constexpr int LDSCTL_OFF = RING_BYTES, MISC_OFF = LDSCTL_OFF + 320;
constexpr int LDS_BYTES = 147456;

struct Frame {
    LAS unsigned char* lds;
    volatile LAS unsigned* MISC;
    gu32* ctl;
    int tid, lane, wave, vcu, G;
    const float* in[21]; float* out; unsigned char* ws;
};

__device__ __forceinline__ int opaque_i(int v) { asm volatile("" : "+v"(v)); return v; }
__device__ __forceinline__ float wave_sum(float v) {
#pragma unroll
    for (int o = 1; o < 64; o <<= 1) v += __shfl_xor(v, o);
    return v;
}
__device__ __forceinline__ float bf2f(unsigned short b) { return __builtin_bit_cast(float, (unsigned)b << 16); }

__device__ __forceinline__ void p0_transpose_item(const float* W, int K, int N, bf16* WT, const float* gk, int k0, int n0s, int n0d, LAS unsigned char* scr, int lane) {
    const int kr = lane >> 4, c = lane & 15;
    f32x4 v[8][2];
#pragma unroll
    for (int i = 0; i < 8; ++i)
#pragma unroll
        for (int s = 0; s < 2; ++s) v[i][s] = *(const GAS f32x4*)(W + (size_t)(k0 + 8 * i + 2 * kr + s) * N + n0s + 4 * c);
    if (gk) {
#pragma unroll
        for (int i = 0; i < 8; ++i)
#pragma unroll
            for (int s = 0; s < 2; ++s) v[i][s] = v[i][s] * gk[k0 + 8 * i + 2 * kr + s]; }
#pragma unroll
    for (int i = 0; i < 8; ++i)
#pragma unroll
        for (int j = 0; j < 4; ++j) *(LAS unsigned*)(scr + (4 * c + j) * 128 + (((4 * i + kr) ^ ((c & 7) << 2)) << 2)) = pg8::cvt_pk_bf16(v[i][0][j], v[i][1][j]);
    LDS_WAIT(); asm volatile("" ::: "memory");
    const int nr = lane >> 3, q = lane & 7;
#pragma unroll
    for (int i = 0; i < 8; ++i) { const int n = nr + 8 * i; const v4u o = *(const LAS v4u*)(scr + n * 128 + ((q ^ ((n >> 2) & 7)) << 4));
        *(GAS v4u*)(WT + (size_t)(n0d + n) * K + k0 + 8 * q) = o; }
    LDS_WAIT(); asm volatile("" ::: "memory");
}
__device__ __forceinline__ int pair_src(int nd, int base, int hstride) { return base + ((nd >> 7) & 1) * hstride + 128 * (nd >> 8) + (nd & 127); }

__device__ __forceinline__ void p0_prologue(Frame& F) {
    LAS unsigned char* scr = F.lds + RING_OFF + F.wave * 16384;
    const int gw = F.vcu * NWAVES + F.wave, NGW = F.G * NWAVES, lane = opaque_i(F.lane);
    const float* norm_g = F.in[5];
    constexpr int I_GU = (D / 64) * (2 * FF / 64), I_D = (FF / 64) * (D / 64), I_GLU = (D / 64) * (2 * D / 64), I_IN = (D / 64) * (3 * D / 64), I_OUT = (D / 64) * (D / 64);
    constexpr int NITEMS = 4 * I_GU + 4 * I_D + I_GLU + I_IN + I_OUT;
    for (int it = gw; it < NITEMS; it += NGW) {
        int r = it;
        if (r < 4 * I_GU) { const int f = r / I_GU; r -= f * I_GU; const int nb = r % (2 * FF / 64), kb = r / (2 * FF / 64), nd = 64 * nb;
            const float* gk = norm_g + ((f >> 1) * 3 + (f & 1) * 2) * D;
            p0_transpose_item(F.in[7] + (size_t)f * D * 2 * FF, D, 2 * FF, (bf16*)(F.ws + WS_WGU) + (size_t)f * 2 * FF * D, gk, 64 * kb, pair_src(nd, 0, FF), nd, scr, lane); continue; }
        r -= 4 * I_GU;
        if (r < 4 * I_D) { const int f = r / I_D; r -= f * I_D; const int nb = r % (D / 64), kb = r / (D / 64), nd = 64 * nb;
            p0_transpose_item(F.in[8] + (size_t)f * FF * D, FF, D, (bf16*)(F.ws + WS_WD) + (size_t)f * D * FF, nullptr, 64 * kb, nd, nd, scr, lane); continue; }
        r -= 4 * I_D;
        if (r < I_GLU) { const int nb = r % (2 * D / 64), kb = r / (2 * D / 64), nd = 64 * nb;
            p0_transpose_item(F.in[17], D, 2 * D, (bf16*)(F.ws + WS_WGLU), nullptr, 64 * kb, pair_src(nd, 0, D), nd, scr, lane); continue; }
        r -= I_GLU;
        if (r < I_IN) { const int nb = r % (3 * D / 64), kb = r / (3 * D / 64), nd = 64 * nb;
            const int ns = nd < 2048 ? pair_src(nd, D, D) : nd - 2048;
            p0_transpose_item(F.in[18], D, 3 * D, (bf16*)(F.ws + WS_WIN), norm_g + 4 * D, 64 * kb, ns, nd, scr, lane); continue; }
        r -= I_IN;
        { const int nb = r % (D / 64), kb = r / (D / 64), nd = 64 * nb;
            p0_transpose_item(F.in[20], D, D, (bf16*)(F.ws + WS_WOUT), nullptr, 64 * kb, nd, nd, scr, lane); }
    }
    bf16* XB = (bf16*)(F.ws + WS_XB); pg8::ssq_t* ssq = (pg8::ssq_t*)(F.ws + WS_SSQ);
    for (int m = gw; m < M; m += NGW) {
        const float* src = m < MP ? F.in[0] + (size_t)m * D : F.in[1] + (size_t)(m - MP) * D;
        const GAS f32x4* xr = (const GAS f32x4*)src + lane;
        GAS unsigned long long* o8 = (GAS unsigned long long*)(XB + (size_t)m * D) + lane;
        float s = 0.f;
#pragma unroll
        for (int j = 0; j < 4; ++j) { const f32x4 v = xr[64 * j]; s += (v.x * v.x + v.y * v.y) + (v.z * v.z + v.w * v.w);
            o8[64 * j] = (unsigned long long)pk2(v.x, v.y) | ((unsigned long long)pk2(v.z, v.w) << 32); }
        s = wave_sum(s);
        if (lane == 0) ssq[m] = pg8::ssq_fix(s);
    }
    for (int i = gw * 64 + lane; i < 7 * M; i += NGW * 64) ssq[M + i] = 0ull;
    float* sp = (float*)(F.ws + WS_SSMP);
    for (int i = gw * 64 + lane; i < NG * PS; i += NGW * 64) {
        const int g = i / PS;
        const float lr = F.in[9][i], li = F.in[10][i], dt = expf(F.in[11][g]);
        const float mag = expf(lr * dt); float sn, cs; sincosf(li * dt, &sn, &cs);
        const float lbr = mag * cs, lbi = mag * sn, den = lr * lr + li * li, nr = lbr - 1.0f, ni = lbi;
        const float fr = (nr * lr + ni * li) / den, fi = (ni * lr - nr * li) / den;
        sp[i] = lbr; sp[4096 + i] = lbi;
#pragma unroll
        for (int c = 0; c < GS; ++c) { const float br = F.in[12][(size_t)i * GS + c], bi = F.in[13][(size_t)i * GS + c];
            sp[8192 + (size_t)i * GS + c] = fr * br - fi * bi; sp[8192 + 65536 + (size_t)i * GS + c] = fr * bi + fi * br; }
    }
}

__device__ __forceinline__ float gelu_tanh(float x) {
    const float a = 0.7978845608028654f * (x + 0.044715f * x * x * x);
    return x * __builtin_amdgcn_rcpf(1.0f + __builtin_amdgcn_exp2f(-2.0f * 1.4426950408889634f * a));
}

__device__ __forceinline__ void ssm_phase(Frame& F) {
    constexpr int TB = 8;
    LAS float* wl = (LAS float*)(F.lds + RING_OFF + F.wave * 16384);
    LAS float* hsr = wl; LAS float* hsi = wl + TB * 65; LAS float* cre = wl + 2 * TB * 65; LAS float* cim = cre + 16 * 65;
    const int gw = F.vcu * NWAVES + F.wave, NGW = F.G * NWAVES, lane = F.lane;
    const float* X = (const float*)(F.ws + WS_X); const float* ssq = (const float*)(F.ws + WS_SSQ) + 1 * M;
    const float* sp = (const float*)(F.ws + WS_SSMP); bf16* Gb = (bf16*)(F.ws + WS_G);
    const float* g1 = F.in[5] + 1 * D; const float* dsk = F.in[16];
    constexpr int NITEM = 8 * NG + 128 * NG;
    for (int it = gw; it < NITEM; it += NGW) {
        int seq, g, L, row0; const float *s0r = nullptr, *s0i = nullptr; float *outr, *outi;
        if (it < 8 * NG) { seq = it / NG; g = it % NG; L = 2048; row0 = seq * 2048; outr = F.out + O_SRP + (size_t)(seq * NG + g) * PS; outi = F.out + O_SIP + (size_t)(seq * NG + g) * PS; }
        else { const int j = it - 8 * NG; seq = j / NG; g = j % NG; L = 8; row0 = MP + seq * 8; s0r = F.in[2] + (size_t)(seq * NG + g) * PS; s0i = F.in[3] + (size_t)(seq * NG + g) * PS;
               outr = F.out + O_SRS + (size_t)(seq * NG + g) * PS; outi = F.out + O_SIS + (size_t)(seq * NG + g) * PS; }
        const int gp = g * PS + lane;
        const float lbr = sp[gp], lbi = sp[4096 + gp];
        float bbr[GS], bbi[GS];
#pragma unroll
        for (int c = 0; c < GS; ++c) { bbr[c] = sp[8192 + (size_t)gp * GS + c]; bbi[c] = sp[8192 + 65536 + (size_t)gp * GS + c]; }
#pragma unroll
        for (int c = 0; c < GS; ++c) { cre[c * 65 + lane] = F.in[14][((size_t)g * GS + c) * PS + lane]; cim[c * 65 + lane] = F.in[15][((size_t)g * GS + c) * PS + lane]; }
        float gn[GS];
#pragma unroll
        for (int c = 0; c < GS; ++c) gn[c] = g1[g * GS + c];
        float hr = s0r ? s0r[lane] : 0.f, hi = s0i ? s0i[lane] : 0.f;
        const int oc = lane & 15, otq = lane >> 4;
        const float dc = dsk[g * GS + oc], gc = g1[g * GS + oc];
        for (int t0 = 0; t0 < L; t0 += TB) {
#pragma unroll
            for (int tl = 0; tl < TB; ++tl) { const int row = row0 + t0 + tl; const float rs = __builtin_amdgcn_rsqf(ssq[row] * (1.0f / D) + EPS);
                const float* xr = X + (size_t)row * D + g * GS; float br = 0.f, bi = 0.f;
#pragma unroll
                for (int c = 0; c < GS; ++c) { const float uu = xr[c] * rs * gn[c]; br += bbr[c] * uu; bi += bbi[c] * uu; }
                const float nr = lbr * hr - lbi * hi + br, ni = lbr * hi + lbi * hr + bi; hr = nr; hi = ni;
                hsr[tl * 65 + lane] = hr; hsi[tl * 65 + lane] = hi; }
            LDS_WAIT(); __builtin_amdgcn_wave_barrier(); asm volatile("" ::: "memory");
#pragma unroll
            for (int j = 0; j < 2; ++j) { const int tl = otq * 2 + j; const int row = row0 + t0 + tl; float y = 0.f;
                for (int p = 0; p < PS; ++p) y += cre[oc * 65 + p] * hsr[tl * 65 + p] - cim[oc * 65 + p] * hsi[tl * 65 + p];
                const float rs = __builtin_amdgcn_rsqf(ssq[row] * (1.0f / D) + EPS);
                const float uu = X[(size_t)row * D + g * GS + oc] * rs * gc;
                y += dc * uu;
                Gb[(size_t)row * D + g * GS + oc] = (bf16)f2bf(gelu_tanh(y)); }
            LDS_WAIT(); __builtin_amdgcn_wave_barrier(); asm volatile("" ::: "memory");
        }
        outr[lane] = hr; outi[lane] = hi;
    }
}


typedef float f32x16 __attribute__((ext_vector_type(16)));
typedef unsigned u32x2v __attribute__((ext_vector_type(2)));
__device__ __forceinline__ unsigned cvtpk(float lo, float hi) { unsigned r; asm volatile("v_cvt_pk_bf16_f32 %0, %1, %2" : "=v"(r) : "v"(lo), "v"(hi)); return r; }
__device__ __forceinline__ bf16x8 pack8(const float* v) { v4u w; w.x = cvtpk(v[0], v[1]); w.y = cvtpk(v[2], v[3]); w.z = cvtpk(v[4], v[5]); w.w = cvtpk(v[6], v[7]); return __builtin_bit_cast(bf16x8, w); }
constexpr int SSM_ROWB = 272;

__device__ __forceinline__ void ssm_phase_fast(Frame& F) {
    LAS unsigned char* img = F.lds + RING_OFF + F.wave * 16384;
    const int lane = opaque_i(F.lane), G = F.G, gq = F.wave * G + F.vcu, NGQ = NWAVES * G;
    const bf16* X = (const bf16*)(F.ws + WS_XB); const pg8::ssq_t* ssq = (const pg8::ssq_t*)(F.ws + WS_SSQ) + 1 * M;
    const float* sp = (const float*)(F.ws + WS_SSMP); bf16* Gb = (bf16*)(F.ws + WS_G);
    const float* g1 = F.in[5] + 1 * D; const float* dsk = F.in[16];
    constexpr int NPI = 8 * NG, NSB = (MS / 32) * NG, NITEM = NPI + NSB;
    const int l31 = lane & 31, h = lane >> 5, l15 = lane & 15, q4 = lane >> 4;
    for (int it = gq; it < NITEM; it += NGQ) {
        const bool sample = it >= NPI;
        int g, row_base, nblk, seq0;
        if (!sample) { seq0 = it / NG; g = it % NG; row_base = seq0 * 2048; nblk = 64; }
        else { const int j = it - NPI; const int rb = j / NG; g = j % NG; row_base = MP + rb * 32; nblk = 1; seq0 = rb * 4; }
        bf16x8 bbq[4];
#pragma unroll
        for (int q = 0; q < 4; ++q) { const int p = 32 * (q & 1) + l31; const float* src = sp + 8192 + (q >> 1) * 65536 + ((size_t)(g * PS + p) * GS + 8 * h);
            float v[8];
#pragma unroll
            for (int j = 0; j < 8; ++j) v[j] = src[j] * g1[g * GS + 8 * h + j];
            bbq[q] = pack8(v); }
        bf16x8 cm[4];
#pragma unroll
        for (int ks = 0; ks < 4; ++ks) { const int p0 = 16 * ks + 4 * q4; const float* cr = F.in[14] + ((size_t)(g * GS + l15) * PS + p0); const float* ci = F.in[15] + ((size_t)(g * GS + l15) * PS + p0);
            float v[8];
#pragma unroll
            for (int j = 0; j < 4; ++j) { v[2 * j] = cr[j]; v[2 * j + 1] = -ci[j]; }
            cm[ks] = pack8(v); }
        float dg[4];
#pragma unroll
        for (int e = 0; e < 4; ++e) dg[e] = dsk[g * GS + 4 * q4 + e] * g1[g * GS + 4 * q4 + e];
        const float lbr = sp[g * PS + lane], lbi = sp[4096 + g * PS + lane];
        float hr = 0.f, hi = 0.f;
        float s0r[4], s0i[4];
        if (sample) {
#pragma unroll
            for (int i = 0; i < 4; ++i) { s0r[i] = F.in[2][((size_t)(seq0 + i) * NG + g) * PS + lane]; s0i[i] = F.in[3][((size_t)(seq0 + i) * NG + g) * PS + lane]; } }
        else {
#pragma unroll
            for (int i = 0; i < 4; ++i) { s0r[i] = 0.f; s0i[i] = 0.f; } }
        v4u xaw; u32x2v xew0, xew1; pg8::ssq_t qa, qe0, qe1;
#define SSM_LOAD(b) do { const int rowA = row_base + 32 * (b) + l31; xaw = *(const GAS v4u*)(X + (size_t)rowA * D + g * GS + 8 * h); qa = ssq[rowA]; \
            const int rowE = row_base + 32 * (b) + l15; xew0 = *(const GAS u32x2v*)(X + (size_t)rowE * D + g * GS + 4 * q4); xew1 = *(const GAS u32x2v*)(X + (size_t)(rowE + 16) * D + g * GS + 4 * q4); qe0 = ssq[rowE]; qe1 = ssq[rowE + 16]; } while (0)
#define BFLO(w) __builtin_bit_cast(float, (w) << 16)
#define BFHI(w) __builtin_bit_cast(float, (w) & 0xffff0000u)
        SSM_LOAD(0);
        for (int b = 0; b < nblk; ++b) {
            const f32x4 ca0 = {BFLO(xaw.x), BFHI(xaw.x), BFLO(xaw.y), BFHI(xaw.y)}, ca1 = {BFLO(xaw.z), BFHI(xaw.z), BFLO(xaw.w), BFHI(xaw.w)};
            const f32x4 ce0 = {BFLO(xew0.x), BFHI(xew0.x), BFLO(xew0.y), BFHI(xew0.y)}, ce1 = {BFLO(xew1.x), BFHI(xew1.x), BFLO(xew1.y), BFHI(xew1.y)}; const pg8::ssq_t cqa = qa, cqe0 = qe0, cqe1 = qe1;
            if (b + 1 < nblk) SSM_LOAD(b + 1);
            const float rsa = pg8::rstd_of(cqa);
            float ua[8];
#pragma unroll
            for (int j = 0; j < 4; ++j) { ua[j] = ca0[j] * rsa; ua[4 + j] = ca1[j] * rsa; }
            const bf16x8 ufrag = pack8(ua);
            const f32x16 zero16 = {0.f, 0.f, 0.f, 0.f, 0.f, 0.f, 0.f, 0.f, 0.f, 0.f, 0.f, 0.f, 0.f, 0.f, 0.f, 0.f};
            f32x16 Xr = __builtin_amdgcn_mfma_f32_32x32x16_bf16(ufrag, bbq[0], zero16, 0, 0, 0);
            f32x16 Yr = __builtin_amdgcn_mfma_f32_32x32x16_bf16(ufrag, bbq[1], zero16, 0, 0, 0);
            f32x16 Xi = __builtin_amdgcn_mfma_f32_32x32x16_bf16(ufrag, bbq[2], zero16, 0, 0, 0);
            f32x16 Yi = __builtin_amdgcn_mfma_f32_32x32x16_bf16(ufrag, bbq[3], zero16, 0, 0, 0);
#pragma unroll
            for (int r = 0; r < 16; ++r) {
                auto s1 = __builtin_amdgcn_permlane32_swap(__float_as_uint(Xr[r]), __float_as_uint(Yr[r]), false, false); Xr[r] = __uint_as_float(s1[0]); Yr[r] = __uint_as_float(s1[1]);
                auto s2 = __builtin_amdgcn_permlane32_swap(__float_as_uint(Xi[r]), __float_as_uint(Yi[r]), false, false); Xi[r] = __uint_as_float(s2[0]); Yi[r] = __uint_as_float(s2[1]); }
#pragma unroll
            for (int i = 0; i < 4; ++i) {
                if (sample) { hr = s0r[i]; hi = s0i[i]; }
#pragma unroll
                for (int s = 0; s < 2; ++s)
#pragma unroll
                    for (int e = 0; e < 4; ++e) { const int r = 4 * i + e; const float br = s ? Yr[r] : Xr[r], bi = s ? Yi[r] : Xi[r];
                        const float nr = lbr * hr - lbi * hi + br, ni = lbr * hi + lbi * hr + bi; hr = nr; hi = ni;
                        *(LAS unsigned*)(img + (8 * i + 4 * s + e) * SSM_ROWB + 4 * lane) = cvtpk(hr, hi); }
                if (sample) { F.out[O_SRS + ((size_t)(seq0 + i) * NG + g) * PS + lane] = hr; F.out[O_SIS + ((size_t)(seq0 + i) * NG + g) * PS + lane] = hi; }
            }
            f32x4 acc0 = {0.f, 0.f, 0.f, 0.f}, acc1 = {0.f, 0.f, 0.f, 0.f};
#pragma unroll
            for (int ks = 0; ks < 4; ++ks) {
                const bf16x8 b0 = *(const LAS bf16x8*)(img + l15 * SSM_ROWB + 64 * ks + 16 * q4);
                const bf16x8 b1 = *(const LAS bf16x8*)(img + (16 + l15) * SSM_ROWB + 64 * ks + 16 * q4);
                acc0 = __builtin_amdgcn_mfma_f32_16x16x32_bf16(cm[ks], b0, acc0, 0, 0, 0);
                acc1 = __builtin_amdgcn_mfma_f32_16x16x32_bf16(cm[ks], b1, acc1, 0, 0, 0); }
            const float rse0 = pg8::rstd_of(cqe0), rse1 = pg8::rstd_of(cqe1);
            float o0[4], o1[4];
#pragma unroll
            for (int e = 0; e < 4; ++e) { o0[e] = gelu_tanh(acc0[e] + dg[e] * ce0[e] * rse0); o1[e] = gelu_tanh(acc1[e] + dg[e] * ce1[e] * rse1); }
            const int rowE = row_base + 32 * b + l15;
            u32x2v w0, w1; w0.x = cvtpk(o0[0], o0[1]); w0.y = cvtpk(o0[2], o0[3]); w1.x = cvtpk(o1[0], o1[1]); w1.y = cvtpk(o1[2], o1[3]);
            *(u32x2v*)(Gb + (size_t)rowE * D + g * GS + 4 * q4) = w0;
            *(u32x2v*)(Gb + (size_t)(rowE + 16) * D + g * GS + 4 * q4) = w1;
        }
#undef SSM_LOAD
#undef BFLO
#undef BFHI
        if (!sample) { F.out[O_SRP + ((size_t)seq0 * NG + g) * PS + lane] = hr; F.out[O_SIP + ((size_t)seq0 * NG + g) * PS + lane] = hi; }
    }
}

__device__ __forceinline__ void conv_phase(Frame& F) {
    const bf16* Z = (const bf16*)(F.ws + WS_Z); const bf16* GBp = (const bf16*)(F.ws + WS_GB); bf16* A2 = (bf16*)(F.ws + WS_A2);
    const float* cw = F.in[19]; const float* cache = F.in[4];
    const int gt = (F.vcu * NWAVES + F.wave) * 64 + opaque_i(F.lane), NGT = F.G * NWAVES * 64;
    for (int it = gt; it < M * (D / 8); it += NGT) {
        const int row = it >> 7, c0 = (it & 127) * 8;
        int t; const float* cb = nullptr;
        if (row < MP) t = row & 2047; else { const int r2 = row - MP; t = r2 & 7; cb = cache + (size_t)(r2 >> 3) * 2 * D; }
        float z0[8], z1[8], z2[8], gb[8];
        { const v4u v = *(const GAS v4u*)(Z + (size_t)row * D + c0); const v4u q = *(const GAS v4u*)(GBp + (size_t)row * D + c0);
#pragma unroll
          for (int e = 0; e < 4; ++e) { z2[2 * e] = __builtin_bit_cast(float, v[e] << 16); z2[2 * e + 1] = __builtin_bit_cast(float, v[e] & 0xffff0000u);
                                        gb[2 * e] = __builtin_bit_cast(float, q[e] << 16); gb[2 * e + 1] = __builtin_bit_cast(float, q[e] & 0xffff0000u); } }
        if (t >= 1) { const v4u v = *(const GAS v4u*)(Z + (size_t)(row - 1) * D + c0);
#pragma unroll
          for (int e = 0; e < 4; ++e) { z1[2 * e] = __builtin_bit_cast(float, v[e] << 16); z1[2 * e + 1] = __builtin_bit_cast(float, v[e] & 0xffff0000u); } }
        else {
#pragma unroll
          for (int e = 0; e < 8; ++e) z1[e] = cb ? cb[D + c0 + e] : 0.f; }
        if (t >= 2) { const v4u v = *(const GAS v4u*)(Z + (size_t)(row - 2) * D + c0);
#pragma unroll
          for (int e = 0; e < 4; ++e) { z0[2 * e] = __builtin_bit_cast(float, v[e] << 16); z0[2 * e + 1] = __builtin_bit_cast(float, v[e] & 0xffff0000u); } }
        else {
#pragma unroll
          for (int e = 0; e < 8; ++e) z0[e] = cb ? cb[t * D + c0 + e] : 0.f; }
        float o[8];
#pragma unroll
        for (int e = 0; e < 8; ++e) o[e] = gb[e] * (cw[c0 + e] * z0[e] + cw[D + c0 + e] * z1[e] + cw[2 * D + c0 + e] * z2[e]);
        v4u w; w.x = pk2(o[0], o[1]); w.y = pk2(o[2], o[3]); w.z = pk2(o[4], o[5]); w.w = pk2(o[6], o[7]);
        *(GAS v4u*)(A2 + (size_t)row * D + c0) = w;
    }
}

__device__ __forceinline__ void final_phase(Frame& F) {
    const bf16* XBp = (const bf16*)(F.ws + WS_XB); const pg8::ssq_t* ssq = (const pg8::ssq_t*)(F.ws + WS_SSQ) + 6 * M; const float* fg = F.in[6];
    const int gw = F.vcu * NWAVES + F.wave, NGW = F.G * NWAVES, lane = opaque_i(F.lane);
    f32x4 gv[4];
#pragma unroll
    for (int j = 0; j < 4; ++j) gv[j] = ((const GAS f32x4*)fg)[lane + 64 * j];
    for (int m = gw; m < M; m += NGW) {
        const float rs = pg8::rstd_of(ssq[m]);
        const GAS unsigned long long* xr = (const GAS unsigned long long*)(XBp + (size_t)m * D) + lane; GAS f32x4* yo = (GAS f32x4*)(F.out + O_Y + (size_t)m * D) + lane;
#pragma unroll
        for (int j = 0; j < 4; ++j) { const unsigned long long w = xr[64 * j]; const unsigned lo = (unsigned)w, hi = (unsigned)(w >> 32);
            const f32x4 xv = {__builtin_bit_cast(float, lo << 16), __builtin_bit_cast(float, lo & 0xffff0000u), __builtin_bit_cast(float, hi << 16), __builtin_bit_cast(float, hi & 0xffff0000u)};
            yo[64 * j] = xv * rs * gv[j]; }
    }
}

struct SameOrder : pg8::StaticOrder { __device__ bool next(int i, pg8::Unit& u) const { const bool r = pg8::StaticOrder::next(i, u); u.pm = 0; u.pn = 0; return r; } };
struct Args { const float* in[21]; float* out; unsigned char* ws; int ph_lo, ph_hi; };
__global__ void __launch_bounds__(NWAVES * 64, 2) skel_fwd(Args args) {
    extern __shared__ __attribute__((aligned(16))) unsigned char lds[];
    Frame F;
    F.lds = (LAS unsigned char*)lds;
    F.MISC = (volatile LAS unsigned*)(F.lds + MISC_OFF);
    F.tid = threadIdx.x; F.lane = F.tid & 63; F.wave = __builtin_amdgcn_readfirstlane(F.tid >> 6);
    F.G = gridDim.x; { const int bx = blockIdx.x; F.vcu = (F.G % 8 == 0) ? (bx % 8) * (F.G / 8) + bx / 8 : bx; }
    F.ws = args.ws; F.out = args.out; F.ctl = (gu32*)(args.ws + WS_CTL);
#pragma unroll
    for (int i = 0; i < 21; ++i) F.in[i] = args.in[i];
    for (int u = F.tid; u < (LDS_BYTES - LDSCTL_OFF) / 4; u += NWAVES * 64) ((LAS unsigned*)(F.lds + LDSCTL_OFF))[u] = 0u;
    __syncthreads();
    XcdBarrier bar; bar.bar = (unsigned*)(F.ctl + CW_BAR); bar.x = 0; bar.st = nullptr;
    if (MK_ONE_LAUNCH) bar = xcd_barrier_post((unsigned*)(F.ctl + CW_BAR), F.MISC + 8);
    const int lo = args.ph_lo, hi = args.ph_hi;
#define IN(k) (lo <= (k) && (k) < hi)
#if defined(PROBE_A_LO)
#define STAMP(k) do { if (blockIdx.x == 0 && F.tid == 0) { const unsigned long long t_ = __builtin_amdgcn_s_memrealtime(); F.MISC[16 + 2 * (k)] = (unsigned)t_; F.MISC[17 + 2 * (k)] = (unsigned)(t_ >> 32); } } while (0)
#else
#define STAMP(k) do { } while (0)
#endif
    STAMP(0);
#define SEAM(k) do { if (MK_ONE_LAUNCH && IN((k) + 1)) xcd_barrier(bar); STAMP((k) + 1); } while (0)
    bf16* XB = (bf16*)(F.ws + WS_XB); bf16* H = (bf16*)(F.ws + WS_H); pg8::ssq_t* ssq = (pg8::ssq_t*)(F.ws + WS_SSQ);
    const int bx = (int)blockIdx.x;

    if (IN(0)) { p0_prologue(F); SEAM(0); }
#define FFN_GU(ph, f, sin) if (IN(ph)) { pg8::Gemm g{XB, (const bf16*)(F.ws + WS_WGU) + (size_t)(f) * 2 * FF * D, M, 2 * FF, D}; pg8::StaticOrder S; S.init(MP, 2 * FF, F.G, bx); \
        pg8::EpiGateUp E{H, FF, ssq + (size_t)(sin) * M}; pg8::gemm_phase<pg8::EpiGateUp, pg8::StaticOrder, true, true>(F.lds + RING_OFF, g, S, E); SEAM(ph); }
#define FFN_DN(ph, f, sout) if (IN(ph)) { pg8::Gemm g{H, (const bf16*)(F.ws + WS_WD) + (size_t)(f) * D * FF, M, D, FF}; pg8::StaticOrder S; S.init(MP, D, F.G, bx); \
        pg8::EpiResid<0> E{(ph) == 2 ? F.in[0] : nullptr, (ph) == 2 ? F.in[1] : nullptr, XB, ssq + (size_t)(sout) * M, 0.5f}; pg8::gemm_phase<pg8::EpiResid<0>, pg8::StaticOrder, true, true>(F.lds + RING_OFF, g, S, E); SEAM(ph); }
    FFN_GU(1, 0, 0)
    FFN_DN(2, 0, 1)
    if (IN(3)) { ssm_phase_fast(F); SEAM(3); }
    if (IN(4)) { pg8::Gemm g{(const bf16*)(F.ws + WS_G), (const bf16*)(F.ws + WS_WGLU), M, 2 * D, D}; pg8::StaticOrder S; S.init(MP, 2 * D, F.G, bx);
        pg8::EpiResid<1> E{nullptr, nullptr, XB, ssq + (size_t)2 * M, 1.0f}; pg8::gemm_phase<pg8::EpiResid<1>, pg8::StaticOrder, true, true>(F.lds + RING_OFF, g, S, E); SEAM(4); }
    FFN_GU(5, 1, 2)
    FFN_DN(6, 1, 3)
    FFN_GU(7, 2, 3)
    FFN_DN(8, 2, 4)
    if (IN(9)) { pg8::Gemm g{XB, (const bf16*)(F.ws + WS_WIN), M, 3 * D, D}; pg8::StaticOrder S; S.init(MP, 3 * D, F.G, bx);
        pg8::EpiConvIn E{(bf16*)(F.ws + WS_Z), (bf16*)(F.ws + WS_GB), ssq + (size_t)4 * M, F.out + O_CP, F.out + O_CS};
        pg8::gemm_phase<pg8::EpiConvIn, pg8::StaticOrder, true, true>(F.lds + RING_OFF, g, S, E); SEAM(9); }
    if (IN(10)) { conv_phase(F); SEAM(10); }
    if (IN(11)) { pg8::Gemm g{(const bf16*)(F.ws + WS_A2), (const bf16*)(F.ws + WS_WOUT), M, D, D}; pg8::StaticOrder S; S.init(MP, D, F.G, bx);
        pg8::EpiResid<0> E{nullptr, nullptr, XB, ssq + (size_t)5 * M, 1.0f}; pg8::gemm_phase<pg8::EpiResid<0>, pg8::StaticOrder, true, true>(F.lds + RING_OFF, g, S, E); SEAM(11); }
    FFN_GU(12, 3, 5)
    FFN_DN(13, 3, 6)
    if (IN(14)) { final_phase(F); }
#if defined(PROBE_DRY)
#ifndef PROBE_VARIANT
#define PROBE_VARIANT 0
#endif
    xcd_barrier(bar); STAMP(15); if (blockIdx.x == 0 && F.tid == 0) { const unsigned long long c_ = __builtin_amdgcn_s_memtime(); F.MISC[60] = (unsigned)c_; F.MISC[61] = (unsigned)(c_ >> 32); }
#if PROBE_DRY == 2
    { pg8::Gemm g{XB, (const bf16*)(F.ws + WS_WGU), M, 2 * FF, D}; SameOrder S; S.init(MP, 2 * FF, F.G, bx);
      pg8::EpiNull E{H + (size_t)M * FF - 1}; pg8::gemm_phase<pg8::EpiNull, SameOrder, true, true>(F.lds + RING_OFF, g, S, E); }
#else
    { pg8::Gemm g{XB, (const bf16*)(F.ws + WS_WGU), M, 2 * FF, D}; pg8::StaticOrder S; S.init(MP, 2 * FF, F.G, bx);
      pg8::EpiNull E{H + (size_t)M * FF - 1}; pg8::gemm_phase<pg8::EpiNull, pg8::StaticOrder, true, true, PROBE_VARIANT>(F.lds + RING_OFF, g, S, E); }
#endif
    xcd_barrier(bar); STAMP(16); if (blockIdx.x == 0 && F.tid == 0) { const unsigned long long c_ = __builtin_amdgcn_s_memtime(); F.MISC[62] = (unsigned)c_; F.MISC[63] = (unsigned)(c_ >> 32); }
#endif
#if defined(PROBE_A_LO)
    __syncthreads();
    if (blockIdx.x == 0 && F.tid == 0) {
#define TS(k) ((unsigned long long)F.MISC[16 + 2 * (k)] | ((unsigned long long)F.MISC[17 + 2 * (k)] << 32))
        const unsigned long long ta = TS(PROBE_A_HI) - TS(PROBE_A_LO), tb = TS(PROBE_B_HI) - TS(PROBE_B_LO);
#if defined(PROBE_CLOCK)
        { const unsigned long long c0 = (unsigned long long)F.MISC[60] | ((unsigned long long)F.MISC[61] << 32), c1 = (unsigned long long)F.MISC[62] | ((unsigned long long)F.MISC[63] << 32);
          F.out[0] += (float)(c1 - c0) / (float)(TS(16) - TS(15)) * 1e-2f; }
#else
        F.out[0] += (float)tb * 1e-5f;
#endif
        const unsigned long long t0 = __builtin_amdgcn_s_memrealtime();
        while (__builtin_amdgcn_s_memrealtime() - t0 < ta * 4ull) __builtin_amdgcn_s_sleep(8);
    }
#endif
#undef IN
#undef SEAM
}

extern "C" void kernel_launch(void* const* d_in, const int* in_sizes, int n_in, void* d_out, int out_size, void* d_ws, size_t ws_size, hipStream_t stream) {
    static int grid = 0;
    if (grid == 0) {
        if (n_in != 21 || out_size != (int)O_END || ws_size < WS_END) { fprintf(stderr, "kernel_launch: unexpected shapes: n_in %d out %d ws %zu; nothing launched\n", n_in, out_size, ws_size); grid = -1; return; }
        int dev = 0, cus = 0, per_cu = 0;
        if (hipGetDevice(&dev) != hipSuccess || hipDeviceGetAttribute(&cus, hipDeviceAttributeMultiprocessorCount, dev) != hipSuccess) { grid = -1; return; }
        if (hipFuncSetAttribute((const void*)skel_fwd, hipFuncAttributeMaxDynamicSharedMemorySize, LDS_BYTES) != hipSuccess) { fprintf(stderr, "kernel_launch: hipFuncSetAttribute failed\n"); grid = -1; return; }
        if (hipOccupancyMaxActiveBlocksPerMultiprocessor(&per_cu, (const void*)skel_fwd, NWAVES * 64, LDS_BYTES) != hipSuccess || per_cu < 1) fprintf(stderr, "kernel_launch: occupancy query reports %d\n", per_cu);
        (void)hipGetLastError();
        grid = cus;
    }
    if (grid < 0) return;
    if (hipMemsetAsync((char*)d_ws + WS_CTL, 0, CTL_ZERO_BYTES, stream) != hipSuccess) return;
    Args a{};
    for (int i = 0; i < 21; ++i) a.in[i] = (const float*)d_in[i];
    a.out = (float*)d_out; a.ws = (unsigned char*)d_ws;
#if MK_ONE_LAUNCH
    a.ph_lo = 0; a.ph_hi = N_PHASES;
    hipLaunchKernelGGL(skel_fwd, dim3(grid), dim3(NWAVES * 64), LDS_BYTES, stream, a);
#else
    for (int p = 0; p < N_PHASES; ++p) { a.ph_lo = p; a.ph_hi = p + 1; hipLaunchKernelGGL(skel_fwd, dim3(grid), dim3(NWAVES * 64), LDS_BYTES, stream, a); }
#endif
}
```

```cpp
#include <hip/hip_runtime.h>
#include <cstdio>
#include <cstdint>
namespace pg8 {
#define PG8_LAS __attribute__((address_space(3)))
typedef unsigned short bf16_t;
typedef short bf16x8 __attribute__((ext_vector_type(8)));
typedef float f32x4 __attribute__((ext_vector_type(4)));
typedef unsigned u32x4 __attribute__((ext_vector_type(4)));
constexpr int BM = 256, BK = 64, HALF = 128, HTB = HALF * BK * 2  , STAGE_BYTES = 8 * HTB, NXCD = 8, WGM = 8;

__host__ __device__ __forceinline__ int lds_byte(int r, int c) { const int st = (r >> 4) * 2 + (c >> 5), rr = r & 15, cc = c & 31, ob = rr * 64 + cc * 2; return st * 1024 + (ob ^ (((ob >> 9) & 1) << 5)); }
__host__ __device__ __forceinline__ void stage_rc(int b, int& R, int& C) { const int st = b / 1024, sb = b % 1024, swz = sb ^ (((sb >> 9) & 1) << 5); R = (st >> 1) * 16 + swz / 64; C = (st & 1) * 32 + (swz % 64) / 2; }
__host__ __device__ __forceinline__ int perm32(int rho) { const int n = rho >> 4, i = rho & 15; return 8 * (i >> 2) + 4 * n + (i & 3); }

struct Unit { int pm, pn; };
struct Gemm { const bf16_t* A; const bf16_t* Bt; int M, N, K; };

struct StaticOrder {
    int nM, nN, nwg, G, c;
    __host__ __device__ void init(int M, int N, int G_, int c_) { nM = M / BM; nN = N / BM; nwg = nM * nN; G = G_; c = c_; }
    __host__ __device__ bool next(int i, Unit& u) const {
        const long L = (long)i * G + c; if (L >= nwg) return false;
        int wgid = (int)L; { const int q = nwg / NXCD, r = nwg % NXCD, xcd = wgid % NXCD, off = wgid / NXCD; wgid = (xcd < r ? xcd * (q + 1) : r * (q + 1) + (xcd - r) * q) + off; }
        const int nig = WGM * nN, gid = wgid / nig, fm = gid * WGM, gsz = (nM - fm) < WGM ? (nM - fm) : WGM;
        u.pm = fm + ((wgid % nig) % gsz); u.pn = (wgid % nig) / gsz; return true;
    }
    __device__ __forceinline__ void a_ready(const Unit&) const {}
    __device__ __forceinline__ void done(const Unit&) const {}
};


__device__ __forceinline__ unsigned cvt_pk_bf16(float lo, float hi) { unsigned r; asm volatile("v_cvt_pk_bf16_f32 %0, %1, %2" : "=v"(r) : "v"(lo), "v"(hi)); return r; }

typedef unsigned u32x2 __attribute__((ext_vector_type(2)));
constexpr float RMS_EPS = 1e-6f;
constexpr float INV_D = 1.0f / 1024.0f;
__device__ __forceinline__ float sigmoid_f(float x) { return __builtin_amdgcn_rcpf(1.0f + __builtin_amdgcn_exp2f(-1.4426950408889634f * x)); }
typedef unsigned long long ssq_t;
constexpr float SSQ_SCALE = 16777216.0f, SSQ_INV = 1.0f / 16777216.0f;
__device__ __forceinline__ ssq_t ssq_fix(float s) { return (ssq_t)(s * SSQ_SCALE + 0.5f); }
__device__ __forceinline__ float rstd_of(ssq_t q) { return __builtin_amdgcn_rsqf((float)q * (SSQ_INV * INV_D) + RMS_EPS); }
#define PG8_EPI_CALL() \
    __device__ __forceinline__ void operator()(const f32x4 (&acc)[2][2][4][2], const Unit& u, int wr, int wc, int fr, int fq) const { \
        _Pragma("unroll") for (int ai = 0; ai < 2; ++ai) _Pragma("unroll") for (int m = 0; m < 4; ++m) { \
            const f32x4 a[2][2] = {{acc[ai][0][m][0], acc[ai][0][m][1]}, {acc[ai][1][m][0], acc[ai][1][m][1]}}; rg(a, u, ai, m, 3, wr, wc, fr, fq); } }

struct EpiGateUp {
    static constexpr bool PERM = true, AFTER_DRAIN = false;
    bf16_t* H; int ldh; const ssq_t* ssq;
    __device__ __forceinline__ void rg(const f32x4 (&a)[2][2], const Unit& u, int ai, int m, int bjmask, int wr, int wc, int fr, int fq) const {
        const int row = u.pm * BM + ai * HALF + wr * 64 + m * 16 + fr, col0 = u.pn * HALF + wc * 32 + 8 * fq;
        const float rs = rstd_of(ssq[row]);
        float h[8];
#pragma unroll
        for (int n = 0; n < 2; ++n)
#pragma unroll
            for (int e = 0; e < 4; ++e) { const float g = a[0][n][e] * rs, up = a[1][n][e] * rs; h[4 * n + e] = g * sigmoid_f(g) * up; }
        u32x4 w; w.x = cvt_pk_bf16(h[0], h[1]); w.y = cvt_pk_bf16(h[2], h[3]); w.z = cvt_pk_bf16(h[4], h[5]); w.w = cvt_pk_bf16(h[6], h[7]);
        *(u32x4*)(H + (size_t)row * ldh + col0) = w;
    }
    __device__ __forceinline__ void rgx(const f32x4 (&ax)[2], const Unit& u, int wr, int wc, int fr, int fq) const {
        const int row = 16384 + 16 * u.pm + fr, col0 = u.pn * HALF + wc * 32 + 8 * fq + 4 * wr;
        const float rs = rstd_of(ssq[row]);
        float h[4];
#pragma unroll
        for (int e = 0; e < 4; ++e) { const float g = ax[0][e] * rs, up = ax[1][e] * rs; h[e] = g * sigmoid_f(g) * up; }
        u32x2 w; w.x = cvt_pk_bf16(h[0], h[1]); w.y = cvt_pk_bf16(h[2], h[3]);
        *(u32x2*)(H + (size_t)row * ldh + col0) = w;
    }
    PG8_EPI_CALL()
};

__device__ __forceinline__ void unpack8(const u32x4 w, float (&x)[8]) {
#pragma unroll
    for (int e = 0; e < 4; ++e) { x[2 * e] = __builtin_bit_cast(float, w[e] << 16); x[2 * e + 1] = __builtin_bit_cast(float, w[e] & 0xffff0000u); } }
template <int MODE> struct EpiResid {
    static constexpr bool PERM = true, AFTER_DRAIN = false;
    const float* xin_p; const float* xin_s; bf16_t* XB; ssq_t* ssq; float scale;
    __device__ __forceinline__ void rg(const f32x4 (&a)[2][2], const Unit& u, int ai, int m, int bjmask, int wr, int wc, int fr, int fq) const {
        const int row = u.pm * BM + ai * HALF + wr * 64 + m * 16 + fr;
        const int col0 = (MODE == 0 ? u.pn * BM : u.pn * HALF) + wc * 32 + 8 * fq;
        float sq = 0.f;
#pragma unroll
        for (int bj = 0; bj < (MODE == 0 ? 2 : 1); ++bj) {
            bf16_t* xp = XB + (size_t)row * 1024 + col0 + bj * HALF;
            float x[8];
            if (xin_p) { const float* xi = xin_p + (size_t)row * 1024 + col0 + bj * HALF; const f32x4 x0 = *(const f32x4*)xi, x1 = *(const f32x4*)(xi + 4);
#pragma unroll
                for (int e = 0; e < 4; ++e) { x[e] = x0[e]; x[4 + e] = x1[e]; } }
            else unpack8(*(const u32x4*)xp, x);
#pragma unroll
            for (int e = 0; e < 4; ++e) {
                if (MODE == 0) { x[e] += a[bj][0][e] * scale; x[4 + e] += a[bj][1][e] * scale; }
                else { x[e] += a[0][0][e] * sigmoid_f(a[1][0][e]); x[4 + e] += a[0][1][e] * sigmoid_f(a[1][1][e]); } }
            u32x4 w; w.x = cvt_pk_bf16(x[0], x[1]); w.y = cvt_pk_bf16(x[2], x[3]); w.z = cvt_pk_bf16(x[4], x[5]); w.w = cvt_pk_bf16(x[6], x[7]);
            *(u32x4*)xp = w;
            sq += (x[0] * x[0] + x[1] * x[1]) + (x[2] * x[2] + x[3] * x[3]) + (x[4] * x[4] + x[5] * x[5]) + (x[6] * x[6] + x[7] * x[7]); }
        sq += __shfl_xor(sq, 16); sq += __shfl_xor(sq, 32);
        if (fq == 0) atomicAdd(ssq + row, ssq_fix(sq));
    }
    __device__ __forceinline__ void rgx(const f32x4 (&ax)[2], const Unit& u, int wr, int wc, int fr, int fq) const {
        const int r2 = 16 * u.pm + fr, row = 16384 + r2;
        const int col0 = (MODE == 0 ? u.pn * BM : u.pn * HALF) + wc * 32 + 8 * fq + 4 * wr;
        float sq = 0.f;
#pragma unroll
        for (int bj = 0; bj < (MODE == 0 ? 2 : 1); ++bj) {
            bf16_t* xp = XB + (size_t)row * 1024 + col0 + bj * HALF;
            f32x4 x0;
            if (xin_s) x0 = *(const f32x4*)(xin_s + (size_t)r2 * 1024 + col0 + bj * HALF);
            else { const u32x2 w = *(const u32x2*)xp; x0[0] = __builtin_bit_cast(float, w.x << 16); x0[1] = __builtin_bit_cast(float, w.x & 0xffff0000u); x0[2] = __builtin_bit_cast(float, w.y << 16); x0[3] = __builtin_bit_cast(float, w.y & 0xffff0000u); }
            if (MODE == 0) x0 += ax[bj] * scale;
            else {
#pragma unroll
                for (int e = 0; e < 4; ++e) x0[e] += ax[0][e] * sigmoid_f(ax[1][e]); }
            u32x2 w; w.x = cvt_pk_bf16(x0[0], x0[1]); w.y = cvt_pk_bf16(x0[2], x0[3]);
            *(u32x2*)xp = w;
            sq += (x0[0] * x0[0] + x0[1] * x0[1]) + (x0[2] * x0[2] + x0[3] * x0[3]); }
        sq += __shfl_xor(sq, 16); sq += __shfl_xor(sq, 32);
        if (fq == 0) atomicAdd(ssq + row, ssq_fix(sq));
    }
    PG8_EPI_CALL()
};

struct EpiConvIn {
    static constexpr bool PERM = true, AFTER_DRAIN = false;
    bf16_t* Z; bf16_t* GB; const ssq_t* ssq; float* conv_p; float* conv_s;
    __device__ __forceinline__ void rg(const f32x4 (&a)[2][2], const Unit& u, int ai, int m, int bjmask, int wr, int wc, int fr, int fq) const {
        const int row = u.pm * BM + ai * HALF + wr * 64 + m * 16 + fr;
        const float rs = rstd_of(ssq[row]);
        if (u.pn < 8) {
            const int col0 = u.pn * HALF + wc * 32 + 8 * fq; const float rs2 = rs * rs;
            const f32x4 z0 = a[0][0] * a[1][0] * rs2, z1 = a[0][1] * a[1][1] * rs2;
            u32x4 w; w.x = cvt_pk_bf16(z0[0], z0[1]); w.y = cvt_pk_bf16(z0[2], z0[3]); w.z = cvt_pk_bf16(z1[0], z1[1]); w.w = cvt_pk_bf16(z1[2], z1[3]);
            *(u32x4*)(Z + (size_t)row * 1024 + col0) = w;
            float* cp = nullptr;
            if (row < 16384) { const int t = row & 2047; if (t >= 2046) cp = conv_p + ((size_t)(row >> 11) * 2 + (t - 2046)) * 1024 + col0; }
            else { const int r2 = row - 16384, t = r2 & 7; if (t >= 6) cp = conv_s + ((size_t)(r2 >> 3) * 2 + (t - 6)) * 1024 + col0; }
            if (cp) { *(f32x4*)cp = z0; *(f32x4*)(cp + 4) = z1; }
        } else {
            const int col0 = (u.pn - 8) * BM + wc * 32 + 8 * fq;
#pragma unroll
            for (int bj = 0; bj < 2; ++bj) { const f32x4 g0 = a[bj][0] * rs, g1 = a[bj][1] * rs;
                u32x4 w; w.x = cvt_pk_bf16(g0[0], g0[1]); w.y = cvt_pk_bf16(g0[2], g0[3]); w.z = cvt_pk_bf16(g1[0], g1[1]); w.w = cvt_pk_bf16(g1[2], g1[3]);
                *(u32x4*)(GB + (size_t)row * 1024 + col0 + bj * HALF) = w; }
        }
    }
    __device__ __forceinline__ void rgx(const f32x4 (&ax)[2], const Unit& u, int wr, int wc, int fr, int fq) const {
        const int r2 = 16 * u.pm + fr, row = 16384 + r2;
        const float rs = rstd_of(ssq[row]);
        if (u.pn < 8) {
            const int col0 = u.pn * HALF + wc * 32 + 8 * fq + 4 * wr;
            const f32x4 z0 = ax[0] * ax[1] * (rs * rs);
            u32x2 w; w.x = cvt_pk_bf16(z0[0], z0[1]); w.y = cvt_pk_bf16(z0[2], z0[3]);
            *(u32x2*)(Z + (size_t)row * 1024 + col0) = w;
            const int t = r2 & 7;
            if (t >= 6) *(f32x4*)(conv_s + ((size_t)(r2 >> 3) * 2 + (t - 6)) * 1024 + col0) = z0;
        } else {
            const int col0 = (u.pn - 8) * BM + wc * 32 + 8 * fq + 4 * wr;
#pragma unroll
            for (int bj = 0; bj < 2; ++bj) { const f32x4 g0 = ax[bj] * rs;
                u32x2 w; w.x = cvt_pk_bf16(g0[0], g0[1]); w.y = cvt_pk_bf16(g0[2], g0[3]);
                *(u32x2*)(GB + (size_t)row * 1024 + col0 + bj * HALF) = w; }
        }
    }
    PG8_EPI_CALL()
};

struct EpiNull {
    static constexpr bool PERM = true, AFTER_DRAIN = false;
    bf16_t* sink;
    __device__ __forceinline__ void rg(const f32x4 (&a)[2][2], const Unit& u, int ai, int m, int bjmask, int wr, int wc, int fr, int fq) const {
        asm volatile("" :: "v"(a[0][0]), "v"(a[0][1]), "v"(a[1][0]), "v"(a[1][1]));
    }
    __device__ __forceinline__ void rgx(const f32x4 (&ax)[2], const Unit& u, int wr, int wc, int fr, int fq) const { asm volatile("" :: "v"(ax[0]), "v"(ax[1])); }
    PG8_EPI_CALL()
};

template <class Epi, class Sched, bool ALIGN_EPI = false, bool SP2 = false, int PROBE = 0>
__device__ __forceinline__ void gemm_phase(PG8_LAS unsigned char* lds, const Gemm g, const Sched& S, const Epi& E) {
    int tid_ = threadIdx.x; asm volatile("" : "+v"(tid_));
    const int tid = tid_, wid = __builtin_amdgcn_readfirstlane(tid >> 6), lane = tid & 63, wr = wid >> 2, wc = wid & 3, fr = lane & 15, fq = lane >> 4;
    const int K = g.K, nt = K / BK;
    constexpr int XROW0 = 16384, XR = 16;
    unsigned voffA[2], voffB[2];
#pragma unroll
    for (int i = 0; i < 2; ++i) { int R, C; stage_rc(tid * 16 + i * 8192, R, C); const int Rb = Epi::PERM ? ((R & ~31) + perm32(R & 31)) : R;
        voffA[i] = (unsigned)(R * K + C) * 2u; voffB[i] = (unsigned)(Rb * K + C) * 2u; }
    unsigned voffX; { const int row = wid * 2 + (lane >> 5), q = (lane & 31) * 4, kb = q ^ (((row >> 1) & 7) << 4); voffX = (unsigned)(row * K * 2 + kb); }
    const int xoff0 = fr * 128 + ((fq * 16) ^ (((fr >> 1) & 7) << 4)), xoff1 = fr * 128 + ((64 + fq * 16) ^ (((fr >> 1) & 7) << 4));
    const unsigned kstep = (unsigned)(BK * 2);
    const unsigned hstep = (unsigned)HALF * K * 2;
    const unsigned tstep = 2 * hstep;
    const __amdgpu_buffer_rsrc_t rsA = __builtin_amdgcn_make_buffer_rsrc((void*)g.A, 0, 0x7ffff000, 0x00020000), rsB = __builtin_amdgcn_make_buffer_rsrc((void*)g.Bt, 0, 0x7ffff000, 0x00020000);
    const unsigned ldsw = (unsigned)wid * 1024u;
    const int aoff = lds_byte(wr * 64 + fr, fq * 8), boff = lds_byte(wc * 32 + fr, fq * 8);
#define PG8_SA(b, h) (((b) * 2 + (h)) * HTB)
#define PG8_SB(b, h) ((4 + (b) * 2 + (h)) * HTB)
#define PG8_SX(b) (STAGE_BYTES + (b) * 2048)
#define PG8_STAGEX(b, soff) __builtin_amdgcn_raw_ptr_buffer_load_lds(rsA, (PG8_LAS unsigned*)(lds + PG8_SX(b) + wid * 256), 4, voffX, (soff), 0, 0)
#define PG8_LDAX(dst, b) do { dst[0] = *(const PG8_LAS bf16x8*)(lds + PG8_SX(b) + xoff0); dst[1] = *(const PG8_LAS bf16x8*)(lds + PG8_SX(b) + xoff1); } while (0)
#define PG8_MMAX_NULL() do { asm volatile("" :: "v"(Ax[0]), "v"(Ax[1])); } while (0)
#define PG8_MMAX_REAL() do { if (wr == 0) { _Pragma("unroll") for (int k = 0; k < 2; ++k) { accx[0] = __builtin_amdgcn_mfma_f32_16x16x32_bf16(B0[0][k], Ax[k], accx[0], 0, 0, 0); accx[1] = __builtin_amdgcn_mfma_f32_16x16x32_bf16(B1[0][k], Ax[k], accx[1], 0, 0, 0); } } \
        else { _Pragma("unroll") for (int k = 0; k < 2; ++k) { accx[0] = __builtin_amdgcn_mfma_f32_16x16x32_bf16(B0[1][k], Ax[k], accx[0], 0, 0, 0); accx[1] = __builtin_amdgcn_mfma_f32_16x16x32_bf16(B1[1][k], Ax[k], accx[1], 0, 0, 0); } } } while (0)
#define PG8_MMAX() do { if constexpr ((PROBE & 1) != 0) PG8_MMAX_NULL(); else PG8_MMAX_REAL(); } while (0)
#define PG8_STAGEA(bufoff, soff) do { _Pragma("unroll") for (int _i = 0; _i < 2; ++_i) \
        __builtin_amdgcn_raw_ptr_buffer_load_lds(rsA, (PG8_LAS unsigned*)(lds + (bufoff) + ldsw + _i * 8192), 16, voffA[_i], (soff), 0, 0); } while (0)
#define PG8_STAGEB(bufoff, soff) do { _Pragma("unroll") for (int _i = 0; _i < 2; ++_i) \
        __builtin_amdgcn_raw_ptr_buffer_load_lds(rsB, (PG8_LAS unsigned*)(lds + (bufoff) + ldsw + _i * 8192), 16, voffB[_i], (soff), 0, 0); } while (0)
#define PG8_LDA(dst, b, h) do { _Pragma("unroll") for (int m = 0; m < 4; ++m) _Pragma("unroll") for (int k = 0; k < 2; ++k) dst[m][k] = *(const PG8_LAS bf16x8*)(lds + PG8_SA(b, h) + aoff + m * 2048 + k * 1024); } while (0)
#define PG8_LDB(dst, b, h) do { _Pragma("unroll") for (int n = 0; n < 2; ++n) _Pragma("unroll") for (int k = 0; k < 2; ++k) dst[n][k] = *(const PG8_LAS bf16x8*)(lds + PG8_SB(b, h) + boff + n * 2048 + k * 1024); } while (0)
#define PG8_MMA_NULL(ai, bj, At, Bt) do { _Pragma("unroll") for (int m = 0; m < 4; ++m) _Pragma("unroll") for (int k = 0; k < 2; ++k) asm volatile("" :: "v"(At[m][k])); _Pragma("unroll") for (int n = 0; n < 2; ++n) _Pragma("unroll") for (int k = 0; k < 2; ++k) asm volatile("" :: "v"(Bt[n][k])); } while (0)
#define PG8_MMA_REAL(ai, bj, At, Bt) do { __builtin_amdgcn_s_setprio(1); _Pragma("unroll") for (int m = 0; m < 4; ++m) _Pragma("unroll") for (int n = 0; n < 2; ++n) _Pragma("unroll") for (int k = 0; k < 2; ++k) \
        acc[ai][bj][m][n] = __builtin_amdgcn_mfma_f32_16x16x32_bf16(Bt[n][k], At[m][k], acc[ai][bj][m][n], 0, 0, 0); __builtin_amdgcn_s_setprio(0); } while (0)
#define PG8_MMA(ai, bj, At, Bt) do { if constexpr ((PROBE & 1) != 0) PG8_MMA_NULL(ai, bj, At, Bt); else PG8_MMA_REAL(ai, bj, At, Bt); } while (0)
#define PG8_WAIT_V(n) asm volatile("s_waitcnt vmcnt(" #n ")" ::: "memory")
#define PG8_WAIT_L(n) asm volatile("s_waitcnt lgkmcnt(" #n ")" ::: "memory")
#define PG8_BAR __builtin_amdgcn_s_barrier()
#define PG8_SCHED __builtin_amdgcn_sched_barrier(0)
    Unit cur, nxt; int ui = 0;
    if (!S.next(0, cur)) return;
    f32x4 acc[2][2][4][2];
#pragma unroll
    for (int a = 0; a < 2; ++a)
#pragma unroll
        for (int b = 0; b < 2; ++b)
#pragma unroll
            for (int m = 0; m < 4; ++m)
#pragma unroll
                for (int n = 0; n < 2; ++n) acc[a][b][m][n] = (f32x4){0.f, 0.f, 0.f, 0.f};
    bf16x8 At[4][2], B0[2][2], B1[2][2], Ax[2];
    f32x4 accx[2] = {(f32x4){0.f, 0.f, 0.f, 0.f}, (f32x4){0.f, 0.f, 0.f, 0.f}};
    unsigned cA = (unsigned)cur.pm * tstep, cB = (unsigned)cur.pn * tstep;
    const unsigned xstep = (unsigned)XR * K * 2, xbase = (unsigned)XROW0 * K * 2; unsigned cX = xbase + (unsigned)cur.pm * xstep;
    S.a_ready(cur);
    if constexpr (SP2) {
        PG8_STAGEB(PG8_SB(0, 0), cB); PG8_STAGEB(PG8_SB(0, 1), cB + hstep); PG8_STAGEA(PG8_SA(0, 0), cA); PG8_STAGEX(0, cX); PG8_STAGEA(PG8_SA(0, 1), cA + hstep);
        if (wr == 1) PG8_BAR;
        PG8_WAIT_V(2); PG8_BAR;
        PG8_STAGEB(PG8_SB(1, 0), cB + kstep); PG8_STAGEA(PG8_SA(1, 0), cA + kstep); PG8_STAGEB(PG8_SB(1, 1), cB + hstep + kstep); PG8_STAGEX(1, cX + kstep);
        PG8_WAIT_V(7); PG8_BAR;
    } else {
        PG8_STAGEB(PG8_SB(0, 0), cB); PG8_STAGEA(PG8_SA(0, 0), cA); PG8_STAGEB(PG8_SB(0, 1), cB + hstep); PG8_STAGEA(PG8_SA(0, 1), cA + hstep);
        if (wr == 1) PG8_BAR;
        PG8_WAIT_V(4); PG8_BAR;
        PG8_STAGEB(PG8_SB(1, 0), cB + kstep); PG8_STAGEA(PG8_SA(1, 0), cA + kstep); PG8_STAGEB(PG8_SB(1, 1), cB + hstep + kstep);
        PG8_WAIT_V(6); PG8_BAR;
    }
    for (;;) {
        const bool has_next = S.next(ui + 1, nxt);
        const unsigned nA = has_next ? (unsigned)nxt.pm * tstep : cA, nB = has_next ? (unsigned)nxt.pn * tstep : cB, nX = has_next ? xbase + (unsigned)nxt.pm * xstep : cX;
        for (int t = 0; t < nt; t += 2) {
            const bool last = (t == nt - 2);
            const unsigned a1 = cA + (unsigned)(t + 1) * kstep;
            const unsigned a2 = last ? nA : cA + (unsigned)(t + 2) * kstep, b2 = last ? nB : cB + (unsigned)(t + 2) * kstep;
            const unsigned a3 = a2 + kstep, b3 = b2 + kstep, x2 = last ? nX : cX + (unsigned)(t + 2) * kstep, x3 = x2 + kstep;
            if (last && has_next) S.a_ready(nxt);
            if constexpr (SP2) {
            PG8_LDB(B0, 0, 0); PG8_LDB(B1, 0, 1); PG8_SCHED; PG8_LDA(At, 0, 0); PG8_LDAX(Ax, 0); PG8_STAGEA(PG8_SA(1, 1), a1 + hstep);
            PG8_WAIT_V(9); PG8_WAIT_L(0); PG8_BAR; PG8_MMA(0, 0, At, B0); PG8_MMA(0, 1, At, B1); PG8_MMAX(); PG8_BAR; PG8_SCHED;
            PG8_LDA(At, 0, 1); PG8_STAGEB(PG8_SB(0, 0), b2); PG8_STAGEB(PG8_SB(0, 1), b2 + hstep); PG8_STAGEA(PG8_SA(0, 0), a2); PG8_STAGEX(0, x2);
            PG8_WAIT_V(9); PG8_WAIT_L(0); PG8_BAR; PG8_MMA(1, 0, At, B0); PG8_MMA(1, 1, At, B1); PG8_BAR; PG8_SCHED;
            PG8_LDB(B0, 1, 0); PG8_LDB(B1, 1, 1); PG8_SCHED; PG8_LDA(At, 1, 0); PG8_LDAX(Ax, 1); PG8_STAGEA(PG8_SA(0, 1), a2 + hstep);
            PG8_WAIT_V(9); PG8_WAIT_L(0); PG8_BAR; PG8_MMA(0, 0, At, B0); PG8_MMA(0, 1, At, B1); PG8_MMAX(); PG8_BAR; PG8_SCHED;
            PG8_LDA(At, 1, 1); PG8_STAGEB(PG8_SB(1, 0), b3); PG8_STAGEB(PG8_SB(1, 1), b3 + hstep); PG8_STAGEA(PG8_SA(1, 0), a3); PG8_STAGEX(1, x3);
            PG8_WAIT_V(9); PG8_WAIT_L(0); PG8_BAR; PG8_MMA(1, 0, At, B0); PG8_MMA(1, 1, At, B1); PG8_BAR; PG8_SCHED;
            } else {
            PG8_LDB(B0, 0, 0); PG8_SCHED; PG8_LDA(At, 0, 0); PG8_STAGEA(PG8_SA(1, 1), a1 + hstep);
            PG8_WAIT_L(8); PG8_BAR; PG8_WAIT_L(0); PG8_MMA(0, 0, At, B0); PG8_BAR; PG8_SCHED;
            PG8_LDB(B1, 0, 1); PG8_STAGEB(PG8_SB(0, 0), b2);
            PG8_BAR; PG8_WAIT_L(0); PG8_MMA(0, 1, At, B1); PG8_BAR;
            PG8_LDA(At, 0, 1); PG8_STAGEA(PG8_SA(0, 0), a2);
            PG8_BAR; PG8_WAIT_L(0); PG8_MMA(1, 0, At, B0); PG8_BAR; PG8_SCHED;
            PG8_STAGEB(PG8_SB(0, 1), b2 + hstep);
            PG8_WAIT_V(6); PG8_BAR; PG8_MMA(1, 1, At, B1); PG8_BAR;
            PG8_LDB(B0, 1, 0); PG8_SCHED; PG8_LDA(At, 1, 0); PG8_STAGEA(PG8_SA(0, 1), a2 + hstep);
            PG8_WAIT_L(8); PG8_BAR; PG8_WAIT_L(0); PG8_MMA(0, 0, At, B0); PG8_BAR; PG8_SCHED;
            PG8_LDB(B1, 1, 1); PG8_STAGEB(PG8_SB(1, 0), b3);
            PG8_BAR; PG8_WAIT_L(0); PG8_MMA(0, 1, At, B1); PG8_BAR;
            PG8_LDA(At, 1, 1); PG8_STAGEA(PG8_SA(1, 0), a3);
            PG8_BAR; PG8_WAIT_L(0); PG8_MMA(1, 0, At, B0); PG8_BAR; PG8_SCHED;
            PG8_STAGEB(PG8_SB(1, 1), b3 + hstep);
            PG8_WAIT_V(6); PG8_BAR; PG8_MMA(1, 1, At, B1); PG8_BAR;
            }
        }
        if constexpr (ALIGN_EPI) { if (wr == 0) PG8_BAR; }
        E(acc, cur, wr, wc, fr, fq); E.rgx(accx, cur, wr, wc, fr, fq);
        if (!has_next) break;
#pragma unroll
        for (int a = 0; a < 2; ++a)
#pragma unroll
            for (int b = 0; b < 2; ++b)
#pragma unroll
                for (int m = 0; m < 4; ++m)
#pragma unroll
                    for (int n = 0; n < 2; ++n) acc[a][b][m][n] = (f32x4){0.f, 0.f, 0.f, 0.f};
        accx[0] = (f32x4){0.f, 0.f, 0.f, 0.f}; accx[1] = (f32x4){0.f, 0.f, 0.f, 0.f};
        cur = nxt; cA = nA; cB = nB; cX = nX; ++ui;
        if constexpr (ALIGN_EPI) { if (wr == 1) PG8_BAR; }
    }
    PG8_WAIT_V(0);
    if constexpr (!ALIGN_EPI) { if (wr == 0) PG8_BAR; }
    PG8_BAR;
#undef PG8_SA
#undef PG8_SB
#undef PG8_STAGEA
#undef PG8_STAGEB
#undef PG8_SX
#undef PG8_STAGEX
#undef PG8_LDAX
#undef PG8_MMAX
#undef PG8_LDA
#undef PG8_LDB
#undef PG8_MMA
#undef PG8_WAIT_V
#undef PG8_WAIT_L
#undef PG8_BAR
#undef PG8_SCHED
}
}

#define GAS __attribute__((address_space(1)))
#define LAS __attribute__((address_space(3)))
typedef unsigned short bf16;
typedef unsigned v4u __attribute__((ext_vector_type(4)));
typedef float f32x4 __attribute__((ext_vector_type(4)));
typedef short bf16x8 __attribute__((ext_vector_type(8)));
typedef GAS unsigned gu32;
typedef GAS unsigned long long gu64;
#define RLX_AGENT __ATOMIC_RELAXED, __HIP_MEMORY_SCOPE_AGENT
#define LDS_WAIT() asm volatile("s_waitcnt lgkmcnt(0)" ::: "memory")
#define VM_WAIT() asm volatile("s_waitcnt vmcnt(0)" ::: "memory")
__device__ __forceinline__ unsigned long long rt() { return __builtin_amdgcn_s_memrealtime(); }
__device__ __forceinline__ unsigned f2bf(float f) { unsigned u = __builtin_bit_cast(unsigned, f); return (u + 0x7fffu + ((u >> 16) & 1u)) >> 16; }
__device__ __forceinline__ unsigned pk2(float lo, float hi) { return f2bf(lo) | (f2bf(hi) << 16); }

#define XB_TMO      128
#define XB_XCNT(j)  (256  + 64 * (j))
#define XB_XSUB(j)  (1280 + 64 * (j))
#define XB_XGEN(j)  (2304 + 64 * (j))
#define XB_TOP      3328
#define XB_TOPGEN   3392
#define XCD_BAR_WORDS 3456
#define XB_SPIN_CAP (1u << 18)

__device__ __forceinline__ unsigned xb_ld(unsigned* p)              { return __hip_atomic_load(p, __ATOMIC_RELAXED, __HIP_MEMORY_SCOPE_AGENT); }
__device__ __forceinline__ unsigned xb_add(unsigned* p, unsigned v) { return __hip_atomic_fetch_add(p, v, __ATOMIC_RELAXED, __HIP_MEMORY_SCOPE_AGENT); }
__device__ __forceinline__ unsigned xb_xcc_id() { return (unsigned)__builtin_amdgcn_s_getreg((3 << 11) | 20) & 0xFu; }
#define XB_SPIN(cond, bar) do { unsigned _sp = 0; while (cond) { __builtin_amdgcn_s_sleep(1); \
    if ((++_sp & 255u) == 0u) { if (xb_ld(&(bar)[XB_TMO])) break; if (_sp > XB_SPIN_CAP) { atomicAdd(&(bar)[XB_TMO], 1u); break; } } } } while (0)

struct XcdBarrier {
    unsigned* bar; unsigned x; unsigned n;
    volatile LAS unsigned* st;
};

__device__ __forceinline__ XcdBarrier xcd_barrier_post(unsigned* bar, volatile LAS unsigned* st, unsigned n) {
    XcdBarrier b; b.bar = bar; b.x = xb_xcc_id(); b.st = st; b.n = n;
    if (threadIdx.x == 0) (void)xb_add(&bar[XB_XCNT(b.x)], 1u);
    return b;
}
__device__ __forceinline__ void xcd_barrier_complete(unsigned* bar, unsigned x, unsigned G, unsigned& nloc, unsigned& nx) {
    unsigned sum, cnt, mine, sp = 0u;
    for (;;) {
        sum = 0u; cnt = 0u; mine = 0u;
#pragma unroll
        for (unsigned j = 0; j < 16; ++j) { const unsigned c = xb_ld(&bar[XB_XCNT(j)]); sum += c; cnt += (c > 0u) ? 1u : 0u; mine = (j == x) ? c : mine; }
        if (sum == G) break;
        __builtin_amdgcn_s_sleep(1);
        if ((++sp & 255u) == 0u) { if (xb_ld(&bar[XB_TMO])) break; if (sp > XB_SPIN_CAP) { atomicAdd(&bar[XB_TMO], 1u); break; } }
    }
    nloc = mine > 0u ? mine : 1u; nx = cnt > 0u ? cnt : 1u;
}

__device__ __forceinline__ void xcd_barrier(const XcdBarrier& b) {
    asm volatile("s_waitcnt vmcnt(0)" ::: "memory");
    __syncthreads();
    if (threadIdx.x == 0) {
        unsigned* bar = b.bar;
        __builtin_amdgcn_s_waitcnt(0);
        unsigned nloc = b.st[0], nx = b.st[1];
        if (nloc == 0u) { xcd_barrier_complete(bar, b.x, b.n, nloc, nx); b.st[0] = nloc; b.st[1] = nx; }
        const unsigned old = xb_add(&bar[XB_XSUB(b.x)], 1u);
        const unsigned gen = old / nloc;
        if (old + 1u == (gen + 1u) * nloc) {
            __builtin_amdgcn_fence(__ATOMIC_RELEASE, "agent");
            asm volatile("s_waitcnt vmcnt(0)" ::: "memory");
            const unsigned og = xb_add(&bar[XB_TOP], 1u);
            const unsigned tg = og / nx;
            if (og + 1u == (tg + 1u) * nx) xb_add(&bar[XB_TOPGEN], 1u);
            else XB_SPIN(xb_ld(&bar[XB_TOPGEN]) == tg, bar);
            __builtin_amdgcn_fence(__ATOMIC_ACQUIRE, "agent");
            xb_add(&bar[XB_XGEN(b.x)], 1u);
            asm volatile("s_waitcnt vmcnt(0)" ::: "memory");
        } else {
            XB_SPIN(xb_ld(&bar[XB_XGEN(b.x)]) == gen, bar);
            __builtin_amdgcn_fence(__ATOMIC_ACQUIRE, "agent");
            asm volatile("s_waitcnt vmcnt(0)" ::: "memory");
        }
    }
    __syncthreads();
}


constexpr int NWAVES = 8;
#ifndef MK_ONE_LAUNCH
#define MK_ONE_LAUNCH 1
#endif
constexpr int N_PHASES = 15;

constexpr int D = 1024, FF = 4096, MP = 8 * 2048, MS = 128 * 8, M = MP + MS;
constexpr int NG = 64, PS = 64, GS = 16;
constexpr float EPS = 1e-6f;
constexpr size_t O_Y = 0, O_SRP = (size_t)M * D, O_SIP = O_SRP + 8 * 4096, O_CP = O_SIP + 8 * 4096, O_SRS = O_CP + 8 * 2 * 1024, O_SIS = O_SRS + 128 * 4096, O_CS = O_SIS + 128 * 4096, O_END = O_CS + 128 * 2 * 1024;
static_assert(O_END == 19218432, "output size");

constexpr size_t MiB = 1u << 20;
constexpr size_t WS_CTL = 0, CTL_ZERO_BYTES = 1 * MiB;
constexpr size_t WS_SSQ = 112 * MiB;
constexpr size_t WS_SSME = 114 * MiB;
constexpr size_t WS_SSMP = 2 * MiB;
constexpr size_t WS_WGU = 4 * MiB;
constexpr size_t WS_WD = 68 * MiB;
constexpr size_t WS_WGLU = 100 * MiB;
constexpr size_t WS_WIN = 104 * MiB;
constexpr size_t WS_WOUT = 110 * MiB;
constexpr size_t WS_X = 112 * MiB;
constexpr size_t WS_XB = 180 * MiB;
constexpr size_t WS_H = 214 * MiB;
constexpr size_t WS_G = 350 * MiB, WS_A2 = WS_G, WS_Z = 384 * MiB, WS_GB = 418 * MiB;
constexpr size_t WS_END = 452 * MiB;
constexpr int CW_TMO = 0;
constexpr int CW_BAR = 4096;
constexpr int CW_SK = 16384;

constexpr int RING_OFF = 0, RING_BYTES = 131072 + 4096;
constexpr int LDSCTL_OFF = RING_BYTES, MISC_OFF = LDSCTL_OFF + 320;
constexpr int LDS_BYTES = 147456;

struct Frame {
    LAS unsigned char* lds;
    volatile LAS unsigned* MISC;
    gu32* ctl;
    int tid, lane, wave, vcu, G, gi, ci;
    const float* in[21]; float* out; unsigned char* ws;
};

__device__ __forceinline__ int opaque_i(int v) { asm volatile("" : "+v"(v)); return v; }
__device__ __forceinline__ float wave_sum(float v) {
#pragma unroll
    for (int o = 1; o < 64; o <<= 1) v += __shfl_xor(v, o);
    return v;
}
__device__ __forceinline__ float bf2f(unsigned short b) { return __builtin_bit_cast(float, (unsigned)b << 16); }

__device__ __forceinline__ void p0_transpose_item(const float* W, int K, int N, bf16* WT, const float* gk, int k0, int n0s, int n0d, LAS unsigned char* scr, int lane) {
    const int kr = lane >> 4, c = lane & 15;
    f32x4 v[8][2];
#pragma unroll
    for (int i = 0; i < 8; ++i)
#pragma unroll
        for (int s = 0; s < 2; ++s) v[i][s] = *(const GAS f32x4*)(W + (size_t)(k0 + 8 * i + 2 * kr + s) * N + n0s + 4 * c);
    if (gk) {
#pragma unroll
        for (int i = 0; i < 8; ++i)
#pragma unroll
            for (int s = 0; s < 2; ++s) v[i][s] = v[i][s] * gk[k0 + 8 * i + 2 * kr + s]; }
#pragma unroll
    for (int i = 0; i < 8; ++i)
#pragma unroll
        for (int j = 0; j < 4; ++j) *(LAS unsigned*)(scr + (4 * c + j) * 128 + (((4 * i + kr) ^ ((c & 7) << 2)) << 2)) = pg8::cvt_pk_bf16(v[i][0][j], v[i][1][j]);
    LDS_WAIT(); asm volatile("" ::: "memory");
    const int nr = lane >> 3, q = lane & 7;
#pragma unroll
    for (int i = 0; i < 8; ++i) { const int n = nr + 8 * i; const v4u o = *(const LAS v4u*)(scr + n * 128 + ((q ^ ((n >> 2) & 7)) << 4));
        *(GAS v4u*)(WT + (size_t)(n0d + n) * K + k0 + 8 * q) = o; }
    LDS_WAIT(); asm volatile("" ::: "memory");
}
__device__ __forceinline__ int pair_src(int nd, int base, int hstride) { return base + ((nd >> 7) & 1) * hstride + 128 * (nd >> 8) + (nd & 127); }

__device__ __forceinline__ void p0_prologue(Frame& F) {
    LAS unsigned char* scr = F.lds + RING_OFF + F.wave * 16384;
    const int gw = F.vcu * NWAVES + F.wave, NGW = F.G * NWAVES, lane = opaque_i(F.lane);
    const float* norm_g = F.in[5];
    constexpr int I_GU = (D / 64) * (2 * FF / 64), I_D = (FF / 64) * (D / 64), I_GLU = (D / 64) * (2 * D / 64), I_IN = (D / 64) * (3 * D / 64), I_OUT = (D / 64) * (D / 64);
    constexpr int NITEMS = 4 * I_GU + 4 * I_D + I_GLU + I_IN + I_OUT;
    for (int it = gw; it < NITEMS; it += NGW) {
        int r = it;
        if (r < 4 * I_GU) { const int f = r / I_GU; r -= f * I_GU; const int nb = r % (2 * FF / 64), kb = r / (2 * FF / 64), nd = 64 * nb;
            const float* gk = norm_g + ((f >> 1) * 3 + (f & 1) * 2) * D;
            p0_transpose_item(F.in[7] + (size_t)f * D * 2 * FF, D, 2 * FF, (bf16*)(F.ws + WS_WGU) + (size_t)f * 2 * FF * D, gk, 64 * kb, pair_src(nd, 0, FF), nd, scr, lane); continue; }
        r -= 4 * I_GU;
        if (r < 4 * I_D) { const int f = r / I_D; r -= f * I_D; const int nb = r % (D / 64), kb = r / (D / 64), nd = 64 * nb;
            p0_transpose_item(F.in[8] + (size_t)f * FF * D, FF, D, (bf16*)(F.ws + WS_WD) + (size_t)f * D * FF, nullptr, 64 * kb, nd, nd, scr, lane); continue; }
        r -= 4 * I_D;
        if (r < I_GLU) { const int nb = r % (2 * D / 64), kb = r / (2 * D / 64), nd = 64 * nb;
            p0_transpose_item(F.in[17], D, 2 * D, (bf16*)(F.ws + WS_WGLU), nullptr, 64 * kb, pair_src(nd, 0, D), nd, scr, lane); continue; }
        r -= I_GLU;
        if (r < I_IN) { const int nb = r % (3 * D / 64), kb = r / (3 * D / 64), nd = 64 * nb;
            const int ns = nd < 2048 ? pair_src(nd, D, D) : nd - 2048;
            p0_transpose_item(F.in[18], D, 3 * D, (bf16*)(F.ws + WS_WIN), norm_g + 4 * D, 64 * kb, ns, nd, scr, lane); continue; }
        r -= I_IN;
        { const int nb = r % (D / 64), kb = r / (D / 64), nd = 64 * nb;
            p0_transpose_item(F.in[20], D, D, (bf16*)(F.ws + WS_WOUT), nullptr, 64 * kb, nd, nd, scr, lane); }
    }
    bf16* XB = (bf16*)(F.ws + WS_XB); pg8::ssq_t* ssq = (pg8::ssq_t*)(F.ws + WS_SSQ);
    for (int m = gw; m < M; m += NGW) {
        const float* src = m < MP ? F.in[0] + (size_t)m * D : F.in[1] + (size_t)(m - MP) * D;
        const GAS f32x4* xr = (const GAS f32x4*)src + lane;
        GAS unsigned long long* o8 = (GAS unsigned long long*)(XB + (size_t)m * D) + lane;
        float s = 0.f;
#pragma unroll
        for (int j = 0; j < 4; ++j) { const f32x4 v = xr[64 * j]; s += (v.x * v.x + v.y * v.y) + (v.z * v.z + v.w * v.w);
            o8[64 * j] = (unsigned long long)pk2(v.x, v.y) | ((unsigned long long)pk2(v.z, v.w) << 32); }
        s = wave_sum(s);
        if (lane == 0) ssq[m] = pg8::ssq_fix(s);
    }
    for (int i = gw * 64 + lane; i < 7 * M; i += NGW * 64) ssq[M + i] = 0ull;
    float* sp = (float*)(F.ws + WS_SSMP);
    for (int i = gw * 64 + lane; i < NG * PS; i += NGW * 64) {
        const int g = i / PS;
        const float lr = F.in[9][i], li = F.in[10][i], dt = expf(F.in[11][g]);
        const float mag = expf(lr * dt); float sn, cs; sincosf(li * dt, &sn, &cs);
        const float lbr = mag * cs, lbi = mag * sn, den = lr * lr + li * li, nr = lbr - 1.0f, ni = lbi;
        const float fr = (nr * lr + ni * li) / den, fi = (ni * lr - nr * li) / den;
        sp[i] = lbr; sp[4096 + i] = lbi;
#pragma unroll
        for (int c = 0; c < GS; ++c) { const float br = F.in[12][(size_t)i * GS + c], bi = F.in[13][(size_t)i * GS + c];
            sp[8192 + (size_t)i * GS + c] = fr * br - fi * bi; sp[8192 + 65536 + (size_t)i * GS + c] = fr * bi + fi * br; }
    }
}

__device__ __forceinline__ float gelu_tanh(float x) {
    const float a = 0.7978845608028654f * (x + 0.044715f * x * x * x);
    return x * __builtin_amdgcn_rcpf(1.0f + __builtin_amdgcn_exp2f(-2.0f * 1.4426950408889634f * a));
}


typedef float f32x16 __attribute__((ext_vector_type(16)));
typedef unsigned u32x2v __attribute__((ext_vector_type(2)));
__device__ __forceinline__ unsigned cvtpk(float lo, float hi) { unsigned r; asm volatile("v_cvt_pk_bf16_f32 %0, %1, %2" : "=v"(r) : "v"(lo), "v"(hi)); return r; }
__device__ __forceinline__ bf16x8 pack8(const float* v) { v4u w; w.x = cvtpk(v[0], v[1]); w.y = cvtpk(v[2], v[3]); w.z = cvtpk(v[4], v[5]); w.w = cvtpk(v[6], v[7]); return __builtin_bit_cast(bf16x8, w); }
constexpr int SSM_ROWB = 272;
constexpr int SSM_NCH = 4, SSM_CHB = 16;
#define BFLO(w) __builtin_bit_cast(float, (w) << 16)
#define BFHI(w) __builtin_bit_cast(float, (w) & 0xffff0000u)

template <int MODE>
__device__ __forceinline__ void ssm_run(Frame& F, LAS unsigned char* img, int lane, int g, int row_base, int nblk, bool sample, int seq0, float& hr, float& hi) {
    const bf16* X = (const bf16*)(F.ws + WS_XB); const pg8::ssq_t* ssq = (const pg8::ssq_t*)(F.ws + WS_SSQ) + 1 * M;
    const float* sp = (const float*)(F.ws + WS_SSMP); bf16* Gb = (bf16*)(F.ws + WS_G);
    const float* g1 = F.in[5] + 1 * D; const float* dsk = F.in[16];
    const int l31 = lane & 31, h = lane >> 5, l15 = lane & 15, q4 = lane >> 4;
    bf16x8 bbq[4];
#pragma unroll
    for (int q = 0; q < 4; ++q) { const int p = 32 * (q & 1) + l31; const float* src = sp + 8192 + (q >> 1) * 65536 + ((size_t)(g * PS + p) * GS + 8 * h);
        float v[8];
#pragma unroll
        for (int j = 0; j < 8; ++j) v[j] = src[j] * g1[g * GS + 8 * h + j];
        bbq[q] = pack8(v); }
    bf16x8 cm[4]; float dg[4];
    if (MODE == 1) {
#pragma unroll
        for (int ks = 0; ks < 4; ++ks) { const int p0 = 16 * ks + 4 * q4; const float* cr = F.in[14] + ((size_t)(g * GS + l15) * PS + p0); const float* ci = F.in[15] + ((size_t)(g * GS + l15) * PS + p0);
            float v[8];
#pragma unroll
            for (int j = 0; j < 4; ++j) { v[2 * j] = cr[j]; v[2 * j + 1] = -ci[j]; }
            cm[ks] = pack8(v); }
#pragma unroll
        for (int e = 0; e < 4; ++e) dg[e] = dsk[g * GS + 4 * q4 + e] * g1[g * GS + 4 * q4 + e];
    }
    const float lbr = sp[g * PS + lane], lbi = sp[4096 + g * PS + lane];
    float s0r[4], s0i[4];
    if (sample) {
#pragma unroll
        for (int i = 0; i < 4; ++i) { s0r[i] = F.in[2][((size_t)(seq0 + i) * NG + g) * PS + lane]; s0i[i] = F.in[3][((size_t)(seq0 + i) * NG + g) * PS + lane]; } }
    else {
#pragma unroll
        for (int i = 0; i < 4; ++i) { s0r[i] = 0.f; s0i[i] = 0.f; } }
    v4u xaw; u32x2v xew0, xew1; pg8::ssq_t qa, qe0 = 0, qe1 = 0;
#define SSM_LOAD(b) do { const int rowA = row_base + 32 * (b) + l31; xaw = *(const GAS v4u*)(X + (size_t)rowA * D + g * GS + 8 * h); qa = ssq[rowA]; \
        if (MODE == 1) { const int rowE = row_base + 32 * (b) + l15; xew0 = *(const GAS u32x2v*)(X + (size_t)rowE * D + g * GS + 4 * q4); xew1 = *(const GAS u32x2v*)(X + (size_t)(rowE + 16) * D + g * GS + 4 * q4); qe0 = ssq[rowE]; qe1 = ssq[rowE + 16]; } } while (0)
    SSM_LOAD(0);
    for (int b = 0; b < nblk; ++b) {
        const f32x4 ca0 = {BFLO(xaw.x), BFHI(xaw.x), BFLO(xaw.y), BFHI(xaw.y)}, ca1 = {BFLO(xaw.z), BFHI(xaw.z), BFLO(xaw.w), BFHI(xaw.w)};
        f32x4 ce0, ce1; if (MODE == 1) { ce0 = (f32x4){BFLO(xew0.x), BFHI(xew0.x), BFLO(xew0.y), BFHI(xew0.y)}; ce1 = (f32x4){BFLO(xew1.x), BFHI(xew1.x), BFLO(xew1.y), BFHI(xew1.y)}; }
        const pg8::ssq_t cqa = qa, cqe0 = qe0, cqe1 = qe1;
        if (b + 1 < nblk) SSM_LOAD(b + 1);
        const float rsa = pg8::rstd_of(cqa);
        float ua[8];
#pragma unroll
        for (int j = 0; j < 4; ++j) { ua[j] = ca0[j] * rsa; ua[4 + j] = ca1[j] * rsa; }
        const bf16x8 ufrag = pack8(ua);
        const f32x16 zero16 = {0.f, 0.f, 0.f, 0.f, 0.f, 0.f, 0.f, 0.f, 0.f, 0.f, 0.f, 0.f, 0.f, 0.f, 0.f, 0.f};
        f32x16 Xr = __builtin_amdgcn_mfma_f32_32x32x16_bf16(ufrag, bbq[0], zero16, 0, 0, 0);
        f32x16 Yr = __builtin_amdgcn_mfma_f32_32x32x16_bf16(ufrag, bbq[1], zero16, 0, 0, 0);
        f32x16 Xi = __builtin_amdgcn_mfma_f32_32x32x16_bf16(ufrag, bbq[2], zero16, 0, 0, 0);
        f32x16 Yi = __builtin_amdgcn_mfma_f32_32x32x16_bf16(ufrag, bbq[3], zero16, 0, 0, 0);
#pragma unroll
        for (int r = 0; r < 16; ++r) {
            auto s1 = __builtin_amdgcn_permlane32_swap(__float_as_uint(Xr[r]), __float_as_uint(Yr[r]), false, false); Xr[r] = __uint_as_float(s1[0]); Yr[r] = __uint_as_float(s1[1]);
            auto s2 = __builtin_amdgcn_permlane32_swap(__float_as_uint(Xi[r]), __float_as_uint(Yi[r]), false, false); Xi[r] = __uint_as_float(s2[0]); Yi[r] = __uint_as_float(s2[1]); }
#pragma unroll
        for (int i = 0; i < 4; ++i) {
            if (sample) { hr = s0r[i]; hi = s0i[i]; }
#pragma unroll
            for (int s = 0; s < 2; ++s)
#pragma unroll
                for (int e = 0; e < 4; ++e) { const int r = 4 * i + e; const float br = s ? Yr[r] : Xr[r], bi = s ? Yi[r] : Xi[r];
                    const float nr = lbr * hr - lbi * hi + br, ni = lbr * hi + lbi * hr + bi; hr = nr; hi = ni;
                    if (MODE == 1) *(LAS unsigned*)(img + (8 * i + 4 * s + e) * SSM_ROWB + 4 * lane) = cvtpk(hr, hi); }
            if (sample) { F.out[O_SRS + ((size_t)(seq0 + i) * NG + g) * PS + lane] = hr; F.out[O_SIS + ((size_t)(seq0 + i) * NG + g) * PS + lane] = hi; }
        }
        if (MODE == 1) {
            f32x4 acc0 = {0.f, 0.f, 0.f, 0.f}, acc1 = {0.f, 0.f, 0.f, 0.f};
#pragma unroll
            for (int ks = 0; ks < 4; ++ks) {
                const bf16x8 b0 = *(const LAS bf16x8*)(img + l15 * SSM_ROWB + 64 * ks + 16 * q4);
                const bf16x8 b1 = *(const LAS bf16x8*)(img + (16 + l15) * SSM_ROWB + 64 * ks + 16 * q4);
                acc0 = __builtin_amdgcn_mfma_f32_16x16x32_bf16(cm[ks], b0, acc0, 0, 0, 0);
                acc1 = __builtin_amdgcn_mfma_f32_16x16x32_bf16(cm[ks], b1, acc1, 0, 0, 0); }
            const float rse0 = pg8::rstd_of(cqe0), rse1 = pg8::rstd_of(cqe1);
            float o0[4], o1[4];
#pragma unroll
            for (int e = 0; e < 4; ++e) { o0[e] = gelu_tanh(acc0[e] + dg[e] * ce0[e] * rse0); o1[e] = gelu_tanh(acc1[e] + dg[e] * ce1[e] * rse1); }
            const int rowE = row_base + 32 * b + l15;
            u32x2v w0, w1; w0.x = cvtpk(o0[0], o0[1]); w0.y = cvtpk(o0[2], o0[3]); w1.x = cvtpk(o1[0], o1[1]); w1.y = cvtpk(o1[2], o1[3]);
            *(u32x2v*)(Gb + (size_t)rowE * D + g * GS + 4 * q4) = w0;
            *(u32x2v*)(Gb + (size_t)(rowE + 16) * D + g * GS + 4 * q4) = w1;
        }
    }
#undef SSM_LOAD
}

__device__ __forceinline__ void ssm_phase_pass(Frame& F, int pass) {
    LAS unsigned char* img = F.lds + RING_OFF + F.wave * 16384;
    const int lane = opaque_i(F.lane), s = F.wave * 32 + F.ci, g = s & 63, c = s >> 6;
    float* E = (float*)(F.ws + WS_SSME) + ((size_t)(F.gi * NG + g) * SSM_NCH) * 2 * PS;
    const int row_base = F.gi * 2048 + c * (SSM_CHB * 32);
    if (pass == 0) {
        float hr = 0.f, hi = 0.f;
        ssm_run<0>(F, img, lane, g, row_base, SSM_CHB, false, 0, hr, hi);
        E[(c * 2 + 0) * PS + lane] = hr; E[(c * 2 + 1) * PS + lane] = hi;
        float sr = 0.f, si = 0.f;
        ssm_run<1>(F, img, lane, g, MP + 128 * F.gi + 32 * c, 1, true, 16 * F.gi + 4 * c, sr, si);
    } else {
        const float* sp = (const float*)(F.ws + WS_SSMP);
        float ar = sp[g * PS + lane], ai = sp[4096 + g * PS + lane];
#pragma unroll
        for (int k = 0; k < 9; ++k) { const float nr = ar * ar - ai * ai, ni = 2.0f * ar * ai; ar = nr; ai = ni; }
        float hr = 0.f, hi = 0.f;
        for (int j = 0; j < c; ++j) { const float er = E[(j * 2 + 0) * PS + lane], ei = E[(j * 2 + 1) * PS + lane];
            const float nr = ar * hr - ai * hi + er, ni = ar * hi + ai * hr + ei; hr = nr; hi = ni; }
        ssm_run<1>(F, img, lane, g, row_base, SSM_CHB, false, 0, hr, hi);
        if (c == SSM_NCH - 1) { F.out[O_SRP + ((size_t)F.gi * NG + g) * PS + lane] = hr; F.out[O_SIP + ((size_t)F.gi * NG + g) * PS + lane] = hi; }
    }
}
#undef BFLO
#undef BFHI

__device__ __forceinline__ void conv_phase(Frame& F) {
    const bf16* Z = (const bf16*)(F.ws + WS_Z); const bf16* GBp = (const bf16*)(F.ws + WS_GB); bf16* A2 = (bf16*)(F.ws + WS_A2);
    const float* cw = F.in[19]; const float* cache = F.in[4];
    const int gt = (F.ci * NWAVES + F.wave) * 64 + opaque_i(F.lane), NGT = 32 * NWAVES * 64;
    for (int it = gt; it < (2048 + 128) * (D / 8); it += NGT) {
        const int lr = it >> 7, row = lr < 2048 ? F.gi * 2048 + lr : MP + F.gi * 128 + (lr - 2048), c0 = (it & 127) * 8;
        int t; const float* cb = nullptr;
        if (row < MP) t = row & 2047; else { const int r2 = row - MP; t = r2 & 7; cb = cache + (size_t)(r2 >> 3) * 2 * D; }
        float z0[8], z1[8], z2[8], gb[8];
        { const v4u v = *(const GAS v4u*)(Z + (size_t)row * D + c0); const v4u q = *(const GAS v4u*)(GBp + (size_t)row * D + c0);
#pragma unroll
          for (int e = 0; e < 4; ++e) { z2[2 * e] = __builtin_bit_cast(float, v[e] << 16); z2[2 * e + 1] = __builtin_bit_cast(float, v[e] & 0xffff0000u);
                                        gb[2 * e] = __builtin_bit_cast(float, q[e] << 16); gb[2 * e + 1] = __builtin_bit_cast(float, q[e] & 0xffff0000u); } }
        if (t >= 1) { const v4u v = *(const GAS v4u*)(Z + (size_t)(row - 1) * D + c0);
#pragma unroll
          for (int e = 0; e < 4; ++e) { z1[2 * e] = __builtin_bit_cast(float, v[e] << 16); z1[2 * e + 1] = __builtin_bit_cast(float, v[e] & 0xffff0000u); } }
        else {
#pragma unroll
          for (int e = 0; e < 8; ++e) z1[e] = cb ? cb[D + c0 + e] : 0.f; }
        if (t >= 2) { const v4u v = *(const GAS v4u*)(Z + (size_t)(row - 2) * D + c0);
#pragma unroll
          for (int e = 0; e < 4; ++e) { z0[2 * e] = __builtin_bit_cast(float, v[e] << 16); z0[2 * e + 1] = __builtin_bit_cast(float, v[e] & 0xffff0000u); } }
        else {
#pragma unroll
          for (int e = 0; e < 8; ++e) z0[e] = cb ? cb[t * D + c0 + e] : 0.f; }
        float o[8];
#pragma unroll
        for (int e = 0; e < 8; ++e) o[e] = gb[e] * (cw[c0 + e] * z0[e] + cw[D + c0 + e] * z1[e] + cw[2 * D + c0 + e] * z2[e]);
        v4u w; w.x = pk2(o[0], o[1]); w.y = pk2(o[2], o[3]); w.z = pk2(o[4], o[5]); w.w = pk2(o[6], o[7]);
        *(GAS v4u*)(A2 + (size_t)row * D + c0) = w;
    }
}

__device__ __forceinline__ void final_phase(Frame& F) {
    const bf16* XBp = (const bf16*)(F.ws + WS_XB); const pg8::ssq_t* ssq = (const pg8::ssq_t*)(F.ws + WS_SSQ) + 6 * M; const float* fg = F.in[6];
    const int gw = F.ci * NWAVES + F.wave, NGW = 32 * NWAVES, lane = opaque_i(F.lane);
    f32x4 gv[4];
#pragma unroll
    for (int j = 0; j < 4; ++j) gv[j] = ((const GAS f32x4*)fg)[lane + 64 * j];
    for (int lr = gw; lr < 2048 + 128; lr += NGW) { const int m = lr < 2048 ? F.gi * 2048 + lr : MP + F.gi * 128 + (lr - 2048);
        const float rs = pg8::rstd_of(ssq[m]);
        const GAS unsigned long long* xr = (const GAS unsigned long long*)(XBp + (size_t)m * D) + lane; GAS f32x4* yo = (GAS f32x4*)(F.out + O_Y + (size_t)m * D) + lane;
#pragma unroll
        for (int j = 0; j < 4; ++j) { const unsigned long long w = xr[64 * j]; const unsigned lo = (unsigned)w, hi = (unsigned)(w >> 32);
            const f32x4 xv = {__builtin_bit_cast(float, lo << 16), __builtin_bit_cast(float, lo & 0xffff0000u), __builtin_bit_cast(float, hi << 16), __builtin_bit_cast(float, hi & 0xffff0000u)};
            yo[64 * j] = xv * rs * gv[j]; }
    }
}

struct SameOrder : pg8::StaticOrder { __device__ bool next(int i, pg8::Unit& u) const { const bool r = pg8::StaticOrder::next(i, u); u.pm = 0; u.pn = 0; return r; } };
struct Args { const float* in[21]; float* out; unsigned char* ws; int ph_lo, ph_hi; };
__global__ void __launch_bounds__(NWAVES * 64, 2) skel_fwd(Args args) {
    extern __shared__ __attribute__((aligned(16))) unsigned char lds[];
    Frame F;
    F.lds = (LAS unsigned char*)lds;
    F.MISC = (volatile LAS unsigned*)(F.lds + MISC_OFF);
    F.tid = threadIdx.x; F.lane = F.tid & 63; F.wave = __builtin_amdgcn_readfirstlane(F.tid >> 6);
    F.G = gridDim.x; { const int bx = blockIdx.x; F.vcu = (bx % 8) * (F.G / 8) + bx / 8; F.gi = bx % 8; F.ci = bx / 8; }
    F.ws = args.ws; F.out = args.out; F.ctl = (gu32*)(args.ws + WS_CTL);
#pragma unroll
    for (int i = 0; i < 21; ++i) F.in[i] = args.in[i];
    for (int u = F.tid; u < (LDS_BYTES - LDSCTL_OFF) / 4; u += NWAVES * 64) ((LAS unsigned*)(F.lds + LDSCTL_OFF))[u] = 0u;
    __syncthreads();
    XcdBarrier bar = xcd_barrier_post((unsigned*)(F.ctl + CW_BAR), F.MISC + 8, (unsigned)F.G);
    XcdBarrier gbar = xcd_barrier_post((unsigned*)(F.ctl + CW_BAR) + (1 + F.gi) * XCD_BAR_WORDS, F.MISC + 10, (unsigned)(F.G / 8));
    const int lo = args.ph_lo, hi = args.ph_hi;
#define IN(k) (lo <= (k) && (k) < hi)
#if defined(PROBE_A_LO)
#define STAMP(k) do { if (blockIdx.x == 0 && F.tid == 0) { const unsigned long long t_ = __builtin_amdgcn_s_memrealtime(); F.MISC[16 + 2 * (k)] = (unsigned)t_; F.MISC[17 + 2 * (k)] = (unsigned)(t_ >> 32); } } while (0)
#else
#define STAMP(k) do { } while (0)
#endif
    STAMP(0);
#define SEAM(k) do { if (IN((k) + 1)) { if ((k) == 0) xcd_barrier(bar); else xcd_barrier(gbar); } STAMP((k) + 1); } while (0)
    bf16* XB = (bf16*)(F.ws + WS_XB); bf16* H = (bf16*)(F.ws + WS_H); pg8::ssq_t* ssq = (pg8::ssq_t*)(F.ws + WS_SSQ);
    const int bx = (int)blockIdx.x;

    if (IN(0)) { p0_prologue(F); SEAM(0); }
#define FFN_GU(ph, f, sin) if (IN(ph)) { pg8::Gemm g{XB, (const bf16*)(F.ws + WS_WGU) + (size_t)(f) * 2 * FF * D, M, 2 * FF, D}; pg8::StaticOrder S; S.init(MP, 2 * FF, F.G, bx); \
        pg8::EpiGateUp E{H, FF, ssq + (size_t)(sin) * M}; pg8::gemm_phase<pg8::EpiGateUp, pg8::StaticOrder, true, true>(F.lds + RING_OFF, g, S, E); SEAM(ph); }
#define FFN_DN(ph, f, sout) if (IN(ph)) { pg8::Gemm g{H, (const bf16*)(F.ws + WS_WD) + (size_t)(f) * D * FF, M, D, FF}; pg8::StaticOrder S; S.init(MP, D, F.G, bx); \
        pg8::EpiResid<0> E{(ph) == 2 ? F.in[0] : nullptr, (ph) == 2 ? F.in[1] : nullptr, XB, ssq + (size_t)(sout) * M, 0.5f}; pg8::gemm_phase<pg8::EpiResid<0>, pg8::StaticOrder, true, true>(F.lds + RING_OFF, g, S, E); SEAM(ph); }
    FFN_GU(1, 0, 0)
    FFN_DN(2, 0, 1)
    if (IN(3)) { ssm_phase_pass(F, 0); xcd_barrier(gbar); ssm_phase_pass(F, 1); SEAM(3); }
    if (IN(4)) { pg8::Gemm g{(const bf16*)(F.ws + WS_G), (const bf16*)(F.ws + WS_WGLU), M, 2 * D, D}; pg8::StaticOrder S; S.init(MP, 2 * D, F.G, bx);
        pg8::EpiResid<1> E{nullptr, nullptr, XB, ssq + (size_t)2 * M, 1.0f}; pg8::gemm_phase<pg8::EpiResid<1>, pg8::StaticOrder, true, true>(F.lds + RING_OFF, g, S, E); SEAM(4); }
    FFN_GU(5, 1, 2)
    FFN_DN(6, 1, 3)
    FFN_GU(7, 2, 3)
    FFN_DN(8, 2, 4)
    if (IN(9)) { pg8::Gemm g{XB, (const bf16*)(F.ws + WS_WIN), M, 3 * D, D}; pg8::StaticOrder S; S.init(MP, 3 * D, F.G, bx);
        pg8::EpiConvIn E{(bf16*)(F.ws + WS_Z), (bf16*)(F.ws + WS_GB), ssq + (size_t)4 * M, F.out + O_CP, F.out + O_CS};
        pg8::gemm_phase<pg8::EpiConvIn, pg8::StaticOrder, true, true>(F.lds + RING_OFF, g, S, E); SEAM(9); }
    if (IN(10)) { conv_phase(F); SEAM(10); }
    if (IN(11)) { pg8::Gemm g{(const bf16*)(F.ws + WS_A2), (const bf16*)(F.ws + WS_WOUT), M, D, D}; pg8::StaticOrder S; S.init(MP, D, F.G, bx);
        pg8::EpiResid<0> E{nullptr, nullptr, XB, ssq + (size_t)5 * M, 1.0f}; pg8::gemm_phase<pg8::EpiResid<0>, pg8::StaticOrder, true, true>(F.lds + RING_OFF, g, S, E); SEAM(11); }
    FFN_GU(12, 3, 5)
    FFN_DN(13, 3, 6)
    if (IN(14)) { final_phase(F); }
#if defined(PROBE_DRY)
#ifndef PROBE_VARIANT
#define PROBE_VARIANT 0
#endif
    xcd_barrier(gbar); STAMP(15); if (blockIdx.x == 0 && F.tid == 0) { const unsigned long long c_ = __builtin_amdgcn_s_memtime(); F.MISC[60] = (unsigned)c_; F.MISC[61] = (unsigned)(c_ >> 32); }
#if PROBE_DRY == 2
    { pg8::Gemm g{XB, (const bf16*)(F.ws + WS_WGU), M, 2 * FF, D}; SameOrder S; S.init(MP, 2 * FF, F.G, bx);
      pg8::EpiNull E{H + (size_t)M * FF - 1}; pg8::gemm_phase<pg8::EpiNull, SameOrder, true, true>(F.lds + RING_OFF, g, S, E); }
#else
    { pg8::Gemm g{XB, (const bf16*)(F.ws + WS_WGU), M, 2 * FF, D}; pg8::StaticOrder S; S.init(MP, 2 * FF, F.G, bx);
      pg8::EpiNull E{H + (size_t)M * FF - 1}; pg8::gemm_phase<pg8::EpiNull, pg8::StaticOrder, true, true, PROBE_VARIANT>(F.lds + RING_OFF, g, S, E); }
#endif
    xcd_barrier(gbar); STAMP(16); if (blockIdx.x == 0 && F.tid == 0) { const unsigned long long c_ = __builtin_amdgcn_s_memtime(); F.MISC[62] = (unsigned)c_; F.MISC[63] = (unsigned)(c_ >> 32); }
#endif
#if defined(PROBE_A_LO)
    __syncthreads();
    if (blockIdx.x == 0 && F.tid == 0) {
#if !defined(PROBE_DRY)
        STAMP(15);
#endif
#define TS(k) ((unsigned long long)F.MISC[16 + 2 * (k)] | ((unsigned long long)F.MISC[17 + 2 * (k)] << 32))
        const unsigned long long ta = TS(PROBE_A_HI) - TS(PROBE_A_LO), tb = TS(PROBE_B_HI) - TS(PROBE_B_LO);
#if defined(PROBE_CLOCK)
        { const unsigned long long c0 = (unsigned long long)F.MISC[60] | ((unsigned long long)F.MISC[61] << 32), c1 = (unsigned long long)F.MISC[62] | ((unsigned long long)F.MISC[63] << 32);
          F.out[0] += (float)(c1 - c0) / (float)(TS(16) - TS(15)) * 1e-2f; }
#else
        F.out[0] += (float)tb * 1e-5f;
#endif
        const unsigned long long t0 = __builtin_amdgcn_s_memrealtime();
        const unsigned long long spin = ta * 4ull < 1000000ull ? ta * 4ull : 1000000ull;
        while (__builtin_amdgcn_s_memrealtime() - t0 < spin) __builtin_amdgcn_s_sleep(8);
    }
#endif
#undef IN
#undef SEAM
}

extern "C" void kernel_launch(void* const* d_in, const int* in_sizes, int n_in, void* d_out, int out_size, void* d_ws, size_t ws_size, hipStream_t stream) {
    static int grid = 0;
    if (grid == 0) {
        if (n_in != 21 || out_size != (int)O_END || ws_size < WS_END) { fprintf(stderr, "kernel_launch: unexpected shapes: n_in %d out %d ws %zu; nothing launched\n", n_in, out_size, ws_size); grid = -1; return; }
        int dev = 0, cus = 0, per_cu = 0;
        if (hipGetDevice(&dev) != hipSuccess || hipDeviceGetAttribute(&cus, hipDeviceAttributeMultiprocessorCount, dev) != hipSuccess) { grid = -1; return; }
        if (hipFuncSetAttribute((const void*)skel_fwd, hipFuncAttributeMaxDynamicSharedMemorySize, LDS_BYTES) != hipSuccess) { fprintf(stderr, "kernel_launch: hipFuncSetAttribute failed\n"); grid = -1; return; }
        if (hipOccupancyMaxActiveBlocksPerMultiprocessor(&per_cu, (const void*)skel_fwd, NWAVES * 64, LDS_BYTES) != hipSuccess || per_cu < 1) fprintf(stderr, "kernel_launch: occupancy query reports %d\n", per_cu);
        (void)hipGetLastError();
        if (cus < 256) { fprintf(stderr, "kernel_launch: built for a 256-CU device (8 groups x 32 workgroups), found %d CUs; nothing launched\n", cus); grid = -1; return; }
        grid = 256;
    }
    if (grid < 0) return;
    if (hipMemsetAsync((char*)d_ws + WS_CTL, 0, CTL_ZERO_BYTES, stream) != hipSuccess) return;
    Args a{};
    for (int i = 0; i < 21; ++i) a.in[i] = (const float*)d_in[i];
    a.out = (float*)d_out; a.ws = (unsigned char*)d_ws;
    a.ph_lo = 0; a.ph_hi = N_PHASES;
    hipLaunchKernelGGL(skel_fwd, dim3(grid), dim3(NWAVES * 64), LDS_BYTES, stream, a);
}
```

```cpp
#include <hip/hip_runtime.h>
#include <cstdio>
#include <cstdint>
namespace pg8 {
#define PG8_LAS __attribute__((address_space(3)))
typedef unsigned short bf16_t;
typedef short bf16x8 __attribute__((ext_vector_type(8)));
typedef float f32x4 __attribute__((ext_vector_type(4)));
typedef unsigned u32x4 __attribute__((ext_vector_type(4)));
constexpr int BM = 256, BK = 64, HALF = 128, HTB = HALF * BK * 2  , STAGE_BYTES = 8 * HTB, NXCD = 8, WGM = 8;

__host__ __device__ __forceinline__ int lds_byte(int r, int c) { const int st = (r >> 4) * 2 + (c >> 5), rr = r & 15, cc = c & 31, ob = rr * 64 + cc * 2; return st * 1024 + (ob ^ (((ob >> 9) & 1) << 5)); }
__host__ __device__ __forceinline__ void stage_rc(int b, int& R, int& C) { const int st = b / 1024, sb = b % 1024, swz = sb ^ (((sb >> 9) & 1) << 5); R = (st >> 1) * 16 + swz / 64; C = (st & 1) * 32 + (swz % 64) / 2; }
__host__ __device__ __forceinline__ int perm32(int rho) { const int n = rho >> 4, i = rho & 15; return 8 * (i >> 2) + 4 * n + (i & 3); }

struct Unit { int pm, pn; };
struct Gemm { const bf16_t* A; const bf16_t* Bt; int M, N, K; };

struct StaticOrder {
    int nM, nN, nwg, G, c;
    __host__ __device__ void init(int M, int N, int G_, int c_) { nM = M / BM; nN = N / BM; nwg = nM * nN; G = G_; c = c_; }
    __host__ __device__ bool next(int i, Unit& u) const {
        const long L = (long)i * G + c; if (L >= nwg) return false;
        int wgid = (int)L; { const int q = nwg / NXCD, r = nwg % NXCD, xcd = wgid % NXCD, off = wgid / NXCD; wgid = (xcd < r ? xcd * (q + 1) : r * (q + 1) + (xcd - r) * q) + off; }
        const int nig = WGM * nN, gid = wgid / nig, fm = gid * WGM, gsz = (nM - fm) < WGM ? (nM - fm) : WGM;
        u.pm = fm + ((wgid % nig) % gsz); u.pn = (wgid % nig) / gsz; return true;
    }
    __device__ __forceinline__ void a_ready(const Unit&) const {}
    __device__ __forceinline__ void done(const Unit&) const {}
};


__device__ __forceinline__ unsigned cvt_pk_bf16(float lo, float hi) { unsigned r; asm volatile("v_cvt_pk_bf16_f32 %0, %1, %2" : "=v"(r) : "v"(lo), "v"(hi)); return r; }

typedef unsigned u32x2 __attribute__((ext_vector_type(2)));
constexpr float RMS_EPS = 1e-6f;
constexpr float INV_D = 1.0f / 1024.0f;
__device__ __forceinline__ float sigmoid_f(float x) { return __builtin_amdgcn_rcpf(1.0f + __builtin_amdgcn_exp2f(-1.4426950408889634f * x)); }
typedef unsigned long long ssq_t;
constexpr float SSQ_SCALE = 16777216.0f, SSQ_INV = 1.0f / 16777216.0f;
__device__ __forceinline__ ssq_t ssq_fix(float s) { return (ssq_t)(s * SSQ_SCALE + 0.5f); }
__device__ __forceinline__ float rstd_of(ssq_t q) { return __builtin_amdgcn_rsqf((float)q * (SSQ_INV * INV_D) + RMS_EPS); }
#define PG8_EPI_CALL() \
    __device__ __forceinline__ void operator()(const f32x4 (&acc)[2][2][4][2], const Unit& u, int wr, int wc, int fr, int fq) const { \
        _Pragma("unroll") for (int ai = 0; ai < 2; ++ai) _Pragma("unroll") for (int m = 0; m < 4; ++m) { \
            const f32x4 a[2][2] = {{acc[ai][0][m][0], acc[ai][0][m][1]}, {acc[ai][1][m][0], acc[ai][1][m][1]}}; rg(a, u, ai, m, 3, wr, wc, fr, fq); } }

struct EpiGateUp {
    static constexpr bool PERM = true, AFTER_DRAIN = false;
    bf16_t* H; int ldh; const ssq_t* ssq;
    __device__ __forceinline__ void rg(const f32x4 (&a)[2][2], const Unit& u, int ai, int m, int bjmask, int wr, int wc, int fr, int fq) const {
        const int row = u.pm * BM + ai * HALF + wr * 64 + m * 16 + fr, col0 = u.pn * HALF + wc * 32 + 8 * fq;
        const float rs = rstd_of(ssq[row]);
        float h[8];
#pragma unroll
        for (int n = 0; n < 2; ++n)
#pragma unroll
            for (int e = 0; e < 4; ++e) { const float g = a[0][n][e] * rs, up = a[1][n][e] * rs; h[4 * n + e] = g * sigmoid_f(g) * up; }
        u32x4 w; w.x = cvt_pk_bf16(h[0], h[1]); w.y = cvt_pk_bf16(h[2], h[3]); w.z = cvt_pk_bf16(h[4], h[5]); w.w = cvt_pk_bf16(h[6], h[7]);
        *(u32x4*)(H + (size_t)row * ldh + col0) = w;
    }
    __device__ __forceinline__ void rgx(const f32x4 (&ax)[2], const Unit& u, int wr, int wc, int fr, int fq) const {
        const int row = 16384 + 16 * u.pm + fr, col0 = u.pn * HALF + wc * 32 + 8 * fq + 4 * wr;
        const float rs = rstd_of(ssq[row]);
        float h[4];
#pragma unroll
        for (int e = 0; e < 4; ++e) { const float g = ax[0][e] * rs, up = ax[1][e] * rs; h[e] = g * sigmoid_f(g) * up; }
        u32x2 w; w.x = cvt_pk_bf16(h[0], h[1]); w.y = cvt_pk_bf16(h[2], h[3]);
        *(u32x2*)(H + (size_t)row * ldh + col0) = w;
    }
    PG8_EPI_CALL()
};

__device__ __forceinline__ void unpack8(const u32x4 w, float (&x)[8]) {
#pragma unroll
    for (int e = 0; e < 4; ++e) { x[2 * e] = __builtin_bit_cast(float, w[e] << 16); x[2 * e + 1] = __builtin_bit_cast(float, w[e] & 0xffff0000u); } }
template <int MODE> struct EpiResid {
    static constexpr bool PERM = true, AFTER_DRAIN = false;
    const float* xin_p; const float* xin_s; bf16_t* XB; ssq_t* ssq; float scale;
    __device__ __forceinline__ void rg(const f32x4 (&a)[2][2], const Unit& u, int ai, int m, int bjmask, int wr, int wc, int fr, int fq) const {
        const int row = u.pm * BM + ai * HALF + wr * 64 + m * 16 + fr;
        const int col0 = (MODE == 0 ? u.pn * BM : u.pn * HALF) + wc * 32 + 8 * fq;
        float sq = 0.f;
#pragma unroll
        for (int bj = 0; bj < (MODE == 0 ? 2 : 1); ++bj) {
            bf16_t* xp = XB + (size_t)row * 1024 + col0 + bj * HALF;
            float x[8];
            if (xin_p) { const float* xi = xin_p + (size_t)row * 1024 + col0 + bj * HALF; const f32x4 x0 = *(const f32x4*)xi, x1 = *(const f32x4*)(xi + 4);
#pragma unroll
                for (int e = 0; e < 4; ++e) { x[e] = x0[e]; x[4 + e] = x1[e]; } }
            else unpack8(*(const u32x4*)xp, x);
#pragma unroll
            for (int e = 0; e < 4; ++e) {
                if (MODE == 0) { x[e] += a[bj][0][e] * scale; x[4 + e] += a[bj][1][e] * scale; }
                else { x[e] += a[0][0][e] * sigmoid_f(a[1][0][e]); x[4 + e] += a[0][1][e] * sigmoid_f(a[1][1][e]); } }
            u32x4 w; w.x = cvt_pk_bf16(x[0], x[1]); w.y = cvt_pk_bf16(x[2], x[3]); w.z = cvt_pk_bf16(x[4], x[5]); w.w = cvt_pk_bf16(x[6], x[7]);
            *(u32x4*)xp = w;
            sq += (x[0] * x[0] + x[1] * x[1]) + (x[2] * x[2] + x[3] * x[3]) + (x[4] * x[4] + x[5] * x[5]) + (x[6] * x[6] + x[7] * x[7]); }
        sq += __shfl_xor(sq, 16); sq += __shfl_xor(sq, 32);
        if (fq == 0) atomicAdd(ssq + row, ssq_fix(sq));
    }
    __device__ __forceinline__ void rgx(const f32x4 (&ax)[2], const Unit& u, int wr, int wc, int fr, int fq) const {
        const int r2 = 16 * u.pm + fr, row = 16384 + r2;
        const int col0 = (MODE == 0 ? u.pn * BM : u.pn * HALF) + wc * 32 + 8 * fq + 4 * wr;
        float sq = 0.f;
#pragma unroll
        for (int bj = 0; bj < (MODE == 0 ? 2 : 1); ++bj) {
            bf16_t* xp = XB + (size_t)row * 1024 + col0 + bj * HALF;
            f32x4 x0;
            if (xin_s) x0 = *(const f32x4*)(xin_s + (size_t)r2 * 1024 + col0 + bj * HALF);
            else { const u32x2 w = *(const u32x2*)xp; x0[0] = __builtin_bit_cast(float, w.x << 16); x0[1] = __builtin_bit_cast(float, w.x & 0xffff0000u); x0[2] = __builtin_bit_cast(float, w.y << 16); x0[3] = __builtin_bit_cast(float, w.y & 0xffff0000u); }
            if (MODE == 0) x0 += ax[bj] * scale;
            else {
#pragma unroll
                for (int e = 0; e < 4; ++e) x0[e] += ax[0][e] * sigmoid_f(ax[1][e]); }
            u32x2 w; w.x = cvt_pk_bf16(x0[0], x0[1]); w.y = cvt_pk_bf16(x0[2], x0[3]);
            *(u32x2*)xp = w;
            sq += (x0[0] * x0[0] + x0[1] * x0[1]) + (x0[2] * x0[2] + x0[3] * x0[3]); }
        sq += __shfl_xor(sq, 16); sq += __shfl_xor(sq, 32);
        if (fq == 0) atomicAdd(ssq + row, ssq_fix(sq));
    }
    PG8_EPI_CALL()
};

struct EpiConvIn {
    static constexpr bool PERM = true, AFTER_DRAIN = false;
    bf16_t* Z; bf16_t* GB; const ssq_t* ssq; float* conv_p; float* conv_s;
    __device__ __forceinline__ void rg(const f32x4 (&a)[2][2], const Unit& u, int ai, int m, int bjmask, int wr, int wc, int fr, int fq) const {
        const int row = u.pm * BM + ai * HALF + wr * 64 + m * 16 + fr;
        const float rs = rstd_of(ssq[row]);
        if (u.pn < 8) {
            const int col0 = u.pn * HALF + wc * 32 + 8 * fq; const float rs2 = rs * rs;
            const f32x4 z0 = a[0][0] * a[1][0] * rs2, z1 = a[0][1] * a[1][1] * rs2;
            u32x4 w; w.x = cvt_pk_bf16(z0[0], z0[1]); w.y = cvt_pk_bf16(z0[2], z0[3]); w.z = cvt_pk_bf16(z1[0], z1[1]); w.w = cvt_pk_bf16(z1[2], z1[3]);
            *(u32x4*)(Z + (size_t)row * 1024 + col0) = w;
            float* cp = nullptr;
            if (row < 16384) { const int t = row & 2047; if (t >= 2046) cp = conv_p + ((size_t)(row >> 11) * 2 + (t - 2046)) * 1024 + col0; }
            else { const int r2 = row - 16384, t = r2 & 7; if (t >= 6) cp = conv_s + ((size_t)(r2 >> 3) * 2 + (t - 6)) * 1024 + col0; }
            if (cp) { *(f32x4*)cp = z0; *(f32x4*)(cp + 4) = z1; }
        } else {
            const int col0 = (u.pn - 8) * BM + wc * 32 + 8 * fq;
#pragma unroll
            for (int bj = 0; bj < 2; ++bj) { const f32x4 g0 = a[bj][0] * rs, g1 = a[bj][1] * rs;
                u32x4 w; w.x = cvt_pk_bf16(g0[0], g0[1]); w.y = cvt_pk_bf16(g0[2], g0[3]); w.z = cvt_pk_bf16(g1[0], g1[1]); w.w = cvt_pk_bf16(g1[2], g1[3]);
                *(u32x4*)(GB + (size_t)row * 1024 + col0 + bj * HALF) = w; }
        }
    }
    __device__ __forceinline__ void rgx(const f32x4 (&ax)[2], const Unit& u, int wr, int wc, int fr, int fq) const {
        const int r2 = 16 * u.pm + fr, row = 16384 + r2;
        const float rs = rstd_of(ssq[row]);
        if (u.pn < 8) {
            const int col0 = u.pn * HALF + wc * 32 + 8 * fq + 4 * wr;
            const f32x4 z0 = ax[0] * ax[1] * (rs * rs);
            u32x2 w; w.x = cvt_pk_bf16(z0[0], z0[1]); w.y = cvt_pk_bf16(z0[2], z0[3]);
            *(u32x2*)(Z + (size_t)row * 1024 + col0) = w;
            const int t = r2 & 7;
            if (t >= 6) *(f32x4*)(conv_s + ((size_t)(r2 >> 3) * 2 + (t - 6)) * 1024 + col0) = z0;
        } else {
            const int col0 = (u.pn - 8) * BM + wc * 32 + 8 * fq + 4 * wr;
#pragma unroll
            for (int bj = 0; bj < 2; ++bj) { const f32x4 g0 = ax[bj] * rs;
                u32x2 w; w.x = cvt_pk_bf16(g0[0], g0[1]); w.y = cvt_pk_bf16(g0[2], g0[3]);
                *(u32x2*)(GB + (size_t)row * 1024 + col0 + bj * HALF) = w; }
        }
    }
    PG8_EPI_CALL()
};

struct EpiNull {
    static constexpr bool PERM = true, AFTER_DRAIN = false;
    bf16_t* sink;
    __device__ __forceinline__ void rg(const f32x4 (&a)[2][2], const Unit& u, int ai, int m, int bjmask, int wr, int wc, int fr, int fq) const {
        asm volatile("" :: "v"(a[0][0]), "v"(a[0][1]), "v"(a[1][0]), "v"(a[1][1]));
    }
    __device__ __forceinline__ void rgx(const f32x4 (&ax)[2], const Unit& u, int wr, int wc, int fr, int fq) const { asm volatile("" :: "v"(ax[0]), "v"(ax[1])); }
    PG8_EPI_CALL()
};

template <class Epi, class Sched, bool ALIGN_EPI = false, bool SP2 = false, int PROBE = 0>
__device__ __forceinline__ void gemm_phase(PG8_LAS unsigned char* lds, const Gemm g, const Sched& S, const Epi& E) {
    int tid_ = threadIdx.x; asm volatile("" : "+v"(tid_));
    const int tid = tid_, wid = __builtin_amdgcn_readfirstlane(tid >> 6), lane = tid & 63, wr = wid >> 2, wc = wid & 3, fr = lane & 15, fq = lane >> 4;
    const int K = g.K, nt = K / BK;
    constexpr int XROW0 = 16384, XR = 16;
    unsigned voffA[2], voffB[2];
#pragma unroll
    for (int i = 0; i < 2; ++i) { int R, C; stage_rc(tid * 16 + i * 8192, R, C); const int Rb = Epi::PERM ? ((R & ~31) + perm32(R & 31)) : R;
        voffA[i] = (unsigned)(R * K + C) * 2u; voffB[i] = (unsigned)(Rb * K + C) * 2u; }
    unsigned voffX; { const int row = wid * 2 + (lane >> 5), q = (lane & 31) * 4, kb = q ^ (((row >> 1) & 7) << 4); voffX = (unsigned)(row * K * 2 + kb); }
    const int xoff0 = fr * 128 + ((fq * 16) ^ (((fr >> 1) & 7) << 4)), xoff1 = fr * 128 + ((64 + fq * 16) ^ (((fr >> 1) & 7) << 4));
    const unsigned kstep = (unsigned)(BK * 2);
    const unsigned hstep = (unsigned)HALF * K * 2;
    const unsigned tstep = 2 * hstep;
    const __amdgpu_buffer_rsrc_t rsA = __builtin_amdgcn_make_buffer_rsrc((void*)g.A, 0, 0x7ffff000, 0x00020000), rsB = __builtin_amdgcn_make_buffer_rsrc((void*)g.Bt, 0, 0x7ffff000, 0x00020000);
    const unsigned ldsw = (unsigned)wid * 1024u;
    const int aoff = lds_byte(wr * 64 + fr, fq * 8), boff = lds_byte(wc * 32 + fr, fq * 8);
#define PG8_SA(b, h) (((b) * 2 + (h)) * HTB)
#define PG8_SB(b, h) ((4 + (b) * 2 + (h)) * HTB)
#define PG8_SX(b) (STAGE_BYTES + (b) * 2048)
#define PG8_STAGEX(b, soff) do { if constexpr ((PROBE & (6 | 16)) == 0) __builtin_amdgcn_raw_ptr_buffer_load_lds(rsA, (PG8_LAS unsigned*)(lds + PG8_SX(b) + wid * 256), 4, voffX, (soff), 0, 0); } while (0)
#define PG8_LDAX(dst, b) do { if constexpr ((PROBE & (10 | 32)) == 0) { dst[0] = *(const PG8_LAS bf16x8*)(lds + PG8_SX(b) + xoff0); dst[1] = *(const PG8_LAS bf16x8*)(lds + PG8_SX(b) + xoff1); } } while (0)
#define PG8_MMAX_NULL() do { asm volatile("" :: "v"(Ax[0]), "v"(Ax[1])); } while (0)
#define PG8_MMAX_REAL() do { if (wr == 0) { _Pragma("unroll") for (int k = 0; k < 2; ++k) { accx[0] = __builtin_amdgcn_mfma_f32_16x16x32_bf16(B0[0][k], Ax[k], accx[0], 0, 0, 0); accx[1] = __builtin_amdgcn_mfma_f32_16x16x32_bf16(B1[0][k], Ax[k], accx[1], 0, 0, 0); } } \
        else { _Pragma("unroll") for (int k = 0; k < 2; ++k) { accx[0] = __builtin_amdgcn_mfma_f32_16x16x32_bf16(B0[1][k], Ax[k], accx[0], 0, 0, 0); accx[1] = __builtin_amdgcn_mfma_f32_16x16x32_bf16(B1[1][k], Ax[k], accx[1], 0, 0, 0); } } } while (0)
#define PG8_MMAX() do { if constexpr ((PROBE & (2 | 32)) != 0) { } else if constexpr ((PROBE & 1) != 0) PG8_MMAX_NULL(); else PG8_MMAX_REAL(); } while (0)
#define PG8_STAGEA(bufoff, soff) do { if constexpr ((PROBE & 4) == 0) _Pragma("unroll") for (int _i = 0; _i < 2; ++_i) \
        __builtin_amdgcn_raw_ptr_buffer_load_lds(rsA, (PG8_LAS unsigned*)(lds + (bufoff) + ldsw + _i * 8192), 16, voffA[_i], (soff), 0, 0); } while (0)
#define PG8_STAGEB(bufoff, soff) do { if constexpr ((PROBE & 4) == 0) _Pragma("unroll") for (int _i = 0; _i < 2; ++_i) \
        __builtin_amdgcn_raw_ptr_buffer_load_lds(rsB, (PG8_LAS unsigned*)(lds + (bufoff) + ldsw + _i * 8192), 16, voffB[_i], (soff), 0, 0); } while (0)
#define PG8_LDA(dst, b, h) do { if constexpr ((PROBE & 8) == 0) { _Pragma("unroll") for (int m = 0; m < 4; ++m) _Pragma("unroll") for (int k = 0; k < 2; ++k) dst[m][k] = *(const PG8_LAS bf16x8*)(lds + PG8_SA(b, h) + aoff + m * 2048 + k * 1024); } } while (0)
#define PG8_LDB(dst, b, h) do { if constexpr ((PROBE & 8) == 0) { _Pragma("unroll") for (int n = 0; n < 2; ++n) _Pragma("unroll") for (int k = 0; k < 2; ++k) dst[n][k] = *(const PG8_LAS bf16x8*)(lds + PG8_SB(b, h) + boff + n * 2048 + k * 1024); } } while (0)
#define PG8_MMA_NULL(ai, bj, At, Bt) do { _Pragma("unroll") for (int m = 0; m < 4; ++m) _Pragma("unroll") for (int k = 0; k < 2; ++k) asm volatile("" :: "v"(At[m][k])); _Pragma("unroll") for (int n = 0; n < 2; ++n) _Pragma("unroll") for (int k = 0; k < 2; ++k) asm volatile("" :: "v"(Bt[n][k])); } while (0)
#define PG8_MMA_REAL(ai, bj, At, Bt) do { __builtin_amdgcn_s_setprio(1); _Pragma("unroll") for (int m = 0; m < 4; ++m) _Pragma("unroll") for (int n = 0; n < 2; ++n) _Pragma("unroll") for (int k = 0; k < 2; ++k) \
        acc[ai][bj][m][n] = __builtin_amdgcn_mfma_f32_16x16x32_bf16(Bt[n][k], At[m][k], acc[ai][bj][m][n], 0, 0, 0); __builtin_amdgcn_s_setprio(0); } while (0)
#define PG8_MMA(ai, bj, At, Bt) do { if constexpr ((PROBE & 1) != 0) PG8_MMA_NULL(ai, bj, At, Bt); else PG8_MMA_REAL(ai, bj, At, Bt); } while (0)
#define PG8_WAIT_V(n) asm volatile("s_waitcnt vmcnt(" #n ")" ::: "memory")
#define PG8_WAIT_L(n) asm volatile("s_waitcnt lgkmcnt(" #n ")" ::: "memory")
#define PG8_BAR __builtin_amdgcn_s_barrier()
#define PG8_SCHED __builtin_amdgcn_sched_barrier(0)
    Unit cur, nxt; int ui = 0;
    if (!S.next(0, cur)) return;
    f32x4 acc[2][2][4][2];
#pragma unroll
    for (int a = 0; a < 2; ++a)
#pragma unroll
        for (int b = 0; b < 2; ++b)
#pragma unroll
            for (int m = 0; m < 4; ++m)
#pragma unroll
                for (int n = 0; n < 2; ++n) acc[a][b][m][n] = (f32x4){0.f, 0.f, 0.f, 0.f};
    bf16x8 At[4][2], B0[2][2], B1[2][2], Ax[2];
    if constexpr ((PROBE & 8) != 0) {
#pragma unroll
        for (int m = 0; m < 4; ++m)
#pragma unroll
            for (int k = 0; k < 2; ++k) asm volatile("" : "=v"(At[m][k]));
#pragma unroll
        for (int n = 0; n < 2; ++n)
#pragma unroll
            for (int k = 0; k < 2; ++k) { asm volatile("" : "=v"(B0[n][k])); asm volatile("" : "=v"(B1[n][k])); }
        asm volatile("" : "=v"(Ax[0])); asm volatile("" : "=v"(Ax[1])); }
    f32x4 accx[2] = {(f32x4){0.f, 0.f, 0.f, 0.f}, (f32x4){0.f, 0.f, 0.f, 0.f}};
    unsigned cA = (unsigned)cur.pm * tstep, cB = (unsigned)cur.pn * tstep;
    const unsigned xstep = (unsigned)XR * K * 2, xbase = (unsigned)XROW0 * K * 2; unsigned cX = xbase + (unsigned)cur.pm * xstep;
    S.a_ready(cur);
    if constexpr (SP2) {
        PG8_STAGEB(PG8_SB(0, 0), cB); PG8_STAGEB(PG8_SB(0, 1), cB + hstep); PG8_STAGEA(PG8_SA(0, 0), cA); PG8_STAGEX(0, cX); PG8_STAGEA(PG8_SA(0, 1), cA + hstep);
        if (wr == 1) PG8_BAR;
        PG8_WAIT_V(2); PG8_BAR;
        PG8_STAGEB(PG8_SB(1, 0), cB + kstep); PG8_STAGEA(PG8_SA(1, 0), cA + kstep); PG8_STAGEB(PG8_SB(1, 1), cB + hstep + kstep); PG8_STAGEX(1, cX + kstep);
        PG8_WAIT_V(7); PG8_BAR;
    } else {
        PG8_STAGEB(PG8_SB(0, 0), cB); PG8_STAGEA(PG8_SA(0, 0), cA); PG8_STAGEB(PG8_SB(0, 1), cB + hstep); PG8_STAGEA(PG8_SA(0, 1), cA + hstep);
        if (wr == 1) PG8_BAR;
        PG8_WAIT_V(4); PG8_BAR;
        PG8_STAGEB(PG8_SB(1, 0), cB + kstep); PG8_STAGEA(PG8_SA(1, 0), cA + kstep); PG8_STAGEB(PG8_SB(1, 1), cB + hstep + kstep);
        PG8_WAIT_V(6); PG8_BAR;
    }
    for (;;) {
        const bool has_next = S.next(ui + 1, nxt);
        const unsigned nA = has_next ? (unsigned)nxt.pm * tstep : cA, nB = has_next ? (unsigned)nxt.pn * tstep : cB, nX = has_next ? xbase + (unsigned)nxt.pm * xstep : cX;
        for (int t = 0; t < nt; t += 2) {
            const bool last = (t == nt - 2);
            const unsigned a1 = cA + (unsigned)(t + 1) * kstep;
            const unsigned a2 = last ? nA : cA + (unsigned)(t + 2) * kstep, b2 = last ? nB : cB + (unsigned)(t + 2) * kstep;
            const unsigned a3 = a2 + kstep, b3 = b2 + kstep, x2 = last ? nX : cX + (unsigned)(t + 2) * kstep, x3 = x2 + kstep;
            if (last && has_next) S.a_ready(nxt);
            if constexpr (SP2) {
            PG8_LDB(B0, 0, 0); PG8_LDB(B1, 0, 1); PG8_SCHED; PG8_LDA(At, 0, 0); PG8_LDAX(Ax, 0); PG8_STAGEA(PG8_SA(1, 1), a1 + hstep);
            PG8_WAIT_V(9); PG8_WAIT_L(0); PG8_BAR; PG8_MMA(0, 0, At, B0); PG8_MMA(0, 1, At, B1); PG8_MMAX(); PG8_BAR; PG8_SCHED;
            PG8_LDA(At, 0, 1); PG8_STAGEB(PG8_SB(0, 0), b2); PG8_STAGEB(PG8_SB(0, 1), b2 + hstep); PG8_STAGEA(PG8_SA(0, 0), a2); PG8_STAGEX(0, x2);
            PG8_WAIT_V(9); PG8_WAIT_L(0); PG8_BAR; PG8_MMA(1, 0, At, B0); PG8_MMA(1, 1, At, B1); PG8_BAR; PG8_SCHED;
            PG8_LDB(B0, 1, 0); PG8_LDB(B1, 1, 1); PG8_SCHED; PG8_LDA(At, 1, 0); PG8_LDAX(Ax, 1); PG8_STAGEA(PG8_SA(0, 1), a2 + hstep);
            PG8_WAIT_V(9); PG8_WAIT_L(0); PG8_BAR; PG8_MMA(0, 0, At, B0); PG8_MMA(0, 1, At, B1); PG8_MMAX(); PG8_BAR; PG8_SCHED;
            PG8_LDA(At, 1, 1); PG8_STAGEB(PG8_SB(1, 0), b3); PG8_STAGEB(PG8_SB(1, 1), b3 + hstep); PG8_STAGEA(PG8_SA(1, 0), a3); PG8_STAGEX(1, x3);
            PG8_WAIT_V(9); PG8_WAIT_L(0); PG8_BAR; PG8_MMA(1, 0, At, B0); PG8_MMA(1, 1, At, B1); PG8_BAR; PG8_SCHED;
            } else {
            PG8_LDB(B0, 0, 0); PG8_SCHED; PG8_LDA(At, 0, 0); PG8_STAGEA(PG8_SA(1, 1), a1 + hstep);
            PG8_WAIT_L(8); PG8_BAR; PG8_WAIT_L(0); PG8_MMA(0, 0, At, B0); PG8_BAR; PG8_SCHED;
            PG8_LDB(B1, 0, 1); PG8_STAGEB(PG8_SB(0, 0), b2);
            PG8_BAR; PG8_WAIT_L(0); PG8_MMA(0, 1, At, B1); PG8_BAR;
            PG8_LDA(At, 0, 1); PG8_STAGEA(PG8_SA(0, 0), a2);
            PG8_BAR; PG8_WAIT_L(0); PG8_MMA(1, 0, At, B0); PG8_BAR; PG8_SCHED;
            PG8_STAGEB(PG8_SB(0, 1), b2 + hstep);
            PG8_WAIT_V(6); PG8_BAR; PG8_MMA(1, 1, At, B1); PG8_BAR;
            PG8_LDB(B0, 1, 0); PG8_SCHED; PG8_LDA(At, 1, 0); PG8_STAGEA(PG8_SA(0, 1), a2 + hstep);
            PG8_WAIT_L(8); PG8_BAR; PG8_WAIT_L(0); PG8_MMA(0, 0, At, B0); PG8_BAR; PG8_SCHED;
            PG8_LDB(B1, 1, 1); PG8_STAGEB(PG8_SB(1, 0), b3);
            PG8_BAR; PG8_WAIT_L(0); PG8_MMA(0, 1, At, B1); PG8_BAR;
            PG8_LDA(At, 1, 1); PG8_STAGEA(PG8_SA(1, 0), a3);
            PG8_BAR; PG8_WAIT_L(0); PG8_MMA(1, 0, At, B0); PG8_BAR; PG8_SCHED;
            PG8_STAGEB(PG8_SB(1, 1), b3 + hstep);
            PG8_WAIT_V(6); PG8_BAR; PG8_MMA(1, 1, At, B1); PG8_BAR;
            }
        }
        if constexpr (ALIGN_EPI) { if (wr == 0) PG8_BAR; }
        E(acc, cur, wr, wc, fr, fq); E.rgx(accx, cur, wr, wc, fr, fq);
        if (!has_next) break;
#pragma unroll
        for (int a = 0; a < 2; ++a)
#pragma unroll
            for (int b = 0; b < 2; ++b)
#pragma unroll
                for (int m = 0; m < 4; ++m)
#pragma unroll
                    for (int n = 0; n < 2; ++n) acc[a][b][m][n] = (f32x4){0.f, 0.f, 0.f, 0.f};
        accx[0] = (f32x4){0.f, 0.f, 0.f, 0.f}; accx[1] = (f32x4){0.f, 0.f, 0.f, 0.f};
        cur = nxt; cA = nA; cB = nB; cX = nX; ++ui;
        if constexpr (ALIGN_EPI) { if (wr == 1) PG8_BAR; }
    }
    PG8_WAIT_V(0);
    if constexpr (!ALIGN_EPI) { if (wr == 0) PG8_BAR; }
    PG8_BAR;
#undef PG8_SA
#undef PG8_SB
#undef PG8_STAGEA
#undef PG8_STAGEB
#undef PG8_SX
#undef PG8_STAGEX
#undef PG8_LDAX
#undef PG8_MMAX
#undef PG8_LDA
#undef PG8_LDB
#undef PG8_MMA
#undef PG8_WAIT_V
#undef PG8_WAIT_L
#undef PG8_BAR
#undef PG8_SCHED
}
}

#define GAS __attribute__((address_space(1)))
#define LAS __attribute__((address_space(3)))
typedef unsigned short bf16;
typedef unsigned v4u __attribute__((ext_vector_type(4)));
typedef float f32x4 __attribute__((ext_vector_type(4)));
typedef short bf16x8 __attribute__((ext_vector_type(8)));
typedef GAS unsigned gu32;
typedef GAS unsigned long long gu64;
#define RLX_AGENT __ATOMIC_RELAXED, __HIP_MEMORY_SCOPE_AGENT
#define LDS_WAIT() asm volatile("s_waitcnt lgkmcnt(0)" ::: "memory")
#define VM_WAIT() asm volatile("s_waitcnt vmcnt(0)" ::: "memory")
__device__ __forceinline__ unsigned long long rt() { return __builtin_amdgcn_s_memrealtime(); }
__device__ __forceinline__ unsigned f2bf(float f) { unsigned u = __builtin_bit_cast(unsigned, f); return (u + 0x7fffu + ((u >> 16) & 1u)) >> 16; }
__device__ __forceinline__ unsigned pk2(float lo, float hi) { return f2bf(lo) | (f2bf(hi) << 16); }

#define XB_TMO      128
#define XB_XCNT(j)  (256  + 64 * (j))
#define XB_XSUB(j)  (1280 + 64 * (j))
#define XB_XGEN(j)  (2304 + 64 * (j))
#define XB_TOP      3328
#define XB_TOPGEN   3392
#define XCD_BAR_WORDS 3456
#define XB_SPIN_CAP (1u << 18)

__device__ __forceinline__ unsigned xb_ld(unsigned* p)              { return __hip_atomic_load(p, __ATOMIC_RELAXED, __HIP_MEMORY_SCOPE_AGENT); }
__device__ __forceinline__ unsigned xb_add(unsigned* p, unsigned v) { return __hip_atomic_fetch_add(p, v, __ATOMIC_RELAXED, __HIP_MEMORY_SCOPE_AGENT); }
__device__ __forceinline__ unsigned xb_xcc_id() { return (unsigned)__builtin_amdgcn_s_getreg((3 << 11) | 20) & 0xFu; }
#define XB_SPIN(cond, bar) do { unsigned _sp = 0; while (cond) { __builtin_amdgcn_s_sleep(1); \
    if ((++_sp & 255u) == 0u) { if (xb_ld(&(bar)[XB_TMO])) break; if (_sp > XB_SPIN_CAP) { atomicAdd(&(bar)[XB_TMO], 1u); break; } } } } while (0)

struct XcdBarrier {
    unsigned* bar; unsigned x; unsigned n;
    volatile LAS unsigned* st;
};

__device__ __forceinline__ XcdBarrier xcd_barrier_post(unsigned* bar, volatile LAS unsigned* st, unsigned n) {
    XcdBarrier b; b.bar = bar; b.x = xb_xcc_id(); b.st = st; b.n = n;
    if (threadIdx.x == 0) (void)xb_add(&bar[XB_XCNT(b.x)], 1u);
    return b;
}
__device__ __forceinline__ void xcd_barrier_complete(unsigned* bar, unsigned x, unsigned G, unsigned& nloc, unsigned& nx) {
    unsigned sum, cnt, mine, sp = 0u;
    for (;;) {
        sum = 0u; cnt = 0u; mine = 0u;
#pragma unroll
        for (unsigned j = 0; j < 16; ++j) { const unsigned c = xb_ld(&bar[XB_XCNT(j)]); sum += c; cnt += (c > 0u) ? 1u : 0u; mine = (j == x) ? c : mine; }
        if (sum == G) break;
        __builtin_amdgcn_s_sleep(1);
        if ((++sp & 255u) == 0u) { if (xb_ld(&bar[XB_TMO])) break; if (sp > XB_SPIN_CAP) { atomicAdd(&bar[XB_TMO], 1u); break; } }
    }
    nloc = mine > 0u ? mine : 1u; nx = cnt > 0u ? cnt : 1u;
}

__device__ __forceinline__ void xcd_barrier(const XcdBarrier& b) {
    asm volatile("s_waitcnt vmcnt(0)" ::: "memory");
    __syncthreads();
    if (threadIdx.x == 0) {
        unsigned* bar = b.bar;
        __builtin_amdgcn_s_waitcnt(0);
        unsigned nloc = b.st[0], nx = b.st[1];
        if (nloc == 0u) { xcd_barrier_complete(bar, b.x, b.n, nloc, nx); b.st[0] = nloc; b.st[1] = nx; }
        const unsigned old = xb_add(&bar[XB_XSUB(b.x)], 1u);
        const unsigned gen = old / nloc;
        if (old + 1u == (gen + 1u) * nloc) {
            __builtin_amdgcn_fence(__ATOMIC_RELEASE, "agent");
            asm volatile("s_waitcnt vmcnt(0)" ::: "memory");
            const unsigned og = xb_add(&bar[XB_TOP], 1u);
            const unsigned tg = og / nx;
            if (og + 1u == (tg + 1u) * nx) xb_add(&bar[XB_TOPGEN], 1u);
            else XB_SPIN(xb_ld(&bar[XB_TOPGEN]) == tg, bar);
            __builtin_amdgcn_fence(__ATOMIC_ACQUIRE, "agent");
            xb_add(&bar[XB_XGEN(b.x)], 1u);
            asm volatile("s_waitcnt vmcnt(0)" ::: "memory");
        } else {
            XB_SPIN(xb_ld(&bar[XB_XGEN(b.x)]) == gen, bar);
            __builtin_amdgcn_fence(__ATOMIC_ACQUIRE, "agent");
            asm volatile("s_waitcnt vmcnt(0)" ::: "memory");
        }
    }
    __syncthreads();
}


constexpr int NWAVES = 8;
#ifndef MK_ONE_LAUNCH
#define MK_ONE_LAUNCH 1
#endif
constexpr int N_PHASES = 15;

constexpr int D = 1024, FF = 4096, MP = 8 * 2048, MS = 128 * 8, M = MP + MS;
constexpr int NG = 64, PS = 64, GS = 16;
constexpr float EPS = 1e-6f;
constexpr size_t O_Y = 0, O_SRP = (size_t)M * D, O_SIP = O_SRP + 8 * 4096, O_CP = O_SIP + 8 * 4096, O_SRS = O_CP + 8 * 2 * 1024, O_SIS = O_SRS + 128 * 4096, O_CS = O_SIS + 128 * 4096, O_END = O_CS + 128 * 2 * 1024;
static_assert(O_END == 19218432, "output size");

constexpr size_t MiB = 1u << 20;
constexpr size_t WS_CTL = 0, CTL_ZERO_BYTES = 1 * MiB;
constexpr size_t WS_SSQ = 112 * MiB;
constexpr size_t WS_SSME = 114 * MiB;
constexpr size_t WS_SSMP = 2 * MiB;
constexpr size_t WS_WGU = 4 * MiB;
constexpr size_t WS_WD = 68 * MiB;
constexpr size_t WS_WGLU = 100 * MiB;
constexpr size_t WS_WIN = 104 * MiB;
constexpr size_t WS_WOUT = 110 * MiB;
constexpr size_t WS_X = 112 * MiB;
constexpr size_t WS_XB = 180 * MiB;
constexpr size_t WS_H = 214 * MiB;
constexpr size_t WS_G = 350 * MiB, WS_A2 = WS_G, WS_Z = 384 * MiB, WS_GB = 418 * MiB;
constexpr size_t WS_END = 452 * MiB;
constexpr int CW_TMO = 0;
constexpr int CW_BAR = 4096;
constexpr int CW_SK = 16384;

constexpr int RING_OFF = 0, RING_BYTES = 131072 + 4096;
constexpr int LDSCTL_OFF = RING_BYTES, MISC_OFF = LDSCTL_OFF + 320;
constexpr int LDS_BYTES = 147456;

struct Frame {
    LAS unsigned char* lds;
    volatile LAS unsigned* MISC;
    gu32* ctl;
    int tid, lane, wave, vcu, G, gi, ci;
    const float* in[21]; float* out; unsigned char* ws;
};

__device__ __forceinline__ int opaque_i(int v) { asm volatile("" : "+v"(v)); return v; }
__device__ __forceinline__ float wave_sum(float v) {
#pragma unroll
    for (int o = 1; o < 64; o <<= 1) v += __shfl_xor(v, o);
    return v;
}
__device__ __forceinline__ float bf2f(unsigned short b) { return __builtin_bit_cast(float, (unsigned)b << 16); }

struct P0Item { const float* W; bf16* WT; const float* gk; int K, N, k0, n0s, n0d; };
__device__ __forceinline__ int pair_src(int nd, int base, int hstride) { return base + ((nd >> 7) & 1) * hstride + 128 * (nd >> 8) + (nd & 127); }
__device__ __forceinline__ P0Item p0_item(Frame& F, int it) {
    constexpr int I_GU = (D / 64) * (2 * FF / 64), I_D = (FF / 64) * (D / 64), I_GLU = (D / 64) * (2 * D / 64), I_IN = (D / 64) * (3 * D / 64);
    const float* norm_g = F.in[5]; P0Item p; int r = it;
    if (r < 4 * I_GU) { const int f = r / I_GU; r -= f * I_GU; const int nb = r % (2 * FF / 64), kb = r / (2 * FF / 64), nd = 64 * nb;
        p.W = F.in[7] + (size_t)f * D * 2 * FF; p.K = D; p.N = 2 * FF; p.WT = (bf16*)(F.ws + WS_WGU) + (size_t)f * 2 * FF * D; p.gk = norm_g + ((f >> 1) * 3 + (f & 1) * 2) * D; p.k0 = 64 * kb; p.n0s = pair_src(nd, 0, FF); p.n0d = nd; return p; }
    r -= 4 * I_GU;
    if (r < 4 * I_D) { const int f = r / I_D; r -= f * I_D; const int nb = r % (D / 64), kb = r / (D / 64), nd = 64 * nb;
        p.W = F.in[8] + (size_t)f * FF * D; p.K = FF; p.N = D; p.WT = (bf16*)(F.ws + WS_WD) + (size_t)f * D * FF; p.gk = nullptr; p.k0 = 64 * kb; p.n0s = nd; p.n0d = nd; return p; }
    r -= 4 * I_D;
    if (r < I_GLU) { const int nb = r % (2 * D / 64), kb = r / (2 * D / 64), nd = 64 * nb;
        p.W = F.in[17]; p.K = D; p.N = 2 * D; p.WT = (bf16*)(F.ws + WS_WGLU); p.gk = nullptr; p.k0 = 64 * kb; p.n0s = pair_src(nd, 0, D); p.n0d = nd; return p; }
    r -= I_GLU;
    if (r < I_IN) { const int nb = r % (3 * D / 64), kb = r / (3 * D / 64), nd = 64 * nb;
        p.W = F.in[18]; p.K = D; p.N = 3 * D; p.WT = (bf16*)(F.ws + WS_WIN); p.gk = norm_g + 4 * D; p.k0 = 64 * kb; p.n0s = nd < 2048 ? pair_src(nd, D, D) : nd - 2048; p.n0d = nd; return p; }
    r -= I_IN;
    { const int nb = r % (D / 64), kb = r / (D / 64), nd = 64 * nb;
        p.W = F.in[20]; p.K = D; p.N = D; p.WT = (bf16*)(F.ws + WS_WOUT); p.gk = nullptr; p.k0 = 64 * kb; p.n0s = nd; p.n0d = nd; return p; }
}
#define P0_LOAD(v, gs, p) do { _Pragma("unroll") for (int i = 0; i < 8; ++i) _Pragma("unroll") for (int s = 0; s < 2; ++s) { \
        v[i][s] = *(const GAS f32x4*)((p).W + (size_t)((p).k0 + 8 * i + 2 * kr + s) * (p).N + (p).n0s + 4 * c); gs[i][s] = (p).gk ? (p).gk[(p).k0 + 8 * i + 2 * kr + s] : 1.0f; } } while (0)
#define P0_PROC(v, gs, p) do { \
        _Pragma("unroll") for (int i = 0; i < 8; ++i) _Pragma("unroll") for (int j = 0; j < 4; ++j) \
            *(LAS unsigned*)(scr + (4 * c + j) * 128 + (((4 * i + kr) ^ ((c & 7) << 2)) << 2)) = pg8::cvt_pk_bf16(v[i][0][j] * gs[i][0], v[i][1][j] * gs[i][1]); \
        LDS_WAIT(); asm volatile("" ::: "memory"); \
        _Pragma("unroll") for (int i = 0; i < 8; ++i) { const int n = nr + 8 * i; const v4u o = *(const LAS v4u*)(scr + n * 128 + ((q ^ ((n >> 2) & 7)) << 4)); \
            *(GAS v4u*)((p).WT + (size_t)((p).n0d + n) * (p).K + (p).k0 + 8 * q) = o; } \
        LDS_WAIT(); asm volatile("" ::: "memory"); } while (0)

__device__ __forceinline__ void p0_prologue(Frame& F) {
    LAS unsigned char* scr = F.lds + RING_OFF + F.wave * 16384;
    const int gw = F.vcu * NWAVES + F.wave, NGW = F.G * NWAVES, lane = opaque_i(F.lane);
    constexpr int NITEMS = 4 * (D / 64) * (2 * FF / 64) + 4 * (FF / 64) * (D / 64) + (D / 64) * (2 * D / 64) + (D / 64) * (3 * D / 64) + (D / 64) * (D / 64);
    { const int kr = lane >> 4, c = lane & 15, nr = lane >> 3, q = lane & 7;
      f32x4 va[8][2], vb[8][2]; float ga[8][2], gb[8][2];
      int it = gw; P0Item pa = p0_item(F, it < NITEMS ? it : 0), pb = pa;
      if (it < NITEMS) P0_LOAD(va, ga, pa);
      while (it < NITEMS) {
          const int it1 = it + NGW; if (it1 < NITEMS) { pb = p0_item(F, it1); P0_LOAD(vb, gb, pb); }
          P0_PROC(va, ga, pa);
          if (it1 >= NITEMS) break;
          const int it2 = it1 + NGW; if (it2 < NITEMS) { pa = p0_item(F, it2); P0_LOAD(va, ga, pa); }
          P0_PROC(vb, gb, pb);
          it = it2;
      }
    }
    bf16* XB = (bf16*)(F.ws + WS_XB); pg8::ssq_t* ssq = (pg8::ssq_t*)(F.ws + WS_SSQ);
    for (int m = gw; m < M; m += NGW) {
        const float* src = m < MP ? F.in[0] + (size_t)m * D : F.in[1] + (size_t)(m - MP) * D;
        const GAS f32x4* xr = (const GAS f32x4*)src + lane;
        GAS unsigned long long* o8 = (GAS unsigned long long*)(XB + (size_t)m * D) + lane;
        float s = 0.f;
#pragma unroll
        for (int j = 0; j < 4; ++j) { const f32x4 v = xr[64 * j]; s += (v.x * v.x + v.y * v.y) + (v.z * v.z + v.w * v.w);
            o8[64 * j] = (unsigned long long)pk2(v.x, v.y) | ((unsigned long long)pk2(v.z, v.w) << 32); }
        s = wave_sum(s);
        if (lane == 0) ssq[m] = pg8::ssq_fix(s);
    }
    for (int i = gw * 64 + lane; i < 7 * M; i += NGW * 64) ssq[M + i] = 0ull;
    float* sp = (float*)(F.ws + WS_SSMP);
    for (int i = gw * 64 + lane; i < NG * PS; i += NGW * 64) {
        const int g = i / PS;
        const float lr = F.in[9][i], li = F.in[10][i], dt = expf(F.in[11][g]);
        const float mag = expf(lr * dt); float sn, cs; sincosf(li * dt, &sn, &cs);
        const float lbr = mag * cs, lbi = mag * sn, den = lr * lr + li * li, nr = lbr - 1.0f, ni = lbi;
        const float fr = (nr * lr + ni * li) / den, fi = (ni * lr - nr * li) / den;
        sp[i] = lbr; sp[4096 + i] = lbi;
#pragma unroll
        for (int c = 0; c < GS; ++c) { const float br = F.in[12][(size_t)i * GS + c], bi = F.in[13][(size_t)i * GS + c];
            sp[8192 + (size_t)i * GS + c] = fr * br - fi * bi; sp[8192 + 65536 + (size_t)i * GS + c] = fr * bi + fi * br; }
    }
}

__device__ __forceinline__ float gelu_tanh(float x) {
    const float a = 0.7978845608028654f * (x + 0.044715f * x * x * x);
    return x * __builtin_amdgcn_rcpf(1.0f + __builtin_amdgcn_exp2f(-2.0f * 1.4426950408889634f * a));
}


typedef float f32x16 __attribute__((ext_vector_type(16)));
typedef unsigned u32x2v __attribute__((ext_vector_type(2)));
__device__ __forceinline__ unsigned cvtpk(float lo, float hi) { unsigned r; asm volatile("v_cvt_pk_bf16_f32 %0, %1, %2" : "=v"(r) : "v"(lo), "v"(hi)); return r; }
__device__ __forceinline__ bf16x8 pack8(const float* v) { v4u w; w.x = cvtpk(v[0], v[1]); w.y = cvtpk(v[2], v[3]); w.z = cvtpk(v[4], v[5]); w.w = cvtpk(v[6], v[7]); return __builtin_bit_cast(bf16x8, w); }
constexpr int SSM_ROWB = 272;
constexpr int SSM_NCH = 4, SSM_CHB = 16;
#define BFLO(w) __builtin_bit_cast(float, (w) << 16)
#define BFHI(w) __builtin_bit_cast(float, (w) & 0xffff0000u)

template <int MODE>
__device__ __forceinline__ void ssm_run(Frame& F, LAS unsigned char* img, int lane, int g, int row_base, int nblk, bool sample, int seq0, float& hr, float& hi) {
    const bf16* X = (const bf16*)(F.ws + WS_XB); const pg8::ssq_t* ssq = (const pg8::ssq_t*)(F.ws + WS_SSQ) + 1 * M;
    const float* sp = (const float*)(F.ws + WS_SSMP); bf16* Gb = (bf16*)(F.ws + WS_G);
    const float* g1 = F.in[5] + 1 * D; const float* dsk = F.in[16];
    const int l31 = lane & 31, h = lane >> 5, l15 = lane & 15, q4 = lane >> 4;
    bf16x8 bbq[4];
#pragma unroll
    for (int q = 0; q < 4; ++q) { const int p = 32 * (q & 1) + l31; const float* src = sp + 8192 + (q >> 1) * 65536 + ((size_t)(g * PS + p) * GS + 8 * h);
        float v[8];
#pragma unroll
        for (int j = 0; j < 8; ++j) v[j] = src[j] * g1[g * GS + 8 * h + j];
        bbq[q] = pack8(v); }
    bf16x8 cm[4]; float dg[4];
    if (MODE == 1) {
#pragma unroll
        for (int ks = 0; ks < 4; ++ks) { const int p0 = 16 * ks + 4 * q4; const float* cr = F.in[14] + ((size_t)(g * GS + l15) * PS + p0); const float* ci = F.in[15] + ((size_t)(g * GS + l15) * PS + p0);
            float v[8];
#pragma unroll
            for (int j = 0; j < 4; ++j) { v[2 * j] = cr[j]; v[2 * j + 1] = -ci[j]; }
            cm[ks] = pack8(v); }
#pragma unroll
        for (int e = 0; e < 4; ++e) dg[e] = dsk[g * GS + 4 * q4 + e] * g1[g * GS + 4 * q4 + e];
    }
    const float lbr = sp[g * PS + lane], lbi = sp[4096 + g * PS + lane];
    float s0r[4], s0i[4];
    if (sample) {
#pragma unroll
        for (int i = 0; i < 4; ++i) { s0r[i] = F.in[2][((size_t)(seq0 + i) * NG + g) * PS + lane]; s0i[i] = F.in[3][((size_t)(seq0 + i) * NG + g) * PS + lane]; } }
    else {
#pragma unroll
        for (int i = 0; i < 4; ++i) { s0r[i] = 0.f; s0i[i] = 0.f; } }
    v4u xaw; u32x2v xew0, xew1; pg8::ssq_t qa, qe0 = 0, qe1 = 0;
#define SSM_LOAD(b) do { const int rowA = row_base + 32 * (b) + l31; xaw = *(const GAS v4u*)(X + (size_t)rowA * D + g * GS + 8 * h); qa = ssq[rowA]; \
        if (MODE == 1) { const int rowE = row_base + 32 * (b) + l15; xew0 = *(const GAS u32x2v*)(X + (size_t)rowE * D + g * GS + 4 * q4); xew1 = *(const GAS u32x2v*)(X + (size_t)(rowE + 16) * D + g * GS + 4 * q4); qe0 = ssq[rowE]; qe1 = ssq[rowE + 16]; } } while (0)
    SSM_LOAD(0);
    for (int b = 0; b < nblk; ++b) {
        const f32x4 ca0 = {BFLO(xaw.x), BFHI(xaw.x), BFLO(xaw.y), BFHI(xaw.y)}, ca1 = {BFLO(xaw.z), BFHI(xaw.z), BFLO(xaw.w), BFHI(xaw.w)};
        f32x4 ce0, ce1; if (MODE == 1) { ce0 = (f32x4){BFLO(xew0.x), BFHI(xew0.x), BFLO(xew0.y), BFHI(xew0.y)}; ce1 = (f32x4){BFLO(xew1.x), BFHI(xew1.x), BFLO(xew1.y), BFHI(xew1.y)}; }
        const pg8::ssq_t cqa = qa, cqe0 = qe0, cqe1 = qe1;
        if (b + 1 < nblk) SSM_LOAD(b + 1);
        const float rsa = pg8::rstd_of(cqa);
        float ua[8];
#pragma unroll
        for (int j = 0; j < 4; ++j) { ua[j] = ca0[j] * rsa; ua[4 + j] = ca1[j] * rsa; }
        const bf16x8 ufrag = pack8(ua);
        const f32x16 zero16 = {0.f, 0.f, 0.f, 0.f, 0.f, 0.f, 0.f, 0.f, 0.f, 0.f, 0.f, 0.f, 0.f, 0.f, 0.f, 0.f};
        f32x16 Xr = __builtin_amdgcn_mfma_f32_32x32x16_bf16(ufrag, bbq[0], zero16, 0, 0, 0);
        f32x16 Yr = __builtin_amdgcn_mfma_f32_32x32x16_bf16(ufrag, bbq[1], zero16, 0, 0, 0);
        f32x16 Xi = __builtin_amdgcn_mfma_f32_32x32x16_bf16(ufrag, bbq[2], zero16, 0, 0, 0);
        f32x16 Yi = __builtin_amdgcn_mfma_f32_32x32x16_bf16(ufrag, bbq[3], zero16, 0, 0, 0);
#pragma unroll
        for (int r = 0; r < 16; ++r) {
            auto s1 = __builtin_amdgcn_permlane32_swap(__float_as_uint(Xr[r]), __float_as_uint(Yr[r]), false, false); Xr[r] = __uint_as_float(s1[0]); Yr[r] = __uint_as_float(s1[1]);
            auto s2 = __builtin_amdgcn_permlane32_swap(__float_as_uint(Xi[r]), __float_as_uint(Yi[r]), false, false); Xi[r] = __uint_as_float(s2[0]); Yi[r] = __uint_as_float(s2[1]); }
#pragma unroll
        for (int i = 0; i < 4; ++i) {
            if (sample) { hr = s0r[i]; hi = s0i[i]; }
#pragma unroll
            for (int s = 0; s < 2; ++s)
#pragma unroll
                for (int e = 0; e < 4; ++e) { const int r = 4 * i + e; const float br = s ? Yr[r] : Xr[r], bi = s ? Yi[r] : Xi[r];
                    const float nr = lbr * hr - lbi * hi + br, ni = lbr * hi + lbi * hr + bi; hr = nr; hi = ni;
                    if (MODE == 1) *(LAS unsigned*)(img + (8 * i + 4 * s + e) * SSM_ROWB + 4 * lane) = cvtpk(hr, hi); }
            if (sample) { F.out[O_SRS + ((size_t)(seq0 + i) * NG + g) * PS + lane] = hr; F.out[O_SIS + ((size_t)(seq0 + i) * NG + g) * PS + lane] = hi; }
        }
        if (MODE == 1) {
            f32x4 acc0 = {0.f, 0.f, 0.f, 0.f}, acc1 = {0.f, 0.f, 0.f, 0.f};
#pragma unroll
            for (int ks = 0; ks < 4; ++ks) {
                const bf16x8 b0 = *(const LAS bf16x8*)(img + l15 * SSM_ROWB + 64 * ks + 16 * q4);
                const bf16x8 b1 = *(const LAS bf16x8*)(img + (16 + l15) * SSM_ROWB + 64 * ks + 16 * q4);
                acc0 = __builtin_amdgcn_mfma_f32_16x16x32_bf16(cm[ks], b0, acc0, 0, 0, 0);
                acc1 = __builtin_amdgcn_mfma_f32_16x16x32_bf16(cm[ks], b1, acc1, 0, 0, 0); }
            const float rse0 = pg8::rstd_of(cqe0), rse1 = pg8::rstd_of(cqe1);
            float o0[4], o1[4];
#pragma unroll
            for (int e = 0; e < 4; ++e) { o0[e] = gelu_tanh(acc0[e] + dg[e] * ce0[e] * rse0); o1[e] = gelu_tanh(acc1[e] + dg[e] * ce1[e] * rse1); }
            const int rowE = row_base + 32 * b + l15;
            u32x2v w0, w1; w0.x = cvtpk(o0[0], o0[1]); w0.y = cvtpk(o0[2], o0[3]); w1.x = cvtpk(o1[0], o1[1]); w1.y = cvtpk(o1[2], o1[3]);
            *(u32x2v*)(Gb + (size_t)rowE * D + g * GS + 4 * q4) = w0;
            *(u32x2v*)(Gb + (size_t)(rowE + 16) * D + g * GS + 4 * q4) = w1;
        }
    }
#undef SSM_LOAD
}

__device__ __forceinline__ void ssm_phase_pass(Frame& F, int pass) {
    LAS unsigned char* img = F.lds + RING_OFF + F.wave * 16384;
    const int lane = opaque_i(F.lane), s = F.wave * 32 + F.ci, g = s & 63, c = s >> 6;
    float* E = (float*)(F.ws + WS_SSME) + ((size_t)(F.gi * NG + g) * SSM_NCH) * 2 * PS;
    const int row_base = F.gi * 2048 + c * (SSM_CHB * 32);
    if (pass == 0) {
        float hr = 0.f, hi = 0.f;
        ssm_run<0>(F, img, lane, g, row_base, SSM_CHB, false, 0, hr, hi);
        E[(c * 2 + 0) * PS + lane] = hr; E[(c * 2 + 1) * PS + lane] = hi;
        float sr = 0.f, si = 0.f;
        ssm_run<1>(F, img, lane, g, MP + 128 * F.gi + 32 * c, 1, true, 16 * F.gi + 4 * c, sr, si);
    } else {
        const float* sp = (const float*)(F.ws + WS_SSMP);
        float ar = sp[g * PS + lane], ai = sp[4096 + g * PS + lane];
#pragma unroll
        for (int k = 0; k < 9; ++k) { const float nr = ar * ar - ai * ai, ni = 2.0f * ar * ai; ar = nr; ai = ni; }
        float hr = 0.f, hi = 0.f;
        for (int j = 0; j < c; ++j) { const float er = E[(j * 2 + 0) * PS + lane], ei = E[(j * 2 + 1) * PS + lane];
            const float nr = ar * hr - ai * hi + er, ni = ar * hi + ai * hr + ei; hr = nr; hi = ni; }
        ssm_run<1>(F, img, lane, g, row_base, SSM_CHB, false, 0, hr, hi);
        if (c == SSM_NCH - 1) { F.out[O_SRP + ((size_t)F.gi * NG + g) * PS + lane] = hr; F.out[O_SIP + ((size_t)F.gi * NG + g) * PS + lane] = hi; }
    }
}
#undef BFLO
#undef BFHI

__device__ __forceinline__ void conv_phase(Frame& F) {
    const bf16* Z = (const bf16*)(F.ws + WS_Z); const bf16* GBp = (const bf16*)(F.ws + WS_GB); bf16* A2 = (bf16*)(F.ws + WS_A2);
    const float* cw = F.in[19]; const float* cache = F.in[4];
    const int gt = (F.ci * NWAVES + F.wave) * 64 + opaque_i(F.lane), NGT = 32 * NWAVES * 64;
    for (int it = gt; it < (2048 + 128) * (D / 8); it += NGT) {
        const int lr = it >> 7, row = lr < 2048 ? F.gi * 2048 + lr : MP + F.gi * 128 + (lr - 2048), c0 = (it & 127) * 8;
        int t; const float* cb = nullptr;
        if (row < MP) t = row & 2047; else { const int r2 = row - MP; t = r2 & 7; cb = cache + (size_t)(r2 >> 3) * 2 * D; }
        float z0[8], z1[8], z2[8], gb[8];
        { const v4u v = *(const GAS v4u*)(Z + (size_t)row * D + c0); const v4u q = *(const GAS v4u*)(GBp + (size_t)row * D + c0);
#pragma unroll
          for (int e = 0; e < 4; ++e) { z2[2 * e] = __builtin_bit_cast(float, v[e] << 16); z2[2 * e + 1] = __builtin_bit_cast(float, v[e] & 0xffff0000u);
                                        gb[2 * e] = __builtin_bit_cast(float, q[e] << 16); gb[2 * e + 1] = __builtin_bit_cast(float, q[e] & 0xffff0000u); } }
        if (t >= 1) { const v4u v = *(const GAS v4u*)(Z + (size_t)(row - 1) * D + c0);
#pragma unroll
          for (int e = 0; e < 4; ++e) { z1[2 * e] = __builtin_bit_cast(float, v[e] << 16); z1[2 * e + 1] = __builtin_bit_cast(float, v[e] & 0xffff0000u); } }
        else {
#pragma unroll
          for (int e = 0; e < 8; ++e) z1[e] = cb ? cb[D + c0 + e] : 0.f; }
        if (t >= 2) { const v4u v = *(const GAS v4u*)(Z + (size_t)(row - 2) * D + c0);
#pragma unroll
          for (int e = 0; e < 4; ++e) { z0[2 * e] = __builtin_bit_cast(float, v[e] << 16); z0[2 * e + 1] = __builtin_bit_cast(float, v[e] & 0xffff0000u); } }
        else {
#pragma unroll
          for (int e = 0; e < 8; ++e) z0[e] = cb ? cb[t * D + c0 + e] : 0.f; }
        float o[8];
#pragma unroll
        for (int e = 0; e < 8; ++e) o[e] = gb[e] * (cw[c0 + e] * z0[e] + cw[D + c0 + e] * z1[e] + cw[2 * D + c0 + e] * z2[e]);
        v4u w; w.x = pk2(o[0], o[1]); w.y = pk2(o[2], o[3]); w.z = pk2(o[4], o[5]); w.w = pk2(o[6], o[7]);
        *(GAS v4u*)(A2 + (size_t)row * D + c0) = w;
    }
}

__device__ __forceinline__ void final_phase(Frame& F) {
    const bf16* XBp = (const bf16*)(F.ws + WS_XB); const pg8::ssq_t* ssq = (const pg8::ssq_t*)(F.ws + WS_SSQ) + 6 * M; const float* fg = F.in[6];
    const int gw = F.ci * NWAVES + F.wave, NGW = 32 * NWAVES, lane = opaque_i(F.lane);
    f32x4 gv[4];
#pragma unroll
    for (int j = 0; j < 4; ++j) gv[j] = ((const GAS f32x4*)fg)[lane + 64 * j];
    for (int lr = gw; lr < 2048 + 128; lr += NGW) { const int m = lr < 2048 ? F.gi * 2048 + lr : MP + F.gi * 128 + (lr - 2048);
        const float rs = pg8::rstd_of(ssq[m]);
        const GAS unsigned long long* xr = (const GAS unsigned long long*)(XBp + (size_t)m * D) + lane; GAS f32x4* yo = (GAS f32x4*)(F.out + O_Y + (size_t)m * D) + lane;
#pragma unroll
        for (int j = 0; j < 4; ++j) { const unsigned long long w = xr[64 * j]; const unsigned lo = (unsigned)w, hi = (unsigned)(w >> 32);
            const f32x4 xv = {__builtin_bit_cast(float, lo << 16), __builtin_bit_cast(float, lo & 0xffff0000u), __builtin_bit_cast(float, hi << 16), __builtin_bit_cast(float, hi & 0xffff0000u)};
            yo[64 * j] = xv * rs * gv[j]; }
    }
}

struct SameOrder : pg8::StaticOrder { __device__ bool next(int i, pg8::Unit& u) const { const bool r = pg8::StaticOrder::next(i, u); u.pm = 0; u.pn = 0; return r; } };
struct Args { const float* in[21]; float* out; unsigned char* ws; int ph_lo, ph_hi; };
__global__ void __launch_bounds__(NWAVES * 64, 2) skel_fwd(Args args) {
    extern __shared__ __attribute__((aligned(16))) unsigned char lds[];
    Frame F;
    F.lds = (LAS unsigned char*)lds;
    F.MISC = (volatile LAS unsigned*)(F.lds + MISC_OFF);
    F.tid = threadIdx.x; F.lane = F.tid & 63; F.wave = __builtin_amdgcn_readfirstlane(F.tid >> 6);
    F.G = gridDim.x; { const int bx = blockIdx.x; F.vcu = (bx % 8) * (F.G / 8) + bx / 8; F.gi = bx % 8; F.ci = bx / 8; }
    F.ws = args.ws; F.out = args.out; F.ctl = (gu32*)(args.ws + WS_CTL);
#pragma unroll
    for (int i = 0; i < 21; ++i) F.in[i] = args.in[i];
    for (int u = F.tid; u < (LDS_BYTES - LDSCTL_OFF) / 4; u += NWAVES * 64) ((LAS unsigned*)(F.lds + LDSCTL_OFF))[u] = 0u;
    __syncthreads();
    XcdBarrier bar = xcd_barrier_post((unsigned*)(F.ctl + CW_BAR), F.MISC + 8, (unsigned)F.G);
    XcdBarrier gbar = xcd_barrier_post((unsigned*)(F.ctl + CW_BAR) + (1 + F.gi) * XCD_BAR_WORDS, F.MISC + 10, (unsigned)(F.G / 8));
    const int lo = args.ph_lo, hi = args.ph_hi;
#define IN(k) (lo <= (k) && (k) < hi)
#if defined(PROBE_A_LO)
#define STAMP(k) do { if (blockIdx.x == 0 && F.tid == 0) { const unsigned long long t_ = __builtin_amdgcn_s_memrealtime(); F.MISC[16 + 2 * (k)] = (unsigned)t_; F.MISC[17 + 2 * (k)] = (unsigned)(t_ >> 32); } } while (0)
#else
#define STAMP(k) do { } while (0)
#endif
    STAMP(0);
#define SEAM(k) do { if (IN((k) + 1)) { if ((k) == 0) xcd_barrier(bar); else xcd_barrier(gbar); } STAMP((k) + 1); } while (0)
    bf16* XB = (bf16*)(F.ws + WS_XB); bf16* H = (bf16*)(F.ws + WS_H); pg8::ssq_t* ssq = (pg8::ssq_t*)(F.ws + WS_SSQ);
    const int bx = (int)blockIdx.x;

    if (IN(0)) { p0_prologue(F); SEAM(0); }
#define FFN_GU(ph, f, sin) if (IN(ph)) { pg8::Gemm g{XB, (const bf16*)(F.ws + WS_WGU) + (size_t)(f) * 2 * FF * D, M, 2 * FF, D}; pg8::StaticOrder S; S.init(MP, 2 * FF, F.G, bx); \
        pg8::EpiGateUp E{H, FF, ssq + (size_t)(sin) * M}; pg8::gemm_phase<pg8::EpiGateUp, pg8::StaticOrder, true, true>(F.lds + RING_OFF, g, S, E); SEAM(ph); }
#define FFN_DN(ph, f, sout) if (IN(ph)) { pg8::Gemm g{H, (const bf16*)(F.ws + WS_WD) + (size_t)(f) * D * FF, M, D, FF}; pg8::StaticOrder S; S.init(MP, D, F.G, bx); \
        pg8::EpiResid<0> E{(ph) == 2 ? F.in[0] : nullptr, (ph) == 2 ? F.in[1] : nullptr, XB, ssq + (size_t)(sout) * M, 0.5f}; pg8::gemm_phase<pg8::EpiResid<0>, pg8::StaticOrder, true, true>(F.lds + RING_OFF, g, S, E); SEAM(ph); }
    FFN_GU(1, 0, 0)
    FFN_DN(2, 0, 1)
    if (IN(3)) { ssm_phase_pass(F, 0); xcd_barrier(gbar); ssm_phase_pass(F, 1); SEAM(3); }
    if (IN(4)) { pg8::Gemm g{(const bf16*)(F.ws + WS_G), (const bf16*)(F.ws + WS_WGLU), M, 2 * D, D}; pg8::StaticOrder S; S.init(MP, 2 * D, F.G, bx);
        pg8::EpiResid<1> E{nullptr, nullptr, XB, ssq + (size_t)2 * M, 1.0f}; pg8::gemm_phase<pg8::EpiResid<1>, pg8::StaticOrder, true, true>(F.lds + RING_OFF, g, S, E); SEAM(4); }
    FFN_GU(5, 1, 2)
    FFN_DN(6, 1, 3)
    FFN_GU(7, 2, 3)
    FFN_DN(8, 2, 4)
    if (IN(9)) { pg8::Gemm g{XB, (const bf16*)(F.ws + WS_WIN), M, 3 * D, D}; pg8::StaticOrder S; S.init(MP, 3 * D, F.G, bx);
        pg8::EpiConvIn E{(bf16*)(F.ws + WS_Z), (bf16*)(F.ws + WS_GB), ssq + (size_t)4 * M, F.out + O_CP, F.out + O_CS};
        pg8::gemm_phase<pg8::EpiConvIn, pg8::StaticOrder, true, true>(F.lds + RING_OFF, g, S, E); SEAM(9); }
    if (IN(10)) { conv_phase(F); SEAM(10); }
    if (IN(11)) { pg8::Gemm g{(const bf16*)(F.ws + WS_A2), (const bf16*)(F.ws + WS_WOUT), M, D, D}; pg8::StaticOrder S; S.init(MP, D, F.G, bx);
        pg8::EpiResid<0> E{nullptr, nullptr, XB, ssq + (size_t)5 * M, 1.0f}; pg8::gemm_phase<pg8::EpiResid<0>, pg8::StaticOrder, true, true>(F.lds + RING_OFF, g, S, E); SEAM(11); }
    FFN_GU(12, 3, 5)
    FFN_DN(13, 3, 6)
    if (IN(14)) { final_phase(F); }
#if defined(PROBE_DRY)
#ifndef PROBE_VARIANT
#define PROBE_VARIANT 0
#endif
    xcd_barrier(gbar); STAMP(15); if (blockIdx.x == 0 && F.tid == 0) { const unsigned long long c_ = __builtin_amdgcn_s_memtime(); F.MISC[60] = (unsigned)c_; F.MISC[61] = (unsigned)(c_ >> 32); }
#if PROBE_DRY == 2
    { pg8::Gemm g{XB, (const bf16*)(F.ws + WS_WGU), M, 2 * FF, D}; SameOrder S; S.init(MP, 2 * FF, F.G, bx);
      pg8::EpiNull E{H + (size_t)M * FF - 1}; pg8::gemm_phase<pg8::EpiNull, SameOrder, true, true>(F.lds + RING_OFF, g, S, E); }
#else
    { pg8::Gemm g{XB, (const bf16*)(F.ws + WS_WGU), M, 2 * FF, D}; pg8::StaticOrder S; S.init(MP, 2 * FF, F.G, bx);
      pg8::EpiNull E{H + (size_t)M * FF - 1}; pg8::gemm_phase<pg8::EpiNull, pg8::StaticOrder, true, true, PROBE_VARIANT>(F.lds + RING_OFF, g, S, E); }
#endif
    xcd_barrier(gbar); STAMP(16); if (blockIdx.x == 0 && F.tid == 0) { const unsigned long long c_ = __builtin_amdgcn_s_memtime(); F.MISC[62] = (unsigned)c_; F.MISC[63] = (unsigned)(c_ >> 32); }
#endif
#if defined(PROBE_A_LO)
    __syncthreads();
    if (blockIdx.x == 0 && F.tid == 0) {
#if !defined(PROBE_DRY)
        STAMP(15);
#endif
#define TS(k) ((unsigned long long)F.MISC[16 + 2 * (k)] | ((unsigned long long)F.MISC[17 + 2 * (k)] << 32))
        const unsigned long long ta = TS(PROBE_A_HI) - TS(PROBE_A_LO), tb = TS(PROBE_B_HI) - TS(PROBE_B_LO);
#if defined(PROBE_CLOCK)
        { const unsigned long long c0 = (unsigned long long)F.MISC[60] | ((unsigned long long)F.MISC[61] << 32), c1 = (unsigned long long)F.MISC[62] | ((unsigned long long)F.MISC[63] << 32);
          F.out[0] += (float)(c1 - c0) / (float)(TS(16) - TS(15)) * 1e-2f; }
#else
        F.out[0] += (float)tb * 1e-5f;
#endif
        const unsigned long long t0 = __builtin_amdgcn_s_memrealtime();
        const unsigned long long spin = ta * 4ull < 1000000ull ? ta * 4ull : 1000000ull;
        while (__builtin_amdgcn_s_memrealtime() - t0 < spin) __builtin_amdgcn_s_sleep(8);
    }
#endif
#undef IN
#undef SEAM
}

extern "C" void kernel_launch(void* const* d_in, const int* in_sizes, int n_in, void* d_out, int out_size, void* d_ws, size_t ws_size, hipStream_t stream) {
    static int grid = 0;
    if (grid == 0) {
        if (n_in != 21 || out_size != (int)O_END || ws_size < WS_END) { fprintf(stderr, "kernel_launch: unexpected shapes: n_in %d out %d ws %zu; nothing launched\n", n_in, out_size, ws_size); grid = -1; return; }
        int dev = 0, cus = 0, per_cu = 0;
        if (hipGetDevice(&dev) != hipSuccess || hipDeviceGetAttribute(&cus, hipDeviceAttributeMultiprocessorCount, dev) != hipSuccess) { grid = -1; return; }
        if (hipFuncSetAttribute((const void*)skel_fwd, hipFuncAttributeMaxDynamicSharedMemorySize, LDS_BYTES) != hipSuccess) { fprintf(stderr, "kernel_launch: hipFuncSetAttribute failed\n"); grid = -1; return; }
        if (hipOccupancyMaxActiveBlocksPerMultiprocessor(&per_cu, (const void*)skel_fwd, NWAVES * 64, LDS_BYTES) != hipSuccess || per_cu < 1) fprintf(stderr, "kernel_launch: occupancy query reports %d\n", per_cu);
        (void)hipGetLastError();
        if (cus < 256) { fprintf(stderr, "kernel_launch: built for a 256-CU device (8 groups x 32 workgroups), found %d CUs; nothing launched\n", cus); grid = -1; return; }
        grid = 256;
    }
    if (grid < 0) return;
    if (hipMemsetAsync((char*)d_ws + WS_CTL, 0, CTL_ZERO_BYTES, stream) != hipSuccess) return;
    Args a{};
    for (int i = 0; i < 21; ++i) a.in[i] = (const float*)d_in[i];
    a.out = (float*)d_out; a.ws = (unsigned char*)d_ws;
    a.ph_lo = 0; a.ph_hi = N_PHASES;
    hipLaunchKernelGGL(skel_fwd, dim3(grid), dim3(NWAVES * 64), LDS_BYTES, stream, a);
}
```

```cpp
#include <hip/hip_runtime.h>
#include <cstdio>
#include <cstdint>
namespace pg8 {
#define PG8_LAS __attribute__((address_space(3)))
typedef unsigned short bf16_t;
typedef short bf16x8 __attribute__((ext_vector_type(8)));
typedef float f32x4 __attribute__((ext_vector_type(4)));
typedef unsigned u32x4 __attribute__((ext_vector_type(4)));
constexpr int BM = 256, BK = 64, HALF = 128, HTB = HALF * BK * 2  , STAGE_BYTES = 8 * HTB, NXCD = 8, WGM = 8;

__host__ __device__ __forceinline__ int lds_byte(int r, int c) { const int st = (r >> 4) * 2 + (c >> 5), rr = r & 15, cc = c & 31, ob = rr * 64 + cc * 2; return st * 1024 + (ob ^ (((ob >> 9) & 1) << 5)); }
__host__ __device__ __forceinline__ void stage_rc(int b, int& R, int& C) { const int st = b / 1024, sb = b % 1024, swz = sb ^ (((sb >> 9) & 1) << 5); R = (st >> 1) * 16 + swz / 64; C = (st & 1) * 32 + (swz % 64) / 2; }
__host__ __device__ __forceinline__ int perm32(int rho) { const int n = rho >> 4, i = rho & 15; return 8 * (i >> 2) + 4 * n + (i & 3); }

struct Unit { int pm, pn; };
struct Gemm { const bf16_t* A; const bf16_t* Bt; int M, N, K; };

struct StaticOrder {
    int nM, nN, nwg, G, c;
    __host__ __device__ void init(int M, int N, int G_, int c_) { nM = M / BM; nN = N / BM; nwg = nM * nN; G = G_; c = c_; }
    __host__ __device__ bool next(int i, Unit& u) const {
        const long L = (long)i * G + c; if (L >= nwg) return false;
        int wgid = (int)L; { const int q = nwg / NXCD, r = nwg % NXCD, xcd = wgid % NXCD, off = wgid / NXCD; wgid = (xcd < r ? xcd * (q + 1) : r * (q + 1) + (xcd - r) * q) + off; }
        const int nig = WGM * nN, gid = wgid / nig, fm = gid * WGM, gsz = (nM - fm) < WGM ? (nM - fm) : WGM;
        u.pm = fm + ((wgid % nig) % gsz); u.pn = (wgid % nig) / gsz; return true;
    }
    __device__ __forceinline__ void a_ready(const Unit&) const {}
    __device__ __forceinline__ void done(const Unit&) const {}
};


__device__ __forceinline__ unsigned cvt_pk_bf16(float lo, float hi) { unsigned r; asm volatile("v_cvt_pk_bf16_f32 %0, %1, %2" : "=v"(r) : "v"(lo), "v"(hi)); return r; }

typedef unsigned u32x2 __attribute__((ext_vector_type(2)));
constexpr float RMS_EPS = 1e-6f;
constexpr float INV_D = 1.0f / 1024.0f;
__device__ __forceinline__ float sigmoid_f(float x) { return __builtin_amdgcn_rcpf(1.0f + __builtin_amdgcn_exp2f(-1.4426950408889634f * x)); }
typedef unsigned long long ssq_t;
constexpr float SSQ_SCALE = 16777216.0f, SSQ_INV = 1.0f / 16777216.0f;
__device__ __forceinline__ ssq_t ssq_fix(float s) { return (ssq_t)(s * SSQ_SCALE + 0.5f); }
__device__ __forceinline__ float rstd_of(ssq_t q) { return __builtin_amdgcn_rsqf((float)q * (SSQ_INV * INV_D) + RMS_EPS); }
#define PG8_EPI_CALL() \
    __device__ __forceinline__ void operator()(const f32x4 (&acc)[2][2][4][2], const Unit& u, int wr, int wc, int fr, int fq) const { \
        _Pragma("unroll") for (int ai = 0; ai < 2; ++ai) _Pragma("unroll") for (int m = 0; m < 4; ++m) { \
            const f32x4 a[2][2] = {{acc[ai][0][m][0], acc[ai][0][m][1]}, {acc[ai][1][m][0], acc[ai][1][m][1]}}; rg(a, u, ai, m, 3, wr, wc, fr, fq); } }

struct EpiGateUp {
    static constexpr bool PERM = true, AFTER_DRAIN = false;
    bf16_t* H; int ldh; const ssq_t* ssq;
    __device__ __forceinline__ void rg(const f32x4 (&a)[2][2], const Unit& u, int ai, int m, int bjmask, int wr, int wc, int fr, int fq) const {
        const int row = u.pm * BM + ai * HALF + wr * 64 + m * 16 + fr, col0 = u.pn * HALF + wc * 32 + 8 * fq;
        const float rs = rstd_of(ssq[row]);
        float h[8];
#pragma unroll
        for (int n = 0; n < 2; ++n)
#pragma unroll
            for (int e = 0; e < 4; ++e) { const float g = a[0][n][e] * rs, up = a[1][n][e] * rs; h[4 * n + e] = g * sigmoid_f(g) * up; }
        u32x4 w; w.x = cvt_pk_bf16(h[0], h[1]); w.y = cvt_pk_bf16(h[2], h[3]); w.z = cvt_pk_bf16(h[4], h[5]); w.w = cvt_pk_bf16(h[6], h[7]);
        *(u32x4*)(H + (size_t)row * ldh + col0) = w;
    }
    __device__ __forceinline__ void rgx(const f32x4 (&ax)[2], const Unit& u, int wr, int wc, int fr, int fq) const {
        const int row = 16384 + 16 * u.pm + fr, col0 = u.pn * HALF + wc * 32 + 8 * fq + 4 * wr;
        const float rs = rstd_of(ssq[row]);
        float h[4];
#pragma unroll
        for (int e = 0; e < 4; ++e) { const float g = ax[0][e] * rs, up = ax[1][e] * rs; h[e] = g * sigmoid_f(g) * up; }
        u32x2 w; w.x = cvt_pk_bf16(h[0], h[1]); w.y = cvt_pk_bf16(h[2], h[3]);
        *(u32x2*)(H + (size_t)row * ldh + col0) = w;
    }
    PG8_EPI_CALL()
};

__device__ __forceinline__ void unpack8(const u32x4 w, float (&x)[8]) {
#pragma unroll
    for (int e = 0; e < 4; ++e) { x[2 * e] = __builtin_bit_cast(float, w[e] << 16); x[2 * e + 1] = __builtin_bit_cast(float, w[e] & 0xffff0000u); } }
template <int MODE> struct EpiResid {
    static constexpr bool PERM = true, AFTER_DRAIN = false;
    const float* xin_p; const float* xin_s; bf16_t* XB; ssq_t* ssq; float scale;
    __device__ __forceinline__ void rg(const f32x4 (&a)[2][2], const Unit& u, int ai, int m, int bjmask, int wr, int wc, int fr, int fq) const {
        const int row = u.pm * BM + ai * HALF + wr * 64 + m * 16 + fr;
        const int col0 = (MODE == 0 ? u.pn * BM : u.pn * HALF) + wc * 32 + 8 * fq;
        float sq = 0.f;
#pragma unroll
        for (int bj = 0; bj < (MODE == 0 ? 2 : 1); ++bj) {
            bf16_t* xp = XB + (size_t)row * 1024 + col0 + bj * HALF;
            float x[8];
            if (xin_p) { const float* xi = xin_p + (size_t)row * 1024 + col0 + bj * HALF; const f32x4 x0 = *(const f32x4*)xi, x1 = *(const f32x4*)(xi + 4);
#pragma unroll
                for (int e = 0; e < 4; ++e) { x[e] = x0[e]; x[4 + e] = x1[e]; } }
            else unpack8(*(const u32x4*)xp, x);
#pragma unroll
            for (int e = 0; e < 4; ++e) {
                if (MODE == 0) { x[e] += a[bj][0][e] * scale; x[4 + e] += a[bj][1][e] * scale; }
                else { x[e] += a[0][0][e] * sigmoid_f(a[1][0][e]); x[4 + e] += a[0][1][e] * sigmoid_f(a[1][1][e]); } }
            u32x4 w; w.x = cvt_pk_bf16(x[0], x[1]); w.y = cvt_pk_bf16(x[2], x[3]); w.z = cvt_pk_bf16(x[4], x[5]); w.w = cvt_pk_bf16(x[6], x[7]);
            *(u32x4*)xp = w;
            sq += (x[0] * x[0] + x[1] * x[1]) + (x[2] * x[2] + x[3] * x[3]) + (x[4] * x[4] + x[5] * x[5]) + (x[6] * x[6] + x[7] * x[7]); }
        sq += __shfl_xor(sq, 16); sq += __shfl_xor(sq, 32);
        if (fq == 0) atomicAdd(ssq + row, ssq_fix(sq));
    }
    __device__ __forceinline__ void rgx(const f32x4 (&ax)[2], const Unit& u, int wr, int wc, int fr, int fq) const {
        const int r2 = 16 * u.pm + fr, row = 16384 + r2;
        const int col0 = (MODE == 0 ? u.pn * BM : u.pn * HALF) + wc * 32 + 8 * fq + 4 * wr;
        float sq = 0.f;
#pragma unroll
        for (int bj = 0; bj < (MODE == 0 ? 2 : 1); ++bj) {
            bf16_t* xp = XB + (size_t)row * 1024 + col0 + bj * HALF;
            f32x4 x0;
            if (xin_s) x0 = *(const f32x4*)(xin_s + (size_t)r2 * 1024 + col0 + bj * HALF);
            else { const u32x2 w = *(const u32x2*)xp; x0[0] = __builtin_bit_cast(float, w.x << 16); x0[1] = __builtin_bit_cast(float, w.x & 0xffff0000u); x0[2] = __builtin_bit_cast(float, w.y << 16); x0[3] = __builtin_bit_cast(float, w.y & 0xffff0000u); }
            if (MODE == 0) x0 += ax[bj] * scale;
            else {
#pragma unroll
                for (int e = 0; e < 4; ++e) x0[e] += ax[0][e] * sigmoid_f(ax[1][e]); }
            u32x2 w; w.x = cvt_pk_bf16(x0[0], x0[1]); w.y = cvt_pk_bf16(x0[2], x0[3]);
            *(u32x2*)xp = w;
            sq += (x0[0] * x0[0] + x0[1] * x0[1]) + (x0[2] * x0[2] + x0[3] * x0[3]); }
        sq += __shfl_xor(sq, 16); sq += __shfl_xor(sq, 32);
        if (fq == 0) atomicAdd(ssq + row, ssq_fix(sq));
    }
    PG8_EPI_CALL()
};

struct EpiConvIn {
    static constexpr bool PERM = true, AFTER_DRAIN = false;
    bf16_t* Z; bf16_t* GB; const ssq_t* ssq; float* conv_p; float* conv_s;
    __device__ __forceinline__ void rg(const f32x4 (&a)[2][2], const Unit& u, int ai, int m, int bjmask, int wr, int wc, int fr, int fq) const {
        const int row = u.pm * BM + ai * HALF + wr * 64 + m * 16 + fr;
        const float rs = rstd_of(ssq[row]);
        if (u.pn < 8) {
            const int col0 = u.pn * HALF + wc * 32 + 8 * fq; const float rs2 = rs * rs;
            const f32x4 z0 = a[0][0] * a[1][0] * rs2, z1 = a[0][1] * a[1][1] * rs2;
            u32x4 w; w.x = cvt_pk_bf16(z0[0], z0[1]); w.y = cvt_pk_bf16(z0[2], z0[3]); w.z = cvt_pk_bf16(z1[0], z1[1]); w.w = cvt_pk_bf16(z1[2], z1[3]);
            *(u32x4*)(Z + (size_t)row * 1024 + col0) = w;
            float* cp = nullptr;
            if (row < 16384) { const int t = row & 2047; if (t >= 2046) cp = conv_p + ((size_t)(row >> 11) * 2 + (t - 2046)) * 1024 + col0; }
            else { const int r2 = row - 16384, t = r2 & 7; if (t >= 6) cp = conv_s + ((size_t)(r2 >> 3) * 2 + (t - 6)) * 1024 + col0; }
            if (cp) { *(f32x4*)cp = z0; *(f32x4*)(cp + 4) = z1; }
        } else {
            const int col0 = (u.pn - 8) * BM + wc * 32 + 8 * fq;
#pragma unroll
            for (int bj = 0; bj < 2; ++bj) { const f32x4 g0 = a[bj][0] * rs, g1 = a[bj][1] * rs;
                u32x4 w; w.x = cvt_pk_bf16(g0[0], g0[1]); w.y = cvt_pk_bf16(g0[2], g0[3]); w.z = cvt_pk_bf16(g1[0], g1[1]); w.w = cvt_pk_bf16(g1[2], g1[3]);
                *(u32x4*)(GB + (size_t)row * 1024 + col0 + bj * HALF) = w; }
        }
    }
    __device__ __forceinline__ void rgx(const f32x4 (&ax)[2], const Unit& u, int wr, int wc, int fr, int fq) const {
        const int r2 = 16 * u.pm + fr, row = 16384 + r2;
        const float rs = rstd_of(ssq[row]);
        if (u.pn < 8) {
            const int col0 = u.pn * HALF + wc * 32 + 8 * fq + 4 * wr;
            const f32x4 z0 = ax[0] * ax[1] * (rs * rs);
            u32x2 w; w.x = cvt_pk_bf16(z0[0], z0[1]); w.y = cvt_pk_bf16(z0[2], z0[3]);
            *(u32x2*)(Z + (size_t)row * 1024 + col0) = w;
            const int t = r2 & 7;
            if (t >= 6) *(f32x4*)(conv_s + ((size_t)(r2 >> 3) * 2 + (t - 6)) * 1024 + col0) = z0;
        } else {
            const int col0 = (u.pn - 8) * BM + wc * 32 + 8 * fq + 4 * wr;
#pragma unroll
            for (int bj = 0; bj < 2; ++bj) { const f32x4 g0 = ax[bj] * rs;
                u32x2 w; w.x = cvt_pk_bf16(g0[0], g0[1]); w.y = cvt_pk_bf16(g0[2], g0[3]);
                *(u32x2*)(GB + (size_t)row * 1024 + col0 + bj * HALF) = w; }
        }
    }
    PG8_EPI_CALL()
};

struct EpiNull {
    static constexpr bool PERM = true, AFTER_DRAIN = false;
    bf16_t* sink;
    __device__ __forceinline__ void rg(const f32x4 (&a)[2][2], const Unit& u, int ai, int m, int bjmask, int wr, int wc, int fr, int fq) const {
        asm volatile("" :: "v"(a[0][0]), "v"(a[0][1]), "v"(a[1][0]), "v"(a[1][1]));
    }
    __device__ __forceinline__ void rgx(const f32x4 (&ax)[2], const Unit& u, int wr, int wc, int fr, int fq) const { asm volatile("" :: "v"(ax[0]), "v"(ax[1])); }
    PG8_EPI_CALL()
};

template <class Epi, class Sched, bool ALIGN_EPI = false, bool SP2 = false, int PROBE = 0>
__device__ __forceinline__ void gemm_phase(PG8_LAS unsigned char* lds, const Gemm g, const Sched& S, const Epi& E) {
    int tid_ = threadIdx.x; asm volatile("" : "+v"(tid_));
    const int tid = tid_, wid = __builtin_amdgcn_readfirstlane(tid >> 6), lane = tid & 63, wr = wid >> 2, wc = wid & 3, fr = lane & 15, fq = lane >> 4;
    const int K = g.K, nt = K / BK;
    constexpr int XROW0 = 16384, XR = 16;
    unsigned voffA[2], voffB[2];
#pragma unroll
    for (int i = 0; i < 2; ++i) { int R, C; stage_rc(tid * 16 + i * 8192, R, C); const int Rb = Epi::PERM ? ((R & ~31) + perm32(R & 31)) : R;
        voffA[i] = (unsigned)(R * K + C) * 2u; voffB[i] = (unsigned)(Rb * K + C) * 2u; }
    unsigned voffX; { const int p = (wid & 3) * 1024 + lane * 16, bq = p >> 11, q = p & 2047, row = q >> 7, kb = (q & 127) ^ (((row >> 1) & 7) << 4); voffX = (unsigned)(row * K * 2 + bq * 128 + kb); }
    int xoff0 = fr * 128 + ((fq * 16) ^ (((fr >> 1) & 7) << 4)), xoff1 = fr * 128 + ((64 + fq * 16) ^ (((fr >> 1) & 7) << 4));
    unsigned xpw = 4096;
    const unsigned kstep = (unsigned)(BK * 2);
    const unsigned hstep = (unsigned)HALF * K * 2;
    const unsigned tstep = 2 * hstep;
    const __amdgpu_buffer_rsrc_t rsA = __builtin_amdgcn_make_buffer_rsrc((void*)g.A, 0, 0x7ffff000, 0x00020000), rsB = __builtin_amdgcn_make_buffer_rsrc((void*)g.Bt, 0, 0x7ffff000, 0x00020000);
    const unsigned ldsw = (unsigned)wid * 1024u;
    const int aoff = lds_byte(wr * 64 + fr, fq * 8), boff = lds_byte(wc * 32 + fr, fq * 8);
#define PG8_SA(b, h) (((b) * 2 + (h)) * HTB)
#define PG8_SB(b, h) ((4 + (b) * 2 + (h)) * HTB)
#define PG8_SX(b) (STAGE_BYTES + (b) * 2048)
#define PG8_STAGEXP(soff) do { if constexpr ((PROBE & (6 | 16)) == 0) { if (wr == 0) __builtin_amdgcn_raw_ptr_buffer_load_lds(rsA, (PG8_LAS unsigned*)(lds + STAGE_BYTES + xpw + wid * 1024), 16, voffX, (soff), 0, 0); } } while (0)
#define PG8_LDAX(dst, b) do { if constexpr ((PROBE & (10 | 32)) == 0) { dst[0] = *(const PG8_LAS bf16x8*)(lds + PG8_SX(b) + xoff0); dst[1] = *(const PG8_LAS bf16x8*)(lds + PG8_SX(b) + xoff1); } } while (0)
#define PG8_WAIT_LT(nl, nt) do { if (wr == 0) PG8_WAIT_V(nl); else PG8_WAIT_V(nt); } while (0)
#define PG8_MMAX_NULL() do { asm volatile("" :: "v"(Ax[0]), "v"(Ax[1])); } while (0)
#define PG8_MMAX_REAL() do { if (wr == 0) { _Pragma("unroll") for (int k = 0; k < 2; ++k) { accx[0] = __builtin_amdgcn_mfma_f32_16x16x32_bf16(B0[0][k], Ax[k], accx[0], 0, 0, 0); accx[1] = __builtin_amdgcn_mfma_f32_16x16x32_bf16(B1[0][k], Ax[k], accx[1], 0, 0, 0); } } \
        else { _Pragma("unroll") for (int k = 0; k < 2; ++k) { accx[0] = __builtin_amdgcn_mfma_f32_16x16x32_bf16(B0[1][k], Ax[k], accx[0], 0, 0, 0); accx[1] = __builtin_amdgcn_mfma_f32_16x16x32_bf16(B1[1][k], Ax[k], accx[1], 0, 0, 0); } } } while (0)
#define PG8_MMAX() do { if constexpr ((PROBE & (2 | 32)) != 0) { } else if constexpr ((PROBE & 1) != 0) PG8_MMAX_NULL(); else PG8_MMAX_REAL(); } while (0)
#define PG8_STAGEA(bufoff, soff) do { if constexpr ((PROBE & 4) == 0) _Pragma("unroll") for (int _i = 0; _i < 2; ++_i) \
        __builtin_amdgcn_raw_ptr_buffer_load_lds(rsA, (PG8_LAS unsigned*)(lds + (bufoff) + ldsw + _i * 8192), 16, voffA[_i], (soff), 0, 0); } while (0)
#define PG8_STAGEB(bufoff, soff) do { if constexpr ((PROBE & 4) == 0) _Pragma("unroll") for (int _i = 0; _i < 2; ++_i) \
        __builtin_amdgcn_raw_ptr_buffer_load_lds(rsB, (PG8_LAS unsigned*)(lds + (bufoff) + ldsw + _i * 8192), 16, voffB[_i], (soff), 0, 0); } while (0)
#define PG8_LDA(dst, b, h) do { if constexpr ((PROBE & 8) == 0) { _Pragma("unroll") for (int m = 0; m < 4; ++m) _Pragma("unroll") for (int k = 0; k < 2; ++k) dst[m][k] = *(const PG8_LAS bf16x8*)(lds + PG8_SA(b, h) + aoff + m * 2048 + k * 1024); } } while (0)
#define PG8_LDB(dst, b, h) do { if constexpr ((PROBE & 8) == 0) { _Pragma("unroll") for (int n = 0; n < 2; ++n) _Pragma("unroll") for (int k = 0; k < 2; ++k) dst[n][k] = *(const PG8_LAS bf16x8*)(lds + PG8_SB(b, h) + boff + n * 2048 + k * 1024); } } while (0)
#define PG8_MMA_NULL(ai, bj, At, Bt) do { _Pragma("unroll") for (int m = 0; m < 4; ++m) _Pragma("unroll") for (int k = 0; k < 2; ++k) asm volatile("" :: "v"(At[m][k])); _Pragma("unroll") for (int n = 0; n < 2; ++n) _Pragma("unroll") for (int k = 0; k < 2; ++k) asm volatile("" :: "v"(Bt[n][k])); } while (0)
#define PG8_MMA_REAL(ai, bj, At, Bt) do { __builtin_amdgcn_s_setprio(1); _Pragma("unroll") for (int m = 0; m < 4; ++m) _Pragma("unroll") for (int n = 0; n < 2; ++n) _Pragma("unroll") for (int k = 0; k < 2; ++k) \
        acc[ai][bj][m][n] = __builtin_amdgcn_mfma_f32_16x16x32_bf16(Bt[n][k], At[m][k], acc[ai][bj][m][n], 0, 0, 0); __builtin_amdgcn_s_setprio(0); } while (0)
#define PG8_MMA(ai, bj, At, Bt) do { if constexpr ((PROBE & 1) != 0) PG8_MMA_NULL(ai, bj, At, Bt); else PG8_MMA_REAL(ai, bj, At, Bt); } while (0)
#define PG8_WAIT_V(n) asm volatile("s_waitcnt vmcnt(" #n ")" ::: "memory")
#define PG8_WAIT_L(n) asm volatile("s_waitcnt lgkmcnt(" #n ")" ::: "memory")
#define PG8_BAR __builtin_amdgcn_s_barrier()
#define PG8_SCHED __builtin_amdgcn_sched_barrier(0)
    Unit cur, nxt; int ui = 0;
    if (!S.next(0, cur)) return;
    f32x4 acc[2][2][4][2];
#pragma unroll
    for (int a = 0; a < 2; ++a)
#pragma unroll
        for (int b = 0; b < 2; ++b)
#pragma unroll
            for (int m = 0; m < 4; ++m)
#pragma unroll
                for (int n = 0; n < 2; ++n) acc[a][b][m][n] = (f32x4){0.f, 0.f, 0.f, 0.f};
    bf16x8 At[4][2], B0[2][2], B1[2][2], Ax[2];
    if constexpr ((PROBE & 8) != 0) {
#pragma unroll
        for (int m = 0; m < 4; ++m)
#pragma unroll
            for (int k = 0; k < 2; ++k) asm volatile("" : "=v"(At[m][k]));
#pragma unroll
        for (int n = 0; n < 2; ++n)
#pragma unroll
            for (int k = 0; k < 2; ++k) { asm volatile("" : "=v"(B0[n][k])); asm volatile("" : "=v"(B1[n][k])); }
        asm volatile("" : "=v"(Ax[0])); asm volatile("" : "=v"(Ax[1])); }
    f32x4 accx[2] = {(f32x4){0.f, 0.f, 0.f, 0.f}, (f32x4){0.f, 0.f, 0.f, 0.f}};
    unsigned cA = (unsigned)cur.pm * tstep, cB = (unsigned)cur.pn * tstep;
    const unsigned xstep = (unsigned)XR * K * 2, xbase = (unsigned)XROW0 * K * 2; unsigned cX = xbase + (unsigned)cur.pm * xstep;
    S.a_ready(cur);
    if constexpr (SP2) {
        PG8_STAGEB(PG8_SB(0, 0), cB); PG8_STAGEB(PG8_SB(0, 1), cB + hstep); PG8_STAGEA(PG8_SA(0, 0), cA); { const unsigned keep_ = xpw; xpw = 0; PG8_STAGEXP(cX); xpw = keep_; } PG8_STAGEA(PG8_SA(0, 1), cA + hstep);
        if (wr == 1) PG8_BAR;
        PG8_WAIT_V(2); PG8_BAR;
        PG8_STAGEB(PG8_SB(1, 0), cB + kstep); PG8_STAGEA(PG8_SA(1, 0), cA + kstep); PG8_STAGEB(PG8_SB(1, 1), cB + hstep + kstep);
        PG8_WAIT_V(6); PG8_BAR;
    } else {
        PG8_STAGEB(PG8_SB(0, 0), cB); PG8_STAGEA(PG8_SA(0, 0), cA); PG8_STAGEB(PG8_SB(0, 1), cB + hstep); PG8_STAGEA(PG8_SA(0, 1), cA + hstep);
        if (wr == 1) PG8_BAR;
        PG8_WAIT_V(4); PG8_BAR;
        PG8_STAGEB(PG8_SB(1, 0), cB + kstep); PG8_STAGEA(PG8_SA(1, 0), cA + kstep); PG8_STAGEB(PG8_SB(1, 1), cB + hstep + kstep);
        PG8_WAIT_V(6); PG8_BAR;
    }
    for (;;) {
        const bool has_next = S.next(ui + 1, nxt);
        const unsigned nA = has_next ? (unsigned)nxt.pm * tstep : cA, nB = has_next ? (unsigned)nxt.pn * tstep : cB, nX = has_next ? xbase + (unsigned)nxt.pm * xstep : cX;
        for (int t = 0; t < nt; t += 2) {
            const bool last = (t == nt - 2);
            const unsigned a1 = cA + (unsigned)(t + 1) * kstep;
            const unsigned a2 = last ? nA : cA + (unsigned)(t + 2) * kstep, b2 = last ? nB : cB + (unsigned)(t + 2) * kstep;
            const unsigned a3 = a2 + kstep, b3 = b2 + kstep, x2 = last ? nX : cX + (unsigned)(t + 2) * kstep;
            if (last && has_next) S.a_ready(nxt);
            if constexpr (SP2) {
            PG8_LDB(B0, 0, 0); PG8_LDB(B1, 0, 1); PG8_SCHED; PG8_LDA(At, 0, 0); PG8_LDAX(Ax, 0); PG8_STAGEXP(x2); PG8_STAGEA(PG8_SA(1, 1), a1 + hstep);
            PG8_WAIT_LT(9, 8); PG8_WAIT_L(0); PG8_BAR; PG8_MMA(0, 0, At, B0); PG8_MMA(0, 1, At, B1); PG8_MMAX(); PG8_BAR; PG8_SCHED;
            PG8_LDA(At, 0, 1); PG8_STAGEB(PG8_SB(0, 0), b2); PG8_STAGEB(PG8_SB(0, 1), b2 + hstep); PG8_STAGEA(PG8_SA(0, 0), a2);
            PG8_WAIT_LT(9, 8); PG8_WAIT_L(0); PG8_BAR; PG8_MMA(1, 0, At, B0); PG8_MMA(1, 1, At, B1); PG8_BAR; PG8_SCHED;
            PG8_LDB(B0, 1, 0); PG8_LDB(B1, 1, 1); PG8_SCHED; PG8_LDA(At, 1, 0); PG8_LDAX(Ax, 1); PG8_STAGEA(PG8_SA(0, 1), a2 + hstep);
            PG8_WAIT_V(8); PG8_WAIT_L(0); PG8_BAR; PG8_MMA(0, 0, At, B0); PG8_MMA(0, 1, At, B1); PG8_MMAX(); PG8_BAR; PG8_SCHED;
            PG8_LDA(At, 1, 1); PG8_STAGEB(PG8_SB(1, 0), b3); PG8_STAGEB(PG8_SB(1, 1), b3 + hstep); PG8_STAGEA(PG8_SA(1, 0), a3);
            PG8_WAIT_V(8); PG8_WAIT_L(0); PG8_BAR; PG8_MMA(1, 0, At, B0); PG8_MMA(1, 1, At, B1); PG8_BAR; PG8_SCHED;
            xpw ^= 4096u; xoff0 ^= 4096; xoff1 ^= 4096;
            } else {
            PG8_LDB(B0, 0, 0); PG8_SCHED; PG8_LDA(At, 0, 0); PG8_STAGEA(PG8_SA(1, 1), a1 + hstep);
            PG8_WAIT_L(8); PG8_BAR; PG8_WAIT_L(0); PG8_MMA(0, 0, At, B0); PG8_BAR; PG8_SCHED;
            PG8_LDB(B1, 0, 1); PG8_STAGEB(PG8_SB(0, 0), b2);
            PG8_BAR; PG8_WAIT_L(0); PG8_MMA(0, 1, At, B1); PG8_BAR;
            PG8_LDA(At, 0, 1); PG8_STAGEA(PG8_SA(0, 0), a2);
            PG8_BAR; PG8_WAIT_L(0); PG8_MMA(1, 0, At, B0); PG8_BAR; PG8_SCHED;
            PG8_STAGEB(PG8_SB(0, 1), b2 + hstep);
            PG8_WAIT_V(6); PG8_BAR; PG8_MMA(1, 1, At, B1); PG8_BAR;
            PG8_LDB(B0, 1, 0); PG8_SCHED; PG8_LDA(At, 1, 0); PG8_STAGEA(PG8_SA(0, 1), a2 + hstep);
            PG8_WAIT_L(8); PG8_BAR; PG8_WAIT_L(0); PG8_MMA(0, 0, At, B0); PG8_BAR; PG8_SCHED;
            PG8_LDB(B1, 1, 1); PG8_STAGEB(PG8_SB(1, 0), b3);
            PG8_BAR; PG8_WAIT_L(0); PG8_MMA(0, 1, At, B1); PG8_BAR;
            PG8_LDA(At, 1, 1); PG8_STAGEA(PG8_SA(1, 0), a3);
            PG8_BAR; PG8_WAIT_L(0); PG8_MMA(1, 0, At, B0); PG8_BAR; PG8_SCHED;
            PG8_STAGEB(PG8_SB(1, 1), b3 + hstep);
            PG8_WAIT_V(6); PG8_BAR; PG8_MMA(1, 1, At, B1); PG8_BAR;
            }
        }
        if constexpr (ALIGN_EPI) { if (wr == 0) PG8_BAR; }
        E(acc, cur, wr, wc, fr, fq); E.rgx(accx, cur, wr, wc, fr, fq);
        if (!has_next) break;
#pragma unroll
        for (int a = 0; a < 2; ++a)
#pragma unroll
            for (int b = 0; b < 2; ++b)
#pragma unroll
                for (int m = 0; m < 4; ++m)
#pragma unroll
                    for (int n = 0; n < 2; ++n) acc[a][b][m][n] = (f32x4){0.f, 0.f, 0.f, 0.f};
        accx[0] = (f32x4){0.f, 0.f, 0.f, 0.f}; accx[1] = (f32x4){0.f, 0.f, 0.f, 0.f};
        cur = nxt; cA = nA; cB = nB; cX = nX; ++ui;
        if constexpr (ALIGN_EPI) { if (wr == 1) PG8_BAR; }
    }
    PG8_WAIT_V(0);
    if constexpr (!ALIGN_EPI) { if (wr == 0) PG8_BAR; }
    PG8_BAR;
#undef PG8_SA
#undef PG8_SB
#undef PG8_STAGEA
#undef PG8_STAGEB
#undef PG8_SX
#undef PG8_STAGEXP
#undef PG8_WAIT_LT
#undef PG8_LDAX
#undef PG8_MMAX
#undef PG8_LDA
#undef PG8_LDB
#undef PG8_MMA
#undef PG8_WAIT_V
#undef PG8_WAIT_L
#undef PG8_BAR
#undef PG8_SCHED
}
}

#define GAS __attribute__((address_space(1)))
#define LAS __attribute__((address_space(3)))
typedef unsigned short bf16;
typedef unsigned v4u __attribute__((ext_vector_type(4)));
typedef float f32x4 __attribute__((ext_vector_type(4)));
typedef short bf16x8 __attribute__((ext_vector_type(8)));
typedef GAS unsigned gu32;
typedef GAS unsigned long long gu64;
#define RLX_AGENT __ATOMIC_RELAXED, __HIP_MEMORY_SCOPE_AGENT
#define LDS_WAIT() asm volatile("s_waitcnt lgkmcnt(0)" ::: "memory")
#define VM_WAIT() asm volatile("s_waitcnt vmcnt(0)" ::: "memory")
__device__ __forceinline__ unsigned long long rt() { return __builtin_amdgcn_s_memrealtime(); }
__device__ __forceinline__ unsigned f2bf(float f) { unsigned u = __builtin_bit_cast(unsigned, f); return (u + 0x7fffu + ((u >> 16) & 1u)) >> 16; }
__device__ __forceinline__ unsigned pk2(float lo, float hi) { return f2bf(lo) | (f2bf(hi) << 16); }

#define XB_TMO      128
#define XB_XCNT(j)  (256  + 64 * (j))
#define XB_XSUB(j)  (1280 + 64 * (j))
#define XB_XGEN(j)  (2304 + 64 * (j))
#define XB_TOP      3328
#define XB_TOPGEN   3392
#define XCD_BAR_WORDS 3456
#define XB_SPIN_CAP (1u << 18)

__device__ __forceinline__ unsigned xb_ld(unsigned* p)              { return __hip_atomic_load(p, __ATOMIC_RELAXED, __HIP_MEMORY_SCOPE_AGENT); }
__device__ __forceinline__ unsigned xb_add(unsigned* p, unsigned v) { return __hip_atomic_fetch_add(p, v, __ATOMIC_RELAXED, __HIP_MEMORY_SCOPE_AGENT); }
__device__ __forceinline__ unsigned xb_xcc_id() { return (unsigned)__builtin_amdgcn_s_getreg((3 << 11) | 20) & 0xFu; }
#define XB_SPIN(cond, bar) do { unsigned _sp = 0; while (cond) { __builtin_amdgcn_s_sleep(1); \
    if ((++_sp & 255u) == 0u) { if (xb_ld(&(bar)[XB_TMO])) break; if (_sp > XB_SPIN_CAP) { atomicAdd(&(bar)[XB_TMO], 1u); break; } } } } while (0)

struct XcdBarrier {
    unsigned* bar; unsigned x; unsigned n;
    volatile LAS unsigned* st;
};

__device__ __forceinline__ XcdBarrier xcd_barrier_post(unsigned* bar, volatile LAS unsigned* st, unsigned n) {
    XcdBarrier b; b.bar = bar; b.x = xb_xcc_id(); b.st = st; b.n = n;
    if (threadIdx.x == 0) (void)xb_add(&bar[XB_XCNT(b.x)], 1u);
    return b;
}
__device__ __forceinline__ void xcd_barrier_complete(unsigned* bar, unsigned x, unsigned G, unsigned& nloc, unsigned& nx) {
    unsigned sum, cnt, mine, sp = 0u;
    for (;;) {
        sum = 0u; cnt = 0u; mine = 0u;
#pragma unroll
        for (unsigned j = 0; j < 16; ++j) { const unsigned c = xb_ld(&bar[XB_XCNT(j)]); sum += c; cnt += (c > 0u) ? 1u : 0u; mine = (j == x) ? c : mine; }
        if (sum == G) break;
        __builtin_amdgcn_s_sleep(1);
        if ((++sp & 255u) == 0u) { if (xb_ld(&bar[XB_TMO])) break; if (sp > XB_SPIN_CAP) { atomicAdd(&bar[XB_TMO], 1u); break; } }
    }
    nloc = mine > 0u ? mine : 1u; nx = cnt > 0u ? cnt : 1u;
}

__device__ __forceinline__ void xcd_barrier(const XcdBarrier& b) {
    asm volatile("s_waitcnt vmcnt(0)" ::: "memory");
    __syncthreads();
    if (threadIdx.x == 0) {
        unsigned* bar = b.bar;
        __builtin_amdgcn_s_waitcnt(0);
        unsigned nloc = b.st[0], nx = b.st[1];
        if (nloc == 0u) { xcd_barrier_complete(bar, b.x, b.n, nloc, nx); b.st[0] = nloc; b.st[1] = nx; }
        const unsigned old = xb_add(&bar[XB_XSUB(b.x)], 1u);
        const unsigned gen = old / nloc;
        if (old + 1u == (gen + 1u) * nloc) {
            __builtin_amdgcn_fence(__ATOMIC_RELEASE, "agent");
            asm volatile("s_waitcnt vmcnt(0)" ::: "memory");
            const unsigned og = xb_add(&bar[XB_TOP], 1u);
            const unsigned tg = og / nx;
            if (og + 1u == (tg + 1u) * nx) xb_add(&bar[XB_TOPGEN], 1u);
            else XB_SPIN(xb_ld(&bar[XB_TOPGEN]) == tg, bar);
            __builtin_amdgcn_fence(__ATOMIC_ACQUIRE, "agent");
            xb_add(&bar[XB_XGEN(b.x)], 1u);
            asm volatile("s_waitcnt vmcnt(0)" ::: "memory");
        } else {
            XB_SPIN(xb_ld(&bar[XB_XGEN(b.x)]) == gen, bar);
            __builtin_amdgcn_fence(__ATOMIC_ACQUIRE, "agent");
            asm volatile("s_waitcnt vmcnt(0)" ::: "memory");
        }
    }
    __syncthreads();
}


constexpr int NWAVES = 8;
#ifndef MK_ONE_LAUNCH
#define MK_ONE_LAUNCH 1
#endif
constexpr int N_PHASES = 15;

constexpr int D = 1024, FF = 4096, MP = 8 * 2048, MS = 128 * 8, M = MP + MS;
constexpr int NG = 64, PS = 64, GS = 16;
constexpr float EPS = 1e-6f;
constexpr size_t O_Y = 0, O_SRP = (size_t)M * D, O_SIP = O_SRP + 8 * 4096, O_CP = O_SIP + 8 * 4096, O_SRS = O_CP + 8 * 2 * 1024, O_SIS = O_SRS + 128 * 4096, O_CS = O_SIS + 128 * 4096, O_END = O_CS + 128 * 2 * 1024;
static_assert(O_END == 19218432, "output size");

constexpr size_t MiB = 1u << 20;
constexpr size_t WS_CTL = 0, CTL_ZERO_BYTES = 1 * MiB;
constexpr size_t WS_SSQ = 112 * MiB;
constexpr size_t WS_SSME = 114 * MiB;
constexpr size_t WS_SSMP = 2 * MiB;
constexpr size_t WS_WGU = 4 * MiB;
constexpr size_t WS_WD = 68 * MiB;
constexpr size_t WS_WGLU = 100 * MiB;
constexpr size_t WS_WIN = 104 * MiB;
constexpr size_t WS_WOUT = 110 * MiB;
constexpr size_t WS_X = 112 * MiB;
constexpr size_t WS_XB = 180 * MiB;
constexpr size_t WS_H = 214 * MiB;
constexpr size_t WS_G = 350 * MiB, WS_A2 = WS_G, WS_Z = 384 * MiB, WS_GB = 418 * MiB;
constexpr size_t WS_END = 452 * MiB;
constexpr int CW_TMO = 0;
constexpr int CW_BAR = 4096;
constexpr int CW_SK = 16384;

constexpr int RING_OFF = 0, RING_BYTES = 131072 + 8192;
constexpr int LDSCTL_OFF = RING_BYTES, MISC_OFF = LDSCTL_OFF + 320;
constexpr int LDS_BYTES = 147456;

struct Frame {
    LAS unsigned char* lds;
    volatile LAS unsigned* MISC;
    gu32* ctl;
    int tid, lane, wave, vcu, G, gi, ci;
    const float* in[21]; float* out; unsigned char* ws;
};

__device__ __forceinline__ int opaque_i(int v) { asm volatile("" : "+v"(v)); return v; }
__device__ __forceinline__ float wave_sum(float v) {
#pragma unroll
    for (int o = 1; o < 64; o <<= 1) v += __shfl_xor(v, o);
    return v;
}
__device__ __forceinline__ float bf2f(unsigned short b) { return __builtin_bit_cast(float, (unsigned)b << 16); }

struct P0Item { const float* W; bf16* WT; const float* gk; int K, N, k0, n0s, n0d; };
__device__ __forceinline__ int pair_src(int nd, int base, int hstride) { return base + ((nd >> 7) & 1) * hstride + 128 * (nd >> 8) + (nd & 127); }
__device__ __forceinline__ P0Item p0_item(Frame& F, int it) {
    constexpr int I_GU = (D / 64) * (2 * FF / 64), I_D = (FF / 64) * (D / 64), I_GLU = (D / 64) * (2 * D / 64), I_IN = (D / 64) * (3 * D / 64);
    const float* norm_g = F.in[5]; P0Item p; int r = it;
    if (r < 4 * I_GU) { const int f = r / I_GU; r -= f * I_GU; const int nb = r % (2 * FF / 64), kb = r / (2 * FF / 64), nd = 64 * nb;
        p.W = F.in[7] + (size_t)f * D * 2 * FF; p.K = D; p.N = 2 * FF; p.WT = (bf16*)(F.ws + WS_WGU) + (size_t)f * 2 * FF * D; p.gk = norm_g + ((f >> 1) * 3 + (f & 1) * 2) * D; p.k0 = 64 * kb; p.n0s = pair_src(nd, 0, FF); p.n0d = nd; return p; }
    r -= 4 * I_GU;
    if (r < 4 * I_D) { const int f = r / I_D; r -= f * I_D; const int nb = r % (D / 64), kb = r / (D / 64), nd = 64 * nb;
        p.W = F.in[8] + (size_t)f * FF * D; p.K = FF; p.N = D; p.WT = (bf16*)(F.ws + WS_WD) + (size_t)f * D * FF; p.gk = nullptr; p.k0 = 64 * kb; p.n0s = nd; p.n0d = nd; return p; }
    r -= 4 * I_D;
    if (r < I_GLU) { const int nb = r % (2 * D / 64), kb = r / (2 * D / 64), nd = 64 * nb;
        p.W = F.in[17]; p.K = D; p.N = 2 * D; p.WT = (bf16*)(F.ws + WS_WGLU); p.gk = nullptr; p.k0 = 64 * kb; p.n0s = pair_src(nd, 0, D); p.n0d = nd; return p; }
    r -= I_GLU;
    if (r < I_IN) { const int nb = r % (3 * D / 64), kb = r / (3 * D / 64), nd = 64 * nb;
        p.W = F.in[18]; p.K = D; p.N = 3 * D; p.WT = (bf16*)(F.ws + WS_WIN); p.gk = norm_g + 4 * D; p.k0 = 64 * kb; p.n0s = nd < 2048 ? pair_src(nd, D, D) : nd - 2048; p.n0d = nd; return p; }
    r -= I_IN;
    { const int nb = r % (D / 64), kb = r / (D / 64), nd = 64 * nb;
        p.W = F.in[20]; p.K = D; p.N = D; p.WT = (bf16*)(F.ws + WS_WOUT); p.gk = nullptr; p.k0 = 64 * kb; p.n0s = nd; p.n0d = nd; return p; }
}
#define P0_LOAD(v, gs, p) do { _Pragma("unroll") for (int i = 0; i < 8; ++i) _Pragma("unroll") for (int s = 0; s < 2; ++s) { \
        v[i][s] = *(const GAS f32x4*)((p).W + (size_t)((p).k0 + 8 * i + 2 * kr + s) * (p).N + (p).n0s + 4 * c); gs[i][s] = (p).gk ? (p).gk[(p).k0 + 8 * i + 2 * kr + s] : 1.0f; } } while (0)
#define P0_PROC(v, gs, p) do { \
        _Pragma("unroll") for (int i = 0; i < 8; ++i) _Pragma("unroll") for (int j = 0; j < 4; ++j) \
            *(LAS unsigned*)(scr + (4 * c + j) * 128 + (((4 * i + kr) ^ ((c & 7) << 2)) << 2)) = pg8::cvt_pk_bf16(v[i][0][j] * gs[i][0], v[i][1][j] * gs[i][1]); \
        LDS_WAIT(); asm volatile("" ::: "memory"); \
        _Pragma("unroll") for (int i = 0; i < 8; ++i) { const int n = nr + 8 * i; const v4u o = *(const LAS v4u*)(scr + n * 128 + ((q ^ ((n >> 2) & 7)) << 4)); \
            *(GAS v4u*)((p).WT + (size_t)((p).n0d + n) * (p).K + (p).k0 + 8 * q) = o; } \
        LDS_WAIT(); asm volatile("" ::: "memory"); } while (0)

__device__ __forceinline__ void p0_prologue(Frame& F) {
    LAS unsigned char* scr = F.lds + RING_OFF + F.wave * 16384;
    const int gw = F.vcu * NWAVES + F.wave, NGW = F.G * NWAVES, lane = opaque_i(F.lane);
    constexpr int NITEMS = 4 * (D / 64) * (2 * FF / 64) + 4 * (FF / 64) * (D / 64) + (D / 64) * (2 * D / 64) + (D / 64) * (3 * D / 64) + (D / 64) * (D / 64);
    { const int kr = lane >> 4, c = lane & 15, nr = lane >> 3, q = lane & 7;
      f32x4 va[8][2], vb[8][2]; float ga[8][2], gb[8][2];
      int it = gw; P0Item pa = p0_item(F, it < NITEMS ? it : 0), pb = pa;
      if (it < NITEMS) P0_LOAD(va, ga, pa);
      while (it < NITEMS) {
          const int it1 = it + NGW; if (it1 < NITEMS) { pb = p0_item(F, it1); P0_LOAD(vb, gb, pb); }
          P0_PROC(va, ga, pa);
          if (it1 >= NITEMS) break;
          const int it2 = it1 + NGW; if (it2 < NITEMS) { pa = p0_item(F, it2); P0_LOAD(va, ga, pa); }
          P0_PROC(vb, gb, pb);
          it = it2;
      }
    }
    bf16* XB = (bf16*)(F.ws + WS_XB); pg8::ssq_t* ssq = (pg8::ssq_t*)(F.ws + WS_SSQ);
    for (int m0 = gw; m0 < M; m0 += 4 * NGW) {
        f32x4 v[4][4];
#pragma unroll
        for (int r = 0; r < 4; ++r) { const int m = m0 + r * NGW; if (m < M) { const float* src = m < MP ? F.in[0] + (size_t)m * D : F.in[1] + (size_t)(m - MP) * D;
#pragma unroll
            for (int j = 0; j < 4; ++j) v[r][j] = ((const GAS f32x4*)src)[lane + 64 * j]; } }
#pragma unroll
        for (int r = 0; r < 4; ++r) { const int m = m0 + r * NGW; if (m < M) {
            GAS unsigned long long* o8 = (GAS unsigned long long*)(XB + (size_t)m * D) + lane; float s = 0.f;
#pragma unroll
            for (int j = 0; j < 4; ++j) { const f32x4 w = v[r][j]; s += (w.x * w.x + w.y * w.y) + (w.z * w.z + w.w * w.w);
                o8[64 * j] = (unsigned long long)pg8::cvt_pk_bf16(w.x, w.y) | ((unsigned long long)pg8::cvt_pk_bf16(w.z, w.w) << 32); }
            s = wave_sum(s);
            if (lane == 0) ssq[m] = pg8::ssq_fix(s); } }
    }
    for (int i = gw * 64 + lane; i < 7 * M; i += NGW * 64) ssq[M + i] = 0ull;
    float* sp = (float*)(F.ws + WS_SSMP);
    for (int i = gw * 64 + lane; i < NG * PS; i += NGW * 64) {
        const int g = i / PS;
        const float lr = F.in[9][i], li = F.in[10][i], dt = expf(F.in[11][g]);
        const float mag = expf(lr * dt); float sn, cs; sincosf(li * dt, &sn, &cs);
        const float lbr = mag * cs, lbi = mag * sn, den = lr * lr + li * li, nr = lbr - 1.0f, ni = lbi;
        const float fr = (nr * lr + ni * li) / den, fi = (ni * lr - nr * li) / den;
        sp[i] = lbr; sp[4096 + i] = lbi;
#pragma unroll
        for (int c = 0; c < GS; ++c) { const float br = F.in[12][(size_t)i * GS + c], bi = F.in[13][(size_t)i * GS + c];
            sp[8192 + (size_t)i * GS + c] = fr * br - fi * bi; sp[8192 + 65536 + (size_t)i * GS + c] = fr * bi + fi * br; }
    }
}

__device__ __forceinline__ float gelu_tanh(float x) {
    const float a = 0.7978845608028654f * (x + 0.044715f * x * x * x);
    return x * __builtin_amdgcn_rcpf(1.0f + __builtin_amdgcn_exp2f(-2.0f * 1.4426950408889634f * a));
}


typedef float f32x16 __attribute__((ext_vector_type(16)));
typedef unsigned u32x2v __attribute__((ext_vector_type(2)));
__device__ __forceinline__ unsigned cvtpk(float lo, float hi) { unsigned r; asm volatile("v_cvt_pk_bf16_f32 %0, %1, %2" : "=v"(r) : "v"(lo), "v"(hi)); return r; }
__device__ __forceinline__ bf16x8 pack8(const float* v) { v4u w; w.x = cvtpk(v[0], v[1]); w.y = cvtpk(v[2], v[3]); w.z = cvtpk(v[4], v[5]); w.w = cvtpk(v[6], v[7]); return __builtin_bit_cast(bf16x8, w); }
constexpr int SSM_ROWB = 272;
constexpr int SSM_NCH = 4, SSM_CHB = 16;
#define BFLO(w) __builtin_bit_cast(float, (w) << 16)
#define BFHI(w) __builtin_bit_cast(float, (w) & 0xffff0000u)

template <int MODE>
__device__ __forceinline__ void ssm_run(Frame& F, LAS unsigned char* img, int lane, int g, int row_base, int nblk, bool sample, int seq0, float& hr, float& hi) {
    const bf16* X = (const bf16*)(F.ws + WS_XB); const pg8::ssq_t* ssq = (const pg8::ssq_t*)(F.ws + WS_SSQ) + 1 * M;
    const float* sp = (const float*)(F.ws + WS_SSMP); bf16* Gb = (bf16*)(F.ws + WS_G);
    const float* g1 = F.in[5] + 1 * D; const float* dsk = F.in[16];
    const int l31 = lane & 31, h = lane >> 5, l15 = lane & 15, q4 = lane >> 4;
    bf16x8 bbq[4];
#pragma unroll
    for (int q = 0; q < 4; ++q) { const int p = 32 * (q & 1) + l31; const float* src = sp + 8192 + (q >> 1) * 65536 + ((size_t)(g * PS + p) * GS + 8 * h);
        float v[8];
#pragma unroll
        for (int j = 0; j < 8; ++j) v[j] = src[j] * g1[g * GS + 8 * h + j];
        bbq[q] = pack8(v); }
    bf16x8 cm[4]; float dg[4];
    if (MODE == 1) {
#pragma unroll
        for (int ks = 0; ks < 4; ++ks) { const int p0 = 16 * ks + 4 * q4; const float* cr = F.in[14] + ((size_t)(g * GS + l15) * PS + p0); const float* ci = F.in[15] + ((size_t)(g * GS + l15) * PS + p0);
            float v[8];
#pragma unroll
            for (int j = 0; j < 4; ++j) { v[2 * j] = cr[j]; v[2 * j + 1] = -ci[j]; }
            cm[ks] = pack8(v); }
#pragma unroll
        for (int e = 0; e < 4; ++e) dg[e] = dsk[g * GS + 4 * q4 + e] * g1[g * GS + 4 * q4 + e];
    }
    const float lbr = sp[g * PS + lane], lbi = sp[4096 + g * PS + lane];
    float s0r[4], s0i[4];
    if (sample) {
#pragma unroll
        for (int i = 0; i < 4; ++i) { s0r[i] = F.in[2][((size_t)(seq0 + i) * NG + g) * PS + lane]; s0i[i] = F.in[3][((size_t)(seq0 + i) * NG + g) * PS + lane]; } }
    else {
#pragma unroll
        for (int i = 0; i < 4; ++i) { s0r[i] = 0.f; s0i[i] = 0.f; } }
    v4u xaw; u32x2v xew0, xew1; pg8::ssq_t qa, qe0 = 0, qe1 = 0;
#define SSM_LOAD(b) do { const int rowA = row_base + 32 * (b) + l31; xaw = *(const GAS v4u*)(X + (size_t)rowA * D + g * GS + 8 * h); qa = ssq[rowA]; \
        if (MODE == 1) { const int rowE = row_base + 32 * (b) + l15; xew0 = *(const GAS u32x2v*)(X + (size_t)rowE * D + g * GS + 4 * q4); xew1 = *(const GAS u32x2v*)(X + (size_t)(rowE + 16) * D + g * GS + 4 * q4); qe0 = ssq[rowE]; qe1 = ssq[rowE + 16]; } } while (0)
    SSM_LOAD(0);
    for (int b = 0; b < nblk; ++b) {
        const f32x4 ca0 = {BFLO(xaw.x), BFHI(xaw.x), BFLO(xaw.y), BFHI(xaw.y)}, ca1 = {BFLO(xaw.z), BFHI(xaw.z), BFLO(xaw.w), BFHI(xaw.w)};
        f32x4 ce0, ce1; if (MODE == 1) { ce0 = (f32x4){BFLO(xew0.x), BFHI(xew0.x), BFLO(xew0.y), BFHI(xew0.y)}; ce1 = (f32x4){BFLO(xew1.x), BFHI(xew1.x), BFLO(xew1.y), BFHI(xew1.y)}; }
        const pg8::ssq_t cqa = qa, cqe0 = qe0, cqe1 = qe1;
        if (b + 1 < nblk) SSM_LOAD(b + 1);
        const float rsa = pg8::rstd_of(cqa);
        float ua[8];
#pragma unroll
        for (int j = 0; j < 4; ++j) { ua[j] = ca0[j] * rsa; ua[4 + j] = ca1[j] * rsa; }
        const bf16x8 ufrag = pack8(ua);
        const f32x16 zero16 = {0.f, 0.f, 0.f, 0.f, 0.f, 0.f, 0.f, 0.f, 0.f, 0.f, 0.f, 0.f, 0.f, 0.f, 0.f, 0.f};
        f32x16 Xr = __builtin_amdgcn_mfma_f32_32x32x16_bf16(ufrag, bbq[0], zero16, 0, 0, 0);
        f32x16 Yr = __builtin_amdgcn_mfma_f32_32x32x16_bf16(ufrag, bbq[1], zero16, 0, 0, 0);
        f32x16 Xi = __builtin_amdgcn_mfma_f32_32x32x16_bf16(ufrag, bbq[2], zero16, 0, 0, 0);
        f32x16 Yi = __builtin_amdgcn_mfma_f32_32x32x16_bf16(ufrag, bbq[3], zero16, 0, 0, 0);
#pragma unroll
        for (int r = 0; r < 16; ++r) {
            auto s1 = __builtin_amdgcn_permlane32_swap(__float_as_uint(Xr[r]), __float_as_uint(Yr[r]), false, false); Xr[r] = __uint_as_float(s1[0]); Yr[r] = __uint_as_float(s1[1]);
            auto s2 = __builtin_amdgcn_permlane32_swap(__float_as_uint(Xi[r]), __float_as_uint(Yi[r]), false, false); Xi[r] = __uint_as_float(s2[0]); Yi[r] = __uint_as_float(s2[1]); }
#pragma unroll
        for (int i = 0; i < 4; ++i) {
            if (sample) { hr = s0r[i]; hi = s0i[i]; }
#pragma unroll
            for (int s = 0; s < 2; ++s)
#pragma unroll
                for (int e = 0; e < 4; ++e) { const int r = 4 * i + e; const float br = s ? Yr[r] : Xr[r], bi = s ? Yi[r] : Xi[r];
                    const float nr = lbr * hr - lbi * hi + br, ni = lbr * hi + lbi * hr + bi; hr = nr; hi = ni;
                    if (MODE == 1) *(LAS unsigned*)(img + (8 * i + 4 * s + e) * SSM_ROWB + 4 * lane) = cvtpk(hr, hi); }
            if (sample) { F.out[O_SRS + ((size_t)(seq0 + i) * NG + g) * PS + lane] = hr; F.out[O_SIS + ((size_t)(seq0 + i) * NG + g) * PS + lane] = hi; }
        }
        if (MODE == 1) {
            f32x4 acc0 = {0.f, 0.f, 0.f, 0.f}, acc1 = {0.f, 0.f, 0.f, 0.f};
#pragma unroll
            for (int ks = 0; ks < 4; ++ks) {
                const bf16x8 b0 = *(const LAS bf16x8*)(img + l15 * SSM_ROWB + 64 * ks + 16 * q4);
                const bf16x8 b1 = *(const LAS bf16x8*)(img + (16 + l15) * SSM_ROWB + 64 * ks + 16 * q4);
                acc0 = __builtin_amdgcn_mfma_f32_16x16x32_bf16(cm[ks], b0, acc0, 0, 0, 0);
                acc1 = __builtin_amdgcn_mfma_f32_16x16x32_bf16(cm[ks], b1, acc1, 0, 0, 0); }
            const float rse0 = pg8::rstd_of(cqe0), rse1 = pg8::rstd_of(cqe1);
            float o0[4], o1[4];
#pragma unroll
            for (int e = 0; e < 4; ++e) { o0[e] = gelu_tanh(acc0[e] + dg[e] * ce0[e] * rse0); o1[e] = gelu_tanh(acc1[e] + dg[e] * ce1[e] * rse1); }
            const int rowE = row_base + 32 * b + l15;
            u32x2v w0, w1; w0.x = cvtpk(o0[0], o0[1]); w0.y = cvtpk(o0[2], o0[3]); w1.x = cvtpk(o1[0], o1[1]); w1.y = cvtpk(o1[2], o1[3]);
            *(u32x2v*)(Gb + (size_t)rowE * D + g * GS + 4 * q4) = w0;
            *(u32x2v*)(Gb + (size_t)(rowE + 16) * D + g * GS + 4 * q4) = w1;
        }
    }
#undef SSM_LOAD
}

__device__ __forceinline__ void ssm_phase_pass(Frame& F, int pass) {
    LAS unsigned char* img = F.lds + RING_OFF + F.wave * 16384;
    const int lane = opaque_i(F.lane), s = F.wave * 32 + F.ci, g = s & 63, c = s >> 6;
    float* E = (float*)(F.ws + WS_SSME) + ((size_t)(F.gi * NG + g) * SSM_NCH) * 2 * PS;
    const int row_base = F.gi * 2048 + c * (SSM_CHB * 32);
    if (pass == 0) {
        float hr = 0.f, hi = 0.f;
        ssm_run<0>(F, img, lane, g, row_base, SSM_CHB, false, 0, hr, hi);
        E[(c * 2 + 0) * PS + lane] = hr; E[(c * 2 + 1) * PS + lane] = hi;
        float sr = 0.f, si = 0.f;
        ssm_run<1>(F, img, lane, g, MP + 128 * F.gi + 32 * c, 1, true, 16 * F.gi + 4 * c, sr, si);
    } else {
        const float* sp = (const float*)(F.ws + WS_SSMP);
        float ar = sp[g * PS + lane], ai = sp[4096 + g * PS + lane];
#pragma unroll
        for (int k = 0; k < 9; ++k) { const float nr = ar * ar - ai * ai, ni = 2.0f * ar * ai; ar = nr; ai = ni; }
        float hr = 0.f, hi = 0.f;
        for (int j = 0; j < c; ++j) { const float er = E[(j * 2 + 0) * PS + lane], ei = E[(j * 2 + 1) * PS + lane];
            const float nr = ar * hr - ai * hi + er, ni = ar * hi + ai * hr + ei; hr = nr; hi = ni; }
        ssm_run<1>(F, img, lane, g, row_base, SSM_CHB, false, 0, hr, hi);
        if (c == SSM_NCH - 1) { F.out[O_SRP + ((size_t)F.gi * NG + g) * PS + lane] = hr; F.out[O_SIP + ((size_t)F.gi * NG + g) * PS + lane] = hi; }
    }
}
#undef BFLO
#undef BFHI

__device__ __forceinline__ void conv_phase(Frame& F) {
    const bf16* Z = (const bf16*)(F.ws + WS_Z); const bf16* GBp = (const bf16*)(F.ws + WS_GB); bf16* A2 = (bf16*)(F.ws + WS_A2);
    const float* cw = F.in[19]; const float* cache = F.in[4];
    const int gt = (F.ci * NWAVES + F.wave) * 64 + opaque_i(F.lane), NGT = 32 * NWAVES * 64;
    for (int it = gt; it < (2048 + 128) * (D / 8); it += NGT) {
        const int lr = it >> 7, row = lr < 2048 ? F.gi * 2048 + lr : MP + F.gi * 128 + (lr - 2048), c0 = (it & 127) * 8;
        int t; const float* cb = nullptr;
        if (row < MP) t = row & 2047; else { const int r2 = row - MP; t = r2 & 7; cb = cache + (size_t)(r2 >> 3) * 2 * D; }
        float z0[8], z1[8], z2[8], gb[8];
        { const v4u v = *(const GAS v4u*)(Z + (size_t)row * D + c0); const v4u q = *(const GAS v4u*)(GBp + (size_t)row * D + c0);
#pragma unroll
          for (int e = 0; e < 4; ++e) { z2[2 * e] = __builtin_bit_cast(float, v[e] << 16); z2[2 * e + 1] = __builtin_bit_cast(float, v[e] & 0xffff0000u);
                                        gb[2 * e] = __builtin_bit_cast(float, q[e] << 16); gb[2 * e + 1] = __builtin_bit_cast(float, q[e] & 0xffff0000u); } }
        if (t >= 1) { const v4u v = *(const GAS v4u*)(Z + (size_t)(row - 1) * D + c0);
#pragma unroll
          for (int e = 0; e < 4; ++e) { z1[2 * e] = __builtin_bit_cast(float, v[e] << 16); z1[2 * e + 1] = __builtin_bit_cast(float, v[e] & 0xffff0000u); } }
        else {
#pragma unroll
          for (int e = 0; e < 8; ++e) z1[e] = cb ? cb[D + c0 + e] : 0.f; }
        if (t >= 2) { const v4u v = *(const GAS v4u*)(Z + (size_t)(row - 2) * D + c0);
#pragma unroll
          for (int e = 0; e < 4; ++e) { z0[2 * e] = __builtin_bit_cast(float, v[e] << 16); z0[2 * e + 1] = __builtin_bit_cast(float, v[e] & 0xffff0000u); } }
        else {
#pragma unroll
          for (int e = 0; e < 8; ++e) z0[e] = cb ? cb[t * D + c0 + e] : 0.f; }
        float o[8];
#pragma unroll
        for (int e = 0; e < 8; ++e) o[e] = gb[e] * (cw[c0 + e] * z0[e] + cw[D + c0 + e] * z1[e] + cw[2 * D + c0 + e] * z2[e]);
        v4u w; w.x = pk2(o[0], o[1]); w.y = pk2(o[2], o[3]); w.z = pk2(o[4], o[5]); w.w = pk2(o[6], o[7]);
        *(GAS v4u*)(A2 + (size_t)row * D + c0) = w;
    }
}

__device__ __forceinline__ void final_phase(Frame& F) {
    const bf16* XBp = (const bf16*)(F.ws + WS_XB); const pg8::ssq_t* ssq = (const pg8::ssq_t*)(F.ws + WS_SSQ) + 6 * M; const float* fg = F.in[6];
    const int gw = F.ci * NWAVES + F.wave, NGW = 32 * NWAVES, lane = opaque_i(F.lane);
    f32x4 gv[4];
#pragma unroll
    for (int j = 0; j < 4; ++j) gv[j] = ((const GAS f32x4*)fg)[lane + 64 * j];
    for (int lr = gw; lr < 2048 + 128; lr += NGW) { const int m = lr < 2048 ? F.gi * 2048 + lr : MP + F.gi * 128 + (lr - 2048);
        const float rs = pg8::rstd_of(ssq[m]);
        const GAS unsigned long long* xr = (const GAS unsigned long long*)(XBp + (size_t)m * D) + lane; GAS f32x4* yo = (GAS f32x4*)(F.out + O_Y + (size_t)m * D) + lane;
#pragma unroll
        for (int j = 0; j < 4; ++j) { const unsigned long long w = xr[64 * j]; const unsigned lo = (unsigned)w, hi = (unsigned)(w >> 32);
            const f32x4 xv = {__builtin_bit_cast(float, lo << 16), __builtin_bit_cast(float, lo & 0xffff0000u), __builtin_bit_cast(float, hi << 16), __builtin_bit_cast(float, hi & 0xffff0000u)};
            yo[64 * j] = xv * rs * gv[j]; }
    }
}

struct SameOrder : pg8::StaticOrder { __device__ bool next(int i, pg8::Unit& u) const { const bool r = pg8::StaticOrder::next(i, u); u.pm = 0; u.pn = 0; return r; } };
struct Args { const float* in[21]; float* out; unsigned char* ws; int ph_lo, ph_hi; };
__global__ void __launch_bounds__(NWAVES * 64, 2) skel_fwd(Args args) {
    extern __shared__ __attribute__((aligned(16))) unsigned char lds[];
    Frame F;
    F.lds = (LAS unsigned char*)lds;
    F.MISC = (volatile LAS unsigned*)(F.lds + MISC_OFF);
    F.tid = threadIdx.x; F.lane = F.tid & 63; F.wave = __builtin_amdgcn_readfirstlane(F.tid >> 6);
    F.G = gridDim.x; { const int bx = blockIdx.x; F.vcu = (bx % 8) * (F.G / 8) + bx / 8; F.gi = bx % 8; F.ci = bx / 8; }
    F.ws = args.ws; F.out = args.out; F.ctl = (gu32*)(args.ws + WS_CTL);
#pragma unroll
    for (int i = 0; i < 21; ++i) F.in[i] = args.in[i];
    for (int u = F.tid; u < (LDS_BYTES - LDSCTL_OFF) / 4; u += NWAVES * 64) ((LAS unsigned*)(F.lds + LDSCTL_OFF))[u] = 0u;
    __syncthreads();
    XcdBarrier bar = xcd_barrier_post((unsigned*)(F.ctl + CW_BAR), F.MISC + 8, (unsigned)F.G);
    XcdBarrier gbar = xcd_barrier_post((unsigned*)(F.ctl + CW_BAR) + (1 + F.gi) * XCD_BAR_WORDS, F.MISC + 10, (unsigned)(F.G / 8));
    const int lo = args.ph_lo, hi = args.ph_hi;
#define IN(k) (lo <= (k) && (k) < hi)
#if defined(PROBE_A_LO)
#define STAMP(k) do { if (blockIdx.x == 0 && F.tid == 0) { const unsigned long long t_ = __builtin_amdgcn_s_memrealtime(); F.MISC[16 + 2 * (k)] = (unsigned)t_; F.MISC[17 + 2 * (k)] = (unsigned)(t_ >> 32); } } while (0)
#else
#define STAMP(k) do { } while (0)
#endif
    STAMP(0);
#define SEAM(k) do { if (IN((k) + 1)) { if ((k) == 0) xcd_barrier(bar); else xcd_barrier(gbar); } STAMP((k) + 1); } while (0)
    bf16* XB = (bf16*)(F.ws + WS_XB); bf16* H = (bf16*)(F.ws + WS_H); pg8::ssq_t* ssq = (pg8::ssq_t*)(F.ws + WS_SSQ);
    const int bx = (int)blockIdx.x;

    if (IN(0)) { p0_prologue(F); SEAM(0); }
#define FFN_GU(ph, f, sin) if (IN(ph)) { pg8::Gemm g{XB, (const bf16*)(F.ws + WS_WGU) + (size_t)(f) * 2 * FF * D, M, 2 * FF, D}; pg8::StaticOrder S; S.init(MP, 2 * FF, F.G, bx); \
        pg8::EpiGateUp E{H, FF, ssq + (size_t)(sin) * M}; pg8::gemm_phase<pg8::EpiGateUp, pg8::StaticOrder, true, true>(F.lds + RING_OFF, g, S, E); SEAM(ph); }
#define FFN_DN(ph, f, sout) if (IN(ph)) { pg8::Gemm g{H, (const bf16*)(F.ws + WS_WD) + (size_t)(f) * D * FF, M, D, FF}; pg8::StaticOrder S; S.init(MP, D, F.G, bx); \
        pg8::EpiResid<0> E{(ph) == 2 ? F.in[0] : nullptr, (ph) == 2 ? F.in[1] : nullptr, XB, ssq + (size_t)(sout) * M, 0.5f}; pg8::gemm_phase<pg8::EpiResid<0>, pg8::StaticOrder, true, true>(F.lds + RING_OFF, g, S, E); SEAM(ph); }
    FFN_GU(1, 0, 0)
    FFN_DN(2, 0, 1)
    if (IN(3)) { ssm_phase_pass(F, 0); xcd_barrier(gbar); ssm_phase_pass(F, 1); SEAM(3); }
    if (IN(4)) { pg8::Gemm g{(const bf16*)(F.ws + WS_G), (const bf16*)(F.ws + WS_WGLU), M, 2 * D, D}; pg8::StaticOrder S; S.init(MP, 2 * D, F.G, bx);
        pg8::EpiResid<1> E{nullptr, nullptr, XB, ssq + (size_t)2 * M, 1.0f}; pg8::gemm_phase<pg8::EpiResid<1>, pg8::StaticOrder, true, true>(F.lds + RING_OFF, g, S, E); SEAM(4); }
    FFN_GU(5, 1, 2)
    FFN_DN(6, 1, 3)
    FFN_GU(7, 2, 3)
    FFN_DN(8, 2, 4)
    if (IN(9)) { pg8::Gemm g{XB, (const bf16*)(F.ws + WS_WIN), M, 3 * D, D}; pg8::StaticOrder S; S.init(MP, 3 * D, F.G, bx);
        pg8::EpiConvIn E{(bf16*)(F.ws + WS_Z), (bf16*)(F.ws + WS_GB), ssq + (size_t)4 * M, F.out + O_CP, F.out + O_CS};
        pg8::gemm_phase<pg8::EpiConvIn, pg8::StaticOrder, true, true>(F.lds + RING_OFF, g, S, E); SEAM(9); }
    if (IN(10)) { conv_phase(F); SEAM(10); }
    if (IN(11)) { pg8::Gemm g{(const bf16*)(F.ws + WS_A2), (const bf16*)(F.ws + WS_WOUT), M, D, D}; pg8::StaticOrder S; S.init(MP, D, F.G, bx);
        pg8::EpiResid<0> E{nullptr, nullptr, XB, ssq + (size_t)5 * M, 1.0f}; pg8::gemm_phase<pg8::EpiResid<0>, pg8::StaticOrder, true, true>(F.lds + RING_OFF, g, S, E); SEAM(11); }
    FFN_GU(12, 3, 5)
    FFN_DN(13, 3, 6)
    if (IN(14)) { final_phase(F); }
#if defined(PROBE_DRY)
#ifndef PROBE_VARIANT
#define PROBE_VARIANT 0
#endif
    xcd_barrier(gbar); STAMP(15); if (blockIdx.x == 0 && F.tid == 0) { const unsigned long long c_ = __builtin_amdgcn_s_memtime(); F.MISC[60] = (unsigned)c_; F.MISC[61] = (unsigned)(c_ >> 32); }
#if PROBE_DRY == 2
    { pg8::Gemm g{XB, (const bf16*)(F.ws + WS_WGU), M, 2 * FF, D}; SameOrder S; S.init(MP, 2 * FF, F.G, bx);
      pg8::EpiNull E{H + (size_t)M * FF - 1}; pg8::gemm_phase<pg8::EpiNull, SameOrder, true, true>(F.lds + RING_OFF, g, S, E); }
#else
    { pg8::Gemm g{XB, (const bf16*)(F.ws + WS_WGU), M, 2 * FF, D}; pg8::StaticOrder S; S.init(MP, 2 * FF, F.G, bx);
      pg8::EpiNull E{H + (size_t)M * FF - 1}; pg8::gemm_phase<pg8::EpiNull, pg8::StaticOrder, true, true, PROBE_VARIANT>(F.lds + RING_OFF, g, S, E); }
#endif
    xcd_barrier(gbar); STAMP(16); if (blockIdx.x == 0 && F.tid == 0) { const unsigned long long c_ = __builtin_amdgcn_s_memtime(); F.MISC[62] = (unsigned)c_; F.MISC[63] = (unsigned)(c_ >> 32); }
#endif
#if defined(PROBE_A_LO)
    __syncthreads();
    if (blockIdx.x == 0 && F.tid == 0) {
#if !defined(PROBE_DRY)
        STAMP(15);
#endif
#define TS(k) ((unsigned long long)F.MISC[16 + 2 * (k)] | ((unsigned long long)F.MISC[17 + 2 * (k)] << 32))
        const unsigned long long ta = TS(PROBE_A_HI) - TS(PROBE_A_LO), tb = TS(PROBE_B_HI) - TS(PROBE_B_LO);
#if defined(PROBE_CLOCK)
        { const unsigned long long c0 = (unsigned long long)F.MISC[60] | ((unsigned long long)F.MISC[61] << 32), c1 = (unsigned long long)F.MISC[62] | ((unsigned long long)F.MISC[63] << 32);
          F.out[0] += (float)(c1 - c0) / (float)(TS(16) - TS(15)) * 1e-2f; }
#else
        F.out[0] += (float)tb * 1e-5f;
#endif
        const unsigned long long t0 = __builtin_amdgcn_s_memrealtime();
        const unsigned long long spin = ta * 4ull < 1000000ull ? ta * 4ull : 1000000ull;
        while (__builtin_amdgcn_s_memrealtime() - t0 < spin) __builtin_amdgcn_s_sleep(8);
    }
#endif
#undef IN
#undef SEAM
}

extern "C" void kernel_launch(void* const* d_in, const int* in_sizes, int n_in, void* d_out, int out_size, void* d_ws, size_t ws_size, hipStream_t stream) {
    static int grid = 0;
    if (grid == 0) {
        if (n_in != 21 || out_size != (int)O_END || ws_size < WS_END) { fprintf(stderr, "kernel_launch: unexpected shapes: n_in %d out %d ws %zu; nothing launched\n", n_in, out_size, ws_size); grid = -1; return; }
        int dev = 0, cus = 0, per_cu = 0;
        if (hipGetDevice(&dev) != hipSuccess || hipDeviceGetAttribute(&cus, hipDeviceAttributeMultiprocessorCount, dev) != hipSuccess) { grid = -1; return; }
        if (hipFuncSetAttribute((const void*)skel_fwd, hipFuncAttributeMaxDynamicSharedMemorySize, LDS_BYTES) != hipSuccess) { fprintf(stderr, "kernel_launch: hipFuncSetAttribute failed\n"); grid = -1; return; }
        if (hipOccupancyMaxActiveBlocksPerMultiprocessor(&per_cu, (const void*)skel_fwd, NWAVES * 64, LDS_BYTES) != hipSuccess || per_cu < 1) fprintf(stderr, "kernel_launch: occupancy query reports %d\n", per_cu);
        (void)hipGetLastError();
        if (cus < 256) { fprintf(stderr, "kernel_launch: built for a 256-CU device (8 groups x 32 workgroups), found %d CUs; nothing launched\n", cus); grid = -1; return; }
        grid = 256;
    }
    if (grid < 0) return;
    if (hipMemsetAsync((char*)d_ws + WS_CTL, 0, CTL_ZERO_BYTES, stream) != hipSuccess) return;
    Args a{};
    for (int i = 0; i < 21; ++i) a.in[i] = (const float*)d_in[i];
    a.out = (float*)d_out; a.ws = (unsigned char*)d_ws;
    a.ph_lo = 0; a.ph_hi = N_PHASES;
    hipLaunchKernelGGL(skel_fwd, dim3(grid), dim3(NWAVES * 64), LDS_BYTES, stream, a);
}
```

```cpp
#include <hip/hip_runtime.h>
#include <cstdio>
#include <cstdint>
namespace pg8 {
#define PG8_LAS __attribute__((address_space(3)))
typedef unsigned short bf16_t;
typedef short bf16x8 __attribute__((ext_vector_type(8)));
typedef float f32x4 __attribute__((ext_vector_type(4)));
typedef unsigned u32x4 __attribute__((ext_vector_type(4)));
constexpr int BM = 256, BK = 64, HALF = 128, HTB = HALF * BK * 2  , STAGE_BYTES = 8 * HTB, NXCD = 8, WGM = 8;

__host__ __device__ __forceinline__ int lds_byte(int r, int c) { const int st = (r >> 4) * 2 + (c >> 5), rr = r & 15, cc = c & 31, ob = rr * 64 + cc * 2; return st * 1024 + (ob ^ (((ob >> 9) & 1) << 5)); }
__host__ __device__ __forceinline__ void stage_rc(int b, int& R, int& C) { const int st = b / 1024, sb = b % 1024, swz = sb ^ (((sb >> 9) & 1) << 5); R = (st >> 1) * 16 + swz / 64; C = (st & 1) * 32 + (swz % 64) / 2; }
__host__ __device__ __forceinline__ int perm32(int rho) { const int n = rho >> 4, i = rho & 15; return 8 * (i >> 2) + 4 * n + (i & 3); }

struct Unit { int pm, pn; };
struct Gemm { const bf16_t* A; const bf16_t* Bt; int M, N, K; };

struct StaticOrder {
    int nM, nN, nwg, G, c;
    __host__ __device__ void init(int M, int N, int G_, int c_) { nM = M / BM; nN = N / BM; nwg = nM * nN; G = G_; c = c_; }
    __host__ __device__ bool next(int i, Unit& u) const {
        const long L = (long)i * G + c; if (L >= nwg) return false;
        int wgid = (int)L; { const int q = nwg / NXCD, r = nwg % NXCD, xcd = wgid % NXCD, off = wgid / NXCD; wgid = (xcd < r ? xcd * (q + 1) : r * (q + 1) + (xcd - r) * q) + off; }
        const int nig = WGM * nN, gid = wgid / nig, fm = gid * WGM, gsz = (nM - fm) < WGM ? (nM - fm) : WGM;
        u.pm = fm + ((wgid % nig) % gsz); u.pn = (wgid % nig) / gsz; return true;
    }
    __device__ __forceinline__ void a_ready(const Unit&) const {}
    __device__ __forceinline__ void done(const Unit&) const {}
};


__device__ __forceinline__ unsigned cvt_pk_bf16(float lo, float hi) { unsigned r; asm volatile("v_cvt_pk_bf16_f32 %0, %1, %2" : "=v"(r) : "v"(lo), "v"(hi)); return r; }

typedef unsigned u32x2 __attribute__((ext_vector_type(2)));
constexpr float RMS_EPS = 1e-6f;
constexpr float INV_D = 1.0f / 1024.0f;
__device__ __forceinline__ float sigmoid_f(float x) { return __builtin_amdgcn_rcpf(1.0f + __builtin_amdgcn_exp2f(-1.4426950408889634f * x)); }
typedef unsigned long long ssq_t;
constexpr float SSQ_SCALE = 16777216.0f, SSQ_INV = 1.0f / 16777216.0f;
__device__ __forceinline__ ssq_t ssq_fix(float s) { return (ssq_t)(s * SSQ_SCALE + 0.5f); }
__device__ __forceinline__ float rstd_of(ssq_t q) { return __builtin_amdgcn_rsqf((float)q * (SSQ_INV * INV_D) + RMS_EPS); }
#define PG8_EPI_CALL() \
    __device__ __forceinline__ void operator()(const f32x4 (&acc)[2][2][4][2], const Unit& u, int wr, int wc, int fr, int fq) const { \
        _Pragma("unroll") for (int ai = 0; ai < 2; ++ai) _Pragma("unroll") for (int m = 0; m < 4; ++m) { \
            const f32x4 a[2][2] = {{acc[ai][0][m][0], acc[ai][0][m][1]}, {acc[ai][1][m][0], acc[ai][1][m][1]}}; rg(a, u, ai, m, 3, wr, wc, fr, fq); } }

struct EpiGateUp {
    static constexpr bool PERM = true, AFTER_DRAIN = false;
    bf16_t* H; int ldh; const ssq_t* ssq;
    __device__ __forceinline__ void rg(const f32x4 (&a)[2][2], const Unit& u, int ai, int m, int bjmask, int wr, int wc, int fr, int fq) const {
        const int row = u.pm * BM + ai * HALF + wr * 64 + m * 16 + fr, col0 = u.pn * HALF + wc * 32 + 8 * fq;
        const float rs = rstd_of(ssq[row]);
        float h[8];
#pragma unroll
        for (int n = 0; n < 2; ++n)
#pragma unroll
            for (int e = 0; e < 4; ++e) { const float g = a[0][n][e] * rs, up = a[1][n][e] * rs; h[4 * n + e] = g * sigmoid_f(g) * up; }
        u32x4 w; w.x = cvt_pk_bf16(h[0], h[1]); w.y = cvt_pk_bf16(h[2], h[3]); w.z = cvt_pk_bf16(h[4], h[5]); w.w = cvt_pk_bf16(h[6], h[7]);
        *(u32x4*)(H + (size_t)row * ldh + col0) = w;
    }
    __device__ __forceinline__ void rgx(const f32x4 (&ax)[2], const Unit& u, int wr, int wc, int fr, int fq) const {
        const int row = 16384 + 16 * u.pm + fr, col0 = u.pn * HALF + wc * 32 + 8 * fq + 4 * wr;
        const float rs = rstd_of(ssq[row]);
        float h[4];
#pragma unroll
        for (int e = 0; e < 4; ++e) { const float g = ax[0][e] * rs, up = ax[1][e] * rs; h[e] = g * sigmoid_f(g) * up; }
        u32x2 w; w.x = cvt_pk_bf16(h[0], h[1]); w.y = cvt_pk_bf16(h[2], h[3]);
        *(u32x2*)(H + (size_t)row * ldh + col0) = w;
    }
    PG8_EPI_CALL()
};

__device__ __forceinline__ void unpack8(const u32x4 w, float (&x)[8]) {
#pragma unroll
    for (int e = 0; e < 4; ++e) { x[2 * e] = __builtin_bit_cast(float, w[e] << 16); x[2 * e + 1] = __builtin_bit_cast(float, w[e] & 0xffff0000u); } }
template <int MODE> struct EpiResid {
    static constexpr bool PERM = true, AFTER_DRAIN = false;
    const float* xin_p; const float* xin_s; bf16_t* XB; ssq_t* ssq; float scale;
    __device__ __forceinline__ void rg(const f32x4 (&a)[2][2], const Unit& u, int ai, int m, int bjmask, int wr, int wc, int fr, int fq) const {
        const int row = u.pm * BM + ai * HALF + wr * 64 + m * 16 + fr;
        const int col0 = (MODE == 0 ? u.pn * BM : u.pn * HALF) + wc * 32 + 8 * fq;
        float sq = 0.f;
#pragma unroll
        for (int bj = 0; bj < (MODE == 0 ? 2 : 1); ++bj) {
            bf16_t* xp = XB + (size_t)row * 1024 + col0 + bj * HALF;
            float x[8];
            if (xin_p) { const float* xi = xin_p + (size_t)row * 1024 + col0 + bj * HALF; const f32x4 x0 = *(const f32x4*)xi, x1 = *(const f32x4*)(xi + 4);
#pragma unroll
                for (int e = 0; e < 4; ++e) { x[e] = x0[e]; x[4 + e] = x1[e]; } }
            else unpack8(*(const u32x4*)xp, x);
#pragma unroll
            for (int e = 0; e < 4; ++e) {
                if (MODE == 0) { x[e] += a[bj][0][e] * scale; x[4 + e] += a[bj][1][e] * scale; }
                else { x[e] += a[0][0][e] * sigmoid_f(a[1][0][e]); x[4 + e] += a[0][1][e] * sigmoid_f(a[1][1][e]); } }
            u32x4 w; w.x = cvt_pk_bf16(x[0], x[1]); w.y = cvt_pk_bf16(x[2], x[3]); w.z = cvt_pk_bf16(x[4], x[5]); w.w = cvt_pk_bf16(x[6], x[7]);
            *(u32x4*)xp = w;
            sq += (x[0] * x[0] + x[1] * x[1]) + (x[2] * x[2] + x[3] * x[3]) + (x[4] * x[4] + x[5] * x[5]) + (x[6] * x[6] + x[7] * x[7]); }
        sq += __shfl_xor(sq, 16); sq += __shfl_xor(sq, 32);
        if (fq == 0) atomicAdd(ssq + row, ssq_fix(sq));
    }
    __device__ __forceinline__ void rgx(const f32x4 (&ax)[2], const Unit& u, int wr, int wc, int fr, int fq) const {
        const int r2 = 16 * u.pm + fr, row = 16384 + r2;
        const int col0 = (MODE == 0 ? u.pn * BM : u.pn * HALF) + wc * 32 + 8 * fq + 4 * wr;
        float sq = 0.f;
#pragma unroll
        for (int bj = 0; bj < (MODE == 0 ? 2 : 1); ++bj) {
            bf16_t* xp = XB + (size_t)row * 1024 + col0 + bj * HALF;
            f32x4 x0;
            if (xin_s) x0 = *(const f32x4*)(xin_s + (size_t)r2 * 1024 + col0 + bj * HALF);
            else { const u32x2 w = *(const u32x2*)xp; x0[0] = __builtin_bit_cast(float, w.x << 16); x0[1] = __builtin_bit_cast(float, w.x & 0xffff0000u); x0[2] = __builtin_bit_cast(float, w.y << 16); x0[3] = __builtin_bit_cast(float, w.y & 0xffff0000u); }
            if (MODE == 0) x0 += ax[bj] * scale;
            else {
#pragma unroll
                for (int e = 0; e < 4; ++e) x0[e] += ax[0][e] * sigmoid_f(ax[1][e]); }
            u32x2 w; w.x = cvt_pk_bf16(x0[0], x0[1]); w.y = cvt_pk_bf16(x0[2], x0[3]);
            *(u32x2*)xp = w;
            sq += (x0[0] * x0[0] + x0[1] * x0[1]) + (x0[2] * x0[2] + x0[3] * x0[3]); }
        sq += __shfl_xor(sq, 16); sq += __shfl_xor(sq, 32);
        if (fq == 0) atomicAdd(ssq + row, ssq_fix(sq));
    }
    PG8_EPI_CALL()
};

struct EpiConvIn {
    static constexpr bool PERM = true, AFTER_DRAIN = false;
    bf16_t* Z; bf16_t* GB; const ssq_t* ssq; float* conv_p; float* conv_s;
    __device__ __forceinline__ void rg(const f32x4 (&a)[2][2], const Unit& u, int ai, int m, int bjmask, int wr, int wc, int fr, int fq) const {
        const int row = u.pm * BM + ai * HALF + wr * 64 + m * 16 + fr;
        const float rs = rstd_of(ssq[row]);
        if (u.pn < 8) {
            const int col0 = u.pn * HALF + wc * 32 + 8 * fq; const float rs2 = rs * rs;
            const f32x4 z0 = a[0][0] * a[1][0] * rs2, z1 = a[0][1] * a[1][1] * rs2;
            u32x4 w; w.x = cvt_pk_bf16(z0[0], z0[1]); w.y = cvt_pk_bf16(z0[2], z0[3]); w.z = cvt_pk_bf16(z1[0], z1[1]); w.w = cvt_pk_bf16(z1[2], z1[3]);
            *(u32x4*)(Z + (size_t)row * 1024 + col0) = w;
            float* cp = nullptr;
            if (row < 16384) { const int t = row & 2047; if (t >= 2046) cp = conv_p + ((size_t)(row >> 11) * 2 + (t - 2046)) * 1024 + col0; }
            else { const int r2 = row - 16384, t = r2 & 7; if (t >= 6) cp = conv_s + ((size_t)(r2 >> 3) * 2 + (t - 6)) * 1024 + col0; }
            if (cp) { *(f32x4*)cp = z0; *(f32x4*)(cp + 4) = z1; }
        } else {
            const int col0 = (u.pn - 8) * BM + wc * 32 + 8 * fq;
#pragma unroll
            for (int bj = 0; bj < 2; ++bj) { const f32x4 g0 = a[bj][0] * rs, g1 = a[bj][1] * rs;
                u32x4 w; w.x = cvt_pk_bf16(g0[0], g0[1]); w.y = cvt_pk_bf16(g0[2], g0[3]); w.z = cvt_pk_bf16(g1[0], g1[1]); w.w = cvt_pk_bf16(g1[2], g1[3]);
                *(u32x4*)(GB + (size_t)row * 1024 + col0 + bj * HALF) = w; }
        }
    }
    __device__ __forceinline__ void rgx(const f32x4 (&ax)[2], const Unit& u, int wr, int wc, int fr, int fq) const {
        const int r2 = 16 * u.pm + fr, row = 16384 + r2;
        const float rs = rstd_of(ssq[row]);
        if (u.pn < 8) {
            const int col0 = u.pn * HALF + wc * 32 + 8 * fq + 4 * wr;
            const f32x4 z0 = ax[0] * ax[1] * (rs * rs);
            u32x2 w; w.x = cvt_pk_bf16(z0[0], z0[1]); w.y = cvt_pk_bf16(z0[2], z0[3]);
            *(u32x2*)(Z + (size_t)row * 1024 + col0) = w;
            const int t = r2 & 7;
            if (t >= 6) *(f32x4*)(conv_s + ((size_t)(r2 >> 3) * 2 + (t - 6)) * 1024 + col0) = z0;
        } else {
            const int col0 = (u.pn - 8) * BM + wc * 32 + 8 * fq + 4 * wr;
#pragma unroll
            for (int bj = 0; bj < 2; ++bj) { const f32x4 g0 = ax[bj] * rs;
                u32x2 w; w.x = cvt_pk_bf16(g0[0], g0[1]); w.y = cvt_pk_bf16(g0[2], g0[3]);
                *(u32x2*)(GB + (size_t)row * 1024 + col0 + bj * HALF) = w; }
        }
    }
    PG8_EPI_CALL()
};

struct EpiNull {
    static constexpr bool PERM = true, AFTER_DRAIN = false;
    bf16_t* sink;
    __device__ __forceinline__ void rg(const f32x4 (&a)[2][2], const Unit& u, int ai, int m, int bjmask, int wr, int wc, int fr, int fq) const {
        asm volatile("" :: "v"(a[0][0]), "v"(a[0][1]), "v"(a[1][0]), "v"(a[1][1]));
    }
    __device__ __forceinline__ void rgx(const f32x4 (&ax)[2], const Unit& u, int wr, int wc, int fr, int fq) const { asm volatile("" :: "v"(ax[0]), "v"(ax[1])); }
    PG8_EPI_CALL()
};

template <class Epi, class Sched, bool ALIGN_EPI = false, bool SP2 = false, int PROBE = 0>
__device__ __forceinline__ void gemm_phase(PG8_LAS unsigned char* lds, const Gemm g, const Sched& S, const Epi& E) {
    int tid_ = threadIdx.x; asm volatile("" : "+v"(tid_));
    const int tid = tid_, wid = __builtin_amdgcn_readfirstlane(tid >> 6), lane = tid & 63, wr = wid >> 2, wc = wid & 3, fr = lane & 15, fq = lane >> 4;
    const int K = g.K, nt = K / BK;
    constexpr int XROW0 = 16384, XR = 16;
    unsigned voffA[2], voffB[2];
#pragma unroll
    for (int i = 0; i < 2; ++i) { int R, C; stage_rc(tid * 16 + i * 8192, R, C); const int Rb = Epi::PERM ? ((R & ~31) + perm32(R & 31)) : R;
        voffA[i] = (unsigned)(R * K + C) * 2u; voffB[i] = (unsigned)(Rb * K + C) * 2u; }
    unsigned voffX; { const int p = (wid & 3) * 1024 + lane * 16, bq = p >> 11, q = p & 2047, row = q >> 7, kb = (q & 127) ^ (((row >> 1) & 7) << 4); voffX = (unsigned)(row * K * 2 + bq * 128 + kb); }
    int xoff0 = fr * 128 + ((fq * 16) ^ (((fr >> 1) & 7) << 4)), xoff1 = fr * 128 + ((64 + fq * 16) ^ (((fr >> 1) & 7) << 4));
    unsigned xpw = 4096;
    const unsigned kstep = (unsigned)(BK * 2);
    const unsigned hstep = (unsigned)HALF * K * 2;
    const unsigned tstep = 2 * hstep;
    const __amdgpu_buffer_rsrc_t rsA = __builtin_amdgcn_make_buffer_rsrc((void*)g.A, 0, 0x7ffff000, 0x00020000), rsB = __builtin_amdgcn_make_buffer_rsrc((void*)g.Bt, 0, 0x7ffff000, 0x00020000);
    const unsigned ldsw = (unsigned)wid * 1024u;
    const int aoff = lds_byte(wr * 64 + fr, fq * 8), boff = lds_byte(wc * 32 + fr, fq * 8);
#define PG8_SA(b, h) (((b) * 2 + (h)) * HTB)
#define PG8_SB(b, h) ((4 + (b) * 2 + (h)) * HTB)
#define PG8_SX(b) (STAGE_BYTES + (b) * 2048)
#define PG8_STAGEXP(soff) do { if constexpr ((PROBE & (6 | 16)) == 0) { if (wr == 0) __builtin_amdgcn_raw_ptr_buffer_load_lds(rsA, (PG8_LAS unsigned*)(lds + STAGE_BYTES + xpw + wid * 1024), 16, voffX, (soff), 0, 0); } } while (0)
#define PG8_LDAX(dst, b) do { if constexpr ((PROBE & (10 | 32)) == 0) { dst[0] = *(const PG8_LAS bf16x8*)(lds + PG8_SX(b) + xoff0); dst[1] = *(const PG8_LAS bf16x8*)(lds + PG8_SX(b) + xoff1); } } while (0)
#define PG8_WAIT_LT(nl, nt) do { if (wr == 0) PG8_WAIT_V(nl); else PG8_WAIT_V(nt); } while (0)
#define PG8_MMAX_NULL() do { asm volatile("" :: "v"(Ax[0]), "v"(Ax[1])); } while (0)
#define PG8_MMAX_REAL() do { if (wr == 0) { _Pragma("unroll") for (int k = 0; k < 2; ++k) { accx[0] = __builtin_amdgcn_mfma_f32_16x16x32_bf16(B0[0][k], Ax[k], accx[0], 0, 0, 0); accx[1] = __builtin_amdgcn_mfma_f32_16x16x32_bf16(B1[0][k], Ax[k], accx[1], 0, 0, 0); } } \
        else { _Pragma("unroll") for (int k = 0; k < 2; ++k) { accx[0] = __builtin_amdgcn_mfma_f32_16x16x32_bf16(B0[1][k], Ax[k], accx[0], 0, 0, 0); accx[1] = __builtin_amdgcn_mfma_f32_16x16x32_bf16(B1[1][k], Ax[k], accx[1], 0, 0, 0); } } } while (0)
#define PG8_MMAX() do { if constexpr ((PROBE & (2 | 32)) != 0) { } else if constexpr ((PROBE & 1) != 0) PG8_MMAX_NULL(); else PG8_MMAX_REAL(); } while (0)
#define PG8_STAGEA(bufoff, soff) do { if constexpr ((PROBE & 4) == 0) _Pragma("unroll") for (int _i = 0; _i < 2; ++_i) \
        __builtin_amdgcn_raw_ptr_buffer_load_lds(rsA, (PG8_LAS unsigned*)(lds + (bufoff) + ldsw + _i * 8192), 16, voffA[_i], (soff), 0, 0); } while (0)
#define PG8_STAGEB(bufoff, soff) do { if constexpr ((PROBE & 4) == 0) _Pragma("unroll") for (int _i = 0; _i < 2; ++_i) \
        __builtin_amdgcn_raw_ptr_buffer_load_lds(rsB, (PG8_LAS unsigned*)(lds + (bufoff) + ldsw + _i * 8192), 16, voffB[_i], (soff), 0, 0); } while (0)
#define PG8_LDA(dst, b, h) do { if constexpr ((PROBE & 8) == 0) { _Pragma("unroll") for (int m = 0; m < 4; ++m) _Pragma("unroll") for (int k = 0; k < 2; ++k) dst[m][k] = *(const PG8_LAS bf16x8*)(lds + PG8_SA(b, h) + aoff + m * 2048 + k * 1024); } } while (0)
#define PG8_LDB(dst, b, h) do { if constexpr ((PROBE & 8) == 0) { _Pragma("unroll") for (int n = 0; n < 2; ++n) _Pragma("unroll") for (int k = 0; k < 2; ++k) dst[n][k] = *(const PG8_LAS bf16x8*)(lds + PG8_SB(b, h) + boff + n * 2048 + k * 1024); } } while (0)
#define PG8_MMA_NULL(ai, bj, At, Bt) do { _Pragma("unroll") for (int m = 0; m < 4; ++m) _Pragma("unroll") for (int k = 0; k < 2; ++k) asm volatile("" :: "v"(At[m][k])); _Pragma("unroll") for (int n = 0; n < 2; ++n) _Pragma("unroll") for (int k = 0; k < 2; ++k) asm volatile("" :: "v"(Bt[n][k])); } while (0)
#define PG8_MMA_REAL(ai, bj, At, Bt) do { __builtin_amdgcn_s_setprio(1); _Pragma("unroll") for (int m = 0; m < 4; ++m) _Pragma("unroll") for (int n = 0; n < 2; ++n) _Pragma("unroll") for (int k = 0; k < 2; ++k) \
        acc[ai][bj][m][n] = __builtin_amdgcn_mfma_f32_16x16x32_bf16(Bt[n][k], At[m][k], acc[ai][bj][m][n], 0, 0, 0); __builtin_amdgcn_s_setprio(0); } while (0)
#define PG8_MMA(ai, bj, At, Bt) do { if constexpr ((PROBE & 1) != 0) PG8_MMA_NULL(ai, bj, At, Bt); else PG8_MMA_REAL(ai, bj, At, Bt); } while (0)
#define PG8_WAIT_V(n) asm volatile("s_waitcnt vmcnt(" #n ")" ::: "memory")
#define PG8_WAIT_L(n) asm volatile("s_waitcnt lgkmcnt(" #n ")" ::: "memory")
#define PG8_BAR __builtin_amdgcn_s_barrier()
#define PG8_SCHED __builtin_amdgcn_sched_barrier(0)
    Unit cur, nxt; int ui = 0;
    if (!S.next(0, cur)) return;
    f32x4 acc[2][2][4][2];
#pragma unroll
    for (int a = 0; a < 2; ++a)
#pragma unroll
        for (int b = 0; b < 2; ++b)
#pragma unroll
            for (int m = 0; m < 4; ++m)
#pragma unroll
                for (int n = 0; n < 2; ++n) acc[a][b][m][n] = (f32x4){0.f, 0.f, 0.f, 0.f};
    bf16x8 At[4][2], B0[2][2], B1[2][2], Ax[2];
    if constexpr ((PROBE & 8) != 0) {
#pragma unroll
        for (int m = 0; m < 4; ++m)
#pragma unroll
            for (int k = 0; k < 2; ++k) asm volatile("" : "=v"(At[m][k]));
#pragma unroll
        for (int n = 0; n < 2; ++n)
#pragma unroll
            for (int k = 0; k < 2; ++k) { asm volatile("" : "=v"(B0[n][k])); asm volatile("" : "=v"(B1[n][k])); }
        asm volatile("" : "=v"(Ax[0])); asm volatile("" : "=v"(Ax[1])); }
    f32x4 accx[2] = {(f32x4){0.f, 0.f, 0.f, 0.f}, (f32x4){0.f, 0.f, 0.f, 0.f}};
    unsigned cA = (unsigned)cur.pm * tstep, cB = (unsigned)cur.pn * tstep;
    const unsigned xstep = (unsigned)XR * K * 2, xbase = (unsigned)XROW0 * K * 2; unsigned cX = xbase + (unsigned)cur.pm * xstep;
    S.a_ready(cur);
    if constexpr (SP2) {
        PG8_STAGEB(PG8_SB(0, 0), cB); PG8_STAGEB(PG8_SB(0, 1), cB + hstep); PG8_STAGEA(PG8_SA(0, 0), cA); { const unsigned keep_ = xpw; xpw = 0; PG8_STAGEXP(cX); xpw = keep_; } PG8_STAGEA(PG8_SA(0, 1), cA + hstep);
        if (wr == 1) PG8_BAR;
        PG8_WAIT_V(2); PG8_BAR;
        PG8_STAGEB(PG8_SB(1, 0), cB + kstep); PG8_STAGEA(PG8_SA(1, 0), cA + kstep); PG8_STAGEB(PG8_SB(1, 1), cB + hstep + kstep);
        PG8_WAIT_V(6); PG8_BAR;
    } else {
        PG8_STAGEB(PG8_SB(0, 0), cB); PG8_STAGEA(PG8_SA(0, 0), cA); PG8_STAGEB(PG8_SB(0, 1), cB + hstep); PG8_STAGEA(PG8_SA(0, 1), cA + hstep);
        if (wr == 1) PG8_BAR;
        PG8_WAIT_V(4); PG8_BAR;
        PG8_STAGEB(PG8_SB(1, 0), cB + kstep); PG8_STAGEA(PG8_SA(1, 0), cA + kstep); PG8_STAGEB(PG8_SB(1, 1), cB + hstep + kstep);
        PG8_WAIT_V(6); PG8_BAR;
    }
    for (;;) {
        const bool has_next = S.next(ui + 1, nxt);
        const unsigned nA = has_next ? (unsigned)nxt.pm * tstep : cA, nB = has_next ? (unsigned)nxt.pn * tstep : cB, nX = has_next ? xbase + (unsigned)nxt.pm * xstep : cX;
        for (int t = 0; t < nt; t += 2) {
            const bool last = (t == nt - 2);
            const unsigned a1 = cA + (unsigned)(t + 1) * kstep;
            const unsigned a2 = last ? nA : cA + (unsigned)(t + 2) * kstep, b2 = last ? nB : cB + (unsigned)(t + 2) * kstep;
            const unsigned a3 = a2 + kstep, b3 = b2 + kstep, x2 = last ? nX : cX + (unsigned)(t + 2) * kstep;
            if (last && has_next) S.a_ready(nxt);
            if constexpr (SP2) {
            PG8_LDB(B0, 0, 0); PG8_LDB(B1, 0, 1); PG8_SCHED; PG8_LDA(At, 0, 0); PG8_LDAX(Ax, 0); PG8_STAGEXP(x2); PG8_STAGEA(PG8_SA(1, 1), a1 + hstep);
            PG8_WAIT_LT(9, 8); PG8_WAIT_L(0); PG8_BAR; PG8_MMA(0, 0, At, B0); PG8_MMA(0, 1, At, B1); PG8_MMAX(); PG8_BAR; PG8_SCHED;
            PG8_LDA(At, 0, 1); PG8_STAGEB(PG8_SB(0, 0), b2); PG8_STAGEB(PG8_SB(0, 1), b2 + hstep); PG8_STAGEA(PG8_SA(0, 0), a2);
            PG8_WAIT_LT(9, 8); PG8_WAIT_L(0); PG8_BAR; PG8_MMA(1, 0, At, B0); PG8_MMA(1, 1, At, B1); PG8_BAR; PG8_SCHED;
            PG8_LDB(B0, 1, 0); PG8_LDB(B1, 1, 1); PG8_SCHED; PG8_LDA(At, 1, 0); PG8_LDAX(Ax, 1); PG8_STAGEA(PG8_SA(0, 1), a2 + hstep);
            PG8_WAIT_V(8); PG8_WAIT_L(0); PG8_BAR; PG8_MMA(0, 0, At, B0); PG8_MMA(0, 1, At, B1); PG8_MMAX(); PG8_BAR; PG8_SCHED;
            PG8_LDA(At, 1, 1); PG8_STAGEB(PG8_SB(1, 0), b3); PG8_STAGEB(PG8_SB(1, 1), b3 + hstep); PG8_STAGEA(PG8_SA(1, 0), a3);
            PG8_WAIT_V(8); PG8_WAIT_L(0); PG8_BAR; PG8_MMA(1, 0, At, B0); PG8_MMA(1, 1, At, B1); PG8_BAR; PG8_SCHED;
            xpw ^= 4096u; xoff0 ^= 4096; xoff1 ^= 4096;
            } else {
            PG8_LDB(B0, 0, 0); PG8_SCHED; PG8_LDA(At, 0, 0); PG8_STAGEA(PG8_SA(1, 1), a1 + hstep);
            PG8_WAIT_L(8); PG8_BAR; PG8_WAIT_L(0); PG8_MMA(0, 0, At, B0); PG8_BAR; PG8_SCHED;
            PG8_LDB(B1, 0, 1); PG8_STAGEB(PG8_SB(0, 0), b2);
            PG8_BAR; PG8_WAIT_L(0); PG8_MMA(0, 1, At, B1); PG8_BAR;
            PG8_LDA(At, 0, 1); PG8_STAGEA(PG8_SA(0, 0), a2);
            PG8_BAR; PG8_WAIT_L(0); PG8_MMA(1, 0, At, B0); PG8_BAR; PG8_SCHED;
            PG8_STAGEB(PG8_SB(0, 1), b2 + hstep);
            PG8_WAIT_V(6); PG8_BAR; PG8_MMA(1, 1, At, B1); PG8_BAR;
            PG8_LDB(B0, 1, 0); PG8_SCHED; PG8_LDA(At, 1, 0); PG8_STAGEA(PG8_SA(0, 1), a2 + hstep);
            PG8_WAIT_L(8); PG8_BAR; PG8_WAIT_L(0); PG8_MMA(0, 0, At, B0); PG8_BAR; PG8_SCHED;
            PG8_LDB(B1, 1, 1); PG8_STAGEB(PG8_SB(1, 0), b3);
            PG8_BAR; PG8_WAIT_L(0); PG8_MMA(0, 1, At, B1); PG8_BAR;
            PG8_LDA(At, 1, 1); PG8_STAGEA(PG8_SA(1, 0), a3);
            PG8_BAR; PG8_WAIT_L(0); PG8_MMA(1, 0, At, B0); PG8_BAR; PG8_SCHED;
            PG8_STAGEB(PG8_SB(1, 1), b3 + hstep);
            PG8_WAIT_V(6); PG8_BAR; PG8_MMA(1, 1, At, B1); PG8_BAR;
            }
        }
        if constexpr (ALIGN_EPI) { if (wr == 0) PG8_BAR; }
        E(acc, cur, wr, wc, fr, fq); E.rgx(accx, cur, wr, wc, fr, fq);
        if (!has_next) break;
#pragma unroll
        for (int a = 0; a < 2; ++a)
#pragma unroll
            for (int b = 0; b < 2; ++b)
#pragma unroll
                for (int m = 0; m < 4; ++m)
#pragma unroll
                    for (int n = 0; n < 2; ++n) acc[a][b][m][n] = (f32x4){0.f, 0.f, 0.f, 0.f};
        accx[0] = (f32x4){0.f, 0.f, 0.f, 0.f}; accx[1] = (f32x4){0.f, 0.f, 0.f, 0.f};
        cur = nxt; cA = nA; cB = nB; cX = nX; ++ui;
        if constexpr (ALIGN_EPI) { if (wr == 1) PG8_BAR; }
    }
    PG8_WAIT_V(0);
    if constexpr (!ALIGN_EPI) { if (wr == 0) PG8_BAR; }
    PG8_BAR;
#undef PG8_SA
#undef PG8_SB
#undef PG8_STAGEA
#undef PG8_STAGEB
#undef PG8_SX
#undef PG8_STAGEXP
#undef PG8_WAIT_LT
#undef PG8_LDAX
#undef PG8_MMAX
#undef PG8_LDA
#undef PG8_LDB
#undef PG8_MMA
#undef PG8_WAIT_V
#undef PG8_WAIT_L
#undef PG8_BAR
#undef PG8_SCHED
}
}

#define GAS __attribute__((address_space(1)))
#define LAS __attribute__((address_space(3)))
typedef unsigned short bf16;
typedef unsigned v4u __attribute__((ext_vector_type(4)));
typedef float f32x4 __attribute__((ext_vector_type(4)));
typedef short bf16x8 __attribute__((ext_vector_type(8)));
typedef GAS unsigned gu32;
typedef GAS unsigned long long gu64;
#define RLX_AGENT __ATOMIC_RELAXED, __HIP_MEMORY_SCOPE_AGENT
#define LDS_WAIT() asm volatile("s_waitcnt lgkmcnt(0)" ::: "memory")
#define VM_WAIT() asm volatile("s_waitcnt vmcnt(0)" ::: "memory")
__device__ __forceinline__ unsigned long long rt() { return __builtin_amdgcn_s_memrealtime(); }
__device__ __forceinline__ unsigned f2bf(float f) { unsigned u = __builtin_bit_cast(unsigned, f); return (u + 0x7fffu + ((u >> 16) & 1u)) >> 16; }
__device__ __forceinline__ unsigned pk2(float lo, float hi) { return f2bf(lo) | (f2bf(hi) << 16); }

#define XB_TMO      128
#define XB_XCNT(j)  (256  + 64 * (j))
#define XB_XSUB(j)  (1280 + 64 * (j))
#define XB_XGEN(j)  (2304 + 64 * (j))
#define XB_TOP      3328
#define XB_TOPGEN   3392
#define XCD_BAR_WORDS 3456
#define XB_SPIN_CAP (1u << 18)

__device__ __forceinline__ unsigned xb_ld(unsigned* p)              { return __hip_atomic_load(p, __ATOMIC_RELAXED, __HIP_MEMORY_SCOPE_AGENT); }
__device__ __forceinline__ unsigned xb_add(unsigned* p, unsigned v) { return __hip_atomic_fetch_add(p, v, __ATOMIC_RELAXED, __HIP_MEMORY_SCOPE_AGENT); }
__device__ __forceinline__ unsigned xb_xcc_id() { return (unsigned)__builtin_amdgcn_s_getreg((3 << 11) | 20) & 0xFu; }
#define XB_SPIN(cond, bar) do { unsigned _sp = 0; while (cond) { __builtin_amdgcn_s_sleep(1); \
    if ((++_sp & 255u) == 0u) { if (xb_ld(&(bar)[XB_TMO])) break; if (_sp > XB_SPIN_CAP) { atomicAdd(&(bar)[XB_TMO], 1u); break; } } } } while (0)

struct XcdBarrier {
    unsigned* bar; unsigned x; unsigned n;
    volatile LAS unsigned* st;
};

__device__ __forceinline__ XcdBarrier xcd_barrier_post(unsigned* bar, volatile LAS unsigned* st, unsigned n) {
    XcdBarrier b; b.bar = bar; b.x = xb_xcc_id(); b.st = st; b.n = n;
    if (threadIdx.x == 0) (void)xb_add(&bar[XB_XCNT(b.x)], 1u);
    return b;
}
__device__ __forceinline__ void xcd_barrier_complete(unsigned* bar, unsigned x, unsigned G, unsigned& nloc, unsigned& nx) {
    unsigned sum, cnt, mine, sp = 0u;
    for (;;) {
        sum = 0u; cnt = 0u; mine = 0u;
#pragma unroll
        for (unsigned j = 0; j < 16; ++j) { const unsigned c = xb_ld(&bar[XB_XCNT(j)]); sum += c; cnt += (c > 0u) ? 1u : 0u; mine = (j == x) ? c : mine; }
        if (sum == G) break;
        __builtin_amdgcn_s_sleep(1);
        if ((++sp & 255u) == 0u) { if (xb_ld(&bar[XB_TMO])) break; if (sp > XB_SPIN_CAP) { atomicAdd(&bar[XB_TMO], 1u); break; } }
    }
    nloc = mine > 0u ? mine : 1u; nx = cnt > 0u ? cnt : 1u;
}

__device__ __forceinline__ void xcd_barrier(const XcdBarrier& b) {
    asm volatile("s_waitcnt vmcnt(0)" ::: "memory");
    __syncthreads();
    if (threadIdx.x == 0) {
        unsigned* bar = b.bar;
        __builtin_amdgcn_s_waitcnt(0);
        unsigned nloc = b.st[0], nx = b.st[1];
        if (nloc == 0u) { xcd_barrier_complete(bar, b.x, b.n, nloc, nx); b.st[0] = nloc; b.st[1] = nx; }
        const unsigned old = xb_add(&bar[XB_XSUB(b.x)], 1u);
        const unsigned gen = old / nloc;
        if (old + 1u == (gen + 1u) * nloc) {
            __builtin_amdgcn_fence(__ATOMIC_RELEASE, "agent");
            asm volatile("s_waitcnt vmcnt(0)" ::: "memory");
            const unsigned og = xb_add(&bar[XB_TOP], 1u);
            const unsigned tg = og / nx;
            if (og + 1u == (tg + 1u) * nx) xb_add(&bar[XB_TOPGEN], 1u);
            else XB_SPIN(xb_ld(&bar[XB_TOPGEN]) == tg, bar);
            __builtin_amdgcn_fence(__ATOMIC_ACQUIRE, "agent");
            xb_add(&bar[XB_XGEN(b.x)], 1u);
            asm volatile("s_waitcnt vmcnt(0)" ::: "memory");
        } else {
            XB_SPIN(xb_ld(&bar[XB_XGEN(b.x)]) == gen, bar);
            __builtin_amdgcn_fence(__ATOMIC_ACQUIRE, "agent");
            asm volatile("s_waitcnt vmcnt(0)" ::: "memory");
        }
    }
    __syncthreads();
}


constexpr int NWAVES = 8;
#ifndef MK_ONE_LAUNCH
#define MK_ONE_LAUNCH 1
#endif
constexpr int N_PHASES = 15;

constexpr int D = 1024, FF = 4096, MP = 8 * 2048, MS = 128 * 8, M = MP + MS;
constexpr int NG = 64, PS = 64, GS = 16;
constexpr float EPS = 1e-6f;
constexpr size_t O_Y = 0, O_SRP = (size_t)M * D, O_SIP = O_SRP + 8 * 4096, O_CP = O_SIP + 8 * 4096, O_SRS = O_CP + 8 * 2 * 1024, O_SIS = O_SRS + 128 * 4096, O_CS = O_SIS + 128 * 4096, O_END = O_CS + 128 * 2 * 1024;
static_assert(O_END == 19218432, "output size");

constexpr size_t MiB = 1u << 20;
constexpr size_t WS_CTL = 0, CTL_ZERO_BYTES = 1 * MiB;
constexpr size_t WS_SSQ = 112 * MiB;
constexpr size_t WS_SSME = 114 * MiB;
constexpr size_t WS_SSMP = 2 * MiB;
constexpr size_t WS_WGU = 4 * MiB;
constexpr size_t WS_WD = 68 * MiB;
constexpr size_t WS_WGLU = 100 * MiB;
constexpr size_t WS_WIN = 104 * MiB;
constexpr size_t WS_WOUT = 110 * MiB;
constexpr size_t WS_X = 112 * MiB;
constexpr size_t WS_XB = 180 * MiB;
constexpr size_t WS_H = 214 * MiB;
constexpr size_t WS_G = 350 * MiB, WS_A2 = WS_G, WS_Z = 384 * MiB, WS_GB = 418 * MiB;
constexpr size_t WS_END = 452 * MiB;
constexpr int CW_TMO = 0;
constexpr int CW_BAR = 4096;
constexpr int CW_SK = 16384;

constexpr int RING_OFF = 0, RING_BYTES = 131072 + 8192;
constexpr int LDSCTL_OFF = RING_BYTES, MISC_OFF = LDSCTL_OFF + 320;
constexpr int LDS_BYTES = 147456;

struct Frame {
    LAS unsigned char* lds;
    volatile LAS unsigned* MISC;
    gu32* ctl;
    int tid, lane, wave, vcu, G, gi, ci;
    const float* in[21]; float* out; unsigned char* ws;
};

__device__ __forceinline__ int opaque_i(int v) { asm volatile("" : "+v"(v)); return v; }
__device__ __forceinline__ float wave_sum(float v) {
#pragma unroll
    for (int o = 1; o < 64; o <<= 1) v += __shfl_xor(v, o);
    return v;
}
__device__ __forceinline__ float bf2f(unsigned short b) { return __builtin_bit_cast(float, (unsigned)b << 16); }

struct P0Item { const float* W; bf16* WT; const float* gk; int K, N, k0, n0s, n0d; };
__device__ __forceinline__ int pair_src(int nd, int base, int hstride) { return base + ((nd >> 7) & 1) * hstride + 128 * (nd >> 8) + (nd & 127); }
__device__ __forceinline__ P0Item p0_item(Frame& F, int it) {
    constexpr int I_GU = (D / 64) * (2 * FF / 64), I_D = (FF / 64) * (D / 64), I_GLU = (D / 64) * (2 * D / 64), I_IN = (D / 64) * (3 * D / 64);
    const float* norm_g = F.in[5]; P0Item p; int r = it;
    if (r < 4 * I_GU) { const int f = r / I_GU; r -= f * I_GU; const int nb = r % (2 * FF / 64), kb = r / (2 * FF / 64), nd = 64 * nb;
        p.W = F.in[7] + (size_t)f * D * 2 * FF; p.K = D; p.N = 2 * FF; p.WT = (bf16*)(F.ws + WS_WGU) + (size_t)f * 2 * FF * D; p.gk = norm_g + ((f >> 1) * 3 + (f & 1) * 2) * D; p.k0 = 64 * kb; p.n0s = pair_src(nd, 0, FF); p.n0d = nd; return p; }
    r -= 4 * I_GU;
    if (r < 4 * I_D) { const int f = r / I_D; r -= f * I_D; const int nb = r % (D / 64), kb = r / (D / 64), nd = 64 * nb;
        p.W = F.in[8] + (size_t)f * FF * D; p.K = FF; p.N = D; p.WT = (bf16*)(F.ws + WS_WD) + (size_t)f * D * FF; p.gk = nullptr; p.k0 = 64 * kb; p.n0s = nd; p.n0d = nd; return p; }
    r -= 4 * I_D;
    if (r < I_GLU) { const int nb = r % (2 * D / 64), kb = r / (2 * D / 64), nd = 64 * nb;
        p.W = F.in[17]; p.K = D; p.N = 2 * D; p.WT = (bf16*)(F.ws + WS_WGLU); p.gk = nullptr; p.k0 = 64 * kb; p.n0s = pair_src(nd, 0, D); p.n0d = nd; return p; }
    r -= I_GLU;
    if (r < I_IN) { const int nb = r % (3 * D / 64), kb = r / (3 * D / 64), nd = 64 * nb;
        p.W = F.in[18]; p.K = D; p.N = 3 * D; p.WT = (bf16*)(F.ws + WS_WIN); p.gk = norm_g + 4 * D; p.k0 = 64 * kb; p.n0s = nd < 2048 ? pair_src(nd, D, D) : nd - 2048; p.n0d = nd; return p; }
    r -= I_IN;
    { const int nb = r % (D / 64), kb = r / (D / 64), nd = 64 * nb;
        p.W = F.in[20]; p.K = D; p.N = D; p.WT = (bf16*)(F.ws + WS_WOUT); p.gk = nullptr; p.k0 = 64 * kb; p.n0s = nd; p.n0d = nd; return p; }
}
#define P0_LOAD(v, gs, p) do { _Pragma("unroll") for (int i = 0; i < 8; ++i) _Pragma("unroll") for (int s = 0; s < 2; ++s) { \
        v[i][s] = *(const GAS f32x4*)((p).W + (size_t)((p).k0 + 8 * i + 2 * kr + s) * (p).N + (p).n0s + 4 * c); gs[i][s] = (p).gk ? (p).gk[(p).k0 + 8 * i + 2 * kr + s] : 1.0f; } } while (0)
#define P0_PROC(v, gs, p) do { \
        _Pragma("unroll") for (int i = 0; i < 8; ++i) _Pragma("unroll") for (int j = 0; j < 4; ++j) \
            *(LAS unsigned*)(scr + (4 * c + j) * 128 + (((4 * i + kr) ^ ((c & 7) << 2)) << 2)) = pg8::cvt_pk_bf16(v[i][0][j] * gs[i][0], v[i][1][j] * gs[i][1]); \
        LDS_WAIT(); asm volatile("" ::: "memory"); \
        _Pragma("unroll") for (int i = 0; i < 8; ++i) { const int n = nr + 8 * i; const v4u o = *(const LAS v4u*)(scr + n * 128 + ((q ^ ((n >> 2) & 7)) << 4)); \
            *(GAS v4u*)((p).WT + (size_t)((p).n0d + n) * (p).K + (p).k0 + 8 * q) = o; } \
        LDS_WAIT(); asm volatile("" ::: "memory"); } while (0)

__device__ __forceinline__ void p0_prologue(Frame& F) {
    LAS unsigned char* scr = F.lds + RING_OFF + F.wave * 16384;
    const int gw = F.vcu * NWAVES + F.wave, NGW = F.G * NWAVES, lane = opaque_i(F.lane);
    constexpr int NITEMS = 4 * (D / 64) * (2 * FF / 64) + 4 * (FF / 64) * (D / 64) + (D / 64) * (2 * D / 64) + (D / 64) * (3 * D / 64) + (D / 64) * (D / 64);
    { const int kr = lane >> 4, c = lane & 15, nr = lane >> 3, q = lane & 7;
      f32x4 va[8][2], vb[8][2]; float ga[8][2], gb[8][2];
      int it = gw; P0Item pa = p0_item(F, it < NITEMS ? it : 0), pb = pa;
      if (it < NITEMS) P0_LOAD(va, ga, pa);
      while (it < NITEMS) {
          const int it1 = it + NGW; if (it1 < NITEMS) { pb = p0_item(F, it1); P0_LOAD(vb, gb, pb); }
          P0_PROC(va, ga, pa);
          if (it1 >= NITEMS) break;
          const int it2 = it1 + NGW; if (it2 < NITEMS) { pa = p0_item(F, it2); P0_LOAD(va, ga, pa); }
          P0_PROC(vb, gb, pb);
          it = it2;
      }
    }
    bf16* XB = (bf16*)(F.ws + WS_XB); pg8::ssq_t* ssq = (pg8::ssq_t*)(F.ws + WS_SSQ);
    for (int m0 = gw; m0 < M; m0 += 4 * NGW) {
        f32x4 v[4][4];
#pragma unroll
        for (int r = 0; r < 4; ++r) { const int m = m0 + r * NGW; if (m < M) { const float* src = m < MP ? F.in[0] + (size_t)m * D : F.in[1] + (size_t)(m - MP) * D;
#pragma unroll
            for (int j = 0; j < 4; ++j) v[r][j] = ((const GAS f32x4*)src)[lane + 64 * j]; } }
#pragma unroll
        for (int r = 0; r < 4; ++r) { const int m = m0 + r * NGW; if (m < M) {
            GAS unsigned long long* o8 = (GAS unsigned long long*)(XB + (size_t)m * D) + lane; float s = 0.f;
#pragma unroll
            for (int j = 0; j < 4; ++j) { const f32x4 w = v[r][j]; s += (w.x * w.x + w.y * w.y) + (w.z * w.z + w.w * w.w);
                o8[64 * j] = (unsigned long long)pg8::cvt_pk_bf16(w.x, w.y) | ((unsigned long long)pg8::cvt_pk_bf16(w.z, w.w) << 32); }
            s = wave_sum(s);
            if (lane == 0) ssq[m] = pg8::ssq_fix(s); } }
    }
    for (int i = gw * 64 + lane; i < 7 * M; i += NGW * 64) ssq[M + i] = 0ull;
    float* sp = (float*)(F.ws + WS_SSMP);
    for (int i = gw * 64 + lane; i < NG * PS; i += NGW * 64) {
        const int g = i / PS;
        const float lr = F.in[9][i], li = F.in[10][i], dt = expf(F.in[11][g]);
        const float mag = expf(lr * dt); float sn, cs; sincosf(li * dt, &sn, &cs);
        const float lbr = mag * cs, lbi = mag * sn, den = lr * lr + li * li, nr = lbr - 1.0f, ni = lbi;
        const float fr = (nr * lr + ni * li) / den, fi = (ni * lr - nr * li) / den;
        sp[i] = lbr; sp[4096 + i] = lbi;
#pragma unroll
        for (int c = 0; c < GS; ++c) { const float br = F.in[12][(size_t)i * GS + c], bi = F.in[13][(size_t)i * GS + c];
            sp[8192 + (size_t)i * GS + c] = fr * br - fi * bi; sp[8192 + 65536 + (size_t)i * GS + c] = fr * bi + fi * br; }
    }
}

__device__ __forceinline__ float gelu_tanh(float x) {
    const float a = 0.7978845608028654f * (x + 0.044715f * x * x * x);
    return x * __builtin_amdgcn_rcpf(1.0f + __builtin_amdgcn_exp2f(-2.0f * 1.4426950408889634f * a));
}


typedef float f32x16 __attribute__((ext_vector_type(16)));
typedef unsigned u32x2v __attribute__((ext_vector_type(2)));
__device__ __forceinline__ unsigned cvtpk(float lo, float hi) { unsigned r; asm volatile("v_cvt_pk_bf16_f32 %0, %1, %2" : "=v"(r) : "v"(lo), "v"(hi)); return r; }
__device__ __forceinline__ bf16x8 pack8(const float* v) { v4u w; w.x = cvtpk(v[0], v[1]); w.y = cvtpk(v[2], v[3]); w.z = cvtpk(v[4], v[5]); w.w = cvtpk(v[6], v[7]); return __builtin_bit_cast(bf16x8, w); }
constexpr int SSM_ROWB = 272;
constexpr int SSM_NCH = 8, SSM_CHB = 8;
#define BFLO(w) __builtin_bit_cast(float, (w) << 16)
#define BFHI(w) __builtin_bit_cast(float, (w) & 0xffff0000u)

template <int MODE, int NI>
__device__ __forceinline__ void ssm_run(Frame& F, LAS unsigned char* img0, int lane, int g, const int (&row_base)[NI], int nblk, bool sample, int seq0, float (&hr)[NI], float (&hi)[NI]) {
    const bf16* X = (const bf16*)(F.ws + WS_XB); const pg8::ssq_t* ssq = (const pg8::ssq_t*)(F.ws + WS_SSQ) + 1 * M;
    const float* sp = (const float*)(F.ws + WS_SSMP); bf16* Gb = (bf16*)(F.ws + WS_G);
    const float* g1 = F.in[5] + 1 * D; const float* dsk = F.in[16];
    const int l31 = lane & 31, h = lane >> 5, l15 = lane & 15, q4 = lane >> 4;
    bf16x8 bbq[4];
#pragma unroll
    for (int q = 0; q < 4; ++q) { const int p = 32 * (q & 1) + l31; const float* src = sp + 8192 + (q >> 1) * 65536 + ((size_t)(g * PS + p) * GS + 8 * h);
        float v[8];
#pragma unroll
        for (int j = 0; j < 8; ++j) v[j] = src[j] * g1[g * GS + 8 * h + j];
        bbq[q] = pack8(v); }
    bf16x8 cm[4]; float dg[4];
    if (MODE == 1) {
#pragma unroll
        for (int ks = 0; ks < 4; ++ks) { const int p0 = 16 * ks + 4 * q4; const float* cr = F.in[14] + ((size_t)(g * GS + l15) * PS + p0); const float* ci = F.in[15] + ((size_t)(g * GS + l15) * PS + p0);
            float v[8];
#pragma unroll
            for (int j = 0; j < 4; ++j) { v[2 * j] = cr[j]; v[2 * j + 1] = -ci[j]; }
            cm[ks] = pack8(v); }
#pragma unroll
        for (int e = 0; e < 4; ++e) dg[e] = dsk[g * GS + 4 * q4 + e] * g1[g * GS + 4 * q4 + e];
    }
    const float lbr = sp[g * PS + lane], lbi = sp[4096 + g * PS + lane];
    float s0r[4], s0i[4];
    if (sample) {
#pragma unroll
        for (int i = 0; i < 4; ++i) { s0r[i] = F.in[2][((size_t)(seq0 + i) * NG + g) * PS + lane]; s0i[i] = F.in[3][((size_t)(seq0 + i) * NG + g) * PS + lane]; } }
    else {
#pragma unroll
        for (int i = 0; i < 4; ++i) { s0r[i] = 0.f; s0i[i] = 0.f; } }
    v4u xaw[NI]; u32x2v xew0[NI], xew1[NI]; pg8::ssq_t qa[NI], qe0[NI], qe1[NI];
#define SSM_LOAD(b) do { _Pragma("unroll") for (int j = 0; j < NI; ++j) { const int rowA = row_base[j] + 32 * (b) + l31; xaw[j] = *(const GAS v4u*)(X + (size_t)rowA * D + g * GS + 8 * h); qa[j] = ssq[rowA]; \
        if (MODE == 1) { const int rowE = row_base[j] + 32 * (b) + l15; xew0[j] = *(const GAS u32x2v*)(X + (size_t)rowE * D + g * GS + 4 * q4); xew1[j] = *(const GAS u32x2v*)(X + (size_t)(rowE + 16) * D + g * GS + 4 * q4); qe0[j] = ssq[rowE]; qe1[j] = ssq[rowE + 16]; } \
        else { qe0[j] = 0; qe1[j] = 0; } } } while (0)
    SSM_LOAD(0);
    for (int b = 0; b < nblk; ++b) {
        f32x4 ca0[NI], ca1[NI], ce0[NI], ce1[NI]; pg8::ssq_t cqa[NI], cqe0[NI], cqe1[NI];
#pragma unroll
        for (int j = 0; j < NI; ++j) { ca0[j] = (f32x4){BFLO(xaw[j].x), BFHI(xaw[j].x), BFLO(xaw[j].y), BFHI(xaw[j].y)}; ca1[j] = (f32x4){BFLO(xaw[j].z), BFHI(xaw[j].z), BFLO(xaw[j].w), BFHI(xaw[j].w)};
            if (MODE == 1) { ce0[j] = (f32x4){BFLO(xew0[j].x), BFHI(xew0[j].x), BFLO(xew0[j].y), BFHI(xew0[j].y)}; ce1[j] = (f32x4){BFLO(xew1[j].x), BFHI(xew1[j].x), BFLO(xew1[j].y), BFHI(xew1[j].y)}; }
            cqa[j] = qa[j]; cqe0[j] = qe0[j]; cqe1[j] = qe1[j]; }
        if (b + 1 < nblk) SSM_LOAD(b + 1);
        f32x16 Xr[NI], Yr[NI], Xi[NI], Yi[NI];
#pragma unroll
        for (int j = 0; j < NI; ++j) {
            const float rsa = pg8::rstd_of(cqa[j]);
            float ua[8];
#pragma unroll
            for (int e = 0; e < 4; ++e) { ua[e] = ca0[j][e] * rsa; ua[4 + e] = ca1[j][e] * rsa; }
            const bf16x8 ufrag = pack8(ua);
            const f32x16 zero16 = {0.f, 0.f, 0.f, 0.f, 0.f, 0.f, 0.f, 0.f, 0.f, 0.f, 0.f, 0.f, 0.f, 0.f, 0.f, 0.f};
            Xr[j] = __builtin_amdgcn_mfma_f32_32x32x16_bf16(ufrag, bbq[0], zero16, 0, 0, 0);
            Yr[j] = __builtin_amdgcn_mfma_f32_32x32x16_bf16(ufrag, bbq[1], zero16, 0, 0, 0);
            Xi[j] = __builtin_amdgcn_mfma_f32_32x32x16_bf16(ufrag, bbq[2], zero16, 0, 0, 0);
            Yi[j] = __builtin_amdgcn_mfma_f32_32x32x16_bf16(ufrag, bbq[3], zero16, 0, 0, 0); }
#pragma unroll
        for (int j = 0; j < NI; ++j)
#pragma unroll
            for (int r = 0; r < 16; ++r) {
                auto s1 = __builtin_amdgcn_permlane32_swap(__float_as_uint(Xr[j][r]), __float_as_uint(Yr[j][r]), false, false); Xr[j][r] = __uint_as_float(s1[0]); Yr[j][r] = __uint_as_float(s1[1]);
                auto s2 = __builtin_amdgcn_permlane32_swap(__float_as_uint(Xi[j][r]), __float_as_uint(Yi[j][r]), false, false); Xi[j][r] = __uint_as_float(s2[0]); Yi[j][r] = __uint_as_float(s2[1]); }
#pragma unroll
        for (int i = 0; i < 4; ++i) {
            if (sample) { hr[0] = s0r[i]; hi[0] = s0i[i]; }
#pragma unroll
            for (int s = 0; s < 2; ++s)
#pragma unroll
                for (int e = 0; e < 4; ++e)
#pragma unroll
                    for (int j = 0; j < NI; ++j) { const int r = 4 * i + e; const float br = s ? Yr[j][r] : Xr[j][r], bi = s ? Yi[j][r] : Xi[j][r];
                        const float nr = lbr * hr[j] - lbi * hi[j] + br, ni = lbr * hi[j] + lbi * hr[j] + bi; hr[j] = nr; hi[j] = ni;
                        if (MODE == 1) *(LAS unsigned*)(img0 + j * (32 * SSM_ROWB) + (8 * i + 4 * s + e) * SSM_ROWB + 4 * lane) = cvtpk(nr, ni); }
            if (sample) { F.out[O_SRS + ((size_t)(seq0 + i) * NG + g) * PS + lane] = hr[0]; F.out[O_SIS + ((size_t)(seq0 + i) * NG + g) * PS + lane] = hi[0]; }
        }
        if (MODE == 1) {
#pragma unroll
            for (int j = 0; j < NI; ++j) {
                const LAS unsigned char* img = img0 + j * (32 * SSM_ROWB);
                f32x4 acc0 = {0.f, 0.f, 0.f, 0.f}, acc1 = {0.f, 0.f, 0.f, 0.f};
#pragma unroll
                for (int ks = 0; ks < 4; ++ks) {
                    const bf16x8 b0 = *(const LAS bf16x8*)(img + l15 * SSM_ROWB + 64 * ks + 16 * q4);
                    const bf16x8 b1 = *(const LAS bf16x8*)(img + (16 + l15) * SSM_ROWB + 64 * ks + 16 * q4);
                    acc0 = __builtin_amdgcn_mfma_f32_16x16x32_bf16(cm[ks], b0, acc0, 0, 0, 0);
                    acc1 = __builtin_amdgcn_mfma_f32_16x16x32_bf16(cm[ks], b1, acc1, 0, 0, 0); }
                const float rse0 = pg8::rstd_of(cqe0[j]), rse1 = pg8::rstd_of(cqe1[j]);
                float o0[4], o1[4];
#pragma unroll
                for (int e = 0; e < 4; ++e) { o0[e] = gelu_tanh(acc0[e] + dg[e] * ce0[j][e] * rse0); o1[e] = gelu_tanh(acc1[e] + dg[e] * ce1[j][e] * rse1); }
                const int rowE = row_base[j] + 32 * b + l15;
                u32x2v w0, w1; w0.x = cvtpk(o0[0], o0[1]); w0.y = cvtpk(o0[2], o0[3]); w1.x = cvtpk(o1[0], o1[1]); w1.y = cvtpk(o1[2], o1[3]);
                *(u32x2v*)(Gb + (size_t)rowE * D + g * GS + 4 * q4) = w0;
                *(u32x2v*)(Gb + (size_t)(rowE + 16) * D + g * GS + 4 * q4) = w1; }
        }
    }
#undef SSM_LOAD
}

__device__ __forceinline__ void ssm_phase_pass(Frame& F, int pass) {
    LAS unsigned char* img = F.lds + RING_OFF + F.wave * (2 * 32 * SSM_ROWB);
    const int lane = opaque_i(F.lane), s = F.wave * 32 + F.ci, g = s & 63, c0 = s >> 6;
    float* E = (float*)(F.ws + WS_SSME) + ((size_t)(F.gi * NG + g) * SSM_NCH) * 2 * PS;
    const int rb[2] = {F.gi * 2048 + c0 * (SSM_CHB * 32), F.gi * 2048 + (c0 + 4) * (SSM_CHB * 32)};
    if (pass == 0) {
        float hr[2] = {0.f, 0.f}, hi[2] = {0.f, 0.f};
        ssm_run<0, 2>(F, img, lane, g, rb, SSM_CHB, false, 0, hr, hi);
#pragma unroll
        for (int j = 0; j < 2; ++j) { E[((c0 + 4 * j) * 2 + 0) * PS + lane] = hr[j]; E[((c0 + 4 * j) * 2 + 1) * PS + lane] = hi[j]; }
        float sr[1] = {0.f}, si[1] = {0.f}; const int rs[1] = {MP + 128 * F.gi + 32 * c0};
        ssm_run<1, 1>(F, img, lane, g, rs, 1, true, 16 * F.gi + 4 * c0, sr, si);
    } else {
        const float* sp = (const float*)(F.ws + WS_SSMP);
        float ar = sp[g * PS + lane], ai = sp[4096 + g * PS + lane];
#pragma unroll
        for (int k = 0; k < 8; ++k) { const float nr = ar * ar - ai * ai, ni = 2.0f * ar * ai; ar = nr; ai = ni; }
        float hr[2] = {0.f, 0.f}, hi[2] = {0.f, 0.f}; float tr = 0.f, ti = 0.f;
        for (int j = 0; j < c0 + 4; ++j) { const float er = E[(j * 2 + 0) * PS + lane], ei = E[(j * 2 + 1) * PS + lane];
            const float nr = ar * tr - ai * ti + er, ni = ar * ti + ai * tr + ei; tr = nr; ti = ni;
            if (j + 1 == c0) { hr[0] = tr; hi[0] = ti; } }
        hr[1] = tr; hi[1] = ti;
        ssm_run<1, 2>(F, img, lane, g, rb, SSM_CHB, false, 0, hr, hi);
        if (c0 == 3) { F.out[O_SRP + ((size_t)F.gi * NG + g) * PS + lane] = hr[1]; F.out[O_SIP + ((size_t)F.gi * NG + g) * PS + lane] = hi[1]; }
    }
}
#undef BFLO
#undef BFHI

__device__ __forceinline__ void conv_phase(Frame& F) {
    const bf16* Z = (const bf16*)(F.ws + WS_Z); const bf16* GBp = (const bf16*)(F.ws + WS_GB); bf16* A2 = (bf16*)(F.ws + WS_A2);
    const float* cw = F.in[19]; const float* cache = F.in[4];
    const int gt = (F.ci * NWAVES + F.wave) * 64 + opaque_i(F.lane), NGT = 32 * NWAVES * 64;
    for (int it = gt; it < (2048 + 128) * (D / 8); it += NGT) {
        const int lr = it >> 7, row = lr < 2048 ? F.gi * 2048 + lr : MP + F.gi * 128 + (lr - 2048), c0 = (it & 127) * 8;
        int t; const float* cb = nullptr;
        if (row < MP) t = row & 2047; else { const int r2 = row - MP; t = r2 & 7; cb = cache + (size_t)(r2 >> 3) * 2 * D; }
        float z0[8], z1[8], z2[8], gb[8];
        { const v4u v = *(const GAS v4u*)(Z + (size_t)row * D + c0); const v4u q = *(const GAS v4u*)(GBp + (size_t)row * D + c0);
#pragma unroll
          for (int e = 0; e < 4; ++e) { z2[2 * e] = __builtin_bit_cast(float, v[e] << 16); z2[2 * e + 1] = __builtin_bit_cast(float, v[e] & 0xffff0000u);
                                        gb[2 * e] = __builtin_bit_cast(float, q[e] << 16); gb[2 * e + 1] = __builtin_bit_cast(float, q[e] & 0xffff0000u); } }
        if (t >= 1) { const v4u v = *(const GAS v4u*)(Z + (size_t)(row - 1) * D + c0);
#pragma unroll
          for (int e = 0; e < 4; ++e) { z1[2 * e] = __builtin_bit_cast(float, v[e] << 16); z1[2 * e + 1] = __builtin_bit_cast(float, v[e] & 0xffff0000u); } }
        else {
#pragma unroll
          for (int e = 0; e < 8; ++e) z1[e] = cb ? cb[D + c0 + e] : 0.f; }
        if (t >= 2) { const v4u v = *(const GAS v4u*)(Z + (size_t)(row - 2) * D + c0);
#pragma unroll
          for (int e = 0; e < 4; ++e) { z0[2 * e] = __builtin_bit_cast(float, v[e] << 16); z0[2 * e + 1] = __builtin_bit_cast(float, v[e] & 0xffff0000u); } }
        else {
#pragma unroll
          for (int e = 0; e < 8; ++e) z0[e] = cb ? cb[t * D + c0 + e] : 0.f; }
        float o[8];
#pragma unroll
        for (int e = 0; e < 8; ++e) o[e] = gb[e] * (cw[c0 + e] * z0[e] + cw[D + c0 + e] * z1[e] + cw[2 * D + c0 + e] * z2[e]);
        v4u w; w.x = pk2(o[0], o[1]); w.y = pk2(o[2], o[3]); w.z = pk2(o[4], o[5]); w.w = pk2(o[6], o[7]);
        *(GAS v4u*)(A2 + (size_t)row * D + c0) = w;
    }
}

__device__ __forceinline__ void final_phase(Frame& F) {
    const bf16* XBp = (const bf16*)(F.ws + WS_XB); const pg8::ssq_t* ssq = (const pg8::ssq_t*)(F.ws + WS_SSQ) + 6 * M; const float* fg = F.in[6];
    const int gw = F.ci * NWAVES + F.wave, NGW = 32 * NWAVES, lane = opaque_i(F.lane);
    f32x4 gv[4];
#pragma unroll
    for (int j = 0; j < 4; ++j) gv[j] = ((const GAS f32x4*)fg)[lane + 64 * j];
    for (int lr = gw; lr < 2048 + 128; lr += NGW) { const int m = lr < 2048 ? F.gi * 2048 + lr : MP + F.gi * 128 + (lr - 2048);
        const float rs = pg8::rstd_of(ssq[m]);
        const GAS unsigned long long* xr = (const GAS unsigned long long*)(XBp + (size_t)m * D) + lane; GAS f32x4* yo = (GAS f32x4*)(F.out + O_Y + (size_t)m * D) + lane;
#pragma unroll
        for (int j = 0; j < 4; ++j) { const unsigned long long w = xr[64 * j]; const unsigned lo = (unsigned)w, hi = (unsigned)(w >> 32);
            const f32x4 xv = {__builtin_bit_cast(float, lo << 16), __builtin_bit_cast(float, lo & 0xffff0000u), __builtin_bit_cast(float, hi << 16), __builtin_bit_cast(float, hi & 0xffff0000u)};
            yo[64 * j] = xv * rs * gv[j]; }
    }
}

struct SameOrder : pg8::StaticOrder { __device__ bool next(int i, pg8::Unit& u) const { const bool r = pg8::StaticOrder::next(i, u); u.pm = 0; u.pn = 0; return r; } };
struct Args { const float* in[21]; float* out; unsigned char* ws; int ph_lo, ph_hi; };
__global__ void __launch_bounds__(NWAVES * 64, 2) skel_fwd(Args args) {
    extern __shared__ __attribute__((aligned(16))) unsigned char lds[];
    Frame F;
    F.lds = (LAS unsigned char*)lds;
    F.MISC = (volatile LAS unsigned*)(F.lds + MISC_OFF);
    F.tid = threadIdx.x; F.lane = F.tid & 63; F.wave = __builtin_amdgcn_readfirstlane(F.tid >> 6);
    F.G = gridDim.x; { const int bx = blockIdx.x; F.vcu = (bx % 8) * (F.G / 8) + bx / 8; F.gi = bx % 8; F.ci = bx / 8; }
    F.ws = args.ws; F.out = args.out; F.ctl = (gu32*)(args.ws + WS_CTL);
#pragma unroll
    for (int i = 0; i < 21; ++i) F.in[i] = args.in[i];
    for (int u = F.tid; u < (LDS_BYTES - LDSCTL_OFF) / 4; u += NWAVES * 64) ((LAS unsigned*)(F.lds + LDSCTL_OFF))[u] = 0u;
    __syncthreads();
    XcdBarrier bar = xcd_barrier_post((unsigned*)(F.ctl + CW_BAR), F.MISC + 8, (unsigned)F.G);
    XcdBarrier gbar = xcd_barrier_post((unsigned*)(F.ctl + CW_BAR) + (1 + F.gi) * XCD_BAR_WORDS, F.MISC + 10, (unsigned)(F.G / 8));
    const int lo = args.ph_lo, hi = args.ph_hi;
#define IN(k) (lo <= (k) && (k) < hi)
#if defined(PROBE_A_LO)
#define STAMP(k) do { if (blockIdx.x == 0 && F.tid == 0) { const unsigned long long t_ = __builtin_amdgcn_s_memrealtime(); F.MISC[16 + 2 * (k)] = (unsigned)t_; F.MISC[17 + 2 * (k)] = (unsigned)(t_ >> 32); } } while (0)
#else
#define STAMP(k) do { } while (0)
#endif
    STAMP(0);
#define SEAM(k) do { if (IN((k) + 1)) { if ((k) == 0) xcd_barrier(bar); else xcd_barrier(gbar); } STAMP((k) + 1); } while (0)
    bf16* XB = (bf16*)(F.ws + WS_XB); bf16* H = (bf16*)(F.ws + WS_H); pg8::ssq_t* ssq = (pg8::ssq_t*)(F.ws + WS_SSQ);
    const int bx = (int)blockIdx.x;

    if (IN(0)) { p0_prologue(F); SEAM(0); }
#define FFN_GU(ph, f, sin) if (IN(ph)) { pg8::Gemm g{XB, (const bf16*)(F.ws + WS_WGU) + (size_t)(f) * 2 * FF * D, M, 2 * FF, D}; pg8::StaticOrder S; S.init(MP, 2 * FF, F.G, bx); \
        pg8::EpiGateUp E{H, FF, ssq + (size_t)(sin) * M}; pg8::gemm_phase<pg8::EpiGateUp, pg8::StaticOrder, true, true>(F.lds + RING_OFF, g, S, E); SEAM(ph); }
#define FFN_DN(ph, f, sout) if (IN(ph)) { pg8::Gemm g{H, (const bf16*)(F.ws + WS_WD) + (size_t)(f) * D * FF, M, D, FF}; pg8::StaticOrder S; S.init(MP, D, F.G, bx); \
        pg8::EpiResid<0> E{(ph) == 2 ? F.in[0] : nullptr, (ph) == 2 ? F.in[1] : nullptr, XB, ssq + (size_t)(sout) * M, 0.5f}; pg8::gemm_phase<pg8::EpiResid<0>, pg8::StaticOrder, true, true>(F.lds + RING_OFF, g, S, E); SEAM(ph); }
    FFN_GU(1, 0, 0)
    FFN_DN(2, 0, 1)
#if defined(PROBE_SSM)
    if (IN(3)) { ssm_phase_pass(F, 0); if (PROBE_SSM == 1) { xcd_barrier(gbar); ssm_phase_pass(F, 0); } xcd_barrier(gbar); ssm_phase_pass(F, 1); if (PROBE_SSM == 2) { xcd_barrier(gbar); ssm_phase_pass(F, 1); } SEAM(3); }
#else
    if (IN(3)) { ssm_phase_pass(F, 0); xcd_barrier(gbar); ssm_phase_pass(F, 1); SEAM(3); }
#endif
    if (IN(4)) { pg8::Gemm g{(const bf16*)(F.ws + WS_G), (const bf16*)(F.ws + WS_WGLU), M, 2 * D, D}; pg8::StaticOrder S; S.init(MP, 2 * D, F.G, bx);
        pg8::EpiResid<1> E{nullptr, nullptr, XB, ssq + (size_t)2 * M, 1.0f}; pg8::gemm_phase<pg8::EpiResid<1>, pg8::StaticOrder, true, true>(F.lds + RING_OFF, g, S, E); SEAM(4); }
    FFN_GU(5, 1, 2)
    FFN_DN(6, 1, 3)
    FFN_GU(7, 2, 3)
    FFN_DN(8, 2, 4)
    if (IN(9)) { pg8::Gemm g{XB, (const bf16*)(F.ws + WS_WIN), M, 3 * D, D}; pg8::StaticOrder S; S.init(MP, 3 * D, F.G, bx);
        pg8::EpiConvIn E{(bf16*)(F.ws + WS_Z), (bf16*)(F.ws + WS_GB), ssq + (size_t)4 * M, F.out + O_CP, F.out + O_CS};
        pg8::gemm_phase<pg8::EpiConvIn, pg8::StaticOrder, true, true>(F.lds + RING_OFF, g, S, E); SEAM(9); }
    if (IN(10)) { conv_phase(F); SEAM(10); }
    if (IN(11)) { pg8::Gemm g{(const bf16*)(F.ws + WS_A2), (const bf16*)(F.ws + WS_WOUT), M, D, D}; pg8::StaticOrder S; S.init(MP, D, F.G, bx);
        pg8::EpiResid<0> E{nullptr, nullptr, XB, ssq + (size_t)5 * M, 1.0f}; pg8::gemm_phase<pg8::EpiResid<0>, pg8::StaticOrder, true, true>(F.lds + RING_OFF, g, S, E); SEAM(11); }
    FFN_GU(12, 3, 5)
    FFN_DN(13, 3, 6)
    if (IN(14)) { final_phase(F); }
#if defined(PROBE_DRY)
#ifndef PROBE_VARIANT
#define PROBE_VARIANT 0
#endif
    xcd_barrier(gbar); STAMP(15); if (blockIdx.x == 0 && F.tid == 0) { const unsigned long long c_ = __builtin_amdgcn_s_memtime(); F.MISC[60] = (unsigned)c_; F.MISC[61] = (unsigned)(c_ >> 32); }
#if PROBE_DRY == 2
    { pg8::Gemm g{XB, (const bf16*)(F.ws + WS_WGU), M, 2 * FF, D}; SameOrder S; S.init(MP, 2 * FF, F.G, bx);
      pg8::EpiNull E{H + (size_t)M * FF - 1}; pg8::gemm_phase<pg8::EpiNull, SameOrder, true, true>(F.lds + RING_OFF, g, S, E); }
#else
#if PROBE_DRY == 3
    { pg8::Gemm g{XB, (const bf16*)(F.ws + WS_WGU) + (size_t)3 * 2 * FF * D, M, 2 * FF, D}; pg8::StaticOrder S; S.init(MP, 2 * FF, F.G, bx);
      pg8::EpiGateUp E{H, FF, ssq + (size_t)5 * M}; pg8::gemm_phase<pg8::EpiGateUp, pg8::StaticOrder, true, true, PROBE_VARIANT>(F.lds + RING_OFF, g, S, E); }
#else
    { pg8::Gemm g{XB, (const bf16*)(F.ws + WS_WGU), M, 2 * FF, D}; pg8::StaticOrder S; S.init(MP, 2 * FF, F.G, bx);
      pg8::EpiNull E{H + (size_t)M * FF - 1}; pg8::gemm_phase<pg8::EpiNull, pg8::StaticOrder, true, true, PROBE_VARIANT>(F.lds + RING_OFF, g, S, E); }
#endif
#endif
    xcd_barrier(gbar); STAMP(16); if (blockIdx.x == 0 && F.tid == 0) { const unsigned long long c_ = __builtin_amdgcn_s_memtime(); F.MISC[62] = (unsigned)c_; F.MISC[63] = (unsigned)(c_ >> 32); }
#endif
#if defined(PROBE_A_LO)
    __syncthreads();
    if (blockIdx.x == 0 && F.tid == 0) {
#if !defined(PROBE_DRY)
        STAMP(15);
#endif
#define TS(k) ((unsigned long long)F.MISC[16 + 2 * (k)] | ((unsigned long long)F.MISC[17 + 2 * (k)] << 32))
        const unsigned long long ta = TS(PROBE_A_HI) - TS(PROBE_A_LO), tb = TS(PROBE_B_HI) - TS(PROBE_B_LO);
#if defined(PROBE_CLOCK)
        { const unsigned long long c0 = (unsigned long long)F.MISC[60] | ((unsigned long long)F.MISC[61] << 32), c1 = (unsigned long long)F.MISC[62] | ((unsigned long long)F.MISC[63] << 32);
          F.out[0] += (float)(c1 - c0) / (float)(TS(16) - TS(15)) * 1e-2f; }
#else
        F.out[0] += (float)tb * 1e-5f;
#endif
        const unsigned long long t0 = __builtin_amdgcn_s_memrealtime();
        const unsigned long long spin = ta * 4ull < 1000000ull ? ta * 4ull : 1000000ull;
        while (__builtin_amdgcn_s_memrealtime() - t0 < spin) __builtin_amdgcn_s_sleep(8);
    }
#endif
#undef IN
#undef SEAM
}

extern "C" void kernel_launch(void* const* d_in, const int* in_sizes, int n_in, void* d_out, int out_size, void* d_ws, size_t ws_size, hipStream_t stream) {
    static int grid = 0;
    if (grid == 0) {
        if (n_in != 21 || out_size != (int)O_END || ws_size < WS_END) { fprintf(stderr, "kernel_launch: unexpected shapes: n_in %d out %d ws %zu; nothing launched\n", n_in, out_size, ws_size); grid = -1; return; }
        int dev = 0, cus = 0, per_cu = 0;
        if (hipGetDevice(&dev) != hipSuccess || hipDeviceGetAttribute(&cus, hipDeviceAttributeMultiprocessorCount, dev) != hipSuccess) { grid = -1; return; }
        if (hipFuncSetAttribute((const void*)skel_fwd, hipFuncAttributeMaxDynamicSharedMemorySize, LDS_BYTES) != hipSuccess) { fprintf(stderr, "kernel_launch: hipFuncSetAttribute failed\n"); grid = -1; return; }
        if (hipOccupancyMaxActiveBlocksPerMultiprocessor(&per_cu, (const void*)skel_fwd, NWAVES * 64, LDS_BYTES) != hipSuccess || per_cu < 1) fprintf(stderr, "kernel_launch: occupancy query reports %d\n", per_cu);
        (void)hipGetLastError();
        if (cus < 256) { fprintf(stderr, "kernel_launch: built for a 256-CU device (8 groups x 32 workgroups), found %d CUs; nothing launched\n", cus); grid = -1; return; }
        grid = 256;
    }
    if (grid < 0) return;
    if (hipMemsetAsync((char*)d_ws + WS_CTL, 0, CTL_ZERO_BYTES, stream) != hipSuccess) return;
    Args a{};
    for (int i = 0; i < 21; ++i) a.in[i] = (const float*)d_in[i];
    a.out = (float*)d_out; a.ws = (unsigned char*)d_ws;
    a.ph_lo = 0; a.ph_hi = N_PHASES;
    hipLaunchKernelGGL(skel_fwd, dim3(grid), dim3(NWAVES * 64), LDS_BYTES, stream, a);
}
```

```cpp
#include <hip/hip_runtime.h>
#include <cstdio>
#include <cstdint>
namespace pg8 {
#define PG8_LAS __attribute__((address_space(3)))
typedef unsigned short bf16_t;
typedef short bf16x8 __attribute__((ext_vector_type(8)));
typedef float f32x4 __attribute__((ext_vector_type(4)));
typedef unsigned u32x4 __attribute__((ext_vector_type(4)));
constexpr int BM = 256, BK = 64, HALF = 128, HTB = HALF * BK * 2  , STAGE_BYTES = 8 * HTB, NXCD = 8, WGM = 8;

__host__ __device__ __forceinline__ int lds_byte(int r, int c) { const int st = (r >> 4) * 2 + (c >> 5), rr = r & 15, cc = c & 31, ob = rr * 64 + cc * 2; return st * 1024 + (ob ^ (((ob >> 9) & 1) << 5)); }
__host__ __device__ __forceinline__ void stage_rc(int b, int& R, int& C) { const int st = b / 1024, sb = b % 1024, swz = sb ^ (((sb >> 9) & 1) << 5); R = (st >> 1) * 16 + swz / 64; C = (st & 1) * 32 + (swz % 64) / 2; }
__host__ __device__ __forceinline__ int perm32(int rho) { const int n = rho >> 4, i = rho & 15; return 8 * (i >> 2) + 4 * n + (i & 3); }

struct Unit { int pm, pn; };
struct Gemm { const bf16_t* A; const bf16_t* Bt; int M, N, K; };

struct StaticOrder {
    int nM, nN, nwg, G, c;
    __host__ __device__ void init(int M, int N, int G_, int c_) { nM = M / BM; nN = N / BM; nwg = nM * nN; G = G_; c = c_; }
    __host__ __device__ bool next(int i, Unit& u) const {
        const long L = (long)i * G + c; if (L >= nwg) return false;
        int wgid = (int)L; { const int q = nwg / NXCD, r = nwg % NXCD, xcd = wgid % NXCD, off = wgid / NXCD; wgid = (xcd < r ? xcd * (q + 1) : r * (q + 1) + (xcd - r) * q) + off; }
        const int nig = WGM * nN, gid = wgid / nig, fm = gid * WGM, gsz = (nM - fm) < WGM ? (nM - fm) : WGM;
        u.pm = fm + ((wgid % nig) % gsz); u.pn = (wgid % nig) / gsz; return true;
    }
    __device__ __forceinline__ void a_ready(const Unit&) const {}
    __device__ __forceinline__ void done(const Unit&) const {}
};


__device__ __forceinline__ unsigned cvt_pk_bf16(float lo, float hi) { unsigned r; asm volatile("v_cvt_pk_bf16_f32 %0, %1, %2" : "=v"(r) : "v"(lo), "v"(hi)); return r; }

typedef unsigned u32x2 __attribute__((ext_vector_type(2)));
constexpr float RMS_EPS = 1e-6f;
constexpr float INV_D = 1.0f / 1024.0f;
__device__ __forceinline__ float sigmoid_f(float x) { return __builtin_amdgcn_rcpf(1.0f + __builtin_amdgcn_exp2f(-1.4426950408889634f * x)); }
typedef unsigned long long ssq_t;
constexpr float SSQ_SCALE = 16777216.0f, SSQ_INV = 1.0f / 16777216.0f;
__device__ __forceinline__ ssq_t ssq_fix(float s) { return (ssq_t)(s * SSQ_SCALE + 0.5f); }
__device__ __forceinline__ float rstd_of(ssq_t q) { return __builtin_amdgcn_rsqf((float)q * (SSQ_INV * INV_D) + RMS_EPS); }
#define PG8_EPI_CALL() \
    __device__ __forceinline__ void operator()(const f32x4 (&acc)[2][2][4][2], const Unit& u, int wr, int wc, int fr, int fq) const { \
        _Pragma("unroll") for (int ai = 0; ai < 2; ++ai) _Pragma("unroll") for (int m = 0; m < 4; ++m) { \
            const f32x4 a[2][2] = {{acc[ai][0][m][0], acc[ai][0][m][1]}, {acc[ai][1][m][0], acc[ai][1][m][1]}}; rg(a, u, ai, m, 3, wr, wc, fr, fq); } }

struct EpiGateUp {
    static constexpr bool PERM = true, AFTER_DRAIN = false;
    bf16_t* H; int ldh; const ssq_t* ssq;
    __device__ __forceinline__ void rg(const f32x4 (&a)[2][2], const Unit& u, int ai, int m, int bjmask, int wr, int wc, int fr, int fq) const {
        const int row = u.pm * BM + ai * HALF + wr * 64 + m * 16 + fr, col0 = u.pn * HALF + wc * 32 + 8 * fq;
        const float rs = rstd_of(ssq[row]);
        float h[8];
#pragma unroll
        for (int n = 0; n < 2; ++n)
#pragma unroll
            for (int e = 0; e < 4; ++e) { const float g = a[0][n][e] * rs, up = a[1][n][e] * rs; h[4 * n + e] = g * sigmoid_f(g) * up; }
        u32x4 w; w.x = cvt_pk_bf16(h[0], h[1]); w.y = cvt_pk_bf16(h[2], h[3]); w.z = cvt_pk_bf16(h[4], h[5]); w.w = cvt_pk_bf16(h[6], h[7]);
        *(u32x4*)(H + (size_t)row * ldh + col0) = w;
    }
    __device__ __forceinline__ void rgx(const f32x4 (&ax)[2], const Unit& u, int wr, int wc, int fr, int fq) const {
        const int row = 16384 + 16 * u.pm + fr, col0 = u.pn * HALF + wc * 32 + 8 * fq + 4 * wr;
        const float rs = rstd_of(ssq[row]);
        float h[4];
#pragma unroll
        for (int e = 0; e < 4; ++e) { const float g = ax[0][e] * rs, up = ax[1][e] * rs; h[e] = g * sigmoid_f(g) * up; }
        u32x2 w; w.x = cvt_pk_bf16(h[0], h[1]); w.y = cvt_pk_bf16(h[2], h[3]);
        *(u32x2*)(H + (size_t)row * ldh + col0) = w;
    }
    PG8_EPI_CALL()
};

__device__ __forceinline__ void unpack8(const u32x4 w, float (&x)[8]) {
#pragma unroll
    for (int e = 0; e < 4; ++e) { x[2 * e] = __builtin_bit_cast(float, w[e] << 16); x[2 * e + 1] = __builtin_bit_cast(float, w[e] & 0xffff0000u); } }
template <int MODE> struct EpiResid {
    static constexpr bool PERM = true, AFTER_DRAIN = false;
    const float* xin_p; const float* xin_s; bf16_t* XB; ssq_t* ssq; float scale;
    __device__ __forceinline__ void rg(const f32x4 (&a)[2][2], const Unit& u, int ai, int m, int bjmask, int wr, int wc, int fr, int fq) const {
        const int row = u.pm * BM + ai * HALF + wr * 64 + m * 16 + fr;
        const int col0 = (MODE == 0 ? u.pn * BM : u.pn * HALF) + wc * 32 + 8 * fq;
        float sq = 0.f;
#pragma unroll
        for (int bj = 0; bj < (MODE == 0 ? 2 : 1); ++bj) {
            bf16_t* xp = XB + (size_t)row * 1024 + col0 + bj * HALF;
            float x[8];
            if (xin_p) { const float* xi = xin_p + (size_t)row * 1024 + col0 + bj * HALF; const f32x4 x0 = *(const f32x4*)xi, x1 = *(const f32x4*)(xi + 4);
#pragma unroll
                for (int e = 0; e < 4; ++e) { x[e] = x0[e]; x[4 + e] = x1[e]; } }
            else unpack8(*(const u32x4*)xp, x);
#pragma unroll
            for (int e = 0; e < 4; ++e) {
                if (MODE == 0) { x[e] += a[bj][0][e] * scale; x[4 + e] += a[bj][1][e] * scale; }
                else { x[e] += a[0][0][e] * sigmoid_f(a[1][0][e]); x[4 + e] += a[0][1][e] * sigmoid_f(a[1][1][e]); } }
            u32x4 w; w.x = cvt_pk_bf16(x[0], x[1]); w.y = cvt_pk_bf16(x[2], x[3]); w.z = cvt_pk_bf16(x[4], x[5]); w.w = cvt_pk_bf16(x[6], x[7]);
            *(u32x4*)xp = w;
            sq += (x[0] * x[0] + x[1] * x[1]) + (x[2] * x[2] + x[3] * x[3]) + (x[4] * x[4] + x[5] * x[5]) + (x[6] * x[6] + x[7] * x[7]); }
        sq += __shfl_xor(sq, 16); sq += __shfl_xor(sq, 32);
        if (fq == 0) atomicAdd(ssq + row, ssq_fix(sq));
    }
    __device__ __forceinline__ void rgx(const f32x4 (&ax)[2], const Unit& u, int wr, int wc, int fr, int fq) const {
        const int r2 = 16 * u.pm + fr, row = 16384 + r2;
        const int col0 = (MODE == 0 ? u.pn * BM : u.pn * HALF) + wc * 32 + 8 * fq + 4 * wr;
        float sq = 0.f;
#pragma unroll
        for (int bj = 0; bj < (MODE == 0 ? 2 : 1); ++bj) {
            bf16_t* xp = XB + (size_t)row * 1024 + col0 + bj * HALF;
            f32x4 x0;
            if (xin_s) x0 = *(const f32x4*)(xin_s + (size_t)r2 * 1024 + col0 + bj * HALF);
            else { const u32x2 w = *(const u32x2*)xp; x0[0] = __builtin_bit_cast(float, w.x << 16); x0[1] = __builtin_bit_cast(float, w.x & 0xffff0000u); x0[2] = __builtin_bit_cast(float, w.y << 16); x0[3] = __builtin_bit_cast(float, w.y & 0xffff0000u); }
            if (MODE == 0) x0 += ax[bj] * scale;
            else {
#pragma unroll
                for (int e = 0; e < 4; ++e) x0[e] += ax[0][e] * sigmoid_f(ax[1][e]); }
            u32x2 w; w.x = cvt_pk_bf16(x0[0], x0[1]); w.y = cvt_pk_bf16(x0[2], x0[3]);
            *(u32x2*)xp = w;
            sq += (x0[0] * x0[0] + x0[1] * x0[1]) + (x0[2] * x0[2] + x0[3] * x0[3]); }
        sq += __shfl_xor(sq, 16); sq += __shfl_xor(sq, 32);
        if (fq == 0) atomicAdd(ssq + row, ssq_fix(sq));
    }
    PG8_EPI_CALL()
};

struct EpiConvIn {
    static constexpr bool PERM = true, AFTER_DRAIN = false;
    bf16_t* Z; bf16_t* GB; const ssq_t* ssq; float* conv_p; float* conv_s;
    __device__ __forceinline__ void rg(const f32x4 (&a)[2][2], const Unit& u, int ai, int m, int bjmask, int wr, int wc, int fr, int fq) const {
        const int row = u.pm * BM + ai * HALF + wr * 64 + m * 16 + fr;
        const float rs = rstd_of(ssq[row]);
        if (u.pn < 8) {
            const int col0 = u.pn * HALF + wc * 32 + 8 * fq; const float rs2 = rs * rs;
            const f32x4 z0 = a[0][0] * a[1][0] * rs2, z1 = a[0][1] * a[1][1] * rs2;
            u32x4 w; w.x = cvt_pk_bf16(z0[0], z0[1]); w.y = cvt_pk_bf16(z0[2], z0[3]); w.z = cvt_pk_bf16(z1[0], z1[1]); w.w = cvt_pk_bf16(z1[2], z1[3]);
            *(u32x4*)(Z + (size_t)row * 1024 + col0) = w;
            float* cp = nullptr;
            if (row < 16384) { const int t = row & 2047; if (t >= 2046) cp = conv_p + ((size_t)(row >> 11) * 2 + (t - 2046)) * 1024 + col0; }
            else { const int r2 = row - 16384, t = r2 & 7; if (t >= 6) cp = conv_s + ((size_t)(r2 >> 3) * 2 + (t - 6)) * 1024 + col0; }
            if (cp) { *(f32x4*)cp = z0; *(f32x4*)(cp + 4) = z1; }
        } else {
            const int col0 = (u.pn - 8) * BM + wc * 32 + 8 * fq;
#pragma unroll
            for (int bj = 0; bj < 2; ++bj) { const f32x4 g0 = a[bj][0] * rs, g1 = a[bj][1] * rs;
                u32x4 w; w.x = cvt_pk_bf16(g0[0], g0[1]); w.y = cvt_pk_bf16(g0[2], g0[3]); w.z = cvt_pk_bf16(g1[0], g1[1]); w.w = cvt_pk_bf16(g1[2], g1[3]);
                *(u32x4*)(GB + (size_t)row * 1024 + col0 + bj * HALF) = w; }
        }
    }
    __device__ __forceinline__ void rgx(const f32x4 (&ax)[2], const Unit& u, int wr, int wc, int fr, int fq) const {
        const int r2 = 16 * u.pm + fr, row = 16384 + r2;
        const float rs = rstd_of(ssq[row]);
        if (u.pn < 8) {
            const int col0 = u.pn * HALF + wc * 32 + 8 * fq + 4 * wr;
            const f32x4 z0 = ax[0] * ax[1] * (rs * rs);
            u32x2 w; w.x = cvt_pk_bf16(z0[0], z0[1]); w.y = cvt_pk_bf16(z0[2], z0[3]);
            *(u32x2*)(Z + (size_t)row * 1024 + col0) = w;
            const int t = r2 & 7;
            if (t >= 6) *(f32x4*)(conv_s + ((size_t)(r2 >> 3) * 2 + (t - 6)) * 1024 + col0) = z0;
        } else {
            const int col0 = (u.pn - 8) * BM + wc * 32 + 8 * fq + 4 * wr;
#pragma unroll
            for (int bj = 0; bj < 2; ++bj) { const f32x4 g0 = ax[bj] * rs;
                u32x2 w; w.x = cvt_pk_bf16(g0[0], g0[1]); w.y = cvt_pk_bf16(g0[2], g0[3]);
                *(u32x2*)(GB + (size_t)row * 1024 + col0 + bj * HALF) = w; }
        }
    }
    PG8_EPI_CALL()
};

struct EpiNull {
    static constexpr bool PERM = true, AFTER_DRAIN = false;
    bf16_t* sink;
    __device__ __forceinline__ void rg(const f32x4 (&a)[2][2], const Unit& u, int ai, int m, int bjmask, int wr, int wc, int fr, int fq) const {
        asm volatile("" :: "v"(a[0][0]), "v"(a[0][1]), "v"(a[1][0]), "v"(a[1][1]));
    }
    __device__ __forceinline__ void rgx(const f32x4 (&ax)[2], const Unit& u, int wr, int wc, int fr, int fq) const { asm volatile("" :: "v"(ax[0]), "v"(ax[1])); }
    PG8_EPI_CALL()
};

template <class Epi, class Sched, bool ALIGN_EPI = false, bool SP2 = false, int PROBE = 0>
__device__ __forceinline__ void gemm_phase(PG8_LAS unsigned char* lds, const Gemm g, const Sched& S, const Epi& E) {
    int tid_ = threadIdx.x; asm volatile("" : "+v"(tid_));
    const int tid = tid_, wid = __builtin_amdgcn_readfirstlane(tid >> 6), lane = tid & 63, wr = wid >> 2, wc = wid & 3, fr = lane & 15, fq = lane >> 4;
    const int K = g.K, nt = K / BK;
    constexpr int XROW0 = 16384, XR = 16;
    unsigned voffA[2], voffB[2];
#pragma unroll
    for (int i = 0; i < 2; ++i) { int R, C; stage_rc(tid * 16 + i * 8192, R, C); const int Rb = Epi::PERM ? ((R & ~31) + perm32(R & 31)) : R;
        voffA[i] = (unsigned)(R * K + C) * 2u; voffB[i] = (unsigned)(Rb * K + C) * 2u; }
    unsigned voffX; { const int p = (wid & 3) * 1024 + lane * 16, bq = p >> 11, q = p & 2047, row = q >> 7, kb = (q & 127) ^ (((row >> 1) & 7) << 4); voffX = (unsigned)(row * K * 2 + bq * 128 + kb); }
    int xoff0 = fr * 128 + ((fq * 16) ^ (((fr >> 1) & 7) << 4)), xoff1 = fr * 128 + ((64 + fq * 16) ^ (((fr >> 1) & 7) << 4));
    unsigned xpw = 4096;
    const unsigned kstep = (unsigned)(BK * 2);
    const unsigned hstep = (unsigned)HALF * K * 2;
    const unsigned tstep = 2 * hstep;
    const __amdgpu_buffer_rsrc_t rsA = __builtin_amdgcn_make_buffer_rsrc((void*)g.A, 0, 0x7ffff000, 0x00020000), rsB = __builtin_amdgcn_make_buffer_rsrc((void*)g.Bt, 0, 0x7ffff000, 0x00020000);
    const unsigned ldsw = (unsigned)wid * 1024u;
    const int aoff = lds_byte(wr * 64 + fr, fq * 8), boff = lds_byte(wc * 32 + fr, fq * 8);
#define PG8_SA(b, h) (((b) * 2 + (h)) * HTB)
#define PG8_SB(b, h) ((4 + (b) * 2 + (h)) * HTB)
#define PG8_SX(b) (STAGE_BYTES + (b) * 2048)
#define PG8_STAGEXP(soff) do { if constexpr ((PROBE & (6 | 16)) == 0) { if (wr == 0) __builtin_amdgcn_raw_ptr_buffer_load_lds(rsA, (PG8_LAS unsigned*)(lds + STAGE_BYTES + xpw + wid * 1024), 16, voffX, (soff), 0, 0); } } while (0)
#define PG8_LDAX(dst, b) do { if constexpr ((PROBE & (10 | 32)) == 0) { dst[0] = *(const PG8_LAS bf16x8*)(lds + PG8_SX(b) + xoff0); dst[1] = *(const PG8_LAS bf16x8*)(lds + PG8_SX(b) + xoff1); } } while (0)
#define PG8_WAIT_LT(nl, nt) do { if (wr == 0) PG8_WAIT_V(nl); else PG8_WAIT_V(nt); } while (0)
#define PG8_MMAX_NULL() do { asm volatile("" :: "v"(Ax[0]), "v"(Ax[1])); } while (0)
#define PG8_MMAX_REAL() do { if (wr == 0) { _Pragma("unroll") for (int k = 0; k < 2; ++k) { accx[0] = __builtin_amdgcn_mfma_f32_16x16x32_bf16(B0[0][k], Ax[k], accx[0], 0, 0, 0); accx[1] = __builtin_amdgcn_mfma_f32_16x16x32_bf16(B1[0][k], Ax[k], accx[1], 0, 0, 0); } } \
        else { _Pragma("unroll") for (int k = 0; k < 2; ++k) { accx[0] = __builtin_amdgcn_mfma_f32_16x16x32_bf16(B0[1][k], Ax[k], accx[0], 0, 0, 0); accx[1] = __builtin_amdgcn_mfma_f32_16x16x32_bf16(B1[1][k], Ax[k], accx[1], 0, 0, 0); } } } while (0)
#define PG8_MMAX() do { if constexpr ((PROBE & (2 | 32)) != 0) { } else if constexpr ((PROBE & 1) != 0) PG8_MMAX_NULL(); else PG8_MMAX_REAL(); } while (0)
#define PG8_STAGEA(bufoff, soff) do { if constexpr ((PROBE & 4) == 0) _Pragma("unroll") for (int _i = 0; _i < 2; ++_i) \
        __builtin_amdgcn_raw_ptr_buffer_load_lds(rsA, (PG8_LAS unsigned*)(lds + (bufoff) + ldsw + _i * 8192), 16, voffA[_i], (soff), 0, 0); } while (0)
#define PG8_STAGEB(bufoff, soff) do { if constexpr ((PROBE & 4) == 0) _Pragma("unroll") for (int _i = 0; _i < 2; ++_i) \
        __builtin_amdgcn_raw_ptr_buffer_load_lds(rsB, (PG8_LAS unsigned*)(lds + (bufoff) + ldsw + _i * 8192), 16, voffB[_i], (soff), 0, 0); } while (0)
#define PG8_LDA(dst, b, h) do { if constexpr ((PROBE & 8) == 0) { _Pragma("unroll") for (int m = 0; m < 4; ++m) _Pragma("unroll") for (int k = 0; k < 2; ++k) dst[m][k] = *(const PG8_LAS bf16x8*)(lds + PG8_SA(b, h) + aoff + m * 2048 + k * 1024); } } while (0)
#define PG8_LDB(dst, b, h) do { if constexpr ((PROBE & 8) == 0) { _Pragma("unroll") for (int n = 0; n < 2; ++n) _Pragma("unroll") for (int k = 0; k < 2; ++k) dst[n][k] = *(const PG8_LAS bf16x8*)(lds + PG8_SB(b, h) + boff + n * 2048 + k * 1024); } } while (0)
#define PG8_MMA_NULL(ai, bj, At, Bt) do { _Pragma("unroll") for (int m = 0; m < 4; ++m) _Pragma("unroll") for (int k = 0; k < 2; ++k) asm volatile("" :: "v"(At[m][k])); _Pragma("unroll") for (int n = 0; n < 2; ++n) _Pragma("unroll") for (int k = 0; k < 2; ++k) asm volatile("" :: "v"(Bt[n][k])); } while (0)
#define PG8_MMA_REAL(ai, bj, At, Bt) do { __builtin_amdgcn_s_setprio(1); _Pragma("unroll") for (int m = 0; m < 4; ++m) _Pragma("unroll") for (int n = 0; n < 2; ++n) _Pragma("unroll") for (int k = 0; k < 2; ++k) \
        acc[ai][bj][m][n] = __builtin_amdgcn_mfma_f32_16x16x32_bf16(Bt[n][k], At[m][k], acc[ai][bj][m][n], 0, 0, 0); __builtin_amdgcn_s_setprio(0); } while (0)
#define PG8_MMA(ai, bj, At, Bt) do { if constexpr ((PROBE & 1) != 0) PG8_MMA_NULL(ai, bj, At, Bt); else PG8_MMA_REAL(ai, bj, At, Bt); } while (0)
#define PG8_WAIT_V(n) asm volatile("s_waitcnt vmcnt(" #n ")" ::: "memory")
#define PG8_WAIT_L(n) asm volatile("s_waitcnt lgkmcnt(" #n ")" ::: "memory")
#define PG8_BAR __builtin_amdgcn_s_barrier()
#define PG8_SCHED __builtin_amdgcn_sched_barrier(0)
    Unit cur, nxt; int ui = 0;
    if (!S.next(0, cur)) return;
    f32x4 acc[2][2][4][2];
#pragma unroll
    for (int a = 0; a < 2; ++a)
#pragma unroll
        for (int b = 0; b < 2; ++b)
#pragma unroll
            for (int m = 0; m < 4; ++m)
#pragma unroll
                for (int n = 0; n < 2; ++n) acc[a][b][m][n] = (f32x4){0.f, 0.f, 0.f, 0.f};
    bf16x8 At[4][2], B0[2][2], B1[2][2], Ax[2];
    if constexpr ((PROBE & 8) != 0) {
#pragma unroll
        for (int m = 0; m < 4; ++m)
#pragma unroll
            for (int k = 0; k < 2; ++k) asm volatile("" : "=v"(At[m][k]));
#pragma unroll
        for (int n = 0; n < 2; ++n)
#pragma unroll
            for (int k = 0; k < 2; ++k) { asm volatile("" : "=v"(B0[n][k])); asm volatile("" : "=v"(B1[n][k])); }
        asm volatile("" : "=v"(Ax[0])); asm volatile("" : "=v"(Ax[1])); }
    f32x4 accx[2] = {(f32x4){0.f, 0.f, 0.f, 0.f}, (f32x4){0.f, 0.f, 0.f, 0.f}};
    unsigned cA = (unsigned)cur.pm * tstep, cB = (unsigned)cur.pn * tstep;
    const unsigned xstep = (unsigned)XR * K * 2, xbase = (unsigned)XROW0 * K * 2; unsigned cX = xbase + (unsigned)cur.pm * xstep;
    S.a_ready(cur);
    if constexpr (SP2) {
        PG8_STAGEB(PG8_SB(0, 0), cB); PG8_STAGEB(PG8_SB(0, 1), cB + hstep); PG8_STAGEA(PG8_SA(0, 0), cA); { const unsigned keep_ = xpw; xpw = 0; PG8_STAGEXP(cX); xpw = keep_; } PG8_STAGEA(PG8_SA(0, 1), cA + hstep);
        if (wr == 1) PG8_BAR;
        PG8_WAIT_V(2); PG8_BAR;
        PG8_STAGEB(PG8_SB(1, 0), cB + kstep); PG8_STAGEA(PG8_SA(1, 0), cA + kstep); PG8_STAGEB(PG8_SB(1, 1), cB + hstep + kstep);
        PG8_WAIT_V(6); PG8_BAR;
    } else {
        PG8_STAGEB(PG8_SB(0, 0), cB); PG8_STAGEA(PG8_SA(0, 0), cA); PG8_STAGEB(PG8_SB(0, 1), cB + hstep); PG8_STAGEA(PG8_SA(0, 1), cA + hstep);
        if (wr == 1) PG8_BAR;
        PG8_WAIT_V(4); PG8_BAR;
        PG8_STAGEB(PG8_SB(1, 0), cB + kstep); PG8_STAGEA(PG8_SA(1, 0), cA + kstep); PG8_STAGEB(PG8_SB(1, 1), cB + hstep + kstep);
        PG8_WAIT_V(6); PG8_BAR;
    }
    for (;;) {
        const bool has_next = S.next(ui + 1, nxt);
        const unsigned nA = has_next ? (unsigned)nxt.pm * tstep : cA, nB = has_next ? (unsigned)nxt.pn * tstep : cB, nX = has_next ? xbase + (unsigned)nxt.pm * xstep : cX;
        for (int t = 0; t < nt; t += 2) {
            const bool last = (t == nt - 2);
            const unsigned a1 = cA + (unsigned)(t + 1) * kstep;
            const unsigned a2 = last ? nA : cA + (unsigned)(t + 2) * kstep, b2 = last ? nB : cB + (unsigned)(t + 2) * kstep;
            const unsigned a3 = a2 + kstep, b3 = b2 + kstep, x2 = last ? nX : cX + (unsigned)(t + 2) * kstep;
            if (last && has_next) S.a_ready(nxt);
            if constexpr (SP2) {
            PG8_LDB(B0, 0, 0); PG8_LDB(B1, 0, 1); PG8_SCHED; PG8_LDA(At, 0, 0); PG8_LDAX(Ax, 0); PG8_STAGEXP(x2); PG8_STAGEA(PG8_SA(1, 1), a1 + hstep);
            PG8_WAIT_LT(9, 8); PG8_WAIT_L(0); PG8_BAR; PG8_MMA(0, 0, At, B0); PG8_MMA(0, 1, At, B1); PG8_MMAX(); PG8_BAR; PG8_SCHED;
            PG8_LDA(At, 0, 1); PG8_STAGEB(PG8_SB(0, 0), b2); PG8_STAGEB(PG8_SB(0, 1), b2 + hstep); PG8_STAGEA(PG8_SA(0, 0), a2);
            PG8_WAIT_LT(9, 8); PG8_WAIT_L(0); PG8_BAR; PG8_MMA(1, 0, At, B0); PG8_MMA(1, 1, At, B1); PG8_BAR; PG8_SCHED;
            PG8_LDB(B0, 1, 0); PG8_LDB(B1, 1, 1); PG8_SCHED; PG8_LDA(At, 1, 0); PG8_LDAX(Ax, 1); PG8_STAGEA(PG8_SA(0, 1), a2 + hstep);
            PG8_WAIT_V(8); PG8_WAIT_L(0); PG8_BAR; PG8_MMA(0, 0, At, B0); PG8_MMA(0, 1, At, B1); PG8_MMAX(); PG8_BAR; PG8_SCHED;
            PG8_LDA(At, 1, 1); PG8_STAGEB(PG8_SB(1, 0), b3); PG8_STAGEB(PG8_SB(1, 1), b3 + hstep); PG8_STAGEA(PG8_SA(1, 0), a3);
            PG8_WAIT_V(8); PG8_WAIT_L(0); PG8_BAR; PG8_MMA(1, 0, At, B0); PG8_MMA(1, 1, At, B1); PG8_BAR; PG8_SCHED;
            xpw ^= 4096u; xoff0 ^= 4096; xoff1 ^= 4096;
            } else {
            PG8_LDB(B0, 0, 0); PG8_SCHED; PG8_LDA(At, 0, 0); PG8_STAGEA(PG8_SA(1, 1), a1 + hstep);
            PG8_WAIT_L(8); PG8_BAR; PG8_WAIT_L(0); PG8_MMA(0, 0, At, B0); PG8_BAR; PG8_SCHED;
            PG8_LDB(B1, 0, 1); PG8_STAGEB(PG8_SB(0, 0), b2);
            PG8_BAR; PG8_WAIT_L(0); PG8_MMA(0, 1, At, B1); PG8_BAR;
            PG8_LDA(At, 0, 1); PG8_STAGEA(PG8_SA(0, 0), a2);
            PG8_BAR; PG8_WAIT_L(0); PG8_MMA(1, 0, At, B0); PG8_BAR; PG8_SCHED;
            PG8_STAGEB(PG8_SB(0, 1), b2 + hstep);
            PG8_WAIT_V(6); PG8_BAR; PG8_MMA(1, 1, At, B1); PG8_BAR;
            PG8_LDB(B0, 1, 0); PG8_SCHED; PG8_LDA(At, 1, 0); PG8_STAGEA(PG8_SA(0, 1), a2 + hstep);
            PG8_WAIT_L(8); PG8_BAR; PG8_WAIT_L(0); PG8_MMA(0, 0, At, B0); PG8_BAR; PG8_SCHED;
            PG8_LDB(B1, 1, 1); PG8_STAGEB(PG8_SB(1, 0), b3);
            PG8_BAR; PG8_WAIT_L(0); PG8_MMA(0, 1, At, B1); PG8_BAR;
            PG8_LDA(At, 1, 1); PG8_STAGEA(PG8_SA(1, 0), a3);
            PG8_BAR; PG8_WAIT_L(0); PG8_MMA(1, 0, At, B0); PG8_BAR; PG8_SCHED;
            PG8_STAGEB(PG8_SB(1, 1), b3 + hstep);
            PG8_WAIT_V(6); PG8_BAR; PG8_MMA(1, 1, At, B1); PG8_BAR;
            }
        }
        if constexpr (ALIGN_EPI) { if (wr == 0) PG8_BAR; }
        E(acc, cur, wr, wc, fr, fq); E.rgx(accx, cur, wr, wc, fr, fq);
        if (!has_next) break;
#pragma unroll
        for (int a = 0; a < 2; ++a)
#pragma unroll
            for (int b = 0; b < 2; ++b)
#pragma unroll
                for (int m = 0; m < 4; ++m)
#pragma unroll
                    for (int n = 0; n < 2; ++n) acc[a][b][m][n] = (f32x4){0.f, 0.f, 0.f, 0.f};
        accx[0] = (f32x4){0.f, 0.f, 0.f, 0.f}; accx[1] = (f32x4){0.f, 0.f, 0.f, 0.f};
        cur = nxt; cA = nA; cB = nB; cX = nX; ++ui;
        if constexpr (ALIGN_EPI) { if (wr == 1) PG8_BAR; }
    }
    PG8_WAIT_V(0);
    if constexpr (!ALIGN_EPI) { if (wr == 0) PG8_BAR; }
    PG8_BAR;
#undef PG8_SA
#undef PG8_SB
#undef PG8_STAGEA
#undef PG8_STAGEB
#undef PG8_SX
#undef PG8_STAGEXP
#undef PG8_WAIT_LT
#undef PG8_LDAX
#undef PG8_MMAX
#undef PG8_LDA
#undef PG8_LDB
#undef PG8_MMA
#undef PG8_WAIT_V
#undef PG8_WAIT_L
#undef PG8_BAR
#undef PG8_SCHED
}
}

#define GAS __attribute__((address_space(1)))
#define LAS __attribute__((address_space(3)))
typedef unsigned short bf16;
typedef unsigned v4u __attribute__((ext_vector_type(4)));
typedef float f32x4 __attribute__((ext_vector_type(4)));
typedef short bf16x8 __attribute__((ext_vector_type(8)));
typedef GAS unsigned gu32;
typedef GAS unsigned long long gu64;
#define RLX_AGENT __ATOMIC_RELAXED, __HIP_MEMORY_SCOPE_AGENT
#define LDS_WAIT() asm volatile("s_waitcnt lgkmcnt(0)" ::: "memory")
#define VM_WAIT() asm volatile("s_waitcnt vmcnt(0)" ::: "memory")
__device__ __forceinline__ unsigned long long rt() { return __builtin_amdgcn_s_memrealtime(); }
__device__ __forceinline__ unsigned f2bf(float f) { unsigned u = __builtin_bit_cast(unsigned, f); return (u + 0x7fffu + ((u >> 16) & 1u)) >> 16; }
__device__ __forceinline__ unsigned pk2(float lo, float hi) { return f2bf(lo) | (f2bf(hi) << 16); }

#define XB_TMO      128
#define XB_XCNT(j)  (256  + 64 * (j))
#define XB_XSUB(j)  (1280 + 64 * (j))
#define XB_XGEN(j)  (2304 + 64 * (j))
#define XB_TOP      3328
#define XB_TOPGEN   3392
#define XCD_BAR_WORDS 3456
#define XB_SPIN_CAP (1u << 18)

__device__ __forceinline__ unsigned xb_ld(unsigned* p)              { return __hip_atomic_load(p, __ATOMIC_RELAXED, __HIP_MEMORY_SCOPE_AGENT); }
__device__ __forceinline__ unsigned xb_add(unsigned* p, unsigned v) { return __hip_atomic_fetch_add(p, v, __ATOMIC_RELAXED, __HIP_MEMORY_SCOPE_AGENT); }
__device__ __forceinline__ unsigned xb_xcc_id() { return (unsigned)__builtin_amdgcn_s_getreg((3 << 11) | 20) & 0xFu; }
#define XB_SPIN(cond, bar) do { unsigned _sp = 0; while (cond) { __builtin_amdgcn_s_sleep(1); \
    if ((++_sp & 255u) == 0u) { if (xb_ld(&(bar)[XB_TMO])) break; if (_sp > XB_SPIN_CAP) { atomicAdd(&(bar)[XB_TMO], 1u); break; } } } } while (0)

struct XcdBarrier {
    unsigned* bar; unsigned x; unsigned n;
    volatile LAS unsigned* st;
};

__device__ __forceinline__ XcdBarrier xcd_barrier_post(unsigned* bar, volatile LAS unsigned* st, unsigned n) {
    XcdBarrier b; b.bar = bar; b.x = xb_xcc_id(); b.st = st; b.n = n;
    if (threadIdx.x == 0) (void)xb_add(&bar[XB_XCNT(b.x)], 1u);
    return b;
}
__device__ __forceinline__ void xcd_barrier_complete(unsigned* bar, unsigned x, unsigned G, unsigned& nloc, unsigned& nx) {
    unsigned sum, cnt, mine, sp = 0u;
    for (;;) {
        sum = 0u; cnt = 0u; mine = 0u;
#pragma unroll
        for (unsigned j = 0; j < 16; ++j) { const unsigned c = xb_ld(&bar[XB_XCNT(j)]); sum += c; cnt += (c > 0u) ? 1u : 0u; mine = (j == x) ? c : mine; }
        if (sum == G) break;
        __builtin_amdgcn_s_sleep(1);
        if ((++sp & 255u) == 0u) { if (xb_ld(&bar[XB_TMO])) break; if (sp > XB_SPIN_CAP) { atomicAdd(&bar[XB_TMO], 1u); break; } }
    }
    nloc = mine > 0u ? mine : 1u; nx = cnt > 0u ? cnt : 1u;
}

__device__ __forceinline__ void xcd_barrier(const XcdBarrier& b) {
    asm volatile("s_waitcnt vmcnt(0)" ::: "memory");
    __syncthreads();
    if (threadIdx.x == 0) {
        unsigned* bar = b.bar;
        __builtin_amdgcn_s_waitcnt(0);
        unsigned nloc = b.st[0], nx = b.st[1];
        if (nloc == 0u) { xcd_barrier_complete(bar, b.x, b.n, nloc, nx); b.st[0] = nloc; b.st[1] = nx; }
        const unsigned old = xb_add(&bar[XB_XSUB(b.x)], 1u);
        const unsigned gen = old / nloc;
        if (old + 1u == (gen + 1u) * nloc) {
            __builtin_amdgcn_fence(__ATOMIC_RELEASE, "agent");
            asm volatile("s_waitcnt vmcnt(0)" ::: "memory");
            const unsigned og = xb_add(&bar[XB_TOP], 1u);
            const unsigned tg = og / nx;
            if (og + 1u == (tg + 1u) * nx) xb_add(&bar[XB_TOPGEN], 1u);
            else XB_SPIN(xb_ld(&bar[XB_TOPGEN]) == tg, bar);
            __builtin_amdgcn_fence(__ATOMIC_ACQUIRE, "agent");
            xb_add(&bar[XB_XGEN(b.x)], 1u);
            asm volatile("s_waitcnt vmcnt(0)" ::: "memory");
        } else {
            XB_SPIN(xb_ld(&bar[XB_XGEN(b.x)]) == gen, bar);
            __builtin_amdgcn_fence(__ATOMIC_ACQUIRE, "agent");
            asm volatile("s_waitcnt vmcnt(0)" ::: "memory");
        }
    }
    __syncthreads();
}


constexpr int NWAVES = 8;
#ifndef MK_ONE_LAUNCH
#define MK_ONE_LAUNCH 1
#endif
constexpr int N_PHASES = 15;

constexpr int D = 1024, FF = 4096, MP = 8 * 2048, MS = 128 * 8, M = MP + MS;
constexpr int NG = 64, PS = 64, GS = 16;
constexpr float EPS = 1e-6f;
constexpr size_t O_Y = 0, O_SRP = (size_t)M * D, O_SIP = O_SRP + 8 * 4096, O_CP = O_SIP + 8 * 4096, O_SRS = O_CP + 8 * 2 * 1024, O_SIS = O_SRS + 128 * 4096, O_CS = O_SIS + 128 * 4096, O_END = O_CS + 128 * 2 * 1024;
static_assert(O_END == 19218432, "output size");

constexpr size_t MiB = 1u << 20;
constexpr size_t WS_CTL = 0, CTL_ZERO_BYTES = 1 * MiB;
constexpr size_t WS_SSQ = 112 * MiB;
constexpr size_t WS_SSME = 114 * MiB;
constexpr size_t WS_SSMP = 2 * MiB;
constexpr size_t WS_WGU = 4 * MiB;
constexpr size_t WS_WD = 68 * MiB;
constexpr size_t WS_WGLU = 100 * MiB;
constexpr size_t WS_WIN = 104 * MiB;
constexpr size_t WS_WOUT = 110 * MiB;
constexpr size_t WS_X = 112 * MiB;
constexpr size_t WS_XB = 180 * MiB;
constexpr size_t WS_H = 214 * MiB;
constexpr size_t WS_G = 350 * MiB, WS_A2 = WS_G, WS_Z = 384 * MiB, WS_GB = 418 * MiB;
constexpr size_t WS_END = 452 * MiB;
constexpr int CW_TMO = 0;
constexpr int CW_BAR = 4096;
constexpr int CW_SK = 16384;

constexpr int RING_OFF = 0, RING_BYTES = 131072 + 8192;
constexpr int LDSCTL_OFF = RING_BYTES, MISC_OFF = LDSCTL_OFF + 320;
constexpr int LDS_BYTES = 147456;

struct Frame {
    LAS unsigned char* lds;
    volatile LAS unsigned* MISC;
    gu32* ctl;
    int tid, lane, wave, vcu, G, gi, ci;
    const float* in[21]; float* out; unsigned char* ws;
};

__device__ __forceinline__ int opaque_i(int v) { asm volatile("" : "+v"(v)); return v; }
__device__ __forceinline__ float wave_sum(float v) {
#pragma unroll
    for (int o = 1; o < 64; o <<= 1) v += __shfl_xor(v, o);
    return v;
}
__device__ __forceinline__ float bf2f(unsigned short b) { return __builtin_bit_cast(float, (unsigned)b << 16); }

struct P0Item { const float* W; bf16* WT; const float* gk; int K, N, k0, n0s, n0d; };
__device__ __forceinline__ int pair_src(int nd, int base, int hstride) { return base + ((nd >> 7) & 1) * hstride + 128 * (nd >> 8) + (nd & 127); }
__device__ __forceinline__ P0Item p0_item(Frame& F, int it) {
    constexpr int I_GU = (D / 64) * (2 * FF / 64), I_D = (FF / 64) * (D / 64), I_GLU = (D / 64) * (2 * D / 64), I_IN = (D / 64) * (3 * D / 64);
    const float* norm_g = F.in[5]; P0Item p; int r = it;
    if (r < 4 * I_GU) { const int f = r / I_GU; r -= f * I_GU; const int nb = r % (2 * FF / 64), kb = r / (2 * FF / 64), nd = 64 * nb;
        p.W = F.in[7] + (size_t)f * D * 2 * FF; p.K = D; p.N = 2 * FF; p.WT = (bf16*)(F.ws + WS_WGU) + (size_t)f * 2 * FF * D; p.gk = norm_g + ((f >> 1) * 3 + (f & 1) * 2) * D; p.k0 = 64 * kb; p.n0s = pair_src(nd, 0, FF); p.n0d = nd; return p; }
    r -= 4 * I_GU;
    if (r < 4 * I_D) { const int f = r / I_D; r -= f * I_D; const int nb = r % (D / 64), kb = r / (D / 64), nd = 64 * nb;
        p.W = F.in[8] + (size_t)f * FF * D; p.K = FF; p.N = D; p.WT = (bf16*)(F.ws + WS_WD) + (size_t)f * D * FF; p.gk = nullptr; p.k0 = 64 * kb; p.n0s = nd; p.n0d = nd; return p; }
    r -= 4 * I_D;
    if (r < I_GLU) { const int nb = r % (2 * D / 64), kb = r / (2 * D / 64), nd = 64 * nb;
        p.W = F.in[17]; p.K = D; p.N = 2 * D; p.WT = (bf16*)(F.ws + WS_WGLU); p.gk = nullptr; p.k0 = 64 * kb; p.n0s = pair_src(nd, 0, D); p.n0d = nd; return p; }
    r -= I_GLU;
    if (r < I_IN) { const int nb = r % (3 * D / 64), kb = r / (3 * D / 64), nd = 64 * nb;
        p.W = F.in[18]; p.K = D; p.N = 3 * D; p.WT = (bf16*)(F.ws + WS_WIN); p.gk = norm_g + 4 * D; p.k0 = 64 * kb; p.n0s = nd < 2048 ? pair_src(nd, D, D) : nd - 2048; p.n0d = nd; return p; }
    r -= I_IN;
    { const int nb = r % (D / 64), kb = r / (D / 64), nd = 64 * nb;
        p.W = F.in[20]; p.K = D; p.N = D; p.WT = (bf16*)(F.ws + WS_WOUT); p.gk = nullptr; p.k0 = 64 * kb; p.n0s = nd; p.n0d = nd; return p; }
}
#define P0_LOAD(v, gs, p) do { _Pragma("unroll") for (int i = 0; i < 8; ++i) _Pragma("unroll") for (int s = 0; s < 2; ++s) { \
        v[i][s] = *(const GAS f32x4*)((p).W + (size_t)((p).k0 + 8 * i + 2 * kr + s) * (p).N + (p).n0s + 4 * c); gs[i][s] = (p).gk ? (p).gk[(p).k0 + 8 * i + 2 * kr + s] : 1.0f; } } while (0)
#define P0_PROC(v, gs, p) do { \
        _Pragma("unroll") for (int i = 0; i < 8; ++i) _Pragma("unroll") for (int j = 0; j < 4; ++j) \
            *(LAS unsigned*)(scr + (4 * c + j) * 128 + (((4 * i + kr) ^ ((c & 7) << 2)) << 2)) = pg8::cvt_pk_bf16(v[i][0][j] * gs[i][0], v[i][1][j] * gs[i][1]); \
        LDS_WAIT(); asm volatile("" ::: "memory"); \
        _Pragma("unroll") for (int i = 0; i < 8; ++i) { const int n = nr + 8 * i; const v4u o = *(const LAS v4u*)(scr + n * 128 + ((q ^ ((n >> 2) & 7)) << 4)); \
            *(GAS v4u*)((p).WT + (size_t)((p).n0d + n) * (p).K + (p).k0 + 8 * q) = o; } \
        LDS_WAIT(); asm volatile("" ::: "memory"); } while (0)

__device__ __forceinline__ void p0_prologue(Frame& F) {
    LAS unsigned char* scr = F.lds + RING_OFF + F.wave * 16384;
    const int gw = F.vcu * NWAVES + F.wave, NGW = F.G * NWAVES, lane = opaque_i(F.lane);
    constexpr int NITEMS = 4 * (D / 64) * (2 * FF / 64) + 4 * (FF / 64) * (D / 64) + (D / 64) * (2 * D / 64) + (D / 64) * (3 * D / 64) + (D / 64) * (D / 64);
    { const int kr = lane >> 4, c = lane & 15, nr = lane >> 3, q = lane & 7;
      f32x4 va[8][2], vb[8][2]; float ga[8][2], gb[8][2];
      int it = gw; P0Item pa = p0_item(F, it < NITEMS ? it : 0), pb = pa;
      if (it < NITEMS) P0_LOAD(va, ga, pa);
      while (it < NITEMS) {
          const int it1 = it + NGW; if (it1 < NITEMS) { pb = p0_item(F, it1); P0_LOAD(vb, gb, pb); }
          P0_PROC(va, ga, pa);
          if (it1 >= NITEMS) break;
          const int it2 = it1 + NGW; if (it2 < NITEMS) { pa = p0_item(F, it2); P0_LOAD(va, ga, pa); }
          P0_PROC(vb, gb, pb);
          it = it2;
      }
    }
    bf16* XB = (bf16*)(F.ws + WS_XB); pg8::ssq_t* ssq = (pg8::ssq_t*)(F.ws + WS_SSQ);
    for (int m0 = gw; m0 < M; m0 += 4 * NGW) {
        f32x4 v[4][4];
#pragma unroll
        for (int r = 0; r < 4; ++r) { const int m = m0 + r * NGW; if (m < M) { const float* src = m < MP ? F.in[0] + (size_t)m * D : F.in[1] + (size_t)(m - MP) * D;
#pragma unroll
            for (int j = 0; j < 4; ++j) v[r][j] = ((const GAS f32x4*)src)[lane + 64 * j]; } }
#pragma unroll
        for (int r = 0; r < 4; ++r) { const int m = m0 + r * NGW; if (m < M) {
            GAS unsigned long long* o8 = (GAS unsigned long long*)(XB + (size_t)m * D) + lane; float s = 0.f;
#pragma unroll
            for (int j = 0; j < 4; ++j) { const f32x4 w = v[r][j]; s += (w.x * w.x + w.y * w.y) + (w.z * w.z + w.w * w.w);
                o8[64 * j] = (unsigned long long)pg8::cvt_pk_bf16(w.x, w.y) | ((unsigned long long)pg8::cvt_pk_bf16(w.z, w.w) << 32); }
            s = wave_sum(s);
            if (lane == 0) ssq[m] = pg8::ssq_fix(s); } }
    }
    for (int i = gw * 64 + lane; i < 7 * M; i += NGW * 64) ssq[M + i] = 0ull;
    float* sp = (float*)(F.ws + WS_SSMP);
    for (int i = gw * 64 + lane; i < NG * PS; i += NGW * 64) {
        const int g = i / PS;
        const float lr = F.in[9][i], li = F.in[10][i], dt = expf(F.in[11][g]);
        const float mag = expf(lr * dt); float sn, cs; sincosf(li * dt, &sn, &cs);
        const float lbr = mag * cs, lbi = mag * sn, den = lr * lr + li * li, nr = lbr - 1.0f, ni = lbi;
        const float fr = (nr * lr + ni * li) / den, fi = (ni * lr - nr * li) / den;
        sp[i] = lbr; sp[4096 + i] = lbi;
#pragma unroll
        for (int c = 0; c < GS; ++c) { const float br = F.in[12][(size_t)i * GS + c], bi = F.in[13][(size_t)i * GS + c];
            sp[8192 + (size_t)i * GS + c] = fr * br - fi * bi; sp[8192 + 65536 + (size_t)i * GS + c] = fr * bi + fi * br; }
    }
}

__device__ __forceinline__ float gelu_tanh(float x) {
    const float a = 0.7978845608028654f * (x + 0.044715f * x * x * x);
    return x * __builtin_amdgcn_rcpf(1.0f + __builtin_amdgcn_exp2f(-2.0f * 1.4426950408889634f * a));
}


typedef float f32x16 __attribute__((ext_vector_type(16)));
typedef unsigned u32x2v __attribute__((ext_vector_type(2)));
__device__ __forceinline__ unsigned cvtpk(float lo, float hi) { unsigned r; asm volatile("v_cvt_pk_bf16_f32 %0, %1, %2" : "=v"(r) : "v"(lo), "v"(hi)); return r; }
__device__ __forceinline__ bf16x8 pack8(const float* v) { v4u w; w.x = cvtpk(v[0], v[1]); w.y = cvtpk(v[2], v[3]); w.z = cvtpk(v[4], v[5]); w.w = cvtpk(v[6], v[7]); return __builtin_bit_cast(bf16x8, w); }
__device__ __forceinline__ float fma_s(float a, float b, float c) { float r; asm("v_fma_f32 %0, %1, %2, %3" : "=v"(r) : "v"(a), "v"(b), "v"(c)); return r; }
constexpr int SSM_ROWB = 272;
constexpr int SSM_NCH = 8, SSM_CHB = 8;
#define BFLO(w) __builtin_bit_cast(float, (w) << 16)
#define BFHI(w) __builtin_bit_cast(float, (w) & 0xffff0000u)

template <int MODE, int NI>
__device__ __forceinline__ void ssm_run(Frame& F, LAS unsigned char* img0, int lane, int g, const int (&row_base)[NI], int nblk, bool sample, int seq0, float (&hr)[NI], float (&hi)[NI]) {
    const bf16* X = (const bf16*)(F.ws + WS_XB); const pg8::ssq_t* ssq = (const pg8::ssq_t*)(F.ws + WS_SSQ) + 1 * M;
    const float* sp = (const float*)(F.ws + WS_SSMP); bf16* Gb = (bf16*)(F.ws + WS_G);
    const float* g1 = F.in[5] + 1 * D; const float* dsk = F.in[16];
    const int l31 = lane & 31, h = lane >> 5, l15 = lane & 15, q4 = lane >> 4;
    bf16x8 bbq[4];
#pragma unroll
    for (int q = 0; q < 4; ++q) { const int p = 32 * (q & 1) + l31; const float* src = sp + 8192 + (q >> 1) * 65536 + ((size_t)(g * PS + p) * GS + 8 * h);
        float v[8];
#pragma unroll
        for (int j = 0; j < 8; ++j) v[j] = src[j] * g1[g * GS + 8 * h + j];
        bbq[q] = pack8(v); }
    bf16x8 cm[4]; float dg[4];
    if (MODE == 1) {
#pragma unroll
        for (int ks = 0; ks < 4; ++ks) { const int p0 = 16 * ks + 4 * q4; const float* cr = F.in[14] + ((size_t)(g * GS + l15) * PS + p0); const float* ci = F.in[15] + ((size_t)(g * GS + l15) * PS + p0);
            float v[8];
#pragma unroll
            for (int j = 0; j < 4; ++j) { v[2 * j] = cr[j]; v[2 * j + 1] = -ci[j]; }
            cm[ks] = pack8(v); }
#pragma unroll
        for (int e = 0; e < 4; ++e) dg[e] = dsk[g * GS + 4 * q4 + e] * g1[g * GS + 4 * q4 + e];
    }
    const float lbr = sp[g * PS + lane], lbi = sp[4096 + g * PS + lane], nlbi = -lbi;
    float s0r[4], s0i[4];
    if (sample) {
#pragma unroll
        for (int i = 0; i < 4; ++i) { s0r[i] = F.in[2][((size_t)(seq0 + i) * NG + g) * PS + lane]; s0i[i] = F.in[3][((size_t)(seq0 + i) * NG + g) * PS + lane]; } }
    else {
#pragma unroll
        for (int i = 0; i < 4; ++i) { s0r[i] = 0.f; s0i[i] = 0.f; } }
    v4u xaw[NI]; u32x2v xew0[NI], xew1[NI]; pg8::ssq_t qa[NI], qe0[NI], qe1[NI];
#define SSM_LOAD(b) do { _Pragma("unroll") for (int j = 0; j < NI; ++j) { const int rowA = row_base[j] + 32 * (b) + l31; xaw[j] = *(const GAS v4u*)(X + (size_t)rowA * D + g * GS + 8 * h); qa[j] = ssq[rowA]; \
        if (MODE == 1) { const int rowE = row_base[j] + 32 * (b) + l15; xew0[j] = *(const GAS u32x2v*)(X + (size_t)rowE * D + g * GS + 4 * q4); xew1[j] = *(const GAS u32x2v*)(X + (size_t)(rowE + 16) * D + g * GS + 4 * q4); qe0[j] = ssq[rowE]; qe1[j] = ssq[rowE + 16]; } \
        else { qe0[j] = 0; qe1[j] = 0; } } } while (0)
    SSM_LOAD(0);
    for (int b = 0; b < nblk; ++b) {
        f32x4 ca0[NI], ca1[NI], ce0[NI], ce1[NI]; pg8::ssq_t cqa[NI], cqe0[NI], cqe1[NI];
#pragma unroll
        for (int j = 0; j < NI; ++j) { ca0[j] = (f32x4){BFLO(xaw[j].x), BFHI(xaw[j].x), BFLO(xaw[j].y), BFHI(xaw[j].y)}; ca1[j] = (f32x4){BFLO(xaw[j].z), BFHI(xaw[j].z), BFLO(xaw[j].w), BFHI(xaw[j].w)};
            if (MODE == 1) { ce0[j] = (f32x4){BFLO(xew0[j].x), BFHI(xew0[j].x), BFLO(xew0[j].y), BFHI(xew0[j].y)}; ce1[j] = (f32x4){BFLO(xew1[j].x), BFHI(xew1[j].x), BFLO(xew1[j].y), BFHI(xew1[j].y)}; }
            cqa[j] = qa[j]; cqe0[j] = qe0[j]; cqe1[j] = qe1[j]; }
        if (b + 1 < nblk) SSM_LOAD(b + 1);
        f32x16 Xr[NI], Yr[NI], Xi[NI], Yi[NI];
#pragma unroll
        for (int j = 0; j < NI; ++j) {
            const float rsa = pg8::rstd_of(cqa[j]);
            float ua[8];
#pragma unroll
            for (int e = 0; e < 4; ++e) { ua[e] = ca0[j][e] * rsa; ua[4 + e] = ca1[j][e] * rsa; }
            const bf16x8 ufrag = pack8(ua);
            const f32x16 zero16 = {0.f, 0.f, 0.f, 0.f, 0.f, 0.f, 0.f, 0.f, 0.f, 0.f, 0.f, 0.f, 0.f, 0.f, 0.f, 0.f};
            Xr[j] = __builtin_amdgcn_mfma_f32_32x32x16_bf16(ufrag, bbq[0], zero16, 0, 0, 0);
            Yr[j] = __builtin_amdgcn_mfma_f32_32x32x16_bf16(ufrag, bbq[1], zero16, 0, 0, 0);
            Xi[j] = __builtin_amdgcn_mfma_f32_32x32x16_bf16(ufrag, bbq[2], zero16, 0, 0, 0);
            Yi[j] = __builtin_amdgcn_mfma_f32_32x32x16_bf16(ufrag, bbq[3], zero16, 0, 0, 0); }
#pragma unroll
        for (int j = 0; j < NI; ++j)
#pragma unroll
            for (int r = 0; r < 16; ++r) {
                auto s1 = __builtin_amdgcn_permlane32_swap(__float_as_uint(Xr[j][r]), __float_as_uint(Yr[j][r]), false, false); Xr[j][r] = __uint_as_float(s1[0]); Yr[j][r] = __uint_as_float(s1[1]);
                auto s2 = __builtin_amdgcn_permlane32_swap(__float_as_uint(Xi[j][r]), __float_as_uint(Yi[j][r]), false, false); Xi[j][r] = __uint_as_float(s2[0]); Yi[j][r] = __uint_as_float(s2[1]); }
#pragma unroll
        for (int i = 0; i < 4; ++i) {
            if (sample) { hr[0] = s0r[i]; hi[0] = s0i[i]; }
#pragma unroll
            for (int s = 0; s < 2; ++s)
#pragma unroll
                for (int e = 0; e < 4; ++e)
#pragma unroll
                    for (int j = 0; j < NI; ++j) { const int r = 4 * i + e; const float br = s ? Yr[j][r] : Xr[j][r], bi = s ? Yi[j][r] : Xi[j][r];
                        const float nr = fma_s(lbr, hr[j], fma_s(nlbi, hi[j], br)), ni = fma_s(lbr, hi[j], fma_s(lbi, hr[j], bi)); hr[j] = nr; hi[j] = ni;
                        if (MODE == 1) *(LAS unsigned*)(img0 + j * (32 * SSM_ROWB) + (8 * i + 4 * s + e) * SSM_ROWB + 4 * lane) = cvtpk(nr, ni); }
            if (sample) { F.out[O_SRS + ((size_t)(seq0 + i) * NG + g) * PS + lane] = hr[0]; F.out[O_SIS + ((size_t)(seq0 + i) * NG + g) * PS + lane] = hi[0]; }
        }
        if (MODE == 1) {
#pragma unroll
            for (int j = 0; j < NI; ++j) {
                const LAS unsigned char* img = img0 + j * (32 * SSM_ROWB);
                f32x4 acc0 = {0.f, 0.f, 0.f, 0.f}, acc1 = {0.f, 0.f, 0.f, 0.f};
#pragma unroll
                for (int ks = 0; ks < 4; ++ks) {
                    const bf16x8 b0 = *(const LAS bf16x8*)(img + l15 * SSM_ROWB + 64 * ks + 16 * q4);
                    const bf16x8 b1 = *(const LAS bf16x8*)(img + (16 + l15) * SSM_ROWB + 64 * ks + 16 * q4);
                    acc0 = __builtin_amdgcn_mfma_f32_16x16x32_bf16(cm[ks], b0, acc0, 0, 0, 0);
                    acc1 = __builtin_amdgcn_mfma_f32_16x16x32_bf16(cm[ks], b1, acc1, 0, 0, 0); }
                const float rse0 = pg8::rstd_of(cqe0[j]), rse1 = pg8::rstd_of(cqe1[j]);
                float o0[4], o1[4];
#pragma unroll
                for (int e = 0; e < 4; ++e) { o0[e] = gelu_tanh(acc0[e] + dg[e] * ce0[j][e] * rse0); o1[e] = gelu_tanh(acc1[e] + dg[e] * ce1[j][e] * rse1); }
                const int rowE = row_base[j] + 32 * b + l15;
                u32x2v w0, w1; w0.x = cvtpk(o0[0], o0[1]); w0.y = cvtpk(o0[2], o0[3]); w1.x = cvtpk(o1[0], o1[1]); w1.y = cvtpk(o1[2], o1[3]);
                *(u32x2v*)(Gb + (size_t)rowE * D + g * GS + 4 * q4) = w0;
                *(u32x2v*)(Gb + (size_t)(rowE + 16) * D + g * GS + 4 * q4) = w1; }
        }
    }
#undef SSM_LOAD
}

__device__ __forceinline__ void ssm_phase_pass(Frame& F, int pass) {
    LAS unsigned char* img = F.lds + RING_OFF + F.wave * (2 * 32 * SSM_ROWB);
    const int lane = opaque_i(F.lane), s = F.wave * 32 + F.ci, g = s & 63, c0 = s >> 6;
    float* E = (float*)(F.ws + WS_SSME) + ((size_t)(F.gi * NG + g) * SSM_NCH) * 2 * PS;
    const int rb[2] = {F.gi * 2048 + c0 * (SSM_CHB * 32), F.gi * 2048 + (c0 + 4) * (SSM_CHB * 32)};
    if (pass == 0) {
        float hr[2] = {0.f, 0.f}, hi[2] = {0.f, 0.f};
        ssm_run<0, 2>(F, img, lane, g, rb, SSM_CHB, false, 0, hr, hi);
#pragma unroll
        for (int j = 0; j < 2; ++j) { E[((c0 + 4 * j) * 2 + 0) * PS + lane] = hr[j]; E[((c0 + 4 * j) * 2 + 1) * PS + lane] = hi[j]; }
        float sr[1] = {0.f}, si[1] = {0.f}; const int rs[1] = {MP + 128 * F.gi + 32 * c0};
        ssm_run<1, 1>(F, img, lane, g, rs, 1, true, 16 * F.gi + 4 * c0, sr, si);
    } else {
        const float* sp = (const float*)(F.ws + WS_SSMP);
        float ar = sp[g * PS + lane], ai = sp[4096 + g * PS + lane];
#pragma unroll
        for (int k = 0; k < 8; ++k) { const float nr = ar * ar - ai * ai, ni = 2.0f * ar * ai; ar = nr; ai = ni; }
        float hr[2] = {0.f, 0.f}, hi[2] = {0.f, 0.f}; float tr = 0.f, ti = 0.f;
        for (int j = 0; j < c0 + 4; ++j) { const float er = E[(j * 2 + 0) * PS + lane], ei = E[(j * 2 + 1) * PS + lane];
            const float nr = ar * tr - ai * ti + er, ni = ar * ti + ai * tr + ei; tr = nr; ti = ni;
            if (j + 1 == c0) { hr[0] = tr; hi[0] = ti; } }
        hr[1] = tr; hi[1] = ti;
        ssm_run<1, 2>(F, img, lane, g, rb, SSM_CHB, false, 0, hr, hi);
        if (c0 == 3) { F.out[O_SRP + ((size_t)F.gi * NG + g) * PS + lane] = hr[1]; F.out[O_SIP + ((size_t)F.gi * NG + g) * PS + lane] = hi[1]; }
    }
}
#undef BFLO
#undef BFHI

__device__ __forceinline__ void conv_phase(Frame& F) {
    const bf16* Z = (const bf16*)(F.ws + WS_Z); const bf16* GBp = (const bf16*)(F.ws + WS_GB); bf16* A2 = (bf16*)(F.ws + WS_A2);
    const float* cw = F.in[19]; const float* cache = F.in[4];
    const int gt = (F.ci * NWAVES + F.wave) * 64 + opaque_i(F.lane), NGT = 32 * NWAVES * 64;
    for (int it = gt; it < (2048 + 128) * (D / 8); it += NGT) {
        const int lr = it >> 7, row = lr < 2048 ? F.gi * 2048 + lr : MP + F.gi * 128 + (lr - 2048), c0 = (it & 127) * 8;
        int t; const float* cb = nullptr;
        if (row < MP) t = row & 2047; else { const int r2 = row - MP; t = r2 & 7; cb = cache + (size_t)(r2 >> 3) * 2 * D; }
        float z0[8], z1[8], z2[8], gb[8];
        { const v4u v = *(const GAS v4u*)(Z + (size_t)row * D + c0); const v4u q = *(const GAS v4u*)(GBp + (size_t)row * D + c0);
#pragma unroll
          for (int e = 0; e < 4; ++e) { z2[2 * e] = __builtin_bit_cast(float, v[e] << 16); z2[2 * e + 1] = __builtin_bit_cast(float, v[e] & 0xffff0000u);
                                        gb[2 * e] = __builtin_bit_cast(float, q[e] << 16); gb[2 * e + 1] = __builtin_bit_cast(float, q[e] & 0xffff0000u); } }
        if (t >= 1) { const v4u v = *(const GAS v4u*)(Z + (size_t)(row - 1) * D + c0);
#pragma unroll
          for (int e = 0; e < 4; ++e) { z1[2 * e] = __builtin_bit_cast(float, v[e] << 16); z1[2 * e + 1] = __builtin_bit_cast(float, v[e] & 0xffff0000u); } }
        else {
#pragma unroll
          for (int e = 0; e < 8; ++e) z1[e] = cb ? cb[D + c0 + e] : 0.f; }
        if (t >= 2) { const v4u v = *(const GAS v4u*)(Z + (size_t)(row - 2) * D + c0);
#pragma unroll
          for (int e = 0; e < 4; ++e) { z0[2 * e] = __builtin_bit_cast(float, v[e] << 16); z0[2 * e + 1] = __builtin_bit_cast(float, v[e] & 0xffff0000u); } }
        else {
#pragma unroll
          for (int e = 0; e < 8; ++e) z0[e] = cb ? cb[t * D + c0 + e] : 0.f; }
        float o[8];
#pragma unroll
        for (int e = 0; e < 8; ++e) o[e] = gb[e] * (cw[c0 + e] * z0[e] + cw[D + c0 + e] * z1[e] + cw[2 * D + c0 + e] * z2[e]);
        v4u w; w.x = pk2(o[0], o[1]); w.y = pk2(o[2], o[3]); w.z = pk2(o[4], o[5]); w.w = pk2(o[6], o[7]);
        *(GAS v4u*)(A2 + (size_t)row * D + c0) = w;
    }
}

__device__ __forceinline__ void final_phase(Frame& F) {
    const bf16* XBp = (const bf16*)(F.ws + WS_XB); const pg8::ssq_t* ssq = (const pg8::ssq_t*)(F.ws + WS_SSQ) + 6 * M; const float* fg = F.in[6];
    const int gw = F.ci * NWAVES + F.wave, NGW = 32 * NWAVES, lane = opaque_i(F.lane);
    f32x4 gv[4];
#pragma unroll
    for (int j = 0; j < 4; ++j) gv[j] = ((const GAS f32x4*)fg)[lane + 64 * j];
    for (int lr = gw; lr < 2048 + 128; lr += NGW) { const int m = lr < 2048 ? F.gi * 2048 + lr : MP + F.gi * 128 + (lr - 2048);
        const float rs = pg8::rstd_of(ssq[m]);
        const GAS unsigned long long* xr = (const GAS unsigned long long*)(XBp + (size_t)m * D) + lane; GAS f32x4* yo = (GAS f32x4*)(F.out + O_Y + (size_t)m * D) + lane;
#pragma unroll
        for (int j = 0; j < 4; ++j) { const unsigned long long w = xr[64 * j]; const unsigned lo = (unsigned)w, hi = (unsigned)(w >> 32);
            const f32x4 xv = {__builtin_bit_cast(float, lo << 16), __builtin_bit_cast(float, lo & 0xffff0000u), __builtin_bit_cast(float, hi << 16), __builtin_bit_cast(float, hi & 0xffff0000u)};
            yo[64 * j] = xv * rs * gv[j]; }
    }
}

struct SameOrder : pg8::StaticOrder { __device__ bool next(int i, pg8::Unit& u) const { const bool r = pg8::StaticOrder::next(i, u); u.pm = 0; u.pn = 0; return r; } };
struct Args { const float* in[21]; float* out; unsigned char* ws; int ph_lo, ph_hi; };
__global__ void __launch_bounds__(NWAVES * 64, 2) skel_fwd(Args args) {
    extern __shared__ __attribute__((aligned(16))) unsigned char lds[];
    Frame F;
    F.lds = (LAS unsigned char*)lds;
    F.MISC = (volatile LAS unsigned*)(F.lds + MISC_OFF);
    F.tid = threadIdx.x; F.lane = F.tid & 63; F.wave = __builtin_amdgcn_readfirstlane(F.tid >> 6);
    F.G = gridDim.x; { const int bx = blockIdx.x; F.vcu = (bx % 8) * (F.G / 8) + bx / 8; F.gi = bx % 8; F.ci = bx / 8; }
    F.ws = args.ws; F.out = args.out; F.ctl = (gu32*)(args.ws + WS_CTL);
#pragma unroll
    for (int i = 0; i < 21; ++i) F.in[i] = args.in[i];
    for (int u = F.tid; u < (LDS_BYTES - LDSCTL_OFF) / 4; u += NWAVES * 64) ((LAS unsigned*)(F.lds + LDSCTL_OFF))[u] = 0u;
    __syncthreads();
    XcdBarrier bar = xcd_barrier_post((unsigned*)(F.ctl + CW_BAR), F.MISC + 8, (unsigned)F.G);
    XcdBarrier gbar = xcd_barrier_post((unsigned*)(F.ctl + CW_BAR) + (1 + F.gi) * XCD_BAR_WORDS, F.MISC + 10, (unsigned)(F.G / 8));
    const int lo = args.ph_lo, hi = args.ph_hi;
#define IN(k) (lo <= (k) && (k) < hi)
#if defined(PROBE_A_LO)
#define STAMP(k) do { if (blockIdx.x == 0 && F.tid == 0) { const unsigned long long t_ = __builtin_amdgcn_s_memrealtime(); F.MISC[16 + 2 * (k)] = (unsigned)t_; F.MISC[17 + 2 * (k)] = (unsigned)(t_ >> 32); } } while (0)
#else
#define STAMP(k) do { } while (0)
#endif
    STAMP(0);
#define SEAM(k) do { if (IN((k) + 1)) { if ((k) == 0) xcd_barrier(bar); else xcd_barrier(gbar); } STAMP((k) + 1); } while (0)
    bf16* XB = (bf16*)(F.ws + WS_XB); bf16* H = (bf16*)(F.ws + WS_H); pg8::ssq_t* ssq = (pg8::ssq_t*)(F.ws + WS_SSQ);
    const int bx = (int)blockIdx.x;

    if (IN(0)) { p0_prologue(F); SEAM(0); }
#define FFN_GU(ph, f, sin) if (IN(ph)) { pg8::Gemm g{XB, (const bf16*)(F.ws + WS_WGU) + (size_t)(f) * 2 * FF * D, M, 2 * FF, D}; pg8::StaticOrder S; S.init(MP, 2 * FF, F.G, bx); \
        pg8::EpiGateUp E{H, FF, ssq + (size_t)(sin) * M}; pg8::gemm_phase<pg8::EpiGateUp, pg8::StaticOrder, true, true>(F.lds + RING_OFF, g, S, E); SEAM(ph); }
#define FFN_DN(ph, f, sout) if (IN(ph)) { pg8::Gemm g{H, (const bf16*)(F.ws + WS_WD) + (size_t)(f) * D * FF, M, D, FF}; pg8::StaticOrder S; S.init(MP, D, F.G, bx); \
        pg8::EpiResid<0> E{(ph) == 2 ? F.in[0] : nullptr, (ph) == 2 ? F.in[1] : nullptr, XB, ssq + (size_t)(sout) * M, 0.5f}; pg8::gemm_phase<pg8::EpiResid<0>, pg8::StaticOrder, true, true>(F.lds + RING_OFF, g, S, E); SEAM(ph); }
    FFN_GU(1, 0, 0)
    FFN_DN(2, 0, 1)
#if defined(PROBE_SSM)
    if (IN(3)) { ssm_phase_pass(F, 0); if (PROBE_SSM == 1) { xcd_barrier(gbar); ssm_phase_pass(F, 0); } xcd_barrier(gbar); ssm_phase_pass(F, 1); if (PROBE_SSM == 2) { xcd_barrier(gbar); ssm_phase_pass(F, 1); } SEAM(3); }
#else
    if (IN(3)) { ssm_phase_pass(F, 0); xcd_barrier(gbar); ssm_phase_pass(F, 1); SEAM(3); }
#endif
    if (IN(4)) { pg8::Gemm g{(const bf16*)(F.ws + WS_G), (const bf16*)(F.ws + WS_WGLU), M, 2 * D, D}; pg8::StaticOrder S; S.init(MP, 2 * D, F.G, bx);
        pg8::EpiResid<1> E{nullptr, nullptr, XB, ssq + (size_t)2 * M, 1.0f}; pg8::gemm_phase<pg8::EpiResid<1>, pg8::StaticOrder, true, true>(F.lds + RING_OFF, g, S, E); SEAM(4); }
    FFN_GU(5, 1, 2)
    FFN_DN(6, 1, 3)
    FFN_GU(7, 2, 3)
    FFN_DN(8, 2, 4)
    if (IN(9)) { pg8::Gemm g{XB, (const bf16*)(F.ws + WS_WIN), M, 3 * D, D}; pg8::StaticOrder S; S.init(MP, 3 * D, F.G, bx);
        pg8::EpiConvIn E{(bf16*)(F.ws + WS_Z), (bf16*)(F.ws + WS_GB), ssq + (size_t)4 * M, F.out + O_CP, F.out + O_CS};
        pg8::gemm_phase<pg8::EpiConvIn, pg8::StaticOrder, true, true>(F.lds + RING_OFF, g, S, E); SEAM(9); }
    if (IN(10)) { conv_phase(F); SEAM(10); }
    if (IN(11)) { pg8::Gemm g{(const bf16*)(F.ws + WS_A2), (const bf16*)(F.ws + WS_WOUT), M, D, D}; pg8::StaticOrder S; S.init(MP, D, F.G, bx);
        pg8::EpiResid<0> E{nullptr, nullptr, XB, ssq + (size_t)5 * M, 1.0f}; pg8::gemm_phase<pg8::EpiResid<0>, pg8::StaticOrder, true, true>(F.lds + RING_OFF, g, S, E); SEAM(11); }
    FFN_GU(12, 3, 5)
    FFN_DN(13, 3, 6)
    if (IN(14)) { final_phase(F); }
#if defined(PROBE_DRY)
#ifndef PROBE_VARIANT
#define PROBE_VARIANT 0
#endif
    xcd_barrier(gbar); STAMP(15); if (blockIdx.x == 0 && F.tid == 0) { const unsigned long long c_ = __builtin_amdgcn_s_memtime(); F.MISC[60] = (unsigned)c_; F.MISC[61] = (unsigned)(c_ >> 32); }
#if PROBE_DRY == 2
    { pg8::Gemm g{XB, (const bf16*)(F.ws + WS_WGU), M, 2 * FF, D}; SameOrder S; S.init(MP, 2 * FF, F.G, bx);
      pg8::EpiNull E{H + (size_t)M * FF - 1}; pg8::gemm_phase<pg8::EpiNull, SameOrder, true, true>(F.lds + RING_OFF, g, S, E); }
#else
#if PROBE_DRY == 3
    { pg8::Gemm g{XB, (const bf16*)(F.ws + WS_WGU) + (size_t)3 * 2 * FF * D, M, 2 * FF, D}; pg8::StaticOrder S; S.init(MP, 2 * FF, F.G, bx);
      pg8::EpiGateUp E{H, FF, ssq + (size_t)5 * M}; pg8::gemm_phase<pg8::EpiGateUp, pg8::StaticOrder, true, true, PROBE_VARIANT>(F.lds + RING_OFF, g, S, E); }
#else
    { pg8::Gemm g{XB, (const bf16*)(F.ws + WS_WGU), M, 2 * FF, D}; pg8::StaticOrder S; S.init(MP, 2 * FF, F.G, bx);
      pg8::EpiNull E{H + (size_t)M * FF - 1}; pg8::gemm_phase<pg8::EpiNull, pg8::StaticOrder, true, true, PROBE_VARIANT>(F.lds + RING_OFF, g, S, E); }
#endif
#endif
    xcd_barrier(gbar); STAMP(16); if (blockIdx.x == 0 && F.tid == 0) { const unsigned long long c_ = __builtin_amdgcn_s_memtime(); F.MISC[62] = (unsigned)c_; F.MISC[63] = (unsigned)(c_ >> 32); }
#endif
#if defined(PROBE_A_LO)
    __syncthreads();
    if (blockIdx.x == 0 && F.tid == 0) {
#if !defined(PROBE_DRY)
        STAMP(15);
#endif
#define TS(k) ((unsigned long long)F.MISC[16 + 2 * (k)] | ((unsigned long long)F.MISC[17 + 2 * (k)] << 32))
        const unsigned long long ta = TS(PROBE_A_HI) - TS(PROBE_A_LO), tb = TS(PROBE_B_HI) - TS(PROBE_B_LO);
#if defined(PROBE_CLOCK)
        { const unsigned long long c0 = (unsigned long long)F.MISC[60] | ((unsigned long long)F.MISC[61] << 32), c1 = (unsigned long long)F.MISC[62] | ((unsigned long long)F.MISC[63] << 32);
          F.out[0] += (float)(c1 - c0) / (float)(TS(16) - TS(15)) * 1e-2f; }
#else
        F.out[0] += (float)tb * 1e-5f;
#endif
        const unsigned long long t0 = __builtin_amdgcn_s_memrealtime();
        const unsigned long long spin = ta * 4ull < 1000000ull ? ta * 4ull : 1000000ull;
        while (__builtin_amdgcn_s_memrealtime() - t0 < spin) __builtin_amdgcn_s_sleep(8);
    }
#endif
#undef IN
#undef SEAM
}

extern "C" void kernel_launch(void* const* d_in, const int* in_sizes, int n_in, void* d_out, int out_size, void* d_ws, size_t ws_size, hipStream_t stream) {
    static int grid = 0;
    if (grid == 0) {
        if (n_in != 21 || out_size != (int)O_END || ws_size < WS_END) { fprintf(stderr, "kernel_launch: unexpected shapes: n_in %d out %d ws %zu; nothing launched\n", n_in, out_size, ws_size); grid = -1; return; }
        int dev = 0, cus = 0, per_cu = 0;
        if (hipGetDevice(&dev) != hipSuccess || hipDeviceGetAttribute(&cus, hipDeviceAttributeMultiprocessorCount, dev) != hipSuccess) { grid = -1; return; }
        if (hipFuncSetAttribute((const void*)skel_fwd, hipFuncAttributeMaxDynamicSharedMemorySize, LDS_BYTES) != hipSuccess) { fprintf(stderr, "kernel_launch: hipFuncSetAttribute failed\n"); grid = -1; return; }
        if (hipOccupancyMaxActiveBlocksPerMultiprocessor(&per_cu, (const void*)skel_fwd, NWAVES * 64, LDS_BYTES) != hipSuccess || per_cu < 1) fprintf(stderr, "kernel_launch: occupancy query reports %d\n", per_cu);
        (void)hipGetLastError();
        if (cus < 256) { fprintf(stderr, "kernel_launch: built for a 256-CU device (8 groups x 32 workgroups), found %d CUs; nothing launched\n", cus); grid = -1; return; }
        grid = 256;
    }
    if (grid < 0) return;
    if (hipMemsetAsync((char*)d_ws + WS_CTL, 0, CTL_ZERO_BYTES, stream) != hipSuccess) return;
    Args a{};
    for (int i = 0; i < 21; ++i) a.in[i] = (const float*)d_in[i];
    a.out = (float*)d_out; a.ws = (unsigned char*)d_ws;
    a.ph_lo = 0; a.ph_hi = N_PHASES;
    hipLaunchKernelGGL(skel_fwd, dim3(grid), dim3(NWAVES * 64), LDS_BYTES, stream, a);
}
```

```cpp
#include <hip/hip_runtime.h>
#include <cstdio>
#include <cstdint>
namespace pg8 {
#define PG8_LAS __attribute__((address_space(3)))
typedef unsigned short bf16_t;
typedef short bf16x8 __attribute__((ext_vector_type(8)));
typedef float f32x4 __attribute__((ext_vector_type(4)));
typedef unsigned u32x4 __attribute__((ext_vector_type(4)));
constexpr int BM = 256, BK = 64, HALF = 128, HTB = HALF * BK * 2  , STAGE_BYTES = 8 * HTB, NXCD = 8, WGM = 8;

__host__ __device__ __forceinline__ int lds_byte(int r, int c) { const int st = (r >> 4) * 2 + (c >> 5), rr = r & 15, cc = c & 31, ob = rr * 64 + cc * 2; return st * 1024 + (ob ^ (((ob >> 9) & 1) << 5)); }
__host__ __device__ __forceinline__ void stage_rc(int b, int& R, int& C) { const int st = b / 1024, sb = b % 1024, swz = sb ^ (((sb >> 9) & 1) << 5); R = (st >> 1) * 16 + swz / 64; C = (st & 1) * 32 + (swz % 64) / 2; }
__host__ __device__ __forceinline__ int perm32(int rho) { const int n = rho >> 4, i = rho & 15; return 8 * (i >> 2) + 4 * n + (i & 3); }

struct Unit { int pm, pn; };
struct Gemm { const bf16_t* A; const bf16_t* Bt; int M, N, K; };

struct StaticOrder {
    int nM, nN, nwg, G, c;
    __host__ __device__ void init(int M, int N, int G_, int c_) { nM = M / BM; nN = N / BM; nwg = nM * nN; G = G_; c = c_; }
    __host__ __device__ bool next(int i, Unit& u) const {
        const long L = (long)i * G + c; if (L >= nwg) return false;
        int wgid = (int)L; { const int q = nwg / NXCD, r = nwg % NXCD, xcd = wgid % NXCD, off = wgid / NXCD; wgid = (xcd < r ? xcd * (q + 1) : r * (q + 1) + (xcd - r) * q) + off; }
        const int nig = WGM * nN, gid = wgid / nig, fm = gid * WGM, gsz = (nM - fm) < WGM ? (nM - fm) : WGM;
        u.pm = fm + ((wgid % nig) % gsz); u.pn = (wgid % nig) / gsz; return true;
    }
    __device__ __forceinline__ void a_ready(const Unit&) const {}
    __device__ __forceinline__ void done(const Unit&) const {}
};


__device__ __forceinline__ unsigned cvt_pk_bf16(float lo, float hi) { unsigned r; asm volatile("v_cvt_pk_bf16_f32 %0, %1, %2" : "=v"(r) : "v"(lo), "v"(hi)); return r; }

typedef unsigned u32x2 __attribute__((ext_vector_type(2)));
constexpr float RMS_EPS = 1e-6f;
constexpr float INV_D = 1.0f / 1024.0f;
__device__ __forceinline__ float sigmoid_f(float x) { return __builtin_amdgcn_rcpf(1.0f + __builtin_amdgcn_exp2f(-1.4426950408889634f * x)); }
typedef unsigned long long ssq_t;
constexpr float SSQ_SCALE = 16777216.0f, SSQ_INV = 1.0f / 16777216.0f;
__device__ __forceinline__ ssq_t ssq_fix(float s) { return (ssq_t)(s * SSQ_SCALE + 0.5f); }
__device__ __forceinline__ float rstd_of(ssq_t q) { return __builtin_amdgcn_rsqf((float)q * (SSQ_INV * INV_D) + RMS_EPS); }
#define PG8_EPI_CALL() \
    __device__ __forceinline__ void operator()(const f32x4 (&acc)[2][2][4][2], const Unit& u, int wr, int wc, int fr, int fq) const { \
        _Pragma("unroll") for (int ai = 0; ai < 2; ++ai) _Pragma("unroll") for (int m = 0; m < 4; ++m) { \
            const f32x4 a[2][2] = {{acc[ai][0][m][0], acc[ai][0][m][1]}, {acc[ai][1][m][0], acc[ai][1][m][1]}}; rg(a, u, ai, m, 3, wr, wc, fr, fq); } }

struct EpiGateUp {
    static constexpr bool PERM = true, AFTER_DRAIN = false;
    bf16_t* H; int ldh; const ssq_t* ssq; PG8_LAS float* rs_lds;
    __device__ __forceinline__ void prep(const Unit& u, int tid) const { if (tid < 272) { const int row = tid < 256 ? u.pm * BM + tid : 16384 + 16 * u.pm + (tid - 256); rs_lds[tid] = rstd_of(ssq[row]); } }
    __device__ __forceinline__ void rg(const f32x4 (&a)[2][2], const Unit& u, int ai, int m, int bjmask, int wr, int wc, int fr, int fq) const {
        const int row = u.pm * BM + ai * HALF + wr * 64 + m * 16 + fr, col0 = u.pn * HALF + wc * 32 + 8 * fq;
        const float rs = rs_lds[ai * HALF + wr * 64 + m * 16 + fr];
        float h[8];
#pragma unroll
        for (int n = 0; n < 2; ++n)
#pragma unroll
            for (int e = 0; e < 4; ++e) { const float g = a[0][n][e] * rs, up = a[1][n][e] * rs; h[4 * n + e] = g * sigmoid_f(g) * up; }
        u32x4 w; w.x = cvt_pk_bf16(h[0], h[1]); w.y = cvt_pk_bf16(h[2], h[3]); w.z = cvt_pk_bf16(h[4], h[5]); w.w = cvt_pk_bf16(h[6], h[7]);
        *(u32x4*)(H + (size_t)row * ldh + col0) = w;
    }
    __device__ __forceinline__ void rgx(const f32x4 (&ax)[2], const Unit& u, int wr, int wc, int fr, int fq) const {
        const int row = 16384 + 16 * u.pm + fr, col0 = u.pn * HALF + wc * 32 + 8 * fq + 4 * wr;
        const float rs = rs_lds[256 + fr];
        float h[4];
#pragma unroll
        for (int e = 0; e < 4; ++e) { const float g = ax[0][e] * rs, up = ax[1][e] * rs; h[e] = g * sigmoid_f(g) * up; }
        u32x2 w; w.x = cvt_pk_bf16(h[0], h[1]); w.y = cvt_pk_bf16(h[2], h[3]);
        *(u32x2*)(H + (size_t)row * ldh + col0) = w;
    }
    PG8_EPI_CALL()
};

__device__ __forceinline__ void unpack8(const u32x4 w, float (&x)[8]) {
#pragma unroll
    for (int e = 0; e < 4; ++e) { x[2 * e] = __builtin_bit_cast(float, w[e] << 16); x[2 * e + 1] = __builtin_bit_cast(float, w[e] & 0xffff0000u); } }
template <int MODE> struct EpiResid {
    static constexpr bool PERM = true, AFTER_DRAIN = false;
    const float* xin_p; const float* xin_s; bf16_t* XB; ssq_t* ssq; float scale;
    __device__ __forceinline__ void prep(const Unit&, int) const {}
    __device__ __forceinline__ void rg(const f32x4 (&a)[2][2], const Unit& u, int ai, int m, int bjmask, int wr, int wc, int fr, int fq) const {
        const int row = u.pm * BM + ai * HALF + wr * 64 + m * 16 + fr;
        const int col0 = (MODE == 0 ? u.pn * BM : u.pn * HALF) + wc * 32 + 8 * fq;
        float sq = 0.f;
#pragma unroll
        for (int bj = 0; bj < (MODE == 0 ? 2 : 1); ++bj) {
            bf16_t* xp = XB + (size_t)row * 1024 + col0 + bj * HALF;
            float x[8];
            if (xin_p) { const float* xi = xin_p + (size_t)row * 1024 + col0 + bj * HALF; const f32x4 x0 = *(const f32x4*)xi, x1 = *(const f32x4*)(xi + 4);
#pragma unroll
                for (int e = 0; e < 4; ++e) { x[e] = x0[e]; x[4 + e] = x1[e]; } }
            else unpack8(*(const u32x4*)xp, x);
#pragma unroll
            for (int e = 0; e < 4; ++e) {
                if (MODE == 0) { x[e] += a[bj][0][e] * scale; x[4 + e] += a[bj][1][e] * scale; }
                else { x[e] += a[0][0][e] * sigmoid_f(a[1][0][e]); x[4 + e] += a[0][1][e] * sigmoid_f(a[1][1][e]); } }
            u32x4 w; w.x = cvt_pk_bf16(x[0], x[1]); w.y = cvt_pk_bf16(x[2], x[3]); w.z = cvt_pk_bf16(x[4], x[5]); w.w = cvt_pk_bf16(x[6], x[7]);
            *(u32x4*)xp = w;
            sq += (x[0] * x[0] + x[1] * x[1]) + (x[2] * x[2] + x[3] * x[3]) + (x[4] * x[4] + x[5] * x[5]) + (x[6] * x[6] + x[7] * x[7]); }
        sq += __shfl_xor(sq, 16); sq += __shfl_xor(sq, 32);
        if (fq == 0) atomicAdd(ssq + row, ssq_fix(sq));
    }
    __device__ __forceinline__ void rgx(const f32x4 (&ax)[2], const Unit& u, int wr, int wc, int fr, int fq) const {
        const int r2 = 16 * u.pm + fr, row = 16384 + r2;
        const int col0 = (MODE == 0 ? u.pn * BM : u.pn * HALF) + wc * 32 + 8 * fq + 4 * wr;
        float sq = 0.f;
#pragma unroll
        for (int bj = 0; bj < (MODE == 0 ? 2 : 1); ++bj) {
            bf16_t* xp = XB + (size_t)row * 1024 + col0 + bj * HALF;
            f32x4 x0;
            if (xin_s) x0 = *(const f32x4*)(xin_s + (size_t)r2 * 1024 + col0 + bj * HALF);
            else { const u32x2 w = *(const u32x2*)xp; x0[0] = __builtin_bit_cast(float, w.x << 16); x0[1] = __builtin_bit_cast(float, w.x & 0xffff0000u); x0[2] = __builtin_bit_cast(float, w.y << 16); x0[3] = __builtin_bit_cast(float, w.y & 0xffff0000u); }
            if (MODE == 0) x0 += ax[bj] * scale;
            else {
#pragma unroll
                for (int e = 0; e < 4; ++e) x0[e] += ax[0][e] * sigmoid_f(ax[1][e]); }
            u32x2 w; w.x = cvt_pk_bf16(x0[0], x0[1]); w.y = cvt_pk_bf16(x0[2], x0[3]);
            *(u32x2*)xp = w;
            sq += (x0[0] * x0[0] + x0[1] * x0[1]) + (x0[2] * x0[2] + x0[3] * x0[3]); }
        sq += __shfl_xor(sq, 16); sq += __shfl_xor(sq, 32);
        if (fq == 0) atomicAdd(ssq + row, ssq_fix(sq));
    }
    PG8_EPI_CALL()
};

struct EpiConvIn {
    static constexpr bool PERM = true, AFTER_DRAIN = false;
    bf16_t* Z; bf16_t* GB; const ssq_t* ssq; float* conv_p; float* conv_s; PG8_LAS float* rs_lds;
    __device__ __forceinline__ void prep(const Unit& u, int tid) const { if (tid < 272) { const int row = tid < 256 ? u.pm * BM + tid : 16384 + 16 * u.pm + (tid - 256); rs_lds[tid] = rstd_of(ssq[row]); } }
    __device__ __forceinline__ void rg(const f32x4 (&a)[2][2], const Unit& u, int ai, int m, int bjmask, int wr, int wc, int fr, int fq) const {
        const int row = u.pm * BM + ai * HALF + wr * 64 + m * 16 + fr;
        const float rs = rs_lds[ai * HALF + wr * 64 + m * 16 + fr];
        if (u.pn < 8) {
            const int col0 = u.pn * HALF + wc * 32 + 8 * fq; const float rs2 = rs * rs;
            const f32x4 z0 = a[0][0] * a[1][0] * rs2, z1 = a[0][1] * a[1][1] * rs2;
            u32x4 w; w.x = cvt_pk_bf16(z0[0], z0[1]); w.y = cvt_pk_bf16(z0[2], z0[3]); w.z = cvt_pk_bf16(z1[0], z1[1]); w.w = cvt_pk_bf16(z1[2], z1[3]);
            *(u32x4*)(Z + (size_t)row * 1024 + col0) = w;
            float* cp = nullptr;
            if (row < 16384) { const int t = row & 2047; if (t >= 2046) cp = conv_p + ((size_t)(row >> 11) * 2 + (t - 2046)) * 1024 + col0; }
            else { const int r2 = row - 16384, t = r2 & 7; if (t >= 6) cp = conv_s + ((size_t)(r2 >> 3) * 2 + (t - 6)) * 1024 + col0; }
            if (cp) { *(f32x4*)cp = z0; *(f32x4*)(cp + 4) = z1; }
        } else {
            const int col0 = (u.pn - 8) * BM + wc * 32 + 8 * fq;
#pragma unroll
            for (int bj = 0; bj < 2; ++bj) { const f32x4 g0 = a[bj][0] * rs, g1 = a[bj][1] * rs;
                u32x4 w; w.x = cvt_pk_bf16(g0[0], g0[1]); w.y = cvt_pk_bf16(g0[2], g0[3]); w.z = cvt_pk_bf16(g1[0], g1[1]); w.w = cvt_pk_bf16(g1[2], g1[3]);
                *(u32x4*)(GB + (size_t)row * 1024 + col0 + bj * HALF) = w; }
        }
    }
    __device__ __forceinline__ void rgx(const f32x4 (&ax)[2], const Unit& u, int wr, int wc, int fr, int fq) const {
        const int r2 = 16 * u.pm + fr, row = 16384 + r2;
        const float rs = rs_lds[256 + fr];
        if (u.pn < 8) {
            const int col0 = u.pn * HALF + wc * 32 + 8 * fq + 4 * wr;
            const f32x4 z0 = ax[0] * ax[1] * (rs * rs);
            u32x2 w; w.x = cvt_pk_bf16(z0[0], z0[1]); w.y = cvt_pk_bf16(z0[2], z0[3]);
            *(u32x2*)(Z + (size_t)row * 1024 + col0) = w;
            const int t = r2 & 7;
            if (t >= 6) *(f32x4*)(conv_s + ((size_t)(r2 >> 3) * 2 + (t - 6)) * 1024 + col0) = z0;
        } else {
            const int col0 = (u.pn - 8) * BM + wc * 32 + 8 * fq + 4 * wr;
#pragma unroll
            for (int bj = 0; bj < 2; ++bj) { const f32x4 g0 = ax[bj] * rs;
                u32x2 w; w.x = cvt_pk_bf16(g0[0], g0[1]); w.y = cvt_pk_bf16(g0[2], g0[3]);
                *(u32x2*)(GB + (size_t)row * 1024 + col0 + bj * HALF) = w; }
        }
    }
    PG8_EPI_CALL()
};

struct EpiNull {
    static constexpr bool PERM = true, AFTER_DRAIN = false;
    bf16_t* sink;
    __device__ __forceinline__ void prep(const Unit&, int) const {}
    __device__ __forceinline__ void rg(const f32x4 (&a)[2][2], const Unit& u, int ai, int m, int bjmask, int wr, int wc, int fr, int fq) const {
        asm volatile("" :: "v"(a[0][0]), "v"(a[0][1]), "v"(a[1][0]), "v"(a[1][1]));
    }
    __device__ __forceinline__ void rgx(const f32x4 (&ax)[2], const Unit& u, int wr, int wc, int fr, int fq) const { asm volatile("" :: "v"(ax[0]), "v"(ax[1])); }
    PG8_EPI_CALL()
};

template <class Epi, class Sched, bool ALIGN_EPI = false, bool SP2 = false, int PROBE = 0>
__device__ __forceinline__ void gemm_phase(PG8_LAS unsigned char* lds, const Gemm g, const Sched& S, const Epi& E) {
    int tid_ = threadIdx.x; asm volatile("" : "+v"(tid_));
    const int tid = tid_, wid = __builtin_amdgcn_readfirstlane(tid >> 6), lane = tid & 63, wr = wid >> 2, wc = wid & 3, fr = lane & 15, fq = lane >> 4;
    const int K = g.K, nt = K / BK;
    constexpr int XROW0 = 16384, XR = 16;
    unsigned voffA[2], voffB[2];
#pragma unroll
    for (int i = 0; i < 2; ++i) { int R, C; stage_rc(tid * 16 + i * 8192, R, C); const int Rb = Epi::PERM ? ((R & ~31) + perm32(R & 31)) : R;
        voffA[i] = (unsigned)(R * K + C) * 2u; voffB[i] = (unsigned)(Rb * K + C) * 2u; }
    unsigned voffX; { const int p = (wid & 3) * 1024 + lane * 16, bq = p >> 11, q = p & 2047, row = q >> 7, kb = (q & 127) ^ (((row >> 1) & 7) << 4); voffX = (unsigned)(row * K * 2 + bq * 128 + kb); }
    int xoff0 = fr * 128 + ((fq * 16) ^ (((fr >> 1) & 7) << 4)), xoff1 = fr * 128 + ((64 + fq * 16) ^ (((fr >> 1) & 7) << 4));
    unsigned xpw = 4096;
    const unsigned kstep = (unsigned)(BK * 2);
    const unsigned hstep = (unsigned)HALF * K * 2;
    const unsigned tstep = 2 * hstep;
    const __amdgpu_buffer_rsrc_t rsA = __builtin_amdgcn_make_buffer_rsrc((void*)g.A, 0, 0x7ffff000, 0x00020000), rsB = __builtin_amdgcn_make_buffer_rsrc((void*)g.Bt, 0, 0x7ffff000, 0x00020000);
    const unsigned ldsw = (unsigned)wid * 1024u;
    const int aoff = lds_byte(wr * 64 + fr, fq * 8), boff = lds_byte(wc * 32 + fr, fq * 8);
#define PG8_SA(b, h) (((b) * 2 + (h)) * HTB)
#define PG8_SB(b, h) ((4 + (b) * 2 + (h)) * HTB)
#define PG8_SX(b) (STAGE_BYTES + (b) * 2048)
#define PG8_STAGEXP(soff) do { if constexpr ((PROBE & (6 | 16)) == 0) { if (wr == 0) __builtin_amdgcn_raw_ptr_buffer_load_lds(rsA, (PG8_LAS unsigned*)(lds + STAGE_BYTES + xpw + wid * 1024), 16, voffX, (soff), 0, 0); } } while (0)
#define PG8_LDAX(dst, b) do { if constexpr ((PROBE & (10 | 32)) == 0) { dst[0] = *(const PG8_LAS bf16x8*)(lds + PG8_SX(b) + xoff0); dst[1] = *(const PG8_LAS bf16x8*)(lds + PG8_SX(b) + xoff1); } } while (0)
#define PG8_WAIT_LT(nl, nt) do { if (wr == 0) PG8_WAIT_V(nl); else PG8_WAIT_V(nt); } while (0)
#define PG8_MMAX_NULL() do { asm volatile("" :: "v"(Ax[0]), "v"(Ax[1])); } while (0)
#define PG8_MMAX_REAL() do { if (wr == 0) { _Pragma("unroll") for (int k = 0; k < 2; ++k) { accx[0] = __builtin_amdgcn_mfma_f32_16x16x32_bf16(B0[0][k], Ax[k], accx[0], 0, 0, 0); accx[1] = __builtin_amdgcn_mfma_f32_16x16x32_bf16(B1[0][k], Ax[k], accx[1], 0, 0, 0); } } \
        else { _Pragma("unroll") for (int k = 0; k < 2; ++k) { accx[0] = __builtin_amdgcn_mfma_f32_16x16x32_bf16(B0[1][k], Ax[k], accx[0], 0, 0, 0); accx[1] = __builtin_amdgcn_mfma_f32_16x16x32_bf16(B1[1][k], Ax[k], accx[1], 0, 0, 0); } } } while (0)
#define PG8_MMAX() do { if constexpr ((PROBE & (2 | 32)) != 0) { } else if constexpr ((PROBE & 1) != 0) PG8_MMAX_NULL(); else PG8_MMAX_REAL(); } while (0)
#define PG8_STAGEA(bufoff, soff) do { if constexpr ((PROBE & 4) == 0) _Pragma("unroll") for (int _i = 0; _i < 2; ++_i) \
        __builtin_amdgcn_raw_ptr_buffer_load_lds(rsA, (PG8_LAS unsigned*)(lds + (bufoff) + ldsw + _i * 8192), 16, voffA[_i], (soff), 0, 0); } while (0)
#define PG8_STAGEB(bufoff, soff) do { if constexpr ((PROBE & 4) == 0) _Pragma("unroll") for (int _i = 0; _i < 2; ++_i) \
        __builtin_amdgcn_raw_ptr_buffer_load_lds(rsB, (PG8_LAS unsigned*)(lds + (bufoff) + ldsw + _i * 8192), 16, voffB[_i], (soff), 0, 0); } while (0)
#define PG8_LDA(dst, b, h) do { if constexpr ((PROBE & 8) == 0) { _Pragma("unroll") for (int m = 0; m < 4; ++m) _Pragma("unroll") for (int k = 0; k < 2; ++k) dst[m][k] = *(const PG8_LAS bf16x8*)(lds + PG8_SA(b, h) + aoff + m * 2048 + k * 1024); } } while (0)
#define PG8_LDB(dst, b, h) do { if constexpr ((PROBE & 8) == 0) { _Pragma("unroll") for (int n = 0; n < 2; ++n) _Pragma("unroll") for (int k = 0; k < 2; ++k) dst[n][k] = *(const PG8_LAS bf16x8*)(lds + PG8_SB(b, h) + boff + n * 2048 + k * 1024); } } while (0)
#define PG8_MMA_NULL(ai, bj, At, Bt) do { _Pragma("unroll") for (int m = 0; m < 4; ++m) _Pragma("unroll") for (int k = 0; k < 2; ++k) asm volatile("" :: "v"(At[m][k])); _Pragma("unroll") for (int n = 0; n < 2; ++n) _Pragma("unroll") for (int k = 0; k < 2; ++k) asm volatile("" :: "v"(Bt[n][k])); } while (0)
#define PG8_MMA_REAL(ai, bj, At, Bt) do { __builtin_amdgcn_s_setprio(1); _Pragma("unroll") for (int m = 0; m < 4; ++m) _Pragma("unroll") for (int n = 0; n < 2; ++n) _Pragma("unroll") for (int k = 0; k < 2; ++k) \
        acc[ai][bj][m][n] = __builtin_amdgcn_mfma_f32_16x16x32_bf16(Bt[n][k], At[m][k], acc[ai][bj][m][n], 0, 0, 0); __builtin_amdgcn_s_setprio(0); } while (0)
#define PG8_MMA(ai, bj, At, Bt) do { if constexpr ((PROBE & 1) != 0) PG8_MMA_NULL(ai, bj, At, Bt); else PG8_MMA_REAL(ai, bj, At, Bt); } while (0)
#define PG8_WAIT_V(n) asm volatile("s_waitcnt vmcnt(" #n ")" ::: "memory")
#define PG8_WAIT_L(n) asm volatile("s_waitcnt lgkmcnt(" #n ")" ::: "memory")
#define PG8_BAR __builtin_amdgcn_s_barrier()
#define PG8_SCHED __builtin_amdgcn_sched_barrier(0)
    Unit cur, nxt; int ui = 0;
    if (!S.next(0, cur)) return;
    f32x4 acc[2][2][4][2];
#pragma unroll
    for (int a = 0; a < 2; ++a)
#pragma unroll
        for (int b = 0; b < 2; ++b)
#pragma unroll
            for (int m = 0; m < 4; ++m)
#pragma unroll
                for (int n = 0; n < 2; ++n) acc[a][b][m][n] = (f32x4){0.f, 0.f, 0.f, 0.f};
    bf16x8 At[4][2], B0[2][2], B1[2][2], Ax[2];
    if constexpr ((PROBE & 8) != 0) {
#pragma unroll
        for (int m = 0; m < 4; ++m)
#pragma unroll
            for (int k = 0; k < 2; ++k) asm volatile("" : "=v"(At[m][k]));
#pragma unroll
        for (int n = 0; n < 2; ++n)
#pragma unroll
            for (int k = 0; k < 2; ++k) { asm volatile("" : "=v"(B0[n][k])); asm volatile("" : "=v"(B1[n][k])); }
        asm volatile("" : "=v"(Ax[0])); asm volatile("" : "=v"(Ax[1])); }
    f32x4 accx[2] = {(f32x4){0.f, 0.f, 0.f, 0.f}, (f32x4){0.f, 0.f, 0.f, 0.f}};
    unsigned cA = (unsigned)cur.pm * tstep, cB = (unsigned)cur.pn * tstep;
    const unsigned xstep = (unsigned)XR * K * 2, xbase = (unsigned)XROW0 * K * 2; unsigned cX = xbase + (unsigned)cur.pm * xstep;
    S.a_ready(cur);
    E.prep(cur, tid);
    if constexpr (SP2) {
        PG8_STAGEB(PG8_SB(0, 0), cB); PG8_STAGEB(PG8_SB(0, 1), cB + hstep); PG8_STAGEA(PG8_SA(0, 0), cA); { const unsigned keep_ = xpw; xpw = 0; PG8_STAGEXP(cX); xpw = keep_; } PG8_STAGEA(PG8_SA(0, 1), cA + hstep);
        if (wr == 1) PG8_BAR;
        PG8_WAIT_V(2); PG8_BAR;
        PG8_STAGEB(PG8_SB(1, 0), cB + kstep); PG8_STAGEA(PG8_SA(1, 0), cA + kstep); PG8_STAGEB(PG8_SB(1, 1), cB + hstep + kstep);
        PG8_WAIT_V(6); PG8_BAR;
    } else {
        PG8_STAGEB(PG8_SB(0, 0), cB); PG8_STAGEA(PG8_SA(0, 0), cA); PG8_STAGEB(PG8_SB(0, 1), cB + hstep); PG8_STAGEA(PG8_SA(0, 1), cA + hstep);
        if (wr == 1) PG8_BAR;
        PG8_WAIT_V(4); PG8_BAR;
        PG8_STAGEB(PG8_SB(1, 0), cB + kstep); PG8_STAGEA(PG8_SA(1, 0), cA + kstep); PG8_STAGEB(PG8_SB(1, 1), cB + hstep + kstep);
        PG8_WAIT_V(6); PG8_BAR;
    }
    for (;;) {
        const bool has_next = S.next(ui + 1, nxt);
        const unsigned nA = has_next ? (unsigned)nxt.pm * tstep : cA, nB = has_next ? (unsigned)nxt.pn * tstep : cB, nX = has_next ? xbase + (unsigned)nxt.pm * xstep : cX;
        for (int t = 0; t < nt; t += 2) {
            const bool last = (t == nt - 2);
            const unsigned a1 = cA + (unsigned)(t + 1) * kstep;
            const unsigned a2 = last ? nA : cA + (unsigned)(t + 2) * kstep, b2 = last ? nB : cB + (unsigned)(t + 2) * kstep;
            const unsigned a3 = a2 + kstep, b3 = b2 + kstep, x2 = last ? nX : cX + (unsigned)(t + 2) * kstep;
            if (last && has_next) S.a_ready(nxt);
            if constexpr (SP2) {
            PG8_LDB(B0, 0, 0); PG8_LDB(B1, 0, 1); PG8_SCHED; PG8_LDA(At, 0, 0); PG8_LDAX(Ax, 0); PG8_STAGEXP(x2); PG8_STAGEA(PG8_SA(1, 1), a1 + hstep);
            PG8_WAIT_LT(9, 8); PG8_WAIT_L(0); PG8_BAR; PG8_MMA(0, 0, At, B0); PG8_MMA(0, 1, At, B1); PG8_MMAX(); PG8_BAR; PG8_SCHED;
            PG8_LDA(At, 0, 1); PG8_STAGEB(PG8_SB(0, 0), b2); PG8_STAGEB(PG8_SB(0, 1), b2 + hstep); PG8_STAGEA(PG8_SA(0, 0), a2);
            PG8_WAIT_LT(9, 8); PG8_WAIT_L(0); PG8_BAR; PG8_MMA(1, 0, At, B0); PG8_MMA(1, 1, At, B1); PG8_BAR; PG8_SCHED;
            PG8_LDB(B0, 1, 0); PG8_LDB(B1, 1, 1); PG8_SCHED; PG8_LDA(At, 1, 0); PG8_LDAX(Ax, 1); PG8_STAGEA(PG8_SA(0, 1), a2 + hstep);
            PG8_WAIT_V(8); PG8_WAIT_L(0); PG8_BAR; PG8_MMA(0, 0, At, B0); PG8_MMA(0, 1, At, B1); PG8_MMAX(); PG8_BAR; PG8_SCHED;
            PG8_LDA(At, 1, 1); PG8_STAGEB(PG8_SB(1, 0), b3); PG8_STAGEB(PG8_SB(1, 1), b3 + hstep); PG8_STAGEA(PG8_SA(1, 0), a3);
            PG8_WAIT_V(8); PG8_WAIT_L(0); PG8_BAR; PG8_MMA(1, 0, At, B0); PG8_MMA(1, 1, At, B1); PG8_BAR; PG8_SCHED;
            xpw ^= 4096u; xoff0 ^= 4096; xoff1 ^= 4096;
            } else {
            PG8_LDB(B0, 0, 0); PG8_SCHED; PG8_LDA(At, 0, 0); PG8_STAGEA(PG8_SA(1, 1), a1 + hstep);
            PG8_WAIT_L(8); PG8_BAR; PG8_WAIT_L(0); PG8_MMA(0, 0, At, B0); PG8_BAR; PG8_SCHED;
            PG8_LDB(B1, 0, 1); PG8_STAGEB(PG8_SB(0, 0), b2);
            PG8_BAR; PG8_WAIT_L(0); PG8_MMA(0, 1, At, B1); PG8_BAR;
            PG8_LDA(At, 0, 1); PG8_STAGEA(PG8_SA(0, 0), a2);
            PG8_BAR; PG8_WAIT_L(0); PG8_MMA(1, 0, At, B0); PG8_BAR; PG8_SCHED;
            PG8_STAGEB(PG8_SB(0, 1), b2 + hstep);
            PG8_WAIT_V(6); PG8_BAR; PG8_MMA(1, 1, At, B1); PG8_BAR;
            PG8_LDB(B0, 1, 0); PG8_SCHED; PG8_LDA(At, 1, 0); PG8_STAGEA(PG8_SA(0, 1), a2 + hstep);
            PG8_WAIT_L(8); PG8_BAR; PG8_WAIT_L(0); PG8_MMA(0, 0, At, B0); PG8_BAR; PG8_SCHED;
            PG8_LDB(B1, 1, 1); PG8_STAGEB(PG8_SB(1, 0), b3);
            PG8_BAR; PG8_WAIT_L(0); PG8_MMA(0, 1, At, B1); PG8_BAR;
            PG8_LDA(At, 1, 1); PG8_STAGEA(PG8_SA(1, 0), a3);
            PG8_BAR; PG8_WAIT_L(0); PG8_MMA(1, 0, At, B0); PG8_BAR; PG8_SCHED;
            PG8_STAGEB(PG8_SB(1, 1), b3 + hstep);
            PG8_WAIT_V(6); PG8_BAR; PG8_MMA(1, 1, At, B1); PG8_BAR;
            }
        }
        if constexpr (ALIGN_EPI) { if (wr == 0) PG8_BAR; }
        E(acc, cur, wr, wc, fr, fq); E.rgx(accx, cur, wr, wc, fr, fq);
        if (!has_next) break;
#pragma unroll
        for (int a = 0; a < 2; ++a)
#pragma unroll
            for (int b = 0; b < 2; ++b)
#pragma unroll
                for (int m = 0; m < 4; ++m)
#pragma unroll
                    for (int n = 0; n < 2; ++n) acc[a][b][m][n] = (f32x4){0.f, 0.f, 0.f, 0.f};
        accx[0] = (f32x4){0.f, 0.f, 0.f, 0.f}; accx[1] = (f32x4){0.f, 0.f, 0.f, 0.f};
        cur = nxt; cA = nA; cB = nB; cX = nX; ++ui;
        if constexpr (ALIGN_EPI) { if (wr == 1) PG8_BAR; }
    }
    PG8_WAIT_V(0);
    if constexpr (!ALIGN_EPI) { if (wr == 0) PG8_BAR; }
    PG8_BAR;
#undef PG8_SA
#undef PG8_SB
#undef PG8_STAGEA
#undef PG8_STAGEB
#undef PG8_SX
#undef PG8_STAGEXP
#undef PG8_WAIT_LT
#undef PG8_LDAX
#undef PG8_MMAX
#undef PG8_LDA
#undef PG8_LDB
#undef PG8_MMA
#undef PG8_WAIT_V
#undef PG8_WAIT_L
#undef PG8_BAR
#undef PG8_SCHED
}
}

#define GAS __attribute__((address_space(1)))
#define LAS __attribute__((address_space(3)))
typedef unsigned short bf16;
typedef unsigned v4u __attribute__((ext_vector_type(4)));
typedef float f32x4 __attribute__((ext_vector_type(4)));
typedef short bf16x8 __attribute__((ext_vector_type(8)));
typedef GAS unsigned gu32;
typedef GAS unsigned long long gu64;
#define RLX_AGENT __ATOMIC_RELAXED, __HIP_MEMORY_SCOPE_AGENT
#define LDS_WAIT() asm volatile("s_waitcnt lgkmcnt(0)" ::: "memory")
#define VM_WAIT() asm volatile("s_waitcnt vmcnt(0)" ::: "memory")
__device__ __forceinline__ unsigned long long rt() { return __builtin_amdgcn_s_memrealtime(); }
__device__ __forceinline__ unsigned f2bf(float f) { unsigned u = __builtin_bit_cast(unsigned, f); return (u + 0x7fffu + ((u >> 16) & 1u)) >> 16; }
__device__ __forceinline__ unsigned pk2(float lo, float hi) { return f2bf(lo) | (f2bf(hi) << 16); }

#define XB_TMO      128
#define XB_XCNT(j)  (256  + 64 * (j))
#define XB_XSUB(j)  (1280 + 64 * (j))
#define XB_XGEN(j)  (2304 + 64 * (j))
#define XB_TOP      3328
#define XB_TOPGEN   3392
#define XCD_BAR_WORDS 3456
#define XB_SPIN_CAP (1u << 18)

__device__ __forceinline__ unsigned xb_ld(unsigned* p)              { return __hip_atomic_load(p, __ATOMIC_RELAXED, __HIP_MEMORY_SCOPE_AGENT); }
__device__ __forceinline__ unsigned xb_add(unsigned* p, unsigned v) { return __hip_atomic_fetch_add(p, v, __ATOMIC_RELAXED, __HIP_MEMORY_SCOPE_AGENT); }
__device__ __forceinline__ unsigned xb_xcc_id() { return (unsigned)__builtin_amdgcn_s_getreg((3 << 11) | 20) & 0xFu; }
#define XB_SPIN(cond, bar) do { unsigned _sp = 0; while (cond) { __builtin_amdgcn_s_sleep(1); \
    if ((++_sp & 255u) == 0u) { if (xb_ld(&(bar)[XB_TMO])) break; if (_sp > XB_SPIN_CAP) { atomicAdd(&(bar)[XB_TMO], 1u); break; } } } } while (0)

struct XcdBarrier {
    unsigned* bar; unsigned x; unsigned n;
    volatile LAS unsigned* st;
};

__device__ __forceinline__ XcdBarrier xcd_barrier_post(unsigned* bar, volatile LAS unsigned* st, unsigned n) {
    XcdBarrier b; b.bar = bar; b.x = xb_xcc_id(); b.st = st; b.n = n;
    if (threadIdx.x == 0) (void)xb_add(&bar[XB_XCNT(b.x)], 1u);
    return b;
}
__device__ __forceinline__ void xcd_barrier_complete(unsigned* bar, unsigned x, unsigned G, unsigned& nloc, unsigned& nx) {
    unsigned sum, cnt, mine, sp = 0u;
    for (;;) {
        sum = 0u; cnt = 0u; mine = 0u;
#pragma unroll
        for (unsigned j = 0; j < 16; ++j) { const unsigned c = xb_ld(&bar[XB_XCNT(j)]); sum += c; cnt += (c > 0u) ? 1u : 0u; mine = (j == x) ? c : mine; }
        if (sum == G) break;
        __builtin_amdgcn_s_sleep(1);
        if ((++sp & 255u) == 0u) { if (xb_ld(&bar[XB_TMO])) break; if (sp > XB_SPIN_CAP) { atomicAdd(&bar[XB_TMO], 1u); break; } }
    }
    nloc = mine > 0u ? mine : 1u; nx = cnt > 0u ? cnt : 1u;
}

__device__ __forceinline__ void xcd_barrier(const XcdBarrier& b) {
    asm volatile("s_waitcnt vmcnt(0)" ::: "memory");
    __syncthreads();
    if (threadIdx.x == 0) {
        unsigned* bar = b.bar;
        __builtin_amdgcn_s_waitcnt(0);
        unsigned nloc = b.st[0], nx = b.st[1];
        if (nloc == 0u) { xcd_barrier_complete(bar, b.x, b.n, nloc, nx); b.st[0] = nloc; b.st[1] = nx; }
        const unsigned old = xb_add(&bar[XB_XSUB(b.x)], 1u);
        const unsigned gen = old / nloc;
        if (old + 1u == (gen + 1u) * nloc) {
            __builtin_amdgcn_fence(__ATOMIC_RELEASE, "agent");
            asm volatile("s_waitcnt vmcnt(0)" ::: "memory");
            const unsigned og = xb_add(&bar[XB_TOP], 1u);
            const unsigned tg = og / nx;
            if (og + 1u == (tg + 1u) * nx) xb_add(&bar[XB_TOPGEN], 1u);
            else XB_SPIN(xb_ld(&bar[XB_TOPGEN]) == tg, bar);
            __builtin_amdgcn_fence(__ATOMIC_ACQUIRE, "agent");
            xb_add(&bar[XB_XGEN(b.x)], 1u);
            asm volatile("s_waitcnt vmcnt(0)" ::: "memory");
        } else {
            XB_SPIN(xb_ld(&bar[XB_XGEN(b.x)]) == gen, bar);
            __builtin_amdgcn_fence(__ATOMIC_ACQUIRE, "agent");
            asm volatile("s_waitcnt vmcnt(0)" ::: "memory");
        }
    }
    __syncthreads();
}


constexpr int NWAVES = 8;
#ifndef MK_ONE_LAUNCH
#define MK_ONE_LAUNCH 1
#endif
constexpr int N_PHASES = 15;

constexpr int D = 1024, FF = 4096, MP = 8 * 2048, MS = 128 * 8, M = MP + MS;
constexpr int NG = 64, PS = 64, GS = 16;
constexpr float EPS = 1e-6f;
constexpr size_t O_Y = 0, O_SRP = (size_t)M * D, O_SIP = O_SRP + 8 * 4096, O_CP = O_SIP + 8 * 4096, O_SRS = O_CP + 8 * 2 * 1024, O_SIS = O_SRS + 128 * 4096, O_CS = O_SIS + 128 * 4096, O_END = O_CS + 128 * 2 * 1024;
static_assert(O_END == 19218432, "output size");

constexpr size_t MiB = 1u << 20;
constexpr size_t WS_CTL = 0, CTL_ZERO_BYTES = 1 * MiB;
constexpr size_t WS_SSQ = 112 * MiB;
constexpr size_t WS_SSME = 114 * MiB;
constexpr size_t WS_SSMP = 2 * MiB;
constexpr size_t WS_WGU = 4 * MiB;
constexpr size_t WS_WD = 68 * MiB;
constexpr size_t WS_WGLU = 100 * MiB;
constexpr size_t WS_WIN = 104 * MiB;
constexpr size_t WS_WOUT = 110 * MiB;
constexpr size_t WS_X = 112 * MiB;
constexpr size_t WS_XB = 180 * MiB;
constexpr size_t WS_H = 214 * MiB;
constexpr size_t WS_G = 350 * MiB, WS_A2 = WS_G, WS_Z = 384 * MiB, WS_GB = 418 * MiB;
constexpr size_t WS_END = 452 * MiB;
constexpr int CW_TMO = 0;
constexpr int CW_BAR = 4096;
constexpr int CW_SK = 16384;

constexpr int RING_OFF = 0, RING_BYTES = 131072 + 8192;
constexpr int RSTD_OFF = RING_BYTES;
constexpr int LDSCTL_OFF = RING_BYTES + 2048, MISC_OFF = LDSCTL_OFF + 320;
constexpr int LDS_BYTES = 147456;

struct Frame {
    LAS unsigned char* lds;
    volatile LAS unsigned* MISC;
    gu32* ctl;
    int tid, lane, wave, vcu, G, gi, ci;
    const float* in[21]; float* out; unsigned char* ws;
};

__device__ __forceinline__ int opaque_i(int v) { asm volatile("" : "+v"(v)); return v; }
__device__ __forceinline__ float wave_sum(float v) {
#pragma unroll
    for (int o = 1; o < 64; o <<= 1) v += __shfl_xor(v, o);
    return v;
}
__device__ __forceinline__ float bf2f(unsigned short b) { return __builtin_bit_cast(float, (unsigned)b << 16); }

struct P0Item { const float* W; bf16* WT; const float* gk; int K, N, k0, n0s, n0d; };
__device__ __forceinline__ int pair_src(int nd, int base, int hstride) { return base + ((nd >> 7) & 1) * hstride + 128 * (nd >> 8) + (nd & 127); }
__device__ __forceinline__ P0Item p0_item(Frame& F, int it) {
    constexpr int I_GU = (D / 64) * (2 * FF / 64), I_D = (FF / 64) * (D / 64), I_GLU = (D / 64) * (2 * D / 64), I_IN = (D / 64) * (3 * D / 64);
    const float* norm_g = F.in[5]; P0Item p; int r = it;
    if (r < 4 * I_GU) { const int f = r / I_GU; r -= f * I_GU; const int nb = r % (2 * FF / 64), kb = r / (2 * FF / 64), nd = 64 * nb;
        p.W = F.in[7] + (size_t)f * D * 2 * FF; p.K = D; p.N = 2 * FF; p.WT = (bf16*)(F.ws + WS_WGU) + (size_t)f * 2 * FF * D; p.gk = norm_g + ((f >> 1) * 3 + (f & 1) * 2) * D; p.k0 = 64 * kb; p.n0s = pair_src(nd, 0, FF); p.n0d = nd; return p; }
    r -= 4 * I_GU;
    if (r < 4 * I_D) { const int f = r / I_D; r -= f * I_D; const int nb = r % (D / 64), kb = r / (D / 64), nd = 64 * nb;
        p.W = F.in[8] + (size_t)f * FF * D; p.K = FF; p.N = D; p.WT = (bf16*)(F.ws + WS_WD) + (size_t)f * D * FF; p.gk = nullptr; p.k0 = 64 * kb; p.n0s = nd; p.n0d = nd; return p; }
    r -= 4 * I_D;
    if (r < I_GLU) { const int nb = r % (2 * D / 64), kb = r / (2 * D / 64), nd = 64 * nb;
        p.W = F.in[17]; p.K = D; p.N = 2 * D; p.WT = (bf16*)(F.ws + WS_WGLU); p.gk = nullptr; p.k0 = 64 * kb; p.n0s = pair_src(nd, 0, D); p.n0d = nd; return p; }
    r -= I_GLU;
    if (r < I_IN) { const int nb = r % (3 * D / 64), kb = r / (3 * D / 64), nd = 64 * nb;
        p.W = F.in[18]; p.K = D; p.N = 3 * D; p.WT = (bf16*)(F.ws + WS_WIN); p.gk = norm_g + 4 * D; p.k0 = 64 * kb; p.n0s = nd < 2048 ? pair_src(nd, D, D) : nd - 2048; p.n0d = nd; return p; }
    r -= I_IN;
    { const int nb = r % (D / 64), kb = r / (D / 64), nd = 64 * nb;
        p.W = F.in[20]; p.K = D; p.N = D; p.WT = (bf16*)(F.ws + WS_WOUT); p.gk = nullptr; p.k0 = 64 * kb; p.n0s = nd; p.n0d = nd; return p; }
}
#define P0_LOAD(v, gs, p) do { _Pragma("unroll") for (int i = 0; i < 8; ++i) _Pragma("unroll") for (int s = 0; s < 2; ++s) { \
        v[i][s] = *(const GAS f32x4*)((p).W + (size_t)((p).k0 + 8 * i + 2 * kr + s) * (p).N + (p).n0s + 4 * c); gs[i][s] = (p).gk ? (p).gk[(p).k0 + 8 * i + 2 * kr + s] : 1.0f; } } while (0)
#define P0_PROC(v, gs, p) do { \
        _Pragma("unroll") for (int i = 0; i < 8; ++i) _Pragma("unroll") for (int j = 0; j < 4; ++j) \
            *(LAS unsigned*)(scr + (4 * c + j) * 128 + (((4 * i + kr) ^ ((c & 7) << 2)) << 2)) = pg8::cvt_pk_bf16(v[i][0][j] * gs[i][0], v[i][1][j] * gs[i][1]); \
        LDS_WAIT(); asm volatile("" ::: "memory"); \
        _Pragma("unroll") for (int i = 0; i < 8; ++i) { const int n = nr + 8 * i; const v4u o = *(const LAS v4u*)(scr + n * 128 + ((q ^ ((n >> 2) & 7)) << 4)); \
            *(GAS v4u*)((p).WT + (size_t)((p).n0d + n) * (p).K + (p).k0 + 8 * q) = o; } \
        LDS_WAIT(); asm volatile("" ::: "memory"); } while (0)

__device__ __forceinline__ void p0_prologue(Frame& F) {
    LAS unsigned char* scr = F.lds + RING_OFF + F.wave * 16384;
    const int gw = F.vcu * NWAVES + F.wave, NGW = F.G * NWAVES, lane = opaque_i(F.lane);
    constexpr int NITEMS = 4 * (D / 64) * (2 * FF / 64) + 4 * (FF / 64) * (D / 64) + (D / 64) * (2 * D / 64) + (D / 64) * (3 * D / 64) + (D / 64) * (D / 64);
    { const int kr = lane >> 4, c = lane & 15, nr = lane >> 3, q = lane & 7;
      f32x4 va[8][2], vb[8][2]; float ga[8][2], gb[8][2];
      int it = gw; P0Item pa = p0_item(F, it < NITEMS ? it : 0), pb = pa;
      if (it < NITEMS) P0_LOAD(va, ga, pa);
      while (it < NITEMS) {
          const int it1 = it + NGW; if (it1 < NITEMS) { pb = p0_item(F, it1); P0_LOAD(vb, gb, pb); }
          P0_PROC(va, ga, pa);
          if (it1 >= NITEMS) break;
          const int it2 = it1 + NGW; if (it2 < NITEMS) { pa = p0_item(F, it2); P0_LOAD(va, ga, pa); }
          P0_PROC(vb, gb, pb);
          it = it2;
      }
    }
    bf16* XB = (bf16*)(F.ws + WS_XB); pg8::ssq_t* ssq = (pg8::ssq_t*)(F.ws + WS_SSQ);
    for (int m0 = gw; m0 < M; m0 += 4 * NGW) {
        f32x4 v[4][4];
#pragma unroll
        for (int r = 0; r < 4; ++r) { const int m = m0 + r * NGW; if (m < M) { const float* src = m < MP ? F.in[0] + (size_t)m * D : F.in[1] + (size_t)(m - MP) * D;
#pragma unroll
            for (int j = 0; j < 4; ++j) v[r][j] = ((const GAS f32x4*)src)[lane + 64 * j]; } }
#pragma unroll
        for (int r = 0; r < 4; ++r) { const int m = m0 + r * NGW; if (m < M) {
            GAS unsigned long long* o8 = (GAS unsigned long long*)(XB + (size_t)m * D) + lane; float s = 0.f;
#pragma unroll
            for (int j = 0; j < 4; ++j) { const f32x4 w = v[r][j]; s += (w.x * w.x + w.y * w.y) + (w.z * w.z + w.w * w.w);
                o8[64 * j] = (unsigned long long)pg8::cvt_pk_bf16(w.x, w.y) | ((unsigned long long)pg8::cvt_pk_bf16(w.z, w.w) << 32); }
            s = wave_sum(s);
            if (lane == 0) ssq[m] = pg8::ssq_fix(s); } }
    }
    for (int i = gw * 64 + lane; i < 7 * M; i += NGW * 64) ssq[M + i] = 0ull;
    float* sp = (float*)(F.ws + WS_SSMP);
    for (int i = gw * 64 + lane; i < NG * PS; i += NGW * 64) {
        const int g = i / PS;
        const float lr = F.in[9][i], li = F.in[10][i], dt = expf(F.in[11][g]);
        const float mag = expf(lr * dt); float sn, cs; sincosf(li * dt, &sn, &cs);
        const float lbr = mag * cs, lbi = mag * sn, den = lr * lr + li * li, nr = lbr - 1.0f, ni = lbi;
        const float fr = (nr * lr + ni * li) / den, fi = (ni * lr - nr * li) / den;
        sp[i] = lbr; sp[4096 + i] = lbi;
#pragma unroll
        for (int c = 0; c < GS; ++c) { const float br = F.in[12][(size_t)i * GS + c], bi = F.in[13][(size_t)i * GS + c];
            sp[8192 + (size_t)i * GS + c] = fr * br - fi * bi; sp[8192 + 65536 + (size_t)i * GS + c] = fr * bi + fi * br; }
    }
}

__device__ __forceinline__ float gelu_tanh(float x) {
    const float a = 0.7978845608028654f * (x + 0.044715f * x * x * x);
    return x * __builtin_amdgcn_rcpf(1.0f + __builtin_amdgcn_exp2f(-2.0f * 1.4426950408889634f * a));
}


typedef float f32x16 __attribute__((ext_vector_type(16)));
typedef unsigned u32x2v __attribute__((ext_vector_type(2)));
__device__ __forceinline__ unsigned cvtpk(float lo, float hi) { unsigned r; asm volatile("v_cvt_pk_bf16_f32 %0, %1, %2" : "=v"(r) : "v"(lo), "v"(hi)); return r; }
__device__ __forceinline__ bf16x8 pack8(const float* v) { v4u w; w.x = cvtpk(v[0], v[1]); w.y = cvtpk(v[2], v[3]); w.z = cvtpk(v[4], v[5]); w.w = cvtpk(v[6], v[7]); return __builtin_bit_cast(bf16x8, w); }
__device__ __forceinline__ float fma_s(float a, float b, float c) { float r; asm("v_fma_f32 %0, %1, %2, %3" : "=v"(r) : "v"(a), "v"(b), "v"(c)); return r; }
constexpr int SSM_ROWB = 272;
constexpr int SSM_NCH = 8, SSM_CHB = 8;
#define BFLO(w) __builtin_bit_cast(float, (w) << 16)
#define BFHI(w) __builtin_bit_cast(float, (w) & 0xffff0000u)

template <int MODE, int NI>
__device__ __forceinline__ void ssm_run(Frame& F, LAS unsigned char* img0, int lane, int g, const int (&row_base)[NI], int nblk, bool sample, int seq0, float (&hr)[NI], float (&hi)[NI]) {
    const bf16* X = (const bf16*)(F.ws + WS_XB); const pg8::ssq_t* ssq = (const pg8::ssq_t*)(F.ws + WS_SSQ) + 1 * M;
    const float* sp = (const float*)(F.ws + WS_SSMP); bf16* Gb = (bf16*)(F.ws + WS_G);
    const float* g1 = F.in[5] + 1 * D; const float* dsk = F.in[16];
    const int l31 = lane & 31, h = lane >> 5, l15 = lane & 15, q4 = lane >> 4;
    bf16x8 bbq[4];
#pragma unroll
    for (int q = 0; q < 4; ++q) { const int p = 32 * (q & 1) + l31; const float* src = sp + 8192 + (q >> 1) * 65536 + ((size_t)(g * PS + p) * GS + 8 * h);
        float v[8];
#pragma unroll
        for (int j = 0; j < 8; ++j) v[j] = src[j] * g1[g * GS + 8 * h + j];
        bbq[q] = pack8(v); }
    bf16x8 cm[4]; float dg[4];
    if (MODE == 1) {
#pragma unroll
        for (int ks = 0; ks < 4; ++ks) { const int p0 = 16 * ks + 4 * q4; const float* cr = F.in[14] + ((size_t)(g * GS + l15) * PS + p0); const float* ci = F.in[15] + ((size_t)(g * GS + l15) * PS + p0);
            float v[8];
#pragma unroll
            for (int j = 0; j < 4; ++j) { v[2 * j] = cr[j]; v[2 * j + 1] = -ci[j]; }
            cm[ks] = pack8(v); }
#pragma unroll
        for (int e = 0; e < 4; ++e) dg[e] = dsk[g * GS + 4 * q4 + e] * g1[g * GS + 4 * q4 + e];
    }
    const float lbr = sp[g * PS + lane], lbi = sp[4096 + g * PS + lane], nlbi = -lbi;
    float s0r[4], s0i[4];
    if (sample) {
#pragma unroll
        for (int i = 0; i < 4; ++i) { s0r[i] = F.in[2][((size_t)(seq0 + i) * NG + g) * PS + lane]; s0i[i] = F.in[3][((size_t)(seq0 + i) * NG + g) * PS + lane]; } }
    else {
#pragma unroll
        for (int i = 0; i < 4; ++i) { s0r[i] = 0.f; s0i[i] = 0.f; } }
    v4u xaw[NI]; u32x2v xew0[NI], xew1[NI]; pg8::ssq_t qa[NI], qe0[NI], qe1[NI];
#define SSM_LOAD(b) do { _Pragma("unroll") for (int j = 0; j < NI; ++j) { const int rowA = row_base[j] + 32 * (b) + l31; xaw[j] = *(const GAS v4u*)(X + (size_t)rowA * D + g * GS + 8 * h); qa[j] = ssq[rowA]; \
        if (MODE == 1) { const int rowE = row_base[j] + 32 * (b) + l15; xew0[j] = *(const GAS u32x2v*)(X + (size_t)rowE * D + g * GS + 4 * q4); xew1[j] = *(const GAS u32x2v*)(X + (size_t)(rowE + 16) * D + g * GS + 4 * q4); qe0[j] = ssq[rowE]; qe1[j] = ssq[rowE + 16]; } \
        else { qe0[j] = 0; qe1[j] = 0; } } } while (0)
    SSM_LOAD(0);
    for (int b = 0; b < nblk; ++b) {
        f32x4 ca0[NI], ca1[NI], ce0[NI], ce1[NI]; pg8::ssq_t cqa[NI], cqe0[NI], cqe1[NI];
#pragma unroll
        for (int j = 0; j < NI; ++j) { ca0[j] = (f32x4){BFLO(xaw[j].x), BFHI(xaw[j].x), BFLO(xaw[j].y), BFHI(xaw[j].y)}; ca1[j] = (f32x4){BFLO(xaw[j].z), BFHI(xaw[j].z), BFLO(xaw[j].w), BFHI(xaw[j].w)};
            if (MODE == 1) { ce0[j] = (f32x4){BFLO(xew0[j].x), BFHI(xew0[j].x), BFLO(xew0[j].y), BFHI(xew0[j].y)}; ce1[j] = (f32x4){BFLO(xew1[j].x), BFHI(xew1[j].x), BFLO(xew1[j].y), BFHI(xew1[j].y)}; }
            cqa[j] = qa[j]; cqe0[j] = qe0[j]; cqe1[j] = qe1[j]; }
        if (b + 1 < nblk) SSM_LOAD(b + 1);
        f32x16 Xr[NI], Yr[NI], Xi[NI], Yi[NI];
#pragma unroll
        for (int j = 0; j < NI; ++j) {
            const float rsa = pg8::rstd_of(cqa[j]);
            float ua[8];
#pragma unroll
            for (int e = 0; e < 4; ++e) { ua[e] = ca0[j][e] * rsa; ua[4 + e] = ca1[j][e] * rsa; }
            const bf16x8 ufrag = pack8(ua);
            const f32x16 zero16 = {0.f, 0.f, 0.f, 0.f, 0.f, 0.f, 0.f, 0.f, 0.f, 0.f, 0.f, 0.f, 0.f, 0.f, 0.f, 0.f};
            Xr[j] = __builtin_amdgcn_mfma_f32_32x32x16_bf16(ufrag, bbq[0], zero16, 0, 0, 0);
            Yr[j] = __builtin_amdgcn_mfma_f32_32x32x16_bf16(ufrag, bbq[1], zero16, 0, 0, 0);
            Xi[j] = __builtin_amdgcn_mfma_f32_32x32x16_bf16(ufrag, bbq[2], zero16, 0, 0, 0);
            Yi[j] = __builtin_amdgcn_mfma_f32_32x32x16_bf16(ufrag, bbq[3], zero16, 0, 0, 0); }
#pragma unroll
        for (int j = 0; j < NI; ++j)
#pragma unroll
            for (int r = 0; r < 16; ++r) {
                auto s1 = __builtin_amdgcn_permlane32_swap(__float_as_uint(Xr[j][r]), __float_as_uint(Yr[j][r]), false, false); Xr[j][r] = __uint_as_float(s1[0]); Yr[j][r] = __uint_as_float(s1[1]);
                auto s2 = __builtin_amdgcn_permlane32_swap(__float_as_uint(Xi[j][r]), __float_as_uint(Yi[j][r]), false, false); Xi[j][r] = __uint_as_float(s2[0]); Yi[j][r] = __uint_as_float(s2[1]); }
#pragma unroll
        for (int i = 0; i < 4; ++i) {
            if (sample) { hr[0] = s0r[i]; hi[0] = s0i[i]; }
#pragma unroll
            for (int s = 0; s < 2; ++s)
#pragma unroll
                for (int e = 0; e < 4; ++e)
#pragma unroll
                    for (int j = 0; j < NI; ++j) { const int r = 4 * i + e; const float br = s ? Yr[j][r] : Xr[j][r], bi = s ? Yi[j][r] : Xi[j][r];
                        const float nr = fma_s(lbr, hr[j], fma_s(nlbi, hi[j], br)), ni = fma_s(lbr, hi[j], fma_s(lbi, hr[j], bi)); hr[j] = nr; hi[j] = ni;
                        if (MODE == 1) *(LAS unsigned*)(img0 + j * (32 * SSM_ROWB) + (8 * i + 4 * s + e) * SSM_ROWB + 4 * lane) = cvtpk(nr, ni); }
            if (sample) { F.out[O_SRS + ((size_t)(seq0 + i) * NG + g) * PS + lane] = hr[0]; F.out[O_SIS + ((size_t)(seq0 + i) * NG + g) * PS + lane] = hi[0]; }
        }
        if (MODE == 1) {
#pragma unroll
            for (int j = 0; j < NI; ++j) {
                const LAS unsigned char* img = img0 + j * (32 * SSM_ROWB);
                f32x4 acc0 = {0.f, 0.f, 0.f, 0.f}, acc1 = {0.f, 0.f, 0.f, 0.f};
#pragma unroll
                for (int ks = 0; ks < 4; ++ks) {
                    const bf16x8 b0 = *(const LAS bf16x8*)(img + l15 * SSM_ROWB + 64 * ks + 16 * q4);
                    const bf16x8 b1 = *(const LAS bf16x8*)(img + (16 + l15) * SSM_ROWB + 64 * ks + 16 * q4);
                    acc0 = __builtin_amdgcn_mfma_f32_16x16x32_bf16(cm[ks], b0, acc0, 0, 0, 0);
                    acc1 = __builtin_amdgcn_mfma_f32_16x16x32_bf16(cm[ks], b1, acc1, 0, 0, 0); }
                const float rse0 = pg8::rstd_of(cqe0[j]), rse1 = pg8::rstd_of(cqe1[j]);
                float o0[4], o1[4];
#pragma unroll
                for (int e = 0; e < 4; ++e) { o0[e] = gelu_tanh(acc0[e] + dg[e] * ce0[j][e] * rse0); o1[e] = gelu_tanh(acc1[e] + dg[e] * ce1[j][e] * rse1); }
                const int rowE = row_base[j] + 32 * b + l15;
                u32x2v w0, w1; w0.x = cvtpk(o0[0], o0[1]); w0.y = cvtpk(o0[2], o0[3]); w1.x = cvtpk(o1[0], o1[1]); w1.y = cvtpk(o1[2], o1[3]);
                *(u32x2v*)(Gb + (size_t)rowE * D + g * GS + 4 * q4) = w0;
                *(u32x2v*)(Gb + (size_t)(rowE + 16) * D + g * GS + 4 * q4) = w1; }
        }
    }
#undef SSM_LOAD
}

__device__ __forceinline__ void ssm_phase_pass(Frame& F, int pass) {
    LAS unsigned char* img = F.lds + RING_OFF + F.wave * (2 * 32 * SSM_ROWB);
    const int lane = opaque_i(F.lane), s = F.wave * 32 + F.ci, g = s & 63, c0 = s >> 6;
    float* E = (float*)(F.ws + WS_SSME) + ((size_t)(F.gi * NG + g) * SSM_NCH) * 2 * PS;
    const int rb[2] = {F.gi * 2048 + c0 * (SSM_CHB * 32), F.gi * 2048 + (c0 + 4) * (SSM_CHB * 32)};
    if (pass == 0) {
        float hr[2] = {0.f, 0.f}, hi[2] = {0.f, 0.f};
        ssm_run<0, 2>(F, img, lane, g, rb, SSM_CHB, false, 0, hr, hi);
#pragma unroll
        for (int j = 0; j < 2; ++j) { E[((c0 + 4 * j) * 2 + 0) * PS + lane] = hr[j]; E[((c0 + 4 * j) * 2 + 1) * PS + lane] = hi[j]; }
        float sr[1] = {0.f}, si[1] = {0.f}; const int rs[1] = {MP + 128 * F.gi + 32 * c0};
        ssm_run<1, 1>(F, img, lane, g, rs, 1, true, 16 * F.gi + 4 * c0, sr, si);
    } else {
        const float* sp = (const float*)(F.ws + WS_SSMP);
        float ar = sp[g * PS + lane], ai = sp[4096 + g * PS + lane];
#pragma unroll
        for (int k = 0; k < 8; ++k) { const float nr = ar * ar - ai * ai, ni = 2.0f * ar * ai; ar = nr; ai = ni; }
        float hr[2] = {0.f, 0.f}, hi[2] = {0.f, 0.f}; float tr = 0.f, ti = 0.f;
        for (int j = 0; j < c0 + 4; ++j) { const float er = E[(j * 2 + 0) * PS + lane], ei = E[(j * 2 + 1) * PS + lane];
            const float nr = ar * tr - ai * ti + er, ni = ar * ti + ai * tr + ei; tr = nr; ti = ni;
            if (j + 1 == c0) { hr[0] = tr; hi[0] = ti; } }
        hr[1] = tr; hi[1] = ti;
        ssm_run<1, 2>(F, img, lane, g, rb, SSM_CHB, false, 0, hr, hi);
        if (c0 == 3) { F.out[O_SRP + ((size_t)F.gi * NG + g) * PS + lane] = hr[1]; F.out[O_SIP + ((size_t)F.gi * NG + g) * PS + lane] = hi[1]; }
    }
}
#undef BFLO
#undef BFHI

__device__ __forceinline__ void conv_phase(Frame& F) {
    const bf16* Z = (const bf16*)(F.ws + WS_Z); const bf16* GBp = (const bf16*)(F.ws + WS_GB); bf16* A2 = (bf16*)(F.ws + WS_A2);
    const float* cw = F.in[19]; const float* cache = F.in[4];
    const int gt = (F.ci * NWAVES + F.wave) * 64 + opaque_i(F.lane), NGT = 32 * NWAVES * 64;
    for (int it = gt; it < (2048 + 128) * (D / 8); it += NGT) {
        const int lr = it >> 7, row = lr < 2048 ? F.gi * 2048 + lr : MP + F.gi * 128 + (lr - 2048), c0 = (it & 127) * 8;
        int t; const float* cb = nullptr;
        if (row < MP) t = row & 2047; else { const int r2 = row - MP; t = r2 & 7; cb = cache + (size_t)(r2 >> 3) * 2 * D; }
        float z0[8], z1[8], z2[8], gb[8];
        { const v4u v = *(const GAS v4u*)(Z + (size_t)row * D + c0); const v4u q = *(const GAS v4u*)(GBp + (size_t)row * D + c0);
#pragma unroll
          for (int e = 0; e < 4; ++e) { z2[2 * e] = __builtin_bit_cast(float, v[e] << 16); z2[2 * e + 1] = __builtin_bit_cast(float, v[e] & 0xffff0000u);
                                        gb[2 * e] = __builtin_bit_cast(float, q[e] << 16); gb[2 * e + 1] = __builtin_bit_cast(float, q[e] & 0xffff0000u); } }
        if (t >= 1) { const v4u v = *(const GAS v4u*)(Z + (size_t)(row - 1) * D + c0);
#pragma unroll
          for (int e = 0; e < 4; ++e) { z1[2 * e] = __builtin_bit_cast(float, v[e] << 16); z1[2 * e + 1] = __builtin_bit_cast(float, v[e] & 0xffff0000u); } }
        else {
#pragma unroll
          for (int e = 0; e < 8; ++e) z1[e] = cb ? cb[D + c0 + e] : 0.f; }
        if (t >= 2) { const v4u v = *(const GAS v4u*)(Z + (size_t)(row - 2) * D + c0);
#pragma unroll
          for (int e = 0; e < 4; ++e) { z0[2 * e] = __builtin_bit_cast(float, v[e] << 16); z0[2 * e + 1] = __builtin_bit_cast(float, v[e] & 0xffff0000u); } }
        else {
#pragma unroll
          for (int e = 0; e < 8; ++e) z0[e] = cb ? cb[t * D + c0 + e] : 0.f; }
        float o[8];
#pragma unroll
        for (int e = 0; e < 8; ++e) o[e] = gb[e] * (cw[c0 + e] * z0[e] + cw[D + c0 + e] * z1[e] + cw[2 * D + c0 + e] * z2[e]);
        v4u w; w.x = pk2(o[0], o[1]); w.y = pk2(o[2], o[3]); w.z = pk2(o[4], o[5]); w.w = pk2(o[6], o[7]);
        *(GAS v4u*)(A2 + (size_t)row * D + c0) = w;
    }
}

__device__ __forceinline__ void final_phase(Frame& F) {
    const bf16* XBp = (const bf16*)(F.ws + WS_XB); const pg8::ssq_t* ssq = (const pg8::ssq_t*)(F.ws + WS_SSQ) + 6 * M; const float* fg = F.in[6];
    const int gw = F.ci * NWAVES + F.wave, NGW = 32 * NWAVES, lane = opaque_i(F.lane);
    f32x4 gv[4];
#pragma unroll
    for (int j = 0; j < 4; ++j) gv[j] = ((const GAS f32x4*)fg)[lane + 64 * j];
    for (int lr = gw; lr < 2048 + 128; lr += NGW) { const int m = lr < 2048 ? F.gi * 2048 + lr : MP + F.gi * 128 + (lr - 2048);
        const float rs = pg8::rstd_of(ssq[m]);
        const GAS unsigned long long* xr = (const GAS unsigned long long*)(XBp + (size_t)m * D) + lane; GAS f32x4* yo = (GAS f32x4*)(F.out + O_Y + (size_t)m * D) + lane;
#pragma unroll
        for (int j = 0; j < 4; ++j) { const unsigned long long w = xr[64 * j]; const unsigned lo = (unsigned)w, hi = (unsigned)(w >> 32);
            const f32x4 xv = {__builtin_bit_cast(float, lo << 16), __builtin_bit_cast(float, lo & 0xffff0000u), __builtin_bit_cast(float, hi << 16), __builtin_bit_cast(float, hi & 0xffff0000u)};
            yo[64 * j] = xv * rs * gv[j]; }
    }
}

struct SameOrder : pg8::StaticOrder { __device__ bool next(int i, pg8::Unit& u) const { const bool r = pg8::StaticOrder::next(i, u); u.pm = 0; u.pn = 0; return r; } };
struct Args { const float* in[21]; float* out; unsigned char* ws; int ph_lo, ph_hi; };
__global__ void __launch_bounds__(NWAVES * 64, 2) skel_fwd(Args args) {
    extern __shared__ __attribute__((aligned(16))) unsigned char lds[];
    Frame F;
    F.lds = (LAS unsigned char*)lds;
    F.MISC = (volatile LAS unsigned*)(F.lds + MISC_OFF);
    F.tid = threadIdx.x; F.lane = F.tid & 63; F.wave = __builtin_amdgcn_readfirstlane(F.tid >> 6);
    F.G = gridDim.x; { const int bx = blockIdx.x; F.vcu = (bx % 8) * (F.G / 8) + bx / 8; F.gi = bx % 8; F.ci = bx / 8; }
    F.ws = args.ws; F.out = args.out; F.ctl = (gu32*)(args.ws + WS_CTL);
#pragma unroll
    for (int i = 0; i < 21; ++i) F.in[i] = args.in[i];
    for (int u = F.tid; u < (LDS_BYTES - LDSCTL_OFF) / 4; u += NWAVES * 64) ((LAS unsigned*)(F.lds + LDSCTL_OFF))[u] = 0u;
    __syncthreads();
    XcdBarrier bar = xcd_barrier_post((unsigned*)(F.ctl + CW_BAR), F.MISC + 8, (unsigned)F.G);
    XcdBarrier gbar = xcd_barrier_post((unsigned*)(F.ctl + CW_BAR) + (1 + F.gi) * XCD_BAR_WORDS, F.MISC + 10, (unsigned)(F.G / 8));
    const int lo = args.ph_lo, hi = args.ph_hi;
#define IN(k) (lo <= (k) && (k) < hi)
#if defined(PROBE_A_LO)
#define STAMP(k) do { if (blockIdx.x == 0 && F.tid == 0) { const unsigned long long t_ = __builtin_amdgcn_s_memrealtime(); F.MISC[16 + 2 * (k)] = (unsigned)t_; F.MISC[17 + 2 * (k)] = (unsigned)(t_ >> 32); } } while (0)
#else
#define STAMP(k) do { } while (0)
#endif
    STAMP(0);
#define SEAM(k) do { if (IN((k) + 1)) { if ((k) == 0) xcd_barrier(bar); else xcd_barrier(gbar); } STAMP((k) + 1); } while (0)
    bf16* XB = (bf16*)(F.ws + WS_XB); bf16* H = (bf16*)(F.ws + WS_H); pg8::ssq_t* ssq = (pg8::ssq_t*)(F.ws + WS_SSQ);
    const int bx = (int)blockIdx.x;

    if (IN(0)) { p0_prologue(F); SEAM(0); }
#define FFN_GU(ph, f, sin) if (IN(ph)) { pg8::Gemm g{XB, (const bf16*)(F.ws + WS_WGU) + (size_t)(f) * 2 * FF * D, M, 2 * FF, D}; pg8::StaticOrder S; S.init(MP, 2 * FF, F.G, bx); \
        pg8::EpiGateUp E{H, FF, ssq + (size_t)(sin) * M, (LAS float*)(F.lds + RSTD_OFF)}; pg8::gemm_phase<pg8::EpiGateUp, pg8::StaticOrder, true, true>(F.lds + RING_OFF, g, S, E); SEAM(ph); }
#define FFN_DN(ph, f, sout) if (IN(ph)) { pg8::Gemm g{H, (const bf16*)(F.ws + WS_WD) + (size_t)(f) * D * FF, M, D, FF}; pg8::StaticOrder S; S.init(MP, D, F.G, bx); \
        pg8::EpiResid<0> E{(ph) == 2 ? F.in[0] : nullptr, (ph) == 2 ? F.in[1] : nullptr, XB, ssq + (size_t)(sout) * M, 0.5f}; pg8::gemm_phase<pg8::EpiResid<0>, pg8::StaticOrder, true, true>(F.lds + RING_OFF, g, S, E); SEAM(ph); }
    FFN_GU(1, 0, 0)
    FFN_DN(2, 0, 1)
#if defined(PROBE_SSM)
    if (IN(3)) { ssm_phase_pass(F, 0); if (PROBE_SSM == 1) { xcd_barrier(gbar); ssm_phase_pass(F, 0); } xcd_barrier(gbar); ssm_phase_pass(F, 1); if (PROBE_SSM == 2) { xcd_barrier(gbar); ssm_phase_pass(F, 1); } SEAM(3); }
#else
    if (IN(3)) { ssm_phase_pass(F, 0); xcd_barrier(gbar); ssm_phase_pass(F, 1); SEAM(3); }
#endif
    if (IN(4)) { pg8::Gemm g{(const bf16*)(F.ws + WS_G), (const bf16*)(F.ws + WS_WGLU), M, 2 * D, D}; pg8::StaticOrder S; S.init(MP, 2 * D, F.G, bx);
        pg8::EpiResid<1> E{nullptr, nullptr, XB, ssq + (size_t)2 * M, 1.0f}; pg8::gemm_phase<pg8::EpiResid<1>, pg8::StaticOrder, true, true>(F.lds + RING_OFF, g, S, E); SEAM(4); }
    FFN_GU(5, 1, 2)
    FFN_DN(6, 1, 3)
    FFN_GU(7, 2, 3)
    FFN_DN(8, 2, 4)
    if (IN(9)) { pg8::Gemm g{XB, (const bf16*)(F.ws + WS_WIN), M, 3 * D, D}; pg8::StaticOrder S; S.init(MP, 3 * D, F.G, bx);
        pg8::EpiConvIn E{(bf16*)(F.ws + WS_Z), (bf16*)(F.ws + WS_GB), ssq + (size_t)4 * M, F.out + O_CP, F.out + O_CS, (LAS float*)(F.lds + RSTD_OFF)};
        pg8::gemm_phase<pg8::EpiConvIn, pg8::StaticOrder, true, true>(F.lds + RING_OFF, g, S, E); SEAM(9); }
    if (IN(10)) { conv_phase(F); SEAM(10); }
    if (IN(11)) { pg8::Gemm g{(const bf16*)(F.ws + WS_A2), (const bf16*)(F.ws + WS_WOUT), M, D, D}; pg8::StaticOrder S; S.init(MP, D, F.G, bx);
        pg8::EpiResid<0> E{nullptr, nullptr, XB, ssq + (size_t)5 * M, 1.0f}; pg8::gemm_phase<pg8::EpiResid<0>, pg8::StaticOrder, true, true>(F.lds + RING_OFF, g, S, E); SEAM(11); }
    FFN_GU(12, 3, 5)
    FFN_DN(13, 3, 6)
    if (IN(14)) { final_phase(F); }
#if defined(PROBE_DRY)
#ifndef PROBE_VARIANT
#define PROBE_VARIANT 0
#endif
    xcd_barrier(gbar); STAMP(15); if (blockIdx.x == 0 && F.tid == 0) { const unsigned long long c_ = __builtin_amdgcn_s_memtime(); F.MISC[60] = (unsigned)c_; F.MISC[61] = (unsigned)(c_ >> 32); }
#if PROBE_DRY == 2
    { pg8::Gemm g{XB, (const bf16*)(F.ws + WS_WGU), M, 2 * FF, D}; SameOrder S; S.init(MP, 2 * FF, F.G, bx);
      pg8::EpiNull E{H + (size_t)M * FF - 1}; pg8::gemm_phase<pg8::EpiNull, SameOrder, true, true>(F.lds + RING_OFF, g, S, E); }
#else
#if PROBE_DRY == 3
    { pg8::Gemm g{XB, (const bf16*)(F.ws + WS_WGU) + (size_t)3 * 2 * FF * D, M, 2 * FF, D}; pg8::StaticOrder S; S.init(MP, 2 * FF, F.G, bx);
      pg8::EpiGateUp E{H, FF, ssq + (size_t)5 * M, (LAS float*)(F.lds + RSTD_OFF)}; pg8::gemm_phase<pg8::EpiGateUp, pg8::StaticOrder, true, true, PROBE_VARIANT>(F.lds + RING_OFF, g, S, E); }
#else
    { pg8::Gemm g{XB, (const bf16*)(F.ws + WS_WGU), M, 2 * FF, D}; pg8::StaticOrder S; S.init(MP, 2 * FF, F.G, bx);
      pg8::EpiNull E{H + (size_t)M * FF - 1}; pg8::gemm_phase<pg8::EpiNull, pg8::StaticOrder, true, true, PROBE_VARIANT>(F.lds + RING_OFF, g, S, E); }
#endif
#endif
    xcd_barrier(gbar); STAMP(16); if (blockIdx.x == 0 && F.tid == 0) { const unsigned long long c_ = __builtin_amdgcn_s_memtime(); F.MISC[62] = (unsigned)c_; F.MISC[63] = (unsigned)(c_ >> 32); }
#endif
#if defined(PROBE_A_LO)
    __syncthreads();
    if (blockIdx.x == 0 && F.tid == 0) {
#if !defined(PROBE_DRY)
        STAMP(15);
#endif
#define TS(k) ((unsigned long long)F.MISC[16 + 2 * (k)] | ((unsigned long long)F.MISC[17 + 2 * (k)] << 32))
        const unsigned long long ta = TS(PROBE_A_HI) - TS(PROBE_A_LO), tb = TS(PROBE_B_HI) - TS(PROBE_B_LO);
#if defined(PROBE_CLOCK)
        { const unsigned long long c0 = (unsigned long long)F.MISC[60] | ((unsigned long long)F.MISC[61] << 32), c1 = (unsigned long long)F.MISC[62] | ((unsigned long long)F.MISC[63] << 32);
          F.out[0] += (float)(c1 - c0) / (float)(TS(16) - TS(15)) * 1e-2f; }
#else
        F.out[0] += (float)tb * 1e-5f;
#endif
        const unsigned long long t0 = __builtin_amdgcn_s_memrealtime();
        const unsigned long long spin = ta * 4ull < 1000000ull ? ta * 4ull : 1000000ull;
        while (__builtin_amdgcn_s_memrealtime() - t0 < spin) __builtin_amdgcn_s_sleep(8);
    }
#endif
#undef IN
#undef SEAM
}

extern "C" void kernel_launch(void* const* d_in, const int* in_sizes, int n_in, void* d_out, int out_size, void* d_ws, size_t ws_size, hipStream_t stream) {
    static int grid = 0;
    if (grid == 0) {
        if (n_in != 21 || out_size != (int)O_END || ws_size < WS_END) { fprintf(stderr, "kernel_launch: unexpected shapes: n_in %d out %d ws %zu; nothing launched\n", n_in, out_size, ws_size); grid = -1; return; }
        int dev = 0, cus = 0, per_cu = 0;
        if (hipGetDevice(&dev) != hipSuccess || hipDeviceGetAttribute(&cus, hipDeviceAttributeMultiprocessorCount, dev) != hipSuccess) { grid = -1; return; }
        if (hipFuncSetAttribute((const void*)skel_fwd, hipFuncAttributeMaxDynamicSharedMemorySize, LDS_BYTES) != hipSuccess) { fprintf(stderr, "kernel_launch: hipFuncSetAttribute failed\n"); grid = -1; return; }
        if (hipOccupancyMaxActiveBlocksPerMultiprocessor(&per_cu, (const void*)skel_fwd, NWAVES * 64, LDS_BYTES) != hipSuccess || per_cu < 1) fprintf(stderr, "kernel_launch: occupancy query reports %d\n", per_cu);
        (void)hipGetLastError();
        if (cus < 256) { fprintf(stderr, "kernel_launch: built for a 256-CU device (8 groups x 32 workgroups), found %d CUs; nothing launched\n", cus); grid = -1; return; }
        grid = 256;
    }
    if (grid < 0) return;
    if (hipMemsetAsync((char*)d_ws + WS_CTL, 0, CTL_ZERO_BYTES, stream) != hipSuccess) return;
    Args a{};
    for (int i = 0; i < 21; ++i) a.in[i] = (const float*)d_in[i];
    a.out = (float*)d_out; a.ws = (unsigned char*)d_ws;
    a.ph_lo = 0; a.ph_hi = N_PHASES;
    hipLaunchKernelGGL(skel_fwd, dim3(grid), dim3(NWAVES * 64), LDS_BYTES, stream, a);
}
```

```cpp
#include <hip/hip_runtime.h>
#include <cstdio>
#include <cstdint>
namespace pg8 {
#define PG8_LAS __attribute__((address_space(3)))
typedef unsigned short bf16_t;
typedef short bf16x8 __attribute__((ext_vector_type(8)));
typedef float f32x4 __attribute__((ext_vector_type(4)));
typedef unsigned u32x4 __attribute__((ext_vector_type(4)));
constexpr int BM = 256, BK = 64, HALF = 128, HTB = HALF * BK * 2  , STAGE_BYTES = 8 * HTB, NXCD = 8, WGM = 8;

__host__ __device__ __forceinline__ int lds_byte(int r, int c) { const int st = (r >> 4) * 2 + (c >> 5), rr = r & 15, cc = c & 31, ob = rr * 64 + cc * 2; return st * 1024 + (ob ^ (((ob >> 9) & 1) << 5)); }
__host__ __device__ __forceinline__ void stage_rc(int b, int& R, int& C) { const int st = b / 1024, sb = b % 1024, swz = sb ^ (((sb >> 9) & 1) << 5); R = (st >> 1) * 16 + swz / 64; C = (st & 1) * 32 + (swz % 64) / 2; }
__host__ __device__ __forceinline__ int perm32(int rho) { const int n = rho >> 4, i = rho & 15; return 8 * (i >> 2) + 4 * n + (i & 3); }

struct Unit { int pm, pn; };
struct Gemm { const bf16_t* A; const bf16_t* Bt; int M, N, K; };

struct StaticOrder {
    int nM, nN, nwg, G, c;
    __host__ __device__ void init(int M, int N, int G_, int c_) { nM = M / BM; nN = N / BM; nwg = nM * nN; G = G_; c = c_; }
    __host__ __device__ bool next(int i, Unit& u) const {
        const long L = (long)i * G + c; if (L >= nwg) return false;
        int wgid = (int)L; { const int q = nwg / NXCD, r = nwg % NXCD, xcd = wgid % NXCD, off = wgid / NXCD; wgid = (xcd < r ? xcd * (q + 1) : r * (q + 1) + (xcd - r) * q) + off; }
        const int nig = WGM * nN, gid = wgid / nig, fm = gid * WGM, gsz = (nM - fm) < WGM ? (nM - fm) : WGM;
        u.pm = fm + ((wgid % nig) % gsz); u.pn = (wgid % nig) / gsz; return true;
    }
    __device__ __forceinline__ void a_ready(const Unit&) const {}
    __device__ __forceinline__ void done(const Unit&) const {}
};


__device__ __forceinline__ unsigned cvt_pk_bf16(float lo, float hi) { unsigned r; asm volatile("v_cvt_pk_bf16_f32 %0, %1, %2" : "=v"(r) : "v"(lo), "v"(hi)); return r; }

typedef unsigned u32x2 __attribute__((ext_vector_type(2)));
constexpr float RMS_EPS = 1e-6f;
constexpr float INV_D = 1.0f / 1024.0f;
__device__ __forceinline__ float sigmoid_f(float x) { return __builtin_amdgcn_rcpf(1.0f + __builtin_amdgcn_exp2f(-1.4426950408889634f * x)); }
typedef unsigned long long ssq_t;
constexpr float SSQ_SCALE = 16777216.0f, SSQ_INV = 1.0f / 16777216.0f;
__device__ __forceinline__ ssq_t ssq_fix(float s) { return (ssq_t)(s * SSQ_SCALE + 0.5f); }
__device__ __forceinline__ float rstd_of(ssq_t q) { return __builtin_amdgcn_rsqf((float)q * (SSQ_INV * INV_D) + RMS_EPS); }
__device__ __forceinline__ float mul_s(float a, float b) { float r; asm volatile("v_mul_f32 %0, %1, %2" : "=v"(r) : "v"(a), "v"(b)); return r; }
__device__ __forceinline__ float fma_s(float a, float b, float c) { float r; asm volatile("v_fma_f32 %0, %1, %2, %3" : "=v"(r) : "v"(a), "v"(b), "v"(c)); return r; }
__device__ __forceinline__ float exp2_s(float a) { float r; asm volatile("v_exp_f32 %0, %1" : "=v"(r) : "v"(a)); return r; }
__device__ __forceinline__ float rcp_s(float a) { float r; asm volatile("v_rcp_f32 %0, %1" : "=v"(r) : "v"(a)); return r; }
template <int N> __device__ __forceinline__ void swiglu_batch(const float (&g)[N], const float (&u)[N], float c1, float irs2, float (&h)[N]) {
    float x[N], t[N];
#pragma unroll
    for (int e = 0; e < N; ++e) x[e] = mul_s(g[e], c1);
#pragma unroll
    for (int e = 0; e < N; ++e) x[e] = exp2_s(x[e]);
#pragma unroll
    for (int e = 0; e < N; ++e) x[e] = fma_s(x[e], irs2, irs2);
#pragma unroll
    for (int e = 0; e < N; ++e) x[e] = rcp_s(x[e]);
#pragma unroll
    for (int e = 0; e < N; ++e) t[e] = mul_s(g[e], u[e]);
#pragma unroll
    for (int e = 0; e < N; ++e) h[e] = mul_s(t[e], x[e]);
}
#define PG8_EPI_CALL() \
    __device__ __forceinline__ void operator()(const f32x4 (&acc)[2][2][4][2], const Unit& u, int wr, int wc, int fr, int fq) const { \
        _Pragma("unroll") for (int ai = 0; ai < 2; ++ai) _Pragma("unroll") for (int m = 0; m < 4; ++m) { \
            const f32x4 a[2][2] = {{acc[ai][0][m][0], acc[ai][0][m][1]}, {acc[ai][1][m][0], acc[ai][1][m][1]}}; rg(a, u, ai, m, 3, wr, wc, fr, fq); } }

struct EpiGateUp {
    static constexpr bool PERM = true, AFTER_DRAIN = false;
    bf16_t* H; int ldh; const ssq_t* ssq; PG8_LAS float* rs_lds;
    __device__ __forceinline__ void prep(const Unit& u, int tid) const { if (tid < 272) { const int row = tid < 256 ? u.pm * BM + tid : 16384 + 16 * u.pm + (tid - 256); const ssq_t q = ssq[row];
            rs_lds[2 * tid] = -1.4426950408889634f * rstd_of(q); rs_lds[2 * tid + 1] = (float)q * (SSQ_INV * INV_D) + RMS_EPS; } }
    __device__ __forceinline__ void rg(const f32x4 (&a)[2][2], const Unit& u, int ai, int m, int bjmask, int wr, int wc, int fr, int fq) const {
        const int row = u.pm * BM + ai * HALF + wr * 64 + m * 16 + fr, col0 = u.pn * HALF + wc * 32 + 8 * fq;
        const float c1 = rs_lds[2 * (ai * HALF + wr * 64 + m * 16 + fr)], irs2 = rs_lds[2 * (ai * HALF + wr * 64 + m * 16 + fr) + 1];
        float h[8];
        { const float g8[8] = {a[0][0][0], a[0][0][1], a[0][0][2], a[0][0][3], a[0][1][0], a[0][1][1], a[0][1][2], a[0][1][3]}, u8[8] = {a[1][0][0], a[1][0][1], a[1][0][2], a[1][0][3], a[1][1][0], a[1][1][1], a[1][1][2], a[1][1][3]};
          swiglu_batch<8>(g8, u8, c1, irs2, h); }
        u32x4 w; w.x = cvt_pk_bf16(h[0], h[1]); w.y = cvt_pk_bf16(h[2], h[3]); w.z = cvt_pk_bf16(h[4], h[5]); w.w = cvt_pk_bf16(h[6], h[7]);
        *(u32x4*)(H + (size_t)row * ldh + col0) = w;
    }
    __device__ __forceinline__ void rgx(const f32x4 (&ax)[2], const Unit& u, int wr, int wc, int fr, int fq) const {
        const int row = 16384 + 16 * u.pm + fr, col0 = u.pn * HALF + wc * 32 + 8 * fq + 4 * wr;
        const float c1 = rs_lds[2 * (256 + fr)], irs2 = rs_lds[2 * (256 + fr) + 1];
        float h[4];
        { const float g4[4] = {ax[0][0], ax[0][1], ax[0][2], ax[0][3]}, u4[4] = {ax[1][0], ax[1][1], ax[1][2], ax[1][3]}; swiglu_batch<4>(g4, u4, c1, irs2, h); }
        u32x2 w; w.x = cvt_pk_bf16(h[0], h[1]); w.y = cvt_pk_bf16(h[2], h[3]);
        *(u32x2*)(H + (size_t)row * ldh + col0) = w;
    }
    PG8_EPI_CALL()
};

__device__ __forceinline__ void unpack8(const u32x4 w, float (&x)[8]) {
#pragma unroll
    for (int e = 0; e < 4; ++e) { x[2 * e] = __builtin_bit_cast(float, w[e] << 16); x[2 * e + 1] = __builtin_bit_cast(float, w[e] & 0xffff0000u); } }
template <int MODE> struct EpiResid {
    static constexpr bool PERM = true, AFTER_DRAIN = false;
    const float* xin_p; const float* xin_s; bf16_t* XB; ssq_t* ssq; float scale;
    __device__ __forceinline__ void prep(const Unit&, int) const {}
    __device__ __forceinline__ void rg(const f32x4 (&a)[2][2], const Unit& u, int ai, int m, int bjmask, int wr, int wc, int fr, int fq) const {
        const int row = u.pm * BM + ai * HALF + wr * 64 + m * 16 + fr;
        const int col0 = (MODE == 0 ? u.pn * BM : u.pn * HALF) + wc * 32 + 8 * fq;
        float sq = 0.f;
#pragma unroll
        for (int bj = 0; bj < (MODE == 0 ? 2 : 1); ++bj) {
            bf16_t* xp = XB + (size_t)row * 1024 + col0 + bj * HALF;
            float x[8];
            if (xin_p) { const float* xi = xin_p + (size_t)row * 1024 + col0 + bj * HALF; const f32x4 x0 = *(const f32x4*)xi, x1 = *(const f32x4*)(xi + 4);
#pragma unroll
                for (int e = 0; e < 4; ++e) { x[e] = x0[e]; x[4 + e] = x1[e]; } }
            else unpack8(*(const u32x4*)xp, x);
#pragma unroll
            for (int e = 0; e < 4; ++e) {
                if (MODE == 0) { x[e] += a[bj][0][e] * scale; x[4 + e] += a[bj][1][e] * scale; }
                else { x[e] += a[0][0][e] * sigmoid_f(a[1][0][e]); x[4 + e] += a[0][1][e] * sigmoid_f(a[1][1][e]); } }
            u32x4 w; w.x = cvt_pk_bf16(x[0], x[1]); w.y = cvt_pk_bf16(x[2], x[3]); w.z = cvt_pk_bf16(x[4], x[5]); w.w = cvt_pk_bf16(x[6], x[7]);
            *(u32x4*)xp = w;
            sq += (x[0] * x[0] + x[1] * x[1]) + (x[2] * x[2] + x[3] * x[3]) + (x[4] * x[4] + x[5] * x[5]) + (x[6] * x[6] + x[7] * x[7]); }
        sq += __shfl_xor(sq, 16); sq += __shfl_xor(sq, 32);
        if (fq == 0) atomicAdd(ssq + row, ssq_fix(sq));
    }
    __device__ __forceinline__ void rgx(const f32x4 (&ax)[2], const Unit& u, int wr, int wc, int fr, int fq) const {
        const int r2 = 16 * u.pm + fr, row = 16384 + r2;
        const int col0 = (MODE == 0 ? u.pn * BM : u.pn * HALF) + wc * 32 + 8 * fq + 4 * wr;
        float sq = 0.f;
#pragma unroll
        for (int bj = 0; bj < (MODE == 0 ? 2 : 1); ++bj) {
            bf16_t* xp = XB + (size_t)row * 1024 + col0 + bj * HALF;
            f32x4 x0;
            if (xin_s) x0 = *(const f32x4*)(xin_s + (size_t)r2 * 1024 + col0 + bj * HALF);
            else { const u32x2 w = *(const u32x2*)xp; x0[0] = __builtin_bit_cast(float, w.x << 16); x0[1] = __builtin_bit_cast(float, w.x & 0xffff0000u); x0[2] = __builtin_bit_cast(float, w.y << 16); x0[3] = __builtin_bit_cast(float, w.y & 0xffff0000u); }
            if (MODE == 0) x0 += ax[bj] * scale;
            else {
#pragma unroll
                for (int e = 0; e < 4; ++e) x0[e] += ax[0][e] * sigmoid_f(ax[1][e]); }
            u32x2 w; w.x = cvt_pk_bf16(x0[0], x0[1]); w.y = cvt_pk_bf16(x0[2], x0[3]);
            *(u32x2*)xp = w;
            sq += (x0[0] * x0[0] + x0[1] * x0[1]) + (x0[2] * x0[2] + x0[3] * x0[3]); }
        sq += __shfl_xor(sq, 16); sq += __shfl_xor(sq, 32);
        if (fq == 0) atomicAdd(ssq + row, ssq_fix(sq));
    }
    PG8_EPI_CALL()
};

struct EpiConvIn {
    static constexpr bool PERM = true, AFTER_DRAIN = false;
    bf16_t* Z; bf16_t* GB; const ssq_t* ssq; float* conv_p; float* conv_s; PG8_LAS float* rs_lds;
    __device__ __forceinline__ void prep(const Unit& u, int tid) const { if (tid < 272) { const int row = tid < 256 ? u.pm * BM + tid : 16384 + 16 * u.pm + (tid - 256); const float rs = rstd_of(ssq[row]); rs_lds[2 * tid] = rs; rs_lds[2 * tid + 1] = rs * rs; } }
    __device__ __forceinline__ void rg(const f32x4 (&a)[2][2], const Unit& u, int ai, int m, int bjmask, int wr, int wc, int fr, int fq) const {
        const int row = u.pm * BM + ai * HALF + wr * 64 + m * 16 + fr;
        const float rs = rs_lds[2 * (ai * HALF + wr * 64 + m * 16 + fr)], rs2 = rs_lds[2 * (ai * HALF + wr * 64 + m * 16 + fr) + 1];
        if (u.pn < 8) {
            const int col0 = u.pn * HALF + wc * 32 + 8 * fq;
            const f32x4 z0 = a[0][0] * a[1][0] * rs2, z1 = a[0][1] * a[1][1] * rs2;
            u32x4 w; w.x = cvt_pk_bf16(z0[0], z0[1]); w.y = cvt_pk_bf16(z0[2], z0[3]); w.z = cvt_pk_bf16(z1[0], z1[1]); w.w = cvt_pk_bf16(z1[2], z1[3]);
            *(u32x4*)(Z + (size_t)row * 1024 + col0) = w;
            float* cp = nullptr;
            if (row < 16384) { const int t = row & 2047; if (t >= 2046) cp = conv_p + ((size_t)(row >> 11) * 2 + (t - 2046)) * 1024 + col0; }
            else { const int r2 = row - 16384, t = r2 & 7; if (t >= 6) cp = conv_s + ((size_t)(r2 >> 3) * 2 + (t - 6)) * 1024 + col0; }
            if (cp) { *(f32x4*)cp = z0; *(f32x4*)(cp + 4) = z1; }
        } else {
            const int col0 = (u.pn - 8) * BM + wc * 32 + 8 * fq;
#pragma unroll
            for (int bj = 0; bj < 2; ++bj) { const f32x4 g0 = a[bj][0] * rs, g1 = a[bj][1] * rs;
                u32x4 w; w.x = cvt_pk_bf16(g0[0], g0[1]); w.y = cvt_pk_bf16(g0[2], g0[3]); w.z = cvt_pk_bf16(g1[0], g1[1]); w.w = cvt_pk_bf16(g1[2], g1[3]);
                *(u32x4*)(GB + (size_t)row * 1024 + col0 + bj * HALF) = w; }
        }
    }
    __device__ __forceinline__ void rgx(const f32x4 (&ax)[2], const Unit& u, int wr, int wc, int fr, int fq) const {
        const int r2 = 16 * u.pm + fr, row = 16384 + r2;
        const float rs = rs_lds[2 * (256 + fr)];
        if (u.pn < 8) {
            const int col0 = u.pn * HALF + wc * 32 + 8 * fq + 4 * wr;
            const f32x4 z0 = ax[0] * ax[1] * (rs * rs);
            u32x2 w; w.x = cvt_pk_bf16(z0[0], z0[1]); w.y = cvt_pk_bf16(z0[2], z0[3]);
            *(u32x2*)(Z + (size_t)row * 1024 + col0) = w;
            const int t = r2 & 7;
            if (t >= 6) *(f32x4*)(conv_s + ((size_t)(r2 >> 3) * 2 + (t - 6)) * 1024 + col0) = z0;
        } else {
            const int col0 = (u.pn - 8) * BM + wc * 32 + 8 * fq + 4 * wr;
#pragma unroll
            for (int bj = 0; bj < 2; ++bj) { const f32x4 g0 = ax[bj] * rs;
                u32x2 w; w.x = cvt_pk_bf16(g0[0], g0[1]); w.y = cvt_pk_bf16(g0[2], g0[3]);
                *(u32x2*)(GB + (size_t)row * 1024 + col0 + bj * HALF) = w; }
        }
    }
    PG8_EPI_CALL()
};

struct EpiNull {
    static constexpr bool PERM = true, AFTER_DRAIN = false;
    bf16_t* sink;
    __device__ __forceinline__ void prep(const Unit&, int) const {}
    __device__ __forceinline__ void rg(const f32x4 (&a)[2][2], const Unit& u, int ai, int m, int bjmask, int wr, int wc, int fr, int fq) const {
        asm volatile("" :: "v"(a[0][0]), "v"(a[0][1]), "v"(a[1][0]), "v"(a[1][1]));
    }
    __device__ __forceinline__ void rgx(const f32x4 (&ax)[2], const Unit& u, int wr, int wc, int fr, int fq) const { asm volatile("" :: "v"(ax[0]), "v"(ax[1])); }
    PG8_EPI_CALL()
};

template <class Epi, class Sched, bool ALIGN_EPI = false, bool SP2 = false, int PROBE = 0>
__device__ __forceinline__ void gemm_phase(PG8_LAS unsigned char* lds, const Gemm g, const Sched& S, const Epi& E) {
    int tid_ = threadIdx.x; asm volatile("" : "+v"(tid_));
    const int tid = tid_, wid = __builtin_amdgcn_readfirstlane(tid >> 6), lane = tid & 63, wr = wid >> 2, wc = wid & 3, fr = lane & 15, fq = lane >> 4;
    const int K = g.K, nt = K / BK;
    constexpr int XROW0 = 16384, XR = 16;
    unsigned voffA[2], voffB[2];
#pragma unroll
    for (int i = 0; i < 2; ++i) { int R, C; stage_rc(tid * 16 + i * 8192, R, C); const int Rb = Epi::PERM ? ((R & ~31) + perm32(R & 31)) : R;
        voffA[i] = (unsigned)(R * K + C) * 2u; voffB[i] = (unsigned)(Rb * K + C) * 2u; }
    unsigned voffX; { const int p = (wid & 3) * 1024 + lane * 16, bq = p >> 11, q = p & 2047, row = q >> 7, kb = (q & 127) ^ (((row >> 1) & 7) << 4); voffX = (unsigned)(row * K * 2 + bq * 128 + kb); }
    int xoff0 = fr * 128 + ((fq * 16) ^ (((fr >> 1) & 7) << 4)), xoff1 = fr * 128 + ((64 + fq * 16) ^ (((fr >> 1) & 7) << 4));
    unsigned xpw = 4096;
    const unsigned kstep = (unsigned)(BK * 2);
    const unsigned hstep = (unsigned)HALF * K * 2;
    const unsigned tstep = 2 * hstep;
    const __amdgpu_buffer_rsrc_t rsA = __builtin_amdgcn_make_buffer_rsrc((void*)g.A, 0, 0x7ffff000, 0x00020000), rsB = __builtin_amdgcn_make_buffer_rsrc((void*)g.Bt, 0, 0x7ffff000, 0x00020000);
    const unsigned ldsw = (unsigned)wid * 1024u;
    const int aoff = lds_byte(wr * 64 + fr, fq * 8), boff = lds_byte(wc * 32 + fr, fq * 8);
#define PG8_SA(b, h) (((b) * 2 + (h)) * HTB)
#define PG8_SB(b, h) ((4 + (b) * 2 + (h)) * HTB)
#define PG8_SX(b) (STAGE_BYTES + (b) * 2048)
#define PG8_STAGEXP(soff) do { if constexpr ((PROBE & (6 | 16)) == 0) { if (wr == 0) __builtin_amdgcn_raw_ptr_buffer_load_lds(rsA, (PG8_LAS unsigned*)(lds + STAGE_BYTES + xpw + wid * 1024), 16, voffX, (soff), 0, 0); } } while (0)
#define PG8_LDAX(dst, b) do { if constexpr ((PROBE & (10 | 32)) == 0) { dst[0] = *(const PG8_LAS bf16x8*)(lds + PG8_SX(b) + xoff0); dst[1] = *(const PG8_LAS bf16x8*)(lds + PG8_SX(b) + xoff1); } } while (0)
#define PG8_WAIT_LT(nl, nt) do { if (wr == 0) PG8_WAIT_V(nl); else PG8_WAIT_V(nt); } while (0)
#define PG8_MMAX_NULL() do { asm volatile("" :: "v"(Ax[0]), "v"(Ax[1])); } while (0)
#define PG8_MMAX_REAL() do { if (wr == 0) { _Pragma("unroll") for (int k = 0; k < 2; ++k) { accx[0] = __builtin_amdgcn_mfma_f32_16x16x32_bf16(B0[0][k], Ax[k], accx[0], 0, 0, 0); accx[1] = __builtin_amdgcn_mfma_f32_16x16x32_bf16(B1[0][k], Ax[k], accx[1], 0, 0, 0); } } \
        else { _Pragma("unroll") for (int k = 0; k < 2; ++k) { accx[0] = __builtin_amdgcn_mfma_f32_16x16x32_bf16(B0[1][k], Ax[k], accx[0], 0, 0, 0); accx[1] = __builtin_amdgcn_mfma_f32_16x16x32_bf16(B1[1][k], Ax[k], accx[1], 0, 0, 0); } } } while (0)
#define PG8_MMAX() do { if constexpr ((PROBE & (2 | 32)) != 0) { } else if constexpr ((PROBE & 1) != 0) PG8_MMAX_NULL(); else PG8_MMAX_REAL(); } while (0)
#define PG8_STAGEA(bufoff, soff) do { if constexpr ((PROBE & 4) == 0) _Pragma("unroll") for (int _i = 0; _i < 2; ++_i) \
        __builtin_amdgcn_raw_ptr_buffer_load_lds(rsA, (PG8_LAS unsigned*)(lds + (bufoff) + ldsw + _i * 8192), 16, voffA[_i], (soff), 0, 0); } while (0)
#define PG8_STAGEB(bufoff, soff) do { if constexpr ((PROBE & 4) == 0) _Pragma("unroll") for (int _i = 0; _i < 2; ++_i) \
        __builtin_amdgcn_raw_ptr_buffer_load_lds(rsB, (PG8_LAS unsigned*)(lds + (bufoff) + ldsw + _i * 8192), 16, voffB[_i], (soff), 0, 0); } while (0)
#define PG8_LDA(dst, b, h) do { if constexpr ((PROBE & 8) == 0) { _Pragma("unroll") for (int m = 0; m < 4; ++m) _Pragma("unroll") for (int k = 0; k < 2; ++k) dst[m][k] = *(const PG8_LAS bf16x8*)(lds + PG8_SA(b, h) + aoff + m * 2048 + k * 1024); } } while (0)
#define PG8_LDB(dst, b, h) do { if constexpr ((PROBE & 8) == 0) { _Pragma("unroll") for (int n = 0; n < 2; ++n) _Pragma("unroll") for (int k = 0; k < 2; ++k) dst[n][k] = *(const PG8_LAS bf16x8*)(lds + PG8_SB(b, h) + boff + n * 2048 + k * 1024); } } while (0)
#define PG8_MMA_NULL(ai, bj, At, Bt) do { _Pragma("unroll") for (int m = 0; m < 4; ++m) _Pragma("unroll") for (int k = 0; k < 2; ++k) asm volatile("" :: "v"(At[m][k])); _Pragma("unroll") for (int n = 0; n < 2; ++n) _Pragma("unroll") for (int k = 0; k < 2; ++k) asm volatile("" :: "v"(Bt[n][k])); } while (0)
#define PG8_MMA_REAL(ai, bj, At, Bt) do { __builtin_amdgcn_s_setprio(1); _Pragma("unroll") for (int m = 0; m < 4; ++m) _Pragma("unroll") for (int n = 0; n < 2; ++n) _Pragma("unroll") for (int k = 0; k < 2; ++k) \
        acc[ai][bj][m][n] = __builtin_amdgcn_mfma_f32_16x16x32_bf16(Bt[n][k], At[m][k], acc[ai][bj][m][n], 0, 0, 0); __builtin_amdgcn_s_setprio(0); } while (0)
#define PG8_MMA(ai, bj, At, Bt) do { if constexpr ((PROBE & 1) != 0) PG8_MMA_NULL(ai, bj, At, Bt); else PG8_MMA_REAL(ai, bj, At, Bt); } while (0)
#define PG8_WAIT_V(n) asm volatile("s_waitcnt vmcnt(" #n ")" ::: "memory")
#define PG8_WAIT_L(n) asm volatile("s_waitcnt lgkmcnt(" #n ")" ::: "memory")
#define PG8_BAR __builtin_amdgcn_s_barrier()
#define PG8_SCHED __builtin_amdgcn_sched_barrier(0)
    Unit cur, nxt; int ui = 0;
    if (!S.next(0, cur)) return;
    f32x4 acc[2][2][4][2];
#pragma unroll
    for (int a = 0; a < 2; ++a)
#pragma unroll
        for (int b = 0; b < 2; ++b)
#pragma unroll
            for (int m = 0; m < 4; ++m)
#pragma unroll
                for (int n = 0; n < 2; ++n) acc[a][b][m][n] = (f32x4){0.f, 0.f, 0.f, 0.f};
    bf16x8 At[4][2], B0[2][2], B1[2][2], Ax[2];
    if constexpr ((PROBE & 8) != 0) {
#pragma unroll
        for (int m = 0; m < 4; ++m)
#pragma unroll
            for (int k = 0; k < 2; ++k) asm volatile("" : "=v"(At[m][k]));
#pragma unroll
        for (int n = 0; n < 2; ++n)
#pragma unroll
            for (int k = 0; k < 2; ++k) { asm volatile("" : "=v"(B0[n][k])); asm volatile("" : "=v"(B1[n][k])); }
        asm volatile("" : "=v"(Ax[0])); asm volatile("" : "=v"(Ax[1])); }
    f32x4 accx[2] = {(f32x4){0.f, 0.f, 0.f, 0.f}, (f32x4){0.f, 0.f, 0.f, 0.f}};
    unsigned cA = (unsigned)cur.pm * tstep, cB = (unsigned)cur.pn * tstep;
    const unsigned xstep = (unsigned)XR * K * 2, xbase = (unsigned)XROW0 * K * 2; unsigned cX = xbase + (unsigned)cur.pm * xstep;
    S.a_ready(cur);
    E.prep(cur, tid);
    if constexpr (SP2) {
        PG8_STAGEB(PG8_SB(0, 0), cB); PG8_STAGEB(PG8_SB(0, 1), cB + hstep); PG8_STAGEA(PG8_SA(0, 0), cA); { const unsigned keep_ = xpw; xpw = 0; PG8_STAGEXP(cX); xpw = keep_; } PG8_STAGEA(PG8_SA(0, 1), cA + hstep);
        if (wr == 1) PG8_BAR;
        PG8_WAIT_V(2); PG8_BAR;
        PG8_STAGEB(PG8_SB(1, 0), cB + kstep); PG8_STAGEA(PG8_SA(1, 0), cA + kstep); PG8_STAGEB(PG8_SB(1, 1), cB + hstep + kstep);
        PG8_WAIT_V(6); PG8_BAR;
    } else {
        PG8_STAGEB(PG8_SB(0, 0), cB); PG8_STAGEA(PG8_SA(0, 0), cA); PG8_STAGEB(PG8_SB(0, 1), cB + hstep); PG8_STAGEA(PG8_SA(0, 1), cA + hstep);
        if (wr == 1) PG8_BAR;
        PG8_WAIT_V(4); PG8_BAR;
        PG8_STAGEB(PG8_SB(1, 0), cB + kstep); PG8_STAGEA(PG8_SA(1, 0), cA + kstep); PG8_STAGEB(PG8_SB(1, 1), cB + hstep + kstep);
        PG8_WAIT_V(6); PG8_BAR;
    }
    for (;;) {
        const bool has_next = S.next(ui + 1, nxt);
        const unsigned nA = has_next ? (unsigned)nxt.pm * tstep : cA, nB = has_next ? (unsigned)nxt.pn * tstep : cB, nX = has_next ? xbase + (unsigned)nxt.pm * xstep : cX;
        for (int t = 0; t < nt; t += 2) {
            const bool last = (t == nt - 2);
            const unsigned a1 = cA + (unsigned)(t + 1) * kstep;
            const unsigned a2 = last ? nA : cA + (unsigned)(t + 2) * kstep, b2 = last ? nB : cB + (unsigned)(t + 2) * kstep;
            const unsigned a3 = a2 + kstep, b3 = b2 + kstep, x2 = last ? nX : cX + (unsigned)(t + 2) * kstep;
            if (last && has_next) S.a_ready(nxt);
            if constexpr (SP2) {
            PG8_LDB(B0, 0, 0); PG8_LDB(B1, 0, 1); PG8_SCHED; PG8_LDA(At, 0, 0); PG8_LDAX(Ax, 0); PG8_STAGEXP(x2); PG8_STAGEA(PG8_SA(1, 1), a1 + hstep);
            PG8_WAIT_LT(9, 8); PG8_WAIT_L(0); PG8_BAR; PG8_MMA(0, 0, At, B0); PG8_MMA(0, 1, At, B1); PG8_MMAX(); PG8_BAR; PG8_SCHED;
            PG8_LDA(At, 0, 1); PG8_STAGEB(PG8_SB(0, 0), b2); PG8_STAGEB(PG8_SB(0, 1), b2 + hstep); PG8_STAGEA(PG8_SA(0, 0), a2);
            PG8_WAIT_LT(9, 8); PG8_WAIT_L(0); PG8_BAR; PG8_MMA(1, 0, At, B0); PG8_MMA(1, 1, At, B1); PG8_BAR; PG8_SCHED;
            PG8_LDB(B0, 1, 0); PG8_LDB(B1, 1, 1); PG8_SCHED; PG8_LDA(At, 1, 0); PG8_LDAX(Ax, 1); PG8_STAGEA(PG8_SA(0, 1), a2 + hstep);
            PG8_WAIT_V(8); PG8_WAIT_L(0); PG8_BAR; PG8_MMA(0, 0, At, B0); PG8_MMA(0, 1, At, B1); PG8_MMAX(); PG8_BAR; PG8_SCHED;
            PG8_LDA(At, 1, 1); PG8_STAGEB(PG8_SB(1, 0), b3); PG8_STAGEB(PG8_SB(1, 1), b3 + hstep); PG8_STAGEA(PG8_SA(1, 0), a3);
            PG8_WAIT_V(8); PG8_WAIT_L(0); PG8_BAR; PG8_MMA(1, 0, At, B0); PG8_MMA(1, 1, At, B1); PG8_BAR; PG8_SCHED;
            xpw ^= 4096u; xoff0 ^= 4096; xoff1 ^= 4096;
            } else {
            PG8_LDB(B0, 0, 0); PG8_SCHED; PG8_LDA(At, 0, 0); PG8_STAGEA(PG8_SA(1, 1), a1 + hstep);
            PG8_WAIT_L(8); PG8_BAR; PG8_WAIT_L(0); PG8_MMA(0, 0, At, B0); PG8_BAR; PG8_SCHED;
            PG8_LDB(B1, 0, 1); PG8_STAGEB(PG8_SB(0, 0), b2);
            PG8_BAR; PG8_WAIT_L(0); PG8_MMA(0, 1, At, B1); PG8_BAR;
            PG8_LDA(At, 0, 1); PG8_STAGEA(PG8_SA(0, 0), a2);
            PG8_BAR; PG8_WAIT_L(0); PG8_MMA(1, 0, At, B0); PG8_BAR; PG8_SCHED;
            PG8_STAGEB(PG8_SB(0, 1), b2 + hstep);
            PG8_WAIT_V(6); PG8_BAR; PG8_MMA(1, 1, At, B1); PG8_BAR;
            PG8_LDB(B0, 1, 0); PG8_SCHED; PG8_LDA(At, 1, 0); PG8_STAGEA(PG8_SA(0, 1), a2 + hstep);
            PG8_WAIT_L(8); PG8_BAR; PG8_WAIT_L(0); PG8_MMA(0, 0, At, B0); PG8_BAR; PG8_SCHED;
            PG8_LDB(B1, 1, 1); PG8_STAGEB(PG8_SB(1, 0), b3);
            PG8_BAR; PG8_WAIT_L(0); PG8_MMA(0, 1, At, B1); PG8_BAR;
            PG8_LDA(At, 1, 1); PG8_STAGEA(PG8_SA(1, 0), a3);
            PG8_BAR; PG8_WAIT_L(0); PG8_MMA(1, 0, At, B0); PG8_BAR; PG8_SCHED;
            PG8_STAGEB(PG8_SB(1, 1), b3 + hstep);
            PG8_WAIT_V(6); PG8_BAR; PG8_MMA(1, 1, At, B1); PG8_BAR;
            }
        }
        if constexpr (ALIGN_EPI) { if (wr == 0) PG8_BAR; }
        asm volatile("s_nop 15\n\ts_nop 15" ::: "memory");
        E(acc, cur, wr, wc, fr, fq); E.rgx(accx, cur, wr, wc, fr, fq);
        if (!has_next) break;
#pragma unroll
        for (int a = 0; a < 2; ++a)
#pragma unroll
            for (int b = 0; b < 2; ++b)
#pragma unroll
                for (int m = 0; m < 4; ++m)
#pragma unroll
                    for (int n = 0; n < 2; ++n) acc[a][b][m][n] = (f32x4){0.f, 0.f, 0.f, 0.f};
        accx[0] = (f32x4){0.f, 0.f, 0.f, 0.f}; accx[1] = (f32x4){0.f, 0.f, 0.f, 0.f};
        cur = nxt; cA = nA; cB = nB; cX = nX; ++ui;
        if constexpr (ALIGN_EPI) { if (wr == 1) PG8_BAR; }
    }
    PG8_WAIT_V(0);
    if constexpr (!ALIGN_EPI) { if (wr == 0) PG8_BAR; }
    PG8_BAR;
#undef PG8_SA
#undef PG8_SB
#undef PG8_STAGEA
#undef PG8_STAGEB
#undef PG8_SX
#undef PG8_STAGEXP
#undef PG8_WAIT_LT
#undef PG8_LDAX
#undef PG8_MMAX
#undef PG8_LDA
#undef PG8_LDB
#undef PG8_MMA
#undef PG8_WAIT_V
#undef PG8_WAIT_L
#undef PG8_BAR
#undef PG8_SCHED
}
}

#define GAS __attribute__((address_space(1)))
#define LAS __attribute__((address_space(3)))
typedef unsigned short bf16;
typedef unsigned v4u __attribute__((ext_vector_type(4)));
typedef float f32x4 __attribute__((ext_vector_type(4)));
typedef short bf16x8 __attribute__((ext_vector_type(8)));
typedef GAS unsigned gu32;
typedef GAS unsigned long long gu64;
#define RLX_AGENT __ATOMIC_RELAXED, __HIP_MEMORY_SCOPE_AGENT
#define LDS_WAIT() asm volatile("s_waitcnt lgkmcnt(0)" ::: "memory")
#define VM_WAIT() asm volatile("s_waitcnt vmcnt(0)" ::: "memory")
__device__ __forceinline__ unsigned long long rt() { return __builtin_amdgcn_s_memrealtime(); }
__device__ __forceinline__ unsigned f2bf(float f) { unsigned u = __builtin_bit_cast(unsigned, f); return (u + 0x7fffu + ((u >> 16) & 1u)) >> 16; }
__device__ __forceinline__ unsigned pk2(float lo, float hi) { return f2bf(lo) | (f2bf(hi) << 16); }

#define XB_TMO      128
#define XB_XCNT(j)  (256  + 64 * (j))
#define XB_XSUB(j)  (1280 + 64 * (j))
#define XB_XGEN(j)  (2304 + 64 * (j))
#define XB_TOP      3328
#define XB_TOPGEN   3392
#define XCD_BAR_WORDS 3456
#define XB_SPIN_CAP (1u << 18)

__device__ __forceinline__ unsigned xb_ld(unsigned* p)              { return __hip_atomic_load(p, __ATOMIC_RELAXED, __HIP_MEMORY_SCOPE_AGENT); }
__device__ __forceinline__ unsigned xb_add(unsigned* p, unsigned v) { return __hip_atomic_fetch_add(p, v, __ATOMIC_RELAXED, __HIP_MEMORY_SCOPE_AGENT); }
__device__ __forceinline__ unsigned xb_xcc_id() { return (unsigned)__builtin_amdgcn_s_getreg((3 << 11) | 20) & 0xFu; }
#define XB_SPIN(cond, bar) do { unsigned _sp = 0; while (cond) { __builtin_amdgcn_s_sleep(1); \
    if ((++_sp & 255u) == 0u) { if (xb_ld(&(bar)[XB_TMO])) break; if (_sp > XB_SPIN_CAP) { atomicAdd(&(bar)[XB_TMO], 1u); break; } } } } while (0)

struct XcdBarrier {
    unsigned* bar; unsigned x; unsigned n;
    volatile LAS unsigned* st;
};

__device__ __forceinline__ XcdBarrier xcd_barrier_post(unsigned* bar, volatile LAS unsigned* st, unsigned n) {
    XcdBarrier b; b.bar = bar; b.x = xb_xcc_id(); b.st = st; b.n = n;
    if (threadIdx.x == 0) (void)xb_add(&bar[XB_XCNT(b.x)], 1u);
    return b;
}
__device__ __forceinline__ void xcd_barrier_complete(unsigned* bar, unsigned x, unsigned G, unsigned& nloc, unsigned& nx) {
    unsigned sum, cnt, mine, sp = 0u;
    for (;;) {
        sum = 0u; cnt = 0u; mine = 0u;
#pragma unroll
        for (unsigned j = 0; j < 16; ++j) { const unsigned c = xb_ld(&bar[XB_XCNT(j)]); sum += c; cnt += (c > 0u) ? 1u : 0u; mine = (j == x) ? c : mine; }
        if (sum == G) break;
        __builtin_amdgcn_s_sleep(1);
        if ((++sp & 255u) == 0u) { if (xb_ld(&bar[XB_TMO])) break; if (sp > XB_SPIN_CAP) { atomicAdd(&bar[XB_TMO], 1u); break; } }
    }
    nloc = mine > 0u ? mine : 1u; nx = cnt > 0u ? cnt : 1u;
}

__device__ __forceinline__ void xcd_barrier(const XcdBarrier& b) {
    asm volatile("s_waitcnt vmcnt(0)" ::: "memory");
    __syncthreads();
    if (threadIdx.x == 0) {
        unsigned* bar = b.bar;
        __builtin_amdgcn_s_waitcnt(0);
        unsigned nloc = b.st[0], nx = b.st[1];
        if (nloc == 0u) { xcd_barrier_complete(bar, b.x, b.n, nloc, nx); b.st[0] = nloc; b.st[1] = nx; }
        const unsigned old = xb_add(&bar[XB_XSUB(b.x)], 1u);
        const unsigned gen = old / nloc;
        if (old + 1u == (gen + 1u) * nloc) {
            __builtin_amdgcn_fence(__ATOMIC_RELEASE, "agent");
            asm volatile("s_waitcnt vmcnt(0)" ::: "memory");
            const unsigned og = xb_add(&bar[XB_TOP], 1u);
            const unsigned tg = og / nx;
            if (og + 1u == (tg + 1u) * nx) xb_add(&bar[XB_TOPGEN], 1u);
            else XB_SPIN(xb_ld(&bar[XB_TOPGEN]) == tg, bar);
            __builtin_amdgcn_fence(__ATOMIC_ACQUIRE, "agent");
            xb_add(&bar[XB_XGEN(b.x)], 1u);
            asm volatile("s_waitcnt vmcnt(0)" ::: "memory");
        } else {
            XB_SPIN(xb_ld(&bar[XB_XGEN(b.x)]) == gen, bar);
            __builtin_amdgcn_fence(__ATOMIC_ACQUIRE, "agent");
            asm volatile("s_waitcnt vmcnt(0)" ::: "memory");
        }
    }
    __syncthreads();
}


constexpr int NWAVES = 8;
#ifndef MK_ONE_LAUNCH
#define MK_ONE_LAUNCH 1
#endif
constexpr int N_PHASES = 15;

constexpr int D = 1024, FF = 4096, MP = 8 * 2048, MS = 128 * 8, M = MP + MS;
constexpr int NG = 64, PS = 64, GS = 16;
constexpr float EPS = 1e-6f;
constexpr size_t O_Y = 0, O_SRP = (size_t)M * D, O_SIP = O_SRP + 8 * 4096, O_CP = O_SIP + 8 * 4096, O_SRS = O_CP + 8 * 2 * 1024, O_SIS = O_SRS + 128 * 4096, O_CS = O_SIS + 128 * 4096, O_END = O_CS + 128 * 2 * 1024;
static_assert(O_END == 19218432, "output size");

constexpr size_t MiB = 1u << 20;
constexpr size_t WS_CTL = 0, CTL_ZERO_BYTES = 1 * MiB;
constexpr size_t WS_SSQ = 112 * MiB;
constexpr size_t WS_SSME = 114 * MiB;
constexpr size_t WS_SSMP = 2 * MiB;
constexpr size_t WS_WGU = 4 * MiB;
constexpr size_t WS_WD = 68 * MiB;
constexpr size_t WS_WGLU = 100 * MiB;
constexpr size_t WS_WIN = 104 * MiB;
constexpr size_t WS_WOUT = 110 * MiB;
constexpr size_t WS_X = 112 * MiB;
constexpr size_t WS_XB = 180 * MiB;
constexpr size_t WS_H = 214 * MiB;
constexpr size_t WS_G = 350 * MiB, WS_A2 = WS_G, WS_Z = 384 * MiB, WS_GB = 418 * MiB;
constexpr size_t WS_END = 452 * MiB;
constexpr int CW_TMO = 0;
constexpr int CW_BAR = 4096;
constexpr int CW_SK = 16384;

constexpr int RING_OFF = 0, RING_BYTES = 131072 + 8192;
constexpr int RSTD_OFF = RING_BYTES;
constexpr int LDSCTL_OFF = RING_BYTES + 4096, MISC_OFF = LDSCTL_OFF + 320;
constexpr int LDS_BYTES = 147456;

struct Frame {
    LAS unsigned char* lds;
    volatile LAS unsigned* MISC;
    gu32* ctl;
    int tid, lane, wave, vcu, G, gi, ci;
    const float* in[21]; float* out; unsigned char* ws;
};

__device__ __forceinline__ int opaque_i(int v) { asm volatile("" : "+v"(v)); return v; }
__device__ __forceinline__ float wave_sum(float v) {
#pragma unroll
    for (int o = 1; o < 64; o <<= 1) v += __shfl_xor(v, o);
    return v;
}
__device__ __forceinline__ float bf2f(unsigned short b) { return __builtin_bit_cast(float, (unsigned)b << 16); }

struct P0Item { const float* W; bf16* WT; const float* gk; int K, N, k0, n0s, n0d; };
__device__ __forceinline__ int pair_src(int nd, int base, int hstride) { return base + ((nd >> 7) & 1) * hstride + 128 * (nd >> 8) + (nd & 127); }
__device__ __forceinline__ P0Item p0_item(Frame& F, int it) {
    constexpr int I_GU = (D / 64) * (2 * FF / 64), I_D = (FF / 64) * (D / 64), I_GLU = (D / 64) * (2 * D / 64), I_IN = (D / 64) * (3 * D / 64);
    const float* norm_g = F.in[5]; P0Item p; int r = it;
    if (r < 4 * I_GU) { const int f = r / I_GU; r -= f * I_GU; const int nb = r % (2 * FF / 64), kb = r / (2 * FF / 64), nd = 64 * nb;
        p.W = F.in[7] + (size_t)f * D * 2 * FF; p.K = D; p.N = 2 * FF; p.WT = (bf16*)(F.ws + WS_WGU) + (size_t)f * 2 * FF * D; p.gk = norm_g + ((f >> 1) * 3 + (f & 1) * 2) * D; p.k0 = 64 * kb; p.n0s = pair_src(nd, 0, FF); p.n0d = nd; return p; }
    r -= 4 * I_GU;
    if (r < 4 * I_D) { const int f = r / I_D; r -= f * I_D; const int nb = r % (D / 64), kb = r / (D / 64), nd = 64 * nb;
        p.W = F.in[8] + (size_t)f * FF * D; p.K = FF; p.N = D; p.WT = (bf16*)(F.ws + WS_WD) + (size_t)f * D * FF; p.gk = nullptr; p.k0 = 64 * kb; p.n0s = nd; p.n0d = nd; return p; }
    r -= 4 * I_D;
    if (r < I_GLU) { const int nb = r % (2 * D / 64), kb = r / (2 * D / 64), nd = 64 * nb;
        p.W = F.in[17]; p.K = D; p.N = 2 * D; p.WT = (bf16*)(F.ws + WS_WGLU); p.gk = nullptr; p.k0 = 64 * kb; p.n0s = pair_src(nd, 0, D); p.n0d = nd; return p; }
    r -= I_GLU;
    if (r < I_IN) { const int nb = r % (3 * D / 64), kb = r / (3 * D / 64), nd = 64 * nb;
        p.W = F.in[18]; p.K = D; p.N = 3 * D; p.WT = (bf16*)(F.ws + WS_WIN); p.gk = norm_g + 4 * D; p.k0 = 64 * kb; p.n0s = nd < 2048 ? pair_src(nd, D, D) : nd - 2048; p.n0d = nd; return p; }
    r -= I_IN;
    { const int nb = r % (D / 64), kb = r / (D / 64), nd = 64 * nb;
        p.W = F.in[20]; p.K = D; p.N = D; p.WT = (bf16*)(F.ws + WS_WOUT); p.gk = nullptr; p.k0 = 64 * kb; p.n0s = nd; p.n0d = nd; return p; }
}
#define P0_LOAD(v, gs, p) do { _Pragma("unroll") for (int i = 0; i < 8; ++i) _Pragma("unroll") for (int s = 0; s < 2; ++s) { \
        v[i][s] = *(const GAS f32x4*)((p).W + (size_t)((p).k0 + 8 * i + 2 * kr + s) * (p).N + (p).n0s + 4 * c); gs[i][s] = (p).gk ? (p).gk[(p).k0 + 8 * i + 2 * kr + s] : 1.0f; } } while (0)
#define P0_PROC(v, gs, p) do { \
        _Pragma("unroll") for (int i = 0; i < 8; ++i) _Pragma("unroll") for (int j = 0; j < 4; ++j) \
            *(LAS unsigned*)(scr + (4 * c + j) * 128 + (((4 * i + kr) ^ ((c & 7) << 2)) << 2)) = pg8::cvt_pk_bf16(v[i][0][j] * gs[i][0], v[i][1][j] * gs[i][1]); \
        LDS_WAIT(); asm volatile("" ::: "memory"); \
        _Pragma("unroll") for (int i = 0; i < 8; ++i) { const int n = nr + 8 * i; const v4u o = *(const LAS v4u*)(scr + n * 128 + ((q ^ ((n >> 2) & 7)) << 4)); \
            *(GAS v4u*)((p).WT + (size_t)((p).n0d + n) * (p).K + (p).k0 + 8 * q) = o; } \
        LDS_WAIT(); asm volatile("" ::: "memory"); } while (0)

__device__ __forceinline__ void p0_prologue(Frame& F) {
    LAS unsigned char* scr = F.lds + RING_OFF + F.wave * 16384;
    const int gw = F.vcu * NWAVES + F.wave, NGW = F.G * NWAVES, lane = opaque_i(F.lane);
    constexpr int NITEMS = 4 * (D / 64) * (2 * FF / 64) + 4 * (FF / 64) * (D / 64) + (D / 64) * (2 * D / 64) + (D / 64) * (3 * D / 64) + (D / 64) * (D / 64);
    { const int kr = lane >> 4, c = lane & 15, nr = lane >> 3, q = lane & 7;
      f32x4 va[8][2], vb[8][2]; float ga[8][2], gb[8][2];
      int it = gw; P0Item pa = p0_item(F, it < NITEMS ? it : 0), pb = pa;
      if (it < NITEMS) P0_LOAD(va, ga, pa);
      while (it < NITEMS) {
          const int it1 = it + NGW; if (it1 < NITEMS) { pb = p0_item(F, it1); P0_LOAD(vb, gb, pb); }
          P0_PROC(va, ga, pa);
          if (it1 >= NITEMS) break;
          const int it2 = it1 + NGW; if (it2 < NITEMS) { pa = p0_item(F, it2); P0_LOAD(va, ga, pa); }
          P0_PROC(vb, gb, pb);
          it = it2;
      }
    }
    bf16* XB = (bf16*)(F.ws + WS_XB); pg8::ssq_t* ssq = (pg8::ssq_t*)(F.ws + WS_SSQ);
    for (int m0 = gw; m0 < M; m0 += 4 * NGW) {
        f32x4 v[4][4];
#pragma unroll
        for (int r = 0; r < 4; ++r) { const int m = m0 + r * NGW; if (m < M) { const float* src = m < MP ? F.in[0] + (size_t)m * D : F.in[1] + (size_t)(m - MP) * D;
#pragma unroll
            for (int j = 0; j < 4; ++j) v[r][j] = ((const GAS f32x4*)src)[lane + 64 * j]; } }
#pragma unroll
        for (int r = 0; r < 4; ++r) { const int m = m0 + r * NGW; if (m < M) {
            GAS unsigned long long* o8 = (GAS unsigned long long*)(XB + (size_t)m * D) + lane; float s = 0.f;
#pragma unroll
            for (int j = 0; j < 4; ++j) { const f32x4 w = v[r][j]; s += (w.x * w.x + w.y * w.y) + (w.z * w.z + w.w * w.w);
                o8[64 * j] = (unsigned long long)pg8::cvt_pk_bf16(w.x, w.y) | ((unsigned long long)pg8::cvt_pk_bf16(w.z, w.w) << 32); }
            s = wave_sum(s);
            if (lane == 0) ssq[m] = pg8::ssq_fix(s); } }
    }
    for (int i = gw * 64 + lane; i < 7 * M; i += NGW * 64) ssq[M + i] = 0ull;
    float* sp = (float*)(F.ws + WS_SSMP);
    for (int i = gw * 64 + lane; i < NG * PS; i += NGW * 64) {
        const int g = i / PS;
        const float lr = F.in[9][i], li = F.in[10][i], dt = expf(F.in[11][g]);
        const float mag = expf(lr * dt); float sn, cs; sincosf(li * dt, &sn, &cs);
        const float lbr = mag * cs, lbi = mag * sn, den = lr * lr + li * li, nr = lbr - 1.0f, ni = lbi;
        const float fr = (nr * lr + ni * li) / den, fi = (ni * lr - nr * li) / den;
        sp[i] = lbr; sp[4096 + i] = lbi;
#pragma unroll
        for (int c = 0; c < GS; ++c) { const float br = F.in[12][(size_t)i * GS + c], bi = F.in[13][(size_t)i * GS + c];
            sp[8192 + (size_t)i * GS + c] = fr * br - fi * bi; sp[8192 + 65536 + (size_t)i * GS + c] = fr * bi + fi * br; }
    }
}

__device__ __forceinline__ float gelu_tanh(float x) {
    const float a = 0.7978845608028654f * (x + 0.044715f * x * x * x);
    return x * __builtin_amdgcn_rcpf(1.0f + __builtin_amdgcn_exp2f(-2.0f * 1.4426950408889634f * a));
}


typedef float f32x16 __attribute__((ext_vector_type(16)));
typedef unsigned u32x2v __attribute__((ext_vector_type(2)));
__device__ __forceinline__ unsigned cvtpk(float lo, float hi) { unsigned r; asm volatile("v_cvt_pk_bf16_f32 %0, %1, %2" : "=v"(r) : "v"(lo), "v"(hi)); return r; }
__device__ __forceinline__ bf16x8 pack8(const float* v) { v4u w; w.x = cvtpk(v[0], v[1]); w.y = cvtpk(v[2], v[3]); w.z = cvtpk(v[4], v[5]); w.w = cvtpk(v[6], v[7]); return __builtin_bit_cast(bf16x8, w); }
__device__ __forceinline__ float fma_s(float a, float b, float c) { float r; asm("v_fma_f32 %0, %1, %2, %3" : "=v"(r) : "v"(a), "v"(b), "v"(c)); return r; }
constexpr int SSM_ROWB = 272;
constexpr int SSM_NCH = 8, SSM_CHB = 8;
#define BFLO(w) __builtin_bit_cast(float, (w) << 16)
#define BFHI(w) __builtin_bit_cast(float, (w) & 0xffff0000u)

template <int MODE, int NI>
__device__ __forceinline__ void ssm_run(Frame& F, LAS unsigned char* img0, int lane, int g, const int (&row_base)[NI], int nblk, bool sample, int seq0, float (&hr)[NI], float (&hi)[NI]) {
    const bf16* X = (const bf16*)(F.ws + WS_XB); const pg8::ssq_t* ssq = (const pg8::ssq_t*)(F.ws + WS_SSQ) + 1 * M;
    const float* sp = (const float*)(F.ws + WS_SSMP); bf16* Gb = (bf16*)(F.ws + WS_G);
    const float* g1 = F.in[5] + 1 * D; const float* dsk = F.in[16];
    const int l31 = lane & 31, h = lane >> 5, l15 = lane & 15, q4 = lane >> 4;
    bf16x8 bbq[4];
#pragma unroll
    for (int q = 0; q < 4; ++q) { const int p = 32 * (q & 1) + l31; const float* src = sp + 8192 + (q >> 1) * 65536 + ((size_t)(g * PS + p) * GS + 8 * h);
        float v[8];
#pragma unroll
        for (int j = 0; j < 8; ++j) v[j] = src[j] * g1[g * GS + 8 * h + j];
        bbq[q] = pack8(v); }
    bf16x8 cm[4]; float dg[4];
    if (MODE == 1) {
#pragma unroll
        for (int ks = 0; ks < 4; ++ks) { const int p0 = 16 * ks + 4 * q4; const float* cr = F.in[14] + ((size_t)(g * GS + l15) * PS + p0); const float* ci = F.in[15] + ((size_t)(g * GS + l15) * PS + p0);
            float v[8];
#pragma unroll
            for (int j = 0; j < 4; ++j) { v[2 * j] = cr[j]; v[2 * j + 1] = -ci[j]; }
            cm[ks] = pack8(v); }
#pragma unroll
        for (int e = 0; e < 4; ++e) dg[e] = dsk[g * GS + 4 * q4 + e] * g1[g * GS + 4 * q4 + e];
    }
    const float lbr = sp[g * PS + lane], lbi = sp[4096 + g * PS + lane], nlbi = -lbi;
    float s0r[4], s0i[4];
    if (sample) {
#pragma unroll
        for (int i = 0; i < 4; ++i) { s0r[i] = F.in[2][((size_t)(seq0 + i) * NG + g) * PS + lane]; s0i[i] = F.in[3][((size_t)(seq0 + i) * NG + g) * PS + lane]; } }
    else {
#pragma unroll
        for (int i = 0; i < 4; ++i) { s0r[i] = 0.f; s0i[i] = 0.f; } }
    v4u xaw[NI]; u32x2v xew0[NI], xew1[NI]; pg8::ssq_t qa[NI], qe0[NI], qe1[NI];
#define SSM_LOAD(b) do { _Pragma("unroll") for (int j = 0; j < NI; ++j) { const int rowA = row_base[j] + 32 * (b) + l31; xaw[j] = *(const GAS v4u*)(X + (size_t)rowA * D + g * GS + 8 * h); qa[j] = ssq[rowA]; \
        if (MODE == 1) { const int rowE = row_base[j] + 32 * (b) + l15; xew0[j] = *(const GAS u32x2v*)(X + (size_t)rowE * D + g * GS + 4 * q4); xew1[j] = *(const GAS u32x2v*)(X + (size_t)(rowE + 16) * D + g * GS + 4 * q4); qe0[j] = ssq[rowE]; qe1[j] = ssq[rowE + 16]; } \
        else { qe0[j] = 0; qe1[j] = 0; } } } while (0)
    SSM_LOAD(0);
    for (int b = 0; b < nblk; ++b) {
        f32x4 ca0[NI], ca1[NI], ce0[NI], ce1[NI]; pg8::ssq_t cqa[NI], cqe0[NI], cqe1[NI];
#pragma unroll
        for (int j = 0; j < NI; ++j) { ca0[j] = (f32x4){BFLO(xaw[j].x), BFHI(xaw[j].x), BFLO(xaw[j].y), BFHI(xaw[j].y)}; ca1[j] = (f32x4){BFLO(xaw[j].z), BFHI(xaw[j].z), BFLO(xaw[j].w), BFHI(xaw[j].w)};
            if (MODE == 1) { ce0[j] = (f32x4){BFLO(xew0[j].x), BFHI(xew0[j].x), BFLO(xew0[j].y), BFHI(xew0[j].y)}; ce1[j] = (f32x4){BFLO(xew1[j].x), BFHI(xew1[j].x), BFLO(xew1[j].y), BFHI(xew1[j].y)}; }
            cqa[j] = qa[j]; cqe0[j] = qe0[j]; cqe1[j] = qe1[j]; }
        if (b + 1 < nblk) SSM_LOAD(b + 1);
        f32x16 Xr[NI], Yr[NI], Xi[NI], Yi[NI];
#pragma unroll
        for (int j = 0; j < NI; ++j) {
            const float rsa = pg8::rstd_of(cqa[j]);
            float ua[8];
#pragma unroll
            for (int e = 0; e < 4; ++e) { ua[e] = ca0[j][e] * rsa; ua[4 + e] = ca1[j][e] * rsa; }
            const bf16x8 ufrag = pack8(ua);
            const f32x16 zero16 = {0.f, 0.f, 0.f, 0.f, 0.f, 0.f, 0.f, 0.f, 0.f, 0.f, 0.f, 0.f, 0.f, 0.f, 0.f, 0.f};
            Xr[j] = __builtin_amdgcn_mfma_f32_32x32x16_bf16(ufrag, bbq[0], zero16, 0, 0, 0);
            Yr[j] = __builtin_amdgcn_mfma_f32_32x32x16_bf16(ufrag, bbq[1], zero16, 0, 0, 0);
            Xi[j] = __builtin_amdgcn_mfma_f32_32x32x16_bf16(ufrag, bbq[2], zero16, 0, 0, 0);
            Yi[j] = __builtin_amdgcn_mfma_f32_32x32x16_bf16(ufrag, bbq[3], zero16, 0, 0, 0); }
#pragma unroll
        for (int j = 0; j < NI; ++j)
#pragma unroll
            for (int r = 0; r < 16; ++r) {
                auto s1 = __builtin_amdgcn_permlane32_swap(__float_as_uint(Xr[j][r]), __float_as_uint(Yr[j][r]), false, false); Xr[j][r] = __uint_as_float(s1[0]); Yr[j][r] = __uint_as_float(s1[1]);
                auto s2 = __builtin_amdgcn_permlane32_swap(__float_as_uint(Xi[j][r]), __float_as_uint(Yi[j][r]), false, false); Xi[j][r] = __uint_as_float(s2[0]); Yi[j][r] = __uint_as_float(s2[1]); }
#pragma unroll
        for (int i = 0; i < 4; ++i) {
            if (sample) { hr[0] = s0r[i]; hi[0] = s0i[i]; }
#pragma unroll
            for (int s = 0; s < 2; ++s)
#pragma unroll
                for (int e = 0; e < 4; ++e)
#pragma unroll
                    for (int j = 0; j < NI; ++j) { const int r = 4 * i + e; const float br = s ? Yr[j][r] : Xr[j][r], bi = s ? Yi[j][r] : Xi[j][r];
                        const float nr = fma_s(lbr, hr[j], fma_s(nlbi, hi[j], br)), ni = fma_s(lbr, hi[j], fma_s(lbi, hr[j], bi)); hr[j] = nr; hi[j] = ni;
                        if (MODE == 1) *(LAS unsigned*)(img0 + j * (32 * SSM_ROWB) + (8 * i + 4 * s + e) * SSM_ROWB + 4 * lane) = cvtpk(nr, ni); }
            if (sample) { F.out[O_SRS + ((size_t)(seq0 + i) * NG + g) * PS + lane] = hr[0]; F.out[O_SIS + ((size_t)(seq0 + i) * NG + g) * PS + lane] = hi[0]; }
        }
        if (MODE == 1) {
#pragma unroll
            for (int j = 0; j < NI; ++j) {
                const LAS unsigned char* img = img0 + j * (32 * SSM_ROWB);
                f32x4 acc0 = {0.f, 0.f, 0.f, 0.f}, acc1 = {0.f, 0.f, 0.f, 0.f};
#pragma unroll
                for (int ks = 0; ks < 4; ++ks) {
                    const bf16x8 b0 = *(const LAS bf16x8*)(img + l15 * SSM_ROWB + 64 * ks + 16 * q4);
                    const bf16x8 b1 = *(const LAS bf16x8*)(img + (16 + l15) * SSM_ROWB + 64 * ks + 16 * q4);
                    acc0 = __builtin_amdgcn_mfma_f32_16x16x32_bf16(cm[ks], b0, acc0, 0, 0, 0);
                    acc1 = __builtin_amdgcn_mfma_f32_16x16x32_bf16(cm[ks], b1, acc1, 0, 0, 0); }
                const float rse0 = pg8::rstd_of(cqe0[j]), rse1 = pg8::rstd_of(cqe1[j]);
                float o0[4], o1[4];
#pragma unroll
                for (int e = 0; e < 4; ++e) { o0[e] = gelu_tanh(acc0[e] + dg[e] * ce0[j][e] * rse0); o1[e] = gelu_tanh(acc1[e] + dg[e] * ce1[j][e] * rse1); }
                const int rowE = row_base[j] + 32 * b + l15;
                u32x2v w0, w1; w0.x = cvtpk(o0[0], o0[1]); w0.y = cvtpk(o0[2], o0[3]); w1.x = cvtpk(o1[0], o1[1]); w1.y = cvtpk(o1[2], o1[3]);
                *(u32x2v*)(Gb + (size_t)rowE * D + g * GS + 4 * q4) = w0;
                *(u32x2v*)(Gb + (size_t)(rowE + 16) * D + g * GS + 4 * q4) = w1; }
        }
    }
#undef SSM_LOAD
}

__device__ __forceinline__ void ssm_phase_pass(Frame& F, int pass) {
    LAS unsigned char* img = F.lds + RING_OFF + F.wave * (2 * 32 * SSM_ROWB);
    const int lane = opaque_i(F.lane), s = F.wave * 32 + F.ci, g = s & 63, c0 = s >> 6;
    float* E = (float*)(F.ws + WS_SSME) + ((size_t)(F.gi * NG + g) * SSM_NCH) * 2 * PS;
    const int rb[2] = {F.gi * 2048 + c0 * (SSM_CHB * 32), F.gi * 2048 + (c0 + 4) * (SSM_CHB * 32)};
    if (pass == 0) {
        float hr[2] = {0.f, 0.f}, hi[2] = {0.f, 0.f};
        ssm_run<0, 2>(F, img, lane, g, rb, SSM_CHB, false, 0, hr, hi);
#pragma unroll
        for (int j = 0; j < 2; ++j) { E[((c0 + 4 * j) * 2 + 0) * PS + lane] = hr[j]; E[((c0 + 4 * j) * 2 + 1) * PS + lane] = hi[j]; }
        float sr[1] = {0.f}, si[1] = {0.f}; const int rs[1] = {MP + 128 * F.gi + 32 * c0};
        ssm_run<1, 1>(F, img, lane, g, rs, 1, true, 16 * F.gi + 4 * c0, sr, si);
    } else {
        const float* sp = (const float*)(F.ws + WS_SSMP);
        float ar = sp[g * PS + lane], ai = sp[4096 + g * PS + lane];
#pragma unroll
        for (int k = 0; k < 8; ++k) { const float nr = ar * ar - ai * ai, ni = 2.0f * ar * ai; ar = nr; ai = ni; }
        float hr[2] = {0.f, 0.f}, hi[2] = {0.f, 0.f}; float tr = 0.f, ti = 0.f;
        for (int j = 0; j < c0 + 4; ++j) { const float er = E[(j * 2 + 0) * PS + lane], ei = E[(j * 2 + 1) * PS + lane];
            const float nr = ar * tr - ai * ti + er, ni = ar * ti + ai * tr + ei; tr = nr; ti = ni;
            if (j + 1 == c0) { hr[0] = tr; hi[0] = ti; } }
        hr[1] = tr; hi[1] = ti;
        ssm_run<1, 2>(F, img, lane, g, rb, SSM_CHB, false, 0, hr, hi);
        if (c0 == 3) { F.out[O_SRP + ((size_t)F.gi * NG + g) * PS + lane] = hr[1]; F.out[O_SIP + ((size_t)F.gi * NG + g) * PS + lane] = hi[1]; }
    }
}
#undef BFLO
#undef BFHI

__device__ __forceinline__ void conv_phase(Frame& F) {
    const bf16* Z = (const bf16*)(F.ws + WS_Z); const bf16* GBp = (const bf16*)(F.ws + WS_GB); bf16* A2 = (bf16*)(F.ws + WS_A2);
    const float* cw = F.in[19]; const float* cache = F.in[4];
    const int gt = (F.ci * NWAVES + F.wave) * 64 + opaque_i(F.lane), NGT = 32 * NWAVES * 64;
    for (int it = gt; it < (2048 + 128) * (D / 8); it += NGT) {
        const int lr = it >> 7, row = lr < 2048 ? F.gi * 2048 + lr : MP + F.gi * 128 + (lr - 2048), c0 = (it & 127) * 8;
        int t; const float* cb = nullptr;
        if (row < MP) t = row & 2047; else { const int r2 = row - MP; t = r2 & 7; cb = cache + (size_t)(r2 >> 3) * 2 * D; }
        float z0[8], z1[8], z2[8], gb[8];
        { const v4u v = *(const GAS v4u*)(Z + (size_t)row * D + c0); const v4u q = *(const GAS v4u*)(GBp + (size_t)row * D + c0);
#pragma unroll
          for (int e = 0; e < 4; ++e) { z2[2 * e] = __builtin_bit_cast(float, v[e] << 16); z2[2 * e + 1] = __builtin_bit_cast(float, v[e] & 0xffff0000u);
                                        gb[2 * e] = __builtin_bit_cast(float, q[e] << 16); gb[2 * e + 1] = __builtin_bit_cast(float, q[e] & 0xffff0000u); } }
        if (t >= 1) { const v4u v = *(const GAS v4u*)(Z + (size_t)(row - 1) * D + c0);
#pragma unroll
          for (int e = 0; e < 4; ++e) { z1[2 * e] = __builtin_bit_cast(float, v[e] << 16); z1[2 * e + 1] = __builtin_bit_cast(float, v[e] & 0xffff0000u); } }
        else {
#pragma unroll
          for (int e = 0; e < 8; ++e) z1[e] = cb ? cb[D + c0 + e] : 0.f; }
        if (t >= 2) { const v4u v = *(const GAS v4u*)(Z + (size_t)(row - 2) * D + c0);
#pragma unroll
          for (int e = 0; e < 4; ++e) { z0[2 * e] = __builtin_bit_cast(float, v[e] << 16); z0[2 * e + 1] = __builtin_bit_cast(float, v[e] & 0xffff0000u); } }
        else {
#pragma unroll
          for (int e = 0; e < 8; ++e) z0[e] = cb ? cb[t * D + c0 + e] : 0.f; }
        float o[8];
#pragma unroll
        for (int e = 0; e < 8; ++e) o[e] = gb[e] * (cw[c0 + e] * z0[e] + cw[D + c0 + e] * z1[e] + cw[2 * D + c0 + e] * z2[e]);
        v4u w; w.x = pk2(o[0], o[1]); w.y = pk2(o[2], o[3]); w.z = pk2(o[4], o[5]); w.w = pk2(o[6], o[7]);
        *(GAS v4u*)(A2 + (size_t)row * D + c0) = w;
    }
}

__device__ __forceinline__ void final_phase(Frame& F) {
    const bf16* XBp = (const bf16*)(F.ws + WS_XB); const pg8::ssq_t* ssq = (const pg8::ssq_t*)(F.ws + WS_SSQ) + 6 * M; const float* fg = F.in[6];
    const int gw = F.ci * NWAVES + F.wave, NGW = 32 * NWAVES, lane = opaque_i(F.lane);
    f32x4 gv[4];
#pragma unroll
    for (int j = 0; j < 4; ++j) gv[j] = ((const GAS f32x4*)fg)[lane + 64 * j];
    for (int lr = gw; lr < 2048 + 128; lr += NGW) { const int m = lr < 2048 ? F.gi * 2048 + lr : MP + F.gi * 128 + (lr - 2048);
        const float rs = pg8::rstd_of(ssq[m]);
        const GAS unsigned long long* xr = (const GAS unsigned long long*)(XBp + (size_t)m * D) + lane; GAS f32x4* yo = (GAS f32x4*)(F.out + O_Y + (size_t)m * D) + lane;
#pragma unroll
        for (int j = 0; j < 4; ++j) { const unsigned long long w = xr[64 * j]; const unsigned lo = (unsigned)w, hi = (unsigned)(w >> 32);
            const f32x4 xv = {__builtin_bit_cast(float, lo << 16), __builtin_bit_cast(float, lo & 0xffff0000u), __builtin_bit_cast(float, hi << 16), __builtin_bit_cast(float, hi & 0xffff0000u)};
            yo[64 * j] = xv * rs * gv[j]; }
    }
}

struct SameOrder : pg8::StaticOrder { __device__ bool next(int i, pg8::Unit& u) const { const bool r = pg8::StaticOrder::next(i, u); u.pm = 0; u.pn = 0; return r; } };
struct Args { const float* in[21]; float* out; unsigned char* ws; int ph_lo, ph_hi; };
__global__ void __launch_bounds__(NWAVES * 64, 2) skel_fwd(Args args) {
    extern __shared__ __attribute__((aligned(16))) unsigned char lds[];
    Frame F;
    F.lds = (LAS unsigned char*)lds;
    F.MISC = (volatile LAS unsigned*)(F.lds + MISC_OFF);
    F.tid = threadIdx.x; F.lane = F.tid & 63; F.wave = __builtin_amdgcn_readfirstlane(F.tid >> 6);
    F.G = gridDim.x; { const int bx = blockIdx.x; F.vcu = (bx % 8) * (F.G / 8) + bx / 8; F.gi = bx % 8; F.ci = bx / 8; }
    F.ws = args.ws; F.out = args.out; F.ctl = (gu32*)(args.ws + WS_CTL);
#pragma unroll
    for (int i = 0; i < 21; ++i) F.in[i] = args.in[i];
    for (int u = F.tid; u < (LDS_BYTES - LDSCTL_OFF) / 4; u += NWAVES * 64) ((LAS unsigned*)(F.lds + LDSCTL_OFF))[u] = 0u;
    __syncthreads();
    XcdBarrier bar = xcd_barrier_post((unsigned*)(F.ctl + CW_BAR), F.MISC + 8, (unsigned)F.G);
    XcdBarrier gbar = xcd_barrier_post((unsigned*)(F.ctl + CW_BAR) + (1 + F.gi) * XCD_BAR_WORDS, F.MISC + 10, (unsigned)(F.G / 8));
    const int lo = args.ph_lo, hi = args.ph_hi;
#define IN(k) (lo <= (k) && (k) < hi)
#if defined(PROBE_A_LO)
#define STAMP(k) do { if (blockIdx.x == 0 && F.tid == 0) { const unsigned long long t_ = __builtin_amdgcn_s_memrealtime(); F.MISC[16 + 2 * (k)] = (unsigned)t_; F.MISC[17 + 2 * (k)] = (unsigned)(t_ >> 32); } } while (0)
#else
#define STAMP(k) do { } while (0)
#endif
    STAMP(0);
#define SEAM(k) do { if (IN((k) + 1)) { if ((k) == 0) xcd_barrier(bar); else xcd_barrier(gbar); } STAMP((k) + 1); } while (0)
    bf16* XB = (bf16*)(F.ws + WS_XB); bf16* H = (bf16*)(F.ws + WS_H); pg8::ssq_t* ssq = (pg8::ssq_t*)(F.ws + WS_SSQ);
    const int bx = (int)blockIdx.x;

    if (IN(0)) { p0_prologue(F); SEAM(0); }
#define FFN_GU(ph, f, sin) if (IN(ph)) { pg8::Gemm g{XB, (const bf16*)(F.ws + WS_WGU) + (size_t)(f) * 2 * FF * D, M, 2 * FF, D}; pg8::StaticOrder S; S.init(MP, 2 * FF, F.G, bx); \
        pg8::EpiGateUp E{H, FF, ssq + (size_t)(sin) * M, (LAS float*)(F.lds + RSTD_OFF)}; pg8::gemm_phase<pg8::EpiGateUp, pg8::StaticOrder, true, true>(F.lds + RING_OFF, g, S, E); SEAM(ph); }
#define FFN_DN(ph, f, sout) if (IN(ph)) { pg8::Gemm g{H, (const bf16*)(F.ws + WS_WD) + (size_t)(f) * D * FF, M, D, FF}; pg8::StaticOrder S; S.init(MP, D, F.G, bx); \
        pg8::EpiResid<0> E{(ph) == 2 ? F.in[0] : nullptr, (ph) == 2 ? F.in[1] : nullptr, XB, ssq + (size_t)(sout) * M, 0.5f}; pg8::gemm_phase<pg8::EpiResid<0>, pg8::StaticOrder, true, true>(F.lds + RING_OFF, g, S, E); SEAM(ph); }
    FFN_GU(1, 0, 0)
    FFN_DN(2, 0, 1)
#if defined(PROBE_SSM)
    if (IN(3)) { ssm_phase_pass(F, 0); if (PROBE_SSM == 1) { xcd_barrier(gbar); ssm_phase_pass(F, 0); } xcd_barrier(gbar); ssm_phase_pass(F, 1); if (PROBE_SSM == 2) { xcd_barrier(gbar); ssm_phase_pass(F, 1); } SEAM(3); }
#else
    if (IN(3)) { ssm_phase_pass(F, 0); xcd_barrier(gbar); ssm_phase_pass(F, 1); SEAM(3); }
#endif
    if (IN(4)) { pg8::Gemm g{(const bf16*)(F.ws + WS_G), (const bf16*)(F.ws + WS_WGLU), M, 2 * D, D}; pg8::StaticOrder S; S.init(MP, 2 * D, F.G, bx);
        pg8::EpiResid<1> E{nullptr, nullptr, XB, ssq + (size_t)2 * M, 1.0f}; pg8::gemm_phase<pg8::EpiResid<1>, pg8::StaticOrder, true, true>(F.lds + RING_OFF, g, S, E); SEAM(4); }
    FFN_GU(5, 1, 2)
    FFN_DN(6, 1, 3)
    FFN_GU(7, 2, 3)
    FFN_DN(8, 2, 4)
    if (IN(9)) { pg8::Gemm g{XB, (const bf16*)(F.ws + WS_WIN), M, 3 * D, D}; pg8::StaticOrder S; S.init(MP, 3 * D, F.G, bx);
        pg8::EpiConvIn E{(bf16*)(F.ws + WS_Z), (bf16*)(F.ws + WS_GB), ssq + (size_t)4 * M, F.out + O_CP, F.out + O_CS, (LAS float*)(F.lds + RSTD_OFF)};
        pg8::gemm_phase<pg8::EpiConvIn, pg8::StaticOrder, true, true>(F.lds + RING_OFF, g, S, E); SEAM(9); }
    if (IN(10)) { conv_phase(F); SEAM(10); }
    if (IN(11)) { pg8::Gemm g{(const bf16*)(F.ws + WS_A2), (const bf16*)(F.ws + WS_WOUT), M, D, D}; pg8::StaticOrder S; S.init(MP, D, F.G, bx);
        pg8::EpiResid<0> E{nullptr, nullptr, XB, ssq + (size_t)5 * M, 1.0f}; pg8::gemm_phase<pg8::EpiResid<0>, pg8::StaticOrder, true, true>(F.lds + RING_OFF, g, S, E); SEAM(11); }
    FFN_GU(12, 3, 5)
    FFN_DN(13, 3, 6)
    if (IN(14)) { final_phase(F); }
#if defined(PROBE_DRY)
#ifndef PROBE_VARIANT
#define PROBE_VARIANT 0
#endif
    xcd_barrier(gbar); STAMP(15); if (blockIdx.x == 0 && F.tid == 0) { const unsigned long long c_ = __builtin_amdgcn_s_memtime(); F.MISC[60] = (unsigned)c_; F.MISC[61] = (unsigned)(c_ >> 32); }
#if PROBE_DRY == 2
    { pg8::Gemm g{XB, (const bf16*)(F.ws + WS_WGU), M, 2 * FF, D}; SameOrder S; S.init(MP, 2 * FF, F.G, bx);
      pg8::EpiNull E{H + (size_t)M * FF - 1}; pg8::gemm_phase<pg8::EpiNull, SameOrder, true, true>(F.lds + RING_OFF, g, S, E); }
#else
#if PROBE_DRY == 3
    { pg8::Gemm g{XB, (const bf16*)(F.ws + WS_WGU) + (size_t)3 * 2 * FF * D, M, 2 * FF, D}; pg8::StaticOrder S; S.init(MP, 2 * FF, F.G, bx);
      pg8::EpiGateUp E{H, FF, ssq + (size_t)5 * M, (LAS float*)(F.lds + RSTD_OFF)}; pg8::gemm_phase<pg8::EpiGateUp, pg8::StaticOrder, true, true, PROBE_VARIANT>(F.lds + RING_OFF, g, S, E); }
#else
    { pg8::Gemm g{XB, (const bf16*)(F.ws + WS_WGU), M, 2 * FF, D}; pg8::StaticOrder S; S.init(MP, 2 * FF, F.G, bx);
      pg8::EpiNull E{H + (size_t)M * FF - 1}; pg8::gemm_phase<pg8::EpiNull, pg8::StaticOrder, true, true, PROBE_VARIANT>(F.lds + RING_OFF, g, S, E); }
#endif
#endif
    xcd_barrier(gbar); STAMP(16); if (blockIdx.x == 0 && F.tid == 0) { const unsigned long long c_ = __builtin_amdgcn_s_memtime(); F.MISC[62] = (unsigned)c_; F.MISC[63] = (unsigned)(c_ >> 32); }
#endif
#if defined(PROBE_A_LO)
    __syncthreads();
    if (blockIdx.x == 0 && F.tid == 0) {
#if !defined(PROBE_DRY)
        STAMP(15);
#endif
#define TS(k) ((unsigned long long)F.MISC[16 + 2 * (k)] | ((unsigned long long)F.MISC[17 + 2 * (k)] << 32))
        const unsigned long long ta = TS(PROBE_A_HI) - TS(PROBE_A_LO), tb = TS(PROBE_B_HI) - TS(PROBE_B_LO);
#if defined(PROBE_CLOCK)
        { const unsigned long long c0 = (unsigned long long)F.MISC[60] | ((unsigned long long)F.MISC[61] << 32), c1 = (unsigned long long)F.MISC[62] | ((unsigned long long)F.MISC[63] << 32);
          F.out[0] += (float)(c1 - c0) / (float)(TS(16) - TS(15)) * 1e-2f; }
#else
        F.out[0] += (float)tb * 1e-5f;
#endif
        const unsigned long long t0 = __builtin_amdgcn_s_memrealtime();
        const unsigned long long spin = ta * 4ull < 1000000ull ? ta * 4ull : 1000000ull;
        while (__builtin_amdgcn_s_memrealtime() - t0 < spin) __builtin_amdgcn_s_sleep(8);
    }
#endif
#undef IN
#undef SEAM
}

extern "C" void kernel_launch(void* const* d_in, const int* in_sizes, int n_in, void* d_out, int out_size, void* d_ws, size_t ws_size, hipStream_t stream) {
    static int grid = 0;
    if (grid == 0) {
        if (n_in != 21 || out_size != (int)O_END || ws_size < WS_END) { fprintf(stderr, "kernel_launch: unexpected shapes: n_in %d out %d ws %zu; nothing launched\n", n_in, out_size, ws_size); grid = -1; return; }
        int dev = 0, cus = 0, per_cu = 0;
        if (hipGetDevice(&dev) != hipSuccess || hipDeviceGetAttribute(&cus, hipDeviceAttributeMultiprocessorCount, dev) != hipSuccess) { grid = -1; return; }
        if (hipFuncSetAttribute((const void*)skel_fwd, hipFuncAttributeMaxDynamicSharedMemorySize, LDS_BYTES) != hipSuccess) { fprintf(stderr, "kernel_launch: hipFuncSetAttribute failed\n"); grid = -1; return; }
        if (hipOccupancyMaxActiveBlocksPerMultiprocessor(&per_cu, (const void*)skel_fwd, NWAVES * 64, LDS_BYTES) != hipSuccess || per_cu < 1) fprintf(stderr, "kernel_launch: occupancy query reports %d\n", per_cu);
        (void)hipGetLastError();
        if (cus < 256) { fprintf(stderr, "kernel_launch: built for a 256-CU device (8 groups x 32 workgroups), found %d CUs; nothing launched\n", cus); grid = -1; return; }
        grid = 256;
    }
    if (grid < 0) return;
    if (hipMemsetAsync((char*)d_ws + WS_CTL, 0, CTL_ZERO_BYTES, stream) != hipSuccess) return;
    Args a{};
    for (int i = 0; i < 21; ++i) a.in[i] = (const float*)d_in[i];
    a.out = (float*)d_out; a.ws = (unsigned char*)d_ws;
    a.ph_lo = 0; a.ph_hi = N_PHASES;
    hipLaunchKernelGGL(skel_fwd, dim3(grid), dim3(NWAVES * 64), LDS_BYTES, stream, a);
}
```

```cpp
#include <hip/hip_runtime.h>
#include <cstdio>
#include <cstdint>
namespace pg8 {
#define PG8_LAS __attribute__((address_space(3)))
typedef unsigned short bf16_t;
typedef short bf16x8 __attribute__((ext_vector_type(8)));
typedef float f32x4 __attribute__((ext_vector_type(4)));
typedef unsigned u32x4 __attribute__((ext_vector_type(4)));
constexpr int BM = 256, BK = 64, HALF = 128, HTB = HALF * BK * 2  , STAGE_BYTES = 8 * HTB, NXCD = 8, WGM = 8;

__host__ __device__ __forceinline__ int lds_byte(int r, int c) { const int st = (r >> 4) * 2 + (c >> 5), rr = r & 15, cc = c & 31, ob = rr * 64 + cc * 2; return st * 1024 + (ob ^ (((ob >> 9) & 1) << 5)); }
__host__ __device__ __forceinline__ void stage_rc(int b, int& R, int& C) { const int st = b / 1024, sb = b % 1024, swz = sb ^ (((sb >> 9) & 1) << 5); R = (st >> 1) * 16 + swz / 64; C = (st & 1) * 32 + (swz % 64) / 2; }
__host__ __device__ __forceinline__ int perm32(int rho) { const int n = rho >> 4, i = rho & 15; return 8 * (i >> 2) + 4 * n + (i & 3); }

struct Unit { int pm, pn; };
struct Gemm { const bf16_t* A; const bf16_t* Bt; int M, N, K; };

struct StaticOrder {
    int nM, nN, nwg, G, c;
    __host__ __device__ void init(int M, int N, int G_, int c_) { nM = M / BM; nN = N / BM; nwg = nM * nN; G = G_; c = c_; }
    __host__ __device__ bool next(int i, Unit& u) const {
        const long L = (long)i * G + c; if (L >= nwg) return false;
        int wgid = (int)L; { const int q = nwg / NXCD, r = nwg % NXCD, xcd = wgid % NXCD, off = wgid / NXCD; wgid = (xcd < r ? xcd * (q + 1) : r * (q + 1) + (xcd - r) * q) + off; }
        const int nig = WGM * nN, gid = wgid / nig, fm = gid * WGM, gsz = (nM - fm) < WGM ? (nM - fm) : WGM;
        u.pm = fm + ((wgid % nig) % gsz); u.pn = (wgid % nig) / gsz; return true;
    }
    __device__ __forceinline__ void a_ready(const Unit&) const {}
    __device__ __forceinline__ void done(const Unit&) const {}
};


__device__ __forceinline__ unsigned cvt_pk_bf16(float lo, float hi) { unsigned r; asm volatile("v_cvt_pk_bf16_f32 %0, %1, %2" : "=v"(r) : "v"(lo), "v"(hi)); return r; }

typedef unsigned u32x2 __attribute__((ext_vector_type(2)));
constexpr float RMS_EPS = 1e-6f;
constexpr float INV_D = 1.0f / 1024.0f;
__device__ __forceinline__ float sigmoid_f(float x) { return __builtin_amdgcn_rcpf(1.0f + __builtin_amdgcn_exp2f(-1.4426950408889634f * x)); }
typedef unsigned long long ssq_t;
constexpr float SSQ_SCALE = 16777216.0f, SSQ_INV = 1.0f / 16777216.0f;
__device__ __forceinline__ ssq_t ssq_fix(float s) { return (ssq_t)(s * SSQ_SCALE + 0.5f); }
__device__ __forceinline__ float rstd_of(ssq_t q) { return __builtin_amdgcn_rsqf((float)q * (SSQ_INV * INV_D) + RMS_EPS); }
__device__ __forceinline__ void st16_sc1(void* p, u32x4 v) { asm volatile("global_store_dwordx4 %0, %1, off sc1\n\ts_nop 1" :: "v"(p), "v"(v) : "memory"); }
__device__ __forceinline__ void st8_sc1(void* p, u32x2 v) { asm volatile("global_store_dwordx2 %0, %1, off sc1\n\ts_nop 1" :: "v"(p), "v"(v) : "memory"); }
__device__ __forceinline__ float mul_s(float a, float b) { float r; asm volatile("v_mul_f32 %0, %1, %2" : "=v"(r) : "v"(a), "v"(b)); return r; }
__device__ __forceinline__ float fma_s(float a, float b, float c) { float r; asm volatile("v_fma_f32 %0, %1, %2, %3" : "=v"(r) : "v"(a), "v"(b), "v"(c)); return r; }
__device__ __forceinline__ float exp2_s(float a) { float r; asm volatile("v_exp_f32 %0, %1" : "=v"(r) : "v"(a)); return r; }
__device__ __forceinline__ float rcp_s(float a) { float r; asm volatile("v_rcp_f32 %0, %1" : "=v"(r) : "v"(a)); return r; }
template <int N> __device__ __forceinline__ void swiglu_batch(const float (&g)[N], const float (&u)[N], float c1, float irs2, float (&h)[N]) {
    float x[N], t[N];
#pragma unroll
    for (int e = 0; e < N; ++e) x[e] = mul_s(g[e], c1);
#pragma unroll
    for (int e = 0; e < N; ++e) x[e] = exp2_s(x[e]);
#pragma unroll
    for (int e = 0; e < N; ++e) x[e] = fma_s(x[e], irs2, irs2);
#pragma unroll
    for (int e = 0; e < N; ++e) x[e] = rcp_s(x[e]);
#pragma unroll
    for (int e = 0; e < N; ++e) t[e] = mul_s(g[e], u[e]);
#pragma unroll
    for (int e = 0; e < N; ++e) h[e] = mul_s(t[e], x[e]);
}
#define PG8_EPI_CALL() \
    __device__ __forceinline__ void operator()(const f32x4 (&acc)[2][2][4][2], const Unit& u, int wr, int wc, int fr, int fq) const { \
        _Pragma("unroll") for (int ai = 0; ai < 2; ++ai) _Pragma("unroll") for (int m = 0; m < 4; ++m) { \
            const f32x4 a[2][2] = {{acc[ai][0][m][0], acc[ai][0][m][1]}, {acc[ai][1][m][0], acc[ai][1][m][1]}}; rg(a, u, ai, m, 3, wr, wc, fr, fq); } }

struct EpiGateUp {
    static constexpr bool PERM = true, AFTER_DRAIN = false;
    bf16_t* H; int ldh; const ssq_t* ssq; PG8_LAS float* rs_lds;
    __device__ __forceinline__ void prep(const Unit& u, int tid) const { if (tid < 272) { const int row = tid < 256 ? u.pm * BM + tid : 16384 + 16 * u.pm + (tid - 256); const ssq_t q = ssq[row];
            rs_lds[2 * tid] = -1.4426950408889634f * rstd_of(q); rs_lds[2 * tid + 1] = (float)q * (SSQ_INV * INV_D) + RMS_EPS; } }
    __device__ __forceinline__ void rg(const f32x4 (&a)[2][2], const Unit& u, int ai, int m, int bjmask, int wr, int wc, int fr, int fq) const {
        const int row = u.pm * BM + ai * HALF + wr * 64 + m * 16 + fr, col0 = u.pn * HALF + wc * 32 + 8 * fq;
        const float c1 = rs_lds[2 * (ai * HALF + wr * 64 + m * 16 + fr)], irs2 = rs_lds[2 * (ai * HALF + wr * 64 + m * 16 + fr) + 1];
        float h[8];
        { const float g8[8] = {a[0][0][0], a[0][0][1], a[0][0][2], a[0][0][3], a[0][1][0], a[0][1][1], a[0][1][2], a[0][1][3]}, u8[8] = {a[1][0][0], a[1][0][1], a[1][0][2], a[1][0][3], a[1][1][0], a[1][1][1], a[1][1][2], a[1][1][3]};
          swiglu_batch<8>(g8, u8, c1, irs2, h); }
        u32x4 w; w.x = cvt_pk_bf16(h[0], h[1]); w.y = cvt_pk_bf16(h[2], h[3]); w.z = cvt_pk_bf16(h[4], h[5]); w.w = cvt_pk_bf16(h[6], h[7]);
        st16_sc1(H + (size_t)row * ldh + col0, w);
    }
    __device__ __forceinline__ void rgx(const f32x4 (&ax)[2], const Unit& u, int wr, int wc, int fr, int fq) const {
        const int row = 16384 + 16 * u.pm + fr, col0 = u.pn * HALF + wc * 32 + 8 * fq + 4 * wr;
        const float c1 = rs_lds[2 * (256 + fr)], irs2 = rs_lds[2 * (256 + fr) + 1];
        float h[4];
        { const float g4[4] = {ax[0][0], ax[0][1], ax[0][2], ax[0][3]}, u4[4] = {ax[1][0], ax[1][1], ax[1][2], ax[1][3]}; swiglu_batch<4>(g4, u4, c1, irs2, h); }
        u32x2 w; w.x = cvt_pk_bf16(h[0], h[1]); w.y = cvt_pk_bf16(h[2], h[3]);
        st8_sc1(H + (size_t)row * ldh + col0, w);
    }
    PG8_EPI_CALL()
};

__device__ __forceinline__ void unpack8(const u32x4 w, float (&x)[8]) {
#pragma unroll
    for (int e = 0; e < 4; ++e) { x[2 * e] = __builtin_bit_cast(float, w[e] << 16); x[2 * e + 1] = __builtin_bit_cast(float, w[e] & 0xffff0000u); } }
template <int MODE> struct EpiResid {
    static constexpr bool PERM = true, AFTER_DRAIN = false;
    const float* xin_p; const float* xin_s; bf16_t* XB; ssq_t* ssq; float scale;
    __device__ __forceinline__ void prep(const Unit&, int) const {}
    __device__ __forceinline__ void rg(const f32x4 (&a)[2][2], const Unit& u, int ai, int m, int bjmask, int wr, int wc, int fr, int fq) const {
        const int row = u.pm * BM + ai * HALF + wr * 64 + m * 16 + fr;
        const int col0 = (MODE == 0 ? u.pn * BM : u.pn * HALF) + wc * 32 + 8 * fq;
        float sq = 0.f;
#pragma unroll
        for (int bj = 0; bj < (MODE == 0 ? 2 : 1); ++bj) {
            bf16_t* xp = XB + (size_t)row * 1024 + col0 + bj * HALF;
            float x[8];
            if (xin_p) { const float* xi = xin_p + (size_t)row * 1024 + col0 + bj * HALF; const f32x4 x0 = *(const f32x4*)xi, x1 = *(const f32x4*)(xi + 4);
#pragma unroll
                for (int e = 0; e < 4; ++e) { x[e] = x0[e]; x[4 + e] = x1[e]; } }
            else unpack8(*(const u32x4*)xp, x);
#pragma unroll
            for (int e = 0; e < 4; ++e) {
                if (MODE == 0) { x[e] += a[bj][0][e] * scale; x[4 + e] += a[bj][1][e] * scale; }
                else { x[e] += a[0][0][e] * sigmoid_f(a[1][0][e]); x[4 + e] += a[0][1][e] * sigmoid_f(a[1][1][e]); } }
            u32x4 w; w.x = cvt_pk_bf16(x[0], x[1]); w.y = cvt_pk_bf16(x[2], x[3]); w.z = cvt_pk_bf16(x[4], x[5]); w.w = cvt_pk_bf16(x[6], x[7]);
            st16_sc1(xp, w);
            sq += (x[0] * x[0] + x[1] * x[1]) + (x[2] * x[2] + x[3] * x[3]) + (x[4] * x[4] + x[5] * x[5]) + (x[6] * x[6] + x[7] * x[7]); }
        sq += __shfl_xor(sq, 16); sq += __shfl_xor(sq, 32);
        if (fq == 0) atomicAdd(ssq + row, ssq_fix(sq));
    }
    __device__ __forceinline__ void rgx(const f32x4 (&ax)[2], const Unit& u, int wr, int wc, int fr, int fq) const {
        const int r2 = 16 * u.pm + fr, row = 16384 + r2;
        const int col0 = (MODE == 0 ? u.pn * BM : u.pn * HALF) + wc * 32 + 8 * fq + 4 * wr;
        float sq = 0.f;
#pragma unroll
        for (int bj = 0; bj < (MODE == 0 ? 2 : 1); ++bj) {
            bf16_t* xp = XB + (size_t)row * 1024 + col0 + bj * HALF;
            f32x4 x0;
            if (xin_s) x0 = *(const f32x4*)(xin_s + (size_t)r2 * 1024 + col0 + bj * HALF);
            else { const u32x2 w = *(const u32x2*)xp; x0[0] = __builtin_bit_cast(float, w.x << 16); x0[1] = __builtin_bit_cast(float, w.x & 0xffff0000u); x0[2] = __builtin_bit_cast(float, w.y << 16); x0[3] = __builtin_bit_cast(float, w.y & 0xffff0000u); }
            if (MODE == 0) x0 += ax[bj] * scale;
            else {
#pragma unroll
                for (int e = 0; e < 4; ++e) x0[e] += ax[0][e] * sigmoid_f(ax[1][e]); }
            u32x2 w; w.x = cvt_pk_bf16(x0[0], x0[1]); w.y = cvt_pk_bf16(x0[2], x0[3]);
            st8_sc1(xp, w);
            sq += (x0[0] * x0[0] + x0[1] * x0[1]) + (x0[2] * x0[2] + x0[3] * x0[3]); }
        sq += __shfl_xor(sq, 16); sq += __shfl_xor(sq, 32);
        if (fq == 0) atomicAdd(ssq + row, ssq_fix(sq));
    }
    PG8_EPI_CALL()
};

struct EpiConvIn {
    static constexpr bool PERM = true, AFTER_DRAIN = false;
    bf16_t* Z; bf16_t* GB; const ssq_t* ssq; float* conv_p; float* conv_s; PG8_LAS float* rs_lds;
    __device__ __forceinline__ void prep(const Unit& u, int tid) const { if (tid < 272) { const int row = tid < 256 ? u.pm * BM + tid : 16384 + 16 * u.pm + (tid - 256); const float rs = rstd_of(ssq[row]); rs_lds[2 * tid] = rs; rs_lds[2 * tid + 1] = rs * rs; } }
    __device__ __forceinline__ void rg(const f32x4 (&a)[2][2], const Unit& u, int ai, int m, int bjmask, int wr, int wc, int fr, int fq) const {
        const int row = u.pm * BM + ai * HALF + wr * 64 + m * 16 + fr;
        const float rs = rs_lds[2 * (ai * HALF + wr * 64 + m * 16 + fr)], rs2 = rs_lds[2 * (ai * HALF + wr * 64 + m * 16 + fr) + 1];
        if (u.pn < 8) {
            const int col0 = u.pn * HALF + wc * 32 + 8 * fq;
            const f32x4 z0 = a[0][0] * a[1][0] * rs2, z1 = a[0][1] * a[1][1] * rs2;
            u32x4 w; w.x = cvt_pk_bf16(z0[0], z0[1]); w.y = cvt_pk_bf16(z0[2], z0[3]); w.z = cvt_pk_bf16(z1[0], z1[1]); w.w = cvt_pk_bf16(z1[2], z1[3]);
            st16_sc1(Z + (size_t)row * 1024 + col0, w);
            float* cp = nullptr;
            if (row < 16384) { const int t = row & 2047; if (t >= 2046) cp = conv_p + ((size_t)(row >> 11) * 2 + (t - 2046)) * 1024 + col0; }
            else { const int r2 = row - 16384, t = r2 & 7; if (t >= 6) cp = conv_s + ((size_t)(r2 >> 3) * 2 + (t - 6)) * 1024 + col0; }
            if (cp) { *(f32x4*)cp = z0; *(f32x4*)(cp + 4) = z1; }
        } else {
            const int col0 = (u.pn - 8) * BM + wc * 32 + 8 * fq;
#pragma unroll
            for (int bj = 0; bj < 2; ++bj) { const f32x4 g0 = a[bj][0] * rs, g1 = a[bj][1] * rs;
                u32x4 w; w.x = cvt_pk_bf16(g0[0], g0[1]); w.y = cvt_pk_bf16(g0[2], g0[3]); w.z = cvt_pk_bf16(g1[0], g1[1]); w.w = cvt_pk_bf16(g1[2], g1[3]);
                st16_sc1(GB + (size_t)row * 1024 + col0 + bj * HALF, w); }
        }
    }
    __device__ __forceinline__ void rgx(const f32x4 (&ax)[2], const Unit& u, int wr, int wc, int fr, int fq) const {
        const int r2 = 16 * u.pm + fr, row = 16384 + r2;
        const float rs = rs_lds[2 * (256 + fr)];
        if (u.pn < 8) {
            const int col0 = u.pn * HALF + wc * 32 + 8 * fq + 4 * wr;
            const f32x4 z0 = ax[0] * ax[1] * (rs * rs);
            u32x2 w; w.x = cvt_pk_bf16(z0[0], z0[1]); w.y = cvt_pk_bf16(z0[2], z0[3]);
            st8_sc1(Z + (size_t)row * 1024 + col0, w);
            const int t = r2 & 7;
            if (t >= 6) *(f32x4*)(conv_s + ((size_t)(r2 >> 3) * 2 + (t - 6)) * 1024 + col0) = z0;
        } else {
            const int col0 = (u.pn - 8) * BM + wc * 32 + 8 * fq + 4 * wr;
#pragma unroll
            for (int bj = 0; bj < 2; ++bj) { const f32x4 g0 = ax[bj] * rs;
                u32x2 w; w.x = cvt_pk_bf16(g0[0], g0[1]); w.y = cvt_pk_bf16(g0[2], g0[3]);
                st8_sc1(GB + (size_t)row * 1024 + col0 + bj * HALF, w); }
        }
    }
    PG8_EPI_CALL()
};

struct EpiNull {
    static constexpr bool PERM = true, AFTER_DRAIN = false;
    bf16_t* sink;
    __device__ __forceinline__ void prep(const Unit&, int) const {}
    __device__ __forceinline__ void rg(const f32x4 (&a)[2][2], const Unit& u, int ai, int m, int bjmask, int wr, int wc, int fr, int fq) const {
        asm volatile("" :: "v"(a[0][0]), "v"(a[0][1]), "v"(a[1][0]), "v"(a[1][1]));
    }
    __device__ __forceinline__ void rgx(const f32x4 (&ax)[2], const Unit& u, int wr, int wc, int fr, int fq) const { asm volatile("" :: "v"(ax[0]), "v"(ax[1])); }
    PG8_EPI_CALL()
};

template <class Epi, class Sched, bool ALIGN_EPI = false, bool SP2 = false, int PROBE = 0>
__device__ __forceinline__ void gemm_phase(PG8_LAS unsigned char* lds, const Gemm g, const Sched& S, const Epi& E) {
    int tid_ = threadIdx.x; asm volatile("" : "+v"(tid_));
    const int tid = tid_, wid = __builtin_amdgcn_readfirstlane(tid >> 6), lane = tid & 63, wr = wid >> 2, wc = wid & 3, fr = lane & 15, fq = lane >> 4;
    const int K = g.K, nt = K / BK;
    constexpr int XROW0 = 16384, XR = 16;
    unsigned voffA[2], voffB[2];
#pragma unroll
    for (int i = 0; i < 2; ++i) { int R, C; stage_rc(tid * 16 + i * 8192, R, C); const int Rb = Epi::PERM ? ((R & ~31) + perm32(R & 31)) : R;
        voffA[i] = (unsigned)(R * K + C) * 2u; voffB[i] = (unsigned)(Rb * K + C) * 2u; }
    unsigned voffX; { const int p = (wid & 3) * 1024 + lane * 16, bq = p >> 11, q = p & 2047, row = q >> 7, kb = (q & 127) ^ (((row >> 1) & 7) << 4); voffX = (unsigned)(row * K * 2 + bq * 128 + kb); }
    int xoff0 = fr * 128 + ((fq * 16) ^ (((fr >> 1) & 7) << 4)), xoff1 = fr * 128 + ((64 + fq * 16) ^ (((fr >> 1) & 7) << 4));
    unsigned xpw = 4096;
    const unsigned kstep = (unsigned)(BK * 2);
    const unsigned hstep = (unsigned)HALF * K * 2;
    const unsigned tstep = 2 * hstep;
    const __amdgpu_buffer_rsrc_t rsA = __builtin_amdgcn_make_buffer_rsrc((void*)g.A, 0, 0x7ffff000, 0x00020000), rsB = __builtin_amdgcn_make_buffer_rsrc((void*)g.Bt, 0, 0x7ffff000, 0x00020000);
    const unsigned ldsw = (unsigned)wid * 1024u;
    const int aoff = lds_byte(wr * 64 + fr, fq * 8), boff = lds_byte(wc * 32 + fr, fq * 8);
#define PG8_SA(b, h) (((b) * 2 + (h)) * HTB)
#define PG8_SB(b, h) ((4 + (b) * 2 + (h)) * HTB)
#define PG8_SX(b) (STAGE_BYTES + (b) * 2048)
#define PG8_STAGEXP(soff) do { if constexpr ((PROBE & (6 | 16)) == 0) { if (wr == 0) __builtin_amdgcn_raw_ptr_buffer_load_lds(rsA, (PG8_LAS unsigned*)(lds + STAGE_BYTES + xpw + wid * 1024), 16, voffX, (soff), 0, 0); } } while (0)
#define PG8_LDAX(dst, b) do { if constexpr ((PROBE & (10 | 32)) == 0) { dst[0] = *(const PG8_LAS bf16x8*)(lds + PG8_SX(b) + xoff0); dst[1] = *(const PG8_LAS bf16x8*)(lds + PG8_SX(b) + xoff1); } } while (0)
#define PG8_WAIT_LT(nl, nt) do { if (wr == 0) PG8_WAIT_V(nl); else PG8_WAIT_V(nt); } while (0)
#define PG8_MMAX_NULL() do { asm volatile("" :: "v"(Ax[0]), "v"(Ax[1])); } while (0)
#define PG8_MMAX_REAL() do { if (wr == 0) { _Pragma("unroll") for (int k = 0; k < 2; ++k) { accx[0] = __builtin_amdgcn_mfma_f32_16x16x32_bf16(B0[0][k], Ax[k], accx[0], 0, 0, 0); accx[1] = __builtin_amdgcn_mfma_f32_16x16x32_bf16(B1[0][k], Ax[k], accx[1], 0, 0, 0); } } \
        else { _Pragma("unroll") for (int k = 0; k < 2; ++k) { accx[0] = __builtin_amdgcn_mfma_f32_16x16x32_bf16(B0[1][k], Ax[k], accx[0], 0, 0, 0); accx[1] = __builtin_amdgcn_mfma_f32_16x16x32_bf16(B1[1][k], Ax[k], accx[1], 0, 0, 0); } } } while (0)
#define PG8_MMAX() do { if constexpr ((PROBE & (2 | 32)) != 0) { } else if constexpr ((PROBE & 1) != 0) PG8_MMAX_NULL(); else PG8_MMAX_REAL(); } while (0)
#define PG8_STAGEA(bufoff, soff) do { if constexpr ((PROBE & 4) == 0) _Pragma("unroll") for (int _i = 0; _i < 2; ++_i) \
        __builtin_amdgcn_raw_ptr_buffer_load_lds(rsA, (PG8_LAS unsigned*)(lds + (bufoff) + ldsw + _i * 8192), 16, voffA[_i], (soff), 0, 0); } while (0)
#define PG8_STAGEB(bufoff, soff) do { if constexpr ((PROBE & 4) == 0) _Pragma("unroll") for (int _i = 0; _i < 2; ++_i) \
        __builtin_amdgcn_raw_ptr_buffer_load_lds(rsB, (PG8_LAS unsigned*)(lds + (bufoff) + ldsw + _i * 8192), 16, voffB[_i], (soff), 0, 0); } while (0)
#define PG8_LDA(dst, b, h) do { if constexpr ((PROBE & 8) == 0) { _Pragma("unroll") for (int m = 0; m < 4; ++m) _Pragma("unroll") for (int k = 0; k < 2; ++k) dst[m][k] = *(const PG8_LAS bf16x8*)(lds + PG8_SA(b, h) + aoff + m * 2048 + k * 1024); } } while (0)
#define PG8_LDB(dst, b, h) do { if constexpr ((PROBE & 8) == 0) { _Pragma("unroll") for (int n = 0; n < 2; ++n) _Pragma("unroll") for (int k = 0; k < 2; ++k) dst[n][k] = *(const PG8_LAS bf16x8*)(lds + PG8_SB(b, h) + boff + n * 2048 + k * 1024); } } while (0)
#define PG8_MMA_NULL(ai, bj, At, Bt) do { _Pragma("unroll") for (int m = 0; m < 4; ++m) _Pragma("unroll") for (int k = 0; k < 2; ++k) asm volatile("" :: "v"(At[m][k])); _Pragma("unroll") for (int n = 0; n < 2; ++n) _Pragma("unroll") for (int k = 0; k < 2; ++k) asm volatile("" :: "v"(Bt[n][k])); } while (0)
#define PG8_MMA_REAL(ai, bj, At, Bt) do { __builtin_amdgcn_s_setprio(1); _Pragma("unroll") for (int m = 0; m < 4; ++m) _Pragma("unroll") for (int n = 0; n < 2; ++n) _Pragma("unroll") for (int k = 0; k < 2; ++k) \
        acc[ai][bj][m][n] = __builtin_amdgcn_mfma_f32_16x16x32_bf16(Bt[n][k], At[m][k], acc[ai][bj][m][n], 0, 0, 0); __builtin_amdgcn_s_setprio(0); } while (0)
#define PG8_MMA(ai, bj, At, Bt) do { if constexpr ((PROBE & 1) != 0) PG8_MMA_NULL(ai, bj, At, Bt); else PG8_MMA_REAL(ai, bj, At, Bt); } while (0)
#define PG8_WAIT_V(n) asm volatile("s_waitcnt vmcnt(" #n ")" ::: "memory")
#define PG8_WAIT_L(n) asm volatile("s_waitcnt lgkmcnt(" #n ")" ::: "memory")
#define PG8_BAR __builtin_amdgcn_s_barrier()
#define PG8_SCHED __builtin_amdgcn_sched_barrier(0)
    Unit cur, nxt; int ui = 0;
    if (!S.next(0, cur)) return;
    f32x4 acc[2][2][4][2];
#pragma unroll
    for (int a = 0; a < 2; ++a)
#pragma unroll
        for (int b = 0; b < 2; ++b)
#pragma unroll
            for (int m = 0; m < 4; ++m)
#pragma unroll
                for (int n = 0; n < 2; ++n) acc[a][b][m][n] = (f32x4){0.f, 0.f, 0.f, 0.f};
    bf16x8 At[4][2], B0[2][2], B1[2][2], Ax[2];
    if constexpr ((PROBE & 8) != 0) {
#pragma unroll
        for (int m = 0; m < 4; ++m)
#pragma unroll
            for (int k = 0; k < 2; ++k) asm volatile("" : "=v"(At[m][k]));
#pragma unroll
        for (int n = 0; n < 2; ++n)
#pragma unroll
            for (int k = 0; k < 2; ++k) { asm volatile("" : "=v"(B0[n][k])); asm volatile("" : "=v"(B1[n][k])); }
        asm volatile("" : "=v"(Ax[0])); asm volatile("" : "=v"(Ax[1])); }
    f32x4 accx[2] = {(f32x4){0.f, 0.f, 0.f, 0.f}, (f32x4){0.f, 0.f, 0.f, 0.f}};
    unsigned cA = (unsigned)cur.pm * tstep, cB = (unsigned)cur.pn * tstep;
    const unsigned xstep = (unsigned)XR * K * 2, xbase = (unsigned)XROW0 * K * 2; unsigned cX = xbase + (unsigned)cur.pm * xstep;
    S.a_ready(cur);
    E.prep(cur, tid);
    if constexpr (SP2) {
        PG8_STAGEB(PG8_SB(0, 0), cB); PG8_STAGEB(PG8_SB(0, 1), cB + hstep); PG8_STAGEA(PG8_SA(0, 0), cA); { const unsigned keep_ = xpw; xpw = 0; PG8_STAGEXP(cX); xpw = keep_; } PG8_STAGEA(PG8_SA(0, 1), cA + hstep);
        if (wr == 1) PG8_BAR;
        PG8_WAIT_V(2); PG8_BAR;
        PG8_STAGEB(PG8_SB(1, 0), cB + kstep); PG8_STAGEA(PG8_SA(1, 0), cA + kstep); PG8_STAGEB(PG8_SB(1, 1), cB + hstep + kstep);
        PG8_WAIT_V(6); PG8_BAR;
    } else {
        PG8_STAGEB(PG8_SB(0, 0), cB); PG8_STAGEA(PG8_SA(0, 0), cA); PG8_STAGEB(PG8_SB(0, 1), cB + hstep); PG8_STAGEA(PG8_SA(0, 1), cA + hstep);
        if (wr == 1) PG8_BAR;
        PG8_WAIT_V(4); PG8_BAR;
        PG8_STAGEB(PG8_SB(1, 0), cB + kstep); PG8_STAGEA(PG8_SA(1, 0), cA + kstep); PG8_STAGEB(PG8_SB(1, 1), cB + hstep + kstep);
        PG8_WAIT_V(6); PG8_BAR;
    }
    for (;;) {
        const bool has_next = S.next(ui + 1, nxt);
        const unsigned nA = has_next ? (unsigned)nxt.pm * tstep : cA, nB = has_next ? (unsigned)nxt.pn * tstep : cB, nX = has_next ? xbase + (unsigned)nxt.pm * xstep : cX;
        for (int t = 0; t < nt; t += 2) {
            const bool last = (t == nt - 2);
            const unsigned a1 = cA + (unsigned)(t + 1) * kstep;
            const unsigned a2 = last ? nA : cA + (unsigned)(t + 2) * kstep, b2 = last ? nB : cB + (unsigned)(t + 2) * kstep;
            const unsigned a3 = a2 + kstep, b3 = b2 + kstep, x2 = last ? nX : cX + (unsigned)(t + 2) * kstep;
            if (last && has_next) S.a_ready(nxt);
            if constexpr (SP2) {
            PG8_LDB(B0, 0, 0); PG8_LDB(B1, 0, 1); PG8_SCHED; PG8_LDA(At, 0, 0); PG8_LDAX(Ax, 0); PG8_STAGEXP(x2); PG8_STAGEA(PG8_SA(1, 1), a1 + hstep);
            PG8_WAIT_LT(9, 8); PG8_WAIT_L(0); PG8_BAR; PG8_MMA(0, 0, At, B0); PG8_MMA(0, 1, At, B1); PG8_MMAX(); PG8_BAR; PG8_SCHED;
            PG8_LDA(At, 0, 1); PG8_STAGEB(PG8_SB(0, 0), b2); PG8_STAGEB(PG8_SB(0, 1), b2 + hstep); PG8_STAGEA(PG8_SA(0, 0), a2);
            PG8_WAIT_LT(9, 8); PG8_WAIT_L(0); PG8_BAR; PG8_MMA(1, 0, At, B0); PG8_MMA(1, 1, At, B1); PG8_BAR; PG8_SCHED;
            PG8_LDB(B0, 1, 0); PG8_LDB(B1, 1, 1); PG8_SCHED; PG8_LDA(At, 1, 0); PG8_LDAX(Ax, 1); PG8_STAGEA(PG8_SA(0, 1), a2 + hstep);
            PG8_WAIT_V(8); PG8_WAIT_L(0); PG8_BAR; PG8_MMA(0, 0, At, B0); PG8_MMA(0, 1, At, B1); PG8_MMAX(); PG8_BAR; PG8_SCHED;
            PG8_LDA(At, 1, 1); PG8_STAGEB(PG8_SB(1, 0), b3); PG8_STAGEB(PG8_SB(1, 1), b3 + hstep); PG8_STAGEA(PG8_SA(1, 0), a3);
            PG8_WAIT_V(8); PG8_WAIT_L(0); PG8_BAR; PG8_MMA(1, 0, At, B0); PG8_MMA(1, 1, At, B1); PG8_BAR; PG8_SCHED;
            xpw ^= 4096u; xoff0 ^= 4096; xoff1 ^= 4096;
            } else {
            PG8_LDB(B0, 0, 0); PG8_SCHED; PG8_LDA(At, 0, 0); PG8_STAGEA(PG8_SA(1, 1), a1 + hstep);
            PG8_WAIT_L(8); PG8_BAR; PG8_WAIT_L(0); PG8_MMA(0, 0, At, B0); PG8_BAR; PG8_SCHED;
            PG8_LDB(B1, 0, 1); PG8_STAGEB(PG8_SB(0, 0), b2);
            PG8_BAR; PG8_WAIT_L(0); PG8_MMA(0, 1, At, B1); PG8_BAR;
            PG8_LDA(At, 0, 1); PG8_STAGEA(PG8_SA(0, 0), a2);
            PG8_BAR; PG8_WAIT_L(0); PG8_MMA(1, 0, At, B0); PG8_BAR; PG8_SCHED;
            PG8_STAGEB(PG8_SB(0, 1), b2 + hstep);
            PG8_WAIT_V(6); PG8_BAR; PG8_MMA(1, 1, At, B1); PG8_BAR;
            PG8_LDB(B0, 1, 0); PG8_SCHED; PG8_LDA(At, 1, 0); PG8_STAGEA(PG8_SA(0, 1), a2 + hstep);
            PG8_WAIT_L(8); PG8_BAR; PG8_WAIT_L(0); PG8_MMA(0, 0, At, B0); PG8_BAR; PG8_SCHED;
            PG8_LDB(B1, 1, 1); PG8_STAGEB(PG8_SB(1, 0), b3);
            PG8_BAR; PG8_WAIT_L(0); PG8_MMA(0, 1, At, B1); PG8_BAR;
            PG8_LDA(At, 1, 1); PG8_STAGEA(PG8_SA(1, 0), a3);
            PG8_BAR; PG8_WAIT_L(0); PG8_MMA(1, 0, At, B0); PG8_BAR; PG8_SCHED;
            PG8_STAGEB(PG8_SB(1, 1), b3 + hstep);
            PG8_WAIT_V(6); PG8_BAR; PG8_MMA(1, 1, At, B1); PG8_BAR;
            }
        }
        if constexpr (ALIGN_EPI) { if (wr == 0) PG8_BAR; }
        asm volatile("s_nop 15\n\ts_nop 15" ::: "memory");
        E(acc, cur, wr, wc, fr, fq); E.rgx(accx, cur, wr, wc, fr, fq);
        if (!has_next) break;
#pragma unroll
        for (int a = 0; a < 2; ++a)
#pragma unroll
            for (int b = 0; b < 2; ++b)
#pragma unroll
                for (int m = 0; m < 4; ++m)
#pragma unroll
                    for (int n = 0; n < 2; ++n) acc[a][b][m][n] = (f32x4){0.f, 0.f, 0.f, 0.f};
        accx[0] = (f32x4){0.f, 0.f, 0.f, 0.f}; accx[1] = (f32x4){0.f, 0.f, 0.f, 0.f};
        cur = nxt; cA = nA; cB = nB; cX = nX; ++ui;
        if constexpr (ALIGN_EPI) { if (wr == 1) PG8_BAR; }
    }
    PG8_WAIT_V(0);
    if constexpr (!ALIGN_EPI) { if (wr == 0) PG8_BAR; }
    PG8_BAR;
#undef PG8_SA
#undef PG8_SB
#undef PG8_STAGEA
#undef PG8_STAGEB
#undef PG8_SX
#undef PG8_STAGEXP
#undef PG8_WAIT_LT
#undef PG8_LDAX
#undef PG8_MMAX
#undef PG8_LDA
#undef PG8_LDB
#undef PG8_MMA
#undef PG8_WAIT_V
#undef PG8_WAIT_L
#undef PG8_BAR
#undef PG8_SCHED
}
}

#define GAS __attribute__((address_space(1)))
#define LAS __attribute__((address_space(3)))
typedef unsigned short bf16;
typedef unsigned v4u __attribute__((ext_vector_type(4)));
typedef float f32x4 __attribute__((ext_vector_type(4)));
typedef short bf16x8 __attribute__((ext_vector_type(8)));
typedef GAS unsigned gu32;
typedef GAS unsigned long long gu64;
#define RLX_AGENT __ATOMIC_RELAXED, __HIP_MEMORY_SCOPE_AGENT
#define LDS_WAIT() asm volatile("s_waitcnt lgkmcnt(0)" ::: "memory")
#define VM_WAIT() asm volatile("s_waitcnt vmcnt(0)" ::: "memory")
__device__ __forceinline__ unsigned long long rt() { return __builtin_amdgcn_s_memrealtime(); }
__device__ __forceinline__ unsigned f2bf(float f) { unsigned u = __builtin_bit_cast(unsigned, f); return (u + 0x7fffu + ((u >> 16) & 1u)) >> 16; }
__device__ __forceinline__ unsigned pk2(float lo, float hi) { return f2bf(lo) | (f2bf(hi) << 16); }

#define XB_TMO      128
#define XB_XCNT(j)  (256  + 64 * (j))
#define XB_XSUB(j)  (1280 + 64 * (j))
#define XB_XGEN(j)  (2304 + 64 * (j))
#define XB_TOP      3328
#define XB_TOPGEN   3392
#define XCD_BAR_WORDS 3456
#define XB_SPIN_CAP (1u << 18)

__device__ __forceinline__ unsigned xb_ld(unsigned* p)              { return __hip_atomic_load(p, __ATOMIC_RELAXED, __HIP_MEMORY_SCOPE_AGENT); }
__device__ __forceinline__ unsigned xb_add(unsigned* p, unsigned v) { return __hip_atomic_fetch_add(p, v, __ATOMIC_RELAXED, __HIP_MEMORY_SCOPE_AGENT); }
__device__ __forceinline__ unsigned xb_xcc_id() { return (unsigned)__builtin_amdgcn_s_getreg((3 << 11) | 20) & 0xFu; }
#define XB_SPIN(cond, bar) do { unsigned _sp = 0; while (cond) { __builtin_amdgcn_s_sleep(1); \
    if ((++_sp & 255u) == 0u) { if (xb_ld(&(bar)[XB_TMO])) break; if (_sp > XB_SPIN_CAP) { atomicAdd(&(bar)[XB_TMO], 1u); break; } } } } while (0)

struct XcdBarrier {
    unsigned* bar; unsigned x; unsigned n;
    volatile LAS unsigned* st;
};

__device__ __forceinline__ XcdBarrier xcd_barrier_post(unsigned* bar, volatile LAS unsigned* st, unsigned n) {
    XcdBarrier b; b.bar = bar; b.x = xb_xcc_id(); b.st = st; b.n = n;
    if (threadIdx.x == 0) (void)xb_add(&bar[XB_XCNT(b.x)], 1u);
    return b;
}
__device__ __forceinline__ void xcd_barrier_complete(unsigned* bar, unsigned x, unsigned G, unsigned& nloc, unsigned& nx) {
    unsigned sum, cnt, mine, sp = 0u;
    for (;;) {
        sum = 0u; cnt = 0u; mine = 0u;
#pragma unroll
        for (unsigned j = 0; j < 16; ++j) { const unsigned c = xb_ld(&bar[XB_XCNT(j)]); sum += c; cnt += (c > 0u) ? 1u : 0u; mine = (j == x) ? c : mine; }
        if (sum == G) break;
        __builtin_amdgcn_s_sleep(1);
        if ((++sp & 255u) == 0u) { if (xb_ld(&bar[XB_TMO])) break; if (sp > XB_SPIN_CAP) { atomicAdd(&bar[XB_TMO], 1u); break; } }
    }
    nloc = mine > 0u ? mine : 1u; nx = cnt > 0u ? cnt : 1u;
}

__device__ __forceinline__ void xcd_barrier(const XcdBarrier& b) {
    asm volatile("s_waitcnt vmcnt(0)" ::: "memory");
    __syncthreads();
    if (threadIdx.x == 0) {
        unsigned* bar = b.bar;
        __builtin_amdgcn_s_waitcnt(0);
        unsigned nloc = b.st[0], nx = b.st[1];
        if (nloc == 0u) { xcd_barrier_complete(bar, b.x, b.n, nloc, nx); b.st[0] = nloc; b.st[1] = nx; }
        const unsigned old = xb_add(&bar[XB_XSUB(b.x)], 1u);
        const unsigned gen = old / nloc;
        if (old + 1u == (gen + 1u) * nloc) {
            __builtin_amdgcn_fence(__ATOMIC_RELEASE, "agent");
            asm volatile("s_waitcnt vmcnt(0)" ::: "memory");
            const unsigned og = xb_add(&bar[XB_TOP], 1u);
            const unsigned tg = og / nx;
            if (og + 1u == (tg + 1u) * nx) xb_add(&bar[XB_TOPGEN], 1u);
            else XB_SPIN(xb_ld(&bar[XB_TOPGEN]) == tg, bar);
            __builtin_amdgcn_fence(__ATOMIC_ACQUIRE, "agent");
            xb_add(&bar[XB_XGEN(b.x)], 1u);
            asm volatile("s_waitcnt vmcnt(0)" ::: "memory");
        } else {
            XB_SPIN(xb_ld(&bar[XB_XGEN(b.x)]) == gen, bar);
            __builtin_amdgcn_fence(__ATOMIC_ACQUIRE, "agent");
            asm volatile("s_waitcnt vmcnt(0)" ::: "memory");
        }
    }
    __syncthreads();
}


constexpr int NWAVES = 8;
#ifndef MK_ONE_LAUNCH
#define MK_ONE_LAUNCH 1
#endif
constexpr int N_PHASES = 15;

constexpr int D = 1024, FF = 4096, MP = 8 * 2048, MS = 128 * 8, M = MP + MS;
constexpr int NG = 64, PS = 64, GS = 16;
constexpr float EPS = 1e-6f;
constexpr size_t O_Y = 0, O_SRP = (size_t)M * D, O_SIP = O_SRP + 8 * 4096, O_CP = O_SIP + 8 * 4096, O_SRS = O_CP + 8 * 2 * 1024, O_SIS = O_SRS + 128 * 4096, O_CS = O_SIS + 128 * 4096, O_END = O_CS + 128 * 2 * 1024;
static_assert(O_END == 19218432, "output size");

constexpr size_t MiB = 1u << 20;
constexpr size_t WS_CTL = 0, CTL_ZERO_BYTES = 1 * MiB;
constexpr size_t WS_SSQ = 112 * MiB;
constexpr size_t WS_SSME = 114 * MiB;
constexpr size_t WS_SSMP = 2 * MiB;
constexpr size_t WS_WGU = 4 * MiB;
constexpr size_t WS_WD = 68 * MiB;
constexpr size_t WS_WGLU = 100 * MiB;
constexpr size_t WS_WIN = 104 * MiB;
constexpr size_t WS_WOUT = 110 * MiB;
constexpr size_t WS_X = 112 * MiB;
constexpr size_t WS_XB = 180 * MiB;
constexpr size_t WS_H = 214 * MiB;
constexpr size_t WS_G = 350 * MiB, WS_A2 = WS_G, WS_Z = 384 * MiB, WS_GB = 418 * MiB;
constexpr size_t WS_END = 452 * MiB;
constexpr int CW_TMO = 0;
constexpr int CW_BAR = 4096;
constexpr int CW_SK = 16384;

constexpr int RING_OFF = 0, RING_BYTES = 131072 + 8192;
constexpr int RSTD_OFF = RING_BYTES;
constexpr int LDSCTL_OFF = RING_BYTES + 4096, MISC_OFF = LDSCTL_OFF + 320;
constexpr int LDS_BYTES = 147456;

struct Frame {
    LAS unsigned char* lds;
    volatile LAS unsigned* MISC;
    gu32* ctl;
    int tid, lane, wave, vcu, G, gi, ci;
    const float* in[21]; float* out; unsigned char* ws;
};

__device__ __forceinline__ void st16_wt(void* p, v4u v) { asm volatile("global_store_dwordx4 %0, %1, off sc1\n\ts_nop 1" :: "v"(p), "v"(v) : "memory"); }
__device__ __forceinline__ void st8_wt(void* p, unsigned long long v) { asm volatile("global_store_dwordx2 %0, %1, off sc1\n\ts_nop 1" :: "v"(p), "v"(v) : "memory"); }
__device__ __forceinline__ int opaque_i(int v) { asm volatile("" : "+v"(v)); return v; }
__device__ __forceinline__ float wave_sum(float v) {
#pragma unroll
    for (int o = 1; o < 64; o <<= 1) v += __shfl_xor(v, o);
    return v;
}
__device__ __forceinline__ float bf2f(unsigned short b) { return __builtin_bit_cast(float, (unsigned)b << 16); }

struct P0Item { const float* W; bf16* WT; const float* gk; int K, N, k0, n0s, n0d; };
__device__ __forceinline__ int pair_src(int nd, int base, int hstride) { return base + ((nd >> 7) & 1) * hstride + 128 * (nd >> 8) + (nd & 127); }
__device__ __forceinline__ P0Item p0_item(Frame& F, int it) {
    constexpr int I_GU = (D / 64) * (2 * FF / 64), I_D = (FF / 64) * (D / 64), I_GLU = (D / 64) * (2 * D / 64), I_IN = (D / 64) * (3 * D / 64);
    const float* norm_g = F.in[5]; P0Item p; int r = it;
    if (r < 4 * I_GU) { const int f = r / I_GU; r -= f * I_GU; const int nb = r % (2 * FF / 64), kb = r / (2 * FF / 64), nd = 64 * nb;
        p.W = F.in[7] + (size_t)f * D * 2 * FF; p.K = D; p.N = 2 * FF; p.WT = (bf16*)(F.ws + WS_WGU) + (size_t)f * 2 * FF * D; p.gk = norm_g + ((f >> 1) * 3 + (f & 1) * 2) * D; p.k0 = 64 * kb; p.n0s = pair_src(nd, 0, FF); p.n0d = nd; return p; }
    r -= 4 * I_GU;
    if (r < 4 * I_D) { const int f = r / I_D; r -= f * I_D; const int nb = r % (D / 64), kb = r / (D / 64), nd = 64 * nb;
        p.W = F.in[8] + (size_t)f * FF * D; p.K = FF; p.N = D; p.WT = (bf16*)(F.ws + WS_WD) + (size_t)f * D * FF; p.gk = nullptr; p.k0 = 64 * kb; p.n0s = nd; p.n0d = nd; return p; }
    r -= 4 * I_D;
    if (r < I_GLU) { const int nb = r % (2 * D / 64), kb = r / (2 * D / 64), nd = 64 * nb;
        p.W = F.in[17]; p.K = D; p.N = 2 * D; p.WT = (bf16*)(F.ws + WS_WGLU); p.gk = nullptr; p.k0 = 64 * kb; p.n0s = pair_src(nd, 0, D); p.n0d = nd; return p; }
    r -= I_GLU;
    if (r < I_IN) { const int nb = r % (3 * D / 64), kb = r / (3 * D / 64), nd = 64 * nb;
        p.W = F.in[18]; p.K = D; p.N = 3 * D; p.WT = (bf16*)(F.ws + WS_WIN); p.gk = norm_g + 4 * D; p.k0 = 64 * kb; p.n0s = nd < 2048 ? pair_src(nd, D, D) : nd - 2048; p.n0d = nd; return p; }
    r -= I_IN;
    { const int nb = r % (D / 64), kb = r / (D / 64), nd = 64 * nb;
        p.W = F.in[20]; p.K = D; p.N = D; p.WT = (bf16*)(F.ws + WS_WOUT); p.gk = nullptr; p.k0 = 64 * kb; p.n0s = nd; p.n0d = nd; return p; }
}
#define P0_LOAD(v, gs, p) do { _Pragma("unroll") for (int i = 0; i < 8; ++i) _Pragma("unroll") for (int s = 0; s < 2; ++s) { \
        v[i][s] = *(const GAS f32x4*)((p).W + (size_t)((p).k0 + 8 * i + 2 * kr + s) * (p).N + (p).n0s + 4 * c); gs[i][s] = (p).gk ? (p).gk[(p).k0 + 8 * i + 2 * kr + s] : 1.0f; } } while (0)
#define P0_PROC(v, gs, p) do { \
        _Pragma("unroll") for (int i = 0; i < 8; ++i) _Pragma("unroll") for (int j = 0; j < 4; ++j) \
            *(LAS unsigned*)(scr + (4 * c + j) * 128 + (((4 * i + kr) ^ ((c & 7) << 2)) << 2)) = pg8::cvt_pk_bf16(v[i][0][j] * gs[i][0], v[i][1][j] * gs[i][1]); \
        LDS_WAIT(); asm volatile("" ::: "memory"); \
        _Pragma("unroll") for (int i = 0; i < 8; ++i) { const int n = nr + 8 * i; const v4u o = *(const LAS v4u*)(scr + n * 128 + ((q ^ ((n >> 2) & 7)) << 4)); \
            st16_wt((p).WT + (size_t)((p).n0d + n) * (p).K + (p).k0 + 8 * q, o); } \
        LDS_WAIT(); asm volatile("" ::: "memory"); } while (0)

__device__ __forceinline__ void p0_prologue(Frame& F) {
    LAS unsigned char* scr = F.lds + RING_OFF + F.wave * 16384;
    const int gw = F.vcu * NWAVES + F.wave, NGW = F.G * NWAVES, lane = opaque_i(F.lane);
    constexpr int NITEMS = 4 * (D / 64) * (2 * FF / 64) + 4 * (FF / 64) * (D / 64) + (D / 64) * (2 * D / 64) + (D / 64) * (3 * D / 64) + (D / 64) * (D / 64);
    { const int kr = lane >> 4, c = lane & 15, nr = lane >> 3, q = lane & 7;
      f32x4 va[8][2], vb[8][2]; float ga[8][2], gb[8][2];
      int it = gw; P0Item pa = p0_item(F, it < NITEMS ? it : 0), pb = pa;
      if (it < NITEMS) P0_LOAD(va, ga, pa);
      while (it < NITEMS) {
          const int it1 = it + NGW; if (it1 < NITEMS) { pb = p0_item(F, it1); P0_LOAD(vb, gb, pb); }
          P0_PROC(va, ga, pa);
          if (it1 >= NITEMS) break;
          const int it2 = it1 + NGW; if (it2 < NITEMS) { pa = p0_item(F, it2); P0_LOAD(va, ga, pa); }
          P0_PROC(vb, gb, pb);
          it = it2;
      }
    }
    bf16* XB = (bf16*)(F.ws + WS_XB); pg8::ssq_t* ssq = (pg8::ssq_t*)(F.ws + WS_SSQ);
    for (int m0 = gw; m0 < M; m0 += 4 * NGW) {
        f32x4 v[4][4];
#pragma unroll
        for (int r = 0; r < 4; ++r) { const int m = m0 + r * NGW; if (m < M) { const float* src = m < MP ? F.in[0] + (size_t)m * D : F.in[1] + (size_t)(m - MP) * D;
#pragma unroll
            for (int j = 0; j < 4; ++j) v[r][j] = ((const GAS f32x4*)src)[lane + 64 * j]; } }
#pragma unroll
        for (int r = 0; r < 4; ++r) { const int m = m0 + r * NGW; if (m < M) {
            float s = 0.f;
#pragma unroll
            for (int j = 0; j < 4; ++j) { const f32x4 w = v[r][j]; s += (w.x * w.x + w.y * w.y) + (w.z * w.z + w.w * w.w);
                st8_wt(XB + (size_t)m * D + 4 * (lane + 64 * j), (unsigned long long)pg8::cvt_pk_bf16(w.x, w.y) | ((unsigned long long)pg8::cvt_pk_bf16(w.z, w.w) << 32)); }
            s = wave_sum(s);
            if (lane == 0) ssq[m] = pg8::ssq_fix(s); } }
    }
    for (int i = gw * 64 + lane; i < 7 * M; i += NGW * 64) ssq[M + i] = 0ull;
    float* sp = (float*)(F.ws + WS_SSMP);
    for (int i = gw * 64 + lane; i < NG * PS; i += NGW * 64) {
        const int g = i / PS;
        const float lr = F.in[9][i], li = F.in[10][i], dt = expf(F.in[11][g]);
        const float mag = expf(lr * dt); float sn, cs; sincosf(li * dt, &sn, &cs);
        const float lbr = mag * cs, lbi = mag * sn, den = lr * lr + li * li, nr = lbr - 1.0f, ni = lbi;
        const float fr = (nr * lr + ni * li) / den, fi = (ni * lr - nr * li) / den;
        sp[i] = lbr; sp[4096 + i] = lbi;
#pragma unroll
        for (int c = 0; c < GS; ++c) { const float br = F.in[12][(size_t)i * GS + c], bi = F.in[13][(size_t)i * GS + c];
            sp[8192 + (size_t)i * GS + c] = fr * br - fi * bi; sp[8192 + 65536 + (size_t)i * GS + c] = fr * bi + fi * br; }
    }
}

__device__ __forceinline__ float gelu_tanh(float x) {
    const float a = 0.7978845608028654f * (x + 0.044715f * x * x * x);
    return x * __builtin_amdgcn_rcpf(1.0f + __builtin_amdgcn_exp2f(-2.0f * 1.4426950408889634f * a));
}


typedef float f32x16 __attribute__((ext_vector_type(16)));
typedef unsigned u32x2v __attribute__((ext_vector_type(2)));
__device__ __forceinline__ unsigned cvtpk(float lo, float hi) { unsigned r; asm volatile("v_cvt_pk_bf16_f32 %0, %1, %2" : "=v"(r) : "v"(lo), "v"(hi)); return r; }
__device__ __forceinline__ bf16x8 pack8(const float* v) { v4u w; w.x = cvtpk(v[0], v[1]); w.y = cvtpk(v[2], v[3]); w.z = cvtpk(v[4], v[5]); w.w = cvtpk(v[6], v[7]); return __builtin_bit_cast(bf16x8, w); }
__device__ __forceinline__ float fma_s(float a, float b, float c) { float r; asm("v_fma_f32 %0, %1, %2, %3" : "=v"(r) : "v"(a), "v"(b), "v"(c)); return r; }
constexpr int SSM_ROWB = 272;
constexpr int SSM_NCH = 8, SSM_CHB = 8;
#define BFLO(w) __builtin_bit_cast(float, (w) << 16)
#define BFHI(w) __builtin_bit_cast(float, (w) & 0xffff0000u)

template <int MODE, int NI>
__device__ __forceinline__ void ssm_run(Frame& F, LAS unsigned char* img0, int lane, int g, const int (&row_base)[NI], int nblk, bool sample, int seq0, float (&hr)[NI], float (&hi)[NI]) {
    const bf16* X = (const bf16*)(F.ws + WS_XB); const pg8::ssq_t* ssq = (const pg8::ssq_t*)(F.ws + WS_SSQ) + 1 * M;
    const float* sp = (const float*)(F.ws + WS_SSMP); bf16* Gb = (bf16*)(F.ws + WS_G);
    const float* g1 = F.in[5] + 1 * D; const float* dsk = F.in[16];
    const int l31 = lane & 31, h = lane >> 5, l15 = lane & 15, q4 = lane >> 4;
    bf16x8 bbq[4];
#pragma unroll
    for (int q = 0; q < 4; ++q) { const int p = 32 * (q & 1) + l31; const float* src = sp + 8192 + (q >> 1) * 65536 + ((size_t)(g * PS + p) * GS + 8 * h);
        float v[8];
#pragma unroll
        for (int j = 0; j < 8; ++j) v[j] = src[j] * g1[g * GS + 8 * h + j];
        bbq[q] = pack8(v); }
    bf16x8 cm[4]; float dg[4];
    if (MODE == 1) {
#pragma unroll
        for (int ks = 0; ks < 4; ++ks) { const int p0 = 16 * ks + 4 * q4; const float* cr = F.in[14] + ((size_t)(g * GS + l15) * PS + p0); const float* ci = F.in[15] + ((size_t)(g * GS + l15) * PS + p0);
            float v[8];
#pragma unroll
            for (int j = 0; j < 4; ++j) { v[2 * j] = cr[j]; v[2 * j + 1] = -ci[j]; }
            cm[ks] = pack8(v); }
#pragma unroll
        for (int e = 0; e < 4; ++e) dg[e] = dsk[g * GS + 4 * q4 + e] * g1[g * GS + 4 * q4 + e];
    }
    const float lbr = sp[g * PS + lane], lbi = sp[4096 + g * PS + lane], nlbi = -lbi;
    float s0r[4], s0i[4];
    if (sample) {
#pragma unroll
        for (int i = 0; i < 4; ++i) { s0r[i] = F.in[2][((size_t)(seq0 + i) * NG + g) * PS + lane]; s0i[i] = F.in[3][((size_t)(seq0 + i) * NG + g) * PS + lane]; } }
    else {
#pragma unroll
        for (int i = 0; i < 4; ++i) { s0r[i] = 0.f; s0i[i] = 0.f; } }
    v4u xaw[NI]; u32x2v xew0[NI], xew1[NI]; pg8::ssq_t qa[NI], qe0[NI], qe1[NI];
#define SSM_LOAD(b) do { _Pragma("unroll") for (int j = 0; j < NI; ++j) { const int rowA = row_base[j] + 32 * (b) + l31; xaw[j] = *(const GAS v4u*)(X + (size_t)rowA * D + g * GS + 8 * h); qa[j] = ssq[rowA]; \
        if (MODE == 1) { const int rowE = row_base[j] + 32 * (b) + l15; xew0[j] = *(const GAS u32x2v*)(X + (size_t)rowE * D + g * GS + 4 * q4); xew1[j] = *(const GAS u32x2v*)(X + (size_t)(rowE + 16) * D + g * GS + 4 * q4); qe0[j] = ssq[rowE]; qe1[j] = ssq[rowE + 16]; } \
        else { qe0[j] = 0; qe1[j] = 0; } } } while (0)
    SSM_LOAD(0);
    for (int b = 0; b < nblk; ++b) {
        f32x4 ca0[NI], ca1[NI], ce0[NI], ce1[NI]; pg8::ssq_t cqa[NI], cqe0[NI], cqe1[NI];
#pragma unroll
        for (int j = 0; j < NI; ++j) { ca0[j] = (f32x4){BFLO(xaw[j].x), BFHI(xaw[j].x), BFLO(xaw[j].y), BFHI(xaw[j].y)}; ca1[j] = (f32x4){BFLO(xaw[j].z), BFHI(xaw[j].z), BFLO(xaw[j].w), BFHI(xaw[j].w)};
            if (MODE == 1) { ce0[j] = (f32x4){BFLO(xew0[j].x), BFHI(xew0[j].x), BFLO(xew0[j].y), BFHI(xew0[j].y)}; ce1[j] = (f32x4){BFLO(xew1[j].x), BFHI(xew1[j].x), BFLO(xew1[j].y), BFHI(xew1[j].y)}; }
            cqa[j] = qa[j]; cqe0[j] = qe0[j]; cqe1[j] = qe1[j]; }
        if (b + 1 < nblk) SSM_LOAD(b + 1);
        f32x16 Xr[NI], Yr[NI], Xi[NI], Yi[NI];
#pragma unroll
        for (int j = 0; j < NI; ++j) {
            const float rsa = pg8::rstd_of(cqa[j]);
            float ua[8];
#pragma unroll
            for (int e = 0; e < 4; ++e) { ua[e] = ca0[j][e] * rsa; ua[4 + e] = ca1[j][e] * rsa; }
            const bf16x8 ufrag = pack8(ua);
            const f32x16 zero16 = {0.f, 0.f, 0.f, 0.f, 0.f, 0.f, 0.f, 0.f, 0.f, 0.f, 0.f, 0.f, 0.f, 0.f, 0.f, 0.f};
            Xr[j] = __builtin_amdgcn_mfma_f32_32x32x16_bf16(ufrag, bbq[0], zero16, 0, 0, 0);
            Yr[j] = __builtin_amdgcn_mfma_f32_32x32x16_bf16(ufrag, bbq[1], zero16, 0, 0, 0);
            Xi[j] = __builtin_amdgcn_mfma_f32_32x32x16_bf16(ufrag, bbq[2], zero16, 0, 0, 0);
            Yi[j] = __builtin_amdgcn_mfma_f32_32x32x16_bf16(ufrag, bbq[3], zero16, 0, 0, 0); }
#pragma unroll
        for (int j = 0; j < NI; ++j)
#pragma unroll
            for (int r = 0; r < 16; ++r) {
                auto s1 = __builtin_amdgcn_permlane32_swap(__float_as_uint(Xr[j][r]), __float_as_uint(Yr[j][r]), false, false); Xr[j][r] = __uint_as_float(s1[0]); Yr[j][r] = __uint_as_float(s1[1]);
                auto s2 = __builtin_amdgcn_permlane32_swap(__float_as_uint(Xi[j][r]), __float_as_uint(Yi[j][r]), false, false); Xi[j][r] = __uint_as_float(s2[0]); Yi[j][r] = __uint_as_float(s2[1]); }
#pragma unroll
        for (int i = 0; i < 4; ++i) {
            if (sample) { hr[0] = s0r[i]; hi[0] = s0i[i]; }
#pragma unroll
            for (int s = 0; s < 2; ++s)
#pragma unroll
                for (int e = 0; e < 4; ++e)
#pragma unroll
                    for (int j = 0; j < NI; ++j) { const int r = 4 * i + e; const float br = s ? Yr[j][r] : Xr[j][r], bi = s ? Yi[j][r] : Xi[j][r];
                        const float nr = fma_s(lbr, hr[j], fma_s(nlbi, hi[j], br)), ni = fma_s(lbr, hi[j], fma_s(lbi, hr[j], bi)); hr[j] = nr; hi[j] = ni;
                        if (MODE == 1) *(LAS unsigned*)(img0 + j * (32 * SSM_ROWB) + (8 * i + 4 * s + e) * SSM_ROWB + 4 * lane) = cvtpk(nr, ni); }
            if (sample) { F.out[O_SRS + ((size_t)(seq0 + i) * NG + g) * PS + lane] = hr[0]; F.out[O_SIS + ((size_t)(seq0 + i) * NG + g) * PS + lane] = hi[0]; }
        }
        if (MODE == 1) {
#pragma unroll
            for (int j = 0; j < NI; ++j) {
                const LAS unsigned char* img = img0 + j * (32 * SSM_ROWB);
                f32x4 acc0 = {0.f, 0.f, 0.f, 0.f}, acc1 = {0.f, 0.f, 0.f, 0.f};
#pragma unroll
                for (int ks = 0; ks < 4; ++ks) {
                    const bf16x8 b0 = *(const LAS bf16x8*)(img + l15 * SSM_ROWB + 64 * ks + 16 * q4);
                    const bf16x8 b1 = *(const LAS bf16x8*)(img + (16 + l15) * SSM_ROWB + 64 * ks + 16 * q4);
                    acc0 = __builtin_amdgcn_mfma_f32_16x16x32_bf16(cm[ks], b0, acc0, 0, 0, 0);
                    acc1 = __builtin_amdgcn_mfma_f32_16x16x32_bf16(cm[ks], b1, acc1, 0, 0, 0); }
                const float rse0 = pg8::rstd_of(cqe0[j]), rse1 = pg8::rstd_of(cqe1[j]);
                float o0[4], o1[4];
#pragma unroll
                for (int e = 0; e < 4; ++e) { o0[e] = gelu_tanh(acc0[e] + dg[e] * ce0[j][e] * rse0); o1[e] = gelu_tanh(acc1[e] + dg[e] * ce1[j][e] * rse1); }
                const int rowE = row_base[j] + 32 * b + l15;
                u32x2v w0, w1; w0.x = cvtpk(o0[0], o0[1]); w0.y = cvtpk(o0[2], o0[3]); w1.x = cvtpk(o1[0], o1[1]); w1.y = cvtpk(o1[2], o1[3]);
                st8_wt(Gb + (size_t)rowE * D + g * GS + 4 * q4, (unsigned long long)w0.x | ((unsigned long long)w0.y << 32));
                st8_wt(Gb + (size_t)(rowE + 16) * D + g * GS + 4 * q4, (unsigned long long)w1.x | ((unsigned long long)w1.y << 32)); }
        }
    }
#undef SSM_LOAD
}

__device__ __forceinline__ void ssm_phase_pass(Frame& F, int pass) {
    LAS unsigned char* img = F.lds + RING_OFF + F.wave * (2 * 32 * SSM_ROWB);
    const int lane = opaque_i(F.lane), s = F.wave * 32 + F.ci, g = s & 63, c0 = s >> 6;
    float* E = (float*)(F.ws + WS_SSME) + ((size_t)(F.gi * NG + g) * SSM_NCH) * 2 * PS;
    const int rb[2] = {F.gi * 2048 + c0 * (SSM_CHB * 32), F.gi * 2048 + (c0 + 4) * (SSM_CHB * 32)};
    if (pass == 0) {
        float hr[2] = {0.f, 0.f}, hi[2] = {0.f, 0.f};
        ssm_run<0, 2>(F, img, lane, g, rb, SSM_CHB, false, 0, hr, hi);
#pragma unroll
        for (int j = 0; j < 2; ++j) { E[((c0 + 4 * j) * 2 + 0) * PS + lane] = hr[j]; E[((c0 + 4 * j) * 2 + 1) * PS + lane] = hi[j]; }
        float sr[1] = {0.f}, si[1] = {0.f}; const int rs[1] = {MP + 128 * F.gi + 32 * c0};
        ssm_run<1, 1>(F, img, lane, g, rs, 1, true, 16 * F.gi + 4 * c0, sr, si);
    } else {
        const float* sp = (const float*)(F.ws + WS_SSMP);
        float ar = sp[g * PS + lane], ai = sp[4096 + g * PS + lane];
#pragma unroll
        for (int k = 0; k < 8; ++k) { const float nr = ar * ar - ai * ai, ni = 2.0f * ar * ai; ar = nr; ai = ni; }
        float hr[2] = {0.f, 0.f}, hi[2] = {0.f, 0.f}; float tr = 0.f, ti = 0.f;
        for (int j = 0; j < c0 + 4; ++j) { const float er = E[(j * 2 + 0) * PS + lane], ei = E[(j * 2 + 1) * PS + lane];
            const float nr = ar * tr - ai * ti + er, ni = ar * ti + ai * tr + ei; tr = nr; ti = ni;
            if (j + 1 == c0) { hr[0] = tr; hi[0] = ti; } }
        hr[1] = tr; hi[1] = ti;
        ssm_run<1, 2>(F, img, lane, g, rb, SSM_CHB, false, 0, hr, hi);
        if (c0 == 3) { F.out[O_SRP + ((size_t)F.gi * NG + g) * PS + lane] = hr[1]; F.out[O_SIP + ((size_t)F.gi * NG + g) * PS + lane] = hi[1]; }
    }
}
#undef BFLO
#undef BFHI

__device__ __forceinline__ void conv_phase(Frame& F) {
    const bf16* Z = (const bf16*)(F.ws + WS_Z); const bf16* GBp = (const bf16*)(F.ws + WS_GB); bf16* A2 = (bf16*)(F.ws + WS_A2);
    const float* cw = F.in[19]; const float* cache = F.in[4];
    const int gt = (F.ci * NWAVES + F.wave) * 64 + opaque_i(F.lane), NGT = 32 * NWAVES * 64;
    for (int it = gt; it < (2048 + 128) * (D / 8); it += NGT) {
        const int lr = it >> 7, row = lr < 2048 ? F.gi * 2048 + lr : MP + F.gi * 128 + (lr - 2048), c0 = (it & 127) * 8;
        int t; const float* cb = nullptr;
        if (row < MP) t = row & 2047; else { const int r2 = row - MP; t = r2 & 7; cb = cache + (size_t)(r2 >> 3) * 2 * D; }
        float z0[8], z1[8], z2[8], gb[8];
        { const v4u v = *(const GAS v4u*)(Z + (size_t)row * D + c0); const v4u q = *(const GAS v4u*)(GBp + (size_t)row * D + c0);
#pragma unroll
          for (int e = 0; e < 4; ++e) { z2[2 * e] = __builtin_bit_cast(float, v[e] << 16); z2[2 * e + 1] = __builtin_bit_cast(float, v[e] & 0xffff0000u);
                                        gb[2 * e] = __builtin_bit_cast(float, q[e] << 16); gb[2 * e + 1] = __builtin_bit_cast(float, q[e] & 0xffff0000u); } }
        if (t >= 1) { const v4u v = *(const GAS v4u*)(Z + (size_t)(row - 1) * D + c0);
#pragma unroll
          for (int e = 0; e < 4; ++e) { z1[2 * e] = __builtin_bit_cast(float, v[e] << 16); z1[2 * e + 1] = __builtin_bit_cast(float, v[e] & 0xffff0000u); } }
        else {
#pragma unroll
          for (int e = 0; e < 8; ++e) z1[e] = cb ? cb[D + c0 + e] : 0.f; }
        if (t >= 2) { const v4u v = *(const GAS v4u*)(Z + (size_t)(row - 2) * D + c0);
#pragma unroll
          for (int e = 0; e < 4; ++e) { z0[2 * e] = __builtin_bit_cast(float, v[e] << 16); z0[2 * e + 1] = __builtin_bit_cast(float, v[e] & 0xffff0000u); } }
        else {
#pragma unroll
          for (int e = 0; e < 8; ++e) z0[e] = cb ? cb[t * D + c0 + e] : 0.f; }
        float o[8];
#pragma unroll
        for (int e = 0; e < 8; ++e) o[e] = gb[e] * (cw[c0 + e] * z0[e] + cw[D + c0 + e] * z1[e] + cw[2 * D + c0 + e] * z2[e]);
        v4u w; w.x = pk2(o[0], o[1]); w.y = pk2(o[2], o[3]); w.z = pk2(o[4], o[5]); w.w = pk2(o[6], o[7]);
        st16_wt(A2 + (size_t)row * D + c0, w);
    }
}

__device__ __forceinline__ void final_phase(Frame& F) {
    const bf16* XBp = (const bf16*)(F.ws + WS_XB); const pg8::ssq_t* ssq = (const pg8::ssq_t*)(F.ws + WS_SSQ) + 6 * M; const float* fg = F.in[6];
    const int gw = F.ci * NWAVES + F.wave, NGW = 32 * NWAVES, lane = opaque_i(F.lane);
    f32x4 gv[4];
#pragma unroll
    for (int j = 0; j < 4; ++j) gv[j] = ((const GAS f32x4*)fg)[lane + 64 * j];
    for (int lr = gw; lr < 2048 + 128; lr += NGW) { const int m = lr < 2048 ? F.gi * 2048 + lr : MP + F.gi * 128 + (lr - 2048);
        const float rs = pg8::rstd_of(ssq[m]);
        const GAS unsigned long long* xr = (const GAS unsigned long long*)(XBp + (size_t)m * D) + lane; GAS f32x4* yo = (GAS f32x4*)(F.out + O_Y + (size_t)m * D) + lane;
#pragma unroll
        for (int j = 0; j < 4; ++j) { const unsigned long long w = xr[64 * j]; const unsigned lo = (unsigned)w, hi = (unsigned)(w >> 32);
            const f32x4 xv = {__builtin_bit_cast(float, lo << 16), __builtin_bit_cast(float, lo & 0xffff0000u), __builtin_bit_cast(float, hi << 16), __builtin_bit_cast(float, hi & 0xffff0000u)};
            yo[64 * j] = xv * rs * gv[j]; }
    }
}

struct SameOrder : pg8::StaticOrder { __device__ bool next(int i, pg8::Unit& u) const { const bool r = pg8::StaticOrder::next(i, u); u.pm = 0; u.pn = 0; return r; } };
struct Args { const float* in[21]; float* out; unsigned char* ws; int ph_lo, ph_hi; };
__global__ void __launch_bounds__(NWAVES * 64, 2) skel_fwd(Args args) {
    extern __shared__ __attribute__((aligned(16))) unsigned char lds[];
    Frame F;
    F.lds = (LAS unsigned char*)lds;
    F.MISC = (volatile LAS unsigned*)(F.lds + MISC_OFF);
    F.tid = threadIdx.x; F.lane = F.tid & 63; F.wave = __builtin_amdgcn_readfirstlane(F.tid >> 6);
    F.G = gridDim.x; { const int bx = blockIdx.x; F.vcu = (bx % 8) * (F.G / 8) + bx / 8; F.gi = bx % 8; F.ci = bx / 8; }
    F.ws = args.ws; F.out = args.out; F.ctl = (gu32*)(args.ws + WS_CTL);
#pragma unroll
    for (int i = 0; i < 21; ++i) F.in[i] = args.in[i];
    for (int u = F.tid; u < (LDS_BYTES - LDSCTL_OFF) / 4; u += NWAVES * 64) ((LAS unsigned*)(F.lds + LDSCTL_OFF))[u] = 0u;
    __syncthreads();
    XcdBarrier bar = xcd_barrier_post((unsigned*)(F.ctl + CW_BAR), F.MISC + 8, (unsigned)F.G);
    XcdBarrier gbar = xcd_barrier_post((unsigned*)(F.ctl + CW_BAR) + (1 + F.gi) * XCD_BAR_WORDS, F.MISC + 10, (unsigned)(F.G / 8));
    const int lo = args.ph_lo, hi = args.ph_hi;
#define IN(k) (lo <= (k) && (k) < hi)
#if defined(PROBE_A_LO)
#define STAMP(k) do { if (blockIdx.x == 0 && F.tid == 0) { const unsigned long long t_ = __builtin_amdgcn_s_memrealtime(); F.MISC[16 + 2 * (k)] = (unsigned)t_; F.MISC[17 + 2 * (k)] = (unsigned)(t_ >> 32); } } while (0)
#else
#define STAMP(k) do { } while (0)
#endif
    STAMP(0);
#define SEAM(k) do { if (IN((k) + 1)) { if ((k) == 0) xcd_barrier(bar); else xcd_barrier(gbar); } STAMP((k) + 1); } while (0)
    bf16* XB = (bf16*)(F.ws + WS_XB); bf16* H = (bf16*)(F.ws + WS_H); pg8::ssq_t* ssq = (pg8::ssq_t*)(F.ws + WS_SSQ);
    const int bx = (int)blockIdx.x;

    if (IN(0)) { p0_prologue(F); SEAM(0); }
#define FFN_GU(ph, f, sin) if (IN(ph)) { pg8::Gemm g{XB, (const bf16*)(F.ws + WS_WGU) + (size_t)(f) * 2 * FF * D, M, 2 * FF, D}; pg8::StaticOrder S; S.init(MP, 2 * FF, F.G, bx); \
        pg8::EpiGateUp E{H, FF, ssq + (size_t)(sin) * M, (LAS float*)(F.lds + RSTD_OFF)}; pg8::gemm_phase<pg8::EpiGateUp, pg8::StaticOrder, true, true>(F.lds + RING_OFF, g, S, E); SEAM(ph); }
#define FFN_DN(ph, f, sout) if (IN(ph)) { pg8::Gemm g{H, (const bf16*)(F.ws + WS_WD) + (size_t)(f) * D * FF, M, D, FF}; pg8::StaticOrder S; S.init(MP, D, F.G, bx); \
        pg8::EpiResid<0> E{(ph) == 2 ? F.in[0] : nullptr, (ph) == 2 ? F.in[1] : nullptr, XB, ssq + (size_t)(sout) * M, 0.5f}; pg8::gemm_phase<pg8::EpiResid<0>, pg8::StaticOrder, true, true>(F.lds + RING_OFF, g, S, E); SEAM(ph); }
    FFN_GU(1, 0, 0)
    FFN_DN(2, 0, 1)
#if defined(PROBE_SSM)
    if (IN(3)) { ssm_phase_pass(F, 0); if (PROBE_SSM == 1) { xcd_barrier(gbar); ssm_phase_pass(F, 0); } xcd_barrier(gbar); ssm_phase_pass(F, 1); if (PROBE_SSM == 2) { xcd_barrier(gbar); ssm_phase_pass(F, 1); } SEAM(3); }
#else
    if (IN(3)) { ssm_phase_pass(F, 0); xcd_barrier(gbar); ssm_phase_pass(F, 1); SEAM(3); }
#endif
    if (IN(4)) { pg8::Gemm g{(const bf16*)(F.ws + WS_G), (const bf16*)(F.ws + WS_WGLU), M, 2 * D, D}; pg8::StaticOrder S; S.init(MP, 2 * D, F.G, bx);
        pg8::EpiResid<1> E{nullptr, nullptr, XB, ssq + (size_t)2 * M, 1.0f}; pg8::gemm_phase<pg8::EpiResid<1>, pg8::StaticOrder, true, true>(F.lds + RING_OFF, g, S, E); SEAM(4); }
    FFN_GU(5, 1, 2)
    FFN_DN(6, 1, 3)
    FFN_GU(7, 2, 3)
    FFN_DN(8, 2, 4)
    if (IN(9)) { pg8::Gemm g{XB, (const bf16*)(F.ws + WS_WIN), M, 3 * D, D}; pg8::StaticOrder S; S.init(MP, 3 * D, F.G, bx);
        pg8::EpiConvIn E{(bf16*)(F.ws + WS_Z), (bf16*)(F.ws + WS_GB), ssq + (size_t)4 * M, F.out + O_CP, F.out + O_CS, (LAS float*)(F.lds + RSTD_OFF)};
        pg8::gemm_phase<pg8::EpiConvIn, pg8::StaticOrder, true, true>(F.lds + RING_OFF, g, S, E); SEAM(9); }
    if (IN(10)) { conv_phase(F); SEAM(10); }
    if (IN(11)) { pg8::Gemm g{(const bf16*)(F.ws + WS_A2), (const bf16*)(F.ws + WS_WOUT), M, D, D}; pg8::StaticOrder S; S.init(MP, D, F.G, bx);
        pg8::EpiResid<0> E{nullptr, nullptr, XB, ssq + (size_t)5 * M, 1.0f}; pg8::gemm_phase<pg8::EpiResid<0>, pg8::StaticOrder, true, true>(F.lds + RING_OFF, g, S, E); SEAM(11); }
    FFN_GU(12, 3, 5)
    FFN_DN(13, 3, 6)
    if (IN(14)) { final_phase(F); }
#if defined(PROBE_DRY)
#ifndef PROBE_VARIANT
#define PROBE_VARIANT 0
#endif
    xcd_barrier(gbar); STAMP(15); if (blockIdx.x == 0 && F.tid == 0) { const unsigned long long c_ = __builtin_amdgcn_s_memtime(); F.MISC[60] = (unsigned)c_; F.MISC[61] = (unsigned)(c_ >> 32); }
#if PROBE_DRY == 2
    { pg8::Gemm g{XB, (const bf16*)(F.ws + WS_WGU), M, 2 * FF, D}; SameOrder S; S.init(MP, 2 * FF, F.G, bx);
      pg8::EpiNull E{H + (size_t)M * FF - 1}; pg8::gemm_phase<pg8::EpiNull, SameOrder, true, true>(F.lds + RING_OFF, g, S, E); }
#else
#if PROBE_DRY == 3
    { pg8::Gemm g{XB, (const bf16*)(F.ws + WS_WGU) + (size_t)3 * 2 * FF * D, M, 2 * FF, D}; pg8::StaticOrder S; S.init(MP, 2 * FF, F.G, bx);
      pg8::EpiGateUp E{H, FF, ssq + (size_t)5 * M, (LAS float*)(F.lds + RSTD_OFF)}; pg8::gemm_phase<pg8::EpiGateUp, pg8::StaticOrder, true, true, PROBE_VARIANT>(F.lds + RING_OFF, g, S, E); }
#else
    { pg8::Gemm g{XB, (const bf16*)(F.ws + WS_WGU), M, 2 * FF, D}; pg8::StaticOrder S; S.init(MP, 2 * FF, F.G, bx);
      pg8::EpiNull E{H + (size_t)M * FF - 1}; pg8::gemm_phase<pg8::EpiNull, pg8::StaticOrder, true, true, PROBE_VARIANT>(F.lds + RING_OFF, g, S, E); }
#endif
#endif
    xcd_barrier(gbar); STAMP(16); if (blockIdx.x == 0 && F.tid == 0) { const unsigned long long c_ = __builtin_amdgcn_s_memtime(); F.MISC[62] = (unsigned)c_; F.MISC[63] = (unsigned)(c_ >> 32); }
#endif
#if defined(PROBE_A_LO)
    __syncthreads();
    if (blockIdx.x == 0 && F.tid == 0) {
#if !defined(PROBE_DRY)
        STAMP(15);
#endif
#define TS(k) ((unsigned long long)F.MISC[16 + 2 * (k)] | ((unsigned long long)F.MISC[17 + 2 * (k)] << 32))
        const unsigned long long ta = TS(PROBE_A_HI) - TS(PROBE_A_LO), tb = TS(PROBE_B_HI) - TS(PROBE_B_LO);
#if defined(PROBE_CLOCK)
        { const unsigned long long c0 = (unsigned long long)F.MISC[60] | ((unsigned long long)F.MISC[61] << 32), c1 = (unsigned long long)F.MISC[62] | ((unsigned long long)F.MISC[63] << 32);
          F.out[0] += (float)(c1 - c0) / (float)(TS(16) - TS(15)) * 1e-2f; }
#else
        F.out[0] += (float)tb * 1e-5f;
#endif
        const unsigned long long t0 = __builtin_amdgcn_s_memrealtime();
        const unsigned long long spin = ta * 4ull < 1000000ull ? ta * 4ull : 1000000ull;
        while (__builtin_amdgcn_s_memrealtime() - t0 < spin) __builtin_amdgcn_s_sleep(8);
    }
#endif
#undef IN
#undef SEAM
}

extern "C" void kernel_launch(void* const* d_in, const int* in_sizes, int n_in, void* d_out, int out_size, void* d_ws, size_t ws_size, hipStream_t stream) {
    static int grid = 0;
    if (grid == 0) {
        if (n_in != 21 || out_size != (int)O_END || ws_size < WS_END) { fprintf(stderr, "kernel_launch: unexpected shapes: n_in %d out %d ws %zu; nothing launched\n", n_in, out_size, ws_size); grid = -1; return; }
        int dev = 0, cus = 0, per_cu = 0;
        if (hipGetDevice(&dev) != hipSuccess || hipDeviceGetAttribute(&cus, hipDeviceAttributeMultiprocessorCount, dev) != hipSuccess) { grid = -1; return; }
        if (hipFuncSetAttribute((const void*)skel_fwd, hipFuncAttributeMaxDynamicSharedMemorySize, LDS_BYTES) != hipSuccess) { fprintf(stderr, "kernel_launch: hipFuncSetAttribute failed\n"); grid = -1; return; }
        if (hipOccupancyMaxActiveBlocksPerMultiprocessor(&per_cu, (const void*)skel_fwd, NWAVES * 64, LDS_BYTES) != hipSuccess || per_cu < 1) fprintf(stderr, "kernel_launch: occupancy query reports %d\n", per_cu);
        (void)hipGetLastError();
        if (cus < 256) { fprintf(stderr, "kernel_launch: built for a 256-CU device (8 groups x 32 workgroups), found %d CUs; nothing launched\n", cus); grid = -1; return; }
        grid = 256;
    }
    if (grid < 0) return;
    if (hipMemsetAsync((char*)d_ws + WS_CTL, 0, CTL_ZERO_BYTES, stream) != hipSuccess) return;
    Args a{};
    for (int i = 0; i < 21; ++i) a.in[i] = (const float*)d_in[i];
    a.out = (float*)d_out; a.ws = (unsigned char*)d_ws;
    a.ph_lo = 0; a.ph_hi = N_PHASES;
    hipLaunchKernelGGL(skel_fwd, dim3(grid), dim3(NWAVES * 64), LDS_BYTES, stream, a);
}
```

```cpp
#include <hip/hip_runtime.h>
#include <cstdio>
#include <cstdint>
namespace pg8 {
#define PG8_LAS __attribute__((address_space(3)))
typedef unsigned short bf16_t;
typedef short bf16x8 __attribute__((ext_vector_type(8)));
typedef float f32x4 __attribute__((ext_vector_type(4)));
typedef unsigned u32x4 __attribute__((ext_vector_type(4)));
constexpr int BM = 256, BK = 64, HALF = 128, HTB = HALF * BK * 2  , STAGE_BYTES = 8 * HTB, NXCD = 8, WGM = 8;

__host__ __device__ __forceinline__ int lds_byte(int r, int c) { const int st = (r >> 4) * 2 + (c >> 5), rr = r & 15, cc = c & 31, ob = rr * 64 + cc * 2; return st * 1024 + (ob ^ (((ob >> 9) & 1) << 5)); }
__host__ __device__ __forceinline__ void stage_rc(int b, int& R, int& C) { const int st = b / 1024, sb = b % 1024, swz = sb ^ (((sb >> 9) & 1) << 5); R = (st >> 1) * 16 + swz / 64; C = (st & 1) * 32 + (swz % 64) / 2; }
__host__ __device__ __forceinline__ int perm32(int rho) { const int n = rho >> 4, i = rho & 15; return 8 * (i >> 2) + 4 * n + (i & 3); }

struct Unit { int pm, pn; };
struct Gemm { const bf16_t* A; const bf16_t* Bt; int M, N, K; };

struct StaticOrder {
    int nM, nN, nwg, G, c;
    __host__ __device__ void init(int M, int N, int G_, int c_) { nM = M / BM; nN = N / BM; nwg = nM * nN; G = G_; c = c_; }
    __host__ __device__ bool next(int i, Unit& u) const {
        const long L = (long)i * G + c; if (L >= nwg) return false;
        int wgid = (int)L; { const int q = nwg / NXCD, r = nwg % NXCD, xcd = wgid % NXCD, off = wgid / NXCD; wgid = (xcd < r ? xcd * (q + 1) : r * (q + 1) + (xcd - r) * q) + off; }
        const int nig = WGM * nN, gid = wgid / nig, fm = gid * WGM, gsz = (nM - fm) < WGM ? (nM - fm) : WGM;
        u.pm = fm + ((wgid % nig) % gsz); u.pn = (wgid % nig) / gsz; return true;
    }
    __device__ __forceinline__ void a_ready(const Unit&) const {}
    __device__ __forceinline__ void done(const Unit&) const {}
};


__device__ __forceinline__ unsigned cvt_pk_bf16(float lo, float hi) { unsigned r; asm volatile("v_cvt_pk_bf16_f32 %0, %1, %2" : "=v"(r) : "v"(lo), "v"(hi)); return r; }

typedef unsigned u32x2 __attribute__((ext_vector_type(2)));
constexpr float RMS_EPS = 1e-6f;
constexpr float INV_D = 1.0f / 1024.0f;
__device__ __forceinline__ float sigmoid_f(float x) { return __builtin_amdgcn_rcpf(1.0f + __builtin_amdgcn_exp2f(-1.4426950408889634f * x)); }
typedef unsigned long long ssq_t;
constexpr float SSQ_SCALE = 16777216.0f, SSQ_INV = 1.0f / 16777216.0f;
__device__ __forceinline__ ssq_t ssq_fix(float s) { return (ssq_t)(s * SSQ_SCALE + 0.5f); }
__device__ __forceinline__ float rstd_of(ssq_t q) { return __builtin_amdgcn_rsqf((float)q * (SSQ_INV * INV_D) + RMS_EPS); }
__device__ __forceinline__ void st16_sc1(void* p, u32x4 v) { asm volatile("global_store_dwordx4 %0, %1, off sc1\n\ts_nop 1" :: "v"(p), "v"(v) : "memory"); }
__device__ __forceinline__ void st8_sc1(void* p, u32x2 v) { asm volatile("global_store_dwordx2 %0, %1, off sc1\n\ts_nop 1" :: "v"(p), "v"(v) : "memory"); }
__device__ __forceinline__ float mul_s(float a, float b) { float r; asm volatile("v_mul_f32 %0, %1, %2" : "=v"(r) : "v"(a), "v"(b)); return r; }
__device__ __forceinline__ float fma_s(float a, float b, float c) { float r; asm volatile("v_fma_f32 %0, %1, %2, %3" : "=v"(r) : "v"(a), "v"(b), "v"(c)); return r; }
__device__ __forceinline__ float exp2_s(float a) { float r; asm volatile("v_exp_f32 %0, %1" : "=v"(r) : "v"(a)); return r; }
__device__ __forceinline__ float rcp_s(float a) { float r; asm volatile("v_rcp_f32 %0, %1" : "=v"(r) : "v"(a)); return r; }
template <int N> __device__ __forceinline__ void swiglu_batch(const float (&g)[N], const float (&u)[N], float c1, float irs2, float (&h)[N]) {
    float x[N], t[N];
#pragma unroll
    for (int e = 0; e < N; ++e) x[e] = mul_s(g[e], c1);
#pragma unroll
    for (int e = 0; e < N; ++e) x[e] = exp2_s(x[e]);
#pragma unroll
    for (int e = 0; e < N; ++e) x[e] = fma_s(x[e], irs2, irs2);
#pragma unroll
    for (int e = 0; e < N; ++e) x[e] = rcp_s(x[e]);
#pragma unroll
    for (int e = 0; e < N; ++e) t[e] = mul_s(g[e], u[e]);
#pragma unroll
    for (int e = 0; e < N; ++e) h[e] = mul_s(t[e], x[e]);
}
#define PG8_EPI_CALL() \
    __device__ __forceinline__ void operator()(const f32x4 (&acc)[2][2][4][2], const Unit& u, int wr, int wc, int fr, int fq) const { \
        _Pragma("unroll") for (int ai = 0; ai < 2; ++ai) _Pragma("unroll") for (int m = 0; m < 4; ++m) { \
            const f32x4 a[2][2] = {{acc[ai][0][m][0], acc[ai][0][m][1]}, {acc[ai][1][m][0], acc[ai][1][m][1]}}; rg(a, u, ai, m, 3, wr, wc, fr, fq); } }

struct EpiGateUp {
    static constexpr bool PERM = true, AFTER_DRAIN = false;
    bf16_t* H; int ldh; const ssq_t* ssq; PG8_LAS float* rs_lds;
    __device__ __forceinline__ void prep(const Unit& u, int tid) const { if (tid < 272) { const int row = tid < 256 ? u.pm * BM + tid : 16384 + 16 * u.pm + (tid - 256); const ssq_t q = ssq[row];
            rs_lds[2 * tid] = -1.4426950408889634f * rstd_of(q); rs_lds[2 * tid + 1] = (float)q * (SSQ_INV * INV_D) + RMS_EPS; } }
    __device__ __forceinline__ void rg(const f32x4 (&a)[2][2], const Unit& u, int ai, int m, int bjmask, int wr, int wc, int fr, int fq) const {
        const int row = u.pm * BM + ai * HALF + wr * 64 + m * 16 + fr, col0 = u.pn * HALF + wc * 32 + 8 * fq;
        const float c1 = rs_lds[2 * (ai * HALF + wr * 64 + m * 16 + fr)], irs2 = rs_lds[2 * (ai * HALF + wr * 64 + m * 16 + fr) + 1];
        float h[8];
        { const float g8[8] = {a[0][0][0], a[0][0][1], a[0][0][2], a[0][0][3], a[0][1][0], a[0][1][1], a[0][1][2], a[0][1][3]}, u8[8] = {a[1][0][0], a[1][0][1], a[1][0][2], a[1][0][3], a[1][1][0], a[1][1][1], a[1][1][2], a[1][1][3]};
          swiglu_batch<8>(g8, u8, c1, irs2, h); }
        u32x4 w; w.x = cvt_pk_bf16(h[0], h[1]); w.y = cvt_pk_bf16(h[2], h[3]); w.z = cvt_pk_bf16(h[4], h[5]); w.w = cvt_pk_bf16(h[6], h[7]);
        st16_sc1(H + (size_t)row * ldh + col0, w);
    }
    __device__ __forceinline__ void rgx(const f32x4 (&ax)[2], const Unit& u, int wr, int wc, int fr, int fq) const {
        const int row = 16384 + 16 * u.pm + fr, col0 = u.pn * HALF + wc * 32 + 8 * fq + 4 * wr;
        const float c1 = rs_lds[2 * (256 + fr)], irs2 = rs_lds[2 * (256 + fr) + 1];
        float h[4];
        { const float g4[4] = {ax[0][0], ax[0][1], ax[0][2], ax[0][3]}, u4[4] = {ax[1][0], ax[1][1], ax[1][2], ax[1][3]}; swiglu_batch<4>(g4, u4, c1, irs2, h); }
        u32x2 w; w.x = cvt_pk_bf16(h[0], h[1]); w.y = cvt_pk_bf16(h[2], h[3]);
        st8_sc1(H + (size_t)row * ldh + col0, w);
    }
    PG8_EPI_CALL()
};

__device__ __forceinline__ void unpack8(const u32x4 w, float (&x)[8]) {
#pragma unroll
    for (int e = 0; e < 4; ++e) { x[2 * e] = __builtin_bit_cast(float, w[e] << 16); x[2 * e + 1] = __builtin_bit_cast(float, w[e] & 0xffff0000u); } }
template <int MODE> struct EpiResid {
    static constexpr bool PERM = true, AFTER_DRAIN = false;
    const float* xin_p; const float* xin_s; bf16_t* XB; ssq_t* ssq; float scale;
    __device__ __forceinline__ void prep(const Unit&, int) const {}
    __device__ __forceinline__ void rg(const f32x4 (&a)[2][2], const Unit& u, int ai, int m, int bjmask, int wr, int wc, int fr, int fq) const {
        const int row = u.pm * BM + ai * HALF + wr * 64 + m * 16 + fr;
        const int col0 = (MODE == 0 ? u.pn * BM : u.pn * HALF) + wc * 32 + 8 * fq;
        float sq = 0.f;
#pragma unroll
        for (int bj = 0; bj < (MODE == 0 ? 2 : 1); ++bj) {
            bf16_t* xp = XB + (size_t)row * 1024 + col0 + bj * HALF;
            float x[8];
            if (xin_p) { const float* xi = xin_p + (size_t)row * 1024 + col0 + bj * HALF; const f32x4 x0 = *(const f32x4*)xi, x1 = *(const f32x4*)(xi + 4);
#pragma unroll
                for (int e = 0; e < 4; ++e) { x[e] = x0[e]; x[4 + e] = x1[e]; } }
            else unpack8(*(const u32x4*)xp, x);
#pragma unroll
            for (int e = 0; e < 4; ++e) {
                if (MODE == 0) { x[e] += a[bj][0][e] * scale; x[4 + e] += a[bj][1][e] * scale; }
                else { x[e] += a[0][0][e] * sigmoid_f(a[1][0][e]); x[4 + e] += a[0][1][e] * sigmoid_f(a[1][1][e]); } }
            u32x4 w; w.x = cvt_pk_bf16(x[0], x[1]); w.y = cvt_pk_bf16(x[2], x[3]); w.z = cvt_pk_bf16(x[4], x[5]); w.w = cvt_pk_bf16(x[6], x[7]);
            st16_sc1(xp, w);
            sq += (x[0] * x[0] + x[1] * x[1]) + (x[2] * x[2] + x[3] * x[3]) + (x[4] * x[4] + x[5] * x[5]) + (x[6] * x[6] + x[7] * x[7]); }
        sq += __shfl_xor(sq, 16); sq += __shfl_xor(sq, 32);
        if (fq == 0) atomicAdd(ssq + row, ssq_fix(sq));
    }
    __device__ __forceinline__ void rgx(const f32x4 (&ax)[2], const Unit& u, int wr, int wc, int fr, int fq) const {
        const int r2 = 16 * u.pm + fr, row = 16384 + r2;
        const int col0 = (MODE == 0 ? u.pn * BM : u.pn * HALF) + wc * 32 + 8 * fq + 4 * wr;
        float sq = 0.f;
#pragma unroll
        for (int bj = 0; bj < (MODE == 0 ? 2 : 1); ++bj) {
            bf16_t* xp = XB + (size_t)row * 1024 + col0 + bj * HALF;
            f32x4 x0;
            if (xin_s) x0 = *(const f32x4*)(xin_s + (size_t)r2 * 1024 + col0 + bj * HALF);
            else { const u32x2 w = *(const u32x2*)xp; x0[0] = __builtin_bit_cast(float, w.x << 16); x0[1] = __builtin_bit_cast(float, w.x & 0xffff0000u); x0[2] = __builtin_bit_cast(float, w.y << 16); x0[3] = __builtin_bit_cast(float, w.y & 0xffff0000u); }
            if (MODE == 0) x0 += ax[bj] * scale;
            else {
#pragma unroll
                for (int e = 0; e < 4; ++e) x0[e] += ax[0][e] * sigmoid_f(ax[1][e]); }
            u32x2 w; w.x = cvt_pk_bf16(x0[0], x0[1]); w.y = cvt_pk_bf16(x0[2], x0[3]);
            st8_sc1(xp, w);
            sq += (x0[0] * x0[0] + x0[1] * x0[1]) + (x0[2] * x0[2] + x0[3] * x0[3]); }
        sq += __shfl_xor(sq, 16); sq += __shfl_xor(sq, 32);
        if (fq == 0) atomicAdd(ssq + row, ssq_fix(sq));
    }
    PG8_EPI_CALL()
};

struct EpiConvIn {
    static constexpr bool PERM = true, AFTER_DRAIN = false;
    bf16_t* Z; bf16_t* GB; const ssq_t* ssq; float* conv_p; float* conv_s; PG8_LAS float* rs_lds;
    __device__ __forceinline__ void prep(const Unit& u, int tid) const { if (tid < 272) { const int row = tid < 256 ? u.pm * BM + tid : 16384 + 16 * u.pm + (tid - 256); const float rs = rstd_of(ssq[row]); rs_lds[2 * tid] = rs; rs_lds[2 * tid + 1] = rs * rs; } }
    __device__ __forceinline__ void rg(const f32x4 (&a)[2][2], const Unit& u, int ai, int m, int bjmask, int wr, int wc, int fr, int fq) const {
        const int row = u.pm * BM + ai * HALF + wr * 64 + m * 16 + fr;
        const float rs = rs_lds[2 * (ai * HALF + wr * 64 + m * 16 + fr)], rs2 = rs_lds[2 * (ai * HALF + wr * 64 + m * 16 + fr) + 1];
        if (u.pn < 8) {
            const int col0 = u.pn * HALF + wc * 32 + 8 * fq;
            const f32x4 z0 = a[0][0] * a[1][0] * rs2, z1 = a[0][1] * a[1][1] * rs2;
            u32x4 w; w.x = cvt_pk_bf16(z0[0], z0[1]); w.y = cvt_pk_bf16(z0[2], z0[3]); w.z = cvt_pk_bf16(z1[0], z1[1]); w.w = cvt_pk_bf16(z1[2], z1[3]);
            st16_sc1(Z + (size_t)row * 1024 + col0, w);
            float* cp = nullptr;
            if (row < 16384) { const int t = row & 2047; if (t >= 2046) cp = conv_p + ((size_t)(row >> 11) * 2 + (t - 2046)) * 1024 + col0; }
            else { const int r2 = row - 16384, t = r2 & 7; if (t >= 6) cp = conv_s + ((size_t)(r2 >> 3) * 2 + (t - 6)) * 1024 + col0; }
            if (cp) { *(f32x4*)cp = z0; *(f32x4*)(cp + 4) = z1; }
        } else {
            const int col0 = (u.pn - 8) * BM + wc * 32 + 8 * fq;
#pragma unroll
            for (int bj = 0; bj < 2; ++bj) { const f32x4 g0 = a[bj][0] * rs, g1 = a[bj][1] * rs;
                u32x4 w; w.x = cvt_pk_bf16(g0[0], g0[1]); w.y = cvt_pk_bf16(g0[2], g0[3]); w.z = cvt_pk_bf16(g1[0], g1[1]); w.w = cvt_pk_bf16(g1[2], g1[3]);
                st16_sc1(GB + (size_t)row * 1024 + col0 + bj * HALF, w); }
        }
    }
    __device__ __forceinline__ void rgx(const f32x4 (&ax)[2], const Unit& u, int wr, int wc, int fr, int fq) const {
        const int r2 = 16 * u.pm + fr, row = 16384 + r2;
        const float rs = rs_lds[2 * (256 + fr)];
        if (u.pn < 8) {
            const int col0 = u.pn * HALF + wc * 32 + 8 * fq + 4 * wr;
            const f32x4 z0 = ax[0] * ax[1] * (rs * rs);
            u32x2 w; w.x = cvt_pk_bf16(z0[0], z0[1]); w.y = cvt_pk_bf16(z0[2], z0[3]);
            st8_sc1(Z + (size_t)row * 1024 + col0, w);
            const int t = r2 & 7;
            if (t >= 6) *(f32x4*)(conv_s + ((size_t)(r2 >> 3) * 2 + (t - 6)) * 1024 + col0) = z0;
        } else {
            const int col0 = (u.pn - 8) * BM + wc * 32 + 8 * fq + 4 * wr;
#pragma unroll
            for (int bj = 0; bj < 2; ++bj) { const f32x4 g0 = ax[bj] * rs;
                u32x2 w; w.x = cvt_pk_bf16(g0[0], g0[1]); w.y = cvt_pk_bf16(g0[2], g0[3]);
                st8_sc1(GB + (size_t)row * 1024 + col0 + bj * HALF, w); }
        }
    }
    PG8_EPI_CALL()
};

struct EpiNull {
    static constexpr bool PERM = true, AFTER_DRAIN = false;
    bf16_t* sink;
    __device__ __forceinline__ void prep(const Unit&, int) const {}
    __device__ __forceinline__ void rg(const f32x4 (&a)[2][2], const Unit& u, int ai, int m, int bjmask, int wr, int wc, int fr, int fq) const {
        asm volatile("" :: "v"(a[0][0]), "v"(a[0][1]), "v"(a[1][0]), "v"(a[1][1]));
    }
    __device__ __forceinline__ void rgx(const f32x4 (&ax)[2], const Unit& u, int wr, int wc, int fr, int fq) const { asm volatile("" :: "v"(ax[0]), "v"(ax[1])); }
    PG8_EPI_CALL()
};

template <class Epi, class Sched, bool ALIGN_EPI = false, bool SP2 = false, int PROBE = 0>
__device__ __forceinline__ void gemm_phase(PG8_LAS unsigned char* lds, const Gemm g, const Sched& S, const Epi& E) {
    int tid_ = threadIdx.x; asm volatile("" : "+v"(tid_));
    const int tid = tid_, wid = __builtin_amdgcn_readfirstlane(tid >> 6), lane = tid & 63, wr = wid >> 2, wc = wid & 3, fr = lane & 15, fq = lane >> 4;
    const int K = g.K, nt = K / BK;
    constexpr int XROW0 = 16384, XR = 16;
    unsigned voffA[2], voffB[2];
#pragma unroll
    for (int i = 0; i < 2; ++i) { int R, C; stage_rc(tid * 16 + i * 8192, R, C); const int Rb = Epi::PERM ? ((R & ~31) + perm32(R & 31)) : R;
        voffA[i] = (unsigned)(R * K + C) * 2u; voffB[i] = (unsigned)(Rb * K + C) * 2u; }
    unsigned voffX; { const int p = (wid & 3) * 1024 + lane * 16, bq = p >> 11, q = p & 2047, row = q >> 7, kb = (q & 127) ^ (((row >> 1) & 7) << 4); voffX = (unsigned)(row * K * 2 + bq * 128 + kb); }
    int xoff0 = fr * 128 + ((fq * 16) ^ (((fr >> 1) & 7) << 4)), xoff1 = fr * 128 + ((64 + fq * 16) ^ (((fr >> 1) & 7) << 4));
    unsigned xpw = 4096;
    const unsigned kstep = (unsigned)(BK * 2);
    const unsigned hstep = (unsigned)HALF * K * 2;
    const unsigned tstep = 2 * hstep;
    const __amdgpu_buffer_rsrc_t rsA = __builtin_amdgcn_make_buffer_rsrc((void*)g.A, 0, 0x7ffff000, 0x00020000), rsB = __builtin_amdgcn_make_buffer_rsrc((void*)g.Bt, 0, 0x7ffff000, 0x00020000);
    const unsigned ldsw = (unsigned)wid * 1024u;
    const int aoff = lds_byte(wr * 64 + fr, fq * 8), boff = lds_byte(wc * 32 + fr, fq * 8);
#define PG8_SA(b, h) (((b) * 2 + (h)) * HTB)
#define PG8_SB(b, h) ((4 + (b) * 2 + (h)) * HTB)
#define PG8_SX(b) (STAGE_BYTES + (b) * 2048)
#define PG8_STAGEXP(soff) do { if constexpr ((PROBE & (6 | 16)) == 0) { if (wr == 0) __builtin_amdgcn_raw_ptr_buffer_load_lds(rsA, (PG8_LAS unsigned*)(lds + STAGE_BYTES + xpw + wid * 1024), 16, voffX, (soff), 0, 0); } } while (0)
#define PG8_LDAX(dst, b) do { if constexpr ((PROBE & (10 | 32)) == 0) { dst[0] = *(const PG8_LAS bf16x8*)(lds + PG8_SX(b) + xoff0); dst[1] = *(const PG8_LAS bf16x8*)(lds + PG8_SX(b) + xoff1); } } while (0)
#define PG8_WAIT_LT(nl, nt) do { if (wr == 0) PG8_WAIT_V(nl); else PG8_WAIT_V(nt); } while (0)
#define PG8_MMAX_NULL() do { asm volatile("" :: "v"(Ax[0]), "v"(Ax[1])); } while (0)
#define PG8_MMAX_REAL() do { if (wr == 0) { _Pragma("unroll") for (int k = 0; k < 2; ++k) { accx[0] = __builtin_amdgcn_mfma_f32_16x16x32_bf16(B0[0][k], Ax[k], accx[0], 0, 0, 0); accx[1] = __builtin_amdgcn_mfma_f32_16x16x32_bf16(B1[0][k], Ax[k], accx[1], 0, 0, 0); } } \
        else { _Pragma("unroll") for (int k = 0; k < 2; ++k) { accx[0] = __builtin_amdgcn_mfma_f32_16x16x32_bf16(B0[1][k], Ax[k], accx[0], 0, 0, 0); accx[1] = __builtin_amdgcn_mfma_f32_16x16x32_bf16(B1[1][k], Ax[k], accx[1], 0, 0, 0); } } } while (0)
#define PG8_MMAX() do { if constexpr ((PROBE & (2 | 32)) != 0) { } else if constexpr ((PROBE & 1) != 0) PG8_MMAX_NULL(); else PG8_MMAX_REAL(); } while (0)
#define PG8_STAGEA(bufoff, soff) do { if constexpr ((PROBE & 4) == 0) _Pragma("unroll") for (int _i = 0; _i < 2; ++_i) \
        __builtin_amdgcn_raw_ptr_buffer_load_lds(rsA, (PG8_LAS unsigned*)(lds + (bufoff) + ldsw + _i * 8192), 16, voffA[_i], (soff), 0, 0); } while (0)
#define PG8_STAGEB(bufoff, soff) do { if constexpr ((PROBE & 4) == 0) _Pragma("unroll") for (int _i = 0; _i < 2; ++_i) \
        __builtin_amdgcn_raw_ptr_buffer_load_lds(rsB, (PG8_LAS unsigned*)(lds + (bufoff) + ldsw + _i * 8192), 16, voffB[_i], (soff), 0, 0); } while (0)
#define PG8_LDA(dst, b, h) do { if constexpr ((PROBE & 8) == 0) { _Pragma("unroll") for (int m = 0; m < 4; ++m) _Pragma("unroll") for (int k = 0; k < 2; ++k) dst[m][k] = *(const PG8_LAS bf16x8*)(lds + PG8_SA(b, h) + aoff + m * 2048 + k * 1024); } } while (0)
#define PG8_LDB(dst, b, h) do { if constexpr ((PROBE & 8) == 0) { _Pragma("unroll") for (int n = 0; n < 2; ++n) _Pragma("unroll") for (int k = 0; k < 2; ++k) dst[n][k] = *(const PG8_LAS bf16x8*)(lds + PG8_SB(b, h) + boff + n * 2048 + k * 1024); } } while (0)
#define PG8_MMA_NULL(ai, bj, At, Bt) do { _Pragma("unroll") for (int m = 0; m < 4; ++m) _Pragma("unroll") for (int k = 0; k < 2; ++k) asm volatile("" :: "v"(At[m][k])); _Pragma("unroll") for (int n = 0; n < 2; ++n) _Pragma("unroll") for (int k = 0; k < 2; ++k) asm volatile("" :: "v"(Bt[n][k])); } while (0)
#define PG8_MMA_REAL(ai, bj, At, Bt) do { __builtin_amdgcn_s_setprio(1); _Pragma("unroll") for (int m = 0; m < 4; ++m) _Pragma("unroll") for (int n = 0; n < 2; ++n) _Pragma("unroll") for (int k = 0; k < 2; ++k) \
        acc[ai][bj][m][n] = __builtin_amdgcn_mfma_f32_16x16x32_bf16(Bt[n][k], At[m][k], acc[ai][bj][m][n], 0, 0, 0); __builtin_amdgcn_s_setprio(0); } while (0)
#define PG8_MMA(ai, bj, At, Bt) do { if constexpr ((PROBE & 1) != 0) PG8_MMA_NULL(ai, bj, At, Bt); else PG8_MMA_REAL(ai, bj, At, Bt); } while (0)
#define PG8_WAIT_V(n) asm volatile("s_waitcnt vmcnt(" #n ")" ::: "memory")
#define PG8_WAIT_L(n) asm volatile("s_waitcnt lgkmcnt(" #n ")" ::: "memory")
#define PG8_BAR __builtin_amdgcn_s_barrier()
#define PG8_SCHED __builtin_amdgcn_sched_barrier(0)
    Unit cur, nxt; int ui = 0;
    if (!S.next(0, cur)) return;
    f32x4 acc[2][2][4][2];
#pragma unroll
    for (int a = 0; a < 2; ++a)
#pragma unroll
        for (int b = 0; b < 2; ++b)
#pragma unroll
            for (int m = 0; m < 4; ++m)
#pragma unroll
                for (int n = 0; n < 2; ++n) acc[a][b][m][n] = (f32x4){0.f, 0.f, 0.f, 0.f};
    bf16x8 At[4][2], B0[2][2], B1[2][2], Ax[2];
    if constexpr ((PROBE & 8) != 0) {
#pragma unroll
        for (int m = 0; m < 4; ++m)
#pragma unroll
            for (int k = 0; k < 2; ++k) asm volatile("" : "=v"(At[m][k]));
#pragma unroll
        for (int n = 0; n < 2; ++n)
#pragma unroll
            for (int k = 0; k < 2; ++k) { asm volatile("" : "=v"(B0[n][k])); asm volatile("" : "=v"(B1[n][k])); }
        asm volatile("" : "=v"(Ax[0])); asm volatile("" : "=v"(Ax[1])); }
    f32x4 accx[2] = {(f32x4){0.f, 0.f, 0.f, 0.f}, (f32x4){0.f, 0.f, 0.f, 0.f}};
    unsigned cA = (unsigned)cur.pm * tstep, cB = (unsigned)cur.pn * tstep;
    const unsigned xstep = (unsigned)XR * K * 2, xbase = (unsigned)XROW0 * K * 2; unsigned cX = xbase + (unsigned)cur.pm * xstep;
    S.a_ready(cur);
    E.prep(cur, tid);
    if constexpr (SP2) {
        PG8_STAGEB(PG8_SB(0, 0), cB); PG8_STAGEB(PG8_SB(0, 1), cB + hstep); PG8_STAGEA(PG8_SA(0, 0), cA); { const unsigned keep_ = xpw; xpw = 0; PG8_STAGEXP(cX); xpw = keep_; } PG8_STAGEA(PG8_SA(0, 1), cA + hstep);
        if (wr == 1) PG8_BAR;
        PG8_WAIT_V(2); PG8_BAR;
        PG8_STAGEB(PG8_SB(1, 0), cB + kstep); PG8_STAGEA(PG8_SA(1, 0), cA + kstep); PG8_STAGEB(PG8_SB(1, 1), cB + hstep + kstep);
        PG8_WAIT_V(6); PG8_BAR;
    } else {
        PG8_STAGEB(PG8_SB(0, 0), cB); PG8_STAGEA(PG8_SA(0, 0), cA); PG8_STAGEB(PG8_SB(0, 1), cB + hstep); PG8_STAGEA(PG8_SA(0, 1), cA + hstep);
        if (wr == 1) PG8_BAR;
        PG8_WAIT_V(4); PG8_BAR;
        PG8_STAGEB(PG8_SB(1, 0), cB + kstep); PG8_STAGEA(PG8_SA(1, 0), cA + kstep); PG8_STAGEB(PG8_SB(1, 1), cB + hstep + kstep);
        PG8_WAIT_V(6); PG8_BAR;
    }
    for (;;) {
        const bool has_next = S.next(ui + 1, nxt);
        const unsigned nA = has_next ? (unsigned)nxt.pm * tstep : cA, nB = has_next ? (unsigned)nxt.pn * tstep : cB, nX = has_next ? xbase + (unsigned)nxt.pm * xstep : cX;
        for (int t = 0; t < nt; t += 2) {
            const bool last = (t == nt - 2);
            const unsigned a1 = cA + (unsigned)(t + 1) * kstep;
            const unsigned a2 = last ? nA : cA + (unsigned)(t + 2) * kstep, b2 = last ? nB : cB + (unsigned)(t + 2) * kstep;
            const unsigned a3 = a2 + kstep, b3 = b2 + kstep, x2 = last ? nX : cX + (unsigned)(t + 2) * kstep;
            if (last && has_next) S.a_ready(nxt);
            if constexpr (SP2) {
            PG8_LDB(B0, 0, 0); PG8_LDB(B1, 0, 1); PG8_SCHED; PG8_LDA(At, 0, 0); PG8_LDAX(Ax, 0); PG8_STAGEXP(x2); PG8_STAGEA(PG8_SA(1, 1), a1 + hstep);
            PG8_WAIT_LT(9, 8); PG8_WAIT_L(0); PG8_BAR; PG8_MMA(0, 0, At, B0); PG8_MMA(0, 1, At, B1); PG8_MMAX(); PG8_BAR; PG8_SCHED;
            PG8_LDA(At, 0, 1); PG8_STAGEB(PG8_SB(0, 0), b2); PG8_STAGEB(PG8_SB(0, 1), b2 + hstep); PG8_STAGEA(PG8_SA(0, 0), a2);
            PG8_WAIT_LT(9, 8); PG8_WAIT_L(0); PG8_BAR; PG8_MMA(1, 0, At, B0); PG8_MMA(1, 1, At, B1); PG8_BAR; PG8_SCHED;
            PG8_LDB(B0, 1, 0); PG8_LDB(B1, 1, 1); PG8_SCHED; PG8_LDA(At, 1, 0); PG8_LDAX(Ax, 1); PG8_STAGEA(PG8_SA(0, 1), a2 + hstep);
            PG8_WAIT_V(8); PG8_WAIT_L(0); PG8_BAR; PG8_MMA(0, 0, At, B0); PG8_MMA(0, 1, At, B1); PG8_MMAX(); PG8_BAR; PG8_SCHED;
            PG8_LDA(At, 1, 1); PG8_STAGEB(PG8_SB(1, 0), b3); PG8_STAGEB(PG8_SB(1, 1), b3 + hstep); PG8_STAGEA(PG8_SA(1, 0), a3);
            PG8_WAIT_V(8); PG8_WAIT_L(0); PG8_BAR; PG8_MMA(1, 0, At, B0); PG8_MMA(1, 1, At, B1); PG8_BAR; PG8_SCHED;
            xpw ^= 4096u; xoff0 ^= 4096; xoff1 ^= 4096;
            } else {
            PG8_LDB(B0, 0, 0); PG8_SCHED; PG8_LDA(At, 0, 0); PG8_STAGEA(PG8_SA(1, 1), a1 + hstep);
            PG8_WAIT_L(8); PG8_BAR; PG8_WAIT_L(0); PG8_MMA(0, 0, At, B0); PG8_BAR; PG8_SCHED;
            PG8_LDB(B1, 0, 1); PG8_STAGEB(PG8_SB(0, 0), b2);
            PG8_BAR; PG8_WAIT_L(0); PG8_MMA(0, 1, At, B1); PG8_BAR;
            PG8_LDA(At, 0, 1); PG8_STAGEA(PG8_SA(0, 0), a2);
            PG8_BAR; PG8_WAIT_L(0); PG8_MMA(1, 0, At, B0); PG8_BAR; PG8_SCHED;
            PG8_STAGEB(PG8_SB(0, 1), b2 + hstep);
            PG8_WAIT_V(6); PG8_BAR; PG8_MMA(1, 1, At, B1); PG8_BAR;
            PG8_LDB(B0, 1, 0); PG8_SCHED; PG8_LDA(At, 1, 0); PG8_STAGEA(PG8_SA(0, 1), a2 + hstep);
            PG8_WAIT_L(8); PG8_BAR; PG8_WAIT_L(0); PG8_MMA(0, 0, At, B0); PG8_BAR; PG8_SCHED;
            PG8_LDB(B1, 1, 1); PG8_STAGEB(PG8_SB(1, 0), b3);
            PG8_BAR; PG8_WAIT_L(0); PG8_MMA(0, 1, At, B1); PG8_BAR;
            PG8_LDA(At, 1, 1); PG8_STAGEA(PG8_SA(1, 0), a3);
            PG8_BAR; PG8_WAIT_L(0); PG8_MMA(1, 0, At, B0); PG8_BAR; PG8_SCHED;
            PG8_STAGEB(PG8_SB(1, 1), b3 + hstep);
            PG8_WAIT_V(6); PG8_BAR; PG8_MMA(1, 1, At, B1); PG8_BAR;
            }
        }
        if constexpr (ALIGN_EPI) { if (wr == 0) PG8_BAR; }
        asm volatile("s_nop 15\n\ts_nop 15" ::: "memory");
        E(acc, cur, wr, wc, fr, fq); E.rgx(accx, cur, wr, wc, fr, fq);
        if (!has_next) break;
#pragma unroll
        for (int a = 0; a < 2; ++a)
#pragma unroll
            for (int b = 0; b < 2; ++b)
#pragma unroll
                for (int m = 0; m < 4; ++m)
#pragma unroll
                    for (int n = 0; n < 2; ++n) acc[a][b][m][n] = (f32x4){0.f, 0.f, 0.f, 0.f};
        accx[0] = (f32x4){0.f, 0.f, 0.f, 0.f}; accx[1] = (f32x4){0.f, 0.f, 0.f, 0.f};
        cur = nxt; cA = nA; cB = nB; cX = nX; ++ui;
        if constexpr (ALIGN_EPI) { if (wr == 1) PG8_BAR; }
    }
    PG8_WAIT_V(0);
    if constexpr (!ALIGN_EPI) { if (wr == 0) PG8_BAR; }
    PG8_BAR;
#undef PG8_SA
#undef PG8_SB
#undef PG8_STAGEA
#undef PG8_STAGEB
#undef PG8_SX
#undef PG8_STAGEXP
#undef PG8_WAIT_LT
#undef PG8_LDAX
#undef PG8_MMAX
#undef PG8_LDA
#undef PG8_LDB
#undef PG8_MMA
#undef PG8_WAIT_V
#undef PG8_WAIT_L
#undef PG8_BAR
#undef PG8_SCHED
}
}

#define GAS __attribute__((address_space(1)))
#define LAS __attribute__((address_space(3)))
typedef unsigned short bf16;
typedef unsigned v4u __attribute__((ext_vector_type(4)));
typedef float f32x4 __attribute__((ext_vector_type(4)));
typedef short bf16x8 __attribute__((ext_vector_type(8)));
typedef GAS unsigned gu32;
typedef GAS unsigned long long gu64;
#define RLX_AGENT __ATOMIC_RELAXED, __HIP_MEMORY_SCOPE_AGENT
#define LDS_WAIT() asm volatile("s_waitcnt lgkmcnt(0)" ::: "memory")
#define VM_WAIT() asm volatile("s_waitcnt vmcnt(0)" ::: "memory")
__device__ __forceinline__ unsigned long long rt() { return __builtin_amdgcn_s_memrealtime(); }
__device__ __forceinline__ unsigned f2bf(float f) { unsigned u = __builtin_bit_cast(unsigned, f); return (u + 0x7fffu + ((u >> 16) & 1u)) >> 16; }
__device__ __forceinline__ unsigned pk2(float lo, float hi) { return f2bf(lo) | (f2bf(hi) << 16); }

#define XB_TMO      128
#define XB_XCNT(j)  (256  + 64 * (j))
#define XB_XSUB(j)  (1280 + 64 * (j))
#define XB_XGEN(j)  (2304 + 64 * (j))
#define XB_TOP      3328
#define XB_TOPGEN   3392
#define XCD_BAR_WORDS 3456
#define XB_SPIN_CAP (1u << 18)

__device__ __forceinline__ unsigned xb_ld(unsigned* p)              { return __hip_atomic_load(p, __ATOMIC_RELAXED, __HIP_MEMORY_SCOPE_AGENT); }
__device__ __forceinline__ unsigned xb_add(unsigned* p, unsigned v) { return __hip_atomic_fetch_add(p, v, __ATOMIC_RELAXED, __HIP_MEMORY_SCOPE_AGENT); }
__device__ __forceinline__ unsigned xb_xcc_id() { return (unsigned)__builtin_amdgcn_s_getreg((3 << 11) | 20) & 0xFu; }
#define XB_SPIN(cond, bar) do { unsigned _sp = 0; while (cond) { __builtin_amdgcn_s_sleep(1); \
    if ((++_sp & 255u) == 0u) { if (xb_ld(&(bar)[XB_TMO])) break; if (_sp > XB_SPIN_CAP) { atomicAdd(&(bar)[XB_TMO], 1u); break; } } } } while (0)

struct XcdBarrier {
    unsigned* bar; unsigned x; unsigned n;
    volatile LAS unsigned* st;
};

__device__ __forceinline__ XcdBarrier xcd_barrier_post(unsigned* bar, volatile LAS unsigned* st, unsigned n) {
    XcdBarrier b; b.bar = bar; b.x = xb_xcc_id(); b.st = st; b.n = n;
    if (threadIdx.x == 0) (void)xb_add(&bar[XB_XCNT(b.x)], 1u);
    return b;
}
__device__ __forceinline__ void xcd_barrier_complete(unsigned* bar, unsigned x, unsigned G, unsigned& nloc, unsigned& nx) {
    unsigned sum, cnt, mine, sp = 0u;
    for (;;) {
        sum = 0u; cnt = 0u; mine = 0u;
#pragma unroll
        for (unsigned j = 0; j < 16; ++j) { const unsigned c = xb_ld(&bar[XB_XCNT(j)]); sum += c; cnt += (c > 0u) ? 1u : 0u; mine = (j == x) ? c : mine; }
        if (sum == G) break;
        __builtin_amdgcn_s_sleep(1);
        if ((++sp & 255u) == 0u) { if (xb_ld(&bar[XB_TMO])) break; if (sp > XB_SPIN_CAP) { atomicAdd(&bar[XB_TMO], 1u); break; } }
    }
    nloc = mine > 0u ? mine : 1u; nx = cnt > 0u ? cnt : 1u;
}

template <bool RELEASE = true>
__device__ __forceinline__ void xcd_barrier(const XcdBarrier& b) {
    asm volatile("s_waitcnt vmcnt(0)" ::: "memory");
    __syncthreads();
    if (threadIdx.x == 0) {
        unsigned* bar = b.bar;
        __builtin_amdgcn_s_waitcnt(0);
        unsigned nloc = b.st[0], nx = b.st[1];
        if (nloc == 0u) { xcd_barrier_complete(bar, b.x, b.n, nloc, nx); b.st[0] = nloc; b.st[1] = nx; }
        const unsigned old = xb_add(&bar[XB_XSUB(b.x)], 1u);
        const unsigned gen = old / nloc;
        if (old + 1u == (gen + 1u) * nloc) {
            if constexpr (RELEASE) __builtin_amdgcn_fence(__ATOMIC_RELEASE, "agent");
            asm volatile("s_waitcnt vmcnt(0)" ::: "memory");
            if (nx > 1u) {
            const unsigned og = xb_add(&bar[XB_TOP], 1u);
            const unsigned tg = og / nx;
            if (og + 1u == (tg + 1u) * nx) xb_add(&bar[XB_TOPGEN], 1u);
            else XB_SPIN(xb_ld(&bar[XB_TOPGEN]) == tg, bar); }
            __builtin_amdgcn_fence(__ATOMIC_ACQUIRE, "agent");
            xb_add(&bar[XB_XGEN(b.x)], 1u);
            asm volatile("s_waitcnt vmcnt(0)" ::: "memory");
        } else {
            XB_SPIN(xb_ld(&bar[XB_XGEN(b.x)]) == gen, bar);
            __builtin_amdgcn_fence(__ATOMIC_ACQUIRE, "agent");
            asm volatile("s_waitcnt vmcnt(0)" ::: "memory");
        }
    }
    __syncthreads();
}


constexpr int NWAVES = 8;
#ifndef MK_ONE_LAUNCH
#define MK_ONE_LAUNCH 1
#endif
constexpr int N_PHASES = 15;

constexpr int D = 1024, FF = 4096, MP = 8 * 2048, MS = 128 * 8, M = MP + MS;
constexpr int NG = 64, PS = 64, GS = 16;
constexpr float EPS = 1e-6f;
constexpr size_t O_Y = 0, O_SRP = (size_t)M * D, O_SIP = O_SRP + 8 * 4096, O_CP = O_SIP + 8 * 4096, O_SRS = O_CP + 8 * 2 * 1024, O_SIS = O_SRS + 128 * 4096, O_CS = O_SIS + 128 * 4096, O_END = O_CS + 128 * 2 * 1024;
static_assert(O_END == 19218432, "output size");

constexpr size_t MiB = 1u << 20;
constexpr size_t WS_CTL = 0, CTL_ZERO_BYTES = 1 * MiB;
constexpr size_t WS_SSQ = 112 * MiB;
constexpr size_t WS_SSME = 114 * MiB;
constexpr size_t WS_SSMP = 2 * MiB;
constexpr size_t WS_WGU = 4 * MiB;
constexpr size_t WS_WD = 68 * MiB;
constexpr size_t WS_WGLU = 100 * MiB;
constexpr size_t WS_WIN = 104 * MiB;
constexpr size_t WS_WOUT = 110 * MiB;
constexpr size_t WS_X = 112 * MiB;
constexpr size_t WS_XB = 180 * MiB;
constexpr size_t WS_H = 214 * MiB;
constexpr size_t WS_G = 350 * MiB, WS_A2 = WS_G, WS_Z = 384 * MiB, WS_GB = 418 * MiB;
constexpr size_t WS_END = 452 * MiB;
constexpr int CW_TMO = 0;
constexpr int CW_BAR = 4096;
constexpr int CW_SK = 16384;

constexpr int RING_OFF = 0, RING_BYTES = 131072 + 8192;
constexpr int RSTD_OFF = RING_BYTES;
constexpr int LDSCTL_OFF = RING_BYTES + 4096, MISC_OFF = LDSCTL_OFF + 320;
constexpr int LDS_BYTES = 147456;

struct Frame {
    LAS unsigned char* lds;
    volatile LAS unsigned* MISC;
    gu32* ctl;
    int tid, lane, wave, vcu, G, gi, ci;
    const float* in[21]; float* out; unsigned char* ws;
};

__device__ __forceinline__ void st16_wt(void* p, v4u v) { asm volatile("global_store_dwordx4 %0, %1, off sc1\n\ts_nop 1" :: "v"(p), "v"(v) : "memory"); }
__device__ __forceinline__ void st8_wt(void* p, unsigned long long v) { asm volatile("global_store_dwordx2 %0, %1, off sc1\n\ts_nop 1" :: "v"(p), "v"(v) : "memory"); }
__device__ __forceinline__ int opaque_i(int v) { asm volatile("" : "+v"(v)); return v; }
__device__ __forceinline__ float wave_sum(float v) {
#pragma unroll
    for (int o = 1; o < 64; o <<= 1) v += __shfl_xor(v, o);
    return v;
}
__device__ __forceinline__ float bf2f(unsigned short b) { return __builtin_bit_cast(float, (unsigned)b << 16); }

struct P0Item { const float* W; bf16* WT; const float* gk; int K, N, k0, n0s, n0d; };
__device__ __forceinline__ int pair_src(int nd, int base, int hstride) { return base + ((nd >> 7) & 1) * hstride + 128 * (nd >> 8) + (nd & 127); }
__device__ __forceinline__ P0Item p0_item(Frame& F, int it) {
    constexpr int I_GU = (D / 64) * (2 * FF / 64), I_D = (FF / 64) * (D / 64), I_GLU = (D / 64) * (2 * D / 64), I_IN = (D / 64) * (3 * D / 64);
    const float* norm_g = F.in[5]; P0Item p; int r = it;
    if (r < 4 * I_GU) { const int f = r / I_GU; r -= f * I_GU; const int nb = r % (2 * FF / 64), kb = r / (2 * FF / 64), nd = 64 * nb;
        p.W = F.in[7] + (size_t)f * D * 2 * FF; p.K = D; p.N = 2 * FF; p.WT = (bf16*)(F.ws + WS_WGU) + (size_t)f * 2 * FF * D; p.gk = norm_g + ((f >> 1) * 3 + (f & 1) * 2) * D; p.k0 = 64 * kb; p.n0s = pair_src(nd, 0, FF); p.n0d = nd; return p; }
    r -= 4 * I_GU;
    if (r < 4 * I_D) { const int f = r / I_D; r -= f * I_D; const int nb = r % (D / 64), kb = r / (D / 64), nd = 64 * nb;
        p.W = F.in[8] + (size_t)f * FF * D; p.K = FF; p.N = D; p.WT = (bf16*)(F.ws + WS_WD) + (size_t)f * D * FF; p.gk = nullptr; p.k0 = 64 * kb; p.n0s = nd; p.n0d = nd; return p; }
    r -= 4 * I_D;
    if (r < I_GLU) { const int nb = r % (2 * D / 64), kb = r / (2 * D / 64), nd = 64 * nb;
        p.W = F.in[17]; p.K = D; p.N = 2 * D; p.WT = (bf16*)(F.ws + WS_WGLU); p.gk = nullptr; p.k0 = 64 * kb; p.n0s = pair_src(nd, 0, D); p.n0d = nd; return p; }
    r -= I_GLU;
    if (r < I_IN) { const int nb = r % (3 * D / 64), kb = r / (3 * D / 64), nd = 64 * nb;
        p.W = F.in[18]; p.K = D; p.N = 3 * D; p.WT = (bf16*)(F.ws + WS_WIN); p.gk = norm_g + 4 * D; p.k0 = 64 * kb; p.n0s = nd < 2048 ? pair_src(nd, D, D) : nd - 2048; p.n0d = nd; return p; }
    r -= I_IN;
    { const int nb = r % (D / 64), kb = r / (D / 64), nd = 64 * nb;
        p.W = F.in[20]; p.K = D; p.N = D; p.WT = (bf16*)(F.ws + WS_WOUT); p.gk = nullptr; p.k0 = 64 * kb; p.n0s = nd; p.n0d = nd; return p; }
}
#define P0_LOAD(v, gs, p) do { _Pragma("unroll") for (int i = 0; i < 8; ++i) _Pragma("unroll") for (int s = 0; s < 2; ++s) { \
        v[i][s] = *(const GAS f32x4*)((p).W + (size_t)((p).k0 + 8 * i + 2 * kr + s) * (p).N + (p).n0s + 4 * c); gs[i][s] = (p).gk ? (p).gk[(p).k0 + 8 * i + 2 * kr + s] : 1.0f; } } while (0)
#define P0_PROC(v, gs, p) do { \
        _Pragma("unroll") for (int i = 0; i < 8; ++i) _Pragma("unroll") for (int j = 0; j < 4; ++j) \
            *(LAS unsigned*)(scr + (4 * c + j) * 128 + (((4 * i + kr) ^ ((c & 7) << 2)) << 2)) = pg8::cvt_pk_bf16(v[i][0][j] * gs[i][0], v[i][1][j] * gs[i][1]); \
        LDS_WAIT(); asm volatile("" ::: "memory"); \
        _Pragma("unroll") for (int i = 0; i < 8; ++i) { const int n = nr + 8 * i; const v4u o = *(const LAS v4u*)(scr + n * 128 + ((q ^ ((n >> 2) & 7)) << 4)); \
            st16_wt((p).WT + (size_t)((p).n0d + n) * (p).K + (p).k0 + 8 * q, o); } \
        LDS_WAIT(); asm volatile("" ::: "memory"); } while (0)

__device__ __forceinline__ void p0_prologue(Frame& F) {
    LAS unsigned char* scr = F.lds + RING_OFF + F.wave * 16384;
    const int gw = F.vcu * NWAVES + F.wave, NGW = F.G * NWAVES, lane = opaque_i(F.lane);
    constexpr int NITEMS = 4 * (D / 64) * (2 * FF / 64) + 4 * (FF / 64) * (D / 64) + (D / 64) * (2 * D / 64) + (D / 64) * (3 * D / 64) + (D / 64) * (D / 64);
    { const int kr = lane >> 4, c = lane & 15, nr = lane >> 3, q = lane & 7;
      f32x4 va[8][2], vb[8][2]; float ga[8][2], gb[8][2];
      int it = gw; P0Item pa = p0_item(F, it < NITEMS ? it : 0), pb = pa;
      if (it < NITEMS) P0_LOAD(va, ga, pa);
      while (it < NITEMS) {
          const int it1 = it + NGW; if (it1 < NITEMS) { pb = p0_item(F, it1); P0_LOAD(vb, gb, pb); }
          P0_PROC(va, ga, pa);
          if (it1 >= NITEMS) break;
          const int it2 = it1 + NGW; if (it2 < NITEMS) { pa = p0_item(F, it2); P0_LOAD(va, ga, pa); }
          P0_PROC(vb, gb, pb);
          it = it2;
      }
    }
    bf16* XB = (bf16*)(F.ws + WS_XB); pg8::ssq_t* ssq = (pg8::ssq_t*)(F.ws + WS_SSQ);
    for (int m0 = gw; m0 < M; m0 += 4 * NGW) {
        f32x4 v[4][4];
#pragma unroll
        for (int r = 0; r < 4; ++r) { const int m = m0 + r * NGW; if (m < M) { const float* src = m < MP ? F.in[0] + (size_t)m * D : F.in[1] + (size_t)(m - MP) * D;
#pragma unroll
            for (int j = 0; j < 4; ++j) v[r][j] = ((const GAS f32x4*)src)[lane + 64 * j]; } }
#pragma unroll
        for (int r = 0; r < 4; ++r) { const int m = m0 + r * NGW; if (m < M) {
            float s = 0.f;
#pragma unroll
            for (int j = 0; j < 4; ++j) { const f32x4 w = v[r][j]; s += (w.x * w.x + w.y * w.y) + (w.z * w.z + w.w * w.w);
                st8_wt(XB + (size_t)m * D + 4 * (lane + 64 * j), (unsigned long long)pg8::cvt_pk_bf16(w.x, w.y) | ((unsigned long long)pg8::cvt_pk_bf16(w.z, w.w) << 32)); }
            s = wave_sum(s);
            if (lane == 0) ssq[m] = pg8::ssq_fix(s); } }
    }
    for (int i = gw * 64 + lane; i < 7 * M; i += NGW * 64) ssq[M + i] = 0ull;
    float* sp = (float*)(F.ws + WS_SSMP);
    for (int i = gw * 64 + lane; i < NG * PS; i += NGW * 64) {
        const int g = i / PS;
        const float lr = F.in[9][i], li = F.in[10][i], dt = expf(F.in[11][g]);
        const float mag = expf(lr * dt); float sn, cs; sincosf(li * dt, &sn, &cs);
        const float lbr = mag * cs, lbi = mag * sn, den = lr * lr + li * li, nr = lbr - 1.0f, ni = lbi;
        const float fr = (nr * lr + ni * li) / den, fi = (ni * lr - nr * li) / den;
        sp[i] = lbr; sp[4096 + i] = lbi;
#pragma unroll
        for (int c = 0; c < GS; ++c) { const float br = F.in[12][(size_t)i * GS + c], bi = F.in[13][(size_t)i * GS + c];
            sp[8192 + (size_t)i * GS + c] = fr * br - fi * bi; sp[8192 + 65536 + (size_t)i * GS + c] = fr * bi + fi * br; }
    }
}

__device__ __forceinline__ float gelu_tanh(float x) {
    const float a = 0.7978845608028654f * (x + 0.044715f * x * x * x);
    return x * __builtin_amdgcn_rcpf(1.0f + __builtin_amdgcn_exp2f(-2.0f * 1.4426950408889634f * a));
}


typedef float f32x16 __attribute__((ext_vector_type(16)));
typedef unsigned u32x2v __attribute__((ext_vector_type(2)));
__device__ __forceinline__ unsigned cvtpk(float lo, float hi) { unsigned r; asm volatile("v_cvt_pk_bf16_f32 %0, %1, %2" : "=v"(r) : "v"(lo), "v"(hi)); return r; }
__device__ __forceinline__ bf16x8 pack8(const float* v) { v4u w; w.x = cvtpk(v[0], v[1]); w.y = cvtpk(v[2], v[3]); w.z = cvtpk(v[4], v[5]); w.w = cvtpk(v[6], v[7]); return __builtin_bit_cast(bf16x8, w); }
__device__ __forceinline__ float fma_s(float a, float b, float c) { float r; asm("v_fma_f32 %0, %1, %2, %3" : "=v"(r) : "v"(a), "v"(b), "v"(c)); return r; }
constexpr int SSM_ROWB = 272;
constexpr int SSM_NCH = 8, SSM_CHB = 8;
#define BFLO(w) __builtin_bit_cast(float, (w) << 16)
#define BFHI(w) __builtin_bit_cast(float, (w) & 0xffff0000u)

template <int MODE, int NI>
__device__ __forceinline__ void ssm_run(Frame& F, LAS unsigned char* img0, int lane, int g, const int (&row_base)[NI], int nblk, bool sample, int seq0, float (&hr)[NI], float (&hi)[NI]) {
    const bf16* X = (const bf16*)(F.ws + WS_XB); const pg8::ssq_t* ssq = (const pg8::ssq_t*)(F.ws + WS_SSQ) + 1 * M;
    const float* sp = (const float*)(F.ws + WS_SSMP); bf16* Gb = (bf16*)(F.ws + WS_G);
    const float* g1 = F.in[5] + 1 * D; const float* dsk = F.in[16];
    const int l31 = lane & 31, h = lane >> 5, l15 = lane & 15, q4 = lane >> 4;
    bf16x8 bbq[4];
#pragma unroll
    for (int q = 0; q < 4; ++q) { const int p = 32 * (q & 1) + l31; const float* src = sp + 8192 + (q >> 1) * 65536 + ((size_t)(g * PS + p) * GS + 8 * h);
        float v[8];
#pragma unroll
        for (int j = 0; j < 8; ++j) v[j] = src[j] * g1[g * GS + 8 * h + j];
        bbq[q] = pack8(v); }
    bf16x8 cm[4]; float dg[4];
    if (MODE == 1) {
#pragma unroll
        for (int ks = 0; ks < 4; ++ks) { const int p0 = 16 * ks + 4 * q4; const float* cr = F.in[14] + ((size_t)(g * GS + l15) * PS + p0); const float* ci = F.in[15] + ((size_t)(g * GS + l15) * PS + p0);
            float v[8];
#pragma unroll
            for (int j = 0; j < 4; ++j) { v[2 * j] = cr[j]; v[2 * j + 1] = -ci[j]; }
            cm[ks] = pack8(v); }
#pragma unroll
        for (int e = 0; e < 4; ++e) dg[e] = dsk[g * GS + 4 * q4 + e] * g1[g * GS + 4 * q4 + e];
    }
    const float lbr = sp[g * PS + lane], lbi = sp[4096 + g * PS + lane], nlbi = -lbi;
    float s0r[4], s0i[4];
    if (sample) {
#pragma unroll
        for (int i = 0; i < 4; ++i) { s0r[i] = F.in[2][((size_t)(seq0 + i) * NG + g) * PS + lane]; s0i[i] = F.in[3][((size_t)(seq0 + i) * NG + g) * PS + lane]; } }
    else {
#pragma unroll
        for (int i = 0; i < 4; ++i) { s0r[i] = 0.f; s0i[i] = 0.f; } }
    v4u xaw[NI]; u32x2v xew0[NI], xew1[NI]; pg8::ssq_t qa[NI], qe0[NI], qe1[NI];
#define SSM_LOAD(b) do { _Pragma("unroll") for (int j = 0; j < NI; ++j) { const int rowA = row_base[j] + 32 * (b) + l31; xaw[j] = *(const GAS v4u*)(X + (size_t)rowA * D + g * GS + 8 * h); qa[j] = ssq[rowA]; \
        if (MODE == 1) { const int rowE = row_base[j] + 32 * (b) + l15; xew0[j] = *(const GAS u32x2v*)(X + (size_t)rowE * D + g * GS + 4 * q4); xew1[j] = *(const GAS u32x2v*)(X + (size_t)(rowE + 16) * D + g * GS + 4 * q4); qe0[j] = ssq[rowE]; qe1[j] = ssq[rowE + 16]; } \
        else { qe0[j] = 0; qe1[j] = 0; } } } while (0)
    SSM_LOAD(0);
    for (int b = 0; b < nblk; ++b) {
        f32x4 ca0[NI], ca1[NI], ce0[NI], ce1[NI]; pg8::ssq_t cqa[NI], cqe0[NI], cqe1[NI];
#pragma unroll
        for (int j = 0; j < NI; ++j) { ca0[j] = (f32x4){BFLO(xaw[j].x), BFHI(xaw[j].x), BFLO(xaw[j].y), BFHI(xaw[j].y)}; ca1[j] = (f32x4){BFLO(xaw[j].z), BFHI(xaw[j].z), BFLO(xaw[j].w), BFHI(xaw[j].w)};
            if (MODE == 1) { ce0[j] = (f32x4){BFLO(xew0[j].x), BFHI(xew0[j].x), BFLO(xew0[j].y), BFHI(xew0[j].y)}; ce1[j] = (f32x4){BFLO(xew1[j].x), BFHI(xew1[j].x), BFLO(xew1[j].y), BFHI(xew1[j].y)}; }
            cqa[j] = qa[j]; cqe0[j] = qe0[j]; cqe1[j] = qe1[j]; }
        if (b + 1 < nblk) SSM_LOAD(b + 1);
        f32x16 Xr[NI], Yr[NI], Xi[NI], Yi[NI];
#pragma unroll
        for (int j = 0; j < NI; ++j) {
            const float rsa = pg8::rstd_of(cqa[j]);
            float ua[8];
#pragma unroll
            for (int e = 0; e < 4; ++e) { ua[e] = ca0[j][e] * rsa; ua[4 + e] = ca1[j][e] * rsa; }
            const bf16x8 ufrag = pack8(ua);
            const f32x16 zero16 = {0.f, 0.f, 0.f, 0.f, 0.f, 0.f, 0.f, 0.f, 0.f, 0.f, 0.f, 0.f, 0.f, 0.f, 0.f, 0.f};
            Xr[j] = __builtin_amdgcn_mfma_f32_32x32x16_bf16(ufrag, bbq[0], zero16, 0, 0, 0);
            Yr[j] = __builtin_amdgcn_mfma_f32_32x32x16_bf16(ufrag, bbq[1], zero16, 0, 0, 0);
            Xi[j] = __builtin_amdgcn_mfma_f32_32x32x16_bf16(ufrag, bbq[2], zero16, 0, 0, 0);
            Yi[j] = __builtin_amdgcn_mfma_f32_32x32x16_bf16(ufrag, bbq[3], zero16, 0, 0, 0); }
#pragma unroll
        for (int j = 0; j < NI; ++j)
#pragma unroll
            for (int r = 0; r < 16; ++r) {
                auto s1 = __builtin_amdgcn_permlane32_swap(__float_as_uint(Xr[j][r]), __float_as_uint(Yr[j][r]), false, false); Xr[j][r] = __uint_as_float(s1[0]); Yr[j][r] = __uint_as_float(s1[1]);
                auto s2 = __builtin_amdgcn_permlane32_swap(__float_as_uint(Xi[j][r]), __float_as_uint(Yi[j][r]), false, false); Xi[j][r] = __uint_as_float(s2[0]); Yi[j][r] = __uint_as_float(s2[1]); }
#pragma unroll
        for (int i = 0; i < 4; ++i) {
            if (sample) { hr[0] = s0r[i]; hi[0] = s0i[i]; }
#pragma unroll
            for (int s = 0; s < 2; ++s)
#pragma unroll
                for (int e = 0; e < 4; ++e)
#pragma unroll
                    for (int j = 0; j < NI; ++j) { const int r = 4 * i + e; const float br = s ? Yr[j][r] : Xr[j][r], bi = s ? Yi[j][r] : Xi[j][r];
                        const float nr = fma_s(lbr, hr[j], fma_s(nlbi, hi[j], br)), ni = fma_s(lbr, hi[j], fma_s(lbi, hr[j], bi)); hr[j] = nr; hi[j] = ni;
                        if (MODE == 1) *(LAS unsigned*)(img0 + j * (32 * SSM_ROWB) + (8 * i + 4 * s + e) * SSM_ROWB + 4 * lane) = cvtpk(nr, ni); }
            if (sample) { F.out[O_SRS + ((size_t)(seq0 + i) * NG + g) * PS + lane] = hr[0]; F.out[O_SIS + ((size_t)(seq0 + i) * NG + g) * PS + lane] = hi[0]; }
        }
        if (MODE == 1) {
#pragma unroll
            for (int j = 0; j < NI; ++j) {
                const LAS unsigned char* img = img0 + j * (32 * SSM_ROWB);
                f32x4 acc0 = {0.f, 0.f, 0.f, 0.f}, acc1 = {0.f, 0.f, 0.f, 0.f};
#pragma unroll
                for (int ks = 0; ks < 4; ++ks) {
                    const bf16x8 b0 = *(const LAS bf16x8*)(img + l15 * SSM_ROWB + 64 * ks + 16 * q4);
                    const bf16x8 b1 = *(const LAS bf16x8*)(img + (16 + l15) * SSM_ROWB + 64 * ks + 16 * q4);
                    acc0 = __builtin_amdgcn_mfma_f32_16x16x32_bf16(cm[ks], b0, acc0, 0, 0, 0);
                    acc1 = __builtin_amdgcn_mfma_f32_16x16x32_bf16(cm[ks], b1, acc1, 0, 0, 0); }
                const float rse0 = pg8::rstd_of(cqe0[j]), rse1 = pg8::rstd_of(cqe1[j]);
                float o0[4], o1[4];
#pragma unroll
                for (int e = 0; e < 4; ++e) { o0[e] = gelu_tanh(acc0[e] + dg[e] * ce0[j][e] * rse0); o1[e] = gelu_tanh(acc1[e] + dg[e] * ce1[j][e] * rse1); }
                const int rowE = row_base[j] + 32 * b + l15;
                u32x2v w0, w1; w0.x = cvtpk(o0[0], o0[1]); w0.y = cvtpk(o0[2], o0[3]); w1.x = cvtpk(o1[0], o1[1]); w1.y = cvtpk(o1[2], o1[3]);
                st8_wt(Gb + (size_t)rowE * D + g * GS + 4 * q4, (unsigned long long)w0.x | ((unsigned long long)w0.y << 32));
                st8_wt(Gb + (size_t)(rowE + 16) * D + g * GS + 4 * q4, (unsigned long long)w1.x | ((unsigned long long)w1.y << 32)); }
        }
    }
#undef SSM_LOAD
}

__device__ __forceinline__ void ssm_phase_pass(Frame& F, int pass) {
    LAS unsigned char* img = F.lds + RING_OFF + F.wave * (2 * 32 * SSM_ROWB);
    const int lane = opaque_i(F.lane), s = F.wave * 32 + F.ci, g = s & 63, c0 = s >> 6;
    float* E = (float*)(F.ws + WS_SSME) + ((size_t)(F.gi * NG + g) * SSM_NCH) * 2 * PS;
    const int rb[2] = {F.gi * 2048 + c0 * (SSM_CHB * 32), F.gi * 2048 + (c0 + 4) * (SSM_CHB * 32)};
    if (pass == 0) {
        float hr[2] = {0.f, 0.f}, hi[2] = {0.f, 0.f};
        ssm_run<0, 2>(F, img, lane, g, rb, SSM_CHB, false, 0, hr, hi);
#pragma unroll
        for (int j = 0; j < 2; ++j) { __hip_atomic_store(E + ((c0 + 4 * j) * 2 + 0) * PS + lane, hr[j], __ATOMIC_RELAXED, __HIP_MEMORY_SCOPE_AGENT); __hip_atomic_store(E + ((c0 + 4 * j) * 2 + 1) * PS + lane, hi[j], __ATOMIC_RELAXED, __HIP_MEMORY_SCOPE_AGENT); }
        float sr[1] = {0.f}, si[1] = {0.f}; const int rs[1] = {MP + 128 * F.gi + 32 * c0};
        ssm_run<1, 1>(F, img, lane, g, rs, 1, true, 16 * F.gi + 4 * c0, sr, si);
    } else {
        const float* sp = (const float*)(F.ws + WS_SSMP);
        float ar = sp[g * PS + lane], ai = sp[4096 + g * PS + lane];
#pragma unroll
        for (int k = 0; k < 8; ++k) { const float nr = ar * ar - ai * ai, ni = 2.0f * ar * ai; ar = nr; ai = ni; }
        float hr[2] = {0.f, 0.f}, hi[2] = {0.f, 0.f}; float tr = 0.f, ti = 0.f;
        for (int j = 0; j < c0 + 4; ++j) { const float er = E[(j * 2 + 0) * PS + lane], ei = E[(j * 2 + 1) * PS + lane];
            const float nr = ar * tr - ai * ti + er, ni = ar * ti + ai * tr + ei; tr = nr; ti = ni;
            if (j + 1 == c0) { hr[0] = tr; hi[0] = ti; } }
        hr[1] = tr; hi[1] = ti;
        ssm_run<1, 2>(F, img, lane, g, rb, SSM_CHB, false, 0, hr, hi);
        if (c0 == 3) { F.out[O_SRP + ((size_t)F.gi * NG + g) * PS + lane] = hr[1]; F.out[O_SIP + ((size_t)F.gi * NG + g) * PS + lane] = hi[1]; }
    }
}
#undef BFLO
#undef BFHI

__device__ __forceinline__ void conv_phase(Frame& F) {
    const bf16* Z = (const bf16*)(F.ws + WS_Z); const bf16* GBp = (const bf16*)(F.ws + WS_GB); bf16* A2 = (bf16*)(F.ws + WS_A2);
    const float* cw = F.in[19]; const float* cache = F.in[4];
    const int gt = (F.ci * NWAVES + F.wave) * 64 + opaque_i(F.lane), NGT = 32 * NWAVES * 64;
    for (int it = gt; it < (2048 + 128) * (D / 8); it += NGT) {
        const int lr = it >> 7, row = lr < 2048 ? F.gi * 2048 + lr : MP + F.gi * 128 + (lr - 2048), c0 = (it & 127) * 8;
        int t; const float* cb = nullptr;
        if (row < MP) t = row & 2047; else { const int r2 = row - MP; t = r2 & 7; cb = cache + (size_t)(r2 >> 3) * 2 * D; }
        float z0[8], z1[8], z2[8], gb[8];
        { const v4u v = *(const GAS v4u*)(Z + (size_t)row * D + c0); const v4u q = *(const GAS v4u*)(GBp + (size_t)row * D + c0);
#pragma unroll
          for (int e = 0; e < 4; ++e) { z2[2 * e] = __builtin_bit_cast(float, v[e] << 16); z2[2 * e + 1] = __builtin_bit_cast(float, v[e] & 0xffff0000u);
                                        gb[2 * e] = __builtin_bit_cast(float, q[e] << 16); gb[2 * e + 1] = __builtin_bit_cast(float, q[e] & 0xffff0000u); } }
        if (t >= 1) { const v4u v = *(const GAS v4u*)(Z + (size_t)(row - 1) * D + c0);
#pragma unroll
          for (int e = 0; e < 4; ++e) { z1[2 * e] = __builtin_bit_cast(float, v[e] << 16); z1[2 * e + 1] = __builtin_bit_cast(float, v[e] & 0xffff0000u); } }
        else {
#pragma unroll
          for (int e = 0; e < 8; ++e) z1[e] = cb ? cb[D + c0 + e] : 0.f; }
        if (t >= 2) { const v4u v = *(const GAS v4u*)(Z + (size_t)(row - 2) * D + c0);
#pragma unroll
          for (int e = 0; e < 4; ++e) { z0[2 * e] = __builtin_bit_cast(float, v[e] << 16); z0[2 * e + 1] = __builtin_bit_cast(float, v[e] & 0xffff0000u); } }
        else {
#pragma unroll
          for (int e = 0; e < 8; ++e) z0[e] = cb ? cb[t * D + c0 + e] : 0.f; }
        float o[8];
#pragma unroll
        for (int e = 0; e < 8; ++e) o[e] = gb[e] * (cw[c0 + e] * z0[e] + cw[D + c0 + e] * z1[e] + cw[2 * D + c0 + e] * z2[e]);
        v4u w; w.x = pk2(o[0], o[1]); w.y = pk2(o[2], o[3]); w.z = pk2(o[4], o[5]); w.w = pk2(o[6], o[7]);
        st16_wt(A2 + (size_t)row * D + c0, w);
    }
}

__device__ __forceinline__ void final_phase(Frame& F) {
    const bf16* XBp = (const bf16*)(F.ws + WS_XB); const pg8::ssq_t* ssq = (const pg8::ssq_t*)(F.ws + WS_SSQ) + 6 * M; const float* fg = F.in[6];
    const int gw = F.ci * NWAVES + F.wave, NGW = 32 * NWAVES, lane = opaque_i(F.lane);
    f32x4 gv[4];
#pragma unroll
    for (int j = 0; j < 4; ++j) gv[j] = ((const GAS f32x4*)fg)[lane + 64 * j];
    for (int lr = gw; lr < 2048 + 128; lr += NGW) { const int m = lr < 2048 ? F.gi * 2048 + lr : MP + F.gi * 128 + (lr - 2048);
        const float rs = pg8::rstd_of(ssq[m]);
        const GAS unsigned long long* xr = (const GAS unsigned long long*)(XBp + (size_t)m * D) + lane; GAS f32x4* yo = (GAS f32x4*)(F.out + O_Y + (size_t)m * D) + lane;
#pragma unroll
        for (int j = 0; j < 4; ++j) { const unsigned long long w = xr[64 * j]; const unsigned lo = (unsigned)w, hi = (unsigned)(w >> 32);
            const f32x4 xv = {__builtin_bit_cast(float, lo << 16), __builtin_bit_cast(float, lo & 0xffff0000u), __builtin_bit_cast(float, hi << 16), __builtin_bit_cast(float, hi & 0xffff0000u)};
            yo[64 * j] = xv * rs * gv[j]; }
    }
}

struct SameOrder : pg8::StaticOrder { __device__ bool next(int i, pg8::Unit& u) const { const bool r = pg8::StaticOrder::next(i, u); u.pm = 0; u.pn = 0; return r; } };
struct Args { const float* in[21]; float* out; unsigned char* ws; int ph_lo, ph_hi; };
__global__ void __launch_bounds__(NWAVES * 64, 2) skel_fwd(Args args) {
    extern __shared__ __attribute__((aligned(16))) unsigned char lds[];
    Frame F;
    F.lds = (LAS unsigned char*)lds;
    F.MISC = (volatile LAS unsigned*)(F.lds + MISC_OFF);
    F.tid = threadIdx.x; F.lane = F.tid & 63; F.wave = __builtin_amdgcn_readfirstlane(F.tid >> 6);
    F.G = gridDim.x; { const int bx = blockIdx.x; F.vcu = (bx % 8) * (F.G / 8) + bx / 8; F.gi = bx % 8; F.ci = bx / 8; }
    F.ws = args.ws; F.out = args.out; F.ctl = (gu32*)(args.ws + WS_CTL);
#pragma unroll
    for (int i = 0; i < 21; ++i) F.in[i] = args.in[i];
    for (int u = F.tid; u < (LDS_BYTES - LDSCTL_OFF) / 4; u += NWAVES * 64) ((LAS unsigned*)(F.lds + LDSCTL_OFF))[u] = 0u;
    __syncthreads();
    XcdBarrier bar = xcd_barrier_post((unsigned*)(F.ctl + CW_BAR), F.MISC + 8, (unsigned)F.G);
    XcdBarrier gbar = xcd_barrier_post((unsigned*)(F.ctl + CW_BAR) + (1 + F.gi) * XCD_BAR_WORDS, F.MISC + 10, (unsigned)(F.G / 8));
    const int lo = args.ph_lo, hi = args.ph_hi;
#define IN(k) (lo <= (k) && (k) < hi)
#if defined(PROBE_A_LO)
#define STAMP(k) do { if (blockIdx.x == 0 && F.tid == 0) { const unsigned long long t_ = __builtin_amdgcn_s_memrealtime(); F.MISC[16 + 2 * (k)] = (unsigned)t_; F.MISC[17 + 2 * (k)] = (unsigned)(t_ >> 32); } } while (0)
#else
#define STAMP(k) do { } while (0)
#endif
    STAMP(0);
#define SEAM(k) do { if (IN((k) + 1)) { if ((k) == 0) xcd_barrier<true>(bar); else xcd_barrier<false>(gbar); } STAMP((k) + 1); } while (0)
    bf16* XB = (bf16*)(F.ws + WS_XB); bf16* H = (bf16*)(F.ws + WS_H); pg8::ssq_t* ssq = (pg8::ssq_t*)(F.ws + WS_SSQ);
    const int bx = (int)blockIdx.x;

    if (IN(0)) { p0_prologue(F); SEAM(0); }
#define FFN_GU(ph, f, sin) if (IN(ph)) { pg8::Gemm g{XB, (const bf16*)(F.ws + WS_WGU) + (size_t)(f) * 2 * FF * D, M, 2 * FF, D}; pg8::StaticOrder S; S.init(MP, 2 * FF, F.G, bx); \
        pg8::EpiGateUp E{H, FF, ssq + (size_t)(sin) * M, (LAS float*)(F.lds + RSTD_OFF)}; pg8::gemm_phase<pg8::EpiGateUp, pg8::StaticOrder, true, true>(F.lds + RING_OFF, g, S, E); SEAM(ph); }
#define FFN_DN(ph, f, sout) if (IN(ph)) { pg8::Gemm g{H, (const bf16*)(F.ws + WS_WD) + (size_t)(f) * D * FF, M, D, FF}; pg8::StaticOrder S; S.init(MP, D, F.G, bx); \
        pg8::EpiResid<0> E{(ph) == 2 ? F.in[0] : nullptr, (ph) == 2 ? F.in[1] : nullptr, XB, ssq + (size_t)(sout) * M, 0.5f}; pg8::gemm_phase<pg8::EpiResid<0>, pg8::StaticOrder, true, true>(F.lds + RING_OFF, g, S, E); SEAM(ph); }
    FFN_GU(1, 0, 0)
    FFN_DN(2, 0, 1)
#if defined(PROBE_SSM)
    if (IN(3)) { ssm_phase_pass(F, 0); if (PROBE_SSM == 1) { xcd_barrier<false>(gbar); ssm_phase_pass(F, 0); } xcd_barrier<false>(gbar); ssm_phase_pass(F, 1); if (PROBE_SSM == 2) { xcd_barrier<false>(gbar); ssm_phase_pass(F, 1); } SEAM(3); }
#else
    if (IN(3)) { ssm_phase_pass(F, 0); xcd_barrier<false>(gbar); ssm_phase_pass(F, 1); SEAM(3); }
#endif
    if (IN(4)) { pg8::Gemm g{(const bf16*)(F.ws + WS_G), (const bf16*)(F.ws + WS_WGLU), M, 2 * D, D}; pg8::StaticOrder S; S.init(MP, 2 * D, F.G, bx);
        pg8::EpiResid<1> E{nullptr, nullptr, XB, ssq + (size_t)2 * M, 1.0f}; pg8::gemm_phase<pg8::EpiResid<1>, pg8::StaticOrder, true, true>(F.lds + RING_OFF, g, S, E); SEAM(4); }
    FFN_GU(5, 1, 2)
    FFN_DN(6, 1, 3)
    FFN_GU(7, 2, 3)
    FFN_DN(8, 2, 4)
    if (IN(9)) { pg8::Gemm g{XB, (const bf16*)(F.ws + WS_WIN), M, 3 * D, D}; pg8::StaticOrder S; S.init(MP, 3 * D, F.G, bx);
        pg8::EpiConvIn E{(bf16*)(F.ws + WS_Z), (bf16*)(F.ws + WS_GB), ssq + (size_t)4 * M, F.out + O_CP, F.out + O_CS, (LAS float*)(F.lds + RSTD_OFF)};
        pg8::gemm_phase<pg8::EpiConvIn, pg8::StaticOrder, true, true>(F.lds + RING_OFF, g, S, E); SEAM(9); }
    if (IN(10)) { conv_phase(F); SEAM(10); }
    if (IN(11)) { pg8::Gemm g{(const bf16*)(F.ws + WS_A2), (const bf16*)(F.ws + WS_WOUT), M, D, D}; pg8::StaticOrder S; S.init(MP, D, F.G, bx);
        pg8::EpiResid<0> E{nullptr, nullptr, XB, ssq + (size_t)5 * M, 1.0f}; pg8::gemm_phase<pg8::EpiResid<0>, pg8::StaticOrder, true, true>(F.lds + RING_OFF, g, S, E); SEAM(11); }
    FFN_GU(12, 3, 5)
    FFN_DN(13, 3, 6)
    if (IN(14)) { final_phase(F); }
#if defined(PROBE_DRY)
#ifndef PROBE_VARIANT
#define PROBE_VARIANT 0
#endif
    xcd_barrier<false>(gbar); STAMP(15); if (blockIdx.x == 0 && F.tid == 0) { const unsigned long long c_ = __builtin_amdgcn_s_memtime(); F.MISC[60] = (unsigned)c_; F.MISC[61] = (unsigned)(c_ >> 32); }
#if PROBE_DRY == 2
    { pg8::Gemm g{XB, (const bf16*)(F.ws + WS_WGU), M, 2 * FF, D}; SameOrder S; S.init(MP, 2 * FF, F.G, bx);
      pg8::EpiNull E{H + (size_t)M * FF - 1}; pg8::gemm_phase<pg8::EpiNull, SameOrder, true, true>(F.lds + RING_OFF, g, S, E); }
#else
#if PROBE_DRY == 3
    { pg8::Gemm g{XB, (const bf16*)(F.ws + WS_WGU) + (size_t)3 * 2 * FF * D, M, 2 * FF, D}; pg8::StaticOrder S; S.init(MP, 2 * FF, F.G, bx);
      pg8::EpiGateUp E{H, FF, ssq + (size_t)5 * M, (LAS float*)(F.lds + RSTD_OFF)}; pg8::gemm_phase<pg8::EpiGateUp, pg8::StaticOrder, true, true, PROBE_VARIANT>(F.lds + RING_OFF, g, S, E); }
#else
    { pg8::Gemm g{XB, (const bf16*)(F.ws + WS_WGU), M, 2 * FF, D}; pg8::StaticOrder S; S.init(MP, 2 * FF, F.G, bx);
      pg8::EpiNull E{H + (size_t)M * FF - 1}; pg8::gemm_phase<pg8::EpiNull, pg8::StaticOrder, true, true, PROBE_VARIANT>(F.lds + RING_OFF, g, S, E); }
#endif
#endif
    xcd_barrier<false>(gbar); STAMP(16); if (blockIdx.x == 0 && F.tid == 0) { const unsigned long long c_ = __builtin_amdgcn_s_memtime(); F.MISC[62] = (unsigned)c_; F.MISC[63] = (unsigned)(c_ >> 32); }
#endif
#if defined(PROBE_A_LO)
    __syncthreads();
    if (blockIdx.x == 0 && F.tid == 0) {
#if !defined(PROBE_DRY)
        STAMP(15);
#endif
#define TS(k) ((unsigned long long)F.MISC[16 + 2 * (k)] | ((unsigned long long)F.MISC[17 + 2 * (k)] << 32))
        const unsigned long long ta = TS(PROBE_A_HI) - TS(PROBE_A_LO), tb = TS(PROBE_B_HI) - TS(PROBE_B_LO);
#if defined(PROBE_CLOCK)
        { const unsigned long long c0 = (unsigned long long)F.MISC[60] | ((unsigned long long)F.MISC[61] << 32), c1 = (unsigned long long)F.MISC[62] | ((unsigned long long)F.MISC[63] << 32);
          F.out[0] += (float)(c1 - c0) / (float)(TS(16) - TS(15)) * 1e-2f; }
#else
        F.out[0] += (float)tb * 1e-5f;
#endif
        const unsigned long long t0 = __builtin_amdgcn_s_memrealtime();
        const unsigned long long spin = ta * 4ull < 1000000ull ? ta * 4ull : 1000000ull;
        while (__builtin_amdgcn_s_memrealtime() - t0 < spin) __builtin_amdgcn_s_sleep(8);
    }
#endif
#undef IN
#undef SEAM
}

extern "C" void kernel_launch(void* const* d_in, const int* in_sizes, int n_in, void* d_out, int out_size, void* d_ws, size_t ws_size, hipStream_t stream) {
    static int grid = 0;
    if (grid == 0) {
        if (n_in != 21 || out_size != (int)O_END || ws_size < WS_END) { fprintf(stderr, "kernel_launch: unexpected shapes: n_in %d out %d ws %zu; nothing launched\n", n_in, out_size, ws_size); grid = -1; return; }
        int dev = 0, cus = 0, per_cu = 0;
        if (hipGetDevice(&dev) != hipSuccess || hipDeviceGetAttribute(&cus, hipDeviceAttributeMultiprocessorCount, dev) != hipSuccess) { grid = -1; return; }
        if (hipFuncSetAttribute((const void*)skel_fwd, hipFuncAttributeMaxDynamicSharedMemorySize, LDS_BYTES) != hipSuccess) { fprintf(stderr, "kernel_launch: hipFuncSetAttribute failed\n"); grid = -1; return; }
        if (hipOccupancyMaxActiveBlocksPerMultiprocessor(&per_cu, (const void*)skel_fwd, NWAVES * 64, LDS_BYTES) != hipSuccess || per_cu < 1) fprintf(stderr, "kernel_launch: occupancy query reports %d\n", per_cu);
        (void)hipGetLastError();
        if (cus < 256) { fprintf(stderr, "kernel_launch: built for a 256-CU device (8 groups x 32 workgroups), found %d CUs; nothing launched\n", cus); grid = -1; return; }
        grid = 256;
    }
    if (grid < 0) return;
    if (hipMemsetAsync((char*)d_ws + WS_CTL, 0, CTL_ZERO_BYTES, stream) != hipSuccess) return;
    Args a{};
    for (int i = 0; i < 21; ++i) a.in[i] = (const float*)d_in[i];
    a.out = (float*)d_out; a.ws = (unsigned char*)d_ws;
    a.ph_lo = 0; a.ph_hi = N_PHASES;
    hipLaunchKernelGGL(skel_fwd, dim3(grid), dim3(NWAVES * 64), LDS_BYTES, stream, a);
}
```

```cpp
#include <hip/hip_runtime.h>
#include <cstdio>
#include <cstdint>
namespace pg8 {
#define PG8_LAS __attribute__((address_space(3)))
typedef unsigned short bf16_t;
typedef short bf16x8 __attribute__((ext_vector_type(8)));
typedef float f32x4 __attribute__((ext_vector_type(4)));
typedef unsigned u32x4 __attribute__((ext_vector_type(4)));
constexpr int BM = 256, BK = 64, HALF = 128, HTB = HALF * BK * 2  , STAGE_BYTES = 8 * HTB, NXCD = 8, WGM = 8;

__host__ __device__ __forceinline__ int lds_byte(int r, int c) { const int st = (r >> 4) * 2 + (c >> 5), rr = r & 15, cc = c & 31, ob = rr * 64 + cc * 2; return st * 1024 + (ob ^ (((ob >> 9) & 1) << 5)); }
__host__ __device__ __forceinline__ void stage_rc(int b, int& R, int& C) { const int st = b / 1024, sb = b % 1024, swz = sb ^ (((sb >> 9) & 1) << 5); R = (st >> 1) * 16 + swz / 64; C = (st & 1) * 32 + (swz % 64) / 2; }
__host__ __device__ __forceinline__ int perm32(int rho) { const int n = rho >> 4, i = rho & 15; return 8 * (i >> 2) + 4 * n + (i & 3); }

struct Unit { int pm, pn; };
struct Gemm { const bf16_t* A; const bf16_t* Bt; int M, N, K; };

struct StaticOrder {
    int nM, nN, nwg, G, c;
    __host__ __device__ void init(int M, int N, int G_, int c_) { nM = M / BM; nN = N / BM; nwg = nM * nN; G = G_; c = c_; }
    __host__ __device__ bool next(int i, Unit& u) const {
        const long L = (long)i * G + c; if (L >= nwg) return false;
        int wgid = (int)L; { const int q = nwg / NXCD, r = nwg % NXCD, xcd = wgid % NXCD, off = wgid / NXCD; wgid = (xcd < r ? xcd * (q + 1) : r * (q + 1) + (xcd - r) * q) + off; }
        const int nig = WGM * nN, gid = wgid / nig, fm = gid * WGM, gsz = (nM - fm) < WGM ? (nM - fm) : WGM;
        u.pm = fm + ((wgid % nig) % gsz); u.pn = (wgid % nig) / gsz; return true;
    }
    __device__ __forceinline__ void a_ready(const Unit&) const {}
    __device__ __forceinline__ void done(const Unit&) const {}
};


__device__ __forceinline__ unsigned cvt_pk_bf16(float lo, float hi) { unsigned r; asm volatile("v_cvt_pk_bf16_f32 %0, %1, %2" : "=v"(r) : "v"(lo), "v"(hi)); return r; }

typedef unsigned u32x2 __attribute__((ext_vector_type(2)));
constexpr float RMS_EPS = 1e-6f;
constexpr float INV_D = 1.0f / 1024.0f;
__device__ __forceinline__ float sigmoid_f(float x) { return __builtin_amdgcn_rcpf(1.0f + __builtin_amdgcn_exp2f(-1.4426950408889634f * x)); }
typedef unsigned long long ssq_t;
constexpr float SSQ_SCALE = 16777216.0f, SSQ_INV = 1.0f / 16777216.0f;
__device__ __forceinline__ ssq_t ssq_fix(float s) { return (ssq_t)(s * SSQ_SCALE + 0.5f); }
__device__ __forceinline__ float rstd_of(ssq_t q) { return __builtin_amdgcn_rsqf((float)q * (SSQ_INV * INV_D) + RMS_EPS); }
__device__ __forceinline__ void st16_sc1(void* p, u32x4 v) { asm volatile("global_store_dwordx4 %0, %1, off sc1\n\ts_nop 1" :: "v"(p), "v"(v) : "memory"); }
__device__ __forceinline__ void st8_sc1(void* p, u32x2 v) { asm volatile("global_store_dwordx2 %0, %1, off sc1\n\ts_nop 1" :: "v"(p), "v"(v) : "memory"); }
__device__ __forceinline__ float mul_s(float a, float b) { float r; asm volatile("v_mul_f32 %0, %1, %2" : "=v"(r) : "v"(a), "v"(b)); return r; }
__device__ __forceinline__ float fma_s(float a, float b, float c) { float r; asm volatile("v_fma_f32 %0, %1, %2, %3" : "=v"(r) : "v"(a), "v"(b), "v"(c)); return r; }
__device__ __forceinline__ float exp2_s(float a) { float r; asm volatile("v_exp_f32 %0, %1" : "=v"(r) : "v"(a)); return r; }
__device__ __forceinline__ float rcp_s(float a) { float r; asm volatile("v_rcp_f32 %0, %1" : "=v"(r) : "v"(a)); return r; }
template <int N> __device__ __forceinline__ void swiglu_batch(const float (&g)[N], const float (&u)[N], float c1, float irs2, float (&h)[N]) {
    float x[N], t[N];
#pragma unroll
    for (int e = 0; e < N; ++e) x[e] = mul_s(g[e], c1);
#pragma unroll
    for (int e = 0; e < N; ++e) x[e] = exp2_s(x[e]);
#pragma unroll
    for (int e = 0; e < N; ++e) x[e] = fma_s(x[e], irs2, irs2);
#pragma unroll
    for (int e = 0; e < N; ++e) x[e] = rcp_s(x[e]);
#pragma unroll
    for (int e = 0; e < N; ++e) t[e] = mul_s(g[e], u[e]);
#pragma unroll
    for (int e = 0; e < N; ++e) h[e] = mul_s(t[e], x[e]);
}
#define PG8_EPI_CALL() \
    __device__ __forceinline__ void operator()(const f32x4 (&acc)[2][2][4][2], const Unit& u, int wr, int wc, int fr, int fq) const { \
        _Pragma("unroll") for (int ai = 0; ai < 2; ++ai) _Pragma("unroll") for (int m = 0; m < 4; ++m) { \
            const f32x4 a[2][2] = {{acc[ai][0][m][0], acc[ai][0][m][1]}, {acc[ai][1][m][0], acc[ai][1][m][1]}}; rg(a, u, ai, m, 3, wr, wc, fr, fq); } }

struct EpiGateUp {
    static constexpr bool PERM = true, AFTER_DRAIN = false;
    bf16_t* H; int ldh; const ssq_t* ssq; PG8_LAS float* rs_lds;
    __device__ __forceinline__ void prep(const Unit& u, int tid) const { if (tid < 272) { const int row = tid < 256 ? u.pm * BM + tid : 16384 + 16 * u.pm + (tid - 256); const ssq_t q = ssq[row];
            rs_lds[2 * tid] = -1.4426950408889634f * rstd_of(q); rs_lds[2 * tid + 1] = (float)q * (SSQ_INV * INV_D) + RMS_EPS; } }
    __device__ __forceinline__ void rg(const f32x4 (&a)[2][2], const Unit& u, int ai, int m, int bjmask, int wr, int wc, int fr, int fq) const {
        const int row = u.pm * BM + ai * HALF + wr * 64 + m * 16 + fr, col0 = u.pn * HALF + wc * 32 + 8 * fq;
        const float c1 = rs_lds[2 * (ai * HALF + wr * 64 + m * 16 + fr)], irs2 = rs_lds[2 * (ai * HALF + wr * 64 + m * 16 + fr) + 1];
        float h[8];
        { const float g8[8] = {a[0][0][0], a[0][0][1], a[0][0][2], a[0][0][3], a[0][1][0], a[0][1][1], a[0][1][2], a[0][1][3]}, u8[8] = {a[1][0][0], a[1][0][1], a[1][0][2], a[1][0][3], a[1][1][0], a[1][1][1], a[1][1][2], a[1][1][3]};
          swiglu_batch<8>(g8, u8, c1, irs2, h); }
        u32x4 w; w.x = cvt_pk_bf16(h[0], h[1]); w.y = cvt_pk_bf16(h[2], h[3]); w.z = cvt_pk_bf16(h[4], h[5]); w.w = cvt_pk_bf16(h[6], h[7]);
        st16_sc1(H + (size_t)row * ldh + col0, w);
    }
    __device__ __forceinline__ void rgx(const f32x4 (&ax)[2], const Unit& u, int wr, int wc, int fr, int fq) const {
        const int row = 16384 + 16 * u.pm + fr, col0 = u.pn * HALF + wc * 32 + 8 * fq + 4 * wr;
        const float c1 = rs_lds[2 * (256 + fr)], irs2 = rs_lds[2 * (256 + fr) + 1];
        float h[4];
        { const float g4[4] = {ax[0][0], ax[0][1], ax[0][2], ax[0][3]}, u4[4] = {ax[1][0], ax[1][1], ax[1][2], ax[1][3]}; swiglu_batch<4>(g4, u4, c1, irs2, h); }
        u32x2 w; w.x = cvt_pk_bf16(h[0], h[1]); w.y = cvt_pk_bf16(h[2], h[3]);
        st8_sc1(H + (size_t)row * ldh + col0, w);
    }
    PG8_EPI_CALL()
};

__device__ __forceinline__ void unpack8(const u32x4 w, float (&x)[8]) {
#pragma unroll
    for (int e = 0; e < 4; ++e) { x[2 * e] = __builtin_bit_cast(float, w[e] << 16); x[2 * e + 1] = __builtin_bit_cast(float, w[e] & 0xffff0000u); } }
template <int MODE> struct EpiResid {
    static constexpr bool PERM = true, AFTER_DRAIN = false;
    static constexpr int NBJ = MODE == 0 ? 2 : 1;
    const float* xin_p; const float* xin_s; bf16_t* XB; ssq_t* ssq; float scale;
    __device__ __forceinline__ void prep(const Unit&, int) const {}
    __device__ __forceinline__ void rg_do(const f32x4 (&a)[2][2], float (&x)[NBJ][8], int row, int col0, int fq) const {
        float sq = 0.f;
#pragma unroll
        for (int bj = 0; bj < NBJ; ++bj) {
#pragma unroll
            for (int e = 0; e < 4; ++e) {
                if (MODE == 0) { x[bj][e] += a[bj][0][e] * scale; x[bj][4 + e] += a[bj][1][e] * scale; }
                else { x[bj][e] += a[0][0][e] * sigmoid_f(a[1][0][e]); x[bj][4 + e] += a[0][1][e] * sigmoid_f(a[1][1][e]); } }
            u32x4 w; w.x = cvt_pk_bf16(x[bj][0], x[bj][1]); w.y = cvt_pk_bf16(x[bj][2], x[bj][3]); w.z = cvt_pk_bf16(x[bj][4], x[bj][5]); w.w = cvt_pk_bf16(x[bj][6], x[bj][7]);
            st16_sc1(XB + (size_t)row * 1024 + col0 + bj * HALF, w);
            sq += (x[bj][0] * x[bj][0] + x[bj][1] * x[bj][1]) + (x[bj][2] * x[bj][2] + x[bj][3] * x[bj][3]) + (x[bj][4] * x[bj][4] + x[bj][5] * x[bj][5]) + (x[bj][6] * x[bj][6] + x[bj][7] * x[bj][7]); }
        sq += __shfl_xor(sq, 16); sq += __shfl_xor(sq, 32);
        if (fq == 0) atomicAdd(ssq + row, ssq_fix(sq));
    }
    __device__ __forceinline__ void operator()(const f32x4 (&acc)[2][2][4][2], const Unit& u, int wr, int wc, int fr, int fq) const {
        const int col0 = (MODE == 0 ? u.pn * BM : u.pn * HALF) + wc * 32 + 8 * fq;
#pragma unroll
        for (int ai = 0; ai < 2; ++ai) {
            const int rowb = u.pm * BM + ai * HALF + wr * 64 + fr;
            float x[4][NBJ][8];
            if (xin_p) {
#pragma unroll
                for (int m = 0; m < 4; ++m)
#pragma unroll
                    for (int bj = 0; bj < NBJ; ++bj) { const float* xi = xin_p + (size_t)(rowb + m * 16) * 1024 + col0 + bj * HALF; const f32x4 x0 = *(const f32x4*)xi, x1 = *(const f32x4*)(xi + 4);
#pragma unroll
                        for (int e = 0; e < 4; ++e) { x[m][bj][e] = x0[e]; x[m][bj][4 + e] = x1[e]; } }
            } else {
                u32x4 w[4][NBJ];
#pragma unroll
                for (int m = 0; m < 4; ++m)
#pragma unroll
                    for (int bj = 0; bj < NBJ; ++bj) w[m][bj] = *(const u32x4*)(XB + (size_t)(rowb + m * 16) * 1024 + col0 + bj * HALF);
#pragma unroll
                for (int m = 0; m < 4; ++m)
#pragma unroll
                    for (int bj = 0; bj < NBJ; ++bj) unpack8(w[m][bj], x[m][bj]);
            }
#pragma unroll
            for (int m = 0; m < 4; ++m) { const f32x4 a[2][2] = {{acc[ai][0][m][0], acc[ai][0][m][1]}, {acc[ai][1][m][0], acc[ai][1][m][1]}}; rg_do(a, x[m], rowb + m * 16, col0, fq); }
        }
    }
    __device__ __forceinline__ void rgx(const f32x4 (&ax)[2], const Unit& u, int wr, int wc, int fr, int fq) const {
        const int r2 = 16 * u.pm + fr, row = 16384 + r2;
        const int col0 = (MODE == 0 ? u.pn * BM : u.pn * HALF) + wc * 32 + 8 * fq + 4 * wr;
        f32x4 xo[NBJ];
#pragma unroll
        for (int bj = 0; bj < NBJ; ++bj) {
            if (xin_s) xo[bj] = *(const f32x4*)(xin_s + (size_t)r2 * 1024 + col0 + bj * HALF);
            else { const u32x2 w = *(const u32x2*)(XB + (size_t)row * 1024 + col0 + bj * HALF); xo[bj][0] = __builtin_bit_cast(float, w.x << 16); xo[bj][1] = __builtin_bit_cast(float, w.x & 0xffff0000u); xo[bj][2] = __builtin_bit_cast(float, w.y << 16); xo[bj][3] = __builtin_bit_cast(float, w.y & 0xffff0000u); } }
        float sq = 0.f;
#pragma unroll
        for (int bj = 0; bj < NBJ; ++bj) {
            f32x4 x0 = xo[bj];
            if (MODE == 0) x0 += ax[bj] * scale;
            else {
#pragma unroll
                for (int e = 0; e < 4; ++e) x0[e] += ax[0][e] * sigmoid_f(ax[1][e]); }
            u32x2 w; w.x = cvt_pk_bf16(x0[0], x0[1]); w.y = cvt_pk_bf16(x0[2], x0[3]);
            st8_sc1(XB + (size_t)row * 1024 + col0 + bj * HALF, w);
            sq += (x0[0] * x0[0] + x0[1] * x0[1]) + (x0[2] * x0[2] + x0[3] * x0[3]); }
        sq += __shfl_xor(sq, 16); sq += __shfl_xor(sq, 32);
        if (fq == 0) atomicAdd(ssq + row, ssq_fix(sq));
    }
};

struct EpiConvIn {
    static constexpr bool PERM = true, AFTER_DRAIN = false;
    bf16_t* Z; bf16_t* GB; const ssq_t* ssq; float* conv_p; float* conv_s; PG8_LAS float* rs_lds;
    __device__ __forceinline__ void prep(const Unit& u, int tid) const { if (tid < 272) { const int row = tid < 256 ? u.pm * BM + tid : 16384 + 16 * u.pm + (tid - 256); const float rs = rstd_of(ssq[row]); rs_lds[2 * tid] = rs; rs_lds[2 * tid + 1] = rs * rs; } }
    __device__ __forceinline__ void rg(const f32x4 (&a)[2][2], const Unit& u, int ai, int m, int bjmask, int wr, int wc, int fr, int fq) const {
        const int row = u.pm * BM + ai * HALF + wr * 64 + m * 16 + fr;
        const float rs = rs_lds[2 * (ai * HALF + wr * 64 + m * 16 + fr)], rs2 = rs_lds[2 * (ai * HALF + wr * 64 + m * 16 + fr) + 1];
        if (u.pn < 8) {
            const int col0 = u.pn * HALF + wc * 32 + 8 * fq;
            const f32x4 z0 = a[0][0] * a[1][0] * rs2, z1 = a[0][1] * a[1][1] * rs2;
            u32x4 w; w.x = cvt_pk_bf16(z0[0], z0[1]); w.y = cvt_pk_bf16(z0[2], z0[3]); w.z = cvt_pk_bf16(z1[0], z1[1]); w.w = cvt_pk_bf16(z1[2], z1[3]);
            st16_sc1(Z + (size_t)row * 1024 + col0, w);
            float* cp = nullptr;
            if (row < 16384) { const int t = row & 2047; if (t >= 2046) cp = conv_p + ((size_t)(row >> 11) * 2 + (t - 2046)) * 1024 + col0; }
            else { const int r2 = row - 16384, t = r2 & 7; if (t >= 6) cp = conv_s + ((size_t)(r2 >> 3) * 2 + (t - 6)) * 1024 + col0; }
            if (cp) { *(f32x4*)cp = z0; *(f32x4*)(cp + 4) = z1; }
        } else {
            const int col0 = (u.pn - 8) * BM + wc * 32 + 8 * fq;
#pragma unroll
            for (int bj = 0; bj < 2; ++bj) { const f32x4 g0 = a[bj][0] * rs, g1 = a[bj][1] * rs;
                u32x4 w; w.x = cvt_pk_bf16(g0[0], g0[1]); w.y = cvt_pk_bf16(g0[2], g0[3]); w.z = cvt_pk_bf16(g1[0], g1[1]); w.w = cvt_pk_bf16(g1[2], g1[3]);
                st16_sc1(GB + (size_t)row * 1024 + col0 + bj * HALF, w); }
        }
    }
    __device__ __forceinline__ void rgx(const f32x4 (&ax)[2], const Unit& u, int wr, int wc, int fr, int fq) const {
        const int r2 = 16 * u.pm + fr, row = 16384 + r2;
        const float rs = rs_lds[2 * (256 + fr)];
        if (u.pn < 8) {
            const int col0 = u.pn * HALF + wc * 32 + 8 * fq + 4 * wr;
            const f32x4 z0 = ax[0] * ax[1] * (rs * rs);
            u32x2 w; w.x = cvt_pk_bf16(z0[0], z0[1]); w.y = cvt_pk_bf16(z0[2], z0[3]);
            st8_sc1(Z + (size_t)row * 1024 + col0, w);
            const int t = r2 & 7;
            if (t >= 6) *(f32x4*)(conv_s + ((size_t)(r2 >> 3) * 2 + (t - 6)) * 1024 + col0) = z0;
        } else {
            const int col0 = (u.pn - 8) * BM + wc * 32 + 8 * fq + 4 * wr;
#pragma unroll
            for (int bj = 0; bj < 2; ++bj) { const f32x4 g0 = ax[bj] * rs;
                u32x2 w; w.x = cvt_pk_bf16(g0[0], g0[1]); w.y = cvt_pk_bf16(g0[2], g0[3]);
                st8_sc1(GB + (size_t)row * 1024 + col0 + bj * HALF, w); }
        }
    }
    PG8_EPI_CALL()
};

struct EpiNull {
    static constexpr bool PERM = true, AFTER_DRAIN = false;
    bf16_t* sink;
    __device__ __forceinline__ void prep(const Unit&, int) const {}
    __device__ __forceinline__ void rg(const f32x4 (&a)[2][2], const Unit& u, int ai, int m, int bjmask, int wr, int wc, int fr, int fq) const {
        asm volatile("" :: "v"(a[0][0]), "v"(a[0][1]), "v"(a[1][0]), "v"(a[1][1]));
    }
    __device__ __forceinline__ void rgx(const f32x4 (&ax)[2], const Unit& u, int wr, int wc, int fr, int fq) const { asm volatile("" :: "v"(ax[0]), "v"(ax[1])); }
    PG8_EPI_CALL()
};

template <class Epi, class Sched, bool ALIGN_EPI = false, bool SP2 = false, int PROBE = 0>
__device__ __forceinline__ void gemm_phase(PG8_LAS unsigned char* lds, const Gemm g, const Sched& S, const Epi& E) {
    int tid_ = threadIdx.x; asm volatile("" : "+v"(tid_));
    const int tid = tid_, wid = __builtin_amdgcn_readfirstlane(tid >> 6), lane = tid & 63, wr = wid >> 2, wc = wid & 3, fr = lane & 15, fq = lane >> 4;
    const int K = g.K, nt = K / BK;
    constexpr int XROW0 = 16384, XR = 16;
    unsigned voffA[2], voffB[2];
#pragma unroll
    for (int i = 0; i < 2; ++i) { int R, C; stage_rc(tid * 16 + i * 8192, R, C); const int Rb = Epi::PERM ? ((R & ~31) + perm32(R & 31)) : R;
        voffA[i] = (unsigned)(R * K + C) * 2u; voffB[i] = (unsigned)(Rb * K + C) * 2u; }
    unsigned voffX; { const int p = (wid & 3) * 1024 + lane * 16, bq = p >> 11, q = p & 2047, row = q >> 7, kb = (q & 127) ^ (((row >> 1) & 7) << 4); voffX = (unsigned)(row * K * 2 + bq * 128 + kb); }
    int xoff0 = fr * 128 + ((fq * 16) ^ (((fr >> 1) & 7) << 4)), xoff1 = fr * 128 + ((64 + fq * 16) ^ (((fr >> 1) & 7) << 4));
    unsigned xpw = 4096;
    const unsigned kstep = (unsigned)(BK * 2);
    const unsigned hstep = (unsigned)HALF * K * 2;
    const unsigned tstep = 2 * hstep;
    const __amdgpu_buffer_rsrc_t rsA = __builtin_amdgcn_make_buffer_rsrc((void*)g.A, 0, 0x7ffff000, 0x00020000), rsB = __builtin_amdgcn_make_buffer_rsrc((void*)g.Bt, 0, 0x7ffff000, 0x00020000);
    const unsigned ldsw = (unsigned)wid * 1024u;
    const int aoff = lds_byte(wr * 64 + fr, fq * 8), boff = lds_byte(wc * 32 + fr, fq * 8);
#define PG8_SA(b, h) (((b) * 2 + (h)) * HTB)
#define PG8_SB(b, h) ((4 + (b) * 2 + (h)) * HTB)
#define PG8_SX(b) (STAGE_BYTES + (b) * 2048)
#define PG8_STAGEXP(soff) do { if constexpr ((PROBE & (6 | 16)) == 0) { if (wr == 0) __builtin_amdgcn_raw_ptr_buffer_load_lds(rsA, (PG8_LAS unsigned*)(lds + STAGE_BYTES + xpw + wid * 1024), 16, voffX, (soff), 0, 0); } } while (0)
#define PG8_LDAX(dst, b) do { if constexpr ((PROBE & (10 | 32)) == 0) { dst[0] = *(const PG8_LAS bf16x8*)(lds + PG8_SX(b) + xoff0); dst[1] = *(const PG8_LAS bf16x8*)(lds + PG8_SX(b) + xoff1); } } while (0)
#define PG8_WAIT_LT(nl, nt) do { if (wr == 0) PG8_WAIT_V(nl); else PG8_WAIT_V(nt); } while (0)
#define PG8_MMAX_NULL() do { asm volatile("" :: "v"(Ax[0]), "v"(Ax[1])); } while (0)
#define PG8_MMAX_REAL() do { if (wr == 0) { _Pragma("unroll") for (int k = 0; k < 2; ++k) { accx[0] = __builtin_amdgcn_mfma_f32_16x16x32_bf16(B0[0][k], Ax[k], accx[0], 0, 0, 0); accx[1] = __builtin_amdgcn_mfma_f32_16x16x32_bf16(B1[0][k], Ax[k], accx[1], 0, 0, 0); } } \
        else { _Pragma("unroll") for (int k = 0; k < 2; ++k) { accx[0] = __builtin_amdgcn_mfma_f32_16x16x32_bf16(B0[1][k], Ax[k], accx[0], 0, 0, 0); accx[1] = __builtin_amdgcn_mfma_f32_16x16x32_bf16(B1[1][k], Ax[k], accx[1], 0, 0, 0); } } } while (0)
#define PG8_MMAX() do { if constexpr ((PROBE & (2 | 32)) != 0) { } else if constexpr ((PROBE & 1) != 0) PG8_MMAX_NULL(); else PG8_MMAX_REAL(); } while (0)
#define PG8_STAGEA(bufoff, soff) do { if constexpr ((PROBE & 4) == 0) _Pragma("unroll") for (int _i = 0; _i < 2; ++_i) \
        __builtin_amdgcn_raw_ptr_buffer_load_lds(rsA, (PG8_LAS unsigned*)(lds + (bufoff) + ldsw + _i * 8192), 16, voffA[_i], (soff), 0, 0); } while (0)
#define PG8_STAGEB(bufoff, soff) do { if constexpr ((PROBE & 4) == 0) _Pragma("unroll") for (int _i = 0; _i < 2; ++_i) \
        __builtin_amdgcn_raw_ptr_buffer_load_lds(rsB, (PG8_LAS unsigned*)(lds + (bufoff) + ldsw + _i * 8192), 16, voffB[_i], (soff), 0, 0); } while (0)
#define PG8_LDA(dst, b, h) do { if constexpr ((PROBE & 8) == 0) { _Pragma("unroll") for (int m = 0; m < 4; ++m) _Pragma("unroll") for (int k = 0; k < 2; ++k) dst[m][k] = *(const PG8_LAS bf16x8*)(lds + PG8_SA(b, h) + aoff + m * 2048 + k * 1024); } } while (0)
#define PG8_LDB(dst, b, h) do { if constexpr ((PROBE & 8) == 0) { _Pragma("unroll") for (int n = 0; n < 2; ++n) _Pragma("unroll") for (int k = 0; k < 2; ++k) dst[n][k] = *(const PG8_LAS bf16x8*)(lds + PG8_SB(b, h) + boff + n * 2048 + k * 1024); } } while (0)
#define PG8_MMA_NULL(ai, bj, At, Bt) do { _Pragma("unroll") for (int m = 0; m < 4; ++m) _Pragma("unroll") for (int k = 0; k < 2; ++k) asm volatile("" :: "v"(At[m][k])); _Pragma("unroll") for (int n = 0; n < 2; ++n) _Pragma("unroll") for (int k = 0; k < 2; ++k) asm volatile("" :: "v"(Bt[n][k])); } while (0)
#define PG8_MMA_REAL(ai, bj, At, Bt) do { __builtin_amdgcn_s_setprio(1); _Pragma("unroll") for (int m = 0; m < 4; ++m) _Pragma("unroll") for (int n = 0; n < 2; ++n) _Pragma("unroll") for (int k = 0; k < 2; ++k) \
        acc[ai][bj][m][n] = __builtin_amdgcn_mfma_f32_16x16x32_bf16(Bt[n][k], At[m][k], acc[ai][bj][m][n], 0, 0, 0); __builtin_amdgcn_s_setprio(0); } while (0)
#define PG8_MMA(ai, bj, At, Bt) do { if constexpr ((PROBE & 1) != 0) PG8_MMA_NULL(ai, bj, At, Bt); else PG8_MMA_REAL(ai, bj, At, Bt); } while (0)
#define PG8_WAIT_V(n) asm volatile("s_waitcnt vmcnt(" #n ")" ::: "memory")
#define PG8_WAIT_L(n) asm volatile("s_waitcnt lgkmcnt(" #n ")" ::: "memory")
#define PG8_BAR __builtin_amdgcn_s_barrier()
#define PG8_SCHED __builtin_amdgcn_sched_barrier(0)
    Unit cur, nxt; int ui = 0;
    if (!S.next(0, cur)) return;
    f32x4 acc[2][2][4][2];
#pragma unroll
    for (int a = 0; a < 2; ++a)
#pragma unroll
        for (int b = 0; b < 2; ++b)
#pragma unroll
            for (int m = 0; m < 4; ++m)
#pragma unroll
                for (int n = 0; n < 2; ++n) acc[a][b][m][n] = (f32x4){0.f, 0.f, 0.f, 0.f};
    bf16x8 At[4][2], B0[2][2], B1[2][2], Ax[2];
    if constexpr ((PROBE & 8) != 0) {
#pragma unroll
        for (int m = 0; m < 4; ++m)
#pragma unroll
            for (int k = 0; k < 2; ++k) asm volatile("" : "=v"(At[m][k]));
#pragma unroll
        for (int n = 0; n < 2; ++n)
#pragma unroll
            for (int k = 0; k < 2; ++k) { asm volatile("" : "=v"(B0[n][k])); asm volatile("" : "=v"(B1[n][k])); }
        asm volatile("" : "=v"(Ax[0])); asm volatile("" : "=v"(Ax[1])); }
    f32x4 accx[2] = {(f32x4){0.f, 0.f, 0.f, 0.f}, (f32x4){0.f, 0.f, 0.f, 0.f}};
    unsigned cA = (unsigned)cur.pm * tstep, cB = (unsigned)cur.pn * tstep;
    const unsigned xstep = (unsigned)XR * K * 2, xbase = (unsigned)XROW0 * K * 2; unsigned cX = xbase + (unsigned)cur.pm * xstep;
    S.a_ready(cur);
    E.prep(cur, tid);
    if constexpr (SP2) {
        PG8_STAGEB(PG8_SB(0, 0), cB); PG8_STAGEB(PG8_SB(0, 1), cB + hstep); PG8_STAGEA(PG8_SA(0, 0), cA); { const unsigned keep_ = xpw; xpw = 0; PG8_STAGEXP(cX); xpw = keep_; } PG8_STAGEA(PG8_SA(0, 1), cA + hstep);
        if (wr == 1) PG8_BAR;
        PG8_WAIT_V(2); PG8_BAR;
        PG8_STAGEB(PG8_SB(1, 0), cB + kstep); PG8_STAGEA(PG8_SA(1, 0), cA + kstep); PG8_STAGEB(PG8_SB(1, 1), cB + hstep + kstep);
        PG8_WAIT_V(6); PG8_BAR;
    } else {
        PG8_STAGEB(PG8_SB(0, 0), cB); PG8_STAGEA(PG8_SA(0, 0), cA); PG8_STAGEB(PG8_SB(0, 1), cB + hstep); PG8_STAGEA(PG8_SA(0, 1), cA + hstep);
        if (wr == 1) PG8_BAR;
        PG8_WAIT_V(4); PG8_BAR;
        PG8_STAGEB(PG8_SB(1, 0), cB + kstep); PG8_STAGEA(PG8_SA(1, 0), cA + kstep); PG8_STAGEB(PG8_SB(1, 1), cB + hstep + kstep);
        PG8_WAIT_V(6); PG8_BAR;
    }
    for (;;) {
        const bool has_next = S.next(ui + 1, nxt);
        const unsigned nA = has_next ? (unsigned)nxt.pm * tstep : cA, nB = has_next ? (unsigned)nxt.pn * tstep : cB, nX = has_next ? xbase + (unsigned)nxt.pm * xstep : cX;
        for (int t = 0; t < nt; t += 2) {
            const bool last = (t == nt - 2);
            const unsigned a1 = cA + (unsigned)(t + 1) * kstep;
            const unsigned a2 = last ? nA : cA + (unsigned)(t + 2) * kstep, b2 = last ? nB : cB + (unsigned)(t + 2) * kstep;
            const unsigned a3 = a2 + kstep, b3 = b2 + kstep, x2 = last ? nX : cX + (unsigned)(t + 2) * kstep;
            if (last && has_next) S.a_ready(nxt);
            if constexpr (SP2) {
            PG8_LDB(B0, 0, 0); PG8_LDB(B1, 0, 1); PG8_SCHED; PG8_LDA(At, 0, 0); PG8_LDAX(Ax, 0); PG8_STAGEXP(x2); PG8_STAGEA(PG8_SA(1, 1), a1 + hstep);
            PG8_WAIT_LT(9, 8); PG8_WAIT_L(0); PG8_BAR; PG8_MMA(0, 0, At, B0); PG8_MMA(0, 1, At, B1); PG8_MMAX(); PG8_BAR; PG8_SCHED;
            PG8_LDA(At, 0, 1); PG8_STAGEB(PG8_SB(0, 0), b2); PG8_STAGEB(PG8_SB(0, 1), b2 + hstep); PG8_STAGEA(PG8_SA(0, 0), a2);
            PG8_WAIT_LT(9, 8); PG8_WAIT_L(0); PG8_BAR; PG8_MMA(1, 0, At, B0); PG8_MMA(1, 1, At, B1); PG8_BAR; PG8_SCHED;
            PG8_LDB(B0, 1, 0); PG8_LDB(B1, 1, 1); PG8_SCHED; PG8_LDA(At, 1, 0); PG8_LDAX(Ax, 1); PG8_STAGEA(PG8_SA(0, 1), a2 + hstep);
            PG8_WAIT_V(8); PG8_WAIT_L(0); PG8_BAR; PG8_MMA(0, 0, At, B0); PG8_MMA(0, 1, At, B1); PG8_MMAX(); PG8_BAR; PG8_SCHED;
            PG8_LDA(At, 1, 1); PG8_STAGEB(PG8_SB(1, 0), b3); PG8_STAGEB(PG8_SB(1, 1), b3 + hstep); PG8_STAGEA(PG8_SA(1, 0), a3);
            PG8_WAIT_V(8); PG8_WAIT_L(0); PG8_BAR; PG8_MMA(1, 0, At, B0); PG8_MMA(1, 1, At, B1); PG8_BAR; PG8_SCHED;
            xpw ^= 4096u; xoff0 ^= 4096; xoff1 ^= 4096;
            } else {
            PG8_LDB(B0, 0, 0); PG8_SCHED; PG8_LDA(At, 0, 0); PG8_STAGEA(PG8_SA(1, 1), a1 + hstep);
            PG8_WAIT_L(8); PG8_BAR; PG8_WAIT_L(0); PG8_MMA(0, 0, At, B0); PG8_BAR; PG8_SCHED;
            PG8_LDB(B1, 0, 1); PG8_STAGEB(PG8_SB(0, 0), b2);
            PG8_BAR; PG8_WAIT_L(0); PG8_MMA(0, 1, At, B1); PG8_BAR;
            PG8_LDA(At, 0, 1); PG8_STAGEA(PG8_SA(0, 0), a2);
            PG8_BAR; PG8_WAIT_L(0); PG8_MMA(1, 0, At, B0); PG8_BAR; PG8_SCHED;
            PG8_STAGEB(PG8_SB(0, 1), b2 + hstep);
            PG8_WAIT_V(6); PG8_BAR; PG8_MMA(1, 1, At, B1); PG8_BAR;
            PG8_LDB(B0, 1, 0); PG8_SCHED; PG8_LDA(At, 1, 0); PG8_STAGEA(PG8_SA(0, 1), a2 + hstep);
            PG8_WAIT_L(8); PG8_BAR; PG8_WAIT_L(0); PG8_MMA(0, 0, At, B0); PG8_BAR; PG8_SCHED;
            PG8_LDB(B1, 1, 1); PG8_STAGEB(PG8_SB(1, 0), b3);
            PG8_BAR; PG8_WAIT_L(0); PG8_MMA(0, 1, At, B1); PG8_BAR;
            PG8_LDA(At, 1, 1); PG8_STAGEA(PG8_SA(1, 0), a3);
            PG8_BAR; PG8_WAIT_L(0); PG8_MMA(1, 0, At, B0); PG8_BAR; PG8_SCHED;
            PG8_STAGEB(PG8_SB(1, 1), b3 + hstep);
            PG8_WAIT_V(6); PG8_BAR; PG8_MMA(1, 1, At, B1); PG8_BAR;
            }
        }
        if constexpr (ALIGN_EPI) { if (wr == 0) PG8_BAR; }
        asm volatile("s_nop 15\n\ts_nop 15" ::: "memory");
        E(acc, cur, wr, wc, fr, fq); E.rgx(accx, cur, wr, wc, fr, fq);
        if (!has_next) break;
#pragma unroll
        for (int a = 0; a < 2; ++a)
#pragma unroll
            for (int b = 0; b < 2; ++b)
#pragma unroll
                for (int m = 0; m < 4; ++m)
#pragma unroll
                    for (int n = 0; n < 2; ++n) acc[a][b][m][n] = (f32x4){0.f, 0.f, 0.f, 0.f};
        accx[0] = (f32x4){0.f, 0.f, 0.f, 0.f}; accx[1] = (f32x4){0.f, 0.f, 0.f, 0.f};
        cur = nxt; cA = nA; cB = nB; cX = nX; ++ui;
        if constexpr (ALIGN_EPI) { if (wr == 1) PG8_BAR; }
    }
    PG8_WAIT_V(0);
    if constexpr (!ALIGN_EPI) { if (wr == 0) PG8_BAR; }
    PG8_BAR;
#undef PG8_SA
#undef PG8_SB
#undef PG8_STAGEA
#undef PG8_STAGEB
#undef PG8_SX
#undef PG8_STAGEXP
#undef PG8_WAIT_LT
#undef PG8_LDAX
#undef PG8_MMAX
#undef PG8_LDA
#undef PG8_LDB
#undef PG8_MMA
#undef PG8_WAIT_V
#undef PG8_WAIT_L
#undef PG8_BAR
#undef PG8_SCHED
}
}

#define GAS __attribute__((address_space(1)))
#define LAS __attribute__((address_space(3)))
typedef unsigned short bf16;
typedef unsigned v4u __attribute__((ext_vector_type(4)));
typedef float f32x4 __attribute__((ext_vector_type(4)));
typedef short bf16x8 __attribute__((ext_vector_type(8)));
typedef GAS unsigned gu32;
typedef GAS unsigned long long gu64;
#define RLX_AGENT __ATOMIC_RELAXED, __HIP_MEMORY_SCOPE_AGENT
#define LDS_WAIT() asm volatile("s_waitcnt lgkmcnt(0)" ::: "memory")
#define VM_WAIT() asm volatile("s_waitcnt vmcnt(0)" ::: "memory")
__device__ __forceinline__ unsigned long long rt() { return __builtin_amdgcn_s_memrealtime(); }
__device__ __forceinline__ unsigned f2bf(float f) { unsigned u = __builtin_bit_cast(unsigned, f); return (u + 0x7fffu + ((u >> 16) & 1u)) >> 16; }
__device__ __forceinline__ unsigned pk2(float lo, float hi) { return f2bf(lo) | (f2bf(hi) << 16); }

#define XB_TMO      128
#define XB_XCNT(j)  (256  + 64 * (j))
#define XB_XSUB(j)  (1280 + 64 * (j))
#define XB_XGEN(j)  (2304 + 64 * (j))
#define XB_TOP      3328
#define XB_TOPGEN   3392
#define XCD_BAR_WORDS 3456
#define XB_SPIN_CAP (1u << 18)

__device__ __forceinline__ unsigned xb_ld(unsigned* p)              { return __hip_atomic_load(p, __ATOMIC_RELAXED, __HIP_MEMORY_SCOPE_AGENT); }
__device__ __forceinline__ unsigned xb_add(unsigned* p, unsigned v) { return __hip_atomic_fetch_add(p, v, __ATOMIC_RELAXED, __HIP_MEMORY_SCOPE_AGENT); }
__device__ __forceinline__ unsigned xb_xcc_id() { return (unsigned)__builtin_amdgcn_s_getreg((3 << 11) | 20) & 0xFu; }
#define XB_SPIN(cond, bar) do { unsigned _sp = 0; while (cond) { __builtin_amdgcn_s_sleep(1); \
    if ((++_sp & 255u) == 0u) { if (xb_ld(&(bar)[XB_TMO])) break; if (_sp > XB_SPIN_CAP) { atomicAdd(&(bar)[XB_TMO], 1u); break; } } } } while (0)

struct XcdBarrier {
    unsigned* bar; unsigned x; unsigned n;
    volatile LAS unsigned* st;
};

__device__ __forceinline__ XcdBarrier xcd_barrier_post(unsigned* bar, volatile LAS unsigned* st, unsigned n) {
    XcdBarrier b; b.bar = bar; b.x = xb_xcc_id(); b.st = st; b.n = n;
    if (threadIdx.x == 0) (void)xb_add(&bar[XB_XCNT(b.x)], 1u);
    return b;
}
__device__ __forceinline__ void xcd_barrier_complete(unsigned* bar, unsigned x, unsigned G, unsigned& nloc, unsigned& nx) {
    unsigned sum, cnt, mine, sp = 0u;
    for (;;) {
        sum = 0u; cnt = 0u; mine = 0u;
#pragma unroll
        for (unsigned j = 0; j < 16; ++j) { const unsigned c = xb_ld(&bar[XB_XCNT(j)]); sum += c; cnt += (c > 0u) ? 1u : 0u; mine = (j == x) ? c : mine; }
        if (sum == G) break;
        __builtin_amdgcn_s_sleep(1);
        if ((++sp & 255u) == 0u) { if (xb_ld(&bar[XB_TMO])) break; if (sp > XB_SPIN_CAP) { atomicAdd(&bar[XB_TMO], 1u); break; } }
    }
    nloc = mine > 0u ? mine : 1u; nx = cnt > 0u ? cnt : 1u;
}

template <bool RELEASE = true>
__device__ __forceinline__ void xcd_barrier(const XcdBarrier& b) {
    asm volatile("s_waitcnt vmcnt(0)" ::: "memory");
    __syncthreads();
    if (threadIdx.x == 0) {
        unsigned* bar = b.bar;
        __builtin_amdgcn_s_waitcnt(0);
        unsigned nloc = b.st[0], nx = b.st[1];
        if (nloc == 0u) { xcd_barrier_complete(bar, b.x, b.n, nloc, nx); b.st[0] = nloc; b.st[1] = nx; }
        const unsigned old = xb_add(&bar[XB_XSUB(b.x)], 1u);
        const unsigned gen = old / nloc;
        if (old + 1u == (gen + 1u) * nloc) {
            if constexpr (RELEASE) __builtin_amdgcn_fence(__ATOMIC_RELEASE, "agent");
            asm volatile("s_waitcnt vmcnt(0)" ::: "memory");
            if (nx > 1u) {
            const unsigned og = xb_add(&bar[XB_TOP], 1u);
            const unsigned tg = og / nx;
            if (og + 1u == (tg + 1u) * nx) xb_add(&bar[XB_TOPGEN], 1u);
            else XB_SPIN(xb_ld(&bar[XB_TOPGEN]) == tg, bar); }
            __builtin_amdgcn_fence(__ATOMIC_ACQUIRE, "agent");
            xb_add(&bar[XB_XGEN(b.x)], 1u);
            asm volatile("s_waitcnt vmcnt(0)" ::: "memory");
        } else {
            XB_SPIN(xb_ld(&bar[XB_XGEN(b.x)]) == gen, bar);
            __builtin_amdgcn_fence(__ATOMIC_ACQUIRE, "agent");
            asm volatile("s_waitcnt vmcnt(0)" ::: "memory");
        }
    }
    __syncthreads();
}


constexpr int NWAVES = 8;
#ifndef MK_ONE_LAUNCH
#define MK_ONE_LAUNCH 1
#endif
constexpr int N_PHASES = 15;

constexpr int D = 1024, FF = 4096, MP = 8 * 2048, MS = 128 * 8, M = MP + MS;
constexpr int NG = 64, PS = 64, GS = 16;
constexpr float EPS = 1e-6f;
constexpr size_t O_Y = 0, O_SRP = (size_t)M * D, O_SIP = O_SRP + 8 * 4096, O_CP = O_SIP + 8 * 4096, O_SRS = O_CP + 8 * 2 * 1024, O_SIS = O_SRS + 128 * 4096, O_CS = O_SIS + 128 * 4096, O_END = O_CS + 128 * 2 * 1024;
static_assert(O_END == 19218432, "output size");

constexpr size_t MiB = 1u << 20;
constexpr size_t WS_CTL = 0, CTL_ZERO_BYTES = 1 * MiB;
constexpr size_t WS_SSQ = 112 * MiB;
constexpr size_t WS_SSME = 114 * MiB;
constexpr size_t WS_SSMP = 2 * MiB;
constexpr size_t WS_WGU = 4 * MiB;
constexpr size_t WS_WD = 68 * MiB;
constexpr size_t WS_WGLU = 100 * MiB;
constexpr size_t WS_WIN = 104 * MiB;
constexpr size_t WS_WOUT = 110 * MiB;
constexpr size_t WS_X = 112 * MiB;
constexpr size_t WS_XB = 180 * MiB;
constexpr size_t WS_H = 214 * MiB;
constexpr size_t WS_G = 350 * MiB, WS_A2 = WS_G, WS_Z = 384 * MiB, WS_GB = 418 * MiB;
constexpr size_t WS_END = 452 * MiB;
constexpr int CW_TMO = 0;
constexpr int CW_BAR = 4096;
constexpr int CW_SK = 16384;

constexpr int RING_OFF = 0, RING_BYTES = 131072 + 8192;
constexpr int RSTD_OFF = RING_BYTES;
constexpr int LDSCTL_OFF = RING_BYTES + 4096, MISC_OFF = LDSCTL_OFF + 320;
constexpr int LDS_BYTES = 147456;

struct Frame {
    LAS unsigned char* lds;
    volatile LAS unsigned* MISC;
    gu32* ctl;
    int tid, lane, wave, vcu, G, gi, ci;
    const float* in[21]; float* out; unsigned char* ws;
};

__device__ __forceinline__ void st16_wt(void* p, v4u v) { asm volatile("global_store_dwordx4 %0, %1, off sc1\n\ts_nop 1" :: "v"(p), "v"(v) : "memory"); }
__device__ __forceinline__ void st8_wt(void* p, unsigned long long v) { asm volatile("global_store_dwordx2 %0, %1, off sc1\n\ts_nop 1" :: "v"(p), "v"(v) : "memory"); }
__device__ __forceinline__ int opaque_i(int v) { asm volatile("" : "+v"(v)); return v; }
__device__ __forceinline__ float wave_sum(float v) {
#pragma unroll
    for (int o = 1; o < 64; o <<= 1) v += __shfl_xor(v, o);
    return v;
}
__device__ __forceinline__ float bf2f(unsigned short b) { return __builtin_bit_cast(float, (unsigned)b << 16); }

struct P0Item { const float* W; bf16* WT; const float* gk; int K, N, k0, n0s, n0d; };
__device__ __forceinline__ int pair_src(int nd, int base, int hstride) { return base + ((nd >> 7) & 1) * hstride + 128 * (nd >> 8) + (nd & 127); }
__device__ __forceinline__ P0Item p0_item(Frame& F, int it) {
    constexpr int I_GU = (D / 64) * (2 * FF / 64), I_D = (FF / 64) * (D / 64), I_GLU = (D / 64) * (2 * D / 64), I_IN = (D / 64) * (3 * D / 64);
    const float* norm_g = F.in[5]; P0Item p; int r = it;
    if (r < 4 * I_GU) { const int f = r / I_GU; r -= f * I_GU; const int nb = r % (2 * FF / 64), kb = r / (2 * FF / 64), nd = 64 * nb;
        p.W = F.in[7] + (size_t)f * D * 2 * FF; p.K = D; p.N = 2 * FF; p.WT = (bf16*)(F.ws + WS_WGU) + (size_t)f * 2 * FF * D; p.gk = norm_g + ((f >> 1) * 3 + (f & 1) * 2) * D; p.k0 = 64 * kb; p.n0s = pair_src(nd, 0, FF); p.n0d = nd; return p; }
    r -= 4 * I_GU;
    if (r < 4 * I_D) { const int f = r / I_D; r -= f * I_D; const int nb = r % (D / 64), kb = r / (D / 64), nd = 64 * nb;
        p.W = F.in[8] + (size_t)f * FF * D; p.K = FF; p.N = D; p.WT = (bf16*)(F.ws + WS_WD) + (size_t)f * D * FF; p.gk = nullptr; p.k0 = 64 * kb; p.n0s = nd; p.n0d = nd; return p; }
    r -= 4 * I_D;
    if (r < I_GLU) { const int nb = r % (2 * D / 64), kb = r / (2 * D / 64), nd = 64 * nb;
        p.W = F.in[17]; p.K = D; p.N = 2 * D; p.WT = (bf16*)(F.ws + WS_WGLU); p.gk = nullptr; p.k0 = 64 * kb; p.n0s = pair_src(nd, 0, D); p.n0d = nd; return p; }
    r -= I_GLU;
    if (r < I_IN) { const int nb = r % (3 * D / 64), kb = r / (3 * D / 64), nd = 64 * nb;
        p.W = F.in[18]; p.K = D; p.N = 3 * D; p.WT = (bf16*)(F.ws + WS_WIN); p.gk = norm_g + 4 * D; p.k0 = 64 * kb; p.n0s = nd < 2048 ? pair_src(nd, D, D) : nd - 2048; p.n0d = nd; return p; }
    r -= I_IN;
    { const int nb = r % (D / 64), kb = r / (D / 64), nd = 64 * nb;
        p.W = F.in[20]; p.K = D; p.N = D; p.WT = (bf16*)(F.ws + WS_WOUT); p.gk = nullptr; p.k0 = 64 * kb; p.n0s = nd; p.n0d = nd; return p; }
}
#define P0_LOAD(v, gs, p) do { _Pragma("unroll") for (int i = 0; i < 8; ++i) _Pragma("unroll") for (int s = 0; s < 2; ++s) { \
        v[i][s] = *(const GAS f32x4*)((p).W + (size_t)((p).k0 + 8 * i + 2 * kr + s) * (p).N + (p).n0s + 4 * c); gs[i][s] = (p).gk ? (p).gk[(p).k0 + 8 * i + 2 * kr + s] : 1.0f; } } while (0)
#define P0_PROC(v, gs, p) do { \
        _Pragma("unroll") for (int i = 0; i < 8; ++i) _Pragma("unroll") for (int j = 0; j < 4; ++j) \
            *(LAS unsigned*)(scr + (4 * c + j) * 128 + (((4 * i + kr) ^ ((c & 7) << 2)) << 2)) = pg8::cvt_pk_bf16(v[i][0][j] * gs[i][0], v[i][1][j] * gs[i][1]); \
        LDS_WAIT(); asm volatile("" ::: "memory"); \
        _Pragma("unroll") for (int i = 0; i < 8; ++i) { const int n = nr + 8 * i; const v4u o = *(const LAS v4u*)(scr + n * 128 + ((q ^ ((n >> 2) & 7)) << 4)); \
            st16_wt((p).WT + (size_t)((p).n0d + n) * (p).K + (p).k0 + 8 * q, o); } \
        LDS_WAIT(); asm volatile("" ::: "memory"); } while (0)

__device__ __forceinline__ void p0_prologue(Frame& F) {
    LAS unsigned char* scr = F.lds + RING_OFF + F.wave * 16384;
    const int gw = F.vcu * NWAVES + F.wave, NGW = F.G * NWAVES, lane = opaque_i(F.lane);
    constexpr int NITEMS = 4 * (D / 64) * (2 * FF / 64) + 4 * (FF / 64) * (D / 64) + (D / 64) * (2 * D / 64) + (D / 64) * (3 * D / 64) + (D / 64) * (D / 64);
    { const int kr = lane >> 4, c = lane & 15, nr = lane >> 3, q = lane & 7;
      f32x4 va[8][2], vb[8][2]; float ga[8][2], gb[8][2];
      int it = gw; P0Item pa = p0_item(F, it < NITEMS ? it : 0), pb = pa;
      if (it < NITEMS) P0_LOAD(va, ga, pa);
      while (it < NITEMS) {
          const int it1 = it + NGW; if (it1 < NITEMS) { pb = p0_item(F, it1); P0_LOAD(vb, gb, pb); }
          P0_PROC(va, ga, pa);
          if (it1 >= NITEMS) break;
          const int it2 = it1 + NGW; if (it2 < NITEMS) { pa = p0_item(F, it2); P0_LOAD(va, ga, pa); }
          P0_PROC(vb, gb, pb);
          it = it2;
      }
    }
    bf16* XB = (bf16*)(F.ws + WS_XB); pg8::ssq_t* ssq = (pg8::ssq_t*)(F.ws + WS_SSQ);
    for (int m0 = gw; m0 < M; m0 += 4 * NGW) {
        f32x4 v[4][4];
#pragma unroll
        for (int r = 0; r < 4; ++r) { const int m = m0 + r * NGW; if (m < M) { const float* src = m < MP ? F.in[0] + (size_t)m * D : F.in[1] + (size_t)(m - MP) * D;
#pragma unroll
            for (int j = 0; j < 4; ++j) v[r][j] = ((const GAS f32x4*)src)[lane + 64 * j]; } }
#pragma unroll
        for (int r = 0; r < 4; ++r) { const int m = m0 + r * NGW; if (m < M) {
            float s = 0.f;
#pragma unroll
            for (int j = 0; j < 4; ++j) { const f32x4 w = v[r][j]; s += (w.x * w.x + w.y * w.y) + (w.z * w.z + w.w * w.w);
                st8_wt(XB + (size_t)m * D + 4 * (lane + 64 * j), (unsigned long long)pg8::cvt_pk_bf16(w.x, w.y) | ((unsigned long long)pg8::cvt_pk_bf16(w.z, w.w) << 32)); }
            s = wave_sum(s);
            if (lane == 0) ssq[m] = pg8::ssq_fix(s); } }
    }
    for (int i = gw * 64 + lane; i < 7 * M; i += NGW * 64) ssq[M + i] = 0ull;
    float* sp = (float*)(F.ws + WS_SSMP);
    for (int i = gw * 64 + lane; i < NG * PS; i += NGW * 64) {
        const int g = i / PS;
        const float lr = F.in[9][i], li = F.in[10][i], dt = expf(F.in[11][g]);
        const float mag = expf(lr * dt); float sn, cs; sincosf(li * dt, &sn, &cs);
        const float lbr = mag * cs, lbi = mag * sn, den = lr * lr + li * li, nr = lbr - 1.0f, ni = lbi;
        const float fr = (nr * lr + ni * li) / den, fi = (ni * lr - nr * li) / den;
        sp[i] = lbr; sp[4096 + i] = lbi;
#pragma unroll
        for (int c = 0; c < GS; ++c) { const float br = F.in[12][(size_t)i * GS + c], bi = F.in[13][(size_t)i * GS + c];
            sp[8192 + (size_t)i * GS + c] = fr * br - fi * bi; sp[8192 + 65536 + (size_t)i * GS + c] = fr * bi + fi * br; }
    }
}

__device__ __forceinline__ float gelu_tanh(float x) {
    const float a = 0.7978845608028654f * (x + 0.044715f * x * x * x);
    return x * __builtin_amdgcn_rcpf(1.0f + __builtin_amdgcn_exp2f(-2.0f * 1.4426950408889634f * a));
}


typedef float f32x16 __attribute__((ext_vector_type(16)));
typedef unsigned u32x2v __attribute__((ext_vector_type(2)));
__device__ __forceinline__ unsigned cvtpk(float lo, float hi) { unsigned r; asm volatile("v_cvt_pk_bf16_f32 %0, %1, %2" : "=v"(r) : "v"(lo), "v"(hi)); return r; }
__device__ __forceinline__ bf16x8 pack8(const float* v) { v4u w; w.x = cvtpk(v[0], v[1]); w.y = cvtpk(v[2], v[3]); w.z = cvtpk(v[4], v[5]); w.w = cvtpk(v[6], v[7]); return __builtin_bit_cast(bf16x8, w); }
__device__ __forceinline__ float fma_s(float a, float b, float c) { float r; asm("v_fma_f32 %0, %1, %2, %3" : "=v"(r) : "v"(a), "v"(b), "v"(c)); return r; }
constexpr int SSM_ROWB = 272;
constexpr int SSM_NCH = 8, SSM_CHB = 8;
#define BFLO(w) __builtin_bit_cast(float, (w) << 16)
#define BFHI(w) __builtin_bit_cast(float, (w) & 0xffff0000u)

template <int MODE, int NI>
__device__ __forceinline__ void ssm_run(Frame& F, LAS unsigned char* img0, int lane, int g, const int (&row_base)[NI], int nblk, bool sample, int seq0, float (&hr)[NI], float (&hi)[NI]) {
    const bf16* X = (const bf16*)(F.ws + WS_XB); const pg8::ssq_t* ssq = (const pg8::ssq_t*)(F.ws + WS_SSQ) + 1 * M;
    const float* sp = (const float*)(F.ws + WS_SSMP); bf16* Gb = (bf16*)(F.ws + WS_G);
    const float* g1 = F.in[5] + 1 * D; const float* dsk = F.in[16];
    const int l31 = lane & 31, h = lane >> 5, l15 = lane & 15, q4 = lane >> 4;
    bf16x8 bbq[4];
#pragma unroll
    for (int q = 0; q < 4; ++q) { const int p = 32 * (q & 1) + l31; const float* src = sp + 8192 + (q >> 1) * 65536 + ((size_t)(g * PS + p) * GS + 8 * h);
        float v[8];
#pragma unroll
        for (int j = 0; j < 8; ++j) v[j] = src[j] * g1[g * GS + 8 * h + j];
        bbq[q] = pack8(v); }
    bf16x8 cm[4]; float dg[4];
    if (MODE == 1) {
#pragma unroll
        for (int ks = 0; ks < 4; ++ks) { const int p0 = 16 * ks + 4 * q4; const float* cr = F.in[14] + ((size_t)(g * GS + l15) * PS + p0); const float* ci = F.in[15] + ((size_t)(g * GS + l15) * PS + p0);
            float v[8];
#pragma unroll
            for (int j = 0; j < 4; ++j) { v[2 * j] = cr[j]; v[2 * j + 1] = -ci[j]; }
            cm[ks] = pack8(v); }
#pragma unroll
        for (int e = 0; e < 4; ++e) dg[e] = dsk[g * GS + 4 * q4 + e] * g1[g * GS + 4 * q4 + e];
    }
    const float lbr = sp[g * PS + lane], lbi = sp[4096 + g * PS + lane], nlbi = -lbi;
    float s0r[4], s0i[4];
    if (sample) {
#pragma unroll
        for (int i = 0; i < 4; ++i) { s0r[i] = F.in[2][((size_t)(seq0 + i) * NG + g) * PS + lane]; s0i[i] = F.in[3][((size_t)(seq0 + i) * NG + g) * PS + lane]; } }
    else {
#pragma unroll
        for (int i = 0; i < 4; ++i) { s0r[i] = 0.f; s0i[i] = 0.f; } }
    v4u xaw[NI]; u32x2v xew0[NI], xew1[NI]; pg8::ssq_t qa[NI], qe0[NI], qe1[NI];
#define SSM_LOAD(b) do { _Pragma("unroll") for (int j = 0; j < NI; ++j) { const int rowA = row_base[j] + 32 * (b) + l31; xaw[j] = *(const GAS v4u*)(X + (size_t)rowA * D + g * GS + 8 * h); qa[j] = ssq[rowA]; \
        if (MODE == 1) { const int rowE = row_base[j] + 32 * (b) + l15; xew0[j] = *(const GAS u32x2v*)(X + (size_t)rowE * D + g * GS + 4 * q4); xew1[j] = *(const GAS u32x2v*)(X + (size_t)(rowE + 16) * D + g * GS + 4 * q4); qe0[j] = ssq[rowE]; qe1[j] = ssq[rowE + 16]; } \
        else { qe0[j] = 0; qe1[j] = 0; } } } while (0)
    SSM_LOAD(0);
    for (int b = 0; b < nblk; ++b) {
        f32x4 ca0[NI], ca1[NI], ce0[NI], ce1[NI]; pg8::ssq_t cqa[NI], cqe0[NI], cqe1[NI];
#pragma unroll
        for (int j = 0; j < NI; ++j) { ca0[j] = (f32x4){BFLO(xaw[j].x), BFHI(xaw[j].x), BFLO(xaw[j].y), BFHI(xaw[j].y)}; ca1[j] = (f32x4){BFLO(xaw[j].z), BFHI(xaw[j].z), BFLO(xaw[j].w), BFHI(xaw[j].w)};
            if (MODE == 1) { ce0[j] = (f32x4){BFLO(xew0[j].x), BFHI(xew0[j].x), BFLO(xew0[j].y), BFHI(xew0[j].y)}; ce1[j] = (f32x4){BFLO(xew1[j].x), BFHI(xew1[j].x), BFLO(xew1[j].y), BFHI(xew1[j].y)}; }
            cqa[j] = qa[j]; cqe0[j] = qe0[j]; cqe1[j] = qe1[j]; }
        if (b + 1 < nblk) SSM_LOAD(b + 1);
        f32x16 Xr[NI], Yr[NI], Xi[NI], Yi[NI];
#pragma unroll
        for (int j = 0; j < NI; ++j) {
            const float rsa = pg8::rstd_of(cqa[j]);
            float ua[8];
#pragma unroll
            for (int e = 0; e < 4; ++e) { ua[e] = ca0[j][e] * rsa; ua[4 + e] = ca1[j][e] * rsa; }
            const bf16x8 ufrag = pack8(ua);
            const f32x16 zero16 = {0.f, 0.f, 0.f, 0.f, 0.f, 0.f, 0.f, 0.f, 0.f, 0.f, 0.f, 0.f, 0.f, 0.f, 0.f, 0.f};
            Xr[j] = __builtin_amdgcn_mfma_f32_32x32x16_bf16(ufrag, bbq[0], zero16, 0, 0, 0);
            Yr[j] = __builtin_amdgcn_mfma_f32_32x32x16_bf16(ufrag, bbq[1], zero16, 0, 0, 0);
            Xi[j] = __builtin_amdgcn_mfma_f32_32x32x16_bf16(ufrag, bbq[2], zero16, 0, 0, 0);
            Yi[j] = __builtin_amdgcn_mfma_f32_32x32x16_bf16(ufrag, bbq[3], zero16, 0, 0, 0); }
#pragma unroll
        for (int j = 0; j < NI; ++j)
#pragma unroll
            for (int r = 0; r < 16; ++r) {
                auto s1 = __builtin_amdgcn_permlane32_swap(__float_as_uint(Xr[j][r]), __float_as_uint(Yr[j][r]), false, false); Xr[j][r] = __uint_as_float(s1[0]); Yr[j][r] = __uint_as_float(s1[1]);
                auto s2 = __builtin_amdgcn_permlane32_swap(__float_as_uint(Xi[j][r]), __float_as_uint(Yi[j][r]), false, false); Xi[j][r] = __uint_as_float(s2[0]); Yi[j][r] = __uint_as_float(s2[1]); }
#pragma unroll
        for (int i = 0; i < 4; ++i) {
            if (sample) { hr[0] = s0r[i]; hi[0] = s0i[i]; }
#pragma unroll
            for (int s = 0; s < 2; ++s)
#pragma unroll
                for (int e = 0; e < 4; ++e)
#pragma unroll
                    for (int j = 0; j < NI; ++j) { const int r = 4 * i + e; const float br = s ? Yr[j][r] : Xr[j][r], bi = s ? Yi[j][r] : Xi[j][r];
                        const float nr = fma_s(lbr, hr[j], fma_s(nlbi, hi[j], br)), ni = fma_s(lbr, hi[j], fma_s(lbi, hr[j], bi)); hr[j] = nr; hi[j] = ni;
                        if (MODE == 1) *(LAS unsigned*)(img0 + j * (32 * SSM_ROWB) + (8 * i + 4 * s + e) * SSM_ROWB + 4 * lane) = cvtpk(nr, ni); }
            if (sample) { F.out[O_SRS + ((size_t)(seq0 + i) * NG + g) * PS + lane] = hr[0]; F.out[O_SIS + ((size_t)(seq0 + i) * NG + g) * PS + lane] = hi[0]; }
        }
        if (MODE == 1) {
#pragma unroll
            for (int j = 0; j < NI; ++j) {
                const LAS unsigned char* img = img0 + j * (32 * SSM_ROWB);
                f32x4 acc0 = {0.f, 0.f, 0.f, 0.f}, acc1 = {0.f, 0.f, 0.f, 0.f};
#pragma unroll
                for (int ks = 0; ks < 4; ++ks) {
                    const bf16x8 b0 = *(const LAS bf16x8*)(img + l15 * SSM_ROWB + 64 * ks + 16 * q4);
                    const bf16x8 b1 = *(const LAS bf16x8*)(img + (16 + l15) * SSM_ROWB + 64 * ks + 16 * q4);
                    acc0 = __builtin_amdgcn_mfma_f32_16x16x32_bf16(cm[ks], b0, acc0, 0, 0, 0);
                    acc1 = __builtin_amdgcn_mfma_f32_16x16x32_bf16(cm[ks], b1, acc1, 0, 0, 0); }
                const float rse0 = pg8::rstd_of(cqe0[j]), rse1 = pg8::rstd_of(cqe1[j]);
                float o0[4], o1[4];
#pragma unroll
                for (int e = 0; e < 4; ++e) { o0[e] = gelu_tanh(acc0[e] + dg[e] * ce0[j][e] * rse0); o1[e] = gelu_tanh(acc1[e] + dg[e] * ce1[j][e] * rse1); }
                const int rowE = row_base[j] + 32 * b + l15;
                u32x2v w0, w1; w0.x = cvtpk(o0[0], o0[1]); w0.y = cvtpk(o0[2], o0[3]); w1.x = cvtpk(o1[0], o1[1]); w1.y = cvtpk(o1[2], o1[3]);
                st8_wt(Gb + (size_t)rowE * D + g * GS + 4 * q4, (unsigned long long)w0.x | ((unsigned long long)w0.y << 32));
                st8_wt(Gb + (size_t)(rowE + 16) * D + g * GS + 4 * q4, (unsigned long long)w1.x | ((unsigned long long)w1.y << 32)); }
        }
    }
#undef SSM_LOAD
}

__device__ __forceinline__ void ssm_phase_pass(Frame& F, int pass) {
    LAS unsigned char* img = F.lds + RING_OFF + F.wave * (2 * 32 * SSM_ROWB);
    const int lane = opaque_i(F.lane), s = F.wave * 32 + F.ci, g = s & 63, c0 = s >> 6;
    float* E = (float*)(F.ws + WS_SSME) + ((size_t)(F.gi * NG + g) * SSM_NCH) * 2 * PS;
    const int rb[2] = {F.gi * 2048 + c0 * (SSM_CHB * 32), F.gi * 2048 + (c0 + 4) * (SSM_CHB * 32)};
    if (pass == 0) {
        float hr[2] = {0.f, 0.f}, hi[2] = {0.f, 0.f};
        ssm_run<0, 2>(F, img, lane, g, rb, SSM_CHB, false, 0, hr, hi);
#pragma unroll
        for (int j = 0; j < 2; ++j) { __hip_atomic_store(E + ((c0 + 4 * j) * 2 + 0) * PS + lane, hr[j], __ATOMIC_RELAXED, __HIP_MEMORY_SCOPE_AGENT); __hip_atomic_store(E + ((c0 + 4 * j) * 2 + 1) * PS + lane, hi[j], __ATOMIC_RELAXED, __HIP_MEMORY_SCOPE_AGENT); }
        float sr[1] = {0.f}, si[1] = {0.f}; const int rs[1] = {MP + 128 * F.gi + 32 * c0};
        ssm_run<1, 1>(F, img, lane, g, rs, 1, true, 16 * F.gi + 4 * c0, sr, si);
    } else {
        const float* sp = (const float*)(F.ws + WS_SSMP);
        float ar = sp[g * PS + lane], ai = sp[4096 + g * PS + lane];
#pragma unroll
        for (int k = 0; k < 8; ++k) { const float nr = ar * ar - ai * ai, ni = 2.0f * ar * ai; ar = nr; ai = ni; }
        float hr[2] = {0.f, 0.f}, hi[2] = {0.f, 0.f}; float tr = 0.f, ti = 0.f;
        for (int j = 0; j < c0 + 4; ++j) { const float er = E[(j * 2 + 0) * PS + lane], ei = E[(j * 2 + 1) * PS + lane];
            const float nr = ar * tr - ai * ti + er, ni = ar * ti + ai * tr + ei; tr = nr; ti = ni;
            if (j + 1 == c0) { hr[0] = tr; hi[0] = ti; } }
        hr[1] = tr; hi[1] = ti;
        ssm_run<1, 2>(F, img, lane, g, rb, SSM_CHB, false, 0, hr, hi);
        if (c0 == 3) { F.out[O_SRP + ((size_t)F.gi * NG + g) * PS + lane] = hr[1]; F.out[O_SIP + ((size_t)F.gi * NG + g) * PS + lane] = hi[1]; }
    }
}
#undef BFLO
#undef BFHI

__device__ __forceinline__ void conv_phase(Frame& F) {
    const bf16* Z = (const bf16*)(F.ws + WS_Z); const bf16* GBp = (const bf16*)(F.ws + WS_GB); bf16* A2 = (bf16*)(F.ws + WS_A2);
    const float* cw = F.in[19]; const float* cache = F.in[4];
    const int gt = (F.ci * NWAVES + F.wave) * 64 + opaque_i(F.lane), NGT = 32 * NWAVES * 64;
    for (int it = gt; it < (2048 + 128) * (D / 8); it += NGT) {
        const int lr = it >> 7, row = lr < 2048 ? F.gi * 2048 + lr : MP + F.gi * 128 + (lr - 2048), c0 = (it & 127) * 8;
        int t; const float* cb = nullptr;
        if (row < MP) t = row & 2047; else { const int r2 = row - MP; t = r2 & 7; cb = cache + (size_t)(r2 >> 3) * 2 * D; }
        float z0[8], z1[8], z2[8], gb[8];
        { const v4u v = *(const GAS v4u*)(Z + (size_t)row * D + c0); const v4u q = *(const GAS v4u*)(GBp + (size_t)row * D + c0);
#pragma unroll
          for (int e = 0; e < 4; ++e) { z2[2 * e] = __builtin_bit_cast(float, v[e] << 16); z2[2 * e + 1] = __builtin_bit_cast(float, v[e] & 0xffff0000u);
                                        gb[2 * e] = __builtin_bit_cast(float, q[e] << 16); gb[2 * e + 1] = __builtin_bit_cast(float, q[e] & 0xffff0000u); } }
        if (t >= 1) { const v4u v = *(const GAS v4u*)(Z + (size_t)(row - 1) * D + c0);
#pragma unroll
          for (int e = 0; e < 4; ++e) { z1[2 * e] = __builtin_bit_cast(float, v[e] << 16); z1[2 * e + 1] = __builtin_bit_cast(float, v[e] & 0xffff0000u); } }
        else {
#pragma unroll
          for (int e = 0; e < 8; ++e) z1[e] = cb ? cb[D + c0 + e] : 0.f; }
        if (t >= 2) { const v4u v = *(const GAS v4u*)(Z + (size_t)(row - 2) * D + c0);
#pragma unroll
          for (int e = 0; e < 4; ++e) { z0[2 * e] = __builtin_bit_cast(float, v[e] << 16); z0[2 * e + 1] = __builtin_bit_cast(float, v[e] & 0xffff0000u); } }
        else {
#pragma unroll
          for (int e = 0; e < 8; ++e) z0[e] = cb ? cb[t * D + c0 + e] : 0.f; }
        float o[8];
#pragma unroll
        for (int e = 0; e < 8; ++e) o[e] = gb[e] * (cw[c0 + e] * z0[e] + cw[D + c0 + e] * z1[e] + cw[2 * D + c0 + e] * z2[e]);
        v4u w; w.x = pk2(o[0], o[1]); w.y = pk2(o[2], o[3]); w.z = pk2(o[4], o[5]); w.w = pk2(o[6], o[7]);
        st16_wt(A2 + (size_t)row * D + c0, w);
    }
}

__device__ __forceinline__ void final_phase(Frame& F) {
    const bf16* XBp = (const bf16*)(F.ws + WS_XB); const pg8::ssq_t* ssq = (const pg8::ssq_t*)(F.ws + WS_SSQ) + 6 * M; const float* fg = F.in[6];
    const int gw = F.ci * NWAVES + F.wave, NGW = 32 * NWAVES, lane = opaque_i(F.lane);
    f32x4 gv[4];
#pragma unroll
    for (int j = 0; j < 4; ++j) gv[j] = ((const GAS f32x4*)fg)[lane + 64 * j];
    for (int lr = gw; lr < 2048 + 128; lr += NGW) { const int m = lr < 2048 ? F.gi * 2048 + lr : MP + F.gi * 128 + (lr - 2048);
        const float rs = pg8::rstd_of(ssq[m]);
        const GAS unsigned long long* xr = (const GAS unsigned long long*)(XBp + (size_t)m * D) + lane; GAS f32x4* yo = (GAS f32x4*)(F.out + O_Y + (size_t)m * D) + lane;
#pragma unroll
        for (int j = 0; j < 4; ++j) { const unsigned long long w = xr[64 * j]; const unsigned lo = (unsigned)w, hi = (unsigned)(w >> 32);
            const f32x4 xv = {__builtin_bit_cast(float, lo << 16), __builtin_bit_cast(float, lo & 0xffff0000u), __builtin_bit_cast(float, hi << 16), __builtin_bit_cast(float, hi & 0xffff0000u)};
            yo[64 * j] = xv * rs * gv[j]; }
    }
}

struct SameOrder : pg8::StaticOrder { __device__ bool next(int i, pg8::Unit& u) const { const bool r = pg8::StaticOrder::next(i, u); u.pm = 0; u.pn = 0; return r; } };
struct Args { const float* in[21]; float* out; unsigned char* ws; int ph_lo, ph_hi; };
__global__ void __launch_bounds__(NWAVES * 64, 2) skel_fwd(Args args) {
    extern __shared__ __attribute__((aligned(16))) unsigned char lds[];
    Frame F;
    F.lds = (LAS unsigned char*)lds;
    F.MISC = (volatile LAS unsigned*)(F.lds + MISC_OFF);
    F.tid = threadIdx.x; F.lane = F.tid & 63; F.wave = __builtin_amdgcn_readfirstlane(F.tid >> 6);
    F.G = gridDim.x; { const int bx = blockIdx.x; F.vcu = (bx % 8) * (F.G / 8) + bx / 8; F.gi = bx % 8; F.ci = bx / 8; }
    F.ws = args.ws; F.out = args.out; F.ctl = (gu32*)(args.ws + WS_CTL);
#pragma unroll
    for (int i = 0; i < 21; ++i) F.in[i] = args.in[i];
    for (int u = F.tid; u < (LDS_BYTES - LDSCTL_OFF) / 4; u += NWAVES * 64) ((LAS unsigned*)(F.lds + LDSCTL_OFF))[u] = 0u;
    __syncthreads();
    XcdBarrier bar = xcd_barrier_post((unsigned*)(F.ctl + CW_BAR), F.MISC + 8, (unsigned)F.G);
    XcdBarrier gbar = xcd_barrier_post((unsigned*)(F.ctl + CW_BAR) + (1 + F.gi) * XCD_BAR_WORDS, F.MISC + 10, (unsigned)(F.G / 8));
    const int lo = args.ph_lo, hi = args.ph_hi;
#define IN(k) (lo <= (k) && (k) < hi)
#if defined(PROBE_A_LO)
#define STAMP(k) do { if (blockIdx.x == 0 && F.tid == 0) { const unsigned long long t_ = __builtin_amdgcn_s_memrealtime(); F.MISC[16 + 2 * (k)] = (unsigned)t_; F.MISC[17 + 2 * (k)] = (unsigned)(t_ >> 32); } } while (0)
#else
#define STAMP(k) do { } while (0)
#endif
    STAMP(0);
#define SEAM(k) do { if (IN((k) + 1)) { if ((k) == 0) xcd_barrier<true>(bar); else xcd_barrier<false>(gbar); } STAMP((k) + 1); } while (0)
    bf16* XB = (bf16*)(F.ws + WS_XB); bf16* H = (bf16*)(F.ws + WS_H); pg8::ssq_t* ssq = (pg8::ssq_t*)(F.ws + WS_SSQ);
    const int bx = (int)blockIdx.x;

    if (IN(0)) { p0_prologue(F); SEAM(0); }
#define FFN_GU(ph, f, sin) if (IN(ph)) { pg8::Gemm g{XB, (const bf16*)(F.ws + WS_WGU) + (size_t)(f) * 2 * FF * D, M, 2 * FF, D}; pg8::StaticOrder S; S.init(MP, 2 * FF, F.G, bx); \
        pg8::EpiGateUp E{H, FF, ssq + (size_t)(sin) * M, (LAS float*)(F.lds + RSTD_OFF)}; pg8::gemm_phase<pg8::EpiGateUp, pg8::StaticOrder, true, true>(F.lds + RING_OFF, g, S, E); SEAM(ph); }
#define FFN_DN(ph, f, sout) if (IN(ph)) { pg8::Gemm g{H, (const bf16*)(F.ws + WS_WD) + (size_t)(f) * D * FF, M, D, FF}; pg8::StaticOrder S; S.init(MP, D, F.G, bx); \
        pg8::EpiResid<0> E{(ph) == 2 ? F.in[0] : nullptr, (ph) == 2 ? F.in[1] : nullptr, XB, ssq + (size_t)(sout) * M, 0.5f}; pg8::gemm_phase<pg8::EpiResid<0>, pg8::StaticOrder, true, true>(F.lds + RING_OFF, g, S, E); SEAM(ph); }
    FFN_GU(1, 0, 0)
    FFN_DN(2, 0, 1)
#if defined(PROBE_SSM)
    if (IN(3)) { ssm_phase_pass(F, 0); if (PROBE_SSM == 1) { xcd_barrier<false>(gbar); ssm_phase_pass(F, 0); } xcd_barrier<false>(gbar); ssm_phase_pass(F, 1); if (PROBE_SSM == 2) { xcd_barrier<false>(gbar); ssm_phase_pass(F, 1); } SEAM(3); }
#else
    if (IN(3)) { ssm_phase_pass(F, 0); xcd_barrier<false>(gbar); ssm_phase_pass(F, 1); SEAM(3); }
#endif
    if (IN(4)) { pg8::Gemm g{(const bf16*)(F.ws + WS_G), (const bf16*)(F.ws + WS_WGLU), M, 2 * D, D}; pg8::StaticOrder S; S.init(MP, 2 * D, F.G, bx);
        pg8::EpiResid<1> E{nullptr, nullptr, XB, ssq + (size_t)2 * M, 1.0f}; pg8::gemm_phase<pg8::EpiResid<1>, pg8::StaticOrder, true, true>(F.lds + RING_OFF, g, S, E); SEAM(4); }
    FFN_GU(5, 1, 2)
    FFN_DN(6, 1, 3)
    FFN_GU(7, 2, 3)
    FFN_DN(8, 2, 4)
    if (IN(9)) { pg8::Gemm g{XB, (const bf16*)(F.ws + WS_WIN), M, 3 * D, D}; pg8::StaticOrder S; S.init(MP, 3 * D, F.G, bx);
        pg8::EpiConvIn E{(bf16*)(F.ws + WS_Z), (bf16*)(F.ws + WS_GB), ssq + (size_t)4 * M, F.out + O_CP, F.out + O_CS, (LAS float*)(F.lds + RSTD_OFF)};
        pg8::gemm_phase<pg8::EpiConvIn, pg8::StaticOrder, true, true>(F.lds + RING_OFF, g, S, E); SEAM(9); }
    if (IN(10)) { conv_phase(F); SEAM(10); }
    if (IN(11)) { pg8::Gemm g{(const bf16*)(F.ws + WS_A2), (const bf16*)(F.ws + WS_WOUT), M, D, D}; pg8::StaticOrder S; S.init(MP, D, F.G, bx);
        pg8::EpiResid<0> E{nullptr, nullptr, XB, ssq + (size_t)5 * M, 1.0f}; pg8::gemm_phase<pg8::EpiResid<0>, pg8::StaticOrder, true, true>(F.lds + RING_OFF, g, S, E); SEAM(11); }
    FFN_GU(12, 3, 5)
    FFN_DN(13, 3, 6)
    if (IN(14)) { final_phase(F); }
#if defined(PROBE_DRY)
#ifndef PROBE_VARIANT
#define PROBE_VARIANT 0
#endif
    xcd_barrier<false>(gbar); STAMP(15); if (blockIdx.x == 0 && F.tid == 0) { const unsigned long long c_ = __builtin_amdgcn_s_memtime(); F.MISC[60] = (unsigned)c_; F.MISC[61] = (unsigned)(c_ >> 32); }
#if PROBE_DRY == 2
    { pg8::Gemm g{XB, (const bf16*)(F.ws + WS_WGU), M, 2 * FF, D}; SameOrder S; S.init(MP, 2 * FF, F.G, bx);
      pg8::EpiNull E{H + (size_t)M * FF - 1}; pg8::gemm_phase<pg8::EpiNull, SameOrder, true, true>(F.lds + RING_OFF, g, S, E); }
#else
#if PROBE_DRY == 3
    { pg8::Gemm g{XB, (const bf16*)(F.ws + WS_WGU) + (size_t)3 * 2 * FF * D, M, 2 * FF, D}; pg8::StaticOrder S; S.init(MP, 2 * FF, F.G, bx);
      pg8::EpiGateUp E{H, FF, ssq + (size_t)5 * M, (LAS float*)(F.lds + RSTD_OFF)}; pg8::gemm_phase<pg8::EpiGateUp, pg8::StaticOrder, true, true, PROBE_VARIANT>(F.lds + RING_OFF, g, S, E); }
#else
    { pg8::Gemm g{XB, (const bf16*)(F.ws + WS_WGU), M, 2 * FF, D}; pg8::StaticOrder S; S.init(MP, 2 * FF, F.G, bx);
      pg8::EpiNull E{H + (size_t)M * FF - 1}; pg8::gemm_phase<pg8::EpiNull, pg8::StaticOrder, true, true, PROBE_VARIANT>(F.lds + RING_OFF, g, S, E); }
#endif
#endif
    xcd_barrier<false>(gbar); STAMP(16); if (blockIdx.x == 0 && F.tid == 0) { const unsigned long long c_ = __builtin_amdgcn_s_memtime(); F.MISC[62] = (unsigned)c_; F.MISC[63] = (unsigned)(c_ >> 32); }
#endif
#if defined(PROBE_A_LO)
    __syncthreads();
    if (blockIdx.x == 0 && F.tid == 0) {
#if !defined(PROBE_DRY)
        STAMP(15);
#endif
#define TS(k) ((unsigned long long)F.MISC[16 + 2 * (k)] | ((unsigned long long)F.MISC[17 + 2 * (k)] << 32))
        const unsigned long long ta = TS(PROBE_A_HI) - TS(PROBE_A_LO), tb = TS(PROBE_B_HI) - TS(PROBE_B_LO);
#if defined(PROBE_CLOCK)
        { const unsigned long long c0 = (unsigned long long)F.MISC[60] | ((unsigned long long)F.MISC[61] << 32), c1 = (unsigned long long)F.MISC[62] | ((unsigned long long)F.MISC[63] << 32);
          F.out[0] += (float)(c1 - c0) / (float)(TS(16) - TS(15)) * 1e-2f; }
#else
        F.out[0] += (float)tb * 1e-5f;
#endif
        const unsigned long long t0 = __builtin_amdgcn_s_memrealtime();
        const unsigned long long spin = ta * 4ull < 1000000ull ? ta * 4ull : 1000000ull;
        while (__builtin_amdgcn_s_memrealtime() - t0 < spin) __builtin_amdgcn_s_sleep(8);
    }
#endif
#undef IN
#undef SEAM
}

extern "C" void kernel_launch(void* const* d_in, const int* in_sizes, int n_in, void* d_out, int out_size, void* d_ws, size_t ws_size, hipStream_t stream) {
    static int grid = 0;
    if (grid == 0) {
        if (n_in != 21 || out_size != (int)O_END || ws_size < WS_END) { fprintf(stderr, "kernel_launch: unexpected shapes: n_in %d out %d ws %zu; nothing launched\n", n_in, out_size, ws_size); grid = -1; return; }
        int dev = 0, cus = 0, per_cu = 0;
        if (hipGetDevice(&dev) != hipSuccess || hipDeviceGetAttribute(&cus, hipDeviceAttributeMultiprocessorCount, dev) != hipSuccess) { grid = -1; return; }
        if (hipFuncSetAttribute((const void*)skel_fwd, hipFuncAttributeMaxDynamicSharedMemorySize, LDS_BYTES) != hipSuccess) { fprintf(stderr, "kernel_launch: hipFuncSetAttribute failed\n"); grid = -1; return; }
        if (hipOccupancyMaxActiveBlocksPerMultiprocessor(&per_cu, (const void*)skel_fwd, NWAVES * 64, LDS_BYTES) != hipSuccess || per_cu < 1) fprintf(stderr, "kernel_launch: occupancy query reports %d\n", per_cu);
        (void)hipGetLastError();
        if (cus < 256) { fprintf(stderr, "kernel_launch: built for a 256-CU device (8 groups x 32 workgroups), found %d CUs; nothing launched\n", cus); grid = -1; return; }
        grid = 256;
    }
    if (grid < 0) return;
    if (hipMemsetAsync((char*)d_ws + WS_CTL, 0, CTL_ZERO_BYTES, stream) != hipSuccess) return;
    Args a{};
    for (int i = 0; i < 21; ++i) a.in[i] = (const float*)d_in[i];
    a.out = (float*)d_out; a.ws = (unsigned char*)d_ws;
    a.ph_lo = 0; a.ph_hi = N_PHASES;
    hipLaunchKernelGGL(skel_fwd, dim3(grid), dim3(NWAVES * 64), LDS_BYTES, stream, a);
}
```
